# Optimizing an MI355X kernel written in HIP

```python
import math
import numpy as np
import jax
import jax.numpy as jnp
from jax import lax

D_MODEL = 2048
BATCH = 1
SEQ = 16384
DEPTH = 2

N_META = 16
GRID_W = 64
C_HY = 1024
HY_ORDER = 2
HY_EMB = 33
HY_HID = 64
SHORT_K = 3
C_FN = 1024
FN_GROUPS = 4
C_NA = 1024
NA_HEADS = 16
NA_HEAD_DIM = C_NA // NA_HEADS
NA_KH_MAX = 8
NA_KW = 16
NA_QB = 16
NA_KU = 32
N_BRANCH = 3
EPS = 1e-6
NEG_INF = -1e30
SPLIT_SIZES = ((HY_ORDER + 1) * C_HY, C_HY, C_FN, C_FN, 3 * C_NA, C_NA, N_BRANCH * D_MODEL)
N_IN = sum(SPLIT_SIZES)

kernel_name = 'hybrid_hyena_fnet_natten_encoder'


def rmsnorm(x, g):
    xf = x.astype(jnp.float32)
    y = xf * lax.rsqrt(jnp.mean(xf * xf, axis=-1, keepdims=True) + EPS)
    return (y * g.astype(jnp.float32)).astype(x.dtype)


def short_conv(x, w, b):
    L = x.shape[1]
    p = SHORT_K // 2
    xp = jnp.pad(x, ((0, 0), (p, p), (0, 0)))
    y = xp[:, 0:L] * w[0]
    for j in range(1, SHORT_K):
        y = y + xp[:, j:j + L] * w[j]
    return y + b


def hyena_filters(L, w1, b1, w2, b2, w3, b3, w4, freq, decay):
    f32 = jnp.float32
    t = jnp.linspace(0.0, 1.0, L, dtype=f32)[:, None]
    bands = (HY_EMB - 1) // 2
    w = 2.0 * math.pi * jnp.arange(L, dtype=f32)[:, None] / L
    f = jnp.linspace(1e-4, bands - 1, bands, dtype=f32)[None, :]
    z = jnp.concatenate([t, jnp.cos(f * w), -jnp.sin(f * w)], axis=-1)
    fr = freq.astype(f32)
    h = jnp.sin(fr * (z @ w1.astype(f32) + b1.astype(f32)))
    h = jnp.sin(fr * (h @ w2.astype(f32) + b2.astype(f32)))
    h = jnp.sin(fr * (h @ w3.astype(f32) + b3.astype(f32)))
    h = (h @ w4.astype(f32)).reshape(L, HY_ORDER, 2, C_HY)
    h = h * jnp.exp(-t[:, :, None, None] * jnp.abs(decay.astype(f32)))
    hf = h[:, :, 0]
    hb = h[:, :, 1]
    k = jnp.concatenate([hf, jnp.zeros((1, HY_ORDER, C_HY), f32), hb[1:][::-1]], axis=0)
    return jnp.fft.rfft(k, axis=0)


def fftconv(v, kf, skip):
    L = v.shape[1]
    vf = jnp.fft.rfft(v.astype(jnp.float32), n=2 * L, axis=1)
    y = jnp.fft.irfft(vf * kf[None], n=2 * L, axis=1)[:, :L]
    return y + v.astype(jnp.float32) * skip.astype(jnp.float32)


def hyena_mixer(u, x1, x2, kf, skip):
    z = fftconv(u, kf[:, 0], skip[0])
    z = x1.astype(jnp.float32) * z
    z = fftconv(z, kf[:, 1], skip[1])
    z = x2.astype(jnp.float32) * z
    return z.astype(u.dtype)


def fourier_mixer(xb):
    B, L, C = xb.shape
    xg = xb.astype(jnp.float32).reshape(B, L, FN_GROUPS, C // FN_GROUPS)
    y = jnp.fft.fft2(xg, axes=(1, 3), norm='ortho').real
    return y.reshape(B, L, C).astype(xb.dtype)


def na_tables(rows):
    kh = min(NA_KH_MAX, rows)
    rs = np.clip(np.arange(rows) - kh // 2, 0, rows - kh)
    cs = np.clip(np.arange(GRID_W) - NA_KW // 2, 0, GRID_W - NA_KW)
    ncb = GRID_W // NA_QB
    cu = np.clip(np.arange(ncb) * NA_QB - NA_KW // 2, 0, GRID_W - NA_KU)
    col_idx = cu[:, None] + np.arange(NA_KU)[None, :]
    qcol = np.arange(ncb)[:, None] * NA_QB + np.arange(NA_QB)[None, :]
    kcol = col_idx[:, None, :]
    qcs = cs[qcol][:, :, None]
    mask = (kcol >= qcs) & (kcol < qcs + NA_KW)
    dc_idx = np.clip(kcol - qcol[:, :, None] + NA_KW - 1, 0, 2 * NA_KW - 2)
    return kh, rs, col_idx, mask, dc_idx


def neighborhood_attention(q, k, v, rpb, meta_bias):
    B, Lt, _ = q.shape
    n = Lt - N_META
    rows = n // GRID_W
    kh, rs, col_idx, mask, dc_idx = na_tables(rows)
    H, dh = NA_HEADS, NA_HEAD_DIM
    scale = dh ** -0.5
    f32 = jnp.float32

    def heads(t):
        return t.reshape(B, Lt, H, dh).transpose(0, 2, 1, 3)

    qh, kh_, vh = heads(q), heads(k), heads(v)
    q_m, k_m, v_m = qh[:, :, :N_META], kh_[:, :, :N_META], vh[:, :, :N_META]

    def grid(t):
        return t[:, :, N_META:].reshape(B, H, rows, GRID_W, dh)

    q_g, k_g, v_g = grid(qh), grid(kh_), grid(vh)
    mb = meta_bias.astype(f32)
    rpb32 = rpb.astype(f32)

    s_m = jnp.einsum('bhqd,bhmd->bhqm', q_m, k_m).astype(f32) * scale + mb[None, :, None, :]
    o_m = jnp.einsum('bhqm,bhmd->bhqd', jax.nn.softmax(s_m, axis=-1).astype(v.dtype), v_m)

    ncb = GRID_W // NA_QB

    def row(args):
        q_r, r, r0 = args
        kb = lax.dynamic_slice_in_dim(k_g, r0, kh, axis=2)[:, :, :, col_idx]
        vb = lax.dynamic_slice_in_dim(v_g, r0, kh, axis=2)[:, :, :, col_idx]
        qb = q_r.reshape(B, H, ncb, NA_QB, dh)
        s_g = jnp.einsum('bhnqd,bhrnkd->bhnqrk', qb, kb).astype(f32) * scale
        dr = r0 + jnp.arange(kh, dtype=jnp.int32) - r + (NA_KH_MAX - 1)
        bias = jnp.take(rpb32, dr, axis=1)[:, :, dc_idx]
        s_g = s_g + bias.transpose(0, 2, 3, 1, 4)[None]
        s_g = jnp.where(mask[:, :, None, :], s_g, NEG_INF)
        s_x = jnp.einsum('bhnqd,bhmd->bhnqm', qb, k_m).astype(f32) * scale + mb[None, :, None, None, :]
        s = jnp.concatenate([s_g.reshape(B, H, ncb, NA_QB, kh * NA_KU), s_x], axis=-1)
        p = jax.nn.softmax(s, axis=-1).astype(v.dtype)
        p_g = p[..., :kh * NA_KU].reshape(B, H, ncb, NA_QB, kh, NA_KU)
        p_x = p[..., kh * NA_KU:]
        o = jnp.einsum('bhnqrk,bhrnkd->bhnqd', p_g, vb) + jnp.einsum('bhnqm,bhmd->bhnqd', p_x, v_m)
        return o.reshape(B, H, GRID_W, dh)

    o_rows = lax.map(row, (jnp.moveaxis(q_g, 2, 0), jnp.arange(rows, dtype=jnp.int32),
                           jnp.asarray(rs, dtype=jnp.int32)))
    o_g = jnp.moveaxis(o_rows, 0, 2).reshape(B, H, n, dh)
    o = jnp.concatenate([o_m, o_g], axis=2)
    return o.transpose(0, 2, 1, 3).reshape(B, Lt, C_NA)


def mixer_layer(h, norm_g, w_in, conv_w, conv_b, w1, b1, w2, b2, w3, b3, w4, freq, decay, skip,
                rpb, meta_bias, w_a, w_b, w_c, w_out):
    L = h.shape[1]
    xn = rmsnorm(h, norm_g)
    z = xn @ w_in
    idx = [int(i) for i in np.cumsum(SPLIT_SIZES)[:-1]]
    hy_in, hy_gate, fn_in, fn_gate, qkv, na_gate, merge = jnp.split(z, idx, axis=-1)
    hy_in = short_conv(hy_in, conv_w, conv_b)
    u, x1, x2 = jnp.split(hy_in, HY_ORDER + 1, axis=-1)
    kf = hyena_filters(L, w1, b1, w2, b2, w3, b3, w4, freq, decay)
    y_a = hyena_mixer(u, x1, x2, kf, skip) * jax.nn.silu(hy_gate)
    y_b = fourier_mixer(fn_in) * jax.nn.silu(fn_gate)
    q, k, v = jnp.split(qkv, 3, axis=-1)
    y_c = neighborhood_attention(q, k, v, rpb, meta_bias) * jax.nn.silu(na_gate)
    g_a, g_b, g_c = jnp.split(jax.nn.sigmoid(merge), N_BRANCH, axis=-1)
    m = g_a * (y_a @ w_a) + g_b * (y_b @ w_b) + g_c * (y_c @ w_c)
    return h + m @ w_out


def setup_inputs(seed: int = 0) -> dict:
    key = jax.random.key(seed)
    ks = jax.random.split(key, 24)

    def nrm(k, shape, std):
        return std * jax.random.normal(k, shape, jnp.float32)

    L = SEQ + N_META
    decay0 = jnp.linspace(math.log(1e-2) / 1.5, math.log(1e-2) / 0.3, C_HY, dtype=jnp.float32)
    return {
        'x': nrm(ks[0], (BATCH, SEQ, D_MODEL), 1.0),
        'meta_tokens': nrm(ks[1], (N_META, D_MODEL), 1.0),
        'norm_g': 1.0 + nrm(ks[2], (DEPTH, D_MODEL), 0.02),
        'w_in': nrm(ks[3], (DEPTH, D_MODEL, N_IN), D_MODEL ** -0.5),
        'hy_conv_w': nrm(ks[4], (DEPTH, SHORT_K, (HY_ORDER + 1) * C_HY), SHORT_K ** -0.5),
        'hy_conv_b': nrm(ks[5], (DEPTH, (HY_ORDER + 1) * C_HY), 0.02),
        'hy_flt_w1': nrm(ks[6], (DEPTH, HY_EMB, HY_HID), HY_EMB ** -0.5),
        'hy_flt_b1': nrm(ks[7], (DEPTH, HY_HID), 0.1),
        'hy_flt_w2': nrm(ks[8], (DEPTH, HY_HID, HY_HID), HY_HID ** -0.5),
        'hy_flt_b2': nrm(ks[9], (DEPTH, HY_HID), 0.1),
        'hy_flt_w3': nrm(ks[10], (DEPTH, HY_HID, HY_HID), HY_HID ** -0.5),
        'hy_flt_b3': nrm(ks[11], (DEPTH, HY_HID), 0.1),
        'hy_flt_w4': nrm(ks[12], (DEPTH, HY_HID, HY_ORDER * 2 * C_HY), 0.5 * L ** -0.5),
        'hy_flt_freq': 1.0 + nrm(ks[13], (DEPTH, HY_HID), 0.1),
        'hy_decay': jnp.broadcast_to(decay0, (DEPTH, HY_ORDER, 2, C_HY)) + nrm(ks[14], (DEPTH, HY_ORDER, 2, C_HY), 0.1),
        'hy_skip': nrm(ks[15], (DEPTH, HY_ORDER, C_HY), 0.5),
        'na_rpb': nrm(ks[16], (DEPTH, NA_HEADS, 2 * NA_KH_MAX - 1, 2 * NA_KW - 1), 0.1),
        'na_meta_bias': nrm(ks[17], (DEPTH, NA_HEADS, N_META), 0.1),
        'w_branch_a': nrm(ks[18], (DEPTH, C_HY, D_MODEL), C_HY ** -0.5),
        'w_branch_b': nrm(ks[19], (DEPTH, C_FN, D_MODEL), C_FN ** -0.5),
        'w_branch_c': nrm(ks[20], (DEPTH, C_NA, D_MODEL), C_NA ** -0.5),
        'w_out': nrm(ks[21], (DEPTH, D_MODEL, D_MODEL), D_MODEL ** -0.5),
        'final_g': 1.0 + nrm(ks[22], (D_MODEL,), 0.02),
    }


def reference(x, meta_tokens, norm_g, w_in, hy_conv_w, hy_conv_b, hy_flt_w1, hy_flt_b1, hy_flt_w2,
              hy_flt_b2, hy_flt_w3, hy_flt_b3, hy_flt_w4, hy_flt_freq, hy_decay, hy_skip, na_rpb,
              na_meta_bias, w_branch_a, w_branch_b, w_branch_c, w_out, final_g):
    B = x.shape[0]
    meta = jnp.broadcast_to(meta_tokens[None].astype(x.dtype), (B, N_META, D_MODEL))
    h = jnp.concatenate([meta, x], axis=1)
    for i in range(DEPTH):
        h = mixer_layer(h, norm_g[i], w_in[i], hy_conv_w[i], hy_conv_b[i],
                        hy_flt_w1[i], hy_flt_b1[i], hy_flt_w2[i], hy_flt_b2[i], hy_flt_w3[i], hy_flt_b3[i],
                        hy_flt_w4[i], hy_flt_freq[i], hy_decay[i], hy_skip[i],
                        na_rpb[i], na_meta_bias[i], w_branch_a[i], w_branch_b[i], w_branch_c[i], w_out[i])
    return rmsnorm(h, final_g)[:, N_META:]
```

```cpp
#include <hip/hip_runtime.h>
#include <hip/hip_cooperative_groups.h>
#include <cstdio>
namespace cg = cooperative_groups;

#define LAS __attribute__((address_space(3)))
typedef unsigned short bf16_t;
typedef short bf16x8 __attribute__((ext_vector_type(8)));
typedef float f32x4 __attribute__((ext_vector_type(4)));
typedef unsigned u32x4 __attribute__((ext_vector_type(4)));
typedef unsigned u32x2 __attribute__((ext_vector_type(2)));

constexpr int L_TOK = 16400, LP = 16640, DM = 2048, NIN = 16384, NMETA = 16, NMAIN = 16384;
constexpr int FN1 = 164, FN2 = 100, FN1P = 192, PROWS = FN2 * FN1P;
constexpr int NTHREADS = 512, LDS_BYTES = 155648;

constexpr size_t SZ_H = (size_t)LP * DM * 4, SZ_XN = (size_t)LP * DM * 2, SZ_XNP = (size_t)PROWS * DM * 2;
constexpr size_t OFF_H = 0;
constexpr size_t OFF_XN = OFF_H + SZ_H;
constexpr size_t OFF_XNP = OFF_XN + SZ_XN;
constexpr size_t OFF_A1 = OFF_XN;
constexpr size_t SZ_A1 = (size_t)FN1 * 1024 * 2 * 128 * 2;
constexpr size_t OFF_HYOUT = OFF_A1 + SZ_A1;
constexpr size_t SZ_HYOUT = (size_t)1024 * LP * 2;
static_assert(OFF_HYOUT + SZ_HYOUT <= OFF_XNP + SZ_XNP, "alias overflow");
constexpr size_t OFF_WT = OFF_XNP + SZ_XNP;
constexpr size_t OFF_WEFF = OFF_WT + (size_t)NIN * DM * 2;
constexpr size_t OFF_WA = OFF_WEFF + (size_t)2048 * 2048 * 2;
constexpr size_t SZ_WBR = (size_t)2048 * 1024 * 2;
constexpr size_t OFF_WO = OFF_WA + 3 * SZ_WBR;
constexpr size_t OFF_HYIN = OFF_WO + (size_t)2048 * 2048 * 2;
constexpr size_t OFF_GATE = OFF_HYIN + (size_t)3072 * LP * 2;
constexpr size_t SZ_GATE = (size_t)LP * 1024 * 2;
constexpr size_t OFF_QKV = OFF_GATE + 3 * SZ_GATE;
constexpr size_t OFF_MERGE = OFF_QKV + (size_t)LP * 3072 * 2;
constexpr size_t OFF_ZT = OFF_MERGE + (size_t)LP * 6144 * 2;
constexpr size_t SZ_ZT = (size_t)2048 * PROWS * 2;
constexpr size_t OFF_M = OFF_ZT;
static_assert(SZ_XN <= SZ_ZT, "alias overflow");
constexpr size_t OFF_FA = OFF_ZT + SZ_ZT;
constexpr size_t OFF_FB = OFF_FA + (size_t)512 * 384 * 2;
constexpr size_t OFF_H3 = OFF_FB + (size_t)FN1 * 256 * 256 * 2;
constexpr size_t WS_END = OFF_H3 + (size_t)2 * L_TOK * 64 * 4;
constexpr size_t HS_HEO = 0, HS_CORR = 131328, HS_Z2 = HS_CORR + 65536, HS_STRIDE = HS_Z2 + 65792;
static_assert(HS_STRIDE * 256 <= (size_t)NMAIN * DM * 4, "scratch overflow");

struct Params {
    const float* x; const float* meta; const float* norm_g; const float* w_in; const float* conv_w; const float* conv_b;
    const float* f_w1; const float* f_b1; const float* f_w2; const float* f_b2; const float* f_w3; const float* f_b3; const float* f_w4;
    const float* f_freq; const float* decay; const float* skip; const float* rpb; const float* meta_bias;
    const float* w_a; const float* w_b; const float* w_c; const float* w_out; const float* final_g;
    float* out; unsigned char* ws;
};

__device__ __forceinline__ int opaque_tid() { int t = threadIdx.x; asm volatile("" : "+v"(t)); return t; }
__device__ __forceinline__ float bf2f(bf16_t b) { return __uint_as_float(((unsigned)b) << 16); }
__device__ __forceinline__ bf16_t f2bf(float f) { unsigned u = __float_as_uint(f); u += 0x7FFFu + ((u >> 16) & 1u); return (bf16_t)(u >> 16); }
__device__ __forceinline__ unsigned cvt_pk_bf16(float lo, float hi) { unsigned r; asm volatile("v_cvt_pk_bf16_f32 %0, %1, %2" : "=v"(r) : "v"(lo), "v"(hi)); return r; }
__device__ __forceinline__ float lo_bf(unsigned u) { return __uint_as_float(u << 16); }
__device__ __forceinline__ float hi_bf(unsigned u) { return __uint_as_float(u & 0xffff0000u); }
__device__ __forceinline__ float silu_f(float v) { return v / (1.0f + __expf(-v)); }
__device__ __forceinline__ float sigm_f(float v) { return 1.0f / (1.0f + __expf(-v)); }
__device__ __forceinline__ float wave_sum(float v) {
#pragma unroll
    for (int o = 32; o >= 1; o >>= 1) v += __shfl_xor(v, o);
    return v;
}

namespace pg8 {
constexpr int BM = 256, BK = 64, HALF = 128, HTB = HALF * BK * 2, STAGE_BYTES = 8 * HTB;
__device__ __forceinline__ int lds_byte(int r, int c) { const int st = (r >> 4) * 2 + (c >> 5), rr = r & 15, cc = c & 31, ob = rr * 64 + cc * 2; return st * 1024 + (ob ^ (((ob >> 9) & 1) << 5)); }
__device__ __forceinline__ void stage_rc(int b, int& R, int& C) { const int st = b / 1024, sb = b % 1024, swz = sb ^ (((sb >> 9) & 1) << 5); R = (st >> 1) * 16 + swz / 64; C = (st & 1) * 32 + (swz % 64) / 2; }
__device__ __forceinline__ int perm32(int rho) { const int n = rho >> 4, i = rho & 15; return 8 * (i >> 2) + 4 * n + (i & 3); }

struct Unit { int pm, pn, aux; size_t offA, offB; };
struct Gemm { const char* base; int lda, ldb, nt, ksplit; long jumpA, jumpB; };

__device__ __forceinline__ void tile_map(int wgid, int nM, int nN, int& pm, int& pn) {
    const int nwg = nM * nN;
    { const int q = nwg / 8, r = nwg % 8, xcd = wgid % 8, off = wgid / 8; wgid = (xcd < r ? xcd * (q + 1) : r * (q + 1) + (xcd - r) * q) + off; }
    const int nig = 8 * nN, gid = wgid / nig, fm = gid * 8, gsz = (nM - fm) < 8 ? (nM - fm) : 8;
    pm = fm + ((wgid % nig) % gsz); pn = (wgid % nig) / gsz;
}

template <class Epi, class Sched>
__device__ __forceinline__ void gemm_phase(LAS unsigned char* lds, const Gemm g, const Sched& S, const Epi& E) {
    const int tid = opaque_tid(), wid = __builtin_amdgcn_readfirstlane(tid >> 6), lane = tid & 63, wr = wid >> 2, wc = wid & 3, fr = lane & 15, fq = lane >> 4;
    const int nt = g.nt;
    unsigned voffA[2], voffB[2];
#pragma unroll
    for (int i = 0; i < 2; ++i) { int R, C; stage_rc(tid * 16 + i * 8192, R, C); const int Rb = (R & ~31) + perm32(R & 31);
        voffA[i] = (unsigned)(R * g.lda + C) * 2u; voffB[i] = (unsigned)(Rb * g.ldb + C) * 2u; }
    const size_t kstep = (size_t)(BK * 2);
    const size_t hstepA = (size_t)HALF * g.lda * 2, hstepB = (size_t)HALF * g.ldb * 2;
    const unsigned ldsw = (unsigned)wid * 1024u;
    const int aoff = lds_byte(wr * 64 + fr, fq * 8), boff = lds_byte(wc * 32 + fr, fq * 8);
#define PG8_KA(p, t) ((p) + (size_t)(t) * kstep + ((t) >= g.ksplit ? g.jumpA : 0l))
#define PG8_KB(p, t) ((p) + (size_t)(t) * kstep + ((t) >= g.ksplit ? g.jumpB : 0l))
#define PG8_SA(b, h) (((b) * 2 + (h)) * HTB)
#define PG8_SB(b, h) ((4 + (b) * 2 + (h)) * HTB)
#define PG8_STAGE(bufoff, gbase, voff) do { _Pragma("unroll") for (int _i = 0; _i < 2; ++_i) \
        __builtin_amdgcn_global_load_lds((const unsigned*)((const char*)(gbase) + (voff)[_i]), (LAS unsigned*)(lds + (bufoff) + ldsw + _i * 8192), 16, 0, 0); } while (0)
#define PG8_LDA(dst, b, h) do { _Pragma("unroll") for (int m = 0; m < 4; ++m) _Pragma("unroll") for (int k = 0; k < 2; ++k) dst[m][k] = *(const LAS bf16x8*)(lds + PG8_SA(b, h) + aoff + m * 2048 + k * 1024); } while (0)
#define PG8_LDB(dst, b, h) do { _Pragma("unroll") for (int n = 0; n < 2; ++n) _Pragma("unroll") for (int k = 0; k < 2; ++k) dst[n][k] = *(const LAS bf16x8*)(lds + PG8_SB(b, h) + boff + n * 2048 + k * 1024); } while (0)
#define PG8_MMA(ai, bj, At, Bt) do { __builtin_amdgcn_s_setprio(1); _Pragma("unroll") for (int m = 0; m < 4; ++m) _Pragma("unroll") for (int n = 0; n < 2; ++n) _Pragma("unroll") for (int k = 0; k < 2; ++k) \
        acc[ai][bj][m][n] = __builtin_amdgcn_mfma_f32_16x16x32_bf16(Bt[n][k], At[m][k], acc[ai][bj][m][n], 0, 0, 0); __builtin_amdgcn_s_setprio(0); } while (0)
#define PG8_WAIT_V(n) asm volatile("s_waitcnt vmcnt(" #n ")" ::: "memory")
#define PG8_WAIT_L(n) asm volatile("s_waitcnt lgkmcnt(" #n ")" ::: "memory")
#define PG8_BAR __builtin_amdgcn_s_barrier()
#define PG8_SCHED __builtin_amdgcn_sched_barrier(0)
    Unit cur, nxt; int ui = 0;
    if (!S.next(0, cur)) return;
    f32x4 acc[2][2][4][2];
#pragma unroll
    for (int a = 0; a < 2; ++a)
#pragma unroll
        for (int b = 0; b < 2; ++b)
#pragma unroll
            for (int m = 0; m < 4; ++m)
#pragma unroll
                for (int n = 0; n < 2; ++n) acc[a][b][m][n] = (f32x4){0.f, 0.f, 0.f, 0.f};
    bf16x8 At[4][2], B0[2][2], B1[2][2];
    const char* cA = g.base + cur.offA; const char* cB = g.base + cur.offB;
    PG8_STAGE(PG8_SB(0, 0), cB, voffB); PG8_STAGE(PG8_SA(0, 0), cA, voffA); PG8_STAGE(PG8_SB(0, 1), cB + hstepB, voffB); PG8_STAGE(PG8_SA(0, 1), cA + hstepA, voffA);
    if (wr == 1) PG8_BAR;
    PG8_WAIT_V(4); PG8_BAR;
    PG8_STAGE(PG8_SB(1, 0), PG8_KB(cB, 1), voffB); PG8_STAGE(PG8_SA(1, 0), PG8_KA(cA, 1), voffA); PG8_STAGE(PG8_SB(1, 1), PG8_KB(cB, 1) + hstepB, voffB);
    PG8_WAIT_V(6); PG8_BAR;
    for (;;) {
        const bool has_next = S.next(ui + 1, nxt);
        const char* nA = has_next ? g.base + nxt.offA : cA; const char* nB = has_next ? g.base + nxt.offB : cB;
        for (int t = 0; t < nt; t += 2) {
            const bool last = (t == nt - 2);
            const char* a1 = PG8_KA(cA, t + 1);
            const char* a2 = last ? nA : PG8_KA(cA, t + 2); const char* b2 = last ? nB : PG8_KB(cB, t + 2);
            const char* a3 = last ? PG8_KA(nA, 1) : PG8_KA(cA, t + 3); const char* b3 = last ? PG8_KB(nB, 1) : PG8_KB(cB, t + 3);
            PG8_LDB(B0, 0, 0); PG8_SCHED; PG8_LDA(At, 0, 0); PG8_STAGE(PG8_SA(1, 1), a1 + hstepA, voffA);
            PG8_WAIT_L(8); PG8_BAR; PG8_WAIT_L(0); PG8_MMA(0, 0, At, B0); PG8_BAR; PG8_SCHED;
            PG8_LDB(B1, 0, 1); PG8_STAGE(PG8_SB(0, 0), b2, voffB);
            PG8_BAR; PG8_WAIT_L(0); PG8_MMA(0, 1, At, B1); PG8_BAR;
            PG8_LDA(At, 0, 1); PG8_STAGE(PG8_SA(0, 0), a2, voffA);
            PG8_BAR; PG8_WAIT_L(0); PG8_MMA(1, 0, At, B0); PG8_BAR; PG8_SCHED;
            PG8_STAGE(PG8_SB(0, 1), b2 + hstepB, voffB);
            PG8_WAIT_V(6); PG8_BAR; PG8_MMA(1, 1, At, B1); PG8_BAR;
            PG8_LDB(B0, 1, 0); PG8_SCHED; PG8_LDA(At, 1, 0); PG8_STAGE(PG8_SA(0, 1), a2 + hstepA, voffA);
            PG8_WAIT_L(8); PG8_BAR; PG8_WAIT_L(0); PG8_MMA(0, 0, At, B0); PG8_BAR; PG8_SCHED;
            PG8_LDB(B1, 1, 1); PG8_STAGE(PG8_SB(1, 0), b3, voffB);
            PG8_BAR; PG8_WAIT_L(0); PG8_MMA(0, 1, At, B1); PG8_BAR;
            PG8_LDA(At, 1, 1); PG8_STAGE(PG8_SA(1, 0), a3, voffA);
            PG8_BAR; PG8_WAIT_L(0); PG8_MMA(1, 0, At, B0); PG8_BAR; PG8_SCHED;
            PG8_STAGE(PG8_SB(1, 1), b3 + hstepB, voffB);
            PG8_WAIT_V(6); PG8_BAR; PG8_MMA(1, 1, At, B1); PG8_BAR;
        }
        E(acc, cur, wr, wc, fr, fq);
        if (!has_next) break;
#pragma unroll
        for (int a = 0; a < 2; ++a)
#pragma unroll
            for (int b = 0; b < 2; ++b)
#pragma unroll
                for (int m = 0; m < 4; ++m)
#pragma unroll
                    for (int n = 0; n < 2; ++n) acc[a][b][m][n] = (f32x4){0.f, 0.f, 0.f, 0.f};
        cur = nxt; cA = nA; cB = nB; ++ui;
    }
    PG8_WAIT_V(0);
    if (wr == 0) PG8_BAR;
    PG8_BAR;
#undef PG8_KA
#undef PG8_KB
#undef PG8_SA
#undef PG8_SB
#undef PG8_STAGE
#undef PG8_LDA
#undef PG8_LDB
#undef PG8_MMA
#undef PG8_WAIT_V
#undef PG8_WAIT_L
#undef PG8_BAR
#undef PG8_SCHED
}
}
using pg8::Unit; using pg8::Gemm;
#define ACC_T const f32x4 (&acc)[2][2][4][2]

enum { K_TOK = 0, K_HYIN = 1, K_F0 = 2, K_FNA = 3, K_FNB = 4, K_BR = 5, K_OUT = 6 };
struct SchedAny {
    int kind, G, c;
    __device__ __forceinline__ bool next(int i, Unit& u) const {
        const long Lx = (long)i * G + c;
        switch (kind) {
        case K_TOK: {
            if (Lx >= 65l * 48) return false; int pn; pg8::tile_map((int)Lx, 65, 48, u.pm, pn); u.pn = pn < 4 ? 12 + pn : 16 + pn; u.aux = 0;
            u.offA = OFF_XN + (size_t)u.pm * 256 * DM * 2; u.offB = OFF_WT + (size_t)u.pn * 256 * DM * 2; return true; }
        case K_HYIN: {
            if (Lx >= 12l * 65) return false; pg8::tile_map((int)Lx, 12, 65, u.pm, u.pn); u.aux = 0;
            u.offA = OFF_WT + (size_t)u.pm * 256 * DM * 2; u.offB = OFF_XN + (size_t)u.pn * 256 * DM * 2; return true; }
        case K_F0: {
            if (Lx >= 8l * 75) return false; pg8::tile_map((int)Lx, 8, 75, u.pm, u.pn); u.aux = 0;
            u.offA = OFF_WEFF + (size_t)u.pm * 256 * DM * 2; u.offB = OFF_XNP + (size_t)u.pn * 256 * DM * 2; return true; }
        case K_FNA: {
            if (Lx >= 2l * 400) return false; pg8::tile_map((int)Lx, 2, 400, u.pm, u.pn); u.aux = 0;
            u.offA = OFF_FA + (size_t)u.pm * 256 * 384 * 2; u.offB = OFF_ZT + (size_t)u.pn * 256 * FN1P * 2; return true; }
        case K_FNB: {
            if (Lx >= 164l * 4) return false; u.aux = (int)(Lx >> 2); u.pm = 0; u.pn = (int)(Lx & 3);
            u.offA = OFF_FB + (size_t)u.aux * 256 * 256 * 2; u.offB = OFF_A1 + (size_t)u.aux * 1024 * 256 * 2 + (size_t)u.pn * 256 * 256 * 2; return true; }
        case K_BR: {
            const int T = (i / 3) * G + c; if (T >= 65 * 8) return false; const int br = i % 3; pg8::tile_map(T, 65, 8, u.pm, u.pn); u.aux = br;
            u.offA = OFF_GATE + (size_t)br * SZ_GATE + (size_t)u.pm * 256 * 1024 * 2; u.offB = OFF_WA + (size_t)br * SZ_WBR + (size_t)u.pn * 256 * 1024 * 2; return true; }
        default: {
            if (Lx >= 65l * 8) return false; pg8::tile_map((int)Lx, 65, 8, u.pm, u.pn); u.aux = 0;
            u.offA = OFF_M + (size_t)u.pm * 256 * DM * 2; u.offB = OFF_WO + (size_t)u.pn * 256 * DM * 2; return true; }
        }
    }
};
#define ROWFENCE asm volatile("" ::: "memory")
#define HARDFENCE do { asm volatile("" ::: "memory"); __builtin_amdgcn_sched_barrier(0); } while (0)
struct EpiAny {
    int kind; unsigned char* ws;
    __device__ __forceinline__ void operator()(ACC_T, const Unit& u, int wr, int wc, int fr, int fq) const {
        const int rl0 = wr * 64 + fr, cl0 = wc * 32 + 8 * fq;
        if (kind == K_TOK) {
            const int t = u.pn; unsigned char* dst; unsigned ld; int c0, act;
            if (t < 16)      { dst = ws + OFF_GATE;               ld = 1024; c0 = (t - 12) * 256; act = 1; }
            else if (t < 24) { dst = ws + OFF_GATE + SZ_GATE;     ld = 1024; c0 = (t - 20) * 256; act = 1; }
            else if (t < 36) { dst = ws + OFF_QKV;                ld = 3072; c0 = (t - 24) * 256; act = 0; }
            else if (t < 40) { dst = ws + OFF_GATE + 2 * SZ_GATE; ld = 1024; c0 = (t - 36) * 256; act = 1; }
            else             { dst = ws + OFF_MERGE;              ld = 6144; c0 = (t - 40) * 256; act = 2; }
#pragma unroll
            for (int ai = 0; ai < 2; ++ai)
#pragma unroll
                for (int m = 0; m < 4; ++m) { const unsigned row = (unsigned)(u.pm * 256 + ai * 128 + m * 16 + rl0);
#pragma unroll
                    for (int bj = 0; bj < 2; ++bj) { const unsigned off = (row * ld + (unsigned)(c0 + bj * 128 + cl0)) * 2u; f32x4 v0 = acc[ai][bj][m][0], v1 = acc[ai][bj][m][1];
                        if (act == 1) {
#pragma unroll
                            for (int j = 0; j < 4; ++j) { v0[j] = silu_f(v0[j]); v1[j] = silu_f(v1[j]); } }
                        else if (act == 2) {
#pragma unroll
                            for (int j = 0; j < 4; ++j) { v0[j] = sigm_f(v0[j]); v1[j] = sigm_f(v1[j]); } }
                        u32x4 w; w.x = cvt_pk_bf16(v0[0], v0[1]); w.y = cvt_pk_bf16(v0[2], v0[3]); w.z = cvt_pk_bf16(v1[0], v1[1]); w.w = cvt_pk_bf16(v1[2], v1[3]);
                        *(u32x4*)(dst + off) = w; }
                    ROWFENCE; }
        } else if (kind == K_HYIN || kind == K_F0) {
            unsigned char* dst = ws + (kind == K_HYIN ? OFF_HYIN : OFF_ZT); const unsigned ld = kind == K_HYIN ? LP : PROWS;
#pragma unroll
            for (int ai = 0; ai < 2; ++ai)
#pragma unroll
                for (int m = 0; m < 4; ++m) { const unsigned row = (unsigned)(u.pm * 256 + ai * 128 + m * 16 + rl0);
#pragma unroll
                    for (int bj = 0; bj < 2; ++bj) { const unsigned off = (row * ld + (unsigned)(u.pn * 256 + bj * 128 + cl0)) * 2u; const f32x4 v0 = acc[ai][bj][m][0], v1 = acc[ai][bj][m][1];
                        u32x4 w; w.x = cvt_pk_bf16(v0[0], v0[1]); w.y = cvt_pk_bf16(v0[2], v0[3]); w.z = cvt_pk_bf16(v1[0], v1[1]); w.w = cvt_pk_bf16(v1[2], v1[3]);
                        *(u32x4*)(dst + off) = w; }
                    ROWFENCE; }
        } else if (kind == K_FNA) {
            unsigned char* dst = ws + OFF_A1;
#pragma unroll
            for (int ai = 0; ai < 2; ++ai)
#pragma unroll
                for (int m = 0; m < 4; ++m) { const int k1 = ai * 128 + m * 16 + rl0;
                    if (k1 < FN1) {
#pragma unroll
                        for (int bj = 0; bj < 2; ++bj)
#pragma unroll
                            for (int n = 0; n < 2; ++n) { const int col = u.pn * 256 + bj * 128 + cl0 + 4 * n; const int ch = col / FN2, l2 = col - ch * FN2; const f32x4 v = acc[ai][bj][m][n];
                                u32x2 w; w.x = cvt_pk_bf16(v[0], v[1]); w.y = cvt_pk_bf16(v[2], v[3]);
                                *(u32x2*)(dst + ((unsigned)((k1 * 1024 + ch) * 2 + u.pm) * 128u + (unsigned)l2) * 2u) = w; } }
                    ROWFENCE; }
        } else if (kind == K_FNB) {
            unsigned char* dst = ws + OFF_GATE + SZ_GATE; const float scale = 1.0f / sqrtf((float)L_TOK * 256.0f);
#pragma unroll
            for (int ai = 0; ai < 2; ++ai)
#pragma unroll
                for (int m = 0; m < 4; ++m) { const int k2 = ai * 128 + m * 16 + rl0;
                    if (k2 < FN2) { const unsigned row = (unsigned)(u.aux + FN1 * k2);
#pragma unroll
                        for (int bj = 0; bj < 2; ++bj) { const unsigned off = (row * 1024u + (unsigned)(u.pn * 256 + bj * 128 + cl0)) * 2u; const u32x4 g = *(const u32x4*)(dst + off);
                            const f32x4 v0 = acc[ai][bj][m][0] * scale, v1 = acc[ai][bj][m][1] * scale;
                            u32x4 w; w.x = cvt_pk_bf16(v0[0] * lo_bf(g.x), v0[1] * hi_bf(g.x)); w.y = cvt_pk_bf16(v0[2] * lo_bf(g.y), v0[3] * hi_bf(g.y));
                            w.z = cvt_pk_bf16(v1[0] * lo_bf(g.z), v1[1] * hi_bf(g.z)); w.w = cvt_pk_bf16(v1[2] * lo_bf(g.w), v1[3] * hi_bf(g.w));
                            *(u32x4*)(dst + off) = w; } }
                    ROWFENCE; }
        } else if (kind == K_BR) {
            unsigned char* dst = ws + OFF_M; const unsigned char* mg = ws + OFF_MERGE; const int br = u.aux;
#pragma unroll
            for (int ai = 0; ai < 2; ++ai)
#pragma unroll
                for (int m = 0; m < 4; ++m) { const unsigned row = (unsigned)(u.pm * 256 + ai * 128 + m * 16 + rl0);
#pragma unroll
                    for (int bj = 0; bj < 2; ++bj) { const unsigned col = (unsigned)(u.pn * 256 + bj * 128 + cl0); const unsigned off = (row * (unsigned)DM + col) * 2u;
                        const u32x4 g = *(const u32x4*)(mg + (row * 6144u + (unsigned)br * 2048u + col) * 2u); const f32x4 v0 = acc[ai][bj][m][0], v1 = acc[ai][bj][m][1];
                        float r0 = v0[0] * lo_bf(g.x), r1 = v0[1] * hi_bf(g.x), r2 = v0[2] * lo_bf(g.y), r3 = v0[3] * hi_bf(g.y), r4 = v1[0] * lo_bf(g.z), r5 = v1[1] * hi_bf(g.z), r6 = v1[2] * lo_bf(g.w), r7 = v1[3] * hi_bf(g.w);
                        if (br > 0) { const u32x4 o = *(const u32x4*)(dst + off); r0 += lo_bf(o.x); r1 += hi_bf(o.x); r2 += lo_bf(o.y); r3 += hi_bf(o.y); r4 += lo_bf(o.z); r5 += hi_bf(o.z); r6 += lo_bf(o.w); r7 += hi_bf(o.w); }
                        u32x4 w; w.x = cvt_pk_bf16(r0, r1); w.y = cvt_pk_bf16(r2, r3); w.z = cvt_pk_bf16(r4, r5); w.w = cvt_pk_bf16(r6, r7);
                        *(u32x4*)(dst + off) = w; }
                    ROWFENCE; }
        } else {
            unsigned char* dst = ws + OFF_H;
#pragma unroll
            for (int ai = 0; ai < 2; ++ai)
#pragma unroll
                for (int m = 0; m < 4; ++m) { const unsigned row = (unsigned)(u.pm * 256 + ai * 128 + m * 16 + rl0);
#pragma unroll
                    for (int bj = 0; bj < 2; ++bj) { const unsigned off = (row * (unsigned)DM + (unsigned)(u.pn * 256 + bj * 128 + cl0)) * 4u;
                        const f32x4 o0 = *(const f32x4*)(dst + off), o1 = *(const f32x4*)(dst + off + 16);
                        *(f32x4*)(dst + off) = o0 + acc[ai][bj][m][0]; *(f32x4*)(dst + off + 16) = o1 + acc[ai][bj][m][1]; }
                    ROWFENCE; }
        }
    }
};

__device__ void phase_prep0(const Params& p, unsigned char* smem) {
    const int tid = opaque_tid(), bid = blockIdx.x, G = gridDim.x;
    const size_t gtid = (size_t)bid * NTHREADS + tid, gstride = (size_t)G * NTHREADS;
    { f32x4* h4 = (f32x4*)(p.ws + OFF_H); const f32x4* x4 = (const f32x4*)p.x; const f32x4* m4 = (const f32x4*)p.meta;
      for (size_t i = gtid; i < (size_t)LP * 512; i += gstride) { const size_t row = i >> 9; f32x4 v = (f32x4){0.f, 0.f, 0.f, 0.f};
          if (row < NMETA) v = m4[i]; else if (row < L_TOK) v = x4[i - (size_t)NMETA * 512]; h4[i] = v; } }
    { bf16_t* fa = (bf16_t*)(p.ws + OFF_FA);
      for (size_t i = gtid; i < (size_t)512 * 384; i += gstride) { const int row = (int)(i / 384), col = (int)(i % 384); const int po = row >> 8, k1 = row & 255, pi = col / 192, l1 = col % 192; float v = 0.f;
          if (k1 < FN1 && l1 < FN1) { const int r = (k1 * l1) % FN1; const float a = 2.0f * (float)r / (float)FN1; const float cs = cospif(a), sn = sinpif(a);
              v = (po == 0) ? (pi == 0 ? cs : sn) : (pi == 0 ? -sn : cs); }
          fa[i] = f2bf(v); } }
    { bf16_t* fb = (bf16_t*)(p.ws + OFF_FB);
      for (size_t i = gtid; i < (size_t)FN1 * 65536; i += gstride) { const int k1 = (int)(i >> 16), k2 = (int)((i >> 8) & 255), kk = (int)(i & 255), part = kk >> 7, l2 = kk & 127; float v = 0.f;
          if (k2 < FN2 && l2 < FN2) { const int lp = k1 + FN1 * k2; const int r = (l2 * lp) % L_TOK; const float a = 2.0f * (float)r / (float)L_TOK; v = part == 0 ? cospif(a) : sinpif(a); }
          fb[i] = f2bf(v); } }
    { float* w1s = (float*)smem;
      float* w2s = w1s + 33 * 64;
      float* w3s = w2s + 64 * 64;
      const int lane = tid & 63, wv = tid >> 6;
      for (int layer = 0; layer < 2; ++layer) {
          __syncthreads();
          for (int i = tid; i < 33 * 64; i += NTHREADS) w1s[i] = p.f_w1[layer * 33 * 64 + i];
          for (int i = tid; i < 64 * 64; i += NTHREADS) { w2s[i] = p.f_w2[layer * 4096 + i]; w3s[i] = p.f_w3[layer * 4096 + i]; }
          __syncthreads();
          const float b1 = p.f_b1[layer * 64 + lane], b2 = p.f_b2[layer * 64 + lane], b3 = p.f_b3[layer * 64 + lane], fr = p.f_freq[layer * 64 + lane];
          float* h3 = (float*)(p.ws + OFF_H3) + (size_t)layer * L_TOK * 64;
          for (int lag = bid * 8 + wv; lag < L_TOK; lag += G * 8) {
              const float tt = (float)lag / (float)(L_TOK - 1); const float w = 6.283185307179586f * (float)lag / (float)L_TOK;
              float z = 0.f;
              if (lane == 0) z = tt;
              else if (lane < 33) { const int j = (lane - 1) & 15; const float f = 1e-4f + (float)j * ((15.0f - 1e-4f) / 15.0f); const float a = f * w; z = lane < 17 ? cosf(a) : -sinf(a); }
              float a1 = b1;
#pragma unroll 3
              for (int i = 0; i < 33; ++i) a1 += __shfl(z, i) * w1s[i * 64 + lane];
              const float h1 = sinf(fr * a1);
              float a2 = b2;
#pragma unroll 8
              for (int i = 0; i < 64; ++i) a2 += __shfl(h1, i) * w2s[i * 64 + lane];
              const float h2 = sinf(fr * a2);
              float a3 = b3;
#pragma unroll 8
              for (int i = 0; i < 64; ++i) a3 += __shfl(h2, i) * w3s[i * 64 + lane];
              h3[(size_t)lag * 64 + lane] = sinf(fr * a3);
          }
      }
      __syncthreads(); }
}

__device__ __forceinline__ void convert_tile(const float* src, int K, int N, bf16_t* dst, int kt, int nt_, float* tile  ) {
    const int tid = opaque_tid();
    __syncthreads();
#pragma unroll
    for (int ps = 0; ps < 2; ++ps) { const int kl = ps * 32 + (tid >> 4), n4 = (tid & 15) * 4;
        const f32x4 v = *(const f32x4*)(src + (size_t)(kt * 64 + kl) * N + nt_ * 64 + n4);
        tile[kl * 65 + n4] = v[0]; tile[kl * 65 + n4 + 1] = v[1]; tile[kl * 65 + n4 + 2] = v[2]; tile[kl * 65 + n4 + 3] = v[3]; }
    __syncthreads();
    const int nl = tid >> 3, k8 = (tid & 7) * 8;
    u32x4 w; w.x = cvt_pk_bf16(tile[(k8 + 0) * 65 + nl], tile[(k8 + 1) * 65 + nl]); w.y = cvt_pk_bf16(tile[(k8 + 2) * 65 + nl], tile[(k8 + 3) * 65 + nl]);
    w.z = cvt_pk_bf16(tile[(k8 + 4) * 65 + nl], tile[(k8 + 5) * 65 + nl]); w.w = cvt_pk_bf16(tile[(k8 + 6) * 65 + nl], tile[(k8 + 7) * 65 + nl]);
    *(u32x4*)(dst + (size_t)(nt_ * 64 + nl) * K + kt * 64 + k8) = w;
}

__device__ void phase_p1(const Params& p, int layer, unsigned char* smem) {
    const int tid = opaque_tid(), bid = blockIdx.x, G = gridDim.x;
    float* tile = (float*)smem;
    { const float* win = p.w_in + (size_t)layer * DM * NIN;
      for (int t = bid; t < 32 * 256; t += G) convert_tile(win, DM, NIN, (bf16_t*)(p.ws + OFF_WT), t & 31, t >> 5, tile);
      for (int br = 0; br < 3; ++br) { const float* wsrc = (br == 0 ? p.w_a : br == 1 ? p.w_b : p.w_c) + (size_t)layer * 1024 * DM;
          for (int t = bid; t < 16 * 32; t += G) convert_tile(wsrc, 1024, DM, (bf16_t*)(p.ws + OFF_WA + br * SZ_WBR), t & 15, t >> 4, tile); }
      const float* wo = p.w_out + (size_t)layer * DM * DM;
      for (int t = bid; t < 32 * 32; t += G) convert_tile(wo, DM, DM, (bf16_t*)(p.ws + OFF_WO), t & 31, t >> 5, tile);
      __syncthreads(); }
    { float* tileT = (float*)smem;
      float* ctab = tileT + 256 * 32;
      float* stab = ctab + 256;
      const float* win = p.w_in + (size_t)layer * DM * NIN;
      for (int t = bid; t < 256; t += G) { const int g = t >> 6, k0 = (t & 63) * 32;
          __syncthreads();
          if (tid < 256) { const float a = 2.0f * (float)tid / 256.0f; ctab[tid] = cospif(a); stab[tid] = sinpif(a); }
#pragma unroll
          for (int ps = 0; ps < 4; ++ps) { const int idx = ps * NTHREADS + tid; const int kl = idx >> 6, c4 = (idx & 63) * 4;
              const f32x4 v = *(const f32x4*)(win + (size_t)(k0 + kl) * NIN + 4096 + g * 256 + c4);
              tileT[(c4 + 0) * 32 + kl] = v[0]; tileT[(c4 + 1) * 32 + kl] = v[1]; tileT[(c4 + 2) * 32 + kl] = v[2]; tileT[(c4 + 3) * 32 + kl] = v[3]; }
          __syncthreads();
          const int cp = tid & 255, part = tid >> 8;
          float acc[32];
#pragma unroll
          for (int k = 0; k < 32; ++k) acc[k] = 0.f;
          for (int c = 0; c < 256; ++c) { const int r = (c * cp) & 255; const float tw = part == 0 ? ctab[r] : -stab[r];
#pragma unroll
              for (int k4 = 0; k4 < 8; ++k4) { const f32x4 v = *(const f32x4*)(tileT + c * 32 + k4 * 4); acc[k4 * 4 + 0] += v[0] * tw; acc[k4 * 4 + 1] += v[1] * tw; acc[k4 * 4 + 2] += v[2] * tw; acc[k4 * 4 + 3] += v[3] * tw; } }
          bf16_t* dst = (bf16_t*)(p.ws + OFF_WEFF) + (size_t)(part * 1024 + g * 256 + cp) * DM + k0;
#pragma unroll
          for (int k8 = 0; k8 < 4; ++k8) { u32x4 w; w.x = cvt_pk_bf16(acc[k8 * 8 + 0], acc[k8 * 8 + 1]); w.y = cvt_pk_bf16(acc[k8 * 8 + 2], acc[k8 * 8 + 3]); w.z = cvt_pk_bf16(acc[k8 * 8 + 4], acc[k8 * 8 + 5]); w.w = cvt_pk_bf16(acc[k8 * 8 + 6], acc[k8 * 8 + 7]);
              *(u32x4*)(dst + k8 * 8) = w; } }
      __syncthreads(); }
    { const int lane = tid & 63, wv = tid >> 6; const float* h = (const float*)(p.ws + OFF_H); const float* gam = p.norm_g + layer * DM;
      bf16_t* xn = (bf16_t*)(p.ws + OFF_XN); bf16_t* xnp = (bf16_t*)(p.ws + OFF_XNP);
      for (int l = bid * 8 + wv; l < LP; l += G * 8) {
          if (l < L_TOK) { const f32x4* row = (const f32x4*)(h + (size_t)l * DM); f32x4 v[8]; float ss = 0.f;
#pragma unroll
              for (int i = 0; i < 8; ++i) { v[i] = row[i * 64 + lane]; ss += v[i][0] * v[i][0] + v[i][1] * v[i][1] + v[i][2] * v[i][2] + v[i][3] * v[i][3]; }
              ss = wave_sum(ss); const float inv = rsqrtf(ss * (1.0f / DM) + 1e-6f);
              const int l1 = l / FN2, l2 = l - l1 * FN2; const size_t pr = (size_t)l2 * FN1P + l1;
#pragma unroll
              for (int i = 0; i < 8; ++i) { const f32x4 gg = ((const f32x4*)gam)[i * 64 + lane]; u32x2 w; w.x = cvt_pk_bf16(v[i][0] * inv * gg[0], v[i][1] * inv * gg[1]); w.y = cvt_pk_bf16(v[i][2] * inv * gg[2], v[i][3] * inv * gg[3]);
                  *(u32x2*)(xn + (size_t)l * DM + (i * 64 + lane) * 4) = w; *(u32x2*)(xnp + pr * DM + (i * 64 + lane) * 4) = w; } }
          else { const u32x2 z = (u32x2){0u, 0u};
#pragma unroll
              for (int i = 0; i < 8; ++i) *(u32x2*)(xn + (size_t)l * DM + (i * 64 + lane) * 4) = z; } }
      for (int idx = bid * 8 + wv; idx < FN2 * (FN1P - FN1); idx += G * 8) { const int l2 = idx / (FN1P - FN1), l1 = FN1 + idx % (FN1P - FN1); const size_t pr = (size_t)l2 * FN1P + l1; const u32x2 z = (u32x2){0u, 0u};
#pragma unroll
          for (int i = 0; i < 8; ++i) *(u32x2*)(xnp + pr * DM + (i * 64 + lane) * 4) = z; } }
}

__device__ void na_unit(const Params& p, int layer, int r, int hd, unsigned char* smem) {
    const int tid = opaque_tid(), j = tid >> 6, c = tid & 63;
    const bf16_t* qkv = (const bf16_t*)(p.ws + OFF_QKV);
    const int r0 = min(max(r - 4, 0), 248);
    unsigned char* sK = smem; unsigned char* sV = smem + 73728; unsigned char* sMK = smem + 147456; unsigned char* sMV = sMK + 2304;
    __syncthreads();
#pragma unroll
    for (int ps = 0; ps < 8; ++ps) { const int tok = ps * 64 + (tid >> 3), ch = tid & 7; const size_t g = (size_t)(NMETA + r0 * 64 + tok) * 3072 + hd * 64 + ch * 8;
        *(u32x4*)(sK + tok * 144 + ch * 16) = *(const u32x4*)(qkv + g + 1024); *(u32x4*)(sV + tok * 144 + ch * 16) = *(const u32x4*)(qkv + g + 2048); }
    if (tid < 128) { const int tok = tid >> 3, ch = tid & 7; const size_t g = (size_t)tok * 3072 + hd * 64 + ch * 8;
        *(u32x4*)(sMK + tok * 144 + ch * 16) = *(const u32x4*)(qkv + g + 1024); *(u32x4*)(sMV + tok * 144 + ch * 16) = *(const u32x4*)(qkv + g + 2048); }
    float q[64];
    { const u32x4* qp = (const u32x4*)(qkv + (size_t)(NMETA + r * 64 + c) * 3072 + hd * 64);
#pragma unroll
      for (int i = 0; i < 8; ++i) { const u32x4 v = qp[i]; q[i * 8 + 0] = lo_bf(v.x) * 0.125f; q[i * 8 + 1] = hi_bf(v.x) * 0.125f; q[i * 8 + 2] = lo_bf(v.y) * 0.125f; q[i * 8 + 3] = hi_bf(v.y) * 0.125f;
          q[i * 8 + 4] = lo_bf(v.z) * 0.125f; q[i * 8 + 5] = hi_bf(v.z) * 0.125f; q[i * 8 + 6] = lo_bf(v.w) * 0.125f; q[i * 8 + 7] = hi_bf(v.w) * 0.125f; } }
    __syncthreads();
    const int cs = min(max(c - 8, 0), 48);
    const float* rp = p.rpb + ((size_t)(layer * 16 + hd) * 15 + (r0 + j - r + 7)) * 31 + (cs - c + 15);
    const float* mb = p.meta_bias + (layer * 16 + hd) * 16 + 2 * j;
    float o[64];
#pragma unroll
    for (int i = 0; i < 64; ++i) o[i] = 0.f;
    float mx = -3.0e38f, lsum = 0.f;
#pragma unroll 1
    for (int i = 0; i < 18; ++i) {
        const int ko = i < 16 ? (j * 64 + cs + i) * 144 : 147456 + (2 * j + i - 16) * 144; const int vo = i < 16 ? ko + 73728 : ko + 2304;
        const float bias = i < 16 ? rp[i] : mb[i - 16];
        float d0 = 0.f, d1 = 0.f;
#pragma unroll
        for (int e = 0; e < 8; ++e) { const u32x4 v = *(const u32x4*)(smem + ko + e * 16);
            d0 += q[e * 8 + 0] * lo_bf(v.x) + q[e * 8 + 2] * lo_bf(v.y) + q[e * 8 + 4] * lo_bf(v.z) + q[e * 8 + 6] * lo_bf(v.w);
            d1 += q[e * 8 + 1] * hi_bf(v.x) + q[e * 8 + 3] * hi_bf(v.y) + q[e * 8 + 5] * hi_bf(v.z) + q[e * 8 + 7] * hi_bf(v.w); }
        const float sc = d0 + d1 + bias; const float mnew = fmaxf(mx, sc); const float alpha = __expf(mx - mnew), pi = __expf(sc - mnew);
        lsum = lsum * alpha + pi; mx = mnew;
#pragma unroll
        for (int e = 0; e < 8; ++e) { const u32x4 v = *(const u32x4*)(smem + vo + e * 16);
            o[e * 8 + 0] = o[e * 8 + 0] * alpha + pi * lo_bf(v.x); o[e * 8 + 1] = o[e * 8 + 1] * alpha + pi * hi_bf(v.x); o[e * 8 + 2] = o[e * 8 + 2] * alpha + pi * lo_bf(v.y); o[e * 8 + 3] = o[e * 8 + 3] * alpha + pi * hi_bf(v.y);
            o[e * 8 + 4] = o[e * 8 + 4] * alpha + pi * lo_bf(v.z); o[e * 8 + 5] = o[e * 8 + 5] * alpha + pi * hi_bf(v.z); o[e * 8 + 6] = o[e * 8 + 6] * alpha + pi * lo_bf(v.w); o[e * 8 + 7] = o[e * 8 + 7] * alpha + pi * hi_bf(v.w); }
    }
    __syncthreads();
    float* part = (float*)smem;
    { float* pp = part + (size_t)(j * 64 + c) * 67;
#pragma unroll
      for (int i = 0; i < 64; ++i) pp[i] = o[i];
      pp[64] = mx; pp[65] = lsum; }
    __syncthreads();
    { const int qc = tid >> 3, d0 = (tid & 7) * 8; float mj[8], M = -3.0e38f;
#pragma unroll
      for (int w = 0; w < 8; ++w) { mj[w] = part[(size_t)(w * 64 + qc) * 67 + 64]; M = fmaxf(M, mj[w]); }
      float Lsum = 0.f, o[8];
#pragma unroll
      for (int e = 0; e < 8; ++e) o[e] = 0.f;
#pragma unroll
      for (int w = 0; w < 8; ++w) { const float f = __expf(mj[w] - M); const float* pp = part + (size_t)(w * 64 + qc) * 67; Lsum += f * pp[65];
#pragma unroll
          for (int e = 0; e < 8; ++e) o[e] += f * pp[d0 + e]; }
      const float inv = 1.0f / Lsum;
      bf16_t* gp = (bf16_t*)(p.ws + OFF_GATE + 2 * SZ_GATE) + (size_t)(NMETA + r * 64 + qc) * 1024 + hd * 64 + d0;
      const u32x4 g = *(const u32x4*)gp;
      u32x4 w; w.x = cvt_pk_bf16(o[0] * inv * lo_bf(g.x), o[1] * inv * hi_bf(g.x)); w.y = cvt_pk_bf16(o[2] * inv * lo_bf(g.y), o[3] * inv * hi_bf(g.y));
      w.z = cvt_pk_bf16(o[4] * inv * lo_bf(g.z), o[5] * inv * hi_bf(g.z)); w.w = cvt_pk_bf16(o[6] * inv * lo_bf(g.w), o[7] * inv * hi_bf(g.w));
      *(u32x4*)gp = w; }
}
__device__ void na_meta_unit(const Params& p, int layer) {
    const int tid = opaque_tid();
    if (tid < 256) { const int hd = tid >> 4, qi = tid & 15; const bf16_t* qkv = (const bf16_t*)(p.ws + OFF_QKV);
        float s[16];
#pragma unroll
        for (int m = 0; m < 16; ++m) { float d = 0.f; for (int e = 0; e < 64; ++e) d += bf2f(qkv[(size_t)qi * 3072 + hd * 64 + e]) * bf2f(qkv[(size_t)m * 3072 + 1024 + hd * 64 + e]);
            s[m] = d * 0.125f + p.meta_bias[(layer * 16 + hd) * 16 + m]; }
        float mx = s[0];
#pragma unroll
        for (int m = 1; m < 16; ++m) mx = fmaxf(mx, s[m]);
        float ls = 0.f;
#pragma unroll
        for (int m = 0; m < 16; ++m) { s[m] = __expf(s[m] - mx); ls += s[m]; }
        const float inv = 1.0f / ls; bf16_t* gp = (bf16_t*)(p.ws + OFF_GATE + 2 * SZ_GATE) + (size_t)qi * 1024 + hd * 64;
        for (int e = 0; e < 64; ++e) { float o = 0.f;
#pragma unroll
            for (int m = 0; m < 16; ++m) o += s[m] * bf2f(qkv[(size_t)m * 3072 + 2048 + hd * 64 + e]);
            gp[e] = f2bf(o * inv * bf2f(gp[e])); } }
}

__device__ __forceinline__ unsigned rev4_14(unsigned k) { unsigned r = __brev(k) >> 18; return ((r & 0x1555u) << 1) | ((r >> 1) & 0x1555u); }
__device__ __forceinline__ float2 cmul(float2 a, float2 b) { return make_float2(a.x * b.x - a.y * b.y, a.x * b.y + a.y * b.x); }
#define PADI(i) ((i) + ((i) >> 4))
#define CFF(n) cff[2 * PADI((n) >> 1) + ((n) & 1)]
__device__ __forceinline__ void hw_sincos(float rev, float& sn, float& cs) { sn = __builtin_amdgcn_sinf(rev); cs = __builtin_amdgcn_cosf(rev); }
__device__ __forceinline__ float c16(int k) { const float t[10] = {1.0f, 0.9238795325f, 0.7071067812f, 0.3826834324f, 0.0f, -0.3826834324f, -0.7071067812f, -0.9238795325f, -1.0f, -0.9238795325f}; return t[k]; }
__device__ __forceinline__ float s16(int k) { const float t[10] = {0.0f, 0.3826834324f, 0.7071067812f, 0.9238795325f, 1.0f, 0.9238795325f, 0.7071067812f, 0.3826834324f, 0.0f, -0.3826834324f}; return t[k]; }
__device__ void fft_fwd(float2* a) {
    for (int span = 4096; span >= 16; span >>= 2) {
        for (int b = opaque_tid(); b < 4096; b += NTHREADS) { const int j = b & (span - 1); const int base = ((b - j) << 2) + j;
            const int i0 = PADI(base), i1 = PADI(base + span), i2 = PADI(base + 2 * span), i3 = PADI(base + 3 * span);
            const float2 a0 = a[i0], a1 = a[i1], a2 = a[i2], a3 = a[i3];
            const float2 t0 = make_float2(a0.x + a2.x, a0.y + a2.y), t1 = make_float2(a0.x - a2.x, a0.y - a2.y), t2 = make_float2(a1.x + a3.x, a1.y + a3.y);
            const float2 t3 = make_float2(a1.y - a3.y, -(a1.x - a3.x));
            float sn, cs; hw_sincos((float)j / (float)(4 * span), sn, cs);
            const float2 w1 = make_float2(cs, -sn), w2 = cmul(w1, w1), w3 = cmul(w2, w1);
            a[i0] = make_float2(t0.x + t2.x, t0.y + t2.y);
            a[i1] = cmul(make_float2(t1.x + t3.x, t1.y + t3.y), w1);
            a[i2] = cmul(make_float2(t0.x - t2.x, t0.y - t2.y), w2);
            a[i3] = cmul(make_float2(t1.x - t3.x, t1.y - t3.y), w3); }
        __syncthreads(); }
    for (int blk = opaque_tid(); blk < 1024; blk += NTHREADS) { float2* pb = a + blk * 17; float2 x[16];
#pragma unroll
        for (int e = 0; e < 16; ++e) x[e] = pb[e];
#pragma unroll
        for (int j = 0; j < 4; ++j) { const float2 a0 = x[j], a1 = x[j + 4], a2 = x[j + 8], a3 = x[j + 12];
            const float2 t0 = make_float2(a0.x + a2.x, a0.y + a2.y), t1 = make_float2(a0.x - a2.x, a0.y - a2.y), t2 = make_float2(a1.x + a3.x, a1.y + a3.y), t3 = make_float2(a1.y - a3.y, -(a1.x - a3.x));
            x[j] = make_float2(t0.x + t2.x, t0.y + t2.y);
            x[j + 4] = cmul(make_float2(t1.x + t3.x, t1.y + t3.y), make_float2(c16(j), -s16(j)));
            x[j + 8] = cmul(make_float2(t0.x - t2.x, t0.y - t2.y), make_float2(c16(2 * j), -s16(2 * j)));
            x[j + 12] = cmul(make_float2(t1.x - t3.x, t1.y - t3.y), make_float2(c16(3 * j), -s16(3 * j))); }
#pragma unroll
        for (int g = 0; g < 4; ++g) { const float2 a0 = x[4 * g], a1 = x[4 * g + 1], a2 = x[4 * g + 2], a3 = x[4 * g + 3];
            const float2 t0 = make_float2(a0.x + a2.x, a0.y + a2.y), t1 = make_float2(a0.x - a2.x, a0.y - a2.y), t2 = make_float2(a1.x + a3.x, a1.y + a3.y), t3 = make_float2(a1.y - a3.y, -(a1.x - a3.x));
            x[4 * g] = make_float2(t0.x + t2.x, t0.y + t2.y); x[4 * g + 1] = make_float2(t1.x + t3.x, t1.y + t3.y);
            x[4 * g + 2] = make_float2(t0.x - t2.x, t0.y - t2.y); x[4 * g + 3] = make_float2(t1.x - t3.x, t1.y - t3.y); }
#pragma unroll
        for (int e = 0; e < 16; ++e) pb[e] = x[e]; }
    __syncthreads();
}
__device__ void fft_inv(float2* a) {
    for (int blk = opaque_tid(); blk < 1024; blk += NTHREADS) { float2* pb = a + blk * 17; float2 x[16];
#pragma unroll
        for (int e = 0; e < 16; ++e) x[e] = pb[e];
#pragma unroll
        for (int g = 0; g < 4; ++g) { const float2 a0 = x[4 * g], a1 = x[4 * g + 1], a2 = x[4 * g + 2], a3 = x[4 * g + 3];
            const float2 t0 = make_float2(a0.x + a2.x, a0.y + a2.y), t1 = make_float2(a0.x - a2.x, a0.y - a2.y), t2 = make_float2(a1.x + a3.x, a1.y + a3.y), t3 = make_float2(-(a1.y - a3.y), a1.x - a3.x);
            x[4 * g] = make_float2(t0.x + t2.x, t0.y + t2.y); x[4 * g + 1] = make_float2(t1.x + t3.x, t1.y + t3.y);
            x[4 * g + 2] = make_float2(t0.x - t2.x, t0.y - t2.y); x[4 * g + 3] = make_float2(t1.x - t3.x, t1.y - t3.y); }
#pragma unroll
        for (int j = 0; j < 4; ++j) { const float2 a0 = x[j], a1 = cmul(x[j + 4], make_float2(c16(j), s16(j))), a2 = cmul(x[j + 8], make_float2(c16(2 * j), s16(2 * j))), a3 = cmul(x[j + 12], make_float2(c16(3 * j), s16(3 * j)));
            const float2 t0 = make_float2(a0.x + a2.x, a0.y + a2.y), t1 = make_float2(a0.x - a2.x, a0.y - a2.y), t2 = make_float2(a1.x + a3.x, a1.y + a3.y), t3 = make_float2(-(a1.y - a3.y), a1.x - a3.x);
            x[j] = make_float2(t0.x + t2.x, t0.y + t2.y); x[j + 4] = make_float2(t1.x + t3.x, t1.y + t3.y);
            x[j + 8] = make_float2(t0.x - t2.x, t0.y - t2.y); x[j + 12] = make_float2(t1.x - t3.x, t1.y - t3.y); }
#pragma unroll
        for (int e = 0; e < 16; ++e) pb[e] = x[e]; }
    __syncthreads();
    for (int span = 16; span <= 4096; span <<= 2) {
        for (int b = opaque_tid(); b < 4096; b += NTHREADS) { const int j = b & (span - 1); const int base = ((b - j) << 2) + j;
            const int i0 = PADI(base), i1 = PADI(base + span), i2 = PADI(base + 2 * span), i3 = PADI(base + 3 * span);
            float sn, cs; hw_sincos((float)j / (float)(4 * span), sn, cs);
            const float2 w1 = make_float2(cs, sn), w2 = cmul(w1, w1), w3 = cmul(w2, w1);
            const float2 a0 = a[i0], a1 = cmul(a[i1], w1), a2 = cmul(a[i2], w2), a3 = cmul(a[i3], w3);
            const float2 t0 = make_float2(a0.x + a2.x, a0.y + a2.y), t1 = make_float2(a0.x - a2.x, a0.y - a2.y), t2 = make_float2(a1.x + a3.x, a1.y + a3.y);
            const float2 t3 = make_float2(-(a1.y - a3.y), a1.x - a3.x);
            a[i0] = make_float2(t0.x + t2.x, t0.y + t2.y);
            a[i1] = make_float2(t1.x + t3.x, t1.y + t3.y);
            a[i2] = make_float2(t0.x - t2.x, t0.y - t2.y);
            a[i3] = make_float2(t1.x - t3.x, t1.y - t3.y); }
        __syncthreads(); }
}
__device__ __forceinline__ float hy_val(const bf16_t* row, int t, float w0, float w1, float w2, float b) {
    const float xm = t > 0 ? bf2f(row[t - 1]) : 0.f, x0 = bf2f(row[t]), xp = t < L_TOK - 1 ? bf2f(row[t + 1]) : 0.f;
    return w0 * xm + w1 * x0 + w2 * xp + b;
}
struct HyCh { const bf16_t* ru; const bf16_t* r1; const bf16_t* r2; float wu[4], w1[4], w2[4]; };
#define HY_U(t)  hy_val(hc.ru, (t), hc.wu[0], hc.wu[1], hc.wu[2], hc.wu[3])
#define HY_X1(t) hy_val(hc.r1, (t), hc.w1[0], hc.w1[1], hc.w1[2], hc.w1[3])
#define HY_X2(t) hy_val(hc.r2, (t), hc.w2[0], hc.w2[1], hc.w2[2], hc.w2[3])

constexpr int SD_WF = 0, SD_WB = 64, SD_GFX = 128, SD_GBX = 144, SD_VMETA = 160, SD_ZMETA = 176, SD_RED = 192  , SD_END = 320;

template <int ORDER>
__device__ void hy_conv(const Params& p, int layer, int ch, const HyCh& hc, float2* cf, float* side, unsigned char* scratch) {
    const int tid = opaque_tid(); float* cff = (float*)cf;
    const float* h3 = (const float*)(p.ws + OFF_H3) + (size_t)layer * L_TOK * 64;
    f32x4* heo = (f32x4*)(scratch + HS_HEO); float* corr = (float*)(scratch + HS_CORR); const float* z2g = (const float*)(scratch + HS_Z2);
    if (tid < 128) { const int dir = tid >> 6, i = tid & 63; side[(dir ? SD_WB : SD_WF) + i] = p.f_w4[((size_t)layer * 64 + i) * 4096 + (ORDER * 2 + dir) * 1024 + ch]; }
    const float dcf = fabsf(p.decay[((layer * 2 + ORDER) * 2 + 0) * 1024 + ch]), dcb = fabsf(p.decay[((layer * 2 + ORDER) * 2 + 1) * 1024 + ch]);
    __syncthreads();
    for (int lag = tid; lag < L_TOK; lag += NTHREADS) { const f32x4* hr = (const f32x4*)(h3 + (size_t)lag * 64); float gf = 0.f, gb = 0.f;
#pragma unroll
        for (int i = 0; i < 16; ++i) { const f32x4 hv = hr[i]; const f32x4 wf = *(const f32x4*)(side + SD_WF + i * 4), wb = *(const f32x4*)(side + SD_WB + i * 4);
            gf += hv[0] * wf[0] + hv[1] * wf[1] + hv[2] * wf[2] + hv[3] * wf[3]; gb += hv[0] * wb[0] + hv[1] * wb[1] + hv[2] * wb[2] + hv[3] * wb[3]; }
        const float tt = (float)lag / (float)(L_TOK - 1); gf *= expf(-tt * dcf); gb *= expf(-tt * dcb);
        if (lag < NMAIN) CFF(lag) = gf; else side[SD_GFX + lag - NMAIN] = gf;
        if (lag >= 1) { if (lag < NMAIN) CFF(32768 - lag) = gb; else side[SD_GBX + lag - NMAIN] = gb; } }
    if (tid == 0) CFF(NMAIN) = 0.f;
    __syncthreads();
#define GF(l) ((l) < NMAIN ? CFF(l) : side[SD_GFX + (l) - NMAIN])
#define GB(m) ((m) < NMAIN ? CFF(32768 - (m)) : side[SD_GBX + (m) - NMAIN])
    for (int jx = tid; jx < NMAIN; jx += NTHREADS) { const int t = jx + NMETA; float a = 0.f;
#pragma unroll
        for (int s = 0; s < NMETA; ++s) { const int l = t - s; a += GF(l) * side[SD_VMETA + s]; }
        corr[jx] = a; }
    { float am[16];
#pragma unroll
      for (int t = 0; t < 16; ++t) am[t] = 0.f;
      for (int s = tid; s < L_TOK; s += NTHREADS) { const float v = (ORDER == 0) ? HY_U(s) : z2g[s];
#pragma unroll
          for (int t = 0; t < 16; ++t) { const int l = t - s; const float gv = l >= 0 ? GF(l) : GB(-l); am[t] += gv * v; } }
#pragma unroll
      for (int t = 0; t < 16; ++t) am[t] = wave_sum(am[t]);
      if ((tid & 63) == 0) {
#pragma unroll
          for (int t = 0; t < 16; ++t) side[SD_RED + (tid >> 6) * 16 + t] = am[t]; }
      __syncthreads();
      if (tid < 16) { float a = 0.f;
#pragma unroll
          for (int w = 0; w < 8; ++w) a += side[SD_RED + w * 16 + tid];
          side[SD_ZMETA + tid] = a; } }
#undef GF
#undef GB
    __syncthreads();
    fft_fwd(cf);
    for (int k = tid; k <= 8192; k += NTHREADS) { const int kp = (16384 - k) & 16383; const float2 a = cf[PADI(rev4_14(k))], bq = cf[PADI(rev4_14(kp))];
        const float bx = bq.x, by = -bq.y; const float sc = 1.0f / 16384.0f;
        heo[k] = (f32x4){0.5f * (a.x + bx) * sc, 0.5f * (a.y + by) * sc, 0.5f * (a.y - by) * sc, -0.5f * (a.x - bx) * sc}; }
    __syncthreads();
    for (int jx = tid; jx < NMAIN; jx += NTHREADS) { CFF(jx) = (ORDER == 0) ? HY_U(jx + NMETA) : z2g[jx + NMETA]; CFF(NMAIN + jx) = 0.f; }
    __syncthreads();
    fft_fwd(cf);
    for (int k = tid; k <= 8192; k += NTHREADS) { const int kp = (16384 - k) & 16383; const unsigned ik = PADI(rev4_14(k)), ikp = PADI(rev4_14(kp)); const float2 a = cf[ik], bq = cf[ikp];
        const float bx = bq.x, by = -bq.y;
        const float2 XE = make_float2(0.5f * (a.x + bx), 0.5f * (a.y + by)), XO = make_float2(0.5f * (a.y - by), -0.5f * (a.x - bx));
        const f32x4 hh = heo[k]; const float2 HE = make_float2(hh[0], hh[1]), HO = make_float2(hh[2], hh[3]);
        float sn, cs; hw_sincos((float)k / 16384.0f, sn, cs); const float2 w = make_float2(cs, -sn);
        const float2 xoho = cmul(XO, HO), wx = cmul(w, xoho), xehe = cmul(XE, HE), xeho = cmul(XE, HO), xohe = cmul(XO, HE);
        const float2 YE = make_float2(xehe.x + wx.x, xehe.y + wx.y), YO = make_float2(xeho.x + xohe.x, xeho.y + xohe.y);
        cf[ik] = make_float2(YE.x - YO.y, YE.y + YO.x); cf[ikp] = make_float2(YE.x + YO.y, -YE.y + YO.x); }
    __syncthreads();
    fft_inv(cf);
}

__device__ void hyena_unit(const Params& p, int layer, int ch, unsigned char* smem, unsigned char* scratch) {
    const int tid = opaque_tid(); float2* cf = (float2*)smem; float* cff = (float*)smem; float* side = (float*)(smem + 139264);
    const bf16_t* hyin = (const bf16_t*)(p.ws + OFF_HYIN);
    HyCh hc; hc.ru = hyin + (size_t)ch * LP; hc.r1 = hyin + (size_t)(1024 + ch) * LP; hc.r2 = hyin + (size_t)(2048 + ch) * LP;
    { const float* cw = p.conv_w + (size_t)layer * 3 * 3072; const float* cb = p.conv_b + (size_t)layer * 3072;
#pragma unroll
      for (int jj = 0; jj < 3; ++jj) { hc.wu[jj] = cw[jj * 3072 + ch]; hc.w1[jj] = cw[jj * 3072 + 1024 + ch]; hc.w2[jj] = cw[jj * 3072 + 2048 + ch]; }
      hc.wu[3] = cb[ch]; hc.w1[3] = cb[1024 + ch]; hc.w2[3] = cb[2048 + ch]; }
    const float sk0 = p.skip[(layer * 2 + 0) * 1024 + ch], sk1 = p.skip[(layer * 2 + 1) * 1024 + ch];
    float* corr = (float*)(scratch + HS_CORR); float* z2g = (float*)(scratch + HS_Z2);
    bf16_t* hyout = (bf16_t*)(p.ws + OFF_HYOUT) + (size_t)ch * LP;
    __syncthreads();
    if (tid < 16) side[SD_VMETA + tid] = HY_U(tid);
    __syncthreads();
    hy_conv<0>(p, layer, ch, hc, cf, side, scratch);
    for (int jx = tid; jx < NMAIN; jx += NTHREADS) { const int t = jx + NMETA; const float z1 = CFF(jx) + corr[jx] + sk0 * HY_U(t); z2g[t] = HY_X1(t) * z1; }
    if (tid < 16) { const float z1 = side[SD_ZMETA + tid] + sk0 * HY_U(tid); const float z2 = HY_X1(tid) * z1; z2g[tid] = z2; side[SD_VMETA + tid] = z2; }
    __syncthreads();
    hy_conv<1>(p, layer, ch, hc, cf, side, scratch);
    for (int jx = tid; jx < NMAIN; jx += NTHREADS) { const int t = jx + NMETA; const float z3 = CFF(jx) + corr[jx] + sk1 * z2g[t]; hyout[t] = f2bf(HY_X2(t) * z3); }
    if (tid < 16) { const float z3 = side[SD_ZMETA + tid] + sk1 * side[SD_VMETA + tid]; hyout[tid] = f2bf(HY_X2(tid) * z3); }
    __syncthreads();
}

__device__ void transpose_unit(const Params& p, int ct, int tt, unsigned char* smem) {
    const int tid = opaque_tid(); bf16_t* tile = (bf16_t*)smem;
    const bf16_t* hyout = (const bf16_t*)(p.ws + OFF_HYOUT); bf16_t* ya = (bf16_t*)(p.ws + OFF_GATE);
    __syncthreads();
    { const int cl = tid >> 3, t8 = (tid & 7) * 8; *(u32x4*)(tile + cl * 72 + t8) = *(const u32x4*)(hyout + (size_t)(ct * 64 + cl) * LP + tt * 64 + t8); }
    __syncthreads();
    { const int tl = tid >> 3, c8 = (tid & 7) * 8; const int t = tt * 64 + tl;
      if (t < L_TOK) { bf16_t* gp = ya + (size_t)t * 1024 + ct * 64 + c8; const u32x4 g = *(const u32x4*)gp;
          float v[8];
#pragma unroll
          for (int i = 0; i < 8; ++i) v[i] = bf2f(tile[(c8 + i) * 72 + tl]);
          u32x4 w; w.x = cvt_pk_bf16(v[0] * lo_bf(g.x), v[1] * hi_bf(g.x)); w.y = cvt_pk_bf16(v[2] * lo_bf(g.y), v[3] * hi_bf(g.y)); w.z = cvt_pk_bf16(v[4] * lo_bf(g.z), v[5] * hi_bf(g.z)); w.w = cvt_pk_bf16(v[6] * lo_bf(g.w), v[7] * hi_bf(g.w));
          *(u32x4*)gp = w; } }
}

__device__ void phase_final(const Params& p) {
    const int tid = opaque_tid(), lane = tid & 63, wv = tid >> 6; const float* h = (const float*)(p.ws + OFF_H);
    for (int l = NMETA + blockIdx.x * 8 + wv; l < L_TOK; l += gridDim.x * 8) { const f32x4* row = (const f32x4*)(h + (size_t)l * DM); f32x4 v[8]; float ss = 0.f;
#pragma unroll
        for (int i = 0; i < 8; ++i) { v[i] = row[i * 64 + lane]; ss += v[i][0] * v[i][0] + v[i][1] * v[i][1] + v[i][2] * v[i][2] + v[i][3] * v[i][3]; }
        ss = wave_sum(ss); const float inv = rsqrtf(ss * (1.0f / DM) + 1e-6f); f32x4* o = (f32x4*)(p.out + (size_t)(l - NMETA) * DM);
#pragma unroll
        for (int i = 0; i < 8; ++i) { const f32x4 gg = ((const f32x4*)p.final_g)[i * 64 + lane]; o[i * 64 + lane] = v[i] * inv * gg; } }
}

enum { OP_P1 = 0, OP_SYNC, OP_GEMM, OP_NA, OP_HYENA, OP_TRANS };
__global__ void __launch_bounds__(512, 2) hybrid_fwd(Params p) {
    extern __shared__ __attribute__((aligned(16))) unsigned char smem[];
    cg::grid_group grid = cg::this_grid();
    LAS unsigned char* lds = (LAS unsigned char*)smem;
    const int bid = blockIdx.x, G = gridDim.x;
    phase_prep0(p, smem);
    constexpr int NOPS = 17;
#pragma clang loop unroll(disable)
    for (int step = 0; step < 2 * NOPS; ++step) {
        const int layer = step / NOPS, s = step - layer * NOPS;
        int op, kind = 0;
        switch (s) {
        case 0: op = OP_P1; break;
        case 2: op = OP_GEMM; kind = K_TOK; break;
        case 3: op = OP_GEMM; kind = K_HYIN; break;
        case 4: op = OP_GEMM; kind = K_F0; break;
        case 6: op = OP_GEMM; kind = K_FNA; break;
        case 7: op = OP_NA; break;
        case 8: op = OP_HYENA; break;
        case 10: op = OP_GEMM; kind = K_FNB; break;
        case 11: op = OP_TRANS; break;
        case 13: op = OP_GEMM; kind = K_BR; break;
        case 15: op = OP_GEMM; kind = K_OUT; break;
        default: op = OP_SYNC; break;
        }
        if (op == OP_SYNC) { grid.sync(); }
        else if (op == OP_GEMM) {
            Gemm g; g.base = (const char*)p.ws; g.jumpA = 0; g.jumpB = 0;
            switch (kind) {
            case K_FNA: g.lda = 384; g.ldb = FN1P; g.nt = 6; g.ksplit = 3; g.jumpB = (long)((size_t)1024 * PROWS * 2) - 384l; break;
            case K_FNB: g.lda = 256; g.ldb = 256; g.nt = 4; g.ksplit = 4; break;
            case K_BR:  g.lda = 1024; g.ldb = 1024; g.nt = 16; g.ksplit = 16; break;
            default:    g.lda = DM; g.ldb = DM; g.nt = 32; g.ksplit = 32; break;
            }
            SchedAny S{kind, G, bid}; EpiAny E{kind, p.ws};
            pg8::gemm_phase(lds, g, S, E);
        }
        else if (op == OP_P1) { phase_p1(p, layer, smem); }
        else if (op == OP_NA) { for (int u = bid; u < 4096; u += G) na_unit(p, layer, u >> 4, u & 15, smem); if (bid == G - 1) na_meta_unit(p, layer); }
        else if (op == OP_HYENA) { for (int ch = bid; ch < 1024; ch += G) hyena_unit(p, layer, ch, smem, (unsigned char*)p.out + (size_t)bid * HS_STRIDE); }
        else { for (int u = bid; u < 16 * 257; u += G) transpose_unit(p, u & 15, u >> 4, smem); }
    }
    phase_final(p);
}

extern "C" void kernel_launch(void* const* d_in, const int* in_sizes, int n_in, void* d_out, int out_size, void* d_ws, size_t ws_size, hipStream_t stream) {
    static int grid_blocks = 0;
    if (grid_blocks == 0) {
        if (n_in != 23 || ws_size < WS_END) { fprintf(stderr, "kernel_launch: need 23 inputs and %zu bytes of workspace (got %d, %zu)\n", (size_t)WS_END, n_in, ws_size); grid_blocks = -1; return; }
        int dev = 0, cus = 0, per_cu = 0;
        hipGetDevice(&dev); hipDeviceGetAttribute(&cus, hipDeviceAttributeMultiprocessorCount, dev);
        if (hipFuncSetAttribute((const void*)hybrid_fwd, hipFuncAttributeMaxDynamicSharedMemorySize, LDS_BYTES) != hipSuccess) { fprintf(stderr, "kernel_launch: hipFuncSetAttribute failed\n"); grid_blocks = -1; return; }
        hipOccupancyMaxActiveBlocksPerMultiprocessor(&per_cu, (const void*)hybrid_fwd, NTHREADS, LDS_BYTES);
        if (per_cu < 1) per_cu = 1;
        grid_blocks = cus * per_cu;
        if (grid_blocks > 256) grid_blocks = 256;
    }
    if (grid_blocks < 0) return;
    Params p{};
    const float** f = (const float**)&p;
    for (int i = 0; i < 23; ++i) f[i] = (const float*)d_in[i];
    p.out = (float*)d_out; p.ws = (unsigned char*)d_ws;
    void* args[] = {&p};
    hipError_t e = hipLaunchCooperativeKernel((const void*)hybrid_fwd, dim3(grid_blocks), dim3(NTHREADS), args, LDS_BYTES, stream);
    if (e != hipSuccess) fprintf(stderr, "cooperative launch failed: %s (grid %d)\n", hipGetErrorString(e), grid_blocks);
}
```

```cpp
#include <hip/hip_runtime.h>
#include <hip/hip_cooperative_groups.h>
#include <cstdio>
namespace cg = cooperative_groups;

#define LAS __attribute__((address_space(3)))
typedef unsigned short bf16_t;
typedef short bf16x8 __attribute__((ext_vector_type(8)));
typedef float f32x4 __attribute__((ext_vector_type(4)));
typedef unsigned u32x4 __attribute__((ext_vector_type(4)));
typedef unsigned u32x2 __attribute__((ext_vector_type(2)));

constexpr int L_TOK = 16400, LP = 16640, DM = 2048, NIN = 16384, NMETA = 16, NMAIN = 16384;
constexpr int FN1 = 164, FN2 = 100, FN1P = 192, PROWS = FN2 * FN1P;
constexpr int NTHREADS = 512, LDS_BYTES = 155648;

constexpr size_t SZ_H = (size_t)LP * DM * 4, SZ_XN = (size_t)LP * DM * 2, SZ_XNP = (size_t)PROWS * DM * 2;
constexpr size_t OFF_H = 0;
constexpr size_t OFF_XN = OFF_H + SZ_H;
constexpr size_t OFF_XNP = OFF_XN + SZ_XN;
constexpr size_t OFF_A1 = OFF_XN;
constexpr size_t SZ_A1 = (size_t)FN1 * 1024 * 2 * 128 * 2;
constexpr size_t OFF_HYOUT = OFF_A1 + SZ_A1;
constexpr size_t SZ_HYOUT = (size_t)1024 * LP * 2;
static_assert(OFF_HYOUT + SZ_HYOUT <= OFF_XNP + SZ_XNP, "alias overflow");
constexpr size_t OFF_WT = OFF_XNP + SZ_XNP;
constexpr size_t OFF_WEFF = OFF_WT + (size_t)NIN * DM * 2;
constexpr size_t OFF_WA = OFF_WEFF + (size_t)2048 * 2048 * 2;
constexpr size_t SZ_WBR = (size_t)2048 * 1024 * 2;
constexpr size_t OFF_WO = OFF_WA + 3 * SZ_WBR;
constexpr size_t OFF_HYIN = OFF_WO + (size_t)2048 * 2048 * 2;
constexpr size_t OFF_GATE = OFF_HYIN + (size_t)3072 * LP * 2;
constexpr size_t SZ_GATE = (size_t)LP * 1024 * 2;
constexpr size_t OFF_QKV = OFF_GATE + 3 * SZ_GATE;
constexpr size_t OFF_MERGE = OFF_QKV + (size_t)LP * 3072 * 2;
constexpr size_t OFF_ZT = OFF_MERGE + (size_t)LP * 6144 * 2;
constexpr size_t SZ_ZT = (size_t)2048 * PROWS * 2;
constexpr size_t OFF_M = OFF_ZT;
static_assert(SZ_XN <= SZ_ZT, "alias overflow");
constexpr size_t OFF_FA = OFF_ZT + SZ_ZT;
constexpr size_t OFF_FB = OFF_FA + (size_t)512 * 384 * 2;
constexpr size_t OFF_H3 = OFF_FB + (size_t)FN1 * 256 * 256 * 2;
constexpr size_t WS_END = OFF_H3 + (size_t)2 * L_TOK * 64 * 4;
constexpr size_t HS_HEO = 0, HS_CORR = 131328, HS_Z2 = HS_CORR + 65536, HS_G2F = HS_Z2 + 65792, HS_G2B = HS_G2F + 65792, HS_STRIDE = HS_G2B + 65792;
static_assert(HS_STRIDE * 256 <= (size_t)NMAIN * DM * 4, "scratch overflow");

struct Params {
    const float* x; const float* meta; const float* norm_g; const float* w_in; const float* conv_w; const float* conv_b;
    const float* f_w1; const float* f_b1; const float* f_w2; const float* f_b2; const float* f_w3; const float* f_b3; const float* f_w4;
    const float* f_freq; const float* decay; const float* skip; const float* rpb; const float* meta_bias;
    const float* w_a; const float* w_b; const float* w_c; const float* w_out; const float* final_g;
    float* out; unsigned char* ws;
};

__device__ __forceinline__ int opaque_tid() { int t = threadIdx.x; asm volatile("" : "+v"(t)); return t; }
__device__ __forceinline__ float bf2f(bf16_t b) { return __uint_as_float(((unsigned)b) << 16); }
__device__ __forceinline__ bf16_t f2bf(float f) { unsigned u = __float_as_uint(f); u += 0x7FFFu + ((u >> 16) & 1u); return (bf16_t)(u >> 16); }
__device__ __forceinline__ unsigned cvt_pk_bf16(float lo, float hi) { unsigned r; asm volatile("v_cvt_pk_bf16_f32 %0, %1, %2" : "=v"(r) : "v"(lo), "v"(hi)); return r; }
__device__ __forceinline__ float lo_bf(unsigned u) { return __uint_as_float(u << 16); }
__device__ __forceinline__ float hi_bf(unsigned u) { return __uint_as_float(u & 0xffff0000u); }
__device__ __forceinline__ float silu_f(float v) { return v / (1.0f + __expf(-v)); }
__device__ __forceinline__ float sigm_f(float v) { return 1.0f / (1.0f + __expf(-v)); }
__device__ __forceinline__ float wave_sum(float v) {
#pragma unroll
    for (int o = 32; o >= 1; o >>= 1) v += __shfl_xor(v, o);
    return v;
}

namespace pg8 {
constexpr int BM = 256, BK = 64, HALF = 128, HTB = HALF * BK * 2, STAGE_BYTES = 8 * HTB;
__device__ __forceinline__ int lds_byte(int r, int c) { const int st = (r >> 4) * 2 + (c >> 5), rr = r & 15, cc = c & 31, ob = rr * 64 + cc * 2; return st * 1024 + (ob ^ (((ob >> 9) & 1) << 5)); }
__device__ __forceinline__ void stage_rc(int b, int& R, int& C) { const int st = b / 1024, sb = b % 1024, swz = sb ^ (((sb >> 9) & 1) << 5); R = (st >> 1) * 16 + swz / 64; C = (st & 1) * 32 + (swz % 64) / 2; }
__device__ __forceinline__ int perm32(int rho) { const int n = rho >> 4, i = rho & 15; return 8 * (i >> 2) + 4 * n + (i & 3); }

struct Unit { int pm, pn, aux; size_t offA, offB; };
struct Gemm { const char* base; int lda, ldb, nt, ksplit; long jumpA, jumpB; };

__device__ __forceinline__ void tile_map(int wgid, int nM, int nN, int& pm, int& pn) {
    const int nwg = nM * nN;
    { const int q = nwg / 8, r = nwg % 8, xcd = wgid % 8, off = wgid / 8; wgid = (xcd < r ? xcd * (q + 1) : r * (q + 1) + (xcd - r) * q) + off; }
    const int nig = 8 * nN, gid = wgid / nig, fm = gid * 8, gsz = (nM - fm) < 8 ? (nM - fm) : 8;
    pm = fm + ((wgid % nig) % gsz); pn = (wgid % nig) / gsz;
}

template <class Epi, class Sched>
__device__ __forceinline__ void gemm_phase(LAS unsigned char* lds, const Gemm g, const Sched& S, const Epi& E) {
    const int tid = opaque_tid(), wid = __builtin_amdgcn_readfirstlane(tid >> 6), lane = tid & 63, wr = wid >> 2, wc = wid & 3, fr = lane & 15, fq = lane >> 4;
    const int nt = g.nt;
    unsigned voffA[2], voffB[2];
#pragma unroll
    for (int i = 0; i < 2; ++i) { int R, C; stage_rc(tid * 16 + i * 8192, R, C); const int Rb = (R & ~31) + perm32(R & 31);
        voffA[i] = (unsigned)(R * g.lda + C) * 2u; voffB[i] = (unsigned)(Rb * g.ldb + C) * 2u; }
    const size_t kstep = (size_t)(BK * 2);
    const size_t hstepA = (size_t)HALF * g.lda * 2, hstepB = (size_t)HALF * g.ldb * 2;
    const unsigned ldsw = (unsigned)wid * 1024u;
    const int aoff = lds_byte(wr * 64 + fr, fq * 8), boff = lds_byte(wc * 32 + fr, fq * 8);
#define PG8_KA(p, t) ((p) + (size_t)(t) * kstep + ((t) >= g.ksplit ? g.jumpA : 0l))
#define PG8_KB(p, t) ((p) + (size_t)(t) * kstep + ((t) >= g.ksplit ? g.jumpB : 0l))
#define PG8_SA(b, h) (((b) * 2 + (h)) * HTB)
#define PG8_SB(b, h) ((4 + (b) * 2 + (h)) * HTB)
#define PG8_STAGE(bufoff, gbase, voff) do { _Pragma("unroll") for (int _i = 0; _i < 2; ++_i) \
        __builtin_amdgcn_global_load_lds((const unsigned*)((const char*)(gbase) + (voff)[_i]), (LAS unsigned*)(lds + (bufoff) + ldsw + _i * 8192), 16, 0, 0); } while (0)
#define PG8_LDA(dst, b, h) do { _Pragma("unroll") for (int m = 0; m < 4; ++m) _Pragma("unroll") for (int k = 0; k < 2; ++k) dst[m][k] = *(const LAS bf16x8*)(lds + PG8_SA(b, h) + aoff + m * 2048 + k * 1024); } while (0)
#define PG8_LDB(dst, b, h) do { _Pragma("unroll") for (int n = 0; n < 2; ++n) _Pragma("unroll") for (int k = 0; k < 2; ++k) dst[n][k] = *(const LAS bf16x8*)(lds + PG8_SB(b, h) + boff + n * 2048 + k * 1024); } while (0)
#define PG8_MMA(ai, bj, At, Bt) do { __builtin_amdgcn_s_setprio(1); _Pragma("unroll") for (int m = 0; m < 4; ++m) _Pragma("unroll") for (int n = 0; n < 2; ++n) _Pragma("unroll") for (int k = 0; k < 2; ++k) \
        acc[ai][bj][m][n] = __builtin_amdgcn_mfma_f32_16x16x32_bf16(Bt[n][k], At[m][k], acc[ai][bj][m][n], 0, 0, 0); __builtin_amdgcn_s_setprio(0); } while (0)
#define PG8_WAIT_V(n) asm volatile("s_waitcnt vmcnt(" #n ")" ::: "memory")
#define PG8_WAIT_L(n) asm volatile("s_waitcnt lgkmcnt(" #n ")" ::: "memory")
#define PG8_BAR __builtin_amdgcn_s_barrier()
#define PG8_SCHED __builtin_amdgcn_sched_barrier(0)
    Unit cur, nxt; int ui = 0;
    if (!S.next(0, cur)) return;
    f32x4 acc[2][2][4][2];
#pragma unroll
    for (int a = 0; a < 2; ++a)
#pragma unroll
        for (int b = 0; b < 2; ++b)
#pragma unroll
            for (int m = 0; m < 4; ++m)
#pragma unroll
                for (int n = 0; n < 2; ++n) acc[a][b][m][n] = (f32x4){0.f, 0.f, 0.f, 0.f};
    bf16x8 At[4][2], B0[2][2], B1[2][2];
    const char* cA = g.base + cur.offA; const char* cB = g.base + cur.offB;
    PG8_STAGE(PG8_SB(0, 0), cB, voffB); PG8_STAGE(PG8_SA(0, 0), cA, voffA); PG8_STAGE(PG8_SB(0, 1), cB + hstepB, voffB); PG8_STAGE(PG8_SA(0, 1), cA + hstepA, voffA);
    if (wr == 1) PG8_BAR;
    PG8_WAIT_V(4); PG8_BAR;
    PG8_STAGE(PG8_SB(1, 0), PG8_KB(cB, 1), voffB); PG8_STAGE(PG8_SA(1, 0), PG8_KA(cA, 1), voffA); PG8_STAGE(PG8_SB(1, 1), PG8_KB(cB, 1) + hstepB, voffB);
    PG8_WAIT_V(6); PG8_BAR;
    for (;;) {
        const bool has_next = S.next(ui + 1, nxt);
        const char* nA = has_next ? g.base + nxt.offA : cA; const char* nB = has_next ? g.base + nxt.offB : cB;
        for (int t = 0; t < nt; t += 2) {
            const bool last = (t == nt - 2);
            const char* a1 = PG8_KA(cA, t + 1);
            const char* a2 = last ? nA : PG8_KA(cA, t + 2); const char* b2 = last ? nB : PG8_KB(cB, t + 2);
            const char* a3 = last ? PG8_KA(nA, 1) : PG8_KA(cA, t + 3); const char* b3 = last ? PG8_KB(nB, 1) : PG8_KB(cB, t + 3);
            PG8_LDB(B0, 0, 0); PG8_SCHED; PG8_LDA(At, 0, 0); PG8_STAGE(PG8_SA(1, 1), a1 + hstepA, voffA);
            PG8_WAIT_L(8); PG8_BAR; PG8_WAIT_L(0); PG8_MMA(0, 0, At, B0); PG8_BAR; PG8_SCHED;
            PG8_LDB(B1, 0, 1); PG8_STAGE(PG8_SB(0, 0), b2, voffB);
            PG8_BAR; PG8_WAIT_L(0); PG8_MMA(0, 1, At, B1); PG8_BAR;
            PG8_LDA(At, 0, 1); PG8_STAGE(PG8_SA(0, 0), a2, voffA);
            PG8_BAR; PG8_WAIT_L(0); PG8_MMA(1, 0, At, B0); PG8_BAR; PG8_SCHED;
            PG8_STAGE(PG8_SB(0, 1), b2 + hstepB, voffB);
            PG8_WAIT_V(6); PG8_BAR; PG8_MMA(1, 1, At, B1); PG8_BAR;
            PG8_LDB(B0, 1, 0); PG8_SCHED; PG8_LDA(At, 1, 0); PG8_STAGE(PG8_SA(0, 1), a2 + hstepA, voffA);
            PG8_WAIT_L(8); PG8_BAR; PG8_WAIT_L(0); PG8_MMA(0, 0, At, B0); PG8_BAR; PG8_SCHED;
            PG8_LDB(B1, 1, 1); PG8_STAGE(PG8_SB(1, 0), b3, voffB);
            PG8_BAR; PG8_WAIT_L(0); PG8_MMA(0, 1, At, B1); PG8_BAR;
            PG8_LDA(At, 1, 1); PG8_STAGE(PG8_SA(1, 0), a3, voffA);
            PG8_BAR; PG8_WAIT_L(0); PG8_MMA(1, 0, At, B0); PG8_BAR; PG8_SCHED;
            PG8_STAGE(PG8_SB(1, 1), b3 + hstepB, voffB);
            PG8_WAIT_V(6); PG8_BAR; PG8_MMA(1, 1, At, B1); PG8_BAR;
        }
        E(acc, cur, wr, wc, fr, fq);
        if (!has_next) break;
#pragma unroll
        for (int a = 0; a < 2; ++a)
#pragma unroll
            for (int b = 0; b < 2; ++b)
#pragma unroll
                for (int m = 0; m < 4; ++m)
#pragma unroll
                    for (int n = 0; n < 2; ++n) acc[a][b][m][n] = (f32x4){0.f, 0.f, 0.f, 0.f};
        cur = nxt; cA = nA; cB = nB; ++ui;
    }
    PG8_WAIT_V(0);
    if (wr == 0) PG8_BAR;
    PG8_BAR;
#undef PG8_KA
#undef PG8_KB
#undef PG8_SA
#undef PG8_SB
#undef PG8_STAGE
#undef PG8_LDA
#undef PG8_LDB
#undef PG8_MMA
#undef PG8_WAIT_V
#undef PG8_WAIT_L
#undef PG8_BAR
#undef PG8_SCHED
}
}
using pg8::Unit; using pg8::Gemm;
#define ACC_T const f32x4 (&acc)[2][2][4][2]

enum { K_TOK = 0, K_HYIN = 1, K_F0 = 2, K_FNA = 3, K_FNB = 4, K_BR = 5, K_OUT = 6, K_IN = 7 };
struct SchedAny {
    int kind, G, c;
    __device__ __forceinline__ bool next(int i, Unit& u) const {
        const long Lx = (long)i * G + c;
        switch (kind) {
        case K_IN: {
            if (Lx < 3120) { int pn; pg8::tile_map((int)Lx, 65, 48, u.pm, pn); u.pn = pn < 4 ? 12 + pn : 16 + pn; u.aux = K_TOK;
                u.offA = OFF_XN + (size_t)u.pm * 256 * DM * 2; u.offB = OFF_WT + (size_t)u.pn * 256 * DM * 2; return true; }
            if (Lx < 3900) { pg8::tile_map((int)Lx - 3120, 12, 65, u.pm, u.pn); u.aux = K_HYIN;
                u.offA = OFF_WT + (size_t)u.pm * 256 * DM * 2; u.offB = OFF_XN + (size_t)u.pn * 256 * DM * 2; return true; }
            if (Lx < 4500) { pg8::tile_map((int)Lx - 3900, 8, 75, u.pm, u.pn); u.aux = K_F0;
                u.offA = OFF_WEFF + (size_t)u.pm * 256 * DM * 2; u.offB = OFF_XNP + (size_t)u.pn * 256 * DM * 2; return true; }
            return false; }
        case K_TOK: {
            if (Lx >= 65l * 48) return false; int pn; pg8::tile_map((int)Lx, 65, 48, u.pm, pn); u.pn = pn < 4 ? 12 + pn : 16 + pn; u.aux = 0;
            u.offA = OFF_XN + (size_t)u.pm * 256 * DM * 2; u.offB = OFF_WT + (size_t)u.pn * 256 * DM * 2; return true; }
        case K_HYIN: {
            if (Lx >= 12l * 65) return false; pg8::tile_map((int)Lx, 12, 65, u.pm, u.pn); u.aux = 0;
            u.offA = OFF_WT + (size_t)u.pm * 256 * DM * 2; u.offB = OFF_XN + (size_t)u.pn * 256 * DM * 2; return true; }
        case K_F0: {
            if (Lx >= 8l * 75) return false; pg8::tile_map((int)Lx, 8, 75, u.pm, u.pn); u.aux = 0;
            u.offA = OFF_WEFF + (size_t)u.pm * 256 * DM * 2; u.offB = OFF_XNP + (size_t)u.pn * 256 * DM * 2; return true; }
        case K_FNA: {
            if (Lx >= 2l * 400) return false; pg8::tile_map((int)Lx, 2, 400, u.pm, u.pn); u.aux = 0;
            u.offA = OFF_FA + (size_t)u.pm * 256 * 384 * 2; u.offB = OFF_ZT + (size_t)u.pn * 256 * FN1P * 2; return true; }
        case K_FNB: {
            if (Lx >= 164l * 4) return false; u.aux = (int)(Lx >> 2); u.pm = 0; u.pn = (int)(Lx & 3);
            u.offA = OFF_FB + (size_t)u.aux * 256 * 256 * 2; u.offB = OFF_A1 + (size_t)u.aux * 1024 * 256 * 2 + (size_t)u.pn * 256 * 256 * 2; return true; }
        case K_BR: {
            const int T = (i / 3) * G + c; if (T >= 65 * 8) return false; const int br = i % 3; pg8::tile_map(T, 65, 8, u.pm, u.pn); u.aux = br;
            u.offA = OFF_GATE + (size_t)br * SZ_GATE + (size_t)u.pm * 256 * 1024 * 2; u.offB = OFF_WA + (size_t)br * SZ_WBR + (size_t)u.pn * 256 * 1024 * 2; return true; }
        default: {
            if (Lx >= 65l * 8) return false; pg8::tile_map((int)Lx, 65, 8, u.pm, u.pn); u.aux = 0;
            u.offA = OFF_M + (size_t)u.pm * 256 * DM * 2; u.offB = OFF_WO + (size_t)u.pn * 256 * DM * 2; return true; }
        }
    }
};
#define ROWFENCE asm volatile("" ::: "memory")
#define HARDFENCE do { asm volatile("" ::: "memory"); __builtin_amdgcn_sched_barrier(0); } while (0)
struct EpiAny {
    int kind; unsigned char* ws;
    __device__ __forceinline__ void operator()(ACC_T, const Unit& u, int wr, int wc, int fr, int fq) const {
        const int rl0 = wr * 64 + fr, cl0 = wc * 32 + 8 * fq;
        const int ek = kind == K_IN ? u.aux : kind;
        if (ek == K_TOK) {
            const int t = u.pn; unsigned char* dst; unsigned ld; int c0, act;
            if (t < 16)      { dst = ws + OFF_GATE;               ld = 1024; c0 = (t - 12) * 256; act = 1; }
            else if (t < 24) { dst = ws + OFF_GATE + SZ_GATE;     ld = 1024; c0 = (t - 20) * 256; act = 1; }
            else if (t < 36) { dst = ws + OFF_QKV;                ld = 3072; c0 = (t - 24) * 256; act = 0; }
            else if (t < 40) { dst = ws + OFF_GATE + 2 * SZ_GATE; ld = 1024; c0 = (t - 36) * 256; act = 1; }
            else             { dst = ws + OFF_MERGE;              ld = 6144; c0 = (t - 40) * 256; act = 2; }
#pragma unroll
            for (int ai = 0; ai < 2; ++ai)
#pragma unroll
                for (int m = 0; m < 4; ++m) { const unsigned row = (unsigned)(u.pm * 256 + ai * 128 + m * 16 + rl0);
#pragma unroll
                    for (int bj = 0; bj < 2; ++bj) { const unsigned off = (row * ld + (unsigned)(c0 + bj * 128 + cl0)) * 2u; f32x4 v0 = acc[ai][bj][m][0], v1 = acc[ai][bj][m][1];
                        if (act == 1) {
#pragma unroll
                            for (int j = 0; j < 4; ++j) { v0[j] = silu_f(v0[j]); v1[j] = silu_f(v1[j]); } }
                        else if (act == 2) {
#pragma unroll
                            for (int j = 0; j < 4; ++j) { v0[j] = sigm_f(v0[j]); v1[j] = sigm_f(v1[j]); } }
                        u32x4 w; w.x = cvt_pk_bf16(v0[0], v0[1]); w.y = cvt_pk_bf16(v0[2], v0[3]); w.z = cvt_pk_bf16(v1[0], v1[1]); w.w = cvt_pk_bf16(v1[2], v1[3]);
                        *(u32x4*)(dst + off) = w; }
                    ROWFENCE; }
        } else if (ek == K_HYIN || ek == K_F0) {
            unsigned char* dst = ws + (ek == K_HYIN ? OFF_HYIN : OFF_ZT); const unsigned ld = ek == K_HYIN ? LP : PROWS;
#pragma unroll
            for (int ai = 0; ai < 2; ++ai)
#pragma unroll
                for (int m = 0; m < 4; ++m) { const unsigned row = (unsigned)(u.pm * 256 + ai * 128 + m * 16 + rl0);
#pragma unroll
                    for (int bj = 0; bj < 2; ++bj) { const unsigned off = (row * ld + (unsigned)(u.pn * 256 + bj * 128 + cl0)) * 2u; const f32x4 v0 = acc[ai][bj][m][0], v1 = acc[ai][bj][m][1];
                        u32x4 w; w.x = cvt_pk_bf16(v0[0], v0[1]); w.y = cvt_pk_bf16(v0[2], v0[3]); w.z = cvt_pk_bf16(v1[0], v1[1]); w.w = cvt_pk_bf16(v1[2], v1[3]);
                        *(u32x4*)(dst + off) = w; }
                    ROWFENCE; }
        } else if (ek == K_FNA) {
            unsigned char* dst = ws + OFF_A1;
#pragma unroll
            for (int ai = 0; ai < 2; ++ai)
#pragma unroll
                for (int m = 0; m < 4; ++m) { const int k1 = ai * 128 + m * 16 + rl0;
                    if (k1 < FN1) {
#pragma unroll
                        for (int bj = 0; bj < 2; ++bj)
#pragma unroll
                            for (int n = 0; n < 2; ++n) { const int col = u.pn * 256 + bj * 128 + cl0 + 4 * n; const int ch = col / FN2, l2 = col - ch * FN2; const f32x4 v = acc[ai][bj][m][n];
                                u32x2 w; w.x = cvt_pk_bf16(v[0], v[1]); w.y = cvt_pk_bf16(v[2], v[3]);
                                *(u32x2*)(dst + ((unsigned)((k1 * 1024 + ch) * 2 + u.pm) * 128u + (unsigned)l2) * 2u) = w; } }
                    ROWFENCE; }
        } else if (ek == K_FNB) {
            unsigned char* dst = ws + OFF_GATE + SZ_GATE; const float scale = 1.0f / sqrtf((float)L_TOK * 256.0f);
#pragma unroll
            for (int ai = 0; ai < 2; ++ai)
#pragma unroll
                for (int m = 0; m < 4; ++m) { const int k2 = ai * 128 + m * 16 + rl0;
                    if (k2 < FN2) { const unsigned row = (unsigned)(u.aux + FN1 * k2);
#pragma unroll
                        for (int bj = 0; bj < 2; ++bj) { const unsigned off = (row * 1024u + (unsigned)(u.pn * 256 + bj * 128 + cl0)) * 2u; const u32x4 g = *(const u32x4*)(dst + off);
                            const f32x4 v0 = acc[ai][bj][m][0] * scale, v1 = acc[ai][bj][m][1] * scale;
                            u32x4 w; w.x = cvt_pk_bf16(v0[0] * lo_bf(g.x), v0[1] * hi_bf(g.x)); w.y = cvt_pk_bf16(v0[2] * lo_bf(g.y), v0[3] * hi_bf(g.y));
                            w.z = cvt_pk_bf16(v1[0] * lo_bf(g.z), v1[1] * hi_bf(g.z)); w.w = cvt_pk_bf16(v1[2] * lo_bf(g.w), v1[3] * hi_bf(g.w));
                            *(u32x4*)(dst + off) = w; } }
                    ROWFENCE; }
        } else if (ek == K_BR) {
            unsigned char* dst = ws + OFF_M; const unsigned char* mg = ws + OFF_MERGE; const int br = u.aux;
#pragma unroll
            for (int ai = 0; ai < 2; ++ai)
#pragma unroll
                for (int m = 0; m < 4; ++m) { const unsigned row = (unsigned)(u.pm * 256 + ai * 128 + m * 16 + rl0);
#pragma unroll
                    for (int bj = 0; bj < 2; ++bj) { const unsigned col = (unsigned)(u.pn * 256 + bj * 128 + cl0); const unsigned off = (row * (unsigned)DM + col) * 2u;
                        const u32x4 g = *(const u32x4*)(mg + (row * 6144u + (unsigned)br * 2048u + col) * 2u); const f32x4 v0 = acc[ai][bj][m][0], v1 = acc[ai][bj][m][1];
                        float r0 = v0[0] * lo_bf(g.x), r1 = v0[1] * hi_bf(g.x), r2 = v0[2] * lo_bf(g.y), r3 = v0[3] * hi_bf(g.y), r4 = v1[0] * lo_bf(g.z), r5 = v1[1] * hi_bf(g.z), r6 = v1[2] * lo_bf(g.w), r7 = v1[3] * hi_bf(g.w);
                        if (br > 0) { const u32x4 o = *(const u32x4*)(dst + off); r0 += lo_bf(o.x); r1 += hi_bf(o.x); r2 += lo_bf(o.y); r3 += hi_bf(o.y); r4 += lo_bf(o.z); r5 += hi_bf(o.z); r6 += lo_bf(o.w); r7 += hi_bf(o.w); }
                        u32x4 w; w.x = cvt_pk_bf16(r0, r1); w.y = cvt_pk_bf16(r2, r3); w.z = cvt_pk_bf16(r4, r5); w.w = cvt_pk_bf16(r6, r7);
                        *(u32x4*)(dst + off) = w; }
                    ROWFENCE; }
        } else {
            unsigned char* dst = ws + OFF_H;
#pragma unroll
            for (int ai = 0; ai < 2; ++ai)
#pragma unroll
                for (int m = 0; m < 4; ++m) { const unsigned row = (unsigned)(u.pm * 256 + ai * 128 + m * 16 + rl0);
#pragma unroll
                    for (int bj = 0; bj < 2; ++bj) { const unsigned off = (row * (unsigned)DM + (unsigned)(u.pn * 256 + bj * 128 + cl0)) * 4u;
                        const f32x4 o0 = *(const f32x4*)(dst + off), o1 = *(const f32x4*)(dst + off + 16);
                        *(f32x4*)(dst + off) = o0 + acc[ai][bj][m][0]; *(f32x4*)(dst + off + 16) = o1 + acc[ai][bj][m][1]; }
                    ROWFENCE; }
        }
    }
};

__device__ void phase_prep0(const Params& p, unsigned char* smem) {
    const int tid = opaque_tid(), bid = blockIdx.x, G = gridDim.x;
    const size_t gtid = (size_t)bid * NTHREADS + tid, gstride = (size_t)G * NTHREADS;
    { f32x4* h4 = (f32x4*)(p.ws + OFF_H); const f32x4* x4 = (const f32x4*)p.x; const f32x4* m4 = (const f32x4*)p.meta;
      for (size_t i = gtid; i < (size_t)LP * 512; i += gstride) { const size_t row = i >> 9; f32x4 v = (f32x4){0.f, 0.f, 0.f, 0.f};
          if (row < NMETA) v = m4[i]; else if (row < L_TOK) v = x4[i - (size_t)NMETA * 512]; h4[i] = v; } }
    { bf16_t* fa = (bf16_t*)(p.ws + OFF_FA);
      for (size_t i = gtid; i < (size_t)512 * 384; i += gstride) { const int row = (int)(i / 384), col = (int)(i % 384); const int po = row >> 8, k1 = row & 255, pi = col / 192, l1 = col % 192; float v = 0.f;
          if (k1 < FN1 && l1 < FN1) { const int r = (k1 * l1) % FN1; const float a = 2.0f * (float)r / (float)FN1; const float cs = cospif(a), sn = sinpif(a);
              v = (po == 0) ? (pi == 0 ? cs : sn) : (pi == 0 ? -sn : cs); }
          fa[i] = f2bf(v); } }
    { bf16_t* fb = (bf16_t*)(p.ws + OFF_FB);
      for (size_t i = gtid; i < (size_t)FN1 * 65536; i += gstride) { const int k1 = (int)(i >> 16), k2 = (int)((i >> 8) & 255), kk = (int)(i & 255), part = kk >> 7, l2 = kk & 127; float v = 0.f;
          if (k2 < FN2 && l2 < FN2) { const int lp = k1 + FN1 * k2; const int r = (l2 * lp) % L_TOK; const float a = 2.0f * (float)r / (float)L_TOK; v = part == 0 ? cospif(a) : sinpif(a); }
          fb[i] = f2bf(v); } }
    { float* w1s = (float*)smem;
      float* w2s = w1s + 33 * 64;
      float* w3s = w2s + 64 * 64;
      const int lane = tid & 63, wv = tid >> 6;
      for (int layer = 0; layer < 2; ++layer) {
          __syncthreads();
          for (int i = tid; i < 33 * 64; i += NTHREADS) w1s[i] = p.f_w1[layer * 33 * 64 + i];
          for (int i = tid; i < 64 * 64; i += NTHREADS) { w2s[i] = p.f_w2[layer * 4096 + i]; w3s[i] = p.f_w3[layer * 4096 + i]; }
          __syncthreads();
          const float b1 = p.f_b1[layer * 64 + lane], b2 = p.f_b2[layer * 64 + lane], b3 = p.f_b3[layer * 64 + lane], fr = p.f_freq[layer * 64 + lane];
          bf16_t* h3 = (bf16_t*)(p.ws + OFF_H3) + (size_t)layer * L_TOK * 64;
          for (int lag = bid * 8 + wv; lag < L_TOK; lag += G * 8) {
              const float tt = (float)lag / (float)(L_TOK - 1); const float w = 6.283185307179586f * (float)lag / (float)L_TOK;
              float z = 0.f;
              if (lane == 0) z = tt;
              else if (lane < 33) { const int j = (lane - 1) & 15; const float f = 1e-4f + (float)j * ((15.0f - 1e-4f) / 15.0f); const float a = f * w; z = lane < 17 ? cosf(a) : -sinf(a); }
              float a1 = b1;
#pragma unroll 3
              for (int i = 0; i < 33; ++i) a1 += __shfl(z, i) * w1s[i * 64 + lane];
              const float h1 = sinf(fr * a1);
              float a2 = b2;
#pragma unroll 8
              for (int i = 0; i < 64; ++i) a2 += __shfl(h1, i) * w2s[i * 64 + lane];
              const float h2 = sinf(fr * a2);
              float a3 = b3;
#pragma unroll 8
              for (int i = 0; i < 64; ++i) a3 += __shfl(h2, i) * w3s[i * 64 + lane];
              h3[(size_t)lag * 64 + lane] = f2bf(sinf(fr * a3));
          }
      }
      __syncthreads(); }
}

__device__ __forceinline__ void convert_tile(const float* src, int K, int N, bf16_t* dst, int kt, int nt_, float* tile  ) {
    const int tid = opaque_tid();
    __syncthreads();
#pragma unroll
    for (int ps = 0; ps < 2; ++ps) { const int kl = ps * 32 + (tid >> 4), n4 = (tid & 15) * 4;
        const f32x4 v = *(const f32x4*)(src + (size_t)(kt * 64 + kl) * N + nt_ * 64 + n4);
        tile[kl * 65 + n4] = v[0]; tile[kl * 65 + n4 + 1] = v[1]; tile[kl * 65 + n4 + 2] = v[2]; tile[kl * 65 + n4 + 3] = v[3]; }
    __syncthreads();
    const int nl = tid >> 3, k8 = (tid & 7) * 8;
    u32x4 w; w.x = cvt_pk_bf16(tile[(k8 + 0) * 65 + nl], tile[(k8 + 1) * 65 + nl]); w.y = cvt_pk_bf16(tile[(k8 + 2) * 65 + nl], tile[(k8 + 3) * 65 + nl]);
    w.z = cvt_pk_bf16(tile[(k8 + 4) * 65 + nl], tile[(k8 + 5) * 65 + nl]); w.w = cvt_pk_bf16(tile[(k8 + 6) * 65 + nl], tile[(k8 + 7) * 65 + nl]);
    *(u32x4*)(dst + (size_t)(nt_ * 64 + nl) * K + kt * 64 + k8) = w;
}

__device__ void phase_p1(const Params& p, int layer, unsigned char* smem) {
    const int tid = opaque_tid(), bid = blockIdx.x, G = gridDim.x;
    float* tile = (float*)smem;
    { const float* win = p.w_in + (size_t)layer * DM * NIN;
      for (int t = bid; t < 32 * 256; t += G) convert_tile(win, DM, NIN, (bf16_t*)(p.ws + OFF_WT), t & 31, t >> 5, tile);
      for (int br = 0; br < 3; ++br) { const float* wsrc = (br == 0 ? p.w_a : br == 1 ? p.w_b : p.w_c) + (size_t)layer * 1024 * DM;
          for (int t = bid; t < 16 * 32; t += G) convert_tile(wsrc, 1024, DM, (bf16_t*)(p.ws + OFF_WA + br * SZ_WBR), t & 15, t >> 4, tile); }
      const float* wo = p.w_out + (size_t)layer * DM * DM;
      for (int t = bid; t < 32 * 32; t += G) convert_tile(wo, DM, DM, (bf16_t*)(p.ws + OFF_WO), t & 31, t >> 5, tile);
      __syncthreads(); }
    { float* tileT = (float*)smem;
      float* ctab = tileT + 256 * 32;
      float* stab = ctab + 256;
      const float* win = p.w_in + (size_t)layer * DM * NIN;
      for (int t = bid; t < 256; t += G) { const int g = t >> 6, k0 = (t & 63) * 32;
          __syncthreads();
          if (tid < 256) { const float a = 2.0f * (float)tid / 256.0f; ctab[tid] = cospif(a); stab[tid] = sinpif(a); }
#pragma unroll
          for (int ps = 0; ps < 4; ++ps) { const int idx = ps * NTHREADS + tid; const int kl = idx >> 6, c4 = (idx & 63) * 4;
              const f32x4 v = *(const f32x4*)(win + (size_t)(k0 + kl) * NIN + 4096 + g * 256 + c4);
              tileT[(c4 + 0) * 32 + kl] = v[0]; tileT[(c4 + 1) * 32 + kl] = v[1]; tileT[(c4 + 2) * 32 + kl] = v[2]; tileT[(c4 + 3) * 32 + kl] = v[3]; }
          __syncthreads();
          const int cp = tid & 255, part = tid >> 8;
          float acc[32];
#pragma unroll
          for (int k = 0; k < 32; ++k) acc[k] = 0.f;
          for (int c = 0; c < 256; ++c) { const int r = (c * cp) & 255; const float tw = part == 0 ? ctab[r] : -stab[r];
#pragma unroll
              for (int k4 = 0; k4 < 8; ++k4) { const f32x4 v = *(const f32x4*)(tileT + c * 32 + k4 * 4); acc[k4 * 4 + 0] += v[0] * tw; acc[k4 * 4 + 1] += v[1] * tw; acc[k4 * 4 + 2] += v[2] * tw; acc[k4 * 4 + 3] += v[3] * tw; } }
          bf16_t* dst = (bf16_t*)(p.ws + OFF_WEFF) + (size_t)(part * 1024 + g * 256 + cp) * DM + k0;
#pragma unroll
          for (int k8 = 0; k8 < 4; ++k8) { u32x4 w; w.x = cvt_pk_bf16(acc[k8 * 8 + 0], acc[k8 * 8 + 1]); w.y = cvt_pk_bf16(acc[k8 * 8 + 2], acc[k8 * 8 + 3]); w.z = cvt_pk_bf16(acc[k8 * 8 + 4], acc[k8 * 8 + 5]); w.w = cvt_pk_bf16(acc[k8 * 8 + 6], acc[k8 * 8 + 7]);
              *(u32x4*)(dst + k8 * 8) = w; } }
      __syncthreads(); }
    { const int lane = tid & 63, wv = tid >> 6; const float* h = (const float*)(p.ws + OFF_H); const float* gam = p.norm_g + layer * DM;
      bf16_t* xn = (bf16_t*)(p.ws + OFF_XN); bf16_t* xnp = (bf16_t*)(p.ws + OFF_XNP);
      for (int l = bid * 8 + wv; l < LP; l += G * 8) {
          if (l < L_TOK) { const f32x4* row = (const f32x4*)(h + (size_t)l * DM); f32x4 v[8]; float ss = 0.f;
#pragma unroll
              for (int i = 0; i < 8; ++i) { v[i] = row[i * 64 + lane]; ss += v[i][0] * v[i][0] + v[i][1] * v[i][1] + v[i][2] * v[i][2] + v[i][3] * v[i][3]; }
              ss = wave_sum(ss); const float inv = rsqrtf(ss * (1.0f / DM) + 1e-6f);
              const int l1 = l / FN2, l2 = l - l1 * FN2; const size_t pr = (size_t)l2 * FN1P + l1;
#pragma unroll
              for (int i = 0; i < 8; ++i) { const f32x4 gg = ((const f32x4*)gam)[i * 64 + lane]; u32x2 w; w.x = cvt_pk_bf16(v[i][0] * inv * gg[0], v[i][1] * inv * gg[1]); w.y = cvt_pk_bf16(v[i][2] * inv * gg[2], v[i][3] * inv * gg[3]);
                  *(u32x2*)(xn + (size_t)l * DM + (i * 64 + lane) * 4) = w; *(u32x2*)(xnp + pr * DM + (i * 64 + lane) * 4) = w; } }
          else { const u32x2 z = (u32x2){0u, 0u};
#pragma unroll
              for (int i = 0; i < 8; ++i) *(u32x2*)(xn + (size_t)l * DM + (i * 64 + lane) * 4) = z; } }
      for (int idx = bid * 8 + wv; idx < FN2 * (FN1P - FN1); idx += G * 8) { const int l2 = idx / (FN1P - FN1), l1 = FN1 + idx % (FN1P - FN1); const size_t pr = (size_t)l2 * FN1P + l1; const u32x2 z = (u32x2){0u, 0u};
#pragma unroll
          for (int i = 0; i < 8; ++i) *(u32x2*)(xnp + pr * DM + (i * 64 + lane) * 4) = z; } }
}

__device__ void na_unit(const Params& p, int layer, int r, int hd, unsigned char* smem) {
    const int tid = opaque_tid(), j = tid >> 6, c = tid & 63;
    const bf16_t* qkv = (const bf16_t*)(p.ws + OFF_QKV);
    const int r0 = min(max(r - 4, 0), 248);
    unsigned char* sK = smem; unsigned char* sV = smem + 73728; unsigned char* sMK = smem + 147456; unsigned char* sMV = sMK + 2304;
    __syncthreads();
#pragma unroll
    for (int ps = 0; ps < 8; ++ps) { const int tok = ps * 64 + (tid >> 3), ch = tid & 7; const size_t g = (size_t)(NMETA + r0 * 64 + tok) * 3072 + hd * 64 + ch * 8;
        *(u32x4*)(sK + tok * 144 + ch * 16) = *(const u32x4*)(qkv + g + 1024); *(u32x4*)(sV + tok * 144 + ch * 16) = *(const u32x4*)(qkv + g + 2048); }
    if (tid < 128) { const int tok = tid >> 3, ch = tid & 7; const size_t g = (size_t)tok * 3072 + hd * 64 + ch * 8;
        *(u32x4*)(sMK + tok * 144 + ch * 16) = *(const u32x4*)(qkv + g + 1024); *(u32x4*)(sMV + tok * 144 + ch * 16) = *(const u32x4*)(qkv + g + 2048); }
    float q[64];
    { const u32x4* qp = (const u32x4*)(qkv + (size_t)(NMETA + r * 64 + c) * 3072 + hd * 64);
#pragma unroll
      for (int i = 0; i < 8; ++i) { const u32x4 v = qp[i]; q[i * 8 + 0] = lo_bf(v.x) * 0.125f; q[i * 8 + 1] = hi_bf(v.x) * 0.125f; q[i * 8 + 2] = lo_bf(v.y) * 0.125f; q[i * 8 + 3] = hi_bf(v.y) * 0.125f;
          q[i * 8 + 4] = lo_bf(v.z) * 0.125f; q[i * 8 + 5] = hi_bf(v.z) * 0.125f; q[i * 8 + 6] = lo_bf(v.w) * 0.125f; q[i * 8 + 7] = hi_bf(v.w) * 0.125f; } }
    __syncthreads();
    const int cs = min(max(c - 8, 0), 48);
    const float* rp = p.rpb + ((size_t)(layer * 16 + hd) * 15 + (r0 + j - r + 7)) * 31 + (cs - c + 15);
    const float* mb = p.meta_bias + (layer * 16 + hd) * 16 + 2 * j;
    float o[64];
#pragma unroll
    for (int i = 0; i < 64; ++i) o[i] = 0.f;
    float mx = -3.0e38f, lsum = 0.f;
#pragma unroll 1
    for (int i = 0; i < 18; ++i) {
        const int ko = i < 16 ? (j * 64 + cs + i) * 144 : 147456 + (2 * j + i - 16) * 144; const int vo = i < 16 ? ko + 73728 : ko + 2304;
        const float bias = i < 16 ? rp[i] : mb[i - 16];
        float d0 = 0.f, d1 = 0.f;
#pragma unroll
        for (int e = 0; e < 8; ++e) { const u32x4 v = *(const u32x4*)(smem + ko + e * 16);
            d0 += q[e * 8 + 0] * lo_bf(v.x) + q[e * 8 + 2] * lo_bf(v.y) + q[e * 8 + 4] * lo_bf(v.z) + q[e * 8 + 6] * lo_bf(v.w);
            d1 += q[e * 8 + 1] * hi_bf(v.x) + q[e * 8 + 3] * hi_bf(v.y) + q[e * 8 + 5] * hi_bf(v.z) + q[e * 8 + 7] * hi_bf(v.w); }
        const float sc = d0 + d1 + bias; const float mnew = fmaxf(mx, sc); const float alpha = __expf(mx - mnew), pi = __expf(sc - mnew);
        lsum = lsum * alpha + pi; mx = mnew;
#pragma unroll
        for (int e = 0; e < 8; ++e) { const u32x4 v = *(const u32x4*)(smem + vo + e * 16);
            o[e * 8 + 0] = o[e * 8 + 0] * alpha + pi * lo_bf(v.x); o[e * 8 + 1] = o[e * 8 + 1] * alpha + pi * hi_bf(v.x); o[e * 8 + 2] = o[e * 8 + 2] * alpha + pi * lo_bf(v.y); o[e * 8 + 3] = o[e * 8 + 3] * alpha + pi * hi_bf(v.y);
            o[e * 8 + 4] = o[e * 8 + 4] * alpha + pi * lo_bf(v.z); o[e * 8 + 5] = o[e * 8 + 5] * alpha + pi * hi_bf(v.z); o[e * 8 + 6] = o[e * 8 + 6] * alpha + pi * lo_bf(v.w); o[e * 8 + 7] = o[e * 8 + 7] * alpha + pi * hi_bf(v.w); }
    }
    __syncthreads();
    float* part = (float*)smem;
    { float* pp = part + (size_t)(j * 64 + c) * 67;
#pragma unroll
      for (int i = 0; i < 64; ++i) pp[i] = o[i];
      pp[64] = mx; pp[65] = lsum; }
    __syncthreads();
    { const int qc = tid >> 3, d0 = (tid & 7) * 8; float mj[8], M = -3.0e38f;
#pragma unroll
      for (int w = 0; w < 8; ++w) { mj[w] = part[(size_t)(w * 64 + qc) * 67 + 64]; M = fmaxf(M, mj[w]); }
      float Lsum = 0.f, o[8];
#pragma unroll
      for (int e = 0; e < 8; ++e) o[e] = 0.f;
#pragma unroll
      for (int w = 0; w < 8; ++w) { const float f = __expf(mj[w] - M); const float* pp = part + (size_t)(w * 64 + qc) * 67; Lsum += f * pp[65];
#pragma unroll
          for (int e = 0; e < 8; ++e) o[e] += f * pp[d0 + e]; }
      const float inv = 1.0f / Lsum;
      bf16_t* gp = (bf16_t*)(p.ws + OFF_GATE + 2 * SZ_GATE) + (size_t)(NMETA + r * 64 + qc) * 1024 + hd * 64 + d0;
      const u32x4 g = *(const u32x4*)gp;
      u32x4 w; w.x = cvt_pk_bf16(o[0] * inv * lo_bf(g.x), o[1] * inv * hi_bf(g.x)); w.y = cvt_pk_bf16(o[2] * inv * lo_bf(g.y), o[3] * inv * hi_bf(g.y));
      w.z = cvt_pk_bf16(o[4] * inv * lo_bf(g.z), o[5] * inv * hi_bf(g.z)); w.w = cvt_pk_bf16(o[6] * inv * lo_bf(g.w), o[7] * inv * hi_bf(g.w));
      *(u32x4*)gp = w; }
}
__device__ void na_meta_unit(const Params& p, int layer) {
    const int tid = opaque_tid();
    if (tid < 256) { const int hd = tid >> 4, qi = tid & 15; const bf16_t* qkv = (const bf16_t*)(p.ws + OFF_QKV);
        float q[64];
        { const u32x4* qp = (const u32x4*)(qkv + (size_t)qi * 3072 + hd * 64);
#pragma unroll
          for (int i = 0; i < 8; ++i) { const u32x4 v = qp[i]; q[i * 8 + 0] = lo_bf(v.x) * 0.125f; q[i * 8 + 1] = hi_bf(v.x) * 0.125f; q[i * 8 + 2] = lo_bf(v.y) * 0.125f; q[i * 8 + 3] = hi_bf(v.y) * 0.125f;
              q[i * 8 + 4] = lo_bf(v.z) * 0.125f; q[i * 8 + 5] = hi_bf(v.z) * 0.125f; q[i * 8 + 6] = lo_bf(v.w) * 0.125f; q[i * 8 + 7] = hi_bf(v.w) * 0.125f; } }
        float o[64];
#pragma unroll
        for (int i = 0; i < 64; ++i) o[i] = 0.f;
        float mx = -3.0e38f, lsum = 0.f;
#pragma unroll 1
        for (int m = 0; m < 16; ++m) { const u32x4* kp = (const u32x4*)(qkv + (size_t)m * 3072 + 1024 + hd * 64); const u32x4* vp = (const u32x4*)(qkv + (size_t)m * 3072 + 2048 + hd * 64);
            float d0 = 0.f, d1 = 0.f;
#pragma unroll
            for (int e = 0; e < 8; ++e) { const u32x4 v = kp[e];
                d0 += q[e * 8 + 0] * lo_bf(v.x) + q[e * 8 + 2] * lo_bf(v.y) + q[e * 8 + 4] * lo_bf(v.z) + q[e * 8 + 6] * lo_bf(v.w);
                d1 += q[e * 8 + 1] * hi_bf(v.x) + q[e * 8 + 3] * hi_bf(v.y) + q[e * 8 + 5] * hi_bf(v.z) + q[e * 8 + 7] * hi_bf(v.w); }
            const float sc = d0 + d1 + p.meta_bias[(layer * 16 + hd) * 16 + m]; const float mnew = fmaxf(mx, sc); const float alpha = __expf(mx - mnew), pi = __expf(sc - mnew);
            lsum = lsum * alpha + pi; mx = mnew;
#pragma unroll
            for (int e = 0; e < 8; ++e) { const u32x4 v = vp[e];
                o[e * 8 + 0] = o[e * 8 + 0] * alpha + pi * lo_bf(v.x); o[e * 8 + 1] = o[e * 8 + 1] * alpha + pi * hi_bf(v.x); o[e * 8 + 2] = o[e * 8 + 2] * alpha + pi * lo_bf(v.y); o[e * 8 + 3] = o[e * 8 + 3] * alpha + pi * hi_bf(v.y);
                o[e * 8 + 4] = o[e * 8 + 4] * alpha + pi * lo_bf(v.z); o[e * 8 + 5] = o[e * 8 + 5] * alpha + pi * hi_bf(v.z); o[e * 8 + 6] = o[e * 8 + 6] * alpha + pi * lo_bf(v.w); o[e * 8 + 7] = o[e * 8 + 7] * alpha + pi * hi_bf(v.w); } }
        const float inv = 1.0f / lsum; u32x4* gp = (u32x4*)((bf16_t*)(p.ws + OFF_GATE + 2 * SZ_GATE) + (size_t)qi * 1024 + hd * 64);
#pragma unroll
        for (int e = 0; e < 8; ++e) { const u32x4 g = gp[e]; u32x4 w;
            w.x = cvt_pk_bf16(o[e * 8 + 0] * inv * lo_bf(g.x), o[e * 8 + 1] * inv * hi_bf(g.x)); w.y = cvt_pk_bf16(o[e * 8 + 2] * inv * lo_bf(g.y), o[e * 8 + 3] * inv * hi_bf(g.y));
            w.z = cvt_pk_bf16(o[e * 8 + 4] * inv * lo_bf(g.z), o[e * 8 + 5] * inv * hi_bf(g.z)); w.w = cvt_pk_bf16(o[e * 8 + 6] * inv * lo_bf(g.w), o[e * 8 + 7] * inv * hi_bf(g.w));
            gp[e] = w; } }
}

__device__ __forceinline__ unsigned rev4_14(unsigned k) { unsigned r = __brev(k) >> 18; return ((r & 0x1555u) << 1) | ((r >> 1) & 0x1555u); }
__device__ __forceinline__ float2 cmul(float2 a, float2 b) { return make_float2(a.x * b.x - a.y * b.y, a.x * b.y + a.y * b.x); }
#define PADI(i) ((i) + ((i) >> 4))
#define CFF(n) cff[2 * PADI((n) >> 1) + ((n) & 1)]
__device__ __forceinline__ void hw_sincos(float rev, float& sn, float& cs) { sn = __builtin_amdgcn_sinf(rev); cs = __builtin_amdgcn_cosf(rev); }
__device__ __forceinline__ float c16(int k) { const float t[10] = {1.0f, 0.9238795325f, 0.7071067812f, 0.3826834324f, 0.0f, -0.3826834324f, -0.7071067812f, -0.9238795325f, -1.0f, -0.9238795325f}; return t[k]; }
__device__ __forceinline__ float s16(int k) { const float t[10] = {0.0f, 0.3826834324f, 0.7071067812f, 0.9238795325f, 1.0f, 0.9238795325f, 0.7071067812f, 0.3826834324f, 0.0f, -0.3826834324f}; return t[k]; }
__device__ void fft_fwd(float2* a) {
    for (int span = 4096; span >= 16; span >>= 2) {
        for (int b = opaque_tid(); b < 4096; b += NTHREADS) { const int j = b & (span - 1); const int base = ((b - j) << 2) + j;
            const int i0 = PADI(base), i1 = PADI(base + span), i2 = PADI(base + 2 * span), i3 = PADI(base + 3 * span);
            const float2 a0 = a[i0], a1 = a[i1], a2 = a[i2], a3 = a[i3];
            const float2 t0 = make_float2(a0.x + a2.x, a0.y + a2.y), t1 = make_float2(a0.x - a2.x, a0.y - a2.y), t2 = make_float2(a1.x + a3.x, a1.y + a3.y);
            const float2 t3 = make_float2(a1.y - a3.y, -(a1.x - a3.x));
            float sn, cs; hw_sincos((float)j / (float)(4 * span), sn, cs);
            const float2 w1 = make_float2(cs, -sn), w2 = cmul(w1, w1), w3 = cmul(w2, w1);
            a[i0] = make_float2(t0.x + t2.x, t0.y + t2.y);
            a[i1] = cmul(make_float2(t1.x + t3.x, t1.y + t3.y), w1);
            a[i2] = cmul(make_float2(t0.x - t2.x, t0.y - t2.y), w2);
            a[i3] = cmul(make_float2(t1.x - t3.x, t1.y - t3.y), w3); }
        __syncthreads(); }
    for (int blk = opaque_tid(); blk < 1024; blk += NTHREADS) { float2* pb = a + blk * 17; float2 x[16];
#pragma unroll
        for (int e = 0; e < 16; ++e) x[e] = pb[e];
#pragma unroll
        for (int j = 0; j < 4; ++j) { const float2 a0 = x[j], a1 = x[j + 4], a2 = x[j + 8], a3 = x[j + 12];
            const float2 t0 = make_float2(a0.x + a2.x, a0.y + a2.y), t1 = make_float2(a0.x - a2.x, a0.y - a2.y), t2 = make_float2(a1.x + a3.x, a1.y + a3.y), t3 = make_float2(a1.y - a3.y, -(a1.x - a3.x));
            x[j] = make_float2(t0.x + t2.x, t0.y + t2.y);
            x[j + 4] = cmul(make_float2(t1.x + t3.x, t1.y + t3.y), make_float2(c16(j), -s16(j)));
            x[j + 8] = cmul(make_float2(t0.x - t2.x, t0.y - t2.y), make_float2(c16(2 * j), -s16(2 * j)));
            x[j + 12] = cmul(make_float2(t1.x - t3.x, t1.y - t3.y), make_float2(c16(3 * j), -s16(3 * j))); }
#pragma unroll
        for (int g = 0; g < 4; ++g) { const float2 a0 = x[4 * g], a1 = x[4 * g + 1], a2 = x[4 * g + 2], a3 = x[4 * g + 3];
            const float2 t0 = make_float2(a0.x + a2.x, a0.y + a2.y), t1 = make_float2(a0.x - a2.x, a0.y - a2.y), t2 = make_float2(a1.x + a3.x, a1.y + a3.y), t3 = make_float2(a1.y - a3.y, -(a1.x - a3.x));
            x[4 * g] = make_float2(t0.x + t2.x, t0.y + t2.y); x[4 * g + 1] = make_float2(t1.x + t3.x, t1.y + t3.y);
            x[4 * g + 2] = make_float2(t0.x - t2.x, t0.y - t2.y); x[4 * g + 3] = make_float2(t1.x - t3.x, t1.y - t3.y); }
#pragma unroll
        for (int e = 0; e < 16; ++e) pb[e] = x[e]; }
    __syncthreads();
}
__device__ void fft_inv(float2* a) {
    for (int blk = opaque_tid(); blk < 1024; blk += NTHREADS) { float2* pb = a + blk * 17; float2 x[16];
#pragma unroll
        for (int e = 0; e < 16; ++e) x[e] = pb[e];
#pragma unroll
        for (int g = 0; g < 4; ++g) { const float2 a0 = x[4 * g], a1 = x[4 * g + 1], a2 = x[4 * g + 2], a3 = x[4 * g + 3];
            const float2 t0 = make_float2(a0.x + a2.x, a0.y + a2.y), t1 = make_float2(a0.x - a2.x, a0.y - a2.y), t2 = make_float2(a1.x + a3.x, a1.y + a3.y), t3 = make_float2(-(a1.y - a3.y), a1.x - a3.x);
            x[4 * g] = make_float2(t0.x + t2.x, t0.y + t2.y); x[4 * g + 1] = make_float2(t1.x + t3.x, t1.y + t3.y);
            x[4 * g + 2] = make_float2(t0.x - t2.x, t0.y - t2.y); x[4 * g + 3] = make_float2(t1.x - t3.x, t1.y - t3.y); }
#pragma unroll
        for (int j = 0; j < 4; ++j) { const float2 a0 = x[j], a1 = cmul(x[j + 4], make_float2(c16(j), s16(j))), a2 = cmul(x[j + 8], make_float2(c16(2 * j), s16(2 * j))), a3 = cmul(x[j + 12], make_float2(c16(3 * j), s16(3 * j)));
            const float2 t0 = make_float2(a0.x + a2.x, a0.y + a2.y), t1 = make_float2(a0.x - a2.x, a0.y - a2.y), t2 = make_float2(a1.x + a3.x, a1.y + a3.y), t3 = make_float2(-(a1.y - a3.y), a1.x - a3.x);
            x[j] = make_float2(t0.x + t2.x, t0.y + t2.y); x[j + 4] = make_float2(t1.x + t3.x, t1.y + t3.y);
            x[j + 8] = make_float2(t0.x - t2.x, t0.y - t2.y); x[j + 12] = make_float2(t1.x - t3.x, t1.y - t3.y); }
#pragma unroll
        for (int e = 0; e < 16; ++e) pb[e] = x[e]; }
    __syncthreads();
    for (int span = 16; span <= 4096; span <<= 2) {
        for (int b = opaque_tid(); b < 4096; b += NTHREADS) { const int j = b & (span - 1); const int base = ((b - j) << 2) + j;
            const int i0 = PADI(base), i1 = PADI(base + span), i2 = PADI(base + 2 * span), i3 = PADI(base + 3 * span);
            float sn, cs; hw_sincos((float)j / (float)(4 * span), sn, cs);
            const float2 w1 = make_float2(cs, sn), w2 = cmul(w1, w1), w3 = cmul(w2, w1);
            const float2 a0 = a[i0], a1 = cmul(a[i1], w1), a2 = cmul(a[i2], w2), a3 = cmul(a[i3], w3);
            const float2 t0 = make_float2(a0.x + a2.x, a0.y + a2.y), t1 = make_float2(a0.x - a2.x, a0.y - a2.y), t2 = make_float2(a1.x + a3.x, a1.y + a3.y);
            const float2 t3 = make_float2(-(a1.y - a3.y), a1.x - a3.x);
            a[i0] = make_float2(t0.x + t2.x, t0.y + t2.y);
            a[i1] = make_float2(t1.x + t3.x, t1.y + t3.y);
            a[i2] = make_float2(t0.x - t2.x, t0.y - t2.y);
            a[i3] = make_float2(t1.x - t3.x, t1.y - t3.y); }
        __syncthreads(); }
}
__device__ __forceinline__ float hy_val(const bf16_t* row, int t, float w0, float w1, float w2, float b) {
    const float xm = t > 0 ? bf2f(row[t - 1]) : 0.f, x0 = bf2f(row[t]), xp = t < L_TOK - 1 ? bf2f(row[t + 1]) : 0.f;
    return w0 * xm + w1 * x0 + w2 * xp + b;
}
struct HyCh { const bf16_t* ru; const bf16_t* r1; const bf16_t* r2; float wu[4], w1[4], w2[4]; };
#define HY_U(t)  hy_val(hc.ru, (t), hc.wu[0], hc.wu[1], hc.wu[2], hc.wu[3])
#define HY_X1(t) hy_val(hc.r1, (t), hc.w1[0], hc.w1[1], hc.w1[2], hc.w1[3])
#define HY_X2(t) hy_val(hc.r2, (t), hc.w2[0], hc.w2[1], hc.w2[2], hc.w2[3])

constexpr int SD_W4B = 0  , SD_GFX = 512, SD_GBX = 528, SD_VMETA = 544, SD_ZMETA = 560, SD_RED = 576  , SD_END = 704;

template <int ORDER>
__device__ void hy_conv(const Params& p, int layer, int ch, const HyCh& hc, float2* cf, float* side, unsigned char* scratch) {
    const int tid = opaque_tid(); float* cff = (float*)cf;
    f32x4* heo = (f32x4*)(scratch + HS_HEO); float* corr = (float*)(scratch + HS_CORR); const float* z2g = (const float*)(scratch + HS_Z2);
    float* g2f = (float*)(scratch + HS_G2F); float* g2b = (float*)(scratch + HS_G2B);
    if (ORDER == 0) {
        bf16_t* w4b = (bf16_t*)(side + SD_W4B);
        for (int i = tid; i < 16 * 64; i += NTHREADS) { const int n = i >> 6, k = i & 63; w4b[i] = n < 4 ? f2bf(p.f_w4[((size_t)layer * 64 + k) * 4096 + n * 1024 + ch]) : (bf16_t)0; }
        __syncthreads();
        const bf16_t* h3b = (const bf16_t*)(p.ws + OFF_H3) + (size_t)layer * L_TOK * 64;
        const int lane = tid & 63, wv = tid >> 6, col = lane & 15, quad = lane >> 4;
        const float dc = col < 4 ? fabsf(p.decay[((layer * 2 + (col >> 1)) * 2 + (col & 1)) * 1024 + ch]) : 0.f;
        const bf16x8 b0 = *(const bf16x8*)(w4b + col * 64 + quad * 8), b1 = *(const bf16x8*)(w4b + col * 64 + 32 + quad * 8);
        for (int g = wv; g < L_TOK / 16; g += 8) { const bf16_t* hr = h3b + (size_t)(g * 16 + col) * 64 + quad * 8;
            const bf16x8 a0 = *(const bf16x8*)hr, a1 = *(const bf16x8*)(hr + 32);
            f32x4 acc = (f32x4){0.f, 0.f, 0.f, 0.f};
            acc = __builtin_amdgcn_mfma_f32_16x16x32_bf16(a0, b0, acc, 0, 0, 0); acc = __builtin_amdgcn_mfma_f32_16x16x32_bf16(a1, b1, acc, 0, 0, 0);
            if (col < 4) {
#pragma unroll
                for (int r = 0; r < 4; ++r) { const int lag = g * 16 + quad * 4 + r; const float v = acc[r] * __expf(-(float)lag * (1.0f / (float)(L_TOK - 1)) * dc);
                    if (col == 0) { if (lag < NMAIN) CFF(lag) = v; else side[SD_GFX + lag - NMAIN] = v; }
                    else if (col == 1) { if (lag >= 1) { if (lag < NMAIN) CFF(32768 - lag) = v; else side[SD_GBX + lag - NMAIN] = v; } }
                    else if (col == 2) g2f[lag] = v;
                    else g2b[lag] = v; } } }
    } else {
        for (int lag = tid; lag < L_TOK; lag += NTHREADS) { const float gf = g2f[lag], gb = g2b[lag];
            if (lag < NMAIN) CFF(lag) = gf; else side[SD_GFX + lag - NMAIN] = gf;
            if (lag >= 1) { if (lag < NMAIN) CFF(32768 - lag) = gb; else side[SD_GBX + lag - NMAIN] = gb; } }
    }
    if (tid == 0) CFF(NMAIN) = 0.f;
    __syncthreads();
#define GF(l) ((l) < NMAIN ? CFF(l) : side[SD_GFX + (l) - NMAIN])
#define GB(m) ((m) < NMAIN ? CFF(32768 - (m)) : side[SD_GBX + (m) - NMAIN])
    for (int jx = tid; jx < NMAIN; jx += NTHREADS) { const int t = jx + NMETA; float a = 0.f;
#pragma unroll
        for (int s = 0; s < NMETA; ++s) { const int l = t - s; a += GF(l) * side[SD_VMETA + s]; }
        corr[jx] = a; }
    { float am[16];
#pragma unroll
      for (int t = 0; t < 16; ++t) am[t] = 0.f;
      for (int s = tid; s < L_TOK; s += NTHREADS) { const float v = (ORDER == 0) ? HY_U(s) : z2g[s];
#pragma unroll
          for (int t = 0; t < 16; ++t) { const int l = t - s; const float gv = l >= 0 ? GF(l) : GB(-l); am[t] += gv * v; } }
#pragma unroll
      for (int t = 0; t < 16; ++t) am[t] = wave_sum(am[t]);
      if ((tid & 63) == 0) {
#pragma unroll
          for (int t = 0; t < 16; ++t) side[SD_RED + (tid >> 6) * 16 + t] = am[t]; }
      __syncthreads();
      if (tid < 16) { float a = 0.f;
#pragma unroll
          for (int w = 0; w < 8; ++w) a += side[SD_RED + w * 16 + tid];
          side[SD_ZMETA + tid] = a; } }
#undef GF
#undef GB
    __syncthreads();
    fft_fwd(cf);
    for (int k = tid; k <= 8192; k += NTHREADS) { const int kp = (16384 - k) & 16383; const float2 a = cf[PADI(rev4_14(k))], bq = cf[PADI(rev4_14(kp))];
        const float bx = bq.x, by = -bq.y; const float sc = 1.0f / 16384.0f;
        heo[k] = (f32x4){0.5f * (a.x + bx) * sc, 0.5f * (a.y + by) * sc, 0.5f * (a.y - by) * sc, -0.5f * (a.x - bx) * sc}; }
    __syncthreads();
    for (int jx = tid; jx < NMAIN; jx += NTHREADS) { CFF(jx) = (ORDER == 0) ? HY_U(jx + NMETA) : z2g[jx + NMETA]; CFF(NMAIN + jx) = 0.f; }
    __syncthreads();
    fft_fwd(cf);
    for (int k = tid; k <= 8192; k += NTHREADS) { const int kp = (16384 - k) & 16383; const unsigned ik = PADI(rev4_14(k)), ikp = PADI(rev4_14(kp)); const float2 a = cf[ik], bq = cf[ikp];
        const float bx = bq.x, by = -bq.y;
        const float2 XE = make_float2(0.5f * (a.x + bx), 0.5f * (a.y + by)), XO = make_float2(0.5f * (a.y - by), -0.5f * (a.x - bx));
        const f32x4 hh = heo[k]; const float2 HE = make_float2(hh[0], hh[1]), HO = make_float2(hh[2], hh[3]);
        float sn, cs; hw_sincos((float)k / 16384.0f, sn, cs); const float2 w = make_float2(cs, -sn);
        const float2 xoho = cmul(XO, HO), wx = cmul(w, xoho), xehe = cmul(XE, HE), xeho = cmul(XE, HO), xohe = cmul(XO, HE);
        const float2 YE = make_float2(xehe.x + wx.x, xehe.y + wx.y), YO = make_float2(xeho.x + xohe.x, xeho.y + xohe.y);
        cf[ik] = make_float2(YE.x - YO.y, YE.y + YO.x); cf[ikp] = make_float2(YE.x + YO.y, -YE.y + YO.x); }
    __syncthreads();
    fft_inv(cf);
}

__device__ void hyena_unit(const Params& p, int layer, int ch, unsigned char* smem, unsigned char* scratch) {
    const int tid = opaque_tid(); float2* cf = (float2*)smem; float* cff = (float*)smem; float* side = (float*)(smem + 139264);
    const bf16_t* hyin = (const bf16_t*)(p.ws + OFF_HYIN);
    HyCh hc; hc.ru = hyin + (size_t)ch * LP; hc.r1 = hyin + (size_t)(1024 + ch) * LP; hc.r2 = hyin + (size_t)(2048 + ch) * LP;
    { const float* cw = p.conv_w + (size_t)layer * 3 * 3072; const float* cb = p.conv_b + (size_t)layer * 3072;
#pragma unroll
      for (int jj = 0; jj < 3; ++jj) { hc.wu[jj] = cw[jj * 3072 + ch]; hc.w1[jj] = cw[jj * 3072 + 1024 + ch]; hc.w2[jj] = cw[jj * 3072 + 2048 + ch]; }
      hc.wu[3] = cb[ch]; hc.w1[3] = cb[1024 + ch]; hc.w2[3] = cb[2048 + ch]; }
    const float sk0 = p.skip[(layer * 2 + 0) * 1024 + ch], sk1 = p.skip[(layer * 2 + 1) * 1024 + ch];
    float* corr = (float*)(scratch + HS_CORR); float* z2g = (float*)(scratch + HS_Z2);
    bf16_t* hyout = (bf16_t*)(p.ws + OFF_HYOUT) + (size_t)ch * LP;
    __syncthreads();
    if (tid < 16) side[SD_VMETA + tid] = HY_U(tid);
    __syncthreads();
    hy_conv<0>(p, layer, ch, hc, cf, side, scratch);
    for (int jx = tid; jx < NMAIN; jx += NTHREADS) { const int t = jx + NMETA; const float z1 = CFF(jx) + corr[jx] + sk0 * HY_U(t); z2g[t] = HY_X1(t) * z1; }
    if (tid < 16) { const float z1 = side[SD_ZMETA + tid] + sk0 * HY_U(tid); const float z2 = HY_X1(tid) * z1; z2g[tid] = z2; side[SD_VMETA + tid] = z2; }
    __syncthreads();
    hy_conv<1>(p, layer, ch, hc, cf, side, scratch);
    for (int jx = tid; jx < NMAIN; jx += NTHREADS) { const int t = jx + NMETA; const float z3 = CFF(jx) + corr[jx] + sk1 * z2g[t]; hyout[t] = f2bf(HY_X2(t) * z3); }
    if (tid < 16) { const float z3 = side[SD_ZMETA + tid] + sk1 * side[SD_VMETA + tid]; hyout[tid] = f2bf(HY_X2(tid) * z3); }
    __syncthreads();
}

__device__ void transpose_unit(const Params& p, int ct, int tt, unsigned char* smem) {
    const int tid = opaque_tid(); bf16_t* tile = (bf16_t*)smem;
    const bf16_t* hyout = (const bf16_t*)(p.ws + OFF_HYOUT); bf16_t* ya = (bf16_t*)(p.ws + OFF_GATE);
    __syncthreads();
    { const int cl = tid >> 3, t8 = (tid & 7) * 8; *(u32x4*)(tile + cl * 72 + t8) = *(const u32x4*)(hyout + (size_t)(ct * 64 + cl) * LP + tt * 64 + t8); }
    __syncthreads();
    { const int tl = tid >> 3, c8 = (tid & 7) * 8; const int t = tt * 64 + tl;
      if (t < L_TOK) { bf16_t* gp = ya + (size_t)t * 1024 + ct * 64 + c8; const u32x4 g = *(const u32x4*)gp;
          float v[8];
#pragma unroll
          for (int i = 0; i < 8; ++i) v[i] = bf2f(tile[(c8 + i) * 72 + tl]);
          u32x4 w; w.x = cvt_pk_bf16(v[0] * lo_bf(g.x), v[1] * hi_bf(g.x)); w.y = cvt_pk_bf16(v[2] * lo_bf(g.y), v[3] * hi_bf(g.y)); w.z = cvt_pk_bf16(v[4] * lo_bf(g.z), v[5] * hi_bf(g.z)); w.w = cvt_pk_bf16(v[6] * lo_bf(g.w), v[7] * hi_bf(g.w));
          *(u32x4*)gp = w; } }
}

__device__ void phase_final(const Params& p) {
    const int tid = opaque_tid(), lane = tid & 63, wv = tid >> 6; const float* h = (const float*)(p.ws + OFF_H);
    for (int l = NMETA + blockIdx.x * 8 + wv; l < L_TOK; l += gridDim.x * 8) { const f32x4* row = (const f32x4*)(h + (size_t)l * DM); f32x4 v[8]; float ss = 0.f;
#pragma unroll
        for (int i = 0; i < 8; ++i) { v[i] = row[i * 64 + lane]; ss += v[i][0] * v[i][0] + v[i][1] * v[i][1] + v[i][2] * v[i][2] + v[i][3] * v[i][3]; }
        ss = wave_sum(ss); const float inv = rsqrtf(ss * (1.0f / DM) + 1e-6f); f32x4* o = (f32x4*)(p.out + (size_t)(l - NMETA) * DM);
#pragma unroll
        for (int i = 0; i < 8; ++i) { const f32x4 gg = ((const f32x4*)p.final_g)[i * 64 + lane]; o[i * 64 + lane] = v[i] * inv * gg; } }
}

enum { OP_P1 = 0, OP_SYNC, OP_GEMM, OP_NA, OP_HYENA, OP_TRANS, OP_NOP };
__global__ void __launch_bounds__(512, 2) hybrid_fwd(Params p) {
    extern __shared__ __attribute__((aligned(16))) unsigned char smem[];
    cg::grid_group grid = cg::this_grid();
    LAS unsigned char* lds = (LAS unsigned char*)smem;
    const int bid = blockIdx.x, G = gridDim.x;
    phase_prep0(p, smem);
    constexpr int NOPS = 17;
#pragma clang loop unroll(disable)
    for (int step = 0; step < 2 * NOPS; ++step) {
        const int layer = step / NOPS, s = step - layer * NOPS;
        int op, kind = 0;
        switch (s) {
        case 0: op = OP_P1; break;
        case 2: op = OP_GEMM; kind = K_IN; break;
        case 3: case 4: op = OP_NOP; break;
        case 6: op = OP_GEMM; kind = K_FNA; break;
        case 7: op = OP_NA; break;
        case 8: op = OP_HYENA; break;
        case 10: op = OP_GEMM; kind = K_FNB; break;
        case 11: op = OP_TRANS; break;
        case 13: op = OP_GEMM; kind = K_BR; break;
        case 15: op = OP_GEMM; kind = K_OUT; break;
        default: op = OP_SYNC; break;
        }
        if (op == OP_NOP) { }
        else if (op == OP_SYNC) { grid.sync(); }
        else if (op == OP_GEMM) {
            Gemm g; g.base = (const char*)p.ws; g.jumpA = 0; g.jumpB = 0;
            switch (kind) {
            case K_FNA: g.lda = 384; g.ldb = FN1P; g.nt = 6; g.ksplit = 3; g.jumpB = (long)((size_t)1024 * PROWS * 2) - 384l; break;
            case K_FNB: g.lda = 256; g.ldb = 256; g.nt = 4; g.ksplit = 4; break;
            case K_BR:  g.lda = 1024; g.ldb = 1024; g.nt = 16; g.ksplit = 16; break;
            default:    g.lda = DM; g.ldb = DM; g.nt = 32; g.ksplit = 32; break;
            }
            SchedAny S{kind, G, bid}; EpiAny E{kind, p.ws};
            pg8::gemm_phase(lds, g, S, E);
        }
        else if (op == OP_P1) { phase_p1(p, layer, smem); }
        else if (op == OP_NA) { for (int u = bid; u < 4096; u += G) na_unit(p, layer, u >> 4, u & 15, smem); if (bid == G - 1) na_meta_unit(p, layer); }
        else if (op == OP_HYENA) { for (int ch = bid; ch < 1024; ch += G) hyena_unit(p, layer, ch, smem, (unsigned char*)p.out + (size_t)bid * HS_STRIDE); }
        else { for (int u = bid; u < 16 * 257; u += G) transpose_unit(p, u & 15, u >> 4, smem); }
    }
    phase_final(p);
}

extern "C" void kernel_launch(void* const* d_in, const int* in_sizes, int n_in, void* d_out, int out_size, void* d_ws, size_t ws_size, hipStream_t stream) {
    static int grid_blocks = 0;
    if (grid_blocks == 0) {
        if (n_in != 23 || ws_size < WS_END) { fprintf(stderr, "kernel_launch: need 23 inputs and %zu bytes of workspace (got %d, %zu)\n", (size_t)WS_END, n_in, ws_size); grid_blocks = -1; return; }
        int dev = 0, cus = 0, per_cu = 0;
        hipGetDevice(&dev); hipDeviceGetAttribute(&cus, hipDeviceAttributeMultiprocessorCount, dev);
        if (hipFuncSetAttribute((const void*)hybrid_fwd, hipFuncAttributeMaxDynamicSharedMemorySize, LDS_BYTES) != hipSuccess) { fprintf(stderr, "kernel_launch: hipFuncSetAttribute failed\n"); grid_blocks = -1; return; }
        hipOccupancyMaxActiveBlocksPerMultiprocessor(&per_cu, (const void*)hybrid_fwd, NTHREADS, LDS_BYTES);
        if (per_cu < 1) per_cu = 1;
        grid_blocks = cus * per_cu;
        if (grid_blocks > 256) grid_blocks = 256;
    }
    if (grid_blocks < 0) return;
    Params p{};
    const float** f = (const float**)&p;
    for (int i = 0; i < 23; ++i) f[i] = (const float*)d_in[i];
    p.out = (float*)d_out; p.ws = (unsigned char*)d_ws;
    void* args[] = {&p};
    hipError_t e = hipLaunchCooperativeKernel((const void*)hybrid_fwd, dim3(grid_blocks), dim3(NTHREADS), args, LDS_BYTES, stream);
    if (e != hipSuccess) fprintf(stderr, "cooperative launch failed: %s (grid %d)\n", hipGetErrorString(e), grid_blocks);
}
```

```cpp
#include <hip/hip_runtime.h>
#include <hip/hip_cooperative_groups.h>
#include <cstdio>
namespace cg = cooperative_groups;

#define LAS __attribute__((address_space(3)))
typedef unsigned short bf16_t;
typedef short bf16x8 __attribute__((ext_vector_type(8)));
typedef float f32x4 __attribute__((ext_vector_type(4)));
typedef unsigned u32x4 __attribute__((ext_vector_type(4)));
typedef unsigned u32x2 __attribute__((ext_vector_type(2)));

constexpr int L_TOK = 16400, LP = 16640, DM = 2048, NIN = 16384, NMETA = 16, NMAIN = 16384;
constexpr int FN1 = 164, FN2 = 100, FN1P = 192, PROWS = FN2 * FN1P;
constexpr int NTHREADS = 512, LDS_BYTES = 155648;

constexpr size_t SZ_H = (size_t)LP * DM * 4, SZ_XN = (size_t)LP * DM * 2, SZ_XNP = (size_t)PROWS * DM * 2;
constexpr size_t OFF_H = 0;
constexpr size_t OFF_XN = OFF_H + SZ_H;
constexpr size_t OFF_XNP = OFF_XN + SZ_XN;
constexpr size_t OFF_A1 = OFF_XN;
constexpr size_t SZ_A1 = (size_t)FN1 * 1024 * 2 * 128 * 2;
constexpr size_t OFF_HYOUT = OFF_A1 + SZ_A1;
constexpr size_t SZ_HYOUT = (size_t)1024 * LP * 2;
static_assert(OFF_HYOUT + SZ_HYOUT <= OFF_XNP + SZ_XNP, "alias overflow");
constexpr size_t OFF_WT = OFF_XNP + SZ_XNP;
constexpr size_t OFF_WEFF = OFF_WT + (size_t)NIN * DM * 2;
constexpr size_t OFF_WA = OFF_WEFF + (size_t)2048 * 2048 * 2;
constexpr size_t SZ_WBR = (size_t)2048 * 1024 * 2;
constexpr size_t OFF_WO = OFF_WA + 3 * SZ_WBR;
constexpr size_t OFF_HYIN = OFF_WO + (size_t)2048 * 2048 * 2;
constexpr size_t OFF_GATE = OFF_HYIN + (size_t)3072 * LP * 2;
constexpr size_t SZ_GATE = (size_t)LP * 1024 * 2;
constexpr size_t OFF_QKV = OFF_GATE + 3 * SZ_GATE;
constexpr size_t OFF_MERGE = OFF_QKV + (size_t)LP * 3072 * 2;
constexpr size_t OFF_ZT = OFF_MERGE + (size_t)LP * 6144 * 2;
constexpr size_t SZ_ZT = (size_t)2048 * PROWS * 2;
constexpr size_t OFF_M = OFF_ZT;
static_assert(SZ_XN <= SZ_ZT, "alias overflow");
constexpr size_t OFF_FA = OFF_ZT + SZ_ZT;
constexpr size_t OFF_FB = OFF_FA + (size_t)512 * 384 * 2;
constexpr size_t OFF_H3 = OFF_FB + (size_t)FN1 * 256 * 256 * 2;
constexpr size_t WS_END = OFF_H3 + (size_t)2 * L_TOK * 64 * 4;
constexpr size_t HS_HEO = 0, HS_CORR = 131328, HS_Z2 = HS_CORR + 65536, HS_G2F = HS_Z2 + 65792, HS_G2B = HS_G2F + 65792, HS_STRIDE = HS_G2B + 65792;
static_assert(HS_STRIDE * 256 <= (size_t)NMAIN * DM * 4, "scratch overflow");

struct Params {
    const float* x; const float* meta; const float* norm_g; const float* w_in; const float* conv_w; const float* conv_b;
    const float* f_w1; const float* f_b1; const float* f_w2; const float* f_b2; const float* f_w3; const float* f_b3; const float* f_w4;
    const float* f_freq; const float* decay; const float* skip; const float* rpb; const float* meta_bias;
    const float* w_a; const float* w_b; const float* w_c; const float* w_out; const float* final_g;
    float* out; unsigned char* ws;
};

__device__ __forceinline__ int opaque_tid() { int t = threadIdx.x; asm volatile("" : "+v"(t)); return t; }
__device__ __forceinline__ float bf2f(bf16_t b) { return __uint_as_float(((unsigned)b) << 16); }
__device__ __forceinline__ bf16_t f2bf(float f) { unsigned u = __float_as_uint(f); u += 0x7FFFu + ((u >> 16) & 1u); return (bf16_t)(u >> 16); }
__device__ __forceinline__ unsigned cvt_pk_bf16(float lo, float hi) { unsigned r; asm volatile("v_cvt_pk_bf16_f32 %0, %1, %2" : "=v"(r) : "v"(lo), "v"(hi)); return r; }
__device__ __forceinline__ float lo_bf(unsigned u) { return __uint_as_float(u << 16); }
__device__ __forceinline__ float hi_bf(unsigned u) { return __uint_as_float(u & 0xffff0000u); }
__device__ __forceinline__ float silu_f(float v) { return v / (1.0f + __expf(-v)); }
__device__ __forceinline__ float sigm_f(float v) { return 1.0f / (1.0f + __expf(-v)); }
__device__ __forceinline__ float wave_sum(float v) {
#pragma unroll
    for (int o = 32; o >= 1; o >>= 1) v += __shfl_xor(v, o);
    return v;
}

namespace pg8 {
constexpr int BM = 256, BK = 64, HALF = 128, HTB = HALF * BK * 2, STAGE_BYTES = 8 * HTB;
__device__ __forceinline__ int lds_byte(int r, int c) { const int st = (r >> 4) * 2 + (c >> 5), rr = r & 15, cc = c & 31, ob = rr * 64 + cc * 2; return st * 1024 + (ob ^ (((ob >> 9) & 1) << 5)); }
__device__ __forceinline__ void stage_rc(int b, int& R, int& C) { const int st = b / 1024, sb = b % 1024, swz = sb ^ (((sb >> 9) & 1) << 5); R = (st >> 1) * 16 + swz / 64; C = (st & 1) * 32 + (swz % 64) / 2; }
__device__ __forceinline__ int perm32(int rho) { const int n = rho >> 4, i = rho & 15; return 8 * (i >> 2) + 4 * n + (i & 3); }

struct Unit { int pm, pn, aux; size_t offA, offB; };
struct Gemm { const char* base; int lda, ldb, nt, ksplit; long jumpA, jumpB; };

__device__ __forceinline__ void tile_map(int wgid, int nM, int nN, int& pm, int& pn) {
    const int nwg = nM * nN;
    { const int q = nwg / 8, r = nwg % 8, xcd = wgid % 8, off = wgid / 8; wgid = (xcd < r ? xcd * (q + 1) : r * (q + 1) + (xcd - r) * q) + off; }
    const int nig = 8 * nN, gid = wgid / nig, fm = gid * 8, gsz = (nM - fm) < 8 ? (nM - fm) : 8;
    pm = fm + ((wgid % nig) % gsz); pn = (wgid % nig) / gsz;
}

template <class Epi, class Sched>
__device__ __forceinline__ void gemm_phase(LAS unsigned char* lds, const Gemm g, const Sched& S, const Epi& E) {
    const int tid = opaque_tid(), wid = __builtin_amdgcn_readfirstlane(tid >> 6), lane = tid & 63, wr = wid >> 2, wc = wid & 3, fr = lane & 15, fq = lane >> 4;
    const int nt = g.nt;
    unsigned voffA[2], voffB[2];
#pragma unroll
    for (int i = 0; i < 2; ++i) { int R, C; stage_rc(tid * 16 + i * 8192, R, C); const int Rb = (R & ~31) + perm32(R & 31);
        voffA[i] = (unsigned)(R * g.lda + C) * 2u; voffB[i] = (unsigned)(Rb * g.ldb + C) * 2u; }
    const size_t kstep = (size_t)(BK * 2);
    const size_t hstepA = (size_t)HALF * g.lda * 2, hstepB = (size_t)HALF * g.ldb * 2;
    const unsigned ldsw = (unsigned)wid * 1024u;
    const int aoff = lds_byte(wr * 64 + fr, fq * 8), boff = lds_byte(wc * 32 + fr, fq * 8);
#define PG8_KA(p, t) ((p) + (size_t)(t) * kstep + ((t) >= g.ksplit ? g.jumpA : 0l))
#define PG8_KB(p, t) ((p) + (size_t)(t) * kstep + ((t) >= g.ksplit ? g.jumpB : 0l))
#define PG8_SA(b, h) (((b) * 2 + (h)) * HTB)
#define PG8_SB(b, h) ((4 + (b) * 2 + (h)) * HTB)
#define PG8_STAGE(bufoff, gbase, voff) do { _Pragma("unroll") for (int _i = 0; _i < 2; ++_i) \
        __builtin_amdgcn_global_load_lds((const unsigned*)((const char*)(gbase) + (voff)[_i]), (LAS unsigned*)(lds + (bufoff) + ldsw + _i * 8192), 16, 0, 0); } while (0)
#define PG8_LDA(dst, b, h) do { _Pragma("unroll") for (int m = 0; m < 4; ++m) _Pragma("unroll") for (int k = 0; k < 2; ++k) dst[m][k] = *(const LAS bf16x8*)(lds + PG8_SA(b, h) + aoff + m * 2048 + k * 1024); } while (0)
#define PG8_LDB(dst, b, h) do { _Pragma("unroll") for (int n = 0; n < 2; ++n) _Pragma("unroll") for (int k = 0; k < 2; ++k) dst[n][k] = *(const LAS bf16x8*)(lds + PG8_SB(b, h) + boff + n * 2048 + k * 1024); } while (0)
#define PG8_MMA(ai, bj, At, Bt) do { __builtin_amdgcn_s_setprio(1); _Pragma("unroll") for (int m = 0; m < 4; ++m) _Pragma("unroll") for (int n = 0; n < 2; ++n) _Pragma("unroll") for (int k = 0; k < 2; ++k) \
        acc[ai][bj][m][n] = __builtin_amdgcn_mfma_f32_16x16x32_bf16(Bt[n][k], At[m][k], acc[ai][bj][m][n], 0, 0, 0); __builtin_amdgcn_s_setprio(0); } while (0)
#define PG8_WAIT_V(n) asm volatile("s_waitcnt vmcnt(" #n ")" ::: "memory")
#define PG8_WAIT_L(n) asm volatile("s_waitcnt lgkmcnt(" #n ")" ::: "memory")
#define PG8_BAR __builtin_amdgcn_s_barrier()
#define PG8_SCHED __builtin_amdgcn_sched_barrier(0)
    Unit cur, nxt; int ui = 0;
    if (!S.next(0, cur)) return;
    f32x4 acc[2][2][4][2];
#pragma unroll
    for (int a = 0; a < 2; ++a)
#pragma unroll
        for (int b = 0; b < 2; ++b)
#pragma unroll
            for (int m = 0; m < 4; ++m)
#pragma unroll
                for (int n = 0; n < 2; ++n) acc[a][b][m][n] = (f32x4){0.f, 0.f, 0.f, 0.f};
    bf16x8 At[4][2], B0[2][2], B1[2][2];
    const char* cA = g.base + cur.offA; const char* cB = g.base + cur.offB;
    PG8_STAGE(PG8_SB(0, 0), cB, voffB); PG8_STAGE(PG8_SA(0, 0), cA, voffA); PG8_STAGE(PG8_SB(0, 1), cB + hstepB, voffB); PG8_STAGE(PG8_SA(0, 1), cA + hstepA, voffA);
    if (wr == 1) PG8_BAR;
    PG8_WAIT_V(4); PG8_BAR;
    PG8_STAGE(PG8_SB(1, 0), PG8_KB(cB, 1), voffB); PG8_STAGE(PG8_SA(1, 0), PG8_KA(cA, 1), voffA); PG8_STAGE(PG8_SB(1, 1), PG8_KB(cB, 1) + hstepB, voffB);
    PG8_WAIT_V(6); PG8_BAR;
    for (;;) {
        const bool has_next = S.next(ui + 1, nxt);
        const char* nA = has_next ? g.base + nxt.offA : cA; const char* nB = has_next ? g.base + nxt.offB : cB;
        for (int t = 0; t < nt; t += 2) {
            const bool last = (t == nt - 2);
            const char* a1 = PG8_KA(cA, t + 1);
            const char* a2 = last ? nA : PG8_KA(cA, t + 2); const char* b2 = last ? nB : PG8_KB(cB, t + 2);
            const char* a3 = last ? PG8_KA(nA, 1) : PG8_KA(cA, t + 3); const char* b3 = last ? PG8_KB(nB, 1) : PG8_KB(cB, t + 3);
            PG8_LDB(B0, 0, 0); PG8_SCHED; PG8_LDA(At, 0, 0); PG8_STAGE(PG8_SA(1, 1), a1 + hstepA, voffA);
            PG8_WAIT_L(8); PG8_BAR; PG8_WAIT_L(0); PG8_MMA(0, 0, At, B0); PG8_BAR; PG8_SCHED;
            PG8_LDB(B1, 0, 1); PG8_STAGE(PG8_SB(0, 0), b2, voffB);
            PG8_BAR; PG8_WAIT_L(0); PG8_MMA(0, 1, At, B1); PG8_BAR;
            PG8_LDA(At, 0, 1); PG8_STAGE(PG8_SA(0, 0), a2, voffA);
            PG8_BAR; PG8_WAIT_L(0); PG8_MMA(1, 0, At, B0); PG8_BAR; PG8_SCHED;
            PG8_STAGE(PG8_SB(0, 1), b2 + hstepB, voffB);
            PG8_WAIT_V(6); PG8_BAR; PG8_MMA(1, 1, At, B1); PG8_BAR;
            PG8_LDB(B0, 1, 0); PG8_SCHED; PG8_LDA(At, 1, 0); PG8_STAGE(PG8_SA(0, 1), a2 + hstepA, voffA);
            PG8_WAIT_L(8); PG8_BAR; PG8_WAIT_L(0); PG8_MMA(0, 0, At, B0); PG8_BAR; PG8_SCHED;
            PG8_LDB(B1, 1, 1); PG8_STAGE(PG8_SB(1, 0), b3, voffB);
            PG8_BAR; PG8_WAIT_L(0); PG8_MMA(0, 1, At, B1); PG8_BAR;
            PG8_LDA(At, 1, 1); PG8_STAGE(PG8_SA(1, 0), a3, voffA);
            PG8_BAR; PG8_WAIT_L(0); PG8_MMA(1, 0, At, B0); PG8_BAR; PG8_SCHED;
            PG8_STAGE(PG8_SB(1, 1), b3 + hstepB, voffB);
            PG8_WAIT_V(6); PG8_BAR; PG8_MMA(1, 1, At, B1); PG8_BAR;
        }
        E(acc, cur, wr, wc, fr, fq);
        if (!has_next) break;
#pragma unroll
        for (int a = 0; a < 2; ++a)
#pragma unroll
            for (int b = 0; b < 2; ++b)
#pragma unroll
                for (int m = 0; m < 4; ++m)
#pragma unroll
                    for (int n = 0; n < 2; ++n) acc[a][b][m][n] = (f32x4){0.f, 0.f, 0.f, 0.f};
        cur = nxt; cA = nA; cB = nB; ++ui;
    }
    PG8_WAIT_V(0);
    if (wr == 0) PG8_BAR;
    PG8_BAR;
#undef PG8_KA
#undef PG8_KB
#undef PG8_SA
#undef PG8_SB
#undef PG8_STAGE
#undef PG8_LDA
#undef PG8_LDB
#undef PG8_MMA
#undef PG8_WAIT_V
#undef PG8_WAIT_L
#undef PG8_BAR
#undef PG8_SCHED
}
}
using pg8::Unit; using pg8::Gemm;
#define ACC_T const f32x4 (&acc)[2][2][4][2]

enum { K_TOK = 0, K_HYIN = 1, K_F0 = 2, K_FNA = 3, K_FNB = 4, K_BR = 5, K_OUT = 6, K_IN = 7 };
struct SchedAny {
    int kind, G, c;
    __device__ __forceinline__ bool next(int i, Unit& u) const {
        const long Lx = (long)i * G + c;
        switch (kind) {
        case K_IN: {
            if (Lx < 3120) { int pn; pg8::tile_map((int)Lx, 65, 48, u.pm, pn); u.pn = pn < 4 ? 12 + pn : 16 + pn; u.aux = K_TOK;
                u.offA = OFF_XN + (size_t)u.pm * 256 * DM * 2; u.offB = OFF_WT + (size_t)u.pn * 256 * DM * 2; return true; }
            if (Lx < 3900) { pg8::tile_map((int)Lx - 3120, 12, 65, u.pm, u.pn); u.aux = K_HYIN;
                u.offA = OFF_WT + (size_t)u.pm * 256 * DM * 2; u.offB = OFF_XN + (size_t)u.pn * 256 * DM * 2; return true; }
            if (Lx < 4500) { pg8::tile_map((int)Lx - 3900, 8, 75, u.pm, u.pn); u.aux = K_F0;
                u.offA = OFF_WEFF + (size_t)u.pm * 256 * DM * 2; u.offB = OFF_XNP + (size_t)u.pn * 256 * DM * 2; return true; }
            return false; }
        case K_TOK: {
            if (Lx >= 65l * 48) return false; int pn; pg8::tile_map((int)Lx, 65, 48, u.pm, pn); u.pn = pn < 4 ? 12 + pn : 16 + pn; u.aux = 0;
            u.offA = OFF_XN + (size_t)u.pm * 256 * DM * 2; u.offB = OFF_WT + (size_t)u.pn * 256 * DM * 2; return true; }
        case K_HYIN: {
            if (Lx >= 12l * 65) return false; pg8::tile_map((int)Lx, 12, 65, u.pm, u.pn); u.aux = 0;
            u.offA = OFF_WT + (size_t)u.pm * 256 * DM * 2; u.offB = OFF_XN + (size_t)u.pn * 256 * DM * 2; return true; }
        case K_F0: {
            if (Lx >= 8l * 75) return false; pg8::tile_map((int)Lx, 8, 75, u.pm, u.pn); u.aux = 0;
            u.offA = OFF_WEFF + (size_t)u.pm * 256 * DM * 2; u.offB = OFF_XNP + (size_t)u.pn * 256 * DM * 2; return true; }
        case K_FNA: {
            if (Lx >= 2l * 400) return false; pg8::tile_map((int)Lx, 2, 400, u.pm, u.pn); u.aux = 0;
            u.offA = OFF_FA + (size_t)u.pm * 256 * 384 * 2; u.offB = OFF_ZT + (size_t)u.pn * 256 * FN1P * 2; return true; }
        case K_FNB: {
            if (Lx >= 164l * 4) return false; u.aux = (int)(Lx >> 2); u.pm = 0; u.pn = (int)(Lx & 3);
            u.offA = OFF_FB + (size_t)u.aux * 256 * 256 * 2; u.offB = OFF_A1 + (size_t)u.aux * 1024 * 256 * 2 + (size_t)u.pn * 256 * 256 * 2; return true; }
        case K_BR: {
            const int T = (i / 3) * G + c; if (T >= 65 * 8) return false; const int br = i % 3; pg8::tile_map(T, 65, 8, u.pm, u.pn); u.aux = br;
            u.offA = OFF_GATE + (size_t)br * SZ_GATE + (size_t)u.pm * 256 * 1024 * 2; u.offB = OFF_WA + (size_t)br * SZ_WBR + (size_t)u.pn * 256 * 1024 * 2; return true; }
        default: {
            if (Lx >= 65l * 8) return false; pg8::tile_map((int)Lx, 65, 8, u.pm, u.pn); u.aux = 0;
            u.offA = OFF_M + (size_t)u.pm * 256 * DM * 2; u.offB = OFF_WO + (size_t)u.pn * 256 * DM * 2; return true; }
        }
    }
};
#define ROWFENCE asm volatile("" ::: "memory")
#define HARDFENCE do { asm volatile("" ::: "memory"); __builtin_amdgcn_sched_barrier(0); } while (0)
struct EpiAny {
    int kind; unsigned char* ws;
    __device__ __forceinline__ void operator()(ACC_T, const Unit& u, int wr, int wc, int fr, int fq) const {
        const int rl0 = wr * 64 + fr, cl0 = wc * 32 + 8 * fq;
        const int ek = kind == K_IN ? u.aux : kind;
        if (ek == K_TOK) {
            const int t = u.pn; unsigned char* dst; unsigned ld; int c0, act;
            if (t < 16)      { dst = ws + OFF_GATE;               ld = 1024; c0 = (t - 12) * 256; act = 1; }
            else if (t < 24) { dst = ws + OFF_GATE + SZ_GATE;     ld = 1024; c0 = (t - 20) * 256; act = 1; }
            else if (t < 36) { dst = ws + OFF_QKV;                ld = 3072; c0 = (t - 24) * 256; act = 0; }
            else if (t < 40) { dst = ws + OFF_GATE + 2 * SZ_GATE; ld = 1024; c0 = (t - 36) * 256; act = 1; }
            else             { dst = ws + OFF_MERGE;              ld = 6144; c0 = (t - 40) * 256; act = 2; }
#pragma unroll
            for (int ai = 0; ai < 2; ++ai)
#pragma unroll
                for (int m = 0; m < 4; ++m) { const unsigned row = (unsigned)(u.pm * 256 + ai * 128 + m * 16 + rl0);
#pragma unroll
                    for (int bj = 0; bj < 2; ++bj) { const unsigned off = (row * ld + (unsigned)(c0 + bj * 128 + cl0)) * 2u; f32x4 v0 = acc[ai][bj][m][0], v1 = acc[ai][bj][m][1];
                        if (act == 1) {
#pragma unroll
                            for (int j = 0; j < 4; ++j) { v0[j] = silu_f(v0[j]); v1[j] = silu_f(v1[j]); } }
                        else if (act == 2) {
#pragma unroll
                            for (int j = 0; j < 4; ++j) { v0[j] = sigm_f(v0[j]); v1[j] = sigm_f(v1[j]); } }
                        u32x4 w; w.x = cvt_pk_bf16(v0[0], v0[1]); w.y = cvt_pk_bf16(v0[2], v0[3]); w.z = cvt_pk_bf16(v1[0], v1[1]); w.w = cvt_pk_bf16(v1[2], v1[3]);
                        *(u32x4*)(dst + off) = w; }
                    ROWFENCE; }
        } else if (ek == K_HYIN || ek == K_F0) {
            unsigned char* dst = ws + (ek == K_HYIN ? OFF_HYIN : OFF_ZT); const unsigned ld = ek == K_HYIN ? LP : PROWS;
#pragma unroll
            for (int ai = 0; ai < 2; ++ai)
#pragma unroll
                for (int m = 0; m < 4; ++m) { const unsigned row = (unsigned)(u.pm * 256 + ai * 128 + m * 16 + rl0);
#pragma unroll
                    for (int bj = 0; bj < 2; ++bj) { const unsigned off = (row * ld + (unsigned)(u.pn * 256 + bj * 128 + cl0)) * 2u; const f32x4 v0 = acc[ai][bj][m][0], v1 = acc[ai][bj][m][1];
                        u32x4 w; w.x = cvt_pk_bf16(v0[0], v0[1]); w.y = cvt_pk_bf16(v0[2], v0[3]); w.z = cvt_pk_bf16(v1[0], v1[1]); w.w = cvt_pk_bf16(v1[2], v1[3]);
                        *(u32x4*)(dst + off) = w; }
                    ROWFENCE; }
        } else if (ek == K_FNA) {
            unsigned char* dst = ws + OFF_A1;
#pragma unroll
            for (int ai = 0; ai < 2; ++ai)
#pragma unroll
                for (int m = 0; m < 4; ++m) { const int k1 = ai * 128 + m * 16 + rl0;
                    if (k1 < FN1) {
#pragma unroll
                        for (int bj = 0; bj < 2; ++bj)
#pragma unroll
                            for (int n = 0; n < 2; ++n) { const int col = u.pn * 256 + bj * 128 + cl0 + 4 * n; const int ch = col / FN2, l2 = col - ch * FN2; const f32x4 v = acc[ai][bj][m][n];
                                u32x2 w; w.x = cvt_pk_bf16(v[0], v[1]); w.y = cvt_pk_bf16(v[2], v[3]);
                                *(u32x2*)(dst + ((unsigned)((k1 * 1024 + ch) * 2 + u.pm) * 128u + (unsigned)l2) * 2u) = w; } }
                    ROWFENCE; }
        } else if (ek == K_FNB) {
            unsigned char* dst = ws + OFF_GATE + SZ_GATE; const float scale = 1.0f / sqrtf((float)L_TOK * 256.0f);
#pragma unroll
            for (int ai = 0; ai < 2; ++ai)
#pragma unroll
                for (int m = 0; m < 4; ++m) { const int k2 = ai * 128 + m * 16 + rl0;
                    if (k2 < FN2) { const unsigned row = (unsigned)(u.aux + FN1 * k2);
#pragma unroll
                        for (int bj = 0; bj < 2; ++bj) { const unsigned off = (row * 1024u + (unsigned)(u.pn * 256 + bj * 128 + cl0)) * 2u; const u32x4 g = *(const u32x4*)(dst + off);
                            const f32x4 v0 = acc[ai][bj][m][0] * scale, v1 = acc[ai][bj][m][1] * scale;
                            u32x4 w; w.x = cvt_pk_bf16(v0[0] * lo_bf(g.x), v0[1] * hi_bf(g.x)); w.y = cvt_pk_bf16(v0[2] * lo_bf(g.y), v0[3] * hi_bf(g.y));
                            w.z = cvt_pk_bf16(v1[0] * lo_bf(g.z), v1[1] * hi_bf(g.z)); w.w = cvt_pk_bf16(v1[2] * lo_bf(g.w), v1[3] * hi_bf(g.w));
                            *(u32x4*)(dst + off) = w; } }
                    ROWFENCE; }
        } else if (ek == K_BR) {
            unsigned char* dst = ws + OFF_M; const unsigned char* mg = ws + OFF_MERGE; const int br = u.aux;
#pragma unroll
            for (int ai = 0; ai < 2; ++ai)
#pragma unroll
                for (int m = 0; m < 4; ++m) { const unsigned row = (unsigned)(u.pm * 256 + ai * 128 + m * 16 + rl0);
#pragma unroll
                    for (int bj = 0; bj < 2; ++bj) { const unsigned col = (unsigned)(u.pn * 256 + bj * 128 + cl0); const unsigned off = (row * (unsigned)DM + col) * 2u;
                        const u32x4 g = *(const u32x4*)(mg + (row * 6144u + (unsigned)br * 2048u + col) * 2u); const f32x4 v0 = acc[ai][bj][m][0], v1 = acc[ai][bj][m][1];
                        float r0 = v0[0] * lo_bf(g.x), r1 = v0[1] * hi_bf(g.x), r2 = v0[2] * lo_bf(g.y), r3 = v0[3] * hi_bf(g.y), r4 = v1[0] * lo_bf(g.z), r5 = v1[1] * hi_bf(g.z), r6 = v1[2] * lo_bf(g.w), r7 = v1[3] * hi_bf(g.w);
                        if (br > 0) { const u32x4 o = *(const u32x4*)(dst + off); r0 += lo_bf(o.x); r1 += hi_bf(o.x); r2 += lo_bf(o.y); r3 += hi_bf(o.y); r4 += lo_bf(o.z); r5 += hi_bf(o.z); r6 += lo_bf(o.w); r7 += hi_bf(o.w); }
                        u32x4 w; w.x = cvt_pk_bf16(r0, r1); w.y = cvt_pk_bf16(r2, r3); w.z = cvt_pk_bf16(r4, r5); w.w = cvt_pk_bf16(r6, r7);
                        *(u32x4*)(dst + off) = w; }
                    ROWFENCE; }
        } else {
            unsigned char* dst = ws + OFF_H;
#pragma unroll
            for (int ai = 0; ai < 2; ++ai)
#pragma unroll
                for (int m = 0; m < 4; ++m) { const unsigned row = (unsigned)(u.pm * 256 + ai * 128 + m * 16 + rl0);
#pragma unroll
                    for (int bj = 0; bj < 2; ++bj) { const unsigned off = (row * (unsigned)DM + (unsigned)(u.pn * 256 + bj * 128 + cl0)) * 4u;
                        const f32x4 o0 = *(const f32x4*)(dst + off), o1 = *(const f32x4*)(dst + off + 16);
                        *(f32x4*)(dst + off) = o0 + acc[ai][bj][m][0]; *(f32x4*)(dst + off + 16) = o1 + acc[ai][bj][m][1]; }
                    ROWFENCE; }
        }
    }
};

__device__ void phase_prep0(const Params& p, unsigned char* smem) {
    const int tid = opaque_tid(), bid = blockIdx.x, G = gridDim.x;
    const size_t gtid = (size_t)bid * NTHREADS + tid, gstride = (size_t)G * NTHREADS;
    { f32x4* h4 = (f32x4*)(p.ws + OFF_H); const f32x4* x4 = (const f32x4*)p.x; const f32x4* m4 = (const f32x4*)p.meta;
      for (size_t i = gtid; i < (size_t)LP * 512; i += gstride) { const size_t row = i >> 9; f32x4 v = (f32x4){0.f, 0.f, 0.f, 0.f};
          if (row < NMETA) v = m4[i]; else if (row < L_TOK) v = x4[i - (size_t)NMETA * 512]; h4[i] = v; } }
    { bf16_t* fa = (bf16_t*)(p.ws + OFF_FA);
      for (size_t i = gtid; i < (size_t)512 * 384; i += gstride) { const int row = (int)(i / 384), col = (int)(i % 384); const int po = row >> 8, k1 = row & 255, pi = col / 192, l1 = col % 192; float v = 0.f;
          if (k1 < FN1 && l1 < FN1) { const int r = (k1 * l1) % FN1; const float a = 2.0f * (float)r / (float)FN1; const float cs = cospif(a), sn = sinpif(a);
              v = (po == 0) ? (pi == 0 ? cs : sn) : (pi == 0 ? -sn : cs); }
          fa[i] = f2bf(v); } }
    { bf16_t* fb = (bf16_t*)(p.ws + OFF_FB);
      for (size_t i = gtid; i < (size_t)FN1 * 65536; i += gstride) { const int k1 = (int)(i >> 16), k2 = (int)((i >> 8) & 255), kk = (int)(i & 255), part = kk >> 7, l2 = kk & 127; float v = 0.f;
          if (k2 < FN2 && l2 < FN2) { const int lp = k1 + FN1 * k2; const int r = (l2 * lp) % L_TOK; const float a = 2.0f * (float)r / (float)L_TOK; v = part == 0 ? cospif(a) : sinpif(a); }
          fb[i] = f2bf(v); } }
    { float* w1s = (float*)smem;
      float* w2s = w1s + 33 * 64;
      float* w3s = w2s + 64 * 64;
      const int lane = tid & 63, wv = tid >> 6;
      for (int layer = 0; layer < 2; ++layer) {
          __syncthreads();
          for (int i = tid; i < 33 * 64; i += NTHREADS) w1s[i] = p.f_w1[layer * 33 * 64 + i];
          for (int i = tid; i < 64 * 64; i += NTHREADS) { w2s[i] = p.f_w2[layer * 4096 + i]; w3s[i] = p.f_w3[layer * 4096 + i]; }
          __syncthreads();
          const float b1 = p.f_b1[layer * 64 + lane], b2 = p.f_b2[layer * 64 + lane], b3 = p.f_b3[layer * 64 + lane], fr = p.f_freq[layer * 64 + lane];
          bf16_t* h3 = (bf16_t*)(p.ws + OFF_H3) + (size_t)layer * L_TOK * 64;
          for (int lag = bid * 8 + wv; lag < L_TOK; lag += G * 8) {
              const float tt = (float)lag / (float)(L_TOK - 1); const float w = 6.283185307179586f * (float)lag / (float)L_TOK;
              float z = 0.f;
              if (lane == 0) z = tt;
              else if (lane < 33) { const int j = (lane - 1) & 15; const float f = 1e-4f + (float)j * ((15.0f - 1e-4f) / 15.0f); const float a = f * w; z = lane < 17 ? cosf(a) : -sinf(a); }
              float a1 = b1;
#pragma unroll 3
              for (int i = 0; i < 33; ++i) a1 += __shfl(z, i) * w1s[i * 64 + lane];
              const float h1 = sinf(fr * a1);
              float a2 = b2;
#pragma unroll 8
              for (int i = 0; i < 64; ++i) a2 += __shfl(h1, i) * w2s[i * 64 + lane];
              const float h2 = sinf(fr * a2);
              float a3 = b3;
#pragma unroll 8
              for (int i = 0; i < 64; ++i) a3 += __shfl(h2, i) * w3s[i * 64 + lane];
              h3[(size_t)lag * 64 + lane] = f2bf(sinf(fr * a3));
          }
      }
      __syncthreads(); }
}

__device__ __forceinline__ void convert_tile(const float* src, int K, int N, bf16_t* dst, int kt, int nt_, float* tile  ) {
    const int tid = opaque_tid();
    __syncthreads();
#pragma unroll
    for (int ps = 0; ps < 2; ++ps) { const int kl = ps * 32 + (tid >> 4), n4 = (tid & 15) * 4;
        const f32x4 v = *(const f32x4*)(src + (size_t)(kt * 64 + kl) * N + nt_ * 64 + n4);
        tile[kl * 65 + n4] = v[0]; tile[kl * 65 + n4 + 1] = v[1]; tile[kl * 65 + n4 + 2] = v[2]; tile[kl * 65 + n4 + 3] = v[3]; }
    __syncthreads();
    const int nl = tid >> 3, k8 = (tid & 7) * 8;
    u32x4 w; w.x = cvt_pk_bf16(tile[(k8 + 0) * 65 + nl], tile[(k8 + 1) * 65 + nl]); w.y = cvt_pk_bf16(tile[(k8 + 2) * 65 + nl], tile[(k8 + 3) * 65 + nl]);
    w.z = cvt_pk_bf16(tile[(k8 + 4) * 65 + nl], tile[(k8 + 5) * 65 + nl]); w.w = cvt_pk_bf16(tile[(k8 + 6) * 65 + nl], tile[(k8 + 7) * 65 + nl]);
    *(u32x4*)(dst + (size_t)(nt_ * 64 + nl) * K + kt * 64 + k8) = w;
}

__device__ void phase_p1(const Params& p, int layer, unsigned char* smem) {
    const int tid = opaque_tid(), bid = blockIdx.x, G = gridDim.x;
    float* tile = (float*)smem;
    { const float* win = p.w_in + (size_t)layer * DM * NIN;
      for (int t = bid; t < 32 * 256; t += G) convert_tile(win, DM, NIN, (bf16_t*)(p.ws + OFF_WT), t & 31, t >> 5, tile);
      for (int br = 0; br < 3; ++br) { const float* wsrc = (br == 0 ? p.w_a : br == 1 ? p.w_b : p.w_c) + (size_t)layer * 1024 * DM;
          for (int t = bid; t < 16 * 32; t += G) convert_tile(wsrc, 1024, DM, (bf16_t*)(p.ws + OFF_WA + br * SZ_WBR), t & 15, t >> 4, tile); }
      const float* wo = p.w_out + (size_t)layer * DM * DM;
      for (int t = bid; t < 32 * 32; t += G) convert_tile(wo, DM, DM, (bf16_t*)(p.ws + OFF_WO), t & 31, t >> 5, tile);
      __syncthreads(); }
    { float* tileT = (float*)smem;
      float* ctab = tileT + 256 * 32;
      float* stab = ctab + 256;
      const float* win = p.w_in + (size_t)layer * DM * NIN;
      for (int t = bid; t < 256; t += G) { const int g = t >> 6, k0 = (t & 63) * 32;
          __syncthreads();
          if (tid < 256) { const float a = 2.0f * (float)tid / 256.0f; ctab[tid] = cospif(a); stab[tid] = sinpif(a); }
#pragma unroll
          for (int ps = 0; ps < 4; ++ps) { const int idx = ps * NTHREADS + tid; const int kl = idx >> 6, c4 = (idx & 63) * 4;
              const f32x4 v = *(const f32x4*)(win + (size_t)(k0 + kl) * NIN + 4096 + g * 256 + c4);
              tileT[(c4 + 0) * 32 + kl] = v[0]; tileT[(c4 + 1) * 32 + kl] = v[1]; tileT[(c4 + 2) * 32 + kl] = v[2]; tileT[(c4 + 3) * 32 + kl] = v[3]; }
          __syncthreads();
          const int cp = tid & 255, part = tid >> 8;
          float acc[32];
#pragma unroll
          for (int k = 0; k < 32; ++k) acc[k] = 0.f;
          for (int c = 0; c < 256; ++c) { const int r = (c * cp) & 255; const float tw = part == 0 ? ctab[r] : -stab[r];
#pragma unroll
              for (int k4 = 0; k4 < 8; ++k4) { const f32x4 v = *(const f32x4*)(tileT + c * 32 + k4 * 4); acc[k4 * 4 + 0] += v[0] * tw; acc[k4 * 4 + 1] += v[1] * tw; acc[k4 * 4 + 2] += v[2] * tw; acc[k4 * 4 + 3] += v[3] * tw; } }
          bf16_t* dst = (bf16_t*)(p.ws + OFF_WEFF) + (size_t)(part * 1024 + g * 256 + cp) * DM + k0;
#pragma unroll
          for (int k8 = 0; k8 < 4; ++k8) { u32x4 w; w.x = cvt_pk_bf16(acc[k8 * 8 + 0], acc[k8 * 8 + 1]); w.y = cvt_pk_bf16(acc[k8 * 8 + 2], acc[k8 * 8 + 3]); w.z = cvt_pk_bf16(acc[k8 * 8 + 4], acc[k8 * 8 + 5]); w.w = cvt_pk_bf16(acc[k8 * 8 + 6], acc[k8 * 8 + 7]);
              *(u32x4*)(dst + k8 * 8) = w; } }
      __syncthreads(); }
    { const int lane = tid & 63, wv = tid >> 6; const float* h = (const float*)(p.ws + OFF_H); const float* gam = p.norm_g + layer * DM;
      bf16_t* xn = (bf16_t*)(p.ws + OFF_XN); bf16_t* xnp = (bf16_t*)(p.ws + OFF_XNP);
      for (int l = bid * 8 + wv; l < LP; l += G * 8) {
          if (l < L_TOK) { const f32x4* row = (const f32x4*)(h + (size_t)l * DM); f32x4 v[8]; float ss = 0.f;
#pragma unroll
              for (int i = 0; i < 8; ++i) { v[i] = row[i * 64 + lane]; ss += v[i][0] * v[i][0] + v[i][1] * v[i][1] + v[i][2] * v[i][2] + v[i][3] * v[i][3]; }
              ss = wave_sum(ss); const float inv = rsqrtf(ss * (1.0f / DM) + 1e-6f);
              const int l1 = l / FN2, l2 = l - l1 * FN2; const size_t pr = (size_t)l2 * FN1P + l1;
#pragma unroll
              for (int i = 0; i < 8; ++i) { const f32x4 gg = ((const f32x4*)gam)[i * 64 + lane]; u32x2 w; w.x = cvt_pk_bf16(v[i][0] * inv * gg[0], v[i][1] * inv * gg[1]); w.y = cvt_pk_bf16(v[i][2] * inv * gg[2], v[i][3] * inv * gg[3]);
                  *(u32x2*)(xn + (size_t)l * DM + (i * 64 + lane) * 4) = w; *(u32x2*)(xnp + pr * DM + (i * 64 + lane) * 4) = w; } }
          else { const u32x2 z = (u32x2){0u, 0u};
#pragma unroll
              for (int i = 0; i < 8; ++i) *(u32x2*)(xn + (size_t)l * DM + (i * 64 + lane) * 4) = z; } }
      for (int idx = bid * 8 + wv; idx < FN2 * (FN1P - FN1); idx += G * 8) { const int l2 = idx / (FN1P - FN1), l1 = FN1 + idx % (FN1P - FN1); const size_t pr = (size_t)l2 * FN1P + l1; const u32x2 z = (u32x2){0u, 0u};
#pragma unroll
          for (int i = 0; i < 8; ++i) *(u32x2*)(xnp + pr * DM + (i * 64 + lane) * 4) = z; } }
}

__device__ void na_unit(const Params& p, int layer, int r, int hd, unsigned char* smem) {
    const int tid = opaque_tid(), j = tid >> 6, c = tid & 63;
    const bf16_t* qkv = (const bf16_t*)(p.ws + OFF_QKV);
    const int r0 = min(max(r - 4, 0), 248);
    unsigned char* sK = smem; unsigned char* sV = smem + 73728; unsigned char* sMK = smem + 147456; unsigned char* sMV = sMK + 2304;
    __syncthreads();
#pragma unroll
    for (int ps = 0; ps < 8; ++ps) { const int tok = ps * 64 + (tid >> 3), ch = tid & 7; const size_t g = (size_t)(NMETA + r0 * 64 + tok) * 3072 + hd * 64 + ch * 8;
        *(u32x4*)(sK + tok * 144 + ch * 16) = *(const u32x4*)(qkv + g + 1024); *(u32x4*)(sV + tok * 144 + ch * 16) = *(const u32x4*)(qkv + g + 2048); }
    if (tid < 128) { const int tok = tid >> 3, ch = tid & 7; const size_t g = (size_t)tok * 3072 + hd * 64 + ch * 8;
        *(u32x4*)(sMK + tok * 144 + ch * 16) = *(const u32x4*)(qkv + g + 1024); *(u32x4*)(sMV + tok * 144 + ch * 16) = *(const u32x4*)(qkv + g + 2048); }
    float q[64];
    { const u32x4* qp = (const u32x4*)(qkv + (size_t)(NMETA + r * 64 + c) * 3072 + hd * 64);
#pragma unroll
      for (int i = 0; i < 8; ++i) { const u32x4 v = qp[i]; q[i * 8 + 0] = lo_bf(v.x) * 0.125f; q[i * 8 + 1] = hi_bf(v.x) * 0.125f; q[i * 8 + 2] = lo_bf(v.y) * 0.125f; q[i * 8 + 3] = hi_bf(v.y) * 0.125f;
          q[i * 8 + 4] = lo_bf(v.z) * 0.125f; q[i * 8 + 5] = hi_bf(v.z) * 0.125f; q[i * 8 + 6] = lo_bf(v.w) * 0.125f; q[i * 8 + 7] = hi_bf(v.w) * 0.125f; } }
    __syncthreads();
    const int cs = min(max(c - 8, 0), 48);
    const float* rp = p.rpb + ((size_t)(layer * 16 + hd) * 15 + (r0 + j - r + 7)) * 31 + (cs - c + 15);
    const float* mb = p.meta_bias + (layer * 16 + hd) * 16 + 2 * j;
    float o[64];
#pragma unroll
    for (int i = 0; i < 64; ++i) o[i] = 0.f;
    float mx = -3.0e38f, lsum = 0.f;
#pragma unroll 1
    for (int i = 0; i < 18; ++i) {
        const int ko = i < 16 ? (j * 64 + cs + i) * 144 : 147456 + (2 * j + i - 16) * 144; const int vo = i < 16 ? ko + 73728 : ko + 2304;
        const float bias = i < 16 ? rp[i] : mb[i - 16];
        float d0 = 0.f, d1 = 0.f;
#pragma unroll
        for (int e = 0; e < 8; ++e) { const u32x4 v = *(const u32x4*)(smem + ko + e * 16);
            d0 += q[e * 8 + 0] * lo_bf(v.x) + q[e * 8 + 2] * lo_bf(v.y) + q[e * 8 + 4] * lo_bf(v.z) + q[e * 8 + 6] * lo_bf(v.w);
            d1 += q[e * 8 + 1] * hi_bf(v.x) + q[e * 8 + 3] * hi_bf(v.y) + q[e * 8 + 5] * hi_bf(v.z) + q[e * 8 + 7] * hi_bf(v.w); }
        const float sc = d0 + d1 + bias; const float mnew = fmaxf(mx, sc); const float alpha = __expf(mx - mnew), pi = __expf(sc - mnew);
        lsum = lsum * alpha + pi; mx = mnew;
#pragma unroll
        for (int e = 0; e < 8; ++e) { const u32x4 v = *(const u32x4*)(smem + vo + e * 16);
            o[e * 8 + 0] = o[e * 8 + 0] * alpha + pi * lo_bf(v.x); o[e * 8 + 1] = o[e * 8 + 1] * alpha + pi * hi_bf(v.x); o[e * 8 + 2] = o[e * 8 + 2] * alpha + pi * lo_bf(v.y); o[e * 8 + 3] = o[e * 8 + 3] * alpha + pi * hi_bf(v.y);
            o[e * 8 + 4] = o[e * 8 + 4] * alpha + pi * lo_bf(v.z); o[e * 8 + 5] = o[e * 8 + 5] * alpha + pi * hi_bf(v.z); o[e * 8 + 6] = o[e * 8 + 6] * alpha + pi * lo_bf(v.w); o[e * 8 + 7] = o[e * 8 + 7] * alpha + pi * hi_bf(v.w); }
    }
    __syncthreads();
    float* part = (float*)smem;
    { float* pp = part + (size_t)(j * 64 + c) * 67;
#pragma unroll
      for (int i = 0; i < 64; ++i) pp[i] = o[i];
      pp[64] = mx; pp[65] = lsum; }
    __syncthreads();
    { const int qc = tid >> 3, d0 = (tid & 7) * 8; float mj[8], M = -3.0e38f;
#pragma unroll
      for (int w = 0; w < 8; ++w) { mj[w] = part[(size_t)(w * 64 + qc) * 67 + 64]; M = fmaxf(M, mj[w]); }
      float Lsum = 0.f, o[8];
#pragma unroll
      for (int e = 0; e < 8; ++e) o[e] = 0.f;
#pragma unroll
      for (int w = 0; w < 8; ++w) { const float f = __expf(mj[w] - M); const float* pp = part + (size_t)(w * 64 + qc) * 67; Lsum += f * pp[65];
#pragma unroll
          for (int e = 0; e < 8; ++e) o[e] += f * pp[d0 + e]; }
      const float inv = 1.0f / Lsum;
      bf16_t* gp = (bf16_t*)(p.ws + OFF_GATE + 2 * SZ_GATE) + (size_t)(NMETA + r * 64 + qc) * 1024 + hd * 64 + d0;
      const u32x4 g = *(const u32x4*)gp;
      u32x4 w; w.x = cvt_pk_bf16(o[0] * inv * lo_bf(g.x), o[1] * inv * hi_bf(g.x)); w.y = cvt_pk_bf16(o[2] * inv * lo_bf(g.y), o[3] * inv * hi_bf(g.y));
      w.z = cvt_pk_bf16(o[4] * inv * lo_bf(g.z), o[5] * inv * hi_bf(g.z)); w.w = cvt_pk_bf16(o[6] * inv * lo_bf(g.w), o[7] * inv * hi_bf(g.w));
      *(u32x4*)gp = w; }
}
__device__ void na_meta_unit(const Params& p, int layer) {
    const int tid = opaque_tid();
    if (tid < 256) { const int hd = tid >> 4, qi = tid & 15; const bf16_t* qkv = (const bf16_t*)(p.ws + OFF_QKV);
        float q[64];
        { const u32x4* qp = (const u32x4*)(qkv + (size_t)qi * 3072 + hd * 64);
#pragma unroll
          for (int i = 0; i < 8; ++i) { const u32x4 v = qp[i]; q[i * 8 + 0] = lo_bf(v.x) * 0.125f; q[i * 8 + 1] = hi_bf(v.x) * 0.125f; q[i * 8 + 2] = lo_bf(v.y) * 0.125f; q[i * 8 + 3] = hi_bf(v.y) * 0.125f;
              q[i * 8 + 4] = lo_bf(v.z) * 0.125f; q[i * 8 + 5] = hi_bf(v.z) * 0.125f; q[i * 8 + 6] = lo_bf(v.w) * 0.125f; q[i * 8 + 7] = hi_bf(v.w) * 0.125f; } }
        float o[64];
#pragma unroll
        for (int i = 0; i < 64; ++i) o[i] = 0.f;
        float mx = -3.0e38f, lsum = 0.f;
#pragma unroll 1
        for (int m = 0; m < 16; ++m) { const u32x4* kp = (const u32x4*)(qkv + (size_t)m * 3072 + 1024 + hd * 64); const u32x4* vp = (const u32x4*)(qkv + (size_t)m * 3072 + 2048 + hd * 64);
            float d0 = 0.f, d1 = 0.f;
#pragma unroll
            for (int e = 0; e < 8; ++e) { const u32x4 v = kp[e];
                d0 += q[e * 8 + 0] * lo_bf(v.x) + q[e * 8 + 2] * lo_bf(v.y) + q[e * 8 + 4] * lo_bf(v.z) + q[e * 8 + 6] * lo_bf(v.w);
                d1 += q[e * 8 + 1] * hi_bf(v.x) + q[e * 8 + 3] * hi_bf(v.y) + q[e * 8 + 5] * hi_bf(v.z) + q[e * 8 + 7] * hi_bf(v.w); }
            const float sc = d0 + d1 + p.meta_bias[(layer * 16 + hd) * 16 + m]; const float mnew = fmaxf(mx, sc); const float alpha = __expf(mx - mnew), pi = __expf(sc - mnew);
            lsum = lsum * alpha + pi; mx = mnew;
#pragma unroll
            for (int e = 0; e < 8; ++e) { const u32x4 v = vp[e];
                o[e * 8 + 0] = o[e * 8 + 0] * alpha + pi * lo_bf(v.x); o[e * 8 + 1] = o[e * 8 + 1] * alpha + pi * hi_bf(v.x); o[e * 8 + 2] = o[e * 8 + 2] * alpha + pi * lo_bf(v.y); o[e * 8 + 3] = o[e * 8 + 3] * alpha + pi * hi_bf(v.y);
                o[e * 8 + 4] = o[e * 8 + 4] * alpha + pi * lo_bf(v.z); o[e * 8 + 5] = o[e * 8 + 5] * alpha + pi * hi_bf(v.z); o[e * 8 + 6] = o[e * 8 + 6] * alpha + pi * lo_bf(v.w); o[e * 8 + 7] = o[e * 8 + 7] * alpha + pi * hi_bf(v.w); } }
        const float inv = 1.0f / lsum; u32x4* gp = (u32x4*)((bf16_t*)(p.ws + OFF_GATE + 2 * SZ_GATE) + (size_t)qi * 1024 + hd * 64);
#pragma unroll
        for (int e = 0; e < 8; ++e) { const u32x4 g = gp[e]; u32x4 w;
            w.x = cvt_pk_bf16(o[e * 8 + 0] * inv * lo_bf(g.x), o[e * 8 + 1] * inv * hi_bf(g.x)); w.y = cvt_pk_bf16(o[e * 8 + 2] * inv * lo_bf(g.y), o[e * 8 + 3] * inv * hi_bf(g.y));
            w.z = cvt_pk_bf16(o[e * 8 + 4] * inv * lo_bf(g.z), o[e * 8 + 5] * inv * hi_bf(g.z)); w.w = cvt_pk_bf16(o[e * 8 + 6] * inv * lo_bf(g.w), o[e * 8 + 7] * inv * hi_bf(g.w));
            gp[e] = w; } }
}

__device__ __forceinline__ unsigned rev4_14(unsigned k) { unsigned r = __brev(k) >> 18; return ((r & 0x1555u) << 1) | ((r >> 1) & 0x1555u); }
__device__ __forceinline__ float2 cmul(float2 a, float2 b) { return make_float2(a.x * b.x - a.y * b.y, a.x * b.y + a.y * b.x); }
#define PADI(i) ((i) + ((i) >> 4))
#define CFF(n) cff[2 * PADI((n) >> 1) + ((n) & 1)]
__device__ __forceinline__ void hw_sincos(float rev, float& sn, float& cs) { sn = __builtin_amdgcn_sinf(rev); cs = __builtin_amdgcn_cosf(rev); }
__device__ __forceinline__ float c16(int k) { const float t[10] = {1.0f, 0.9238795325f, 0.7071067812f, 0.3826834324f, 0.0f, -0.3826834324f, -0.7071067812f, -0.9238795325f, -1.0f, -0.9238795325f}; return t[k]; }
__device__ __forceinline__ float s16(int k) { const float t[10] = {0.0f, 0.3826834324f, 0.7071067812f, 0.9238795325f, 1.0f, 0.9238795325f, 0.7071067812f, 0.3826834324f, 0.0f, -0.3826834324f}; return t[k]; }
__device__ void fft_fwd(float2* a) {
    for (int span = 4096; span >= 16; span >>= 2) {
        for (int b = opaque_tid(); b < 4096; b += NTHREADS) { const int j = b & (span - 1); const int base = ((b - j) << 2) + j;
            const int i0 = PADI(base), i1 = PADI(base + span), i2 = PADI(base + 2 * span), i3 = PADI(base + 3 * span);
            const float2 a0 = a[i0], a1 = a[i1], a2 = a[i2], a3 = a[i3];
            const float2 t0 = make_float2(a0.x + a2.x, a0.y + a2.y), t1 = make_float2(a0.x - a2.x, a0.y - a2.y), t2 = make_float2(a1.x + a3.x, a1.y + a3.y);
            const float2 t3 = make_float2(a1.y - a3.y, -(a1.x - a3.x));
            float sn, cs; hw_sincos((float)j / (float)(4 * span), sn, cs);
            const float2 w1 = make_float2(cs, -sn), w2 = cmul(w1, w1), w3 = cmul(w2, w1);
            a[i0] = make_float2(t0.x + t2.x, t0.y + t2.y);
            a[i1] = cmul(make_float2(t1.x + t3.x, t1.y + t3.y), w1);
            a[i2] = cmul(make_float2(t0.x - t2.x, t0.y - t2.y), w2);
            a[i3] = cmul(make_float2(t1.x - t3.x, t1.y - t3.y), w3); }
        __syncthreads(); }
    for (int blk = opaque_tid(); blk < 1024; blk += NTHREADS) { float2* pb = a + blk * 17; float2 x[16];
#pragma unroll
        for (int e = 0; e < 16; ++e) x[e] = pb[e];
#pragma unroll
        for (int j = 0; j < 4; ++j) { const float2 a0 = x[j], a1 = x[j + 4], a2 = x[j + 8], a3 = x[j + 12];
            const float2 t0 = make_float2(a0.x + a2.x, a0.y + a2.y), t1 = make_float2(a0.x - a2.x, a0.y - a2.y), t2 = make_float2(a1.x + a3.x, a1.y + a3.y), t3 = make_float2(a1.y - a3.y, -(a1.x - a3.x));
            x[j] = make_float2(t0.x + t2.x, t0.y + t2.y);
            x[j + 4] = cmul(make_float2(t1.x + t3.x, t1.y + t3.y), make_float2(c16(j), -s16(j)));
            x[j + 8] = cmul(make_float2(t0.x - t2.x, t0.y - t2.y), make_float2(c16(2 * j), -s16(2 * j)));
            x[j + 12] = cmul(make_float2(t1.x - t3.x, t1.y - t3.y), make_float2(c16(3 * j), -s16(3 * j))); }
#pragma unroll
        for (int g = 0; g < 4; ++g) { const float2 a0 = x[4 * g], a1 = x[4 * g + 1], a2 = x[4 * g + 2], a3 = x[4 * g + 3];
            const float2 t0 = make_float2(a0.x + a2.x, a0.y + a2.y), t1 = make_float2(a0.x - a2.x, a0.y - a2.y), t2 = make_float2(a1.x + a3.x, a1.y + a3.y), t3 = make_float2(a1.y - a3.y, -(a1.x - a3.x));
            x[4 * g] = make_float2(t0.x + t2.x, t0.y + t2.y); x[4 * g + 1] = make_float2(t1.x + t3.x, t1.y + t3.y);
            x[4 * g + 2] = make_float2(t0.x - t2.x, t0.y - t2.y); x[4 * g + 3] = make_float2(t1.x - t3.x, t1.y - t3.y); }
#pragma unroll
        for (int e = 0; e < 16; ++e) pb[e] = x[e]; }
    __syncthreads();
}
__device__ void fft_inv(float2* a) {
    for (int blk = opaque_tid(); blk < 1024; blk += NTHREADS) { float2* pb = a + blk * 17; float2 x[16];
#pragma unroll
        for (int e = 0; e < 16; ++e) x[e] = pb[e];
#pragma unroll
        for (int g = 0; g < 4; ++g) { const float2 a0 = x[4 * g], a1 = x[4 * g + 1], a2 = x[4 * g + 2], a3 = x[4 * g + 3];
            const float2 t0 = make_float2(a0.x + a2.x, a0.y + a2.y), t1 = make_float2(a0.x - a2.x, a0.y - a2.y), t2 = make_float2(a1.x + a3.x, a1.y + a3.y), t3 = make_float2(-(a1.y - a3.y), a1.x - a3.x);
            x[4 * g] = make_float2(t0.x + t2.x, t0.y + t2.y); x[4 * g + 1] = make_float2(t1.x + t3.x, t1.y + t3.y);
            x[4 * g + 2] = make_float2(t0.x - t2.x, t0.y - t2.y); x[4 * g + 3] = make_float2(t1.x - t3.x, t1.y - t3.y); }
#pragma unroll
        for (int j = 0; j < 4; ++j) { const float2 a0 = x[j], a1 = cmul(x[j + 4], make_float2(c16(j), s16(j))), a2 = cmul(x[j + 8], make_float2(c16(2 * j), s16(2 * j))), a3 = cmul(x[j + 12], make_float2(c16(3 * j), s16(3 * j)));
            const float2 t0 = make_float2(a0.x + a2.x, a0.y + a2.y), t1 = make_float2(a0.x - a2.x, a0.y - a2.y), t2 = make_float2(a1.x + a3.x, a1.y + a3.y), t3 = make_float2(-(a1.y - a3.y), a1.x - a3.x);
            x[j] = make_float2(t0.x + t2.x, t0.y + t2.y); x[j + 4] = make_float2(t1.x + t3.x, t1.y + t3.y);
            x[j + 8] = make_float2(t0.x - t2.x, t0.y - t2.y); x[j + 12] = make_float2(t1.x - t3.x, t1.y - t3.y); }
#pragma unroll
        for (int e = 0; e < 16; ++e) pb[e] = x[e]; }
    __syncthreads();
    for (int span = 16; span <= 4096; span <<= 2) {
        for (int b = opaque_tid(); b < 4096; b += NTHREADS) { const int j = b & (span - 1); const int base = ((b - j) << 2) + j;
            const int i0 = PADI(base), i1 = PADI(base + span), i2 = PADI(base + 2 * span), i3 = PADI(base + 3 * span);
            float sn, cs; hw_sincos((float)j / (float)(4 * span), sn, cs);
            const float2 w1 = make_float2(cs, sn), w2 = cmul(w1, w1), w3 = cmul(w2, w1);
            const float2 a0 = a[i0], a1 = cmul(a[i1], w1), a2 = cmul(a[i2], w2), a3 = cmul(a[i3], w3);
            const float2 t0 = make_float2(a0.x + a2.x, a0.y + a2.y), t1 = make_float2(a0.x - a2.x, a0.y - a2.y), t2 = make_float2(a1.x + a3.x, a1.y + a3.y);
            const float2 t3 = make_float2(-(a1.y - a3.y), a1.x - a3.x);
            a[i0] = make_float2(t0.x + t2.x, t0.y + t2.y);
            a[i1] = make_float2(t1.x + t3.x, t1.y + t3.y);
            a[i2] = make_float2(t0.x - t2.x, t0.y - t2.y);
            a[i3] = make_float2(t1.x - t3.x, t1.y - t3.y); }
        __syncthreads(); }
}
__device__ __forceinline__ void hy_val8(const bf16_t* __restrict__ row, int t0, const float (&w)[4], float (&o)[8]) {
    const u32x4 v = *(const u32x4*)(row + t0);
    float x[10];
    x[0] = t0 > 0 ? bf2f(row[t0 - 1]) : 0.f; x[9] = (t0 + 8 < L_TOK) ? bf2f(row[t0 + 8]) : 0.f;
    x[1] = lo_bf(v.x); x[2] = hi_bf(v.x); x[3] = lo_bf(v.y); x[4] = hi_bf(v.y); x[5] = lo_bf(v.z); x[6] = hi_bf(v.z); x[7] = lo_bf(v.w); x[8] = hi_bf(v.w);
#pragma unroll
    for (int e = 0; e < 8; ++e) o[e] = w[0] * x[e] + w[1] * x[e + 1] + w[2] * x[e + 2] + w[3];
}
struct HyCh { const bf16_t* __restrict__ ru; const bf16_t* __restrict__ r1; const bf16_t* __restrict__ r2; float wu[4], w1[4], w2[4]; };

constexpr int SD_W4B = 0  , SD_GFX = 512, SD_GBX = 528, SD_EF = 544, SD_EB = 560, SD_VH = 576, SD_VT = 592, SD_END = 608;
constexpr int NCHUNK = L_TOK / 8;

template <int ORDER>
__device__ void hy_conv(const HyCh& hc, float2* cf, float* side, unsigned char* scratch) {
    const int tid = opaque_tid(); float* cff = (float*)cf;
    f32x4* __restrict__ heo = (f32x4*)(scratch + HS_HEO); const float* __restrict__ z2g = (const float*)(scratch + HS_Z2);
    if (tid < 15) side[SD_EF + tid] = CFF(16369 + tid); else if (tid >= 32 && tid < 47) side[SD_EB + tid - 32] = CFF(32768 - (16369 + tid - 32));
    __syncthreads();
    fft_fwd(cf);
    for (int k = tid; k <= 8192; k += NTHREADS) { const int kp = (16384 - k) & 16383; const float2 a = cf[PADI(rev4_14(k))], bq = cf[PADI(rev4_14(kp))];
        const float bx = bq.x, by = -bq.y; const float sc = 1.0f / 16384.0f;
        heo[k] = (f32x4){0.5f * (a.x + bx) * sc, 0.5f * (a.y + by) * sc, 0.5f * (a.y - by) * sc, -0.5f * (a.x - bx) * sc}; }
    __syncthreads();
    for (int c = tid; c < NCHUNK; c += NTHREADS) { float v[8];
        if (ORDER == 0) hy_val8(hc.ru, 8 * c, hc.wu, v);
        else { const f32x4 p0 = *(const f32x4*)(z2g + 8 * c), p1 = *(const f32x4*)(z2g + 8 * c + 4); v[0] = p0[0]; v[1] = p0[1]; v[2] = p0[2]; v[3] = p0[3]; v[4] = p1[0]; v[5] = p1[1]; v[6] = p1[2]; v[7] = p1[3]; }
        float2* d = cf + PADI(4 * c); d[0] = make_float2(v[0], v[1]); d[1] = make_float2(v[2], v[3]); d[2] = make_float2(v[4], v[5]); d[3] = make_float2(v[6], v[7]);
        if (c < 2) {
#pragma unroll
            for (int e = 0; e < 8; ++e) side[SD_VH + 8 * c + e] = v[e]; }
        if (c >= NCHUNK - 2) {
#pragma unroll
            for (int e = 0; e < 8; ++e) side[SD_VT + 8 * (c - (NCHUNK - 2)) + e] = v[e]; } }
    for (int i = L_TOK / 2 + tid; i < 16384; i += NTHREADS) cf[PADI(i)] = make_float2(0.f, 0.f);
    __syncthreads();
    fft_fwd(cf);
    for (int k = tid; k <= 8192; k += NTHREADS) { const int kp = (16384 - k) & 16383; const unsigned ik = PADI(rev4_14(k)), ikp = PADI(rev4_14(kp)); const float2 a = cf[ik], bq = cf[ikp];
        const float bx = bq.x, by = -bq.y;
        const float2 XE = make_float2(0.5f * (a.x + bx), 0.5f * (a.y + by)), XO = make_float2(0.5f * (a.y - by), -0.5f * (a.x - bx));
        const f32x4 hh = heo[k]; const float2 HE = make_float2(hh[0], hh[1]), HO = make_float2(hh[2], hh[3]);
        float sn, cs; hw_sincos((float)k / 16384.0f, sn, cs); const float2 w = make_float2(cs, -sn);
        const float2 xoho = cmul(XO, HO), wx = cmul(w, xoho), xehe = cmul(XE, HE), xeho = cmul(XE, HO), xohe = cmul(XO, HE);
        const float2 YE = make_float2(xehe.x + wx.x, xehe.y + wx.y), YO = make_float2(xeho.x + xohe.x, xeho.y + xohe.y);
        cf[ik] = make_float2(YE.x - YO.y, YE.y + YO.x); cf[ikp] = make_float2(YE.x + YO.y, -YE.y + YO.x); }
    __syncthreads();
    fft_inv(cf);
    if (tid < 16) { const int t = tid; float d = 0.f;
        for (int s = t + 16384; s < L_TOK; ++s) { const int l = s - t; const float wrong = l == 16384 ? 0.f : side[SD_EF + 16399 - l]; d += (side[SD_GBX + l - 16384] - wrong) * side[SD_VT + s - 16384]; }
        CFF(t) += d; }
    else if (tid >= 32 && tid < 48) { const int t = 16384 + tid - 32; float d = 0.f;
        for (int s = 0; s <= t - 16384; ++s) { const int l = t - s; const float wrong = l == 16384 ? 0.f : side[SD_EB + 16399 - l]; d += (side[SD_GFX + l - 16384] - wrong) * side[SD_VH + s]; }
        CFF(t) += d; }
    __syncthreads();
}

__device__ void hyena_unit(const Params& p, int layer, int ch, unsigned char* smem, unsigned char* scratch) {
    const int tid = opaque_tid(); float2* cf = (float2*)smem; float* cff = (float*)smem; float* side = (float*)(smem + 139264);
    const bf16_t* hyin = (const bf16_t*)(p.ws + OFF_HYIN);
    HyCh hc; hc.ru = hyin + (size_t)ch * LP; hc.r1 = hyin + (size_t)(1024 + ch) * LP; hc.r2 = hyin + (size_t)(2048 + ch) * LP;
    { const float* cw = p.conv_w + (size_t)layer * 3 * 3072; const float* cb = p.conv_b + (size_t)layer * 3072;
#pragma unroll
      for (int jj = 0; jj < 3; ++jj) { hc.wu[jj] = cw[jj * 3072 + ch]; hc.w1[jj] = cw[jj * 3072 + 1024 + ch]; hc.w2[jj] = cw[jj * 3072 + 2048 + ch]; }
      hc.wu[3] = cb[ch]; hc.w1[3] = cb[1024 + ch]; hc.w2[3] = cb[2048 + ch]; }
    const float sk0 = p.skip[(layer * 2 + 0) * 1024 + ch], sk1 = p.skip[(layer * 2 + 1) * 1024 + ch];
    float* __restrict__ z2g = (float*)(scratch + HS_Z2); float* __restrict__ g2f = (float*)(scratch + HS_G2F); float* __restrict__ g2b = (float*)(scratch + HS_G2B);
    bf16_t* __restrict__ hyout = (bf16_t*)(p.ws + OFF_HYOUT) + (size_t)ch * LP;
    __syncthreads();
    { bf16_t* w4b = (bf16_t*)(side + SD_W4B);
      for (int i = tid; i < 16 * 64; i += NTHREADS) { const int n = i >> 6, k = i & 63; w4b[i] = n < 4 ? f2bf(p.f_w4[((size_t)layer * 64 + k) * 4096 + n * 1024 + ch]) : (bf16_t)0; }
      __syncthreads();
      const bf16_t* __restrict__ h3b = (const bf16_t*)(p.ws + OFF_H3) + (size_t)layer * L_TOK * 64;
      const int lane = tid & 63, wv = tid >> 6, col = lane & 15, quad = lane >> 4;
      const float dk = col < 4 ? fabsf(p.decay[((layer * 2 + (col >> 1)) * 2 + (col & 1)) * 1024 + ch]) * (1.4426950408889634f / (float)(L_TOK - 1)) : 0.f;
      const bf16x8 b0 = *(const bf16x8*)(w4b + col * 64 + quad * 8), b1 = *(const bf16x8*)(w4b + col * 64 + 32 + quad * 8);
#pragma unroll 2
      for (int g = wv; g < L_TOK / 16; g += 8) { const bf16_t* hr = h3b + (size_t)(g * 16 + col) * 64 + quad * 8;
          const bf16x8 a0 = *(const bf16x8*)hr, a1 = *(const bf16x8*)(hr + 32);
          f32x4 acc = (f32x4){0.f, 0.f, 0.f, 0.f};
          acc = __builtin_amdgcn_mfma_f32_16x16x32_bf16(a0, b0, acc, 0, 0, 0); acc = __builtin_amdgcn_mfma_f32_16x16x32_bf16(a1, b1, acc, 0, 0, 0);
          if (col < 4) { const int lag0 = g * 16 + quad * 4; float v[4];
#pragma unroll
              for (int r = 0; r < 4; ++r) v[r] = acc[r] * __builtin_amdgcn_exp2f(-(float)(lag0 + r) * dk);
              if (col == 2) *(f32x4*)(g2f + lag0) = (f32x4){v[0], v[1], v[2], v[3]};
              else if (col == 3) *(f32x4*)(g2b + lag0) = (f32x4){v[0], v[1], v[2], v[3]};
              else if (col == 0) { if (lag0 < NMAIN) { float2* d = cf + PADI(lag0 >> 1); d[0] = make_float2(v[0], v[1]); d[1] = make_float2(v[2], v[3]); }
                                   else { side[SD_GFX + lag0 - NMAIN] = v[0]; side[SD_GFX + lag0 - NMAIN + 1] = v[1]; side[SD_GFX + lag0 - NMAIN + 2] = v[2]; side[SD_GFX + lag0 - NMAIN + 3] = v[3]; } }
              else { if (lag0 < NMAIN) {
#pragma unroll
                         for (int r = 0; r < 4; ++r) if (lag0 + r >= 1) CFF(32768 - lag0 - r) = v[r]; }
                     else { side[SD_GBX + lag0 - NMAIN] = v[0]; side[SD_GBX + lag0 - NMAIN + 1] = v[1]; side[SD_GBX + lag0 - NMAIN + 2] = v[2]; side[SD_GBX + lag0 - NMAIN + 3] = v[3]; } } } }
      if (tid == 0) CFF(NMAIN) = 0.f;
      __syncthreads(); }
    hy_conv<0>(hc, cf, side, scratch);
    for (int c = tid; c < NCHUNK; c += NTHREADS) { float u8[8], x8[8]; hy_val8(hc.ru, 8 * c, hc.wu, u8); hy_val8(hc.r1, 8 * c, hc.w1, x8);
        const float2* s = cf + PADI(4 * c); const float2 y0 = s[0], y1 = s[1], y2 = s[2], y3 = s[3];
        const f32x4 o0 = (f32x4){x8[0] * (y0.x + sk0 * u8[0]), x8[1] * (y0.y + sk0 * u8[1]), x8[2] * (y1.x + sk0 * u8[2]), x8[3] * (y1.y + sk0 * u8[3])};
        const f32x4 o1 = (f32x4){x8[4] * (y2.x + sk0 * u8[4]), x8[5] * (y2.y + sk0 * u8[5]), x8[6] * (y3.x + sk0 * u8[6]), x8[7] * (y3.y + sk0 * u8[7])};
        *(f32x4*)(z2g + 8 * c) = o0; *(f32x4*)(z2g + 8 * c + 4) = o1; }
    __syncthreads();
    for (int q = tid; q < L_TOK / 4; q += NTHREADS) { const int lag0 = 4 * q; const f32x4 gf = *(const f32x4*)(g2f + lag0), gb = *(const f32x4*)(g2b + lag0);
        if (lag0 < NMAIN) { float2* d = cf + PADI(lag0 >> 1); d[0] = make_float2(gf[0], gf[1]); d[1] = make_float2(gf[2], gf[3]);
#pragma unroll
            for (int r = 0; r < 4; ++r) if (lag0 + r >= 1) CFF(32768 - lag0 - r) = gb[r]; }
        else {
#pragma unroll
            for (int r = 0; r < 4; ++r) { side[SD_GFX + lag0 - NMAIN + r] = gf[r]; side[SD_GBX + lag0 - NMAIN + r] = gb[r]; } } }
    if (tid == 0) CFF(NMAIN) = 0.f;
    __syncthreads();
    hy_conv<1>(hc, cf, side, scratch);
    for (int c = tid; c < NCHUNK; c += NTHREADS) { float x8[8]; hy_val8(hc.r2, 8 * c, hc.w2, x8);
        const f32x4 p0 = *(const f32x4*)(z2g + 8 * c), p1 = *(const f32x4*)(z2g + 8 * c + 4);
        const float2* s = cf + PADI(4 * c); const float2 y0 = s[0], y1 = s[1], y2 = s[2], y3 = s[3];
        u32x4 w; w.x = cvt_pk_bf16(x8[0] * (y0.x + sk1 * p0[0]), x8[1] * (y0.y + sk1 * p0[1])); w.y = cvt_pk_bf16(x8[2] * (y1.x + sk1 * p0[2]), x8[3] * (y1.y + sk1 * p0[3]));
        w.z = cvt_pk_bf16(x8[4] * (y2.x + sk1 * p1[0]), x8[5] * (y2.y + sk1 * p1[1])); w.w = cvt_pk_bf16(x8[6] * (y3.x + sk1 * p1[2]), x8[7] * (y3.y + sk1 * p1[3]));
        *(u32x4*)(hyout + 8 * c) = w; }
    __syncthreads();
}

__device__ void transpose_unit(const Params& p, int ct, int tt, unsigned char* smem) {
    const int tid = opaque_tid(); bf16_t* tile = (bf16_t*)smem;
    const bf16_t* hyout = (const bf16_t*)(p.ws + OFF_HYOUT); bf16_t* ya = (bf16_t*)(p.ws + OFF_GATE);
    __syncthreads();
    { const int cl = tid >> 3, t8 = (tid & 7) * 8; *(u32x4*)(tile + cl * 72 + t8) = *(const u32x4*)(hyout + (size_t)(ct * 64 + cl) * LP + tt * 64 + t8); }
    __syncthreads();
    { const int tl = tid >> 3, c8 = (tid & 7) * 8; const int t = tt * 64 + tl;
      if (t < L_TOK) { bf16_t* gp = ya + (size_t)t * 1024 + ct * 64 + c8; const u32x4 g = *(const u32x4*)gp;
          float v[8];
#pragma unroll
          for (int i = 0; i < 8; ++i) v[i] = bf2f(tile[(c8 + i) * 72 + tl]);
          u32x4 w; w.x = cvt_pk_bf16(v[0] * lo_bf(g.x), v[1] * hi_bf(g.x)); w.y = cvt_pk_bf16(v[2] * lo_bf(g.y), v[3] * hi_bf(g.y)); w.z = cvt_pk_bf16(v[4] * lo_bf(g.z), v[5] * hi_bf(g.z)); w.w = cvt_pk_bf16(v[6] * lo_bf(g.w), v[7] * hi_bf(g.w));
          *(u32x4*)gp = w; } }
}

__device__ void phase_final(const Params& p) {
    const int tid = opaque_tid(), lane = tid & 63, wv = tid >> 6; const float* h = (const float*)(p.ws + OFF_H);
    for (int l = NMETA + blockIdx.x * 8 + wv; l < L_TOK; l += gridDim.x * 8) { const f32x4* row = (const f32x4*)(h + (size_t)l * DM); f32x4 v[8]; float ss = 0.f;
#pragma unroll
        for (int i = 0; i < 8; ++i) { v[i] = row[i * 64 + lane]; ss += v[i][0] * v[i][0] + v[i][1] * v[i][1] + v[i][2] * v[i][2] + v[i][3] * v[i][3]; }
        ss = wave_sum(ss); const float inv = rsqrtf(ss * (1.0f / DM) + 1e-6f); f32x4* o = (f32x4*)(p.out + (size_t)(l - NMETA) * DM);
#pragma unroll
        for (int i = 0; i < 8; ++i) { const f32x4 gg = ((const f32x4*)p.final_g)[i * 64 + lane]; o[i * 64 + lane] = v[i] * inv * gg; } }
}

enum { OP_P1 = 0, OP_SYNC, OP_GEMM, OP_NA, OP_HYENA, OP_TRANS, OP_NOP };
__global__ void __launch_bounds__(512, 2) hybrid_fwd(Params p) {
    extern __shared__ __attribute__((aligned(16))) unsigned char smem[];
    cg::grid_group grid = cg::this_grid();
    LAS unsigned char* lds = (LAS unsigned char*)smem;
    const int bid = blockIdx.x, G = gridDim.x;
    phase_prep0(p, smem);
    constexpr int NOPS = 17;
#pragma clang loop unroll(disable)
    for (int step = 0; step < 2 * NOPS; ++step) {
        const int layer = step / NOPS, s = step - layer * NOPS;
        int op, kind = 0;
        switch (s) {
        case 0: op = OP_P1; break;
        case 2: op = OP_GEMM; kind = K_IN; break;
        case 3: case 4: op = OP_NOP; break;
        case 6: op = OP_GEMM; kind = K_FNA; break;
        case 7: op = OP_NA; break;
        case 8: op = OP_HYENA; break;
        case 10: op = OP_GEMM; kind = K_FNB; break;
        case 11: op = OP_TRANS; break;
        case 13: op = OP_GEMM; kind = K_BR; break;
        case 15: op = OP_GEMM; kind = K_OUT; break;
        default: op = OP_SYNC; break;
        }
        if (op == OP_NOP) { }
        else if (op == OP_SYNC) { grid.sync(); }
        else if (op == OP_GEMM) {
            Gemm g; g.base = (const char*)p.ws; g.jumpA = 0; g.jumpB = 0;
            switch (kind) {
            case K_FNA: g.lda = 384; g.ldb = FN1P; g.nt = 6; g.ksplit = 3; g.jumpB = (long)((size_t)1024 * PROWS * 2) - 384l; break;
            case K_FNB: g.lda = 256; g.ldb = 256; g.nt = 4; g.ksplit = 4; break;
            case K_BR:  g.lda = 1024; g.ldb = 1024; g.nt = 16; g.ksplit = 16; break;
            default:    g.lda = DM; g.ldb = DM; g.nt = 32; g.ksplit = 32; break;
            }
            SchedAny S{kind, G, bid}; EpiAny E{kind, p.ws};
            pg8::gemm_phase(lds, g, S, E);
        }
        else if (op == OP_P1) { phase_p1(p, layer, smem); }
        else if (op == OP_NA) { for (int u = bid; u < 4096; u += G) na_unit(p, layer, u >> 4, u & 15, smem); if (bid == G - 1) na_meta_unit(p, layer); }
        else if (op == OP_HYENA) { for (int ch = bid; ch < 1024; ch += G) hyena_unit(p, layer, ch, smem, (unsigned char*)p.out + (size_t)bid * HS_STRIDE); }
        else { for (int u = bid; u < 16 * 257; u += G) transpose_unit(p, u & 15, u >> 4, smem); }
    }
    phase_final(p);
}

extern "C" void kernel_launch(void* const* d_in, const int* in_sizes, int n_in, void* d_out, int out_size, void* d_ws, size_t ws_size, hipStream_t stream) {
    static int grid_blocks = 0;
    if (grid_blocks == 0) {
        if (n_in != 23 || ws_size < WS_END) { fprintf(stderr, "kernel_launch: need 23 inputs and %zu bytes of workspace (got %d, %zu)\n", (size_t)WS_END, n_in, ws_size); grid_blocks = -1; return; }
        int dev = 0, cus = 0, per_cu = 0;
        hipGetDevice(&dev); hipDeviceGetAttribute(&cus, hipDeviceAttributeMultiprocessorCount, dev);
        if (hipFuncSetAttribute((const void*)hybrid_fwd, hipFuncAttributeMaxDynamicSharedMemorySize, LDS_BYTES) != hipSuccess) { fprintf(stderr, "kernel_launch: hipFuncSetAttribute failed\n"); grid_blocks = -1; return; }
        hipOccupancyMaxActiveBlocksPerMultiprocessor(&per_cu, (const void*)hybrid_fwd, NTHREADS, LDS_BYTES);
        if (per_cu < 1) per_cu = 1;
        grid_blocks = cus * per_cu;
        if (grid_blocks > 256) grid_blocks = 256;
    }
    if (grid_blocks < 0) return;
    Params p{};
    const float** f = (const float**)&p;
    for (int i = 0; i < 23; ++i) f[i] = (const float*)d_in[i];
    p.out = (float*)d_out; p.ws = (unsigned char*)d_ws;
    void* args[] = {&p};
    hipError_t e = hipLaunchCooperativeKernel((const void*)hybrid_fwd, dim3(grid_blocks), dim3(NTHREADS), args, LDS_BYTES, stream);
    if (e != hipSuccess) fprintf(stderr, "cooperative launch failed: %s (grid %d)\n", hipGetErrorString(e), grid_blocks);
}
```

```cpp
#include <hip/hip_runtime.h>
#include <hip/hip_cooperative_groups.h>
#include <cstdio>
namespace cg = cooperative_groups;

#define LAS __attribute__((address_space(3)))
typedef unsigned short bf16_t;
typedef short bf16x8 __attribute__((ext_vector_type(8)));
typedef float f32x4 __attribute__((ext_vector_type(4)));
typedef unsigned u32x4 __attribute__((ext_vector_type(4)));
typedef unsigned u32x2 __attribute__((ext_vector_type(2)));

constexpr int L_TOK = 16400, LP = 16640, DM = 2048, NIN = 16384, NMETA = 16, NMAIN = 16384;
constexpr int FN1 = 164, FN2 = 100, FN1P = 192, PROWS = FN2 * FN1P;
constexpr int NTHREADS = 512, LDS_BYTES = 155648;

constexpr size_t SZ_H = (size_t)LP * DM * 4, SZ_XN = (size_t)LP * DM * 2, SZ_XNP = (size_t)PROWS * DM * 2;
constexpr size_t OFF_H = 0;
constexpr size_t OFF_XN = OFF_H + SZ_H;
constexpr size_t OFF_XNP = OFF_XN + SZ_XN;
constexpr size_t OFF_A1 = OFF_XN;
constexpr size_t SZ_A1 = (size_t)FN1 * 1024 * 2 * 128 * 2;
constexpr size_t OFF_HYOUT = OFF_A1 + SZ_A1;
constexpr size_t SZ_HYOUT = (size_t)1024 * LP * 2;
static_assert(OFF_HYOUT + SZ_HYOUT <= OFF_XNP + SZ_XNP, "alias overflow");
constexpr size_t OFF_WT = OFF_XNP + SZ_XNP;
constexpr size_t OFF_WEFF = OFF_WT + (size_t)NIN * DM * 2;
constexpr size_t OFF_WA = OFF_WEFF + (size_t)2048 * 2048 * 2;
constexpr size_t SZ_WBR = (size_t)2048 * 1024 * 2;
constexpr size_t OFF_WO = OFF_WA + 3 * SZ_WBR;
constexpr size_t OFF_HYIN = OFF_WO + (size_t)2048 * 2048 * 2;
constexpr size_t OFF_GATE = OFF_HYIN + (size_t)3072 * LP * 2;
constexpr size_t SZ_GATE = (size_t)LP * 1024 * 2;
constexpr size_t OFF_QKV = OFF_GATE + 3 * SZ_GATE;
constexpr size_t OFF_MERGE = OFF_QKV + (size_t)LP * 3072 * 2;
constexpr size_t OFF_ZT = OFF_MERGE + (size_t)LP * 6144 * 2;
constexpr size_t SZ_ZT = (size_t)2048 * PROWS * 2;
constexpr size_t OFF_M = OFF_ZT;
static_assert(SZ_XN <= SZ_ZT, "alias overflow");
constexpr size_t OFF_FA = OFF_ZT + SZ_ZT;
constexpr size_t OFF_FB = OFF_FA + (size_t)512 * 384 * 2;
constexpr size_t OFF_H3 = OFF_FB + (size_t)FN1 * 256 * 256 * 2;
constexpr size_t WS_END = OFF_H3 + (size_t)2 * L_TOK * 64 * 4;
constexpr size_t HS_HEO = 0, HS_CORR = 131328, HS_Z2 = HS_CORR + 65536, HS_G2F = HS_Z2 + 65792, HS_G2B = HS_G2F + 65792, HS_STRIDE = HS_G2B + 65792;
static_assert(HS_STRIDE * 256 <= (size_t)NMAIN * DM * 4, "scratch overflow");

struct Params {
    const float* x; const float* meta; const float* norm_g; const float* w_in; const float* conv_w; const float* conv_b;
    const float* f_w1; const float* f_b1; const float* f_w2; const float* f_b2; const float* f_w3; const float* f_b3; const float* f_w4;
    const float* f_freq; const float* decay; const float* skip; const float* rpb; const float* meta_bias;
    const float* w_a; const float* w_b; const float* w_c; const float* w_out; const float* final_g;
    float* out; unsigned char* ws;
};

__device__ __forceinline__ int opaque_tid() { int t = threadIdx.x; asm volatile("" : "+v"(t)); return t; }
__device__ __forceinline__ float bf2f(bf16_t b) { return __uint_as_float(((unsigned)b) << 16); }
__device__ __forceinline__ bf16_t f2bf(float f) { unsigned u = __float_as_uint(f); u += 0x7FFFu + ((u >> 16) & 1u); return (bf16_t)(u >> 16); }
__device__ __forceinline__ unsigned cvt_pk_bf16(float lo, float hi) { unsigned r; asm volatile("v_cvt_pk_bf16_f32 %0, %1, %2" : "=v"(r) : "v"(lo), "v"(hi)); return r; }
__device__ __forceinline__ float lo_bf(unsigned u) { return __uint_as_float(u << 16); }
__device__ __forceinline__ float hi_bf(unsigned u) { return __uint_as_float(u & 0xffff0000u); }
__device__ __forceinline__ float silu_f(float v) { return v / (1.0f + __expf(-v)); }
__device__ __forceinline__ float sigm_f(float v) { return 1.0f / (1.0f + __expf(-v)); }
__device__ __forceinline__ float wave_sum(float v) {
#pragma unroll
    for (int o = 32; o >= 1; o >>= 1) v += __shfl_xor(v, o);
    return v;
}

namespace pg8 {
constexpr int BM = 256, BK = 64, HALF = 128, HTB = HALF * BK * 2, STAGE_BYTES = 8 * HTB;
__device__ __forceinline__ int lds_byte(int r, int c) { const int st = (r >> 4) * 2 + (c >> 5), rr = r & 15, cc = c & 31, ob = rr * 64 + cc * 2; return st * 1024 + (ob ^ (((ob >> 9) & 1) << 5)); }
__device__ __forceinline__ void stage_rc(int b, int& R, int& C) { const int st = b / 1024, sb = b % 1024, swz = sb ^ (((sb >> 9) & 1) << 5); R = (st >> 1) * 16 + swz / 64; C = (st & 1) * 32 + (swz % 64) / 2; }
__device__ __forceinline__ int perm32(int rho) { const int n = rho >> 4, i = rho & 15; return 8 * (i >> 2) + 4 * n + (i & 3); }

struct Unit { int pm, pn, aux; size_t offA, offB; };
struct Gemm { const char* base; int lda, ldb, nt, ksplit; long jumpA, jumpB; };

__device__ __forceinline__ void tile_map(int wgid, int nM, int nN, int& pm, int& pn) {
    const int nwg = nM * nN;
    { const int q = nwg / 8, r = nwg % 8, xcd = wgid % 8, off = wgid / 8; wgid = (xcd < r ? xcd * (q + 1) : r * (q + 1) + (xcd - r) * q) + off; }
    const int nig = 8 * nN, gid = wgid / nig, fm = gid * 8, gsz = (nM - fm) < 8 ? (nM - fm) : 8;
    pm = fm + ((wgid % nig) % gsz); pn = (wgid % nig) / gsz;
}

template <class Epi, class Sched>
__device__ __forceinline__ void gemm_phase(LAS unsigned char* lds, const Gemm g, const Sched& S, const Epi& E) {
    const int tid = opaque_tid(), wid = __builtin_amdgcn_readfirstlane(tid >> 6), lane = tid & 63, wr = wid >> 2, wc = wid & 3, fr = lane & 15, fq = lane >> 4;
    const int nt = g.nt;
    unsigned voffA[2], voffB[2];
#pragma unroll
    for (int i = 0; i < 2; ++i) { int R, C; stage_rc(tid * 16 + i * 8192, R, C); const int Rb = (R & ~31) + perm32(R & 31);
        voffA[i] = (unsigned)(R * g.lda + C) * 2u; voffB[i] = (unsigned)(Rb * g.ldb + C) * 2u; }
    const size_t kstep = (size_t)(BK * 2);
    const size_t hstepA = (size_t)HALF * g.lda * 2, hstepB = (size_t)HALF * g.ldb * 2;
    const unsigned ldsw = (unsigned)wid * 1024u;
    const int aoff = lds_byte(wr * 64 + fr, fq * 8), boff = lds_byte(wc * 32 + fr, fq * 8);
#define PG8_KA(p, t) ((p) + (size_t)(t) * kstep + ((t) >= g.ksplit ? g.jumpA : 0l))
#define PG8_KB(p, t) ((p) + (size_t)(t) * kstep + ((t) >= g.ksplit ? g.jumpB : 0l))
#define PG8_SA(b, h) (((b) * 2 + (h)) * HTB)
#define PG8_SB(b, h) ((4 + (b) * 2 + (h)) * HTB)
#define PG8_STAGE(bufoff, gbase, voff) do { _Pragma("unroll") for (int _i = 0; _i < 2; ++_i) \
        __builtin_amdgcn_global_load_lds((const unsigned*)((const char*)(gbase) + (voff)[_i]), (LAS unsigned*)(lds + (bufoff) + ldsw + _i * 8192), 16, 0, 0); } while (0)
#define PG8_LDA(dst, b, h) do { _Pragma("unroll") for (int m = 0; m < 4; ++m) _Pragma("unroll") for (int k = 0; k < 2; ++k) dst[m][k] = *(const LAS bf16x8*)(lds + PG8_SA(b, h) + aoff + m * 2048 + k * 1024); } while (0)
#define PG8_LDB(dst, b, h) do { _Pragma("unroll") for (int n = 0; n < 2; ++n) _Pragma("unroll") for (int k = 0; k < 2; ++k) dst[n][k] = *(const LAS bf16x8*)(lds + PG8_SB(b, h) + boff + n * 2048 + k * 1024); } while (0)
#define PG8_MMA(ai, bj, At, Bt) do { __builtin_amdgcn_s_setprio(1); _Pragma("unroll") for (int m = 0; m < 4; ++m) _Pragma("unroll") for (int n = 0; n < 2; ++n) _Pragma("unroll") for (int k = 0; k < 2; ++k) \
        acc[ai][bj][m][n] = __builtin_amdgcn_mfma_f32_16x16x32_bf16(Bt[n][k], At[m][k], acc[ai][bj][m][n], 0, 0, 0); __builtin_amdgcn_s_setprio(0); } while (0)
#define PG8_WAIT_V(n) asm volatile("s_waitcnt vmcnt(" #n ")" ::: "memory")
#define PG8_WAIT_L(n) asm volatile("s_waitcnt lgkmcnt(" #n ")" ::: "memory")
#define PG8_BAR __builtin_amdgcn_s_barrier()
#define PG8_SCHED __builtin_amdgcn_sched_barrier(0)
    Unit cur, nxt; int ui = 0;
    if (!S.next(0, cur)) return;
    f32x4 acc[2][2][4][2];
#pragma unroll
    for (int a = 0; a < 2; ++a)
#pragma unroll
        for (int b = 0; b < 2; ++b)
#pragma unroll
            for (int m = 0; m < 4; ++m)
#pragma unroll
                for (int n = 0; n < 2; ++n) acc[a][b][m][n] = (f32x4){0.f, 0.f, 0.f, 0.f};
    bf16x8 At[4][2], B0[2][2], B1[2][2];
    const char* cA = g.base + cur.offA; const char* cB = g.base + cur.offB;
    PG8_STAGE(PG8_SB(0, 0), cB, voffB); PG8_STAGE(PG8_SA(0, 0), cA, voffA); PG8_STAGE(PG8_SB(0, 1), cB + hstepB, voffB); PG8_STAGE(PG8_SA(0, 1), cA + hstepA, voffA);
    if (wr == 1) PG8_BAR;
    PG8_WAIT_V(4); PG8_BAR;
    PG8_STAGE(PG8_SB(1, 0), PG8_KB(cB, 1), voffB); PG8_STAGE(PG8_SA(1, 0), PG8_KA(cA, 1), voffA); PG8_STAGE(PG8_SB(1, 1), PG8_KB(cB, 1) + hstepB, voffB);
    PG8_WAIT_V(6); PG8_BAR;
    for (;;) {
        const bool has_next = S.next(ui + 1, nxt);
        const char* nA = has_next ? g.base + nxt.offA : cA; const char* nB = has_next ? g.base + nxt.offB : cB;
        for (int t = 0; t < nt; t += 2) {
            const bool last = (t == nt - 2);
            const char* a1 = PG8_KA(cA, t + 1);
            const char* a2 = last ? nA : PG8_KA(cA, t + 2); const char* b2 = last ? nB : PG8_KB(cB, t + 2);
            const char* a3 = last ? PG8_KA(nA, 1) : PG8_KA(cA, t + 3); const char* b3 = last ? PG8_KB(nB, 1) : PG8_KB(cB, t + 3);
            PG8_LDB(B0, 0, 0); PG8_SCHED; PG8_LDA(At, 0, 0); PG8_STAGE(PG8_SA(1, 1), a1 + hstepA, voffA);
            PG8_WAIT_L(8); PG8_BAR; PG8_WAIT_L(0); PG8_MMA(0, 0, At, B0); PG8_BAR; PG8_SCHED;
            PG8_LDB(B1, 0, 1); PG8_STAGE(PG8_SB(0, 0), b2, voffB);
            PG8_BAR; PG8_WAIT_L(0); PG8_MMA(0, 1, At, B1); PG8_BAR;
            PG8_LDA(At, 0, 1); PG8_STAGE(PG8_SA(0, 0), a2, voffA);
            PG8_BAR; PG8_WAIT_L(0); PG8_MMA(1, 0, At, B0); PG8_BAR; PG8_SCHED;
            PG8_STAGE(PG8_SB(0, 1), b2 + hstepB, voffB);
            PG8_WAIT_V(6); PG8_BAR; PG8_MMA(1, 1, At, B1); PG8_BAR;
            PG8_LDB(B0, 1, 0); PG8_SCHED; PG8_LDA(At, 1, 0); PG8_STAGE(PG8_SA(0, 1), a2 + hstepA, voffA);
            PG8_WAIT_L(8); PG8_BAR; PG8_WAIT_L(0); PG8_MMA(0, 0, At, B0); PG8_BAR; PG8_SCHED;
            PG8_LDB(B1, 1, 1); PG8_STAGE(PG8_SB(1, 0), b3, voffB);
            PG8_BAR; PG8_WAIT_L(0); PG8_MMA(0, 1, At, B1); PG8_BAR;
            PG8_LDA(At, 1, 1); PG8_STAGE(PG8_SA(1, 0), a3, voffA);
            PG8_BAR; PG8_WAIT_L(0); PG8_MMA(1, 0, At, B0); PG8_BAR; PG8_SCHED;
            PG8_STAGE(PG8_SB(1, 1), b3 + hstepB, voffB);
            PG8_WAIT_V(6); PG8_BAR; PG8_MMA(1, 1, At, B1); PG8_BAR;
        }
        E(acc, cur, wr, wc, fr, fq);
        if (!has_next) break;
#pragma unroll
        for (int a = 0; a < 2; ++a)
#pragma unroll
            for (int b = 0; b < 2; ++b)
#pragma unroll
                for (int m = 0; m < 4; ++m)
#pragma unroll
                    for (int n = 0; n < 2; ++n) acc[a][b][m][n] = (f32x4){0.f, 0.f, 0.f, 0.f};
        cur = nxt; cA = nA; cB = nB; ++ui;
    }
    PG8_WAIT_V(0);
    if (wr == 0) PG8_BAR;
    PG8_BAR;
#undef PG8_KA
#undef PG8_KB
#undef PG8_SA
#undef PG8_SB
#undef PG8_STAGE
#undef PG8_LDA
#undef PG8_LDB
#undef PG8_MMA
#undef PG8_WAIT_V
#undef PG8_WAIT_L
#undef PG8_BAR
#undef PG8_SCHED
}
}
using pg8::Unit; using pg8::Gemm;
#define ACC_T const f32x4 (&acc)[2][2][4][2]

enum { K_TOK = 0, K_HYIN = 1, K_F0 = 2, K_FNA = 3, K_FNB = 4, K_BR = 5, K_OUT = 6, K_IN = 7 };
struct SchedAny {
    int kind, G, c;
    __device__ __forceinline__ bool next(int i, Unit& u) const {
        const long Lx = (long)i * G + c;
        switch (kind) {
        case K_IN: {
            if (Lx < 3120) { int pn; pg8::tile_map((int)Lx, 65, 48, u.pm, pn); u.pn = pn < 4 ? 12 + pn : 16 + pn; u.aux = K_TOK;
                u.offA = OFF_XN + (size_t)u.pm * 256 * DM * 2; u.offB = OFF_WT + (size_t)u.pn * 256 * DM * 2; return true; }
            if (Lx < 3900) { pg8::tile_map((int)Lx - 3120, 12, 65, u.pm, u.pn); u.aux = K_HYIN;
                u.offA = OFF_WT + (size_t)u.pm * 256 * DM * 2; u.offB = OFF_XN + (size_t)u.pn * 256 * DM * 2; return true; }
            if (Lx < 4500) { pg8::tile_map((int)Lx - 3900, 8, 75, u.pm, u.pn); u.aux = K_F0;
                u.offA = OFF_WEFF + (size_t)u.pm * 256 * DM * 2; u.offB = OFF_XNP + (size_t)u.pn * 256 * DM * 2; return true; }
            return false; }
        case K_TOK: {
            if (Lx >= 65l * 48) return false; int pn; pg8::tile_map((int)Lx, 65, 48, u.pm, pn); u.pn = pn < 4 ? 12 + pn : 16 + pn; u.aux = 0;
            u.offA = OFF_XN + (size_t)u.pm * 256 * DM * 2; u.offB = OFF_WT + (size_t)u.pn * 256 * DM * 2; return true; }
        case K_HYIN: {
            if (Lx >= 12l * 65) return false; pg8::tile_map((int)Lx, 12, 65, u.pm, u.pn); u.aux = 0;
            u.offA = OFF_WT + (size_t)u.pm * 256 * DM * 2; u.offB = OFF_XN + (size_t)u.pn * 256 * DM * 2; return true; }
        case K_F0: {
            if (Lx >= 8l * 75) return false; pg8::tile_map((int)Lx, 8, 75, u.pm, u.pn); u.aux = 0;
            u.offA = OFF_WEFF + (size_t)u.pm * 256 * DM * 2; u.offB = OFF_XNP + (size_t)u.pn * 256 * DM * 2; return true; }
        case K_FNA: {
            if (Lx >= 2l * 400) return false; pg8::tile_map((int)Lx, 2, 400, u.pm, u.pn); u.aux = 0;
            u.offA = OFF_FA + (size_t)u.pm * 256 * 384 * 2; u.offB = OFF_ZT + (size_t)u.pn * 256 * FN1P * 2; return true; }
        case K_FNB: {
            if (Lx >= 164l * 4) return false; u.aux = (int)(Lx >> 2); u.pm = 0; u.pn = (int)(Lx & 3);
            u.offA = OFF_FB + (size_t)u.aux * 256 * 256 * 2; u.offB = OFF_A1 + (size_t)u.aux * 1024 * 256 * 2 + (size_t)u.pn * 256 * 256 * 2; return true; }
        case K_BR: {
            const int T = (i / 3) * G + c; if (T >= 64 * 8) return false; const int br = i % 3; pg8::tile_map(T, 64, 8, u.pm, u.pn); u.aux = br;
            u.offA = OFF_GATE + (size_t)br * SZ_GATE + (size_t)u.pm * 256 * 1024 * 2; u.offB = OFF_WA + (size_t)br * SZ_WBR + (size_t)u.pn * 256 * 1024 * 2; return true; }
        default: {
            if (Lx >= 64l * 8) return false; pg8::tile_map((int)Lx, 64, 8, u.pm, u.pn); u.aux = 0;
            u.offA = OFF_M + (size_t)u.pm * 256 * DM * 2; u.offB = OFF_WO + (size_t)u.pn * 256 * DM * 2; return true; }
        }
    }
};
#define ROWFENCE asm volatile("" ::: "memory")
#define HARDFENCE do { asm volatile("" ::: "memory"); __builtin_amdgcn_sched_barrier(0); } while (0)
struct EpiAny {
    int kind; unsigned char* ws;
    __device__ __forceinline__ void operator()(ACC_T, const Unit& u, int wr, int wc, int fr, int fq) const {
        const int rl0 = wr * 64 + fr, cl0 = wc * 32 + 8 * fq;
        const int ek = kind == K_IN ? u.aux : kind;
        if (ek == K_TOK) {
            const int t = u.pn; unsigned char* dst; unsigned ld; int c0, act;
            if (t < 16)      { dst = ws + OFF_GATE;               ld = 1024; c0 = (t - 12) * 256; act = 1; }
            else if (t < 24) { dst = ws + OFF_GATE + SZ_GATE;     ld = 1024; c0 = (t - 20) * 256; act = 1; }
            else if (t < 36) { dst = ws + OFF_QKV;                ld = 3072; c0 = (t - 24) * 256; act = 0; }
            else if (t < 40) { dst = ws + OFF_GATE + 2 * SZ_GATE; ld = 1024; c0 = (t - 36) * 256; act = 1; }
            else             { dst = ws + OFF_MERGE;              ld = 6144; c0 = (t - 40) * 256; act = 2; }
#pragma unroll
            for (int ai = 0; ai < 2; ++ai)
#pragma unroll
                for (int m = 0; m < 4; ++m) { const unsigned row = (unsigned)(u.pm * 256 + ai * 128 + m * 16 + rl0);
#pragma unroll
                    for (int bj = 0; bj < 2; ++bj) { const unsigned off = (row * ld + (unsigned)(c0 + bj * 128 + cl0)) * 2u; f32x4 v0 = acc[ai][bj][m][0], v1 = acc[ai][bj][m][1];
                        if (act == 1) {
#pragma unroll
                            for (int j = 0; j < 4; ++j) { v0[j] = silu_f(v0[j]); v1[j] = silu_f(v1[j]); } }
                        else if (act == 2) {
#pragma unroll
                            for (int j = 0; j < 4; ++j) { v0[j] = sigm_f(v0[j]); v1[j] = sigm_f(v1[j]); } }
                        u32x4 w; w.x = cvt_pk_bf16(v0[0], v0[1]); w.y = cvt_pk_bf16(v0[2], v0[3]); w.z = cvt_pk_bf16(v1[0], v1[1]); w.w = cvt_pk_bf16(v1[2], v1[3]);
                        *(u32x4*)(dst + off) = w; }
                    ROWFENCE; }
        } else if (ek == K_HYIN || ek == K_F0) {
            unsigned char* dst = ws + (ek == K_HYIN ? OFF_HYIN : OFF_ZT); const unsigned ld = ek == K_HYIN ? LP : PROWS;
#pragma unroll
            for (int ai = 0; ai < 2; ++ai)
#pragma unroll
                for (int m = 0; m < 4; ++m) { const unsigned row = (unsigned)(u.pm * 256 + ai * 128 + m * 16 + rl0);
#pragma unroll
                    for (int bj = 0; bj < 2; ++bj) { const unsigned off = (row * ld + (unsigned)(u.pn * 256 + bj * 128 + cl0)) * 2u; const f32x4 v0 = acc[ai][bj][m][0], v1 = acc[ai][bj][m][1];
                        u32x4 w; w.x = cvt_pk_bf16(v0[0], v0[1]); w.y = cvt_pk_bf16(v0[2], v0[3]); w.z = cvt_pk_bf16(v1[0], v1[1]); w.w = cvt_pk_bf16(v1[2], v1[3]);
                        *(u32x4*)(dst + off) = w; }
                    ROWFENCE; }
        } else if (ek == K_FNA) {
            unsigned char* dst = ws + OFF_A1;
#pragma unroll
            for (int ai = 0; ai < 2; ++ai)
#pragma unroll
                for (int m = 0; m < 4; ++m) { const int k1 = ai * 128 + m * 16 + rl0;
                    if (k1 < FN1) {
#pragma unroll
                        for (int bj = 0; bj < 2; ++bj)
#pragma unroll
                            for (int n = 0; n < 2; ++n) { const int col = u.pn * 256 + bj * 128 + cl0 + 4 * n; const int ch = col / FN2, l2 = col - ch * FN2; const f32x4 v = acc[ai][bj][m][n];
                                u32x2 w; w.x = cvt_pk_bf16(v[0], v[1]); w.y = cvt_pk_bf16(v[2], v[3]);
                                *(u32x2*)(dst + ((unsigned)((k1 * 1024 + ch) * 2 + u.pm) * 128u + (unsigned)l2) * 2u) = w; } }
                    ROWFENCE; }
        } else if (ek == K_FNB) {
            unsigned char* dst = ws + OFF_GATE + SZ_GATE; const float scale = 1.0f / sqrtf((float)L_TOK * 256.0f);
#pragma unroll
            for (int ai = 0; ai < 2; ++ai)
#pragma unroll
                for (int m = 0; m < 4; ++m) { const int k2 = ai * 128 + m * 16 + rl0;
                    if (k2 < FN2) { const unsigned row = (unsigned)(u.aux + FN1 * k2);
#pragma unroll
                        for (int bj = 0; bj < 2; ++bj) { const unsigned off = (row * 1024u + (unsigned)(u.pn * 256 + bj * 128 + cl0)) * 2u; const u32x4 g = *(const u32x4*)(dst + off);
                            const f32x4 v0 = acc[ai][bj][m][0] * scale, v1 = acc[ai][bj][m][1] * scale;
                            u32x4 w; w.x = cvt_pk_bf16(v0[0] * lo_bf(g.x), v0[1] * hi_bf(g.x)); w.y = cvt_pk_bf16(v0[2] * lo_bf(g.y), v0[3] * hi_bf(g.y));
                            w.z = cvt_pk_bf16(v1[0] * lo_bf(g.z), v1[1] * hi_bf(g.z)); w.w = cvt_pk_bf16(v1[2] * lo_bf(g.w), v1[3] * hi_bf(g.w));
                            *(u32x4*)(dst + off) = w; } }
                    ROWFENCE; }
        } else if (ek == K_BR) {
            unsigned char* dst = ws + OFF_M; const unsigned char* mg = ws + OFF_MERGE; const int br = u.aux;
#pragma unroll
            for (int ai = 0; ai < 2; ++ai)
#pragma unroll
                for (int m = 0; m < 4; ++m) { const unsigned row = (unsigned)(u.pm * 256 + ai * 128 + m * 16 + rl0);
#pragma unroll
                    for (int bj = 0; bj < 2; ++bj) { const unsigned col = (unsigned)(u.pn * 256 + bj * 128 + cl0); const unsigned off = (row * (unsigned)DM + col) * 2u;
                        const u32x4 g = *(const u32x4*)(mg + (row * 6144u + (unsigned)br * 2048u + col) * 2u); const f32x4 v0 = acc[ai][bj][m][0], v1 = acc[ai][bj][m][1];
                        float r0 = v0[0] * lo_bf(g.x), r1 = v0[1] * hi_bf(g.x), r2 = v0[2] * lo_bf(g.y), r3 = v0[3] * hi_bf(g.y), r4 = v1[0] * lo_bf(g.z), r5 = v1[1] * hi_bf(g.z), r6 = v1[2] * lo_bf(g.w), r7 = v1[3] * hi_bf(g.w);
                        if (br > 0) { const u32x4 o = *(const u32x4*)(dst + off); r0 += lo_bf(o.x); r1 += hi_bf(o.x); r2 += lo_bf(o.y); r3 += hi_bf(o.y); r4 += lo_bf(o.z); r5 += hi_bf(o.z); r6 += lo_bf(o.w); r7 += hi_bf(o.w); }
                        u32x4 w; w.x = cvt_pk_bf16(r0, r1); w.y = cvt_pk_bf16(r2, r3); w.z = cvt_pk_bf16(r4, r5); w.w = cvt_pk_bf16(r6, r7);
                        *(u32x4*)(dst + off) = w; }
                    ROWFENCE; }
        } else {
            unsigned char* dst = ws + OFF_H;
#pragma unroll
            for (int ai = 0; ai < 2; ++ai)
#pragma unroll
                for (int m = 0; m < 4; ++m) { const unsigned row = (unsigned)(u.pm * 256 + ai * 128 + m * 16 + rl0);
#pragma unroll
                    for (int bj = 0; bj < 2; ++bj) { const unsigned off = (row * (unsigned)DM + (unsigned)(u.pn * 256 + bj * 128 + cl0)) * 4u;
                        const f32x4 o0 = *(const f32x4*)(dst + off), o1 = *(const f32x4*)(dst + off + 16);
                        *(f32x4*)(dst + off) = o0 + acc[ai][bj][m][0]; *(f32x4*)(dst + off + 16) = o1 + acc[ai][bj][m][1]; }
                    ROWFENCE; }
        }
    }
};

__device__ void phase_prep0(const Params& p, unsigned char* smem) {
    const int tid = opaque_tid(), bid = blockIdx.x, G = gridDim.x;
    const size_t gtid = (size_t)bid * NTHREADS + tid, gstride = (size_t)G * NTHREADS;
    { f32x4* h4 = (f32x4*)(p.ws + OFF_H); const f32x4* x4 = (const f32x4*)p.x; const f32x4* m4 = (const f32x4*)p.meta;
      for (size_t i = gtid; i < (size_t)LP * 512; i += gstride) { const size_t row = i >> 9; f32x4 v = (f32x4){0.f, 0.f, 0.f, 0.f};
          if (row < NMETA) v = m4[i]; else if (row < L_TOK) v = x4[i - (size_t)NMETA * 512]; h4[i] = v; } }
    { bf16_t* fa = (bf16_t*)(p.ws + OFF_FA);
      for (size_t i = gtid; i < (size_t)512 * 384; i += gstride) { const int row = (int)(i / 384), col = (int)(i % 384); const int po = row >> 8, k1 = row & 255, pi = col / 192, l1 = col % 192; float v = 0.f;
          if (k1 < FN1 && l1 < FN1) { const int r = (k1 * l1) % FN1; const float a = 2.0f * (float)r / (float)FN1; const float cs = cospif(a), sn = sinpif(a);
              v = (po == 0) ? (pi == 0 ? cs : sn) : (pi == 0 ? -sn : cs); }
          fa[i] = f2bf(v); } }
    { bf16_t* fb = (bf16_t*)(p.ws + OFF_FB);
      for (size_t i = gtid; i < (size_t)FN1 * 65536; i += gstride) { const int k1 = (int)(i >> 16), k2 = (int)((i >> 8) & 255), kk = (int)(i & 255), part = kk >> 7, l2 = kk & 127; float v = 0.f;
          if (k2 < FN2 && l2 < FN2) { const int lp = k1 + FN1 * k2; const int r = (l2 * lp) % L_TOK; const float a = 2.0f * (float)r / (float)L_TOK; v = part == 0 ? cospif(a) : sinpif(a); }
          fb[i] = f2bf(v); } }
    { float* w1s = (float*)smem;
      float* w2s = w1s + 33 * 64;
      float* w3s = w2s + 64 * 64;
      const int lane = tid & 63, wv = tid >> 6;
      for (int layer = 0; layer < 2; ++layer) {
          __syncthreads();
          for (int i = tid; i < 33 * 64; i += NTHREADS) w1s[i] = p.f_w1[layer * 33 * 64 + i];
          for (int i = tid; i < 64 * 64; i += NTHREADS) { w2s[i] = p.f_w2[layer * 4096 + i]; w3s[i] = p.f_w3[layer * 4096 + i]; }
          __syncthreads();
          const float b1 = p.f_b1[layer * 64 + lane], b2 = p.f_b2[layer * 64 + lane], b3 = p.f_b3[layer * 64 + lane], fr = p.f_freq[layer * 64 + lane];
          bf16_t* h3 = (bf16_t*)(p.ws + OFF_H3) + (size_t)layer * L_TOK * 64;
          for (int lag = bid * 8 + wv; lag < L_TOK; lag += G * 8) {
              const float tt = (float)lag / (float)(L_TOK - 1); const float w = 6.283185307179586f * (float)lag / (float)L_TOK;
              float z = 0.f;
              if (lane == 0) z = tt;
              else if (lane < 33) { const int j = (lane - 1) & 15; const float f = 1e-4f + (float)j * ((15.0f - 1e-4f) / 15.0f); const float a = f * w; z = lane < 17 ? cosf(a) : -sinf(a); }
              float a1 = b1;
#pragma unroll 3
              for (int i = 0; i < 33; ++i) a1 += __shfl(z, i) * w1s[i * 64 + lane];
              const float h1 = sinf(fr * a1);
              float a2 = b2;
#pragma unroll 8
              for (int i = 0; i < 64; ++i) a2 += __shfl(h1, i) * w2s[i * 64 + lane];
              const float h2 = sinf(fr * a2);
              float a3 = b3;
#pragma unroll 8
              for (int i = 0; i < 64; ++i) a3 += __shfl(h2, i) * w3s[i * 64 + lane];
              h3[(size_t)lag * 64 + lane] = f2bf(sinf(fr * a3));
          }
      }
      __syncthreads(); }
}

__device__ __forceinline__ void convert_tile(const float* src, int K, int N, bf16_t* dst, int kt, int nt_, float* tile  ) {
    const int tid = opaque_tid();
    __syncthreads();
#pragma unroll
    for (int ps = 0; ps < 2; ++ps) { const int kl = ps * 32 + (tid >> 4), n4 = (tid & 15) * 4;
        const f32x4 v = *(const f32x4*)(src + (size_t)(kt * 64 + kl) * N + nt_ * 64 + n4);
        tile[kl * 65 + n4] = v[0]; tile[kl * 65 + n4 + 1] = v[1]; tile[kl * 65 + n4 + 2] = v[2]; tile[kl * 65 + n4 + 3] = v[3]; }
    __syncthreads();
    const int nl = tid >> 3, k8 = (tid & 7) * 8;
    u32x4 w; w.x = cvt_pk_bf16(tile[(k8 + 0) * 65 + nl], tile[(k8 + 1) * 65 + nl]); w.y = cvt_pk_bf16(tile[(k8 + 2) * 65 + nl], tile[(k8 + 3) * 65 + nl]);
    w.z = cvt_pk_bf16(tile[(k8 + 4) * 65 + nl], tile[(k8 + 5) * 65 + nl]); w.w = cvt_pk_bf16(tile[(k8 + 6) * 65 + nl], tile[(k8 + 7) * 65 + nl]);
    *(u32x4*)(dst + (size_t)(nt_ * 64 + nl) * K + kt * 64 + k8) = w;
}

__device__ void phase_p1(const Params& p, int layer, unsigned char* smem) {
    const int tid = opaque_tid(), bid = blockIdx.x, G = gridDim.x;
    float* tile = (float*)smem;
    { const float* win = p.w_in + (size_t)layer * DM * NIN;
      for (int t = bid; t < 32 * 256; t += G) convert_tile(win, DM, NIN, (bf16_t*)(p.ws + OFF_WT), t & 31, t >> 5, tile);
      for (int br = 0; br < 3; ++br) { const float* wsrc = (br == 0 ? p.w_a : br == 1 ? p.w_b : p.w_c) + (size_t)layer * 1024 * DM;
          for (int t = bid; t < 16 * 32; t += G) convert_tile(wsrc, 1024, DM, (bf16_t*)(p.ws + OFF_WA + br * SZ_WBR), t & 15, t >> 4, tile); }
      const float* wo = p.w_out + (size_t)layer * DM * DM;
      for (int t = bid; t < 32 * 32; t += G) convert_tile(wo, DM, DM, (bf16_t*)(p.ws + OFF_WO), t & 31, t >> 5, tile);
      __syncthreads(); }
    { float* tileT = (float*)smem;
      float* ctab = tileT + 256 * 32;
      float* stab = ctab + 256;
      const float* win = p.w_in + (size_t)layer * DM * NIN;
      for (int t = bid; t < 256; t += G) { const int g = t >> 6, k0 = (t & 63) * 32;
          __syncthreads();
          if (tid < 256) { const float a = 2.0f * (float)tid / 256.0f; ctab[tid] = cospif(a); stab[tid] = sinpif(a); }
#pragma unroll
          for (int ps = 0; ps < 4; ++ps) { const int idx = ps * NTHREADS + tid; const int kl = idx >> 6, c4 = (idx & 63) * 4;
              const f32x4 v = *(const f32x4*)(win + (size_t)(k0 + kl) * NIN + 4096 + g * 256 + c4);
              tileT[(c4 + 0) * 32 + kl] = v[0]; tileT[(c4 + 1) * 32 + kl] = v[1]; tileT[(c4 + 2) * 32 + kl] = v[2]; tileT[(c4 + 3) * 32 + kl] = v[3]; }
          __syncthreads();
          const int cp = tid & 255, part = tid >> 8;
          float acc[32];
#pragma unroll
          for (int k = 0; k < 32; ++k) acc[k] = 0.f;
          for (int c = 0; c < 256; ++c) { const int r = (c * cp) & 255; const float tw = part == 0 ? ctab[r] : -stab[r];
#pragma unroll
              for (int k4 = 0; k4 < 8; ++k4) { const f32x4 v = *(const f32x4*)(tileT + c * 32 + k4 * 4); acc[k4 * 4 + 0] += v[0] * tw; acc[k4 * 4 + 1] += v[1] * tw; acc[k4 * 4 + 2] += v[2] * tw; acc[k4 * 4 + 3] += v[3] * tw; } }
          bf16_t* dst = (bf16_t*)(p.ws + OFF_WEFF) + (size_t)(part * 1024 + g * 256 + cp) * DM + k0;
#pragma unroll
          for (int k8 = 0; k8 < 4; ++k8) { u32x4 w; w.x = cvt_pk_bf16(acc[k8 * 8 + 0], acc[k8 * 8 + 1]); w.y = cvt_pk_bf16(acc[k8 * 8 + 2], acc[k8 * 8 + 3]); w.z = cvt_pk_bf16(acc[k8 * 8 + 4], acc[k8 * 8 + 5]); w.w = cvt_pk_bf16(acc[k8 * 8 + 6], acc[k8 * 8 + 7]);
              *(u32x4*)(dst + k8 * 8) = w; } }
      __syncthreads(); }
    { const int lane = tid & 63, wv = tid >> 6; const float* h = (const float*)(p.ws + OFF_H); const float* gam = p.norm_g + layer * DM;
      bf16_t* xn = (bf16_t*)(p.ws + OFF_XN); bf16_t* xnp = (bf16_t*)(p.ws + OFF_XNP);
      for (int l = bid * 8 + wv; l < LP; l += G * 8) {
          if (l < L_TOK) { const f32x4* row = (const f32x4*)(h + (size_t)l * DM); f32x4 v[8]; float ss = 0.f;
#pragma unroll
              for (int i = 0; i < 8; ++i) { v[i] = row[i * 64 + lane]; ss += v[i][0] * v[i][0] + v[i][1] * v[i][1] + v[i][2] * v[i][2] + v[i][3] * v[i][3]; }
              ss = wave_sum(ss); const float inv = rsqrtf(ss * (1.0f / DM) + 1e-6f);
              const int l1 = l / FN2, l2 = l - l1 * FN2; const size_t pr = (size_t)l2 * FN1P + l1;
#pragma unroll
              for (int i = 0; i < 8; ++i) { const f32x4 gg = ((const f32x4*)gam)[i * 64 + lane]; u32x2 w; w.x = cvt_pk_bf16(v[i][0] * inv * gg[0], v[i][1] * inv * gg[1]); w.y = cvt_pk_bf16(v[i][2] * inv * gg[2], v[i][3] * inv * gg[3]);
                  *(u32x2*)(xn + (size_t)l * DM + (i * 64 + lane) * 4) = w; *(u32x2*)(xnp + pr * DM + (i * 64 + lane) * 4) = w; } }
          else { const u32x2 z = (u32x2){0u, 0u};
#pragma unroll
              for (int i = 0; i < 8; ++i) *(u32x2*)(xn + (size_t)l * DM + (i * 64 + lane) * 4) = z; } }
      for (int idx = bid * 8 + wv; idx < FN2 * (FN1P - FN1); idx += G * 8) { const int l2 = idx / (FN1P - FN1), l1 = FN1 + idx % (FN1P - FN1); const size_t pr = (size_t)l2 * FN1P + l1; const u32x2 z = (u32x2){0u, 0u};
#pragma unroll
          for (int i = 0; i < 8; ++i) *(u32x2*)(xnp + pr * DM + (i * 64 + lane) * 4) = z; } }
}

__device__ void na_unit(const Params& p, int layer, int r, int hd, unsigned char* smem) {
    const int tid = opaque_tid(), j = tid >> 6, c = tid & 63;
    const bf16_t* qkv = (const bf16_t*)(p.ws + OFF_QKV);
    const int r0 = min(max(r - 4, 0), 248);
    unsigned char* sK = smem; unsigned char* sV = smem + 73728; unsigned char* sMK = smem + 147456; unsigned char* sMV = sMK + 2304;
    __syncthreads();
#pragma unroll
    for (int ps = 0; ps < 8; ++ps) { const int tok = ps * 64 + (tid >> 3), ch = tid & 7; const size_t g = (size_t)(NMETA + r0 * 64 + tok) * 3072 + hd * 64 + ch * 8;
        *(u32x4*)(sK + tok * 144 + ch * 16) = *(const u32x4*)(qkv + g + 1024); *(u32x4*)(sV + tok * 144 + ch * 16) = *(const u32x4*)(qkv + g + 2048); }
    if (tid < 128) { const int tok = tid >> 3, ch = tid & 7; const size_t g = (size_t)tok * 3072 + hd * 64 + ch * 8;
        *(u32x4*)(sMK + tok * 144 + ch * 16) = *(const u32x4*)(qkv + g + 1024); *(u32x4*)(sMV + tok * 144 + ch * 16) = *(const u32x4*)(qkv + g + 2048); }
    float q[64];
    { const u32x4* qp = (const u32x4*)(qkv + (size_t)(NMETA + r * 64 + c) * 3072 + hd * 64);
#pragma unroll
      for (int i = 0; i < 8; ++i) { const u32x4 v = qp[i]; q[i * 8 + 0] = lo_bf(v.x) * 0.125f; q[i * 8 + 1] = hi_bf(v.x) * 0.125f; q[i * 8 + 2] = lo_bf(v.y) * 0.125f; q[i * 8 + 3] = hi_bf(v.y) * 0.125f;
          q[i * 8 + 4] = lo_bf(v.z) * 0.125f; q[i * 8 + 5] = hi_bf(v.z) * 0.125f; q[i * 8 + 6] = lo_bf(v.w) * 0.125f; q[i * 8 + 7] = hi_bf(v.w) * 0.125f; } }
    __syncthreads();
    const int cs = min(max(c - 8, 0), 48);
    const float* rp = p.rpb + ((size_t)(layer * 16 + hd) * 15 + (r0 + j - r + 7)) * 31 + (cs - c + 15);
    const float* mb = p.meta_bias + (layer * 16 + hd) * 16 + 2 * j;
    float o[64];
#pragma unroll
    for (int i = 0; i < 64; ++i) o[i] = 0.f;
    float mx = -3.0e38f, lsum = 0.f;
#pragma unroll 1
    for (int i = 0; i < 18; ++i) {
        const int ko = i < 16 ? (j * 64 + cs + i) * 144 : 147456 + (2 * j + i - 16) * 144; const int vo = i < 16 ? ko + 73728 : ko + 2304;
        const float bias = i < 16 ? rp[i] : mb[i - 16];
        float d0 = 0.f, d1 = 0.f;
#pragma unroll
        for (int e = 0; e < 8; ++e) { const u32x4 v = *(const u32x4*)(smem + ko + e * 16);
            d0 += q[e * 8 + 0] * lo_bf(v.x) + q[e * 8 + 2] * lo_bf(v.y) + q[e * 8 + 4] * lo_bf(v.z) + q[e * 8 + 6] * lo_bf(v.w);
            d1 += q[e * 8 + 1] * hi_bf(v.x) + q[e * 8 + 3] * hi_bf(v.y) + q[e * 8 + 5] * hi_bf(v.z) + q[e * 8 + 7] * hi_bf(v.w); }
        const float sc = d0 + d1 + bias; const float mnew = fmaxf(mx, sc); const float alpha = __expf(mx - mnew), pi = __expf(sc - mnew);
        lsum = lsum * alpha + pi; mx = mnew;
#pragma unroll
        for (int e = 0; e < 8; ++e) { const u32x4 v = *(const u32x4*)(smem + vo + e * 16);
            o[e * 8 + 0] = o[e * 8 + 0] * alpha + pi * lo_bf(v.x); o[e * 8 + 1] = o[e * 8 + 1] * alpha + pi * hi_bf(v.x); o[e * 8 + 2] = o[e * 8 + 2] * alpha + pi * lo_bf(v.y); o[e * 8 + 3] = o[e * 8 + 3] * alpha + pi * hi_bf(v.y);
            o[e * 8 + 4] = o[e * 8 + 4] * alpha + pi * lo_bf(v.z); o[e * 8 + 5] = o[e * 8 + 5] * alpha + pi * hi_bf(v.z); o[e * 8 + 6] = o[e * 8 + 6] * alpha + pi * lo_bf(v.w); o[e * 8 + 7] = o[e * 8 + 7] * alpha + pi * hi_bf(v.w); }
    }
    __syncthreads();
    float* part = (float*)smem;
    { float* pp = part + (size_t)(j * 64 + c) * 67;
#pragma unroll
      for (int i = 0; i < 64; ++i) pp[i] = o[i];
      pp[64] = mx; pp[65] = lsum; }
    __syncthreads();
    { const int qc = tid >> 3, d0 = (tid & 7) * 8; float mj[8], M = -3.0e38f;
#pragma unroll
      for (int w = 0; w < 8; ++w) { mj[w] = part[(size_t)(w * 64 + qc) * 67 + 64]; M = fmaxf(M, mj[w]); }
      float Lsum = 0.f, o[8];
#pragma unroll
      for (int e = 0; e < 8; ++e) o[e] = 0.f;
#pragma unroll
      for (int w = 0; w < 8; ++w) { const float f = __expf(mj[w] - M); const float* pp = part + (size_t)(w * 64 + qc) * 67; Lsum += f * pp[65];
#pragma unroll
          for (int e = 0; e < 8; ++e) o[e] += f * pp[d0 + e]; }
      const float inv = 1.0f / Lsum;
      bf16_t* gp = (bf16_t*)(p.ws + OFF_GATE + 2 * SZ_GATE) + (size_t)(NMETA + r * 64 + qc) * 1024 + hd * 64 + d0;
      const u32x4 g = *(const u32x4*)gp;
      u32x4 w; w.x = cvt_pk_bf16(o[0] * inv * lo_bf(g.x), o[1] * inv * hi_bf(g.x)); w.y = cvt_pk_bf16(o[2] * inv * lo_bf(g.y), o[3] * inv * hi_bf(g.y));
      w.z = cvt_pk_bf16(o[4] * inv * lo_bf(g.z), o[5] * inv * hi_bf(g.z)); w.w = cvt_pk_bf16(o[6] * inv * lo_bf(g.w), o[7] * inv * hi_bf(g.w));
      *(u32x4*)gp = w; }
}
__device__ void na_meta_unit(const Params& p, int layer) {
    const int tid = opaque_tid();
    if (tid < 256) { const int hd = tid >> 4, qi = tid & 15; const bf16_t* qkv = (const bf16_t*)(p.ws + OFF_QKV);
        float q[64];
        { const u32x4* qp = (const u32x4*)(qkv + (size_t)qi * 3072 + hd * 64);
#pragma unroll
          for (int i = 0; i < 8; ++i) { const u32x4 v = qp[i]; q[i * 8 + 0] = lo_bf(v.x) * 0.125f; q[i * 8 + 1] = hi_bf(v.x) * 0.125f; q[i * 8 + 2] = lo_bf(v.y) * 0.125f; q[i * 8 + 3] = hi_bf(v.y) * 0.125f;
              q[i * 8 + 4] = lo_bf(v.z) * 0.125f; q[i * 8 + 5] = hi_bf(v.z) * 0.125f; q[i * 8 + 6] = lo_bf(v.w) * 0.125f; q[i * 8 + 7] = hi_bf(v.w) * 0.125f; } }
        float o[64];
#pragma unroll
        for (int i = 0; i < 64; ++i) o[i] = 0.f;
        float mx = -3.0e38f, lsum = 0.f;
#pragma unroll 1
        for (int m = 0; m < 16; ++m) { const u32x4* kp = (const u32x4*)(qkv + (size_t)m * 3072 + 1024 + hd * 64); const u32x4* vp = (const u32x4*)(qkv + (size_t)m * 3072 + 2048 + hd * 64);
            float d0 = 0.f, d1 = 0.f;
#pragma unroll
            for (int e = 0; e < 8; ++e) { const u32x4 v = kp[e];
                d0 += q[e * 8 + 0] * lo_bf(v.x) + q[e * 8 + 2] * lo_bf(v.y) + q[e * 8 + 4] * lo_bf(v.z) + q[e * 8 + 6] * lo_bf(v.w);
                d1 += q[e * 8 + 1] * hi_bf(v.x) + q[e * 8 + 3] * hi_bf(v.y) + q[e * 8 + 5] * hi_bf(v.z) + q[e * 8 + 7] * hi_bf(v.w); }
            const float sc = d0 + d1 + p.meta_bias[(layer * 16 + hd) * 16 + m]; const float mnew = fmaxf(mx, sc); const float alpha = __expf(mx - mnew), pi = __expf(sc - mnew);
            lsum = lsum * alpha + pi; mx = mnew;
#pragma unroll
            for (int e = 0; e < 8; ++e) { const u32x4 v = vp[e];
                o[e * 8 + 0] = o[e * 8 + 0] * alpha + pi * lo_bf(v.x); o[e * 8 + 1] = o[e * 8 + 1] * alpha + pi * hi_bf(v.x); o[e * 8 + 2] = o[e * 8 + 2] * alpha + pi * lo_bf(v.y); o[e * 8 + 3] = o[e * 8 + 3] * alpha + pi * hi_bf(v.y);
                o[e * 8 + 4] = o[e * 8 + 4] * alpha + pi * lo_bf(v.z); o[e * 8 + 5] = o[e * 8 + 5] * alpha + pi * hi_bf(v.z); o[e * 8 + 6] = o[e * 8 + 6] * alpha + pi * lo_bf(v.w); o[e * 8 + 7] = o[e * 8 + 7] * alpha + pi * hi_bf(v.w); } }
        const float inv = 1.0f / lsum; u32x4* gp = (u32x4*)((bf16_t*)(p.ws + OFF_GATE + 2 * SZ_GATE) + (size_t)qi * 1024 + hd * 64);
#pragma unroll
        for (int e = 0; e < 8; ++e) { const u32x4 g = gp[e]; u32x4 w;
            w.x = cvt_pk_bf16(o[e * 8 + 0] * inv * lo_bf(g.x), o[e * 8 + 1] * inv * hi_bf(g.x)); w.y = cvt_pk_bf16(o[e * 8 + 2] * inv * lo_bf(g.y), o[e * 8 + 3] * inv * hi_bf(g.y));
            w.z = cvt_pk_bf16(o[e * 8 + 4] * inv * lo_bf(g.z), o[e * 8 + 5] * inv * hi_bf(g.z)); w.w = cvt_pk_bf16(o[e * 8 + 6] * inv * lo_bf(g.w), o[e * 8 + 7] * inv * hi_bf(g.w));
            gp[e] = w; } }
}

__device__ __forceinline__ unsigned rev4_14(unsigned k) { unsigned r = __brev(k) >> 18; return ((r & 0x1555u) << 1) | ((r >> 1) & 0x1555u); }
__device__ __forceinline__ float2 cmul(float2 a, float2 b) { return make_float2(a.x * b.x - a.y * b.y, a.x * b.y + a.y * b.x); }
#define PADI(i) ((i) + ((i) >> 4))
#define CFF(n) cff[2 * PADI((n) >> 1) + ((n) & 1)]
__device__ __forceinline__ void hw_sincos(float rev, float& sn, float& cs) { sn = __builtin_amdgcn_sinf(rev); cs = __builtin_amdgcn_cosf(rev); }
__device__ __forceinline__ float c16(int k) { const float t[10] = {1.0f, 0.9238795325f, 0.7071067812f, 0.3826834324f, 0.0f, -0.3826834324f, -0.7071067812f, -0.9238795325f, -1.0f, -0.9238795325f}; return t[k]; }
__device__ __forceinline__ float s16(int k) { const float t[10] = {0.0f, 0.3826834324f, 0.7071067812f, 0.9238795325f, 1.0f, 0.9238795325f, 0.7071067812f, 0.3826834324f, 0.0f, -0.3826834324f}; return t[k]; }
__device__ void fft_fwd(float2* a) {
    for (int span = 4096; span >= 16; span >>= 2) {
        for (int b = opaque_tid(); b < 4096; b += NTHREADS) { const int j = b & (span - 1); const int base = ((b - j) << 2) + j;
            const int i0 = PADI(base), i1 = PADI(base + span), i2 = PADI(base + 2 * span), i3 = PADI(base + 3 * span);
            const float2 a0 = a[i0], a1 = a[i1], a2 = a[i2], a3 = a[i3];
            const float2 t0 = make_float2(a0.x + a2.x, a0.y + a2.y), t1 = make_float2(a0.x - a2.x, a0.y - a2.y), t2 = make_float2(a1.x + a3.x, a1.y + a3.y);
            const float2 t3 = make_float2(a1.y - a3.y, -(a1.x - a3.x));
            float sn, cs; hw_sincos((float)j / (float)(4 * span), sn, cs);
            const float2 w1 = make_float2(cs, -sn), w2 = cmul(w1, w1), w3 = cmul(w2, w1);
            a[i0] = make_float2(t0.x + t2.x, t0.y + t2.y);
            a[i1] = cmul(make_float2(t1.x + t3.x, t1.y + t3.y), w1);
            a[i2] = cmul(make_float2(t0.x - t2.x, t0.y - t2.y), w2);
            a[i3] = cmul(make_float2(t1.x - t3.x, t1.y - t3.y), w3); }
        __syncthreads(); }
    for (int blk = opaque_tid(); blk < 1024; blk += NTHREADS) { float2* pb = a + blk * 17; float2 x[16];
#pragma unroll
        for (int e = 0; e < 16; ++e) x[e] = pb[e];
#pragma unroll
        for (int j = 0; j < 4; ++j) { const float2 a0 = x[j], a1 = x[j + 4], a2 = x[j + 8], a3 = x[j + 12];
            const float2 t0 = make_float2(a0.x + a2.x, a0.y + a2.y), t1 = make_float2(a0.x - a2.x, a0.y - a2.y), t2 = make_float2(a1.x + a3.x, a1.y + a3.y), t3 = make_float2(a1.y - a3.y, -(a1.x - a3.x));
            x[j] = make_float2(t0.x + t2.x, t0.y + t2.y);
            x[j + 4] = cmul(make_float2(t1.x + t3.x, t1.y + t3.y), make_float2(c16(j), -s16(j)));
            x[j + 8] = cmul(make_float2(t0.x - t2.x, t0.y - t2.y), make_float2(c16(2 * j), -s16(2 * j)));
            x[j + 12] = cmul(make_float2(t1.x - t3.x, t1.y - t3.y), make_float2(c16(3 * j), -s16(3 * j))); }
#pragma unroll
        for (int g = 0; g < 4; ++g) { const float2 a0 = x[4 * g], a1 = x[4 * g + 1], a2 = x[4 * g + 2], a3 = x[4 * g + 3];
            const float2 t0 = make_float2(a0.x + a2.x, a0.y + a2.y), t1 = make_float2(a0.x - a2.x, a0.y - a2.y), t2 = make_float2(a1.x + a3.x, a1.y + a3.y), t3 = make_float2(a1.y - a3.y, -(a1.x - a3.x));
            x[4 * g] = make_float2(t0.x + t2.x, t0.y + t2.y); x[4 * g + 1] = make_float2(t1.x + t3.x, t1.y + t3.y);
            x[4 * g + 2] = make_float2(t0.x - t2.x, t0.y - t2.y); x[4 * g + 3] = make_float2(t1.x - t3.x, t1.y - t3.y); }
#pragma unroll
        for (int e = 0; e < 16; ++e) pb[e] = x[e]; }
    __syncthreads();
}
__device__ void fft_inv(float2* a) {
    for (int blk = opaque_tid(); blk < 1024; blk += NTHREADS) { float2* pb = a + blk * 17; float2 x[16];
#pragma unroll
        for (int e = 0; e < 16; ++e) x[e] = pb[e];
#pragma unroll
        for (int g = 0; g < 4; ++g) { const float2 a0 = x[4 * g], a1 = x[4 * g + 1], a2 = x[4 * g + 2], a3 = x[4 * g + 3];
            const float2 t0 = make_float2(a0.x + a2.x, a0.y + a2.y), t1 = make_float2(a0.x - a2.x, a0.y - a2.y), t2 = make_float2(a1.x + a3.x, a1.y + a3.y), t3 = make_float2(-(a1.y - a3.y), a1.x - a3.x);
            x[4 * g] = make_float2(t0.x + t2.x, t0.y + t2.y); x[4 * g + 1] = make_float2(t1.x + t3.x, t1.y + t3.y);
            x[4 * g + 2] = make_float2(t0.x - t2.x, t0.y - t2.y); x[4 * g + 3] = make_float2(t1.x - t3.x, t1.y - t3.y); }
#pragma unroll
        for (int j = 0; j < 4; ++j) { const float2 a0 = x[j], a1 = cmul(x[j + 4], make_float2(c16(j), s16(j))), a2 = cmul(x[j + 8], make_float2(c16(2 * j), s16(2 * j))), a3 = cmul(x[j + 12], make_float2(c16(3 * j), s16(3 * j)));
            const float2 t0 = make_float2(a0.x + a2.x, a0.y + a2.y), t1 = make_float2(a0.x - a2.x, a0.y - a2.y), t2 = make_float2(a1.x + a3.x, a1.y + a3.y), t3 = make_float2(-(a1.y - a3.y), a1.x - a3.x);
            x[j] = make_float2(t0.x + t2.x, t0.y + t2.y); x[j + 4] = make_float2(t1.x + t3.x, t1.y + t3.y);
            x[j + 8] = make_float2(t0.x - t2.x, t0.y - t2.y); x[j + 12] = make_float2(t1.x - t3.x, t1.y - t3.y); }
#pragma unroll
        for (int e = 0; e < 16; ++e) pb[e] = x[e]; }
    __syncthreads();
    for (int span = 16; span <= 4096; span <<= 2) {
        for (int b = opaque_tid(); b < 4096; b += NTHREADS) { const int j = b & (span - 1); const int base = ((b - j) << 2) + j;
            const int i0 = PADI(base), i1 = PADI(base + span), i2 = PADI(base + 2 * span), i3 = PADI(base + 3 * span);
            float sn, cs; hw_sincos((float)j / (float)(4 * span), sn, cs);
            const float2 w1 = make_float2(cs, sn), w2 = cmul(w1, w1), w3 = cmul(w2, w1);
            const float2 a0 = a[i0], a1 = cmul(a[i1], w1), a2 = cmul(a[i2], w2), a3 = cmul(a[i3], w3);
            const float2 t0 = make_float2(a0.x + a2.x, a0.y + a2.y), t1 = make_float2(a0.x - a2.x, a0.y - a2.y), t2 = make_float2(a1.x + a3.x, a1.y + a3.y);
            const float2 t3 = make_float2(-(a1.y - a3.y), a1.x - a3.x);
            a[i0] = make_float2(t0.x + t2.x, t0.y + t2.y);
            a[i1] = make_float2(t1.x + t3.x, t1.y + t3.y);
            a[i2] = make_float2(t0.x - t2.x, t0.y - t2.y);
            a[i3] = make_float2(t1.x - t3.x, t1.y - t3.y); }
        __syncthreads(); }
}
__device__ __forceinline__ void hy_val8(const bf16_t* __restrict__ row, int t0, const float (&w)[4], float (&o)[8]) {
    const u32x4 v = *(const u32x4*)(row + t0);
    float x[10];
    x[0] = t0 > 0 ? bf2f(row[t0 - 1]) : 0.f; x[9] = (t0 + 8 < L_TOK) ? bf2f(row[t0 + 8]) : 0.f;
    x[1] = lo_bf(v.x); x[2] = hi_bf(v.x); x[3] = lo_bf(v.y); x[4] = hi_bf(v.y); x[5] = lo_bf(v.z); x[6] = hi_bf(v.z); x[7] = lo_bf(v.w); x[8] = hi_bf(v.w);
#pragma unroll
    for (int e = 0; e < 8; ++e) o[e] = w[0] * x[e] + w[1] * x[e + 1] + w[2] * x[e + 2] + w[3];
}
struct HyCh { const bf16_t* __restrict__ ru; const bf16_t* __restrict__ r1; const bf16_t* __restrict__ r2; float wu[4], w1[4], w2[4]; };

constexpr int SD_W4B = 0  , SD_GFX = 512, SD_GBX = 528, SD_EF = 544, SD_EB = 560, SD_VH = 576, SD_VT = 592, SD_END = 608;
constexpr int NCHUNK = L_TOK / 8;

template <int ORDER>
__device__ void hy_conv(const HyCh& hc, float2* cf, float* side, unsigned char* scratch) {
    const int tid = opaque_tid(); float* cff = (float*)cf;
    f32x4* __restrict__ heo = (f32x4*)(scratch + HS_HEO); const float* __restrict__ z2g = (const float*)(scratch + HS_Z2);
    if (tid < 15) side[SD_EF + tid] = CFF(16369 + tid); else if (tid >= 32 && tid < 47) side[SD_EB + tid - 32] = CFF(32768 - (16369 + tid - 32));
    __syncthreads();
    fft_fwd(cf);
    for (int k = tid; k <= 8192; k += NTHREADS) { const int kp = (16384 - k) & 16383; const float2 a = cf[PADI(rev4_14(k))], bq = cf[PADI(rev4_14(kp))];
        const float bx = bq.x, by = -bq.y; const float sc = 1.0f / 16384.0f;
        heo[k] = (f32x4){0.5f * (a.x + bx) * sc, 0.5f * (a.y + by) * sc, 0.5f * (a.y - by) * sc, -0.5f * (a.x - bx) * sc}; }
    __syncthreads();
    for (int c = tid; c < NCHUNK; c += NTHREADS) { float v[8];
        if (ORDER == 0) hy_val8(hc.ru, 8 * c, hc.wu, v);
        else { const f32x4 p0 = *(const f32x4*)(z2g + 8 * c), p1 = *(const f32x4*)(z2g + 8 * c + 4); v[0] = p0[0]; v[1] = p0[1]; v[2] = p0[2]; v[3] = p0[3]; v[4] = p1[0]; v[5] = p1[1]; v[6] = p1[2]; v[7] = p1[3]; }
        float2* d = cf + PADI(4 * c); d[0] = make_float2(v[0], v[1]); d[1] = make_float2(v[2], v[3]); d[2] = make_float2(v[4], v[5]); d[3] = make_float2(v[6], v[7]);
        if (c < 2) {
#pragma unroll
            for (int e = 0; e < 8; ++e) side[SD_VH + 8 * c + e] = v[e]; }
        if (c >= NCHUNK - 2) {
#pragma unroll
            for (int e = 0; e < 8; ++e) side[SD_VT + 8 * (c - (NCHUNK - 2)) + e] = v[e]; } }
    for (int i = L_TOK / 2 + tid; i < 16384; i += NTHREADS) cf[PADI(i)] = make_float2(0.f, 0.f);
    __syncthreads();
    fft_fwd(cf);
#pragma unroll 4
    for (int k = tid; k <= 8192; k += NTHREADS) { const int kp = (16384 - k) & 16383; const unsigned ik = PADI(rev4_14(k)), ikp = PADI(rev4_14(kp)); const float2 a = cf[ik], bq = cf[ikp];
        const float bx = bq.x, by = -bq.y;
        const float2 XE = make_float2(0.5f * (a.x + bx), 0.5f * (a.y + by)), XO = make_float2(0.5f * (a.y - by), -0.5f * (a.x - bx));
        const f32x4 hh = heo[k]; const float2 HE = make_float2(hh[0], hh[1]), HO = make_float2(hh[2], hh[3]);
        float sn, cs; hw_sincos((float)k / 16384.0f, sn, cs); const float2 w = make_float2(cs, -sn);
        const float2 xoho = cmul(XO, HO), wx = cmul(w, xoho), xehe = cmul(XE, HE), xeho = cmul(XE, HO), xohe = cmul(XO, HE);
        const float2 YE = make_float2(xehe.x + wx.x, xehe.y + wx.y), YO = make_float2(xeho.x + xohe.x, xeho.y + xohe.y);
        cf[ik] = make_float2(YE.x - YO.y, YE.y + YO.x); cf[ikp] = make_float2(YE.x + YO.y, -YE.y + YO.x); }
    __syncthreads();
    fft_inv(cf);
    if (tid < 16) { const int t = tid; float d = 0.f;
        for (int s = t + 16384; s < L_TOK; ++s) { const int l = s - t; const float wrong = l == 16384 ? 0.f : side[SD_EF + 16399 - l]; d += (side[SD_GBX + l - 16384] - wrong) * side[SD_VT + s - 16384]; }
        CFF(t) += d; }
    else if (tid >= 32 && tid < 48) { const int t = 16384 + tid - 32; float d = 0.f;
        for (int s = 0; s <= t - 16384; ++s) { const int l = t - s; const float wrong = l == 16384 ? 0.f : side[SD_EB + 16399 - l]; d += (side[SD_GFX + l - 16384] - wrong) * side[SD_VH + s]; }
        CFF(t) += d; }
    __syncthreads();
}

__device__ void hyena_unit(const Params& p, int layer, int ch, unsigned char* smem, unsigned char* scratch) {
    const int tid = opaque_tid(); float2* cf = (float2*)smem; float* cff = (float*)smem; float* side = (float*)(smem + 139264);
    const bf16_t* hyin = (const bf16_t*)(p.ws + OFF_HYIN);
    HyCh hc; hc.ru = hyin + (size_t)ch * LP; hc.r1 = hyin + (size_t)(1024 + ch) * LP; hc.r2 = hyin + (size_t)(2048 + ch) * LP;
    { const float* cw = p.conv_w + (size_t)layer * 3 * 3072; const float* cb = p.conv_b + (size_t)layer * 3072;
#pragma unroll
      for (int jj = 0; jj < 3; ++jj) { hc.wu[jj] = cw[jj * 3072 + ch]; hc.w1[jj] = cw[jj * 3072 + 1024 + ch]; hc.w2[jj] = cw[jj * 3072 + 2048 + ch]; }
      hc.wu[3] = cb[ch]; hc.w1[3] = cb[1024 + ch]; hc.w2[3] = cb[2048 + ch]; }
    const float sk0 = p.skip[(layer * 2 + 0) * 1024 + ch], sk1 = p.skip[(layer * 2 + 1) * 1024 + ch];
    float* __restrict__ z2g = (float*)(scratch + HS_Z2); float* __restrict__ g2f = (float*)(scratch + HS_G2F); float* __restrict__ g2b = (float*)(scratch + HS_G2B);
    bf16_t* __restrict__ hyout = (bf16_t*)(p.ws + OFF_HYOUT) + (size_t)ch * LP;
    __syncthreads();
    { bf16_t* w4b = (bf16_t*)(side + SD_W4B);
      for (int i = tid; i < 16 * 64; i += NTHREADS) { const int n = i >> 6, k = i & 63; w4b[i] = n < 4 ? f2bf(p.f_w4[((size_t)layer * 64 + k) * 4096 + n * 1024 + ch]) : (bf16_t)0; }
      __syncthreads();
      const bf16_t* __restrict__ h3b = (const bf16_t*)(p.ws + OFF_H3) + (size_t)layer * L_TOK * 64;
      const int lane = tid & 63, wv = tid >> 6, col = lane & 15, quad = lane >> 4;
      const float dk = col < 4 ? fabsf(p.decay[((layer * 2 + (col >> 1)) * 2 + (col & 1)) * 1024 + ch]) * (1.4426950408889634f / (float)(L_TOK - 1)) : 0.f;
      const bf16x8 b0 = *(const bf16x8*)(w4b + col * 64 + quad * 8), b1 = *(const bf16x8*)(w4b + col * 64 + 32 + quad * 8);
      for (int gb = wv; gb < L_TOK / 16; gb += 64) {
          bf16x8 a0[8], a1[8];
#pragma unroll
          for (int i = 0; i < 8; ++i) { const int g = min(gb + 8 * i, L_TOK / 16 - 1); const bf16_t* hr = h3b + (size_t)(g * 16 + col) * 64 + quad * 8; a0[i] = *(const bf16x8*)hr; a1[i] = *(const bf16x8*)(hr + 32); }
#pragma unroll
          for (int i = 0; i < 8; ++i) { const int g = gb + 8 * i;
              if (g < L_TOK / 16) {
                  f32x4 acc = (f32x4){0.f, 0.f, 0.f, 0.f};
                  acc = __builtin_amdgcn_mfma_f32_16x16x32_bf16(a0[i], b0, acc, 0, 0, 0); acc = __builtin_amdgcn_mfma_f32_16x16x32_bf16(a1[i], b1, acc, 0, 0, 0);
                  if (col < 4) { const int lag0 = g * 16 + quad * 4; float v[4];
#pragma unroll
                      for (int r = 0; r < 4; ++r) v[r] = acc[r] * __builtin_amdgcn_exp2f(-(float)(lag0 + r) * dk);
                      if (col == 2) *(f32x4*)(g2f + lag0) = (f32x4){v[0], v[1], v[2], v[3]};
                      else if (col == 3) *(f32x4*)(g2b + lag0) = (f32x4){v[0], v[1], v[2], v[3]};
                      else if (col == 0) { if (lag0 < NMAIN) { float2* d = cf + PADI(lag0 >> 1); d[0] = make_float2(v[0], v[1]); d[1] = make_float2(v[2], v[3]); }
                                           else { side[SD_GFX + lag0 - NMAIN] = v[0]; side[SD_GFX + lag0 - NMAIN + 1] = v[1]; side[SD_GFX + lag0 - NMAIN + 2] = v[2]; side[SD_GFX + lag0 - NMAIN + 3] = v[3]; } }
                      else { if (lag0 < NMAIN) {
#pragma unroll
                                 for (int r = 0; r < 4; ++r) if (lag0 + r >= 1) CFF(32768 - lag0 - r) = v[r]; }
                             else { side[SD_GBX + lag0 - NMAIN] = v[0]; side[SD_GBX + lag0 - NMAIN + 1] = v[1]; side[SD_GBX + lag0 - NMAIN + 2] = v[2]; side[SD_GBX + lag0 - NMAIN + 3] = v[3]; } } } } } }
      if (tid == 0) CFF(NMAIN) = 0.f;
      __syncthreads(); }
    hy_conv<0>(hc, cf, side, scratch);
    for (int c = tid; c < NCHUNK; c += NTHREADS) { float u8[8], x8[8]; hy_val8(hc.ru, 8 * c, hc.wu, u8); hy_val8(hc.r1, 8 * c, hc.w1, x8);
        const float2* s = cf + PADI(4 * c); const float2 y0 = s[0], y1 = s[1], y2 = s[2], y3 = s[3];
        const f32x4 o0 = (f32x4){x8[0] * (y0.x + sk0 * u8[0]), x8[1] * (y0.y + sk0 * u8[1]), x8[2] * (y1.x + sk0 * u8[2]), x8[3] * (y1.y + sk0 * u8[3])};
        const f32x4 o1 = (f32x4){x8[4] * (y2.x + sk0 * u8[4]), x8[5] * (y2.y + sk0 * u8[5]), x8[6] * (y3.x + sk0 * u8[6]), x8[7] * (y3.y + sk0 * u8[7])};
        *(f32x4*)(z2g + 8 * c) = o0; *(f32x4*)(z2g + 8 * c + 4) = o1; }
    __syncthreads();
    for (int q = tid; q < L_TOK / 4; q += NTHREADS) { const int lag0 = 4 * q; const f32x4 gf = *(const f32x4*)(g2f + lag0), gb = *(const f32x4*)(g2b + lag0);
        if (lag0 < NMAIN) { float2* d = cf + PADI(lag0 >> 1); d[0] = make_float2(gf[0], gf[1]); d[1] = make_float2(gf[2], gf[3]);
#pragma unroll
            for (int r = 0; r < 4; ++r) if (lag0 + r >= 1) CFF(32768 - lag0 - r) = gb[r]; }
        else {
#pragma unroll
            for (int r = 0; r < 4; ++r) { side[SD_GFX + lag0 - NMAIN + r] = gf[r]; side[SD_GBX + lag0 - NMAIN + r] = gb[r]; } } }
    if (tid == 0) CFF(NMAIN) = 0.f;
    __syncthreads();
    hy_conv<1>(hc, cf, side, scratch);
    for (int c = tid; c < NCHUNK; c += NTHREADS) { float x8[8]; hy_val8(hc.r2, 8 * c, hc.w2, x8);
        const f32x4 p0 = *(const f32x4*)(z2g + 8 * c), p1 = *(const f32x4*)(z2g + 8 * c + 4);
        const float2* s = cf + PADI(4 * c); const float2 y0 = s[0], y1 = s[1], y2 = s[2], y3 = s[3];
        u32x4 w; w.x = cvt_pk_bf16(x8[0] * (y0.x + sk1 * p0[0]), x8[1] * (y0.y + sk1 * p0[1])); w.y = cvt_pk_bf16(x8[2] * (y1.x + sk1 * p0[2]), x8[3] * (y1.y + sk1 * p0[3]));
        w.z = cvt_pk_bf16(x8[4] * (y2.x + sk1 * p1[0]), x8[5] * (y2.y + sk1 * p1[1])); w.w = cvt_pk_bf16(x8[6] * (y3.x + sk1 * p1[2]), x8[7] * (y3.y + sk1 * p1[3]));
        *(u32x4*)(hyout + 8 * c) = w; }
    __syncthreads();
}

__device__ void transpose_unit(const Params& p, int ct, int tt, unsigned char* smem) {
    const int tid = opaque_tid(); bf16_t* tile = (bf16_t*)smem;
    const bf16_t* hyout = (const bf16_t*)(p.ws + OFF_HYOUT); bf16_t* ya = (bf16_t*)(p.ws + OFF_GATE);
    __syncthreads();
    { const int cl = tid >> 3, t8 = (tid & 7) * 8; *(u32x4*)(tile + cl * 72 + t8) = *(const u32x4*)(hyout + (size_t)(ct * 64 + cl) * LP + tt * 64 + t8); }
    __syncthreads();
    { const int tl = tid >> 3, c8 = (tid & 7) * 8; const int t = tt * 64 + tl;
      if (t < L_TOK) { bf16_t* gp = ya + (size_t)t * 1024 + ct * 64 + c8; const u32x4 g = *(const u32x4*)gp;
          float v[8];
#pragma unroll
          for (int i = 0; i < 8; ++i) v[i] = bf2f(tile[(c8 + i) * 72 + tl]);
          u32x4 w; w.x = cvt_pk_bf16(v[0] * lo_bf(g.x), v[1] * hi_bf(g.x)); w.y = cvt_pk_bf16(v[2] * lo_bf(g.y), v[3] * hi_bf(g.y)); w.z = cvt_pk_bf16(v[4] * lo_bf(g.z), v[5] * hi_bf(g.z)); w.w = cvt_pk_bf16(v[6] * lo_bf(g.w), v[7] * hi_bf(g.w));
          *(u32x4*)gp = w; } }
}

__device__ void phase_final(const Params& p) {
    const int tid = opaque_tid(), lane = tid & 63, wv = tid >> 6; const float* h = (const float*)(p.ws + OFF_H);
    for (int l = NMETA + blockIdx.x * 8 + wv; l < L_TOK; l += gridDim.x * 8) { const f32x4* row = (const f32x4*)(h + (size_t)l * DM); f32x4 v[8]; float ss = 0.f;
#pragma unroll
        for (int i = 0; i < 8; ++i) { v[i] = row[i * 64 + lane]; ss += v[i][0] * v[i][0] + v[i][1] * v[i][1] + v[i][2] * v[i][2] + v[i][3] * v[i][3]; }
        ss = wave_sum(ss); const float inv = rsqrtf(ss * (1.0f / DM) + 1e-6f); f32x4* o = (f32x4*)(p.out + (size_t)(l - NMETA) * DM);
#pragma unroll
        for (int i = 0; i < 8; ++i) { const f32x4 gg = ((const f32x4*)p.final_g)[i * 64 + lane]; o[i * 64 + lane] = v[i] * inv * gg; } }
}

__device__ void mini_branch(const Params& p) {
    const int tid = opaque_tid(), lane = tid & 63, wv = tid >> 6, nt_ = blockIdx.x * 8 + wv;
    if (nt_ < 128) { const int rc = lane & 15, quad = lane >> 4; const int n0 = nt_ * 16;
        const bf16_t* mg = (const bf16_t*)(p.ws + OFF_MERGE); bf16_t* mb = (bf16_t*)(p.ws + OFF_M);
        float tot[4] = {0.f, 0.f, 0.f, 0.f};
#pragma unroll 1
        for (int br = 0; br < 3; ++br) { const bf16_t* A = (const bf16_t*)(p.ws + OFF_GATE + (size_t)br * SZ_GATE) + (size_t)(NMAIN + rc) * 1024 + quad * 8;
            const bf16_t* B = (const bf16_t*)(p.ws + OFF_WA + (size_t)br * SZ_WBR) + (size_t)(n0 + rc) * 1024 + quad * 8;
            f32x4 acc = (f32x4){0.f, 0.f, 0.f, 0.f};
#pragma unroll 1
            for (int kb = 0; kb < 32; kb += 8) { bf16x8 av[8], bv[8];
#pragma unroll
                for (int i = 0; i < 8; ++i) { av[i] = *(const bf16x8*)(A + (kb + i) * 32); bv[i] = *(const bf16x8*)(B + (kb + i) * 32); }
#pragma unroll
                for (int i = 0; i < 8; ++i) acc = __builtin_amdgcn_mfma_f32_16x16x32_bf16(av[i], bv[i], acc, 0, 0, 0); }
#pragma unroll
            for (int r = 0; r < 4; ++r) tot[r] += acc[r] * bf2f(mg[(size_t)(NMAIN + quad * 4 + r) * 6144 + br * 2048 + n0 + rc]); }
#pragma unroll
        for (int r = 0; r < 4; ++r) mb[(size_t)(NMAIN + quad * 4 + r) * DM + n0 + rc] = f2bf(tot[r]); }
}
__device__ void mini_out(const Params& p) {
    const int tid = opaque_tid(), lane = tid & 63, wv = tid >> 6, nt_ = blockIdx.x * 8 + wv;
    if (nt_ < 128) { const int rc = lane & 15, quad = lane >> 4; const int n0 = nt_ * 16;
        const bf16_t* A = (const bf16_t*)(p.ws + OFF_M) + (size_t)(NMAIN + rc) * DM + quad * 8; const bf16_t* B = (const bf16_t*)(p.ws + OFF_WO) + (size_t)(n0 + rc) * DM + quad * 8;
        f32x4 acc = (f32x4){0.f, 0.f, 0.f, 0.f};
#pragma unroll 1
        for (int kb = 0; kb < 64; kb += 8) { bf16x8 av[8], bv[8];
#pragma unroll
            for (int i = 0; i < 8; ++i) { av[i] = *(const bf16x8*)(A + (kb + i) * 32); bv[i] = *(const bf16x8*)(B + (kb + i) * 32); }
#pragma unroll
            for (int i = 0; i < 8; ++i) acc = __builtin_amdgcn_mfma_f32_16x16x32_bf16(av[i], bv[i], acc, 0, 0, 0); }
        float* h = (float*)(p.ws + OFF_H);
#pragma unroll
        for (int r = 0; r < 4; ++r) h[(size_t)(NMAIN + quad * 4 + r) * DM + n0 + rc] += acc[r]; }
}

enum { OP_P1 = 0, OP_SYNC, OP_GEMM, OP_NA, OP_HYENA, OP_TRANS, OP_NOP };
__global__ void __launch_bounds__(512, 2) hybrid_fwd(Params p) {
    extern __shared__ __attribute__((aligned(16))) unsigned char smem[];
    cg::grid_group grid = cg::this_grid();
    LAS unsigned char* lds = (LAS unsigned char*)smem;
    const int bid = blockIdx.x, G = gridDim.x;
    phase_prep0(p, smem);
    constexpr int NOPS = 17;
#pragma clang loop unroll(disable)
    for (int step = 0; step < 2 * NOPS; ++step) {
        const int layer = step / NOPS, s = step - layer * NOPS;
        int op, kind = 0;
        switch (s) {
        case 0: op = OP_P1; break;
        case 2: op = OP_GEMM; kind = K_IN; break;
        case 3: case 4: op = OP_NOP; break;
        case 6: op = OP_GEMM; kind = K_FNA; break;
        case 7: op = OP_NA; break;
        case 8: op = OP_HYENA; break;
        case 10: op = OP_GEMM; kind = K_FNB; break;
        case 11: op = OP_TRANS; break;
        case 13: op = OP_GEMM; kind = K_BR; break;
        case 15: op = OP_GEMM; kind = K_OUT; break;
        default: op = OP_SYNC; break;
        }
        if (op == OP_NOP) { }
        else if (op == OP_SYNC) { grid.sync(); }
        else if (op == OP_GEMM) {
            Gemm g; g.base = (const char*)p.ws; g.jumpA = 0; g.jumpB = 0;
            switch (kind) {
            case K_FNA: g.lda = 384; g.ldb = FN1P; g.nt = 6; g.ksplit = 3; g.jumpB = (long)((size_t)1024 * PROWS * 2) - 384l; break;
            case K_FNB: g.lda = 256; g.ldb = 256; g.nt = 4; g.ksplit = 4; break;
            case K_BR:  g.lda = 1024; g.ldb = 1024; g.nt = 16; g.ksplit = 16; break;
            default:    g.lda = DM; g.ldb = DM; g.nt = 32; g.ksplit = 32; break;
            }
            SchedAny S{kind, G, bid}; EpiAny E{kind, p.ws};
            pg8::gemm_phase(lds, g, S, E);
            if (kind == K_BR) mini_branch(p); else if (kind == K_OUT) mini_out(p);
        }
        else if (op == OP_P1) { phase_p1(p, layer, smem); }
        else if (op == OP_NA) { for (int u = bid; u < 4096; u += G) na_unit(p, layer, u >> 4, u & 15, smem); if (bid == G - 1) na_meta_unit(p, layer); }
        else if (op == OP_HYENA) { for (int ch = bid; ch < 1024; ch += G) hyena_unit(p, layer, ch, smem, (unsigned char*)p.out + (size_t)bid * HS_STRIDE); }
        else { for (int u = bid; u < 16 * 257; u += G) transpose_unit(p, u & 15, u >> 4, smem); }
    }
    phase_final(p);
}

extern "C" void kernel_launch(void* const* d_in, const int* in_sizes, int n_in, void* d_out, int out_size, void* d_ws, size_t ws_size, hipStream_t stream) {
    static int grid_blocks = 0;
    if (grid_blocks == 0) {
        if (n_in != 23 || ws_size < WS_END) { fprintf(stderr, "kernel_launch: need 23 inputs and %zu bytes of workspace (got %d, %zu)\n", (size_t)WS_END, n_in, ws_size); grid_blocks = -1; return; }
        int dev = 0, cus = 0, per_cu = 0;
        hipGetDevice(&dev); hipDeviceGetAttribute(&cus, hipDeviceAttributeMultiprocessorCount, dev);
        if (hipFuncSetAttribute((const void*)hybrid_fwd, hipFuncAttributeMaxDynamicSharedMemorySize, LDS_BYTES) != hipSuccess) { fprintf(stderr, "kernel_launch: hipFuncSetAttribute failed\n"); grid_blocks = -1; return; }
        hipOccupancyMaxActiveBlocksPerMultiprocessor(&per_cu, (const void*)hybrid_fwd, NTHREADS, LDS_BYTES);
        if (per_cu < 1) per_cu = 1;
        grid_blocks = cus * per_cu;
        if (grid_blocks > 256) grid_blocks = 256;
    }
    if (grid_blocks < 0) return;
    Params p{};
    const float** f = (const float**)&p;
    for (int i = 0; i < 23; ++i) f[i] = (const float*)d_in[i];
    p.out = (float*)d_out; p.ws = (unsigned char*)d_ws;
    void* args[] = {&p};
    hipError_t e = hipLaunchCooperativeKernel((const void*)hybrid_fwd, dim3(grid_blocks), dim3(NTHREADS), args, LDS_BYTES, stream);
    if (e != hipSuccess) fprintf(stderr, "cooperative launch failed: %s (grid %d)\n", hipGetErrorString(e), grid_blocks);
}
```

```cpp
#include <hip/hip_runtime.h>
#include <hip/hip_cooperative_groups.h>
#include <cstdio>
namespace cg = cooperative_groups;

#define LAS __attribute__((address_space(3)))
typedef unsigned short bf16_t;
typedef short bf16x8 __attribute__((ext_vector_type(8)));
typedef float f32x4 __attribute__((ext_vector_type(4)));
typedef unsigned u32x4 __attribute__((ext_vector_type(4)));
typedef unsigned u32x2 __attribute__((ext_vector_type(2)));

constexpr int L_TOK = 16400, LP = 16640, DM = 2048, NIN = 16384, NMETA = 16, NMAIN = 16384;
constexpr int FN1 = 164, FN2 = 100, FN1P = 192, PROWS = FN2 * FN1P;
constexpr int NTHREADS = 512, LDS_BYTES = 155648;

constexpr size_t SZ_H = (size_t)LP * DM * 4, SZ_XN = (size_t)LP * DM * 2, SZ_XNP = (size_t)PROWS * DM * 2;
constexpr size_t OFF_H = 0;
constexpr size_t OFF_XN = OFF_H + SZ_H;
constexpr size_t OFF_XNP = OFF_XN + SZ_XN;
constexpr size_t OFF_A1 = OFF_XN;
constexpr size_t SZ_A1 = (size_t)FN1 * 1024 * 2 * 128 * 2;
constexpr size_t OFF_HYOUT = OFF_A1 + SZ_A1;
constexpr size_t SZ_HYOUT = (size_t)1024 * LP * 2;
static_assert(OFF_HYOUT + SZ_HYOUT <= OFF_XNP + SZ_XNP, "alias overflow");
constexpr size_t OFF_WT = OFF_XNP + SZ_XNP;
constexpr size_t OFF_WEFF = OFF_WT + (size_t)NIN * DM * 2;
constexpr size_t OFF_WA = OFF_WEFF + (size_t)2048 * 2048 * 2;
constexpr size_t SZ_WBR = (size_t)2048 * 1024 * 2;
constexpr size_t OFF_WO = OFF_WA + 3 * SZ_WBR;
constexpr size_t OFF_HYIN = OFF_WO + (size_t)2048 * 2048 * 2;
constexpr size_t OFF_GATE = OFF_HYIN + (size_t)3072 * LP * 2;
constexpr size_t SZ_GATE = (size_t)LP * 1024 * 2;
constexpr size_t OFF_QKV = OFF_GATE + 3 * SZ_GATE;
constexpr size_t OFF_MERGE = OFF_QKV + (size_t)LP * 3072 * 2;
constexpr size_t OFF_ZT = OFF_MERGE + (size_t)LP * 6144 * 2;
constexpr size_t SZ_ZT = (size_t)2048 * PROWS * 2;
constexpr size_t OFF_M = OFF_ZT;
static_assert(SZ_XN <= SZ_ZT, "alias overflow");
constexpr size_t OFF_FA = OFF_ZT + SZ_ZT;
constexpr size_t OFF_FB = OFF_FA + (size_t)512 * 384 * 2;
constexpr size_t OFF_H3 = OFF_FB + (size_t)FN1 * 256 * 256 * 2;
constexpr size_t WS_END = OFF_H3 + (size_t)2 * L_TOK * 64 * 4;
constexpr size_t HS_HEO = 0, HS_CORR = 131328, HS_Z2 = HS_CORR + 65536, HS_G2F = HS_Z2 + 65792, HS_G2B = HS_G2F + 65792, HS_STRIDE = HS_G2B + 65792;
static_assert(HS_STRIDE * 256 <= (size_t)NMAIN * DM * 4, "scratch overflow");

struct Params {
    const float* x; const float* meta; const float* norm_g; const float* w_in; const float* conv_w; const float* conv_b;
    const float* f_w1; const float* f_b1; const float* f_w2; const float* f_b2; const float* f_w3; const float* f_b3; const float* f_w4;
    const float* f_freq; const float* decay; const float* skip; const float* rpb; const float* meta_bias;
    const float* w_a; const float* w_b; const float* w_c; const float* w_out; const float* final_g;
    float* out; unsigned char* ws;
};

__device__ __forceinline__ int opaque_tid() { int t = threadIdx.x; asm volatile("" : "+v"(t)); return t; }
__device__ __forceinline__ float bf2f(bf16_t b) { return __uint_as_float(((unsigned)b) << 16); }
__device__ __forceinline__ bf16_t f2bf(float f) { unsigned u = __float_as_uint(f); u += 0x7FFFu + ((u >> 16) & 1u); return (bf16_t)(u >> 16); }
__device__ __forceinline__ unsigned cvt_pk_bf16(float lo, float hi) { unsigned r; asm volatile("v_cvt_pk_bf16_f32 %0, %1, %2" : "=v"(r) : "v"(lo), "v"(hi)); return r; }
__device__ __forceinline__ float lo_bf(unsigned u) { return __uint_as_float(u << 16); }
__device__ __forceinline__ float hi_bf(unsigned u) { return __uint_as_float(u & 0xffff0000u); }
__device__ __forceinline__ float silu_f(float v) { return v / (1.0f + __expf(-v)); }
__device__ __forceinline__ float sigm_f(float v) { return 1.0f / (1.0f + __expf(-v)); }
__device__ __forceinline__ float wave_sum(float v) {
#pragma unroll
    for (int o = 32; o >= 1; o >>= 1) v += __shfl_xor(v, o);
    return v;
}

namespace pg8 {
constexpr int BM = 256, BK = 64, HALF = 128, HTB = HALF * BK * 2, STAGE_BYTES = 8 * HTB;
__device__ __forceinline__ int lds_byte(int r, int c) { const int st = (r >> 4) * 2 + (c >> 5), rr = r & 15, cc = c & 31, ob = rr * 64 + cc * 2; return st * 1024 + (ob ^ (((ob >> 9) & 1) << 5)); }
__device__ __forceinline__ void stage_rc(int b, int& R, int& C) { const int st = b / 1024, sb = b % 1024, swz = sb ^ (((sb >> 9) & 1) << 5); R = (st >> 1) * 16 + swz / 64; C = (st & 1) * 32 + (swz % 64) / 2; }
__device__ __forceinline__ int perm32(int rho) { const int n = rho >> 4, i = rho & 15; return 8 * (i >> 2) + 4 * n + (i & 3); }

struct Unit { int pm, pn, aux; size_t offA, offB; };
struct Gemm { const char* base; int lda, ldb, nt, ksplit; long jumpA, jumpB; };

__device__ __forceinline__ void tile_map(int wgid, int nM, int nN, int& pm, int& pn) {
    const int nwg = nM * nN;
    { const int q = nwg / 8, r = nwg % 8, xcd = wgid % 8, off = wgid / 8; wgid = (xcd < r ? xcd * (q + 1) : r * (q + 1) + (xcd - r) * q) + off; }
    const int nig = 8 * nN, gid = wgid / nig, fm = gid * 8, gsz = (nM - fm) < 8 ? (nM - fm) : 8;
    pm = fm + ((wgid % nig) % gsz); pn = (wgid % nig) / gsz;
}

template <class Epi, class Sched>
__device__ __forceinline__ void gemm_phase(LAS unsigned char* lds, const Gemm g, const Sched& S, const Epi& E) {
    const int tid = opaque_tid(), wid = __builtin_amdgcn_readfirstlane(tid >> 6), lane = tid & 63, wr = wid >> 2, wc = wid & 3, fr = lane & 15, fq = lane >> 4;
    const int nt = g.nt;
    unsigned voffA[2], voffB[2];
#pragma unroll
    for (int i = 0; i < 2; ++i) { int R, C; stage_rc(tid * 16 + i * 8192, R, C); const int Rb = (R & ~31) + perm32(R & 31);
        voffA[i] = (unsigned)(R * g.lda + C) * 2u; voffB[i] = (unsigned)(Rb * g.ldb + C) * 2u; }
    const size_t kstep = (size_t)(BK * 2);
    const size_t hstepA = (size_t)HALF * g.lda * 2, hstepB = (size_t)HALF * g.ldb * 2;
    const unsigned ldsw = (unsigned)wid * 1024u;
    const int aoff = lds_byte(wr * 64 + fr, fq * 8), boff = lds_byte(wc * 32 + fr, fq * 8);
#define PG8_KA(p, t) ((p) + (size_t)(t) * kstep + ((t) >= g.ksplit ? g.jumpA : 0l))
#define PG8_KB(p, t) ((p) + (size_t)(t) * kstep + ((t) >= g.ksplit ? g.jumpB : 0l))
#define PG8_SA(b, h) (((b) * 2 + (h)) * HTB)
#define PG8_SB(b, h) ((4 + (b) * 2 + (h)) * HTB)
#define PG8_STAGE(bufoff, gbase, voff) do { _Pragma("unroll") for (int _i = 0; _i < 2; ++_i) \
        __builtin_amdgcn_global_load_lds((const unsigned*)((const char*)(gbase) + (voff)[_i]), (LAS unsigned*)(lds + (bufoff) + ldsw + _i * 8192), 16, 0, 0); } while (0)
#define PG8_LDA(dst, b, h) do { _Pragma("unroll") for (int m = 0; m < 4; ++m) _Pragma("unroll") for (int k = 0; k < 2; ++k) dst[m][k] = *(const LAS bf16x8*)(lds + PG8_SA(b, h) + aoff + m * 2048 + k * 1024); } while (0)
#define PG8_LDB(dst, b, h) do { _Pragma("unroll") for (int n = 0; n < 2; ++n) _Pragma("unroll") for (int k = 0; k < 2; ++k) dst[n][k] = *(const LAS bf16x8*)(lds + PG8_SB(b, h) + boff + n * 2048 + k * 1024); } while (0)
#define PG8_MMA(ai, bj, At, Bt) do { __builtin_amdgcn_s_setprio(1); _Pragma("unroll") for (int m = 0; m < 4; ++m) _Pragma("unroll") for (int n = 0; n < 2; ++n) _Pragma("unroll") for (int k = 0; k < 2; ++k) \
        acc[ai][bj][m][n] = __builtin_amdgcn_mfma_f32_16x16x32_bf16(Bt[n][k], At[m][k], acc[ai][bj][m][n], 0, 0, 0); __builtin_amdgcn_s_setprio(0); } while (0)
#define PG8_WAIT_V(n) asm volatile("s_waitcnt vmcnt(" #n ")" ::: "memory")
#define PG8_WAIT_L(n) asm volatile("s_waitcnt lgkmcnt(" #n ")" ::: "memory")
#define PG8_BAR __builtin_amdgcn_s_barrier()
#define PG8_SCHED __builtin_amdgcn_sched_barrier(0)
    Unit cur, nxt; int ui = 0;
    if (!S.next(0, cur)) return;
    f32x4 acc[2][2][4][2];
#pragma unroll
    for (int a = 0; a < 2; ++a)
#pragma unroll
        for (int b = 0; b < 2; ++b)
#pragma unroll
            for (int m = 0; m < 4; ++m)
#pragma unroll
                for (int n = 0; n < 2; ++n) acc[a][b][m][n] = (f32x4){0.f, 0.f, 0.f, 0.f};
    bf16x8 At[4][2], B0[2][2], B1[2][2];
    const char* cA = g.base + cur.offA; const char* cB = g.base + cur.offB;
    PG8_STAGE(PG8_SB(0, 0), cB, voffB); PG8_STAGE(PG8_SA(0, 0), cA, voffA); PG8_STAGE(PG8_SB(0, 1), cB + hstepB, voffB); PG8_STAGE(PG8_SA(0, 1), cA + hstepA, voffA);
    if (wr == 1) PG8_BAR;
    PG8_WAIT_V(4); PG8_BAR;
    PG8_STAGE(PG8_SB(1, 0), PG8_KB(cB, 1), voffB); PG8_STAGE(PG8_SA(1, 0), PG8_KA(cA, 1), voffA); PG8_STAGE(PG8_SB(1, 1), PG8_KB(cB, 1) + hstepB, voffB);
    PG8_WAIT_V(6); PG8_BAR;
    for (;;) {
        const bool has_next = S.next(ui + 1, nxt);
        const char* nA = has_next ? g.base + nxt.offA : cA; const char* nB = has_next ? g.base + nxt.offB : cB;
        for (int t = 0; t < nt; t += 2) {
            const bool last = (t == nt - 2);
            const char* a1 = PG8_KA(cA, t + 1);
            const char* a2 = last ? nA : PG8_KA(cA, t + 2); const char* b2 = last ? nB : PG8_KB(cB, t + 2);
            const char* a3 = last ? PG8_KA(nA, 1) : PG8_KA(cA, t + 3); const char* b3 = last ? PG8_KB(nB, 1) : PG8_KB(cB, t + 3);
            PG8_LDB(B0, 0, 0); PG8_SCHED; PG8_LDA(At, 0, 0); PG8_STAGE(PG8_SA(1, 1), a1 + hstepA, voffA);
            PG8_WAIT_L(8); PG8_BAR; PG8_WAIT_L(0); PG8_MMA(0, 0, At, B0); PG8_BAR; PG8_SCHED;
            PG8_LDB(B1, 0, 1); PG8_STAGE(PG8_SB(0, 0), b2, voffB);
            PG8_BAR; PG8_WAIT_L(0); PG8_MMA(0, 1, At, B1); PG8_BAR;
            PG8_LDA(At, 0, 1); PG8_STAGE(PG8_SA(0, 0), a2, voffA);
            PG8_BAR; PG8_WAIT_L(0); PG8_MMA(1, 0, At, B0); PG8_BAR; PG8_SCHED;
            PG8_STAGE(PG8_SB(0, 1), b2 + hstepB, voffB);
            PG8_WAIT_V(6); PG8_BAR; PG8_MMA(1, 1, At, B1); PG8_BAR;
            PG8_LDB(B0, 1, 0); PG8_SCHED; PG8_LDA(At, 1, 0); PG8_STAGE(PG8_SA(0, 1), a2 + hstepA, voffA);
            PG8_WAIT_L(8); PG8_BAR; PG8_WAIT_L(0); PG8_MMA(0, 0, At, B0); PG8_BAR; PG8_SCHED;
            PG8_LDB(B1, 1, 1); PG8_STAGE(PG8_SB(1, 0), b3, voffB);
            PG8_BAR; PG8_WAIT_L(0); PG8_MMA(0, 1, At, B1); PG8_BAR;
            PG8_LDA(At, 1, 1); PG8_STAGE(PG8_SA(1, 0), a3, voffA);
            PG8_BAR; PG8_WAIT_L(0); PG8_MMA(1, 0, At, B0); PG8_BAR; PG8_SCHED;
            PG8_STAGE(PG8_SB(1, 1), b3 + hstepB, voffB);
            PG8_WAIT_V(6); PG8_BAR; PG8_MMA(1, 1, At, B1); PG8_BAR;
        }
        E(acc, cur, wr, wc, fr, fq);
        if (!has_next) break;
#pragma unroll
        for (int a = 0; a < 2; ++a)
#pragma unroll
            for (int b = 0; b < 2; ++b)
#pragma unroll
                for (int m = 0; m < 4; ++m)
#pragma unroll
                    for (int n = 0; n < 2; ++n) acc[a][b][m][n] = (f32x4){0.f, 0.f, 0.f, 0.f};
        cur = nxt; cA = nA; cB = nB; ++ui;
    }
    PG8_WAIT_V(0);
    if (wr == 0) PG8_BAR;
    PG8_BAR;
#undef PG8_KA
#undef PG8_KB
#undef PG8_SA
#undef PG8_SB
#undef PG8_STAGE
#undef PG8_LDA
#undef PG8_LDB
#undef PG8_MMA
#undef PG8_WAIT_V
#undef PG8_WAIT_L
#undef PG8_BAR
#undef PG8_SCHED
}
}
using pg8::Unit; using pg8::Gemm;
#define ACC_T const f32x4 (&acc)[2][2][4][2]

enum { K_TOK = 0, K_HYIN = 1, K_F0 = 2, K_FNA = 3, K_FNB = 4, K_BR = 5, K_OUT = 6, K_IN = 7 };
struct SchedAny {
    int kind, G, c;
    __device__ __forceinline__ bool next(int i, Unit& u) const {
        const long Lx = (long)i * G + c;
        switch (kind) {
        case K_IN: {
            if (Lx < 3120) { int pn; pg8::tile_map((int)Lx, 65, 48, u.pm, pn); u.pn = pn < 4 ? 12 + pn : 16 + pn; u.aux = K_TOK;
                u.offA = OFF_XN + (size_t)u.pm * 256 * DM * 2; u.offB = OFF_WT + (size_t)u.pn * 256 * DM * 2; return true; }
            if (Lx < 3900) { pg8::tile_map((int)Lx - 3120, 12, 65, u.pm, u.pn); u.aux = K_HYIN;
                u.offA = OFF_WT + (size_t)u.pm * 256 * DM * 2; u.offB = OFF_XN + (size_t)u.pn * 256 * DM * 2; return true; }
            if (Lx < 4500) { pg8::tile_map((int)Lx - 3900, 8, 75, u.pm, u.pn); u.aux = K_F0;
                u.offA = OFF_WEFF + (size_t)u.pm * 256 * DM * 2; u.offB = OFF_XNP + (size_t)u.pn * 256 * DM * 2; return true; }
            return false; }
        case K_TOK: {
            if (Lx >= 65l * 48) return false; int pn; pg8::tile_map((int)Lx, 65, 48, u.pm, pn); u.pn = pn < 4 ? 12 + pn : 16 + pn; u.aux = 0;
            u.offA = OFF_XN + (size_t)u.pm * 256 * DM * 2; u.offB = OFF_WT + (size_t)u.pn * 256 * DM * 2; return true; }
        case K_HYIN: {
            if (Lx >= 12l * 65) return false; pg8::tile_map((int)Lx, 12, 65, u.pm, u.pn); u.aux = 0;
            u.offA = OFF_WT + (size_t)u.pm * 256 * DM * 2; u.offB = OFF_XN + (size_t)u.pn * 256 * DM * 2; return true; }
        case K_F0: {
            if (Lx >= 8l * 75) return false; pg8::tile_map((int)Lx, 8, 75, u.pm, u.pn); u.aux = 0;
            u.offA = OFF_WEFF + (size_t)u.pm * 256 * DM * 2; u.offB = OFF_XNP + (size_t)u.pn * 256 * DM * 2; return true; }
        case K_FNA: {
            if (Lx >= 2l * 400) return false; pg8::tile_map((int)Lx, 2, 400, u.pm, u.pn); u.aux = 0;
            u.offA = OFF_FA + (size_t)u.pm * 256 * 384 * 2; u.offB = OFF_ZT + (size_t)u.pn * 256 * FN1P * 2; return true; }
        case K_FNB: {
            if (Lx >= 164l * 4) return false; u.aux = (int)(Lx >> 2); u.pm = 0; u.pn = (int)(Lx & 3);
            u.offA = OFF_FB + (size_t)u.aux * 256 * 256 * 2; u.offB = OFF_A1 + (size_t)u.aux * 1024 * 256 * 2 + (size_t)u.pn * 256 * 256 * 2; return true; }
        case K_BR: {
            const int T = (i / 3) * G + c; if (T >= 64 * 8) return false; const int br = i % 3; pg8::tile_map(T, 64, 8, u.pm, u.pn); u.aux = br;
            u.offA = OFF_GATE + (size_t)br * SZ_GATE + (size_t)u.pm * 256 * 1024 * 2; u.offB = OFF_WA + (size_t)br * SZ_WBR + (size_t)u.pn * 256 * 1024 * 2; return true; }
        default: {
            if (Lx >= 64l * 8) return false; pg8::tile_map((int)Lx, 64, 8, u.pm, u.pn); u.aux = 0;
            u.offA = OFF_M + (size_t)u.pm * 256 * DM * 2; u.offB = OFF_WO + (size_t)u.pn * 256 * DM * 2; return true; }
        }
    }
};
#define ROWFENCE asm volatile("" ::: "memory")
#define HARDFENCE do { asm volatile("" ::: "memory"); __builtin_amdgcn_sched_barrier(0); } while (0)
struct EpiAny {
    int kind; unsigned char* ws;
    __device__ __forceinline__ void operator()(ACC_T, const Unit& u, int wr, int wc, int fr, int fq) const {
        const int rl0 = wr * 64 + fr, cl0 = wc * 32 + 8 * fq;
        const int ek = kind == K_IN ? u.aux : kind;
        if (ek == K_TOK) {
            const int t = u.pn; unsigned char* dst; unsigned ld; int c0, act;
            if (t < 16)      { dst = ws + OFF_GATE;               ld = 1024; c0 = (t - 12) * 256; act = 1; }
            else if (t < 24) { dst = ws + OFF_GATE + SZ_GATE;     ld = 1024; c0 = (t - 20) * 256; act = 1; }
            else if (t < 36) { dst = ws + OFF_QKV;                ld = 3072; c0 = (t - 24) * 256; act = 0; }
            else if (t < 40) { dst = ws + OFF_GATE + 2 * SZ_GATE; ld = 1024; c0 = (t - 36) * 256; act = 1; }
            else             { dst = ws + OFF_MERGE;              ld = 6144; c0 = (t - 40) * 256; act = 2; }
#pragma unroll
            for (int ai = 0; ai < 2; ++ai)
#pragma unroll
                for (int m = 0; m < 4; ++m) { const unsigned row = (unsigned)(u.pm * 256 + ai * 128 + m * 16 + rl0);
#pragma unroll
                    for (int bj = 0; bj < 2; ++bj) { const unsigned off = (row * ld + (unsigned)(c0 + bj * 128 + cl0)) * 2u; f32x4 v0 = acc[ai][bj][m][0], v1 = acc[ai][bj][m][1];
                        if (act == 1) {
#pragma unroll
                            for (int j = 0; j < 4; ++j) { v0[j] = silu_f(v0[j]); v1[j] = silu_f(v1[j]); } }
                        else if (act == 2) {
#pragma unroll
                            for (int j = 0; j < 4; ++j) { v0[j] = sigm_f(v0[j]); v1[j] = sigm_f(v1[j]); } }
                        u32x4 w; w.x = cvt_pk_bf16(v0[0], v0[1]); w.y = cvt_pk_bf16(v0[2], v0[3]); w.z = cvt_pk_bf16(v1[0], v1[1]); w.w = cvt_pk_bf16(v1[2], v1[3]);
                        *(u32x4*)(dst + off) = w; }
                    ROWFENCE; }
        } else if (ek == K_HYIN || ek == K_F0) {
            unsigned char* dst = ws + (ek == K_HYIN ? OFF_HYIN : OFF_ZT); const unsigned ld = ek == K_HYIN ? LP : PROWS;
#pragma unroll
            for (int ai = 0; ai < 2; ++ai)
#pragma unroll
                for (int m = 0; m < 4; ++m) { const unsigned row = (unsigned)(u.pm * 256 + ai * 128 + m * 16 + rl0);
#pragma unroll
                    for (int bj = 0; bj < 2; ++bj) { const unsigned off = (row * ld + (unsigned)(u.pn * 256 + bj * 128 + cl0)) * 2u; const f32x4 v0 = acc[ai][bj][m][0], v1 = acc[ai][bj][m][1];
                        u32x4 w; w.x = cvt_pk_bf16(v0[0], v0[1]); w.y = cvt_pk_bf16(v0[2], v0[3]); w.z = cvt_pk_bf16(v1[0], v1[1]); w.w = cvt_pk_bf16(v1[2], v1[3]);
                        *(u32x4*)(dst + off) = w; }
                    ROWFENCE; }
        } else if (ek == K_FNA) {
            unsigned char* dst = ws + OFF_A1;
#pragma unroll
            for (int ai = 0; ai < 2; ++ai)
#pragma unroll
                for (int m = 0; m < 4; ++m) { const int k1 = ai * 128 + m * 16 + rl0;
                    if (k1 < FN1) {
#pragma unroll
                        for (int bj = 0; bj < 2; ++bj)
#pragma unroll
                            for (int n = 0; n < 2; ++n) { const int col = u.pn * 256 + bj * 128 + cl0 + 4 * n; const int ch = col / FN2, l2 = col - ch * FN2; const f32x4 v = acc[ai][bj][m][n];
                                u32x2 w; w.x = cvt_pk_bf16(v[0], v[1]); w.y = cvt_pk_bf16(v[2], v[3]);
                                *(u32x2*)(dst + ((unsigned)((k1 * 1024 + ch) * 2 + u.pm) * 128u + (unsigned)l2) * 2u) = w; } }
                    ROWFENCE; }
        } else if (ek == K_FNB) {
            unsigned char* dst = ws + OFF_GATE + SZ_GATE; const float scale = 1.0f / sqrtf((float)L_TOK * 256.0f);
#pragma unroll
            for (int ai = 0; ai < 2; ++ai)
#pragma unroll
                for (int m = 0; m < 4; ++m) { const int k2 = ai * 128 + m * 16 + rl0;
                    if (k2 < FN2) { const unsigned row = (unsigned)(u.aux + FN1 * k2);
#pragma unroll
                        for (int bj = 0; bj < 2; ++bj) { const unsigned off = (row * 1024u + (unsigned)(u.pn * 256 + bj * 128 + cl0)) * 2u; const u32x4 g = *(const u32x4*)(dst + off);
                            const f32x4 v0 = acc[ai][bj][m][0] * scale, v1 = acc[ai][bj][m][1] * scale;
                            u32x4 w; w.x = cvt_pk_bf16(v0[0] * lo_bf(g.x), v0[1] * hi_bf(g.x)); w.y = cvt_pk_bf16(v0[2] * lo_bf(g.y), v0[3] * hi_bf(g.y));
                            w.z = cvt_pk_bf16(v1[0] * lo_bf(g.z), v1[1] * hi_bf(g.z)); w.w = cvt_pk_bf16(v1[2] * lo_bf(g.w), v1[3] * hi_bf(g.w));
                            *(u32x4*)(dst + off) = w; } }
                    ROWFENCE; }
        } else if (ek == K_BR) {
            unsigned char* dst = ws + OFF_M; const unsigned char* mg = ws + OFF_MERGE; const int br = u.aux;
#pragma unroll
            for (int ai = 0; ai < 2; ++ai) { u32x4 gq[4][2], oq[4][2];
#pragma unroll
                for (int m = 0; m < 4; ++m) { const unsigned row = (unsigned)(u.pm * 256 + ai * 128 + m * 16 + rl0);
#pragma unroll
                    for (int bj = 0; bj < 2; ++bj) { const unsigned col = (unsigned)(u.pn * 256 + bj * 128 + cl0);
                        gq[m][bj] = *(const u32x4*)(mg + (row * 6144u + (unsigned)br * 2048u + col) * 2u);
                        if (br > 0) oq[m][bj] = *(const u32x4*)(dst + (row * (unsigned)DM + col) * 2u); else oq[m][bj] = (u32x4){0u, 0u, 0u, 0u}; } }
#pragma unroll
                for (int m = 0; m < 4; ++m) { const unsigned row = (unsigned)(u.pm * 256 + ai * 128 + m * 16 + rl0);
#pragma unroll
                    for (int bj = 0; bj < 2; ++bj) { const unsigned col = (unsigned)(u.pn * 256 + bj * 128 + cl0); const unsigned off = (row * (unsigned)DM + col) * 2u;
                        const u32x4 g = gq[m][bj], o = oq[m][bj]; const f32x4 v0 = acc[ai][bj][m][0], v1 = acc[ai][bj][m][1];
                        const float r0 = v0[0] * lo_bf(g.x) + lo_bf(o.x), r1 = v0[1] * hi_bf(g.x) + hi_bf(o.x), r2 = v0[2] * lo_bf(g.y) + lo_bf(o.y), r3 = v0[3] * hi_bf(g.y) + hi_bf(o.y);
                        const float r4 = v1[0] * lo_bf(g.z) + lo_bf(o.z), r5 = v1[1] * hi_bf(g.z) + hi_bf(o.z), r6 = v1[2] * lo_bf(g.w) + lo_bf(o.w), r7 = v1[3] * hi_bf(g.w) + hi_bf(o.w);
                        u32x4 w; w.x = cvt_pk_bf16(r0, r1); w.y = cvt_pk_bf16(r2, r3); w.z = cvt_pk_bf16(r4, r5); w.w = cvt_pk_bf16(r6, r7);
                        *(u32x4*)(dst + off) = w; } }
                ROWFENCE; }
        } else {
            unsigned char* dst = ws + OFF_H;
#pragma unroll
            for (int ai = 0; ai < 2; ++ai) { f32x4 oq[4][2][2];
#pragma unroll
                for (int m = 0; m < 4; ++m) { const unsigned row = (unsigned)(u.pm * 256 + ai * 128 + m * 16 + rl0);
#pragma unroll
                    for (int bj = 0; bj < 2; ++bj) { const unsigned off = (row * (unsigned)DM + (unsigned)(u.pn * 256 + bj * 128 + cl0)) * 4u; oq[m][bj][0] = *(const f32x4*)(dst + off); oq[m][bj][1] = *(const f32x4*)(dst + off + 16); } }
#pragma unroll
                for (int m = 0; m < 4; ++m) { const unsigned row = (unsigned)(u.pm * 256 + ai * 128 + m * 16 + rl0);
#pragma unroll
                    for (int bj = 0; bj < 2; ++bj) { const unsigned off = (row * (unsigned)DM + (unsigned)(u.pn * 256 + bj * 128 + cl0)) * 4u;
                        *(f32x4*)(dst + off) = oq[m][bj][0] + acc[ai][bj][m][0]; *(f32x4*)(dst + off + 16) = oq[m][bj][1] + acc[ai][bj][m][1]; } }
                ROWFENCE; }
        }
    }
};

__device__ void phase_prep0(const Params& p, unsigned char* smem) {
    const int tid = opaque_tid(), bid = blockIdx.x, G = gridDim.x;
    const size_t gtid = (size_t)bid * NTHREADS + tid, gstride = (size_t)G * NTHREADS;
    { f32x4* h4 = (f32x4*)(p.ws + OFF_H); const f32x4* x4 = (const f32x4*)p.x; const f32x4* m4 = (const f32x4*)p.meta;
      for (size_t i = gtid; i < (size_t)LP * 512; i += gstride) { const size_t row = i >> 9; f32x4 v = (f32x4){0.f, 0.f, 0.f, 0.f};
          if (row < NMETA) v = m4[i]; else if (row < L_TOK) v = x4[i - (size_t)NMETA * 512]; h4[i] = v; } }
    { bf16_t* fa = (bf16_t*)(p.ws + OFF_FA);
      for (size_t i = gtid; i < (size_t)512 * 384; i += gstride) { const int row = (int)(i / 384), col = (int)(i % 384); const int po = row >> 8, k1 = row & 255, pi = col / 192, l1 = col % 192; float v = 0.f;
          if (k1 < FN1 && l1 < FN1) { const int r = (k1 * l1) % FN1; const float a = 2.0f * (float)r / (float)FN1; const float cs = cospif(a), sn = sinpif(a);
              v = (po == 0) ? (pi == 0 ? cs : sn) : (pi == 0 ? -sn : cs); }
          fa[i] = f2bf(v); } }
    { bf16_t* fb = (bf16_t*)(p.ws + OFF_FB);
      for (size_t i = gtid; i < (size_t)FN1 * 65536; i += gstride) { const int k1 = (int)(i >> 16), k2 = (int)((i >> 8) & 255), kk = (int)(i & 255), part = kk >> 7, l2 = kk & 127; float v = 0.f;
          if (k2 < FN2 && l2 < FN2) { const int lp = k1 + FN1 * k2; const int r = (l2 * lp) % L_TOK; const float a = 2.0f * (float)r / (float)L_TOK; v = part == 0 ? cospif(a) : sinpif(a); }
          fb[i] = f2bf(v); } }
    { float* w1s = (float*)smem;
      float* w2s = w1s + 33 * 64;
      float* w3s = w2s + 64 * 64;
      const int lane = tid & 63, wv = tid >> 6;
      for (int layer = 0; layer < 2; ++layer) {
          __syncthreads();
          for (int i = tid; i < 33 * 64; i += NTHREADS) w1s[i] = p.f_w1[layer * 33 * 64 + i];
          for (int i = tid; i < 64 * 64; i += NTHREADS) { w2s[i] = p.f_w2[layer * 4096 + i]; w3s[i] = p.f_w3[layer * 4096 + i]; }
          __syncthreads();
          const float b1 = p.f_b1[layer * 64 + lane], b2 = p.f_b2[layer * 64 + lane], b3 = p.f_b3[layer * 64 + lane], fr = p.f_freq[layer * 64 + lane];
          bf16_t* h3 = (bf16_t*)(p.ws + OFF_H3) + (size_t)layer * L_TOK * 64;
          for (int lag = bid * 8 + wv; lag < L_TOK; lag += G * 8) {
              const float tt = (float)lag / (float)(L_TOK - 1); const float w = 6.283185307179586f * (float)lag / (float)L_TOK;
              float z = 0.f;
              if (lane == 0) z = tt;
              else if (lane < 33) { const int j = (lane - 1) & 15; const float f = 1e-4f + (float)j * ((15.0f - 1e-4f) / 15.0f); const float a = f * w; z = lane < 17 ? cosf(a) : -sinf(a); }
              float a1 = b1;
#pragma unroll 3
              for (int i = 0; i < 33; ++i) a1 += __shfl(z, i) * w1s[i * 64 + lane];
              const float h1 = sinf(fr * a1);
              float a2 = b2;
#pragma unroll 8
              for (int i = 0; i < 64; ++i) a2 += __shfl(h1, i) * w2s[i * 64 + lane];
              const float h2 = sinf(fr * a2);
              float a3 = b3;
#pragma unroll 8
              for (int i = 0; i < 64; ++i) a3 += __shfl(h2, i) * w3s[i * 64 + lane];
              h3[(size_t)lag * 64 + lane] = f2bf(sinf(fr * a3));
          }
      }
      __syncthreads(); }
}

__device__ __forceinline__ void convert_tile(const float* src, int K, int N, bf16_t* dst, int kt, int nt_, float* tile  ) {
    const int tid = opaque_tid();
    __syncthreads();
#pragma unroll
    for (int ps = 0; ps < 2; ++ps) { const int kl = ps * 32 + (tid >> 4), n4 = (tid & 15) * 4;
        const f32x4 v = *(const f32x4*)(src + (size_t)(kt * 64 + kl) * N + nt_ * 64 + n4);
        tile[kl * 65 + n4] = v[0]; tile[kl * 65 + n4 + 1] = v[1]; tile[kl * 65 + n4 + 2] = v[2]; tile[kl * 65 + n4 + 3] = v[3]; }
    __syncthreads();
    const int nl = tid >> 3, k8 = (tid & 7) * 8;
    u32x4 w; w.x = cvt_pk_bf16(tile[(k8 + 0) * 65 + nl], tile[(k8 + 1) * 65 + nl]); w.y = cvt_pk_bf16(tile[(k8 + 2) * 65 + nl], tile[(k8 + 3) * 65 + nl]);
    w.z = cvt_pk_bf16(tile[(k8 + 4) * 65 + nl], tile[(k8 + 5) * 65 + nl]); w.w = cvt_pk_bf16(tile[(k8 + 6) * 65 + nl], tile[(k8 + 7) * 65 + nl]);
    *(u32x4*)(dst + (size_t)(nt_ * 64 + nl) * K + kt * 64 + k8) = w;
}

__device__ void phase_p1(const Params& p, int layer, unsigned char* smem) {
    const int tid = opaque_tid(), bid = blockIdx.x, G = gridDim.x;
    float* tile = (float*)smem;
    { const float* win = p.w_in + (size_t)layer * DM * NIN;
      for (int t = bid; t < 32 * 256; t += G) convert_tile(win, DM, NIN, (bf16_t*)(p.ws + OFF_WT), t & 31, t >> 5, tile);
      for (int br = 0; br < 3; ++br) { const float* wsrc = (br == 0 ? p.w_a : br == 1 ? p.w_b : p.w_c) + (size_t)layer * 1024 * DM;
          for (int t = bid; t < 16 * 32; t += G) convert_tile(wsrc, 1024, DM, (bf16_t*)(p.ws + OFF_WA + br * SZ_WBR), t & 15, t >> 4, tile); }
      const float* wo = p.w_out + (size_t)layer * DM * DM;
      for (int t = bid; t < 32 * 32; t += G) convert_tile(wo, DM, DM, (bf16_t*)(p.ws + OFF_WO), t & 31, t >> 5, tile);
      __syncthreads(); }
    { float* tileT = (float*)smem;
      float* ctab = tileT + 256 * 32;
      float* stab = ctab + 256;
      const float* win = p.w_in + (size_t)layer * DM * NIN;
      for (int t = bid; t < 256; t += G) { const int g = t >> 6, k0 = (t & 63) * 32;
          __syncthreads();
          if (tid < 256) { const float a = 2.0f * (float)tid / 256.0f; ctab[tid] = cospif(a); stab[tid] = sinpif(a); }
#pragma unroll
          for (int ps = 0; ps < 4; ++ps) { const int idx = ps * NTHREADS + tid; const int kl = idx >> 6, c4 = (idx & 63) * 4;
              const f32x4 v = *(const f32x4*)(win + (size_t)(k0 + kl) * NIN + 4096 + g * 256 + c4);
              tileT[(c4 + 0) * 32 + kl] = v[0]; tileT[(c4 + 1) * 32 + kl] = v[1]; tileT[(c4 + 2) * 32 + kl] = v[2]; tileT[(c4 + 3) * 32 + kl] = v[3]; }
          __syncthreads();
          const int cp = tid & 255, part = tid >> 8;
          float acc[32];
#pragma unroll
          for (int k = 0; k < 32; ++k) acc[k] = 0.f;
          for (int c = 0; c < 256; ++c) { const int r = (c * cp) & 255; const float tw = part == 0 ? ctab[r] : -stab[r];
#pragma unroll
              for (int k4 = 0; k4 < 8; ++k4) { const f32x4 v = *(const f32x4*)(tileT + c * 32 + k4 * 4); acc[k4 * 4 + 0] += v[0] * tw; acc[k4 * 4 + 1] += v[1] * tw; acc[k4 * 4 + 2] += v[2] * tw; acc[k4 * 4 + 3] += v[3] * tw; } }
          bf16_t* dst = (bf16_t*)(p.ws + OFF_WEFF) + (size_t)(part * 1024 + g * 256 + cp) * DM + k0;
#pragma unroll
          for (int k8 = 0; k8 < 4; ++k8) { u32x4 w; w.x = cvt_pk_bf16(acc[k8 * 8 + 0], acc[k8 * 8 + 1]); w.y = cvt_pk_bf16(acc[k8 * 8 + 2], acc[k8 * 8 + 3]); w.z = cvt_pk_bf16(acc[k8 * 8 + 4], acc[k8 * 8 + 5]); w.w = cvt_pk_bf16(acc[k8 * 8 + 6], acc[k8 * 8 + 7]);
              *(u32x4*)(dst + k8 * 8) = w; } }
      __syncthreads(); }
    { const int lane = tid & 63, wv = tid >> 6; const float* h = (const float*)(p.ws + OFF_H); const float* gam = p.norm_g + layer * DM;
      bf16_t* xn = (bf16_t*)(p.ws + OFF_XN); bf16_t* xnp = (bf16_t*)(p.ws + OFF_XNP);
      for (int l = bid * 8 + wv; l < LP; l += G * 8) {
          if (l < L_TOK) { const f32x4* row = (const f32x4*)(h + (size_t)l * DM); f32x4 v[8]; float ss = 0.f;
#pragma unroll
              for (int i = 0; i < 8; ++i) { v[i] = row[i * 64 + lane]; ss += v[i][0] * v[i][0] + v[i][1] * v[i][1] + v[i][2] * v[i][2] + v[i][3] * v[i][3]; }
              ss = wave_sum(ss); const float inv = rsqrtf(ss * (1.0f / DM) + 1e-6f);
              const int l1 = l / FN2, l2 = l - l1 * FN2; const size_t pr = (size_t)l2 * FN1P + l1;
#pragma unroll
              for (int i = 0; i < 8; ++i) { const f32x4 gg = ((const f32x4*)gam)[i * 64 + lane]; u32x2 w; w.x = cvt_pk_bf16(v[i][0] * inv * gg[0], v[i][1] * inv * gg[1]); w.y = cvt_pk_bf16(v[i][2] * inv * gg[2], v[i][3] * inv * gg[3]);
                  *(u32x2*)(xn + (size_t)l * DM + (i * 64 + lane) * 4) = w; *(u32x2*)(xnp + pr * DM + (i * 64 + lane) * 4) = w; } }
          else { const u32x2 z = (u32x2){0u, 0u};
#pragma unroll
              for (int i = 0; i < 8; ++i) *(u32x2*)(xn + (size_t)l * DM + (i * 64 + lane) * 4) = z; } }
      for (int idx = bid * 8 + wv; idx < FN2 * (FN1P - FN1); idx += G * 8) { const int l2 = idx / (FN1P - FN1), l1 = FN1 + idx % (FN1P - FN1); const size_t pr = (size_t)l2 * FN1P + l1; const u32x2 z = (u32x2){0u, 0u};
#pragma unroll
          for (int i = 0; i < 8; ++i) *(u32x2*)(xnp + pr * DM + (i * 64 + lane) * 4) = z; } }
}

__device__ void na_unit(const Params& p, int layer, int r, int hd, unsigned char* smem) {
    const int tid = opaque_tid(), wv = tid >> 6, lane = tid & 63, l15 = lane & 15, quad = lane >> 4;
    const bf16_t* qkv = (const bf16_t*)(p.ws + OFF_QKV);
    const int r0 = min(max(r - 4, 0), 248);
    unsigned char* sK = smem;
    bf16_t* sVT = (bf16_t*)(smem + 76032);
    float* sRPB = (float*)(smem + 144640);
    float* sMB = (float*)(smem + 146512);
    __syncthreads();
#pragma unroll
    for (int ps = 0; ps < 8; ++ps) { const int tok = ps * 64 + (tid >> 3), ch = tid & 7; const size_t g = (size_t)(NMETA + r0 * 64 + tok) * 3072 + hd * 64 + ch * 8;
        const u32x4 kv = *(const u32x4*)(qkv + g + 1024), vv = *(const u32x4*)(qkv + g + 2048);
        *(u32x4*)(sK + tok * 144 + ch * 16) = kv;
        bf16_t* vt = sVT + (ch * 8) * 536 + tok;
        vt[0] = (bf16_t)vv.x; vt[536] = (bf16_t)(vv.x >> 16); vt[2 * 536] = (bf16_t)vv.y; vt[3 * 536] = (bf16_t)(vv.y >> 16);
        vt[4 * 536] = (bf16_t)vv.z; vt[5 * 536] = (bf16_t)(vv.z >> 16); vt[6 * 536] = (bf16_t)vv.w; vt[7 * 536] = (bf16_t)(vv.w >> 16); }
    if (tid < 128) { const int tok = tid >> 3, ch = tid & 7; const size_t g = (size_t)tok * 3072 + hd * 64 + ch * 8;
        const u32x4 kv = *(const u32x4*)(qkv + g + 1024), vv = *(const u32x4*)(qkv + g + 2048);
        *(u32x4*)(sK + (512 + tok) * 144 + ch * 16) = kv;
        bf16_t* vt = sVT + (ch * 8) * 536 + 512 + tok;
        vt[0] = (bf16_t)vv.x; vt[536] = (bf16_t)(vv.x >> 16); vt[2 * 536] = (bf16_t)vv.y; vt[3 * 536] = (bf16_t)(vv.y >> 16);
        vt[4 * 536] = (bf16_t)vv.z; vt[5 * 536] = (bf16_t)(vv.z >> 16); vt[6 * 536] = (bf16_t)vv.w; vt[7 * 536] = (bf16_t)(vv.w >> 16); }
    if (tid < 465) sRPB[tid] = p.rpb[(size_t)(layer * 16 + hd) * 465 + tid];
    if (tid >= 480 && tid < 496) sMB[tid - 480] = p.meta_bias[(layer * 16 + hd) * 16 + tid - 480];
    const int cb = wv & 3, hf = wv >> 2, c = cb * 16 + l15;
    const bf16_t* qp = qkv + (size_t)(NMETA + r * 64 + c) * 3072 + hd * 64 + quad * 8;
    const bf16x8 bq0 = *(const bf16x8*)qp, bq1 = *(const bf16x8*)(qp + 32);
    __syncthreads();
    const int cu = cb == 0 ? 0 : (cb == 1 ? 8 : (cb == 2 ? 24 : 32)), cs = min(max(c - 8, 0), 48);
    float sc[9][4];
#pragma unroll
    for (int ti = 0; ti < 9; ++ti) { const int j = 4 * hf + (ti >> 1), tt = ti & 1; const int slot0 = ti < 8 ? j * 64 + cu + tt * 16 : 512;
        const unsigned char* kp = sK + (slot0 + l15) * 144 + quad * 16;
        const bf16x8 a0 = *(const bf16x8*)kp, a1 = *(const bf16x8*)(kp + 64);
        f32x4 acc = (f32x4){0.f, 0.f, 0.f, 0.f};
        acc = __builtin_amdgcn_mfma_f32_16x16x32_bf16(a0, bq0, acc, 0, 0, 0); acc = __builtin_amdgcn_mfma_f32_16x16x32_bf16(a1, bq1, acc, 0, 0, 0);
        if (ti < 8) { const float* rp = sRPB + (r0 + j - r + 7) * 31 + (15 - c);
#pragma unroll
            for (int rr = 0; rr < 4; ++rr) { const int kc = cu + tt * 16 + quad * 4 + rr; const bool ok = kc >= cs && kc < cs + 16; const int kcc = ok ? kc : cs;
                sc[ti][rr] = ok ? acc[rr] * 0.125f + rp[kcc] : -1.0e30f; } }
        else {
#pragma unroll
            for (int rr = 0; rr < 4; ++rr) sc[ti][rr] = hf == 0 ? acc[rr] * 0.125f + sMB[quad * 4 + rr] : -1.0e30f; } }
    float mx = -1.0e30f;
#pragma unroll
    for (int ti = 0; ti < 9; ++ti)
#pragma unroll
        for (int rr = 0; rr < 4; ++rr) mx = fmaxf(mx, sc[ti][rr]);
    mx = fmaxf(mx, __shfl_xor(mx, 16)); mx = fmaxf(mx, __shfl_xor(mx, 32));
    float lsum = 0.f;
#pragma unroll
    for (int ti = 0; ti < 9; ++ti)
#pragma unroll
        for (int rr = 0; rr < 4; ++rr) { sc[ti][rr] = __expf(sc[ti][rr] - mx); lsum += sc[ti][rr]; }
    lsum += __shfl_xor(lsum, 16); lsum += __shfl_xor(lsum, 32);
    f32x4 oacc[4];
#pragma unroll
    for (int dt = 0; dt < 4; ++dt) oacc[dt] = (f32x4){0.f, 0.f, 0.f, 0.f};
#pragma unroll
    for (int ks = 0; ks < 5; ++ks) { const int tA = 2 * ks, tB = 2 * ks + 1;
        const int jA = 4 * hf + (tA >> 1); const int slotA = tA < 8 ? jA * 64 + cu + (tA & 1) * 16 : 512; const int slotB = ks < 4 ? (4 * hf + (tB >> 1)) * 64 + cu + 16 : 512;
        u32x4 pa; pa.x = cvt_pk_bf16(sc[tA][0], sc[tA][1]); pa.y = cvt_pk_bf16(sc[tA][2], sc[tA][3]);
        if (ks < 4) { pa.z = cvt_pk_bf16(sc[tA + 1 < 9 ? tA + 1 : 8][0], sc[tA + 1 < 9 ? tA + 1 : 8][1]); pa.w = cvt_pk_bf16(sc[tA + 1 < 9 ? tA + 1 : 8][2], sc[tA + 1 < 9 ? tA + 1 : 8][3]); } else { pa.z = 0u; pa.w = 0u; }
        const bf16x8 af = __builtin_bit_cast(bf16x8, pa);
#pragma unroll
        for (int dt = 0; dt < 4; ++dt) { const bf16_t* vr = sVT + (dt * 16 + l15) * 536 + quad * 4;
            const u32x2 lo = *(const u32x2*)(vr + slotA), hi = *(const u32x2*)(vr + slotB);
            const u32x4 bb = (u32x4){lo.x, lo.y, hi.x, hi.y};
            oacc[dt] = __builtin_amdgcn_mfma_f32_16x16x32_bf16(af, __builtin_bit_cast(bf16x8, bb), oacc[dt], 0, 0, 0); } }
    __syncthreads();
    float* part = (float*)smem + cb * 1056;
    if (hf == 1) {
#pragma unroll
        for (int dt = 0; dt < 4; ++dt)
#pragma unroll
            for (int rr = 0; rr < 4; ++rr) part[(quad * 4 + rr) * 64 + dt * 16 + l15] = oacc[dt][rr];
        if (quad == 0) { part[1024 + l15] = mx; part[1040 + l15] = lsum; } }
    __syncthreads();
    if (hf == 0) { bf16_t* yc = (bf16_t*)(p.ws + OFF_GATE + 2 * SZ_GATE);
#pragma unroll
        for (int rr = 0; rr < 4; ++rr) { const int qy = quad * 4 + rr; const float m0 = __shfl(mx, qy), l0 = __shfl(lsum, qy); const float m1 = part[1024 + qy], l1 = part[1040 + qy];
            const float M = fmaxf(m0, m1), f0 = __expf(m0 - M), f1 = __expf(m1 - M); const float inv = 1.0f / (f0 * l0 + f1 * l1);
            bf16_t* gp = yc + (size_t)(NMETA + r * 64 + cb * 16 + qy) * 1024 + hd * 64 + l15;
#pragma unroll
            for (int dt = 0; dt < 4; ++dt) { const float o = (f0 * oacc[dt][rr] + f1 * part[qy * 64 + dt * 16 + l15]) * inv; gp[dt * 16] = f2bf(o * bf2f(gp[dt * 16])); } } }
}
__device__ void na_meta_unit(const Params& p, int layer) {
    const int tid = opaque_tid();
    if (tid < 256) { const int hd = tid >> 4, qi = tid & 15; const bf16_t* qkv = (const bf16_t*)(p.ws + OFF_QKV);
        float q[64];
        { const u32x4* qp = (const u32x4*)(qkv + (size_t)qi * 3072 + hd * 64);
#pragma unroll
          for (int i = 0; i < 8; ++i) { const u32x4 v = qp[i]; q[i * 8 + 0] = lo_bf(v.x) * 0.125f; q[i * 8 + 1] = hi_bf(v.x) * 0.125f; q[i * 8 + 2] = lo_bf(v.y) * 0.125f; q[i * 8 + 3] = hi_bf(v.y) * 0.125f;
              q[i * 8 + 4] = lo_bf(v.z) * 0.125f; q[i * 8 + 5] = hi_bf(v.z) * 0.125f; q[i * 8 + 6] = lo_bf(v.w) * 0.125f; q[i * 8 + 7] = hi_bf(v.w) * 0.125f; } }
        float o[64];
#pragma unroll
        for (int i = 0; i < 64; ++i) o[i] = 0.f;
        float mx = -3.0e38f, lsum = 0.f;
#pragma unroll 1
        for (int m = 0; m < 16; ++m) { const u32x4* kp = (const u32x4*)(qkv + (size_t)m * 3072 + 1024 + hd * 64); const u32x4* vp = (const u32x4*)(qkv + (size_t)m * 3072 + 2048 + hd * 64);
            float d0 = 0.f, d1 = 0.f;
#pragma unroll
            for (int e = 0; e < 8; ++e) { const u32x4 v = kp[e];
                d0 += q[e * 8 + 0] * lo_bf(v.x) + q[e * 8 + 2] * lo_bf(v.y) + q[e * 8 + 4] * lo_bf(v.z) + q[e * 8 + 6] * lo_bf(v.w);
                d1 += q[e * 8 + 1] * hi_bf(v.x) + q[e * 8 + 3] * hi_bf(v.y) + q[e * 8 + 5] * hi_bf(v.z) + q[e * 8 + 7] * hi_bf(v.w); }
            const float sc = d0 + d1 + p.meta_bias[(layer * 16 + hd) * 16 + m]; const float mnew = fmaxf(mx, sc); const float alpha = __expf(mx - mnew), pi = __expf(sc - mnew);
            lsum = lsum * alpha + pi; mx = mnew;
#pragma unroll
            for (int e = 0; e < 8; ++e) { const u32x4 v = vp[e];
                o[e * 8 + 0] = o[e * 8 + 0] * alpha + pi * lo_bf(v.x); o[e * 8 + 1] = o[e * 8 + 1] * alpha + pi * hi_bf(v.x); o[e * 8 + 2] = o[e * 8 + 2] * alpha + pi * lo_bf(v.y); o[e * 8 + 3] = o[e * 8 + 3] * alpha + pi * hi_bf(v.y);
                o[e * 8 + 4] = o[e * 8 + 4] * alpha + pi * lo_bf(v.z); o[e * 8 + 5] = o[e * 8 + 5] * alpha + pi * hi_bf(v.z); o[e * 8 + 6] = o[e * 8 + 6] * alpha + pi * lo_bf(v.w); o[e * 8 + 7] = o[e * 8 + 7] * alpha + pi * hi_bf(v.w); } }
        const float inv = 1.0f / lsum; u32x4* gp = (u32x4*)((bf16_t*)(p.ws + OFF_GATE + 2 * SZ_GATE) + (size_t)qi * 1024 + hd * 64);
#pragma unroll
        for (int e = 0; e < 8; ++e) { const u32x4 g = gp[e]; u32x4 w;
            w.x = cvt_pk_bf16(o[e * 8 + 0] * inv * lo_bf(g.x), o[e * 8 + 1] * inv * hi_bf(g.x)); w.y = cvt_pk_bf16(o[e * 8 + 2] * inv * lo_bf(g.y), o[e * 8 + 3] * inv * hi_bf(g.y));
            w.z = cvt_pk_bf16(o[e * 8 + 4] * inv * lo_bf(g.z), o[e * 8 + 5] * inv * hi_bf(g.z)); w.w = cvt_pk_bf16(o[e * 8 + 6] * inv * lo_bf(g.w), o[e * 8 + 7] * inv * hi_bf(g.w));
            gp[e] = w; } }
}

__device__ __forceinline__ unsigned rev4_14(unsigned k) { unsigned r = __brev(k) >> 18; return ((r & 0x1555u) << 1) | ((r >> 1) & 0x1555u); }
__device__ __forceinline__ float2 cmul(float2 a, float2 b) { return make_float2(a.x * b.x - a.y * b.y, a.x * b.y + a.y * b.x); }
#define PADI(i) ((i) + ((i) >> 4))
#define CFF(n) cff[2 * PADI((n) >> 1) + ((n) & 1)]
__device__ __forceinline__ void hw_sincos(float rev, float& sn, float& cs) { sn = __builtin_amdgcn_sinf(rev); cs = __builtin_amdgcn_cosf(rev); }
__device__ __forceinline__ float c16(int k) { const float t[10] = {1.0f, 0.9238795325f, 0.7071067812f, 0.3826834324f, 0.0f, -0.3826834324f, -0.7071067812f, -0.9238795325f, -1.0f, -0.9238795325f}; return t[k]; }
__device__ __forceinline__ float s16(int k) { const float t[10] = {0.0f, 0.3826834324f, 0.7071067812f, 0.9238795325f, 1.0f, 0.9238795325f, 0.7071067812f, 0.3826834324f, 0.0f, -0.3826834324f}; return t[k]; }
__device__ void fft_fwd(float2* a) {
    for (int span = 4096; span >= 16; span >>= 2) {
        for (int b = opaque_tid(); b < 4096; b += NTHREADS) { const int j = b & (span - 1); const int base = ((b - j) << 2) + j;
            const int i0 = PADI(base), i1 = PADI(base + span), i2 = PADI(base + 2 * span), i3 = PADI(base + 3 * span);
            const float2 a0 = a[i0], a1 = a[i1], a2 = a[i2], a3 = a[i3];
            const float2 t0 = make_float2(a0.x + a2.x, a0.y + a2.y), t1 = make_float2(a0.x - a2.x, a0.y - a2.y), t2 = make_float2(a1.x + a3.x, a1.y + a3.y);
            const float2 t3 = make_float2(a1.y - a3.y, -(a1.x - a3.x));
            float sn, cs; hw_sincos((float)j / (float)(4 * span), sn, cs);
            const float2 w1 = make_float2(cs, -sn), w2 = cmul(w1, w1), w3 = cmul(w2, w1);
            a[i0] = make_float2(t0.x + t2.x, t0.y + t2.y);
            a[i1] = cmul(make_float2(t1.x + t3.x, t1.y + t3.y), w1);
            a[i2] = cmul(make_float2(t0.x - t2.x, t0.y - t2.y), w2);
            a[i3] = cmul(make_float2(t1.x - t3.x, t1.y - t3.y), w3); }
        __syncthreads(); }
    for (int blk = opaque_tid(); blk < 1024; blk += NTHREADS) { float2* pb = a + blk * 17; float2 x[16];
#pragma unroll
        for (int e = 0; e < 16; ++e) x[e] = pb[e];
#pragma unroll
        for (int j = 0; j < 4; ++j) { const float2 a0 = x[j], a1 = x[j + 4], a2 = x[j + 8], a3 = x[j + 12];
            const float2 t0 = make_float2(a0.x + a2.x, a0.y + a2.y), t1 = make_float2(a0.x - a2.x, a0.y - a2.y), t2 = make_float2(a1.x + a3.x, a1.y + a3.y), t3 = make_float2(a1.y - a3.y, -(a1.x - a3.x));
            x[j] = make_float2(t0.x + t2.x, t0.y + t2.y);
            x[j + 4] = cmul(make_float2(t1.x + t3.x, t1.y + t3.y), make_float2(c16(j), -s16(j)));
            x[j + 8] = cmul(make_float2(t0.x - t2.x, t0.y - t2.y), make_float2(c16(2 * j), -s16(2 * j)));
            x[j + 12] = cmul(make_float2(t1.x - t3.x, t1.y - t3.y), make_float2(c16(3 * j), -s16(3 * j))); }
#pragma unroll
        for (int g = 0; g < 4; ++g) { const float2 a0 = x[4 * g], a1 = x[4 * g + 1], a2 = x[4 * g + 2], a3 = x[4 * g + 3];
            const float2 t0 = make_float2(a0.x + a2.x, a0.y + a2.y), t1 = make_float2(a0.x - a2.x, a0.y - a2.y), t2 = make_float2(a1.x + a3.x, a1.y + a3.y), t3 = make_float2(a1.y - a3.y, -(a1.x - a3.x));
            x[4 * g] = make_float2(t0.x + t2.x, t0.y + t2.y); x[4 * g + 1] = make_float2(t1.x + t3.x, t1.y + t3.y);
            x[4 * g + 2] = make_float2(t0.x - t2.x, t0.y - t2.y); x[4 * g + 3] = make_float2(t1.x - t3.x, t1.y - t3.y); }
#pragma unroll
        for (int e = 0; e < 16; ++e) pb[e] = x[e]; }
    __syncthreads();
}
__device__ void fft_inv(float2* a) {
    for (int blk = opaque_tid(); blk < 1024; blk += NTHREADS) { float2* pb = a + blk * 17; float2 x[16];
#pragma unroll
        for (int e = 0; e < 16; ++e) x[e] = pb[e];
#pragma unroll
        for (int g = 0; g < 4; ++g) { const float2 a0 = x[4 * g], a1 = x[4 * g + 1], a2 = x[4 * g + 2], a3 = x[4 * g + 3];
            const float2 t0 = make_float2(a0.x + a2.x, a0.y + a2.y), t1 = make_float2(a0.x - a2.x, a0.y - a2.y), t2 = make_float2(a1.x + a3.x, a1.y + a3.y), t3 = make_float2(-(a1.y - a3.y), a1.x - a3.x);
            x[4 * g] = make_float2(t0.x + t2.x, t0.y + t2.y); x[4 * g + 1] = make_float2(t1.x + t3.x, t1.y + t3.y);
            x[4 * g + 2] = make_float2(t0.x - t2.x, t0.y - t2.y); x[4 * g + 3] = make_float2(t1.x - t3.x, t1.y - t3.y); }
#pragma unroll
        for (int j = 0; j < 4; ++j) { const float2 a0 = x[j], a1 = cmul(x[j + 4], make_float2(c16(j), s16(j))), a2 = cmul(x[j + 8], make_float2(c16(2 * j), s16(2 * j))), a3 = cmul(x[j + 12], make_float2(c16(3 * j), s16(3 * j)));
            const float2 t0 = make_float2(a0.x + a2.x, a0.y + a2.y), t1 = make_float2(a0.x - a2.x, a0.y - a2.y), t2 = make_float2(a1.x + a3.x, a1.y + a3.y), t3 = make_float2(-(a1.y - a3.y), a1.x - a3.x);
            x[j] = make_float2(t0.x + t2.x, t0.y + t2.y); x[j + 4] = make_float2(t1.x + t3.x, t1.y + t3.y);
            x[j + 8] = make_float2(t0.x - t2.x, t0.y - t2.y); x[j + 12] = make_float2(t1.x - t3.x, t1.y - t3.y); }
#pragma unroll
        for (int e = 0; e < 16; ++e) pb[e] = x[e]; }
    __syncthreads();
    for (int span = 16; span <= 4096; span <<= 2) {
        for (int b = opaque_tid(); b < 4096; b += NTHREADS) { const int j = b & (span - 1); const int base = ((b - j) << 2) + j;
            const int i0 = PADI(base), i1 = PADI(base + span), i2 = PADI(base + 2 * span), i3 = PADI(base + 3 * span);
            float sn, cs; hw_sincos((float)j / (float)(4 * span), sn, cs);
            const float2 w1 = make_float2(cs, sn), w2 = cmul(w1, w1), w3 = cmul(w2, w1);
            const float2 a0 = a[i0], a1 = cmul(a[i1], w1), a2 = cmul(a[i2], w2), a3 = cmul(a[i3], w3);
            const float2 t0 = make_float2(a0.x + a2.x, a0.y + a2.y), t1 = make_float2(a0.x - a2.x, a0.y - a2.y), t2 = make_float2(a1.x + a3.x, a1.y + a3.y);
            const float2 t3 = make_float2(-(a1.y - a3.y), a1.x - a3.x);
            a[i0] = make_float2(t0.x + t2.x, t0.y + t2.y);
            a[i1] = make_float2(t1.x + t3.x, t1.y + t3.y);
            a[i2] = make_float2(t0.x - t2.x, t0.y - t2.y);
            a[i3] = make_float2(t1.x - t3.x, t1.y - t3.y); }
        __syncthreads(); }
}
__device__ __forceinline__ void hy_val8(const bf16_t* __restrict__ row, int t0, const float (&w)[4], float (&o)[8]) {
    const u32x4 v = *(const u32x4*)(row + t0);
    float x[10];
    x[0] = t0 > 0 ? bf2f(row[t0 - 1]) : 0.f; x[9] = (t0 + 8 < L_TOK) ? bf2f(row[t0 + 8]) : 0.f;
    x[1] = lo_bf(v.x); x[2] = hi_bf(v.x); x[3] = lo_bf(v.y); x[4] = hi_bf(v.y); x[5] = lo_bf(v.z); x[6] = hi_bf(v.z); x[7] = lo_bf(v.w); x[8] = hi_bf(v.w);
#pragma unroll
    for (int e = 0; e < 8; ++e) o[e] = w[0] * x[e] + w[1] * x[e + 1] + w[2] * x[e + 2] + w[3];
}
struct HyCh { const bf16_t* __restrict__ ru; const bf16_t* __restrict__ r1; const bf16_t* __restrict__ r2; float wu[4], w1[4], w2[4]; };

constexpr int SD_W4B = 0  , SD_GFX = 512, SD_GBX = 528, SD_EF = 544, SD_EB = 560, SD_VH = 576, SD_VT = 592, SD_END = 608;
constexpr int NCHUNK = L_TOK / 8;

template <int ORDER>
__device__ void hy_conv(const HyCh& hc, float2* cf, float* side, unsigned char* scratch) {
    const int tid = opaque_tid(); float* cff = (float*)cf;
    f32x4* __restrict__ heo = (f32x4*)(scratch + HS_HEO); const float* __restrict__ z2g = (const float*)(scratch + HS_Z2);
    if (tid < 15) side[SD_EF + tid] = CFF(16369 + tid); else if (tid >= 32 && tid < 47) side[SD_EB + tid - 32] = CFF(32768 - (16369 + tid - 32));
    __syncthreads();
    fft_fwd(cf);
    for (int k = tid; k <= 8192; k += NTHREADS) { const int kp = (16384 - k) & 16383; const float2 a = cf[PADI(rev4_14(k))], bq = cf[PADI(rev4_14(kp))];
        const float bx = bq.x, by = -bq.y; const float sc = 1.0f / 16384.0f;
        heo[k] = (f32x4){0.5f * (a.x + bx) * sc, 0.5f * (a.y + by) * sc, 0.5f * (a.y - by) * sc, -0.5f * (a.x - bx) * sc}; }
    __syncthreads();
    for (int c = tid; c < NCHUNK; c += NTHREADS) { float v[8];
        if (ORDER == 0) hy_val8(hc.ru, 8 * c, hc.wu, v);
        else { const f32x4 p0 = *(const f32x4*)(z2g + 8 * c), p1 = *(const f32x4*)(z2g + 8 * c + 4); v[0] = p0[0]; v[1] = p0[1]; v[2] = p0[2]; v[3] = p0[3]; v[4] = p1[0]; v[5] = p1[1]; v[6] = p1[2]; v[7] = p1[3]; }
        float2* d = cf + PADI(4 * c); d[0] = make_float2(v[0], v[1]); d[1] = make_float2(v[2], v[3]); d[2] = make_float2(v[4], v[5]); d[3] = make_float2(v[6], v[7]);
        if (c < 2) {
#pragma unroll
            for (int e = 0; e < 8; ++e) side[SD_VH + 8 * c + e] = v[e]; }
        if (c >= NCHUNK - 2) {
#pragma unroll
            for (int e = 0; e < 8; ++e) side[SD_VT + 8 * (c - (NCHUNK - 2)) + e] = v[e]; } }
    for (int i = L_TOK / 2 + tid; i < 16384; i += NTHREADS) cf[PADI(i)] = make_float2(0.f, 0.f);
    __syncthreads();
    fft_fwd(cf);
#pragma unroll 4
    for (int k = tid; k <= 8192; k += NTHREADS) { const int kp = (16384 - k) & 16383; const unsigned ik = PADI(rev4_14(k)), ikp = PADI(rev4_14(kp)); const float2 a = cf[ik], bq = cf[ikp];
        const float bx = bq.x, by = -bq.y;
        const float2 XE = make_float2(0.5f * (a.x + bx), 0.5f * (a.y + by)), XO = make_float2(0.5f * (a.y - by), -0.5f * (a.x - bx));
        const f32x4 hh = heo[k]; const float2 HE = make_float2(hh[0], hh[1]), HO = make_float2(hh[2], hh[3]);
        float sn, cs; hw_sincos((float)k / 16384.0f, sn, cs); const float2 w = make_float2(cs, -sn);
        const float2 xoho = cmul(XO, HO), wx = cmul(w, xoho), xehe = cmul(XE, HE), xeho = cmul(XE, HO), xohe = cmul(XO, HE);
        const float2 YE = make_float2(xehe.x + wx.x, xehe.y + wx.y), YO = make_float2(xeho.x + xohe.x, xeho.y + xohe.y);
        cf[ik] = make_float2(YE.x - YO.y, YE.y + YO.x); cf[ikp] = make_float2(YE.x + YO.y, -YE.y + YO.x); }
    __syncthreads();
    fft_inv(cf);
    if (tid < 16) { const int t = tid; float d = 0.f;
        for (int s = t + 16384; s < L_TOK; ++s) { const int l = s - t; const float wrong = l == 16384 ? 0.f : side[SD_EF + 16399 - l]; d += (side[SD_GBX + l - 16384] - wrong) * side[SD_VT + s - 16384]; }
        CFF(t) += d; }
    else if (tid >= 32 && tid < 48) { const int t = 16384 + tid - 32; float d = 0.f;
        for (int s = 0; s <= t - 16384; ++s) { const int l = t - s; const float wrong = l == 16384 ? 0.f : side[SD_EB + 16399 - l]; d += (side[SD_GFX + l - 16384] - wrong) * side[SD_VH + s]; }
        CFF(t) += d; }
    __syncthreads();
}

__device__ void hyena_unit(const Params& p, int layer, int ch, unsigned char* smem, unsigned char* scratch) {
    const int tid = opaque_tid(); float2* cf = (float2*)smem; float* cff = (float*)smem; float* side = (float*)(smem + 139264);
    const bf16_t* hyin = (const bf16_t*)(p.ws + OFF_HYIN);
    HyCh hc; hc.ru = hyin + (size_t)ch * LP; hc.r1 = hyin + (size_t)(1024 + ch) * LP; hc.r2 = hyin + (size_t)(2048 + ch) * LP;
    { const float* cw = p.conv_w + (size_t)layer * 3 * 3072; const float* cb = p.conv_b + (size_t)layer * 3072;
#pragma unroll
      for (int jj = 0; jj < 3; ++jj) { hc.wu[jj] = cw[jj * 3072 + ch]; hc.w1[jj] = cw[jj * 3072 + 1024 + ch]; hc.w2[jj] = cw[jj * 3072 + 2048 + ch]; }
      hc.wu[3] = cb[ch]; hc.w1[3] = cb[1024 + ch]; hc.w2[3] = cb[2048 + ch]; }
    const float sk0 = p.skip[(layer * 2 + 0) * 1024 + ch], sk1 = p.skip[(layer * 2 + 1) * 1024 + ch];
    float* __restrict__ z2g = (float*)(scratch + HS_Z2); float* __restrict__ g2f = (float*)(scratch + HS_G2F); float* __restrict__ g2b = (float*)(scratch + HS_G2B);
    bf16_t* __restrict__ hyout = (bf16_t*)(p.ws + OFF_HYOUT) + (size_t)ch * LP;
    __syncthreads();
    { bf16_t* w4b = (bf16_t*)(side + SD_W4B);
      for (int i = tid; i < 16 * 64; i += NTHREADS) { const int n = i >> 6, k = i & 63; w4b[i] = n < 4 ? f2bf(p.f_w4[((size_t)layer * 64 + k) * 4096 + n * 1024 + ch]) : (bf16_t)0; }
      __syncthreads();
      const bf16_t* __restrict__ h3b = (const bf16_t*)(p.ws + OFF_H3) + (size_t)layer * L_TOK * 64;
      const int lane = tid & 63, wv = tid >> 6, col = lane & 15, quad = lane >> 4;
      const float dk = col < 4 ? fabsf(p.decay[((layer * 2 + (col >> 1)) * 2 + (col & 1)) * 1024 + ch]) * (1.4426950408889634f / (float)(L_TOK - 1)) : 0.f;
      const bf16x8 b0 = *(const bf16x8*)(w4b + col * 64 + quad * 8), b1 = *(const bf16x8*)(w4b + col * 64 + 32 + quad * 8);
      for (int gb = wv; gb < L_TOK / 16; gb += 64) {
          bf16x8 a0[8], a1[8];
#pragma unroll
          for (int i = 0; i < 8; ++i) { const int g = min(gb + 8 * i, L_TOK / 16 - 1); const bf16_t* hr = h3b + (size_t)(g * 16 + col) * 64 + quad * 8; a0[i] = *(const bf16x8*)hr; a1[i] = *(const bf16x8*)(hr + 32); }
#pragma unroll
          for (int i = 0; i < 8; ++i) { const int g = gb + 8 * i;
              if (g < L_TOK / 16) {
                  f32x4 acc = (f32x4){0.f, 0.f, 0.f, 0.f};
                  acc = __builtin_amdgcn_mfma_f32_16x16x32_bf16(a0[i], b0, acc, 0, 0, 0); acc = __builtin_amdgcn_mfma_f32_16x16x32_bf16(a1[i], b1, acc, 0, 0, 0);
                  if (col < 4) { const int lag0 = g * 16 + quad * 4; float v[4];
#pragma unroll
                      for (int r = 0; r < 4; ++r) v[r] = acc[r] * __builtin_amdgcn_exp2f(-(float)(lag0 + r) * dk);
                      if (col == 2) *(f32x4*)(g2f + lag0) = (f32x4){v[0], v[1], v[2], v[3]};
                      else if (col == 3) *(f32x4*)(g2b + lag0) = (f32x4){v[0], v[1], v[2], v[3]};
                      else if (col == 0) { if (lag0 < NMAIN) { float2* d = cf + PADI(lag0 >> 1); d[0] = make_float2(v[0], v[1]); d[1] = make_float2(v[2], v[3]); }
                                           else { side[SD_GFX + lag0 - NMAIN] = v[0]; side[SD_GFX + lag0 - NMAIN + 1] = v[1]; side[SD_GFX + lag0 - NMAIN + 2] = v[2]; side[SD_GFX + lag0 - NMAIN + 3] = v[3]; } }
                      else { if (lag0 < NMAIN) {
#pragma unroll
                                 for (int r = 0; r < 4; ++r) if (lag0 + r >= 1) CFF(32768 - lag0 - r) = v[r]; }
                             else { side[SD_GBX + lag0 - NMAIN] = v[0]; side[SD_GBX + lag0 - NMAIN + 1] = v[1]; side[SD_GBX + lag0 - NMAIN + 2] = v[2]; side[SD_GBX + lag0 - NMAIN + 3] = v[3]; } } } } } }
      if (tid == 0) CFF(NMAIN) = 0.f;
      __syncthreads(); }
    hy_conv<0>(hc, cf, side, scratch);
    for (int c = tid; c < NCHUNK; c += NTHREADS) { float u8[8], x8[8]; hy_val8(hc.ru, 8 * c, hc.wu, u8); hy_val8(hc.r1, 8 * c, hc.w1, x8);
        const float2* s = cf + PADI(4 * c); const float2 y0 = s[0], y1 = s[1], y2 = s[2], y3 = s[3];
        const f32x4 o0 = (f32x4){x8[0] * (y0.x + sk0 * u8[0]), x8[1] * (y0.y + sk0 * u8[1]), x8[2] * (y1.x + sk0 * u8[2]), x8[3] * (y1.y + sk0 * u8[3])};
        const f32x4 o1 = (f32x4){x8[4] * (y2.x + sk0 * u8[4]), x8[5] * (y2.y + sk0 * u8[5]), x8[6] * (y3.x + sk0 * u8[6]), x8[7] * (y3.y + sk0 * u8[7])};
        *(f32x4*)(z2g + 8 * c) = o0; *(f32x4*)(z2g + 8 * c + 4) = o1; }
    __syncthreads();
    for (int q = tid; q < L_TOK / 4; q += NTHREADS) { const int lag0 = 4 * q; const f32x4 gf = *(const f32x4*)(g2f + lag0), gb = *(const f32x4*)(g2b + lag0);
        if (lag0 < NMAIN) { float2* d = cf + PADI(lag0 >> 1); d[0] = make_float2(gf[0], gf[1]); d[1] = make_float2(gf[2], gf[3]);
#pragma unroll
            for (int r = 0; r < 4; ++r) if (lag0 + r >= 1) CFF(32768 - lag0 - r) = gb[r]; }
        else {
#pragma unroll
            for (int r = 0; r < 4; ++r) { side[SD_GFX + lag0 - NMAIN + r] = gf[r]; side[SD_GBX + lag0 - NMAIN + r] = gb[r]; } } }
    if (tid == 0) CFF(NMAIN) = 0.f;
    __syncthreads();
    hy_conv<1>(hc, cf, side, scratch);
    for (int c = tid; c < NCHUNK; c += NTHREADS) { float x8[8]; hy_val8(hc.r2, 8 * c, hc.w2, x8);
        const f32x4 p0 = *(const f32x4*)(z2g + 8 * c), p1 = *(const f32x4*)(z2g + 8 * c + 4);
        const float2* s = cf + PADI(4 * c); const float2 y0 = s[0], y1 = s[1], y2 = s[2], y3 = s[3];
        u32x4 w; w.x = cvt_pk_bf16(x8[0] * (y0.x + sk1 * p0[0]), x8[1] * (y0.y + sk1 * p0[1])); w.y = cvt_pk_bf16(x8[2] * (y1.x + sk1 * p0[2]), x8[3] * (y1.y + sk1 * p0[3]));
        w.z = cvt_pk_bf16(x8[4] * (y2.x + sk1 * p1[0]), x8[5] * (y2.y + sk1 * p1[1])); w.w = cvt_pk_bf16(x8[6] * (y3.x + sk1 * p1[2]), x8[7] * (y3.y + sk1 * p1[3]));
        *(u32x4*)(hyout + 8 * c) = w; }
    __syncthreads();
}

__device__ void transpose_unit(const Params& p, int ct, int tt, unsigned char* smem) {
    const int tid = opaque_tid(); bf16_t* tile = (bf16_t*)smem;
    const bf16_t* hyout = (const bf16_t*)(p.ws + OFF_HYOUT); bf16_t* ya = (bf16_t*)(p.ws + OFF_GATE);
    __syncthreads();
    { const int cl = tid >> 3, t8 = (tid & 7) * 8; *(u32x4*)(tile + cl * 72 + t8) = *(const u32x4*)(hyout + (size_t)(ct * 64 + cl) * LP + tt * 64 + t8); }
    __syncthreads();
    { const int tl = tid >> 3, c8 = (tid & 7) * 8; const int t = tt * 64 + tl;
      if (t < L_TOK) { bf16_t* gp = ya + (size_t)t * 1024 + ct * 64 + c8; const u32x4 g = *(const u32x4*)gp;
          float v[8];
#pragma unroll
          for (int i = 0; i < 8; ++i) v[i] = bf2f(tile[(c8 + i) * 72 + tl]);
          u32x4 w; w.x = cvt_pk_bf16(v[0] * lo_bf(g.x), v[1] * hi_bf(g.x)); w.y = cvt_pk_bf16(v[2] * lo_bf(g.y), v[3] * hi_bf(g.y)); w.z = cvt_pk_bf16(v[4] * lo_bf(g.z), v[5] * hi_bf(g.z)); w.w = cvt_pk_bf16(v[6] * lo_bf(g.w), v[7] * hi_bf(g.w));
          *(u32x4*)gp = w; } }
}

__device__ void phase_final(const Params& p) {
    const int tid = opaque_tid(), lane = tid & 63, wv = tid >> 6; const float* h = (const float*)(p.ws + OFF_H);
    for (int l = NMETA + blockIdx.x * 8 + wv; l < L_TOK; l += gridDim.x * 8) { const f32x4* row = (const f32x4*)(h + (size_t)l * DM); f32x4 v[8]; float ss = 0.f;
#pragma unroll
        for (int i = 0; i < 8; ++i) { v[i] = row[i * 64 + lane]; ss += v[i][0] * v[i][0] + v[i][1] * v[i][1] + v[i][2] * v[i][2] + v[i][3] * v[i][3]; }
        ss = wave_sum(ss); const float inv = rsqrtf(ss * (1.0f / DM) + 1e-6f); f32x4* o = (f32x4*)(p.out + (size_t)(l - NMETA) * DM);
#pragma unroll
        for (int i = 0; i < 8; ++i) { const f32x4 gg = ((const f32x4*)p.final_g)[i * 64 + lane]; o[i * 64 + lane] = v[i] * inv * gg; } }
}

__device__ void mini_branch(const Params& p) {
    const int tid = opaque_tid(), lane = tid & 63, wv = tid >> 6, nt_ = blockIdx.x * 8 + wv;
    if (nt_ < 128) { const int rc = lane & 15, quad = lane >> 4; const int n0 = nt_ * 16;
        const bf16_t* mg = (const bf16_t*)(p.ws + OFF_MERGE); bf16_t* mb = (bf16_t*)(p.ws + OFF_M);
        float tot[4] = {0.f, 0.f, 0.f, 0.f};
#pragma unroll 1
        for (int br = 0; br < 3; ++br) { const bf16_t* A = (const bf16_t*)(p.ws + OFF_GATE + (size_t)br * SZ_GATE) + (size_t)(NMAIN + rc) * 1024 + quad * 8;
            const bf16_t* B = (const bf16_t*)(p.ws + OFF_WA + (size_t)br * SZ_WBR) + (size_t)(n0 + rc) * 1024 + quad * 8;
            f32x4 acc = (f32x4){0.f, 0.f, 0.f, 0.f};
#pragma unroll 1
            for (int kb = 0; kb < 32; kb += 8) { bf16x8 av[8], bv[8];
#pragma unroll
                for (int i = 0; i < 8; ++i) { av[i] = *(const bf16x8*)(A + (kb + i) * 32); bv[i] = *(const bf16x8*)(B + (kb + i) * 32); }
#pragma unroll
                for (int i = 0; i < 8; ++i) acc = __builtin_amdgcn_mfma_f32_16x16x32_bf16(av[i], bv[i], acc, 0, 0, 0); }
#pragma unroll
            for (int r = 0; r < 4; ++r) tot[r] += acc[r] * bf2f(mg[(size_t)(NMAIN + quad * 4 + r) * 6144 + br * 2048 + n0 + rc]); }
#pragma unroll
        for (int r = 0; r < 4; ++r) mb[(size_t)(NMAIN + quad * 4 + r) * DM + n0 + rc] = f2bf(tot[r]); }
}
__device__ void mini_out(const Params& p) {
    const int tid = opaque_tid(), lane = tid & 63, wv = tid >> 6, nt_ = blockIdx.x * 8 + wv;
    if (nt_ < 128) { const int rc = lane & 15, quad = lane >> 4; const int n0 = nt_ * 16;
        const bf16_t* A = (const bf16_t*)(p.ws + OFF_M) + (size_t)(NMAIN + rc) * DM + quad * 8; const bf16_t* B = (const bf16_t*)(p.ws + OFF_WO) + (size_t)(n0 + rc) * DM + quad * 8;
        f32x4 acc = (f32x4){0.f, 0.f, 0.f, 0.f};
#pragma unroll 1
        for (int kb = 0; kb < 64; kb += 8) { bf16x8 av[8], bv[8];
#pragma unroll
            for (int i = 0; i < 8; ++i) { av[i] = *(const bf16x8*)(A + (kb + i) * 32); bv[i] = *(const bf16x8*)(B + (kb + i) * 32); }
#pragma unroll
            for (int i = 0; i < 8; ++i) acc = __builtin_amdgcn_mfma_f32_16x16x32_bf16(av[i], bv[i], acc, 0, 0, 0); }
        float* h = (float*)(p.ws + OFF_H);
#pragma unroll
        for (int r = 0; r < 4; ++r) h[(size_t)(NMAIN + quad * 4 + r) * DM + n0 + rc] += acc[r]; }
}

enum { OP_P1 = 0, OP_SYNC, OP_GEMM, OP_NA, OP_HYENA, OP_TRANS, OP_NOP };
__global__ void __launch_bounds__(512, 2) hybrid_fwd(Params p) {
    extern __shared__ __attribute__((aligned(16))) unsigned char smem[];
    cg::grid_group grid = cg::this_grid();
    LAS unsigned char* lds = (LAS unsigned char*)smem;
    const int bid = blockIdx.x, G = gridDim.x;
    phase_prep0(p, smem);
    constexpr int NOPS = 17;
#pragma clang loop unroll(disable)
    for (int step = 0; step < 2 * NOPS; ++step) {
        const int layer = step / NOPS, s = step - layer * NOPS;
        int op, kind = 0;
        switch (s) {
        case 0: op = OP_P1; break;
        case 2: op = OP_GEMM; kind = K_IN; break;
        case 3: case 4: op = OP_NOP; break;
        case 6: op = OP_GEMM; kind = K_FNA; break;
        case 7: op = OP_NA; break;
        case 8: op = OP_HYENA; break;
        case 10: op = OP_GEMM; kind = K_FNB; break;
        case 11: op = OP_TRANS; break;
        case 13: op = OP_GEMM; kind = K_BR; break;
        case 15: op = OP_GEMM; kind = K_OUT; break;
        default: op = OP_SYNC; break;
        }
        if (op == OP_NOP) { }
        else if (op == OP_SYNC) { grid.sync(); }
        else if (op == OP_GEMM) {
            Gemm g; g.base = (const char*)p.ws; g.jumpA = 0; g.jumpB = 0;
            switch (kind) {
            case K_FNA: g.lda = 384; g.ldb = FN1P; g.nt = 6; g.ksplit = 3; g.jumpB = (long)((size_t)1024 * PROWS * 2) - 384l; break;
            case K_FNB: g.lda = 256; g.ldb = 256; g.nt = 4; g.ksplit = 4; break;
            case K_BR:  g.lda = 1024; g.ldb = 1024; g.nt = 16; g.ksplit = 16; break;
            default:    g.lda = DM; g.ldb = DM; g.nt = 32; g.ksplit = 32; break;
            }
            SchedAny S{kind, G, bid}; EpiAny E{kind, p.ws};
            pg8::gemm_phase(lds, g, S, E);
            if (kind == K_BR) mini_branch(p); else if (kind == K_OUT) mini_out(p);
        }
        else if (op == OP_P1) { phase_p1(p, layer, smem); }
        else if (op == OP_NA) { for (int u = bid; u < 4096; u += G) na_unit(p, layer, u >> 4, u & 15, smem); if (bid == G - 1) na_meta_unit(p, layer); }
        else if (op == OP_HYENA) { for (int ch = bid; ch < 1024; ch += G) hyena_unit(p, layer, ch, smem, (unsigned char*)p.out + (size_t)bid * HS_STRIDE); }
        else { for (int u = bid; u < 16 * 257; u += G) transpose_unit(p, u & 15, u >> 4, smem); }
    }
    phase_final(p);
}

extern "C" void kernel_launch(void* const* d_in, const int* in_sizes, int n_in, void* d_out, int out_size, void* d_ws, size_t ws_size, hipStream_t stream) {
    static int grid_blocks = 0;
    if (grid_blocks == 0) {
        if (n_in != 23 || ws_size < WS_END) { fprintf(stderr, "kernel_launch: need 23 inputs and %zu bytes of workspace (got %d, %zu)\n", (size_t)WS_END, n_in, ws_size); grid_blocks = -1; return; }
        int dev = 0, cus = 0, per_cu = 0;
        hipGetDevice(&dev); hipDeviceGetAttribute(&cus, hipDeviceAttributeMultiprocessorCount, dev);
        if (hipFuncSetAttribute((const void*)hybrid_fwd, hipFuncAttributeMaxDynamicSharedMemorySize, LDS_BYTES) != hipSuccess) { fprintf(stderr, "kernel_launch: hipFuncSetAttribute failed\n"); grid_blocks = -1; return; }
        hipOccupancyMaxActiveBlocksPerMultiprocessor(&per_cu, (const void*)hybrid_fwd, NTHREADS, LDS_BYTES);
        if (per_cu < 1) per_cu = 1;
        grid_blocks = cus * per_cu;
        if (grid_blocks > 256) grid_blocks = 256;
    }
    if (grid_blocks < 0) return;
    Params p{};
    const float** f = (const float**)&p;
    for (int i = 0; i < 23; ++i) f[i] = (const float*)d_in[i];
    p.out = (float*)d_out; p.ws = (unsigned char*)d_ws;
    void* args[] = {&p};
    hipError_t e = hipLaunchCooperativeKernel((const void*)hybrid_fwd, dim3(grid_blocks), dim3(NTHREADS), args, LDS_BYTES, stream);
    if (e != hipSuccess) fprintf(stderr, "cooperative launch failed: %s (grid %d)\n", hipGetErrorString(e), grid_blocks);
}
```

```cpp
#include <hip/hip_runtime.h>
#include <hip/hip_cooperative_groups.h>
#include <cstdio>
namespace cg = cooperative_groups;

#define LAS __attribute__((address_space(3)))
typedef unsigned short bf16_t;
typedef short bf16x8 __attribute__((ext_vector_type(8)));
typedef float f32x4 __attribute__((ext_vector_type(4)));
typedef unsigned u32x4 __attribute__((ext_vector_type(4)));
typedef unsigned u32x2 __attribute__((ext_vector_type(2)));

constexpr int L_TOK = 16400, LP = 16640, DM = 2048, NIN = 16384, NMETA = 16, NMAIN = 16384;
constexpr int FN1 = 164, FN2 = 100, FN1P = 192, PROWS = FN2 * FN1P;
constexpr int NTHREADS = 512, LDS_BYTES = 155648;

constexpr size_t SZ_H = (size_t)LP * DM * 4, SZ_XN = (size_t)LP * DM * 2, SZ_XNP = (size_t)PROWS * DM * 2;
constexpr size_t OFF_H = 0;
constexpr size_t OFF_XN = OFF_H + SZ_H;
constexpr size_t OFF_XNP = OFF_XN + SZ_XN;
constexpr size_t OFF_A1 = OFF_XN;
constexpr size_t SZ_A1 = (size_t)FN1 * 1024 * 2 * 128 * 2;
constexpr size_t OFF_HYOUT = OFF_A1 + SZ_A1;
constexpr size_t SZ_HYOUT = (size_t)1024 * LP * 2;
static_assert(OFF_HYOUT + SZ_HYOUT <= OFF_XNP + SZ_XNP, "alias overflow");
constexpr size_t OFF_WT = OFF_XNP + SZ_XNP;
constexpr size_t OFF_WEFF = OFF_WT + (size_t)NIN * DM * 2;
constexpr size_t OFF_WA = OFF_WEFF + (size_t)2048 * 2048 * 2;
constexpr size_t SZ_WBR = (size_t)2048 * 1024 * 2;
constexpr size_t OFF_WO = OFF_WA + 3 * SZ_WBR;
constexpr size_t OFF_HYIN = OFF_WO + (size_t)2048 * 2048 * 2;
constexpr size_t OFF_GATE = OFF_HYIN + (size_t)3072 * LP * 2;
constexpr size_t SZ_GATE = (size_t)LP * 1024 * 2;
constexpr size_t OFF_QKV = OFF_GATE + 3 * SZ_GATE;
constexpr size_t OFF_MERGE = OFF_QKV + (size_t)LP * 3072 * 2;
constexpr size_t OFF_ZT = OFF_MERGE + (size_t)LP * 6144 * 2;
constexpr size_t SZ_ZT = (size_t)2048 * PROWS * 2;
constexpr size_t OFF_M = OFF_ZT;
static_assert(SZ_XN <= SZ_ZT, "alias overflow");
constexpr size_t OFF_FA = OFF_ZT + SZ_ZT;
constexpr size_t OFF_FB = OFF_FA + (size_t)512 * 384 * 2;
constexpr size_t OFF_H3 = OFF_FB + (size_t)FN1 * 256 * 256 * 2;
constexpr size_t WS_END = OFF_H3 + (size_t)2 * L_TOK * 64 * 4;
constexpr size_t HS_HEO = 0, HS_CORR = 131328, HS_Z2 = HS_CORR + 65536, HS_G2F = HS_Z2 + 65792, HS_G2B = HS_G2F + 65792, HS_STRIDE = HS_G2B + 65792;
static_assert(HS_STRIDE * 256 <= (size_t)NMAIN * DM * 4, "scratch overflow");

struct Params {
    const float* x; const float* meta; const float* norm_g; const float* w_in; const float* conv_w; const float* conv_b;
    const float* f_w1; const float* f_b1; const float* f_w2; const float* f_b2; const float* f_w3; const float* f_b3; const float* f_w4;
    const float* f_freq; const float* decay; const float* skip; const float* rpb; const float* meta_bias;
    const float* w_a; const float* w_b; const float* w_c; const float* w_out; const float* final_g;
    float* out; unsigned char* ws;
};

__device__ __forceinline__ int opaque_tid() { int t = threadIdx.x; asm volatile("" : "+v"(t)); return t; }
__device__ __forceinline__ float bf2f(bf16_t b) { return __uint_as_float(((unsigned)b) << 16); }
__device__ __forceinline__ bf16_t f2bf(float f) { unsigned u = __float_as_uint(f); u += 0x7FFFu + ((u >> 16) & 1u); return (bf16_t)(u >> 16); }
__device__ __forceinline__ unsigned cvt_pk_bf16(float lo, float hi) { unsigned r; asm volatile("v_cvt_pk_bf16_f32 %0, %1, %2" : "=v"(r) : "v"(lo), "v"(hi)); return r; }
__device__ __forceinline__ float lo_bf(unsigned u) { return __uint_as_float(u << 16); }
__device__ __forceinline__ float hi_bf(unsigned u) { return __uint_as_float(u & 0xffff0000u); }
__device__ __forceinline__ float silu_f(float v) { return v * __builtin_amdgcn_rcpf(1.0f + __expf(-v)); }
__device__ __forceinline__ float sigm_f(float v) { return __builtin_amdgcn_rcpf(1.0f + __expf(-v)); }
__device__ __forceinline__ float wave_sum(float v) {
#pragma unroll
    for (int o = 32; o >= 1; o >>= 1) v += __shfl_xor(v, o);
    return v;
}

namespace pg8 {
constexpr int BM = 256, BK = 64, HALF = 128, HTB = HALF * BK * 2, STAGE_BYTES = 8 * HTB;
__device__ __forceinline__ int lds_byte(int r, int c) { const int st = (r >> 4) * 2 + (c >> 5), rr = r & 15, cc = c & 31, ob = rr * 64 + cc * 2; return st * 1024 + (ob ^ (((ob >> 9) & 1) << 5)); }
__device__ __forceinline__ void stage_rc(int b, int& R, int& C) { const int st = b / 1024, sb = b % 1024, swz = sb ^ (((sb >> 9) & 1) << 5); R = (st >> 1) * 16 + swz / 64; C = (st & 1) * 32 + (swz % 64) / 2; }
__device__ __forceinline__ int perm32(int rho) { const int n = rho >> 4, i = rho & 15; return 8 * (i >> 2) + 4 * n + (i & 3); }

struct Unit { int pm, pn, aux; size_t offA, offB; };
struct Gemm { const char* base; int lda, ldb, nt, ksplit; long jumpA, jumpB; };

__device__ __forceinline__ void tile_map(int wgid, int nM, int nN, int& pm, int& pn) {
    const int nwg = nM * nN;
    { const int q = nwg / 8, r = nwg % 8, xcd = wgid % 8, off = wgid / 8; wgid = (xcd < r ? xcd * (q + 1) : r * (q + 1) + (xcd - r) * q) + off; }
    const int nig = 8 * nN, gid = wgid / nig, fm = gid * 8, gsz = (nM - fm) < 8 ? (nM - fm) : 8;
    pm = fm + ((wgid % nig) % gsz); pn = (wgid % nig) / gsz;
}

template <class Epi, class Sched>
__device__ __forceinline__ void gemm_phase(LAS unsigned char* lds, const Gemm g, const Sched& S, const Epi& E) {
    const int tid = opaque_tid(), wid = __builtin_amdgcn_readfirstlane(tid >> 6), lane = tid & 63, wr = wid >> 2, wc = wid & 3, fr = lane & 15, fq = lane >> 4;
    const int nt = g.nt;
    unsigned voffA[2], voffB[2];
#pragma unroll
    for (int i = 0; i < 2; ++i) { int R, C; stage_rc(tid * 16 + i * 8192, R, C); const int Rb = (R & ~31) + perm32(R & 31);
        voffA[i] = (unsigned)(R * g.lda + C) * 2u; voffB[i] = (unsigned)(Rb * g.ldb + C) * 2u; }
    const size_t kstep = (size_t)(BK * 2);
    const size_t hstepA = (size_t)HALF * g.lda * 2, hstepB = (size_t)HALF * g.ldb * 2;
    const unsigned ldsw = (unsigned)wid * 1024u;
    const int aoff = lds_byte(wr * 64 + fr, fq * 8), boff = lds_byte(wc * 32 + fr, fq * 8);
#define PG8_KA(p, t) ((p) + (size_t)(t) * kstep + ((t) >= g.ksplit ? g.jumpA : 0l))
#define PG8_KB(p, t) ((p) + (size_t)(t) * kstep + ((t) >= g.ksplit ? g.jumpB : 0l))
#define PG8_SA(b, h) (((b) * 2 + (h)) * HTB)
#define PG8_SB(b, h) ((4 + (b) * 2 + (h)) * HTB)
#define PG8_STAGE(bufoff, gbase, voff) do { _Pragma("unroll") for (int _i = 0; _i < 2; ++_i) \
        __builtin_amdgcn_global_load_lds((const unsigned*)((const char*)(gbase) + (voff)[_i]), (LAS unsigned*)(lds + (bufoff) + ldsw + _i * 8192), 16, 0, 0); } while (0)
#define PG8_LDA(dst, b, h) do { _Pragma("unroll") for (int m = 0; m < 4; ++m) _Pragma("unroll") for (int k = 0; k < 2; ++k) dst[m][k] = *(const LAS bf16x8*)(lds + PG8_SA(b, h) + aoff + m * 2048 + k * 1024); } while (0)
#define PG8_LDB(dst, b, h) do { _Pragma("unroll") for (int n = 0; n < 2; ++n) _Pragma("unroll") for (int k = 0; k < 2; ++k) dst[n][k] = *(const LAS bf16x8*)(lds + PG8_SB(b, h) + boff + n * 2048 + k * 1024); } while (0)
#define PG8_MMA(ai, bj, At, Bt) do { __builtin_amdgcn_s_setprio(1); _Pragma("unroll") for (int m = 0; m < 4; ++m) _Pragma("unroll") for (int n = 0; n < 2; ++n) _Pragma("unroll") for (int k = 0; k < 2; ++k) \
        acc[ai][bj][m][n] = __builtin_amdgcn_mfma_f32_16x16x32_bf16(Bt[n][k], At[m][k], acc[ai][bj][m][n], 0, 0, 0); __builtin_amdgcn_s_setprio(0); } while (0)
#define PG8_WAIT_V(n) asm volatile("s_waitcnt vmcnt(" #n ")" ::: "memory")
#define PG8_WAIT_L(n) asm volatile("s_waitcnt lgkmcnt(" #n ")" ::: "memory")
#define PG8_BAR __builtin_amdgcn_s_barrier()
#define PG8_SCHED __builtin_amdgcn_sched_barrier(0)
    Unit cur, nxt; int ui = 0;
    if (!S.next(0, cur)) return;
    f32x4 acc[2][2][4][2];
#pragma unroll
    for (int a = 0; a < 2; ++a)
#pragma unroll
        for (int b = 0; b < 2; ++b)
#pragma unroll
            for (int m = 0; m < 4; ++m)
#pragma unroll
                for (int n = 0; n < 2; ++n) acc[a][b][m][n] = (f32x4){0.f, 0.f, 0.f, 0.f};
    bf16x8 At[4][2], B0[2][2], B1[2][2];
    const char* cA = g.base + cur.offA; const char* cB = g.base + cur.offB;
    PG8_STAGE(PG8_SB(0, 0), cB, voffB); PG8_STAGE(PG8_SA(0, 0), cA, voffA); PG8_STAGE(PG8_SB(0, 1), cB + hstepB, voffB); PG8_STAGE(PG8_SA(0, 1), cA + hstepA, voffA);
    if (wr == 1) PG8_BAR;
    PG8_WAIT_V(4); PG8_BAR;
    PG8_STAGE(PG8_SB(1, 0), PG8_KB(cB, 1), voffB); PG8_STAGE(PG8_SA(1, 0), PG8_KA(cA, 1), voffA); PG8_STAGE(PG8_SB(1, 1), PG8_KB(cB, 1) + hstepB, voffB);
    PG8_WAIT_V(6); PG8_BAR;
    for (;;) {
        const bool has_next = S.next(ui + 1, nxt);
        const char* nA = has_next ? g.base + nxt.offA : cA; const char* nB = has_next ? g.base + nxt.offB : cB;
        for (int t = 0; t < nt; t += 2) {
            const bool last = (t == nt - 2);
            const char* a1 = PG8_KA(cA, t + 1);
            const char* a2 = last ? nA : PG8_KA(cA, t + 2); const char* b2 = last ? nB : PG8_KB(cB, t + 2);
            const char* a3 = last ? PG8_KA(nA, 1) : PG8_KA(cA, t + 3); const char* b3 = last ? PG8_KB(nB, 1) : PG8_KB(cB, t + 3);
            PG8_LDB(B0, 0, 0); PG8_SCHED; PG8_LDA(At, 0, 0); PG8_STAGE(PG8_SA(1, 1), a1 + hstepA, voffA);
            PG8_WAIT_L(8); PG8_BAR; PG8_WAIT_L(0); PG8_MMA(0, 0, At, B0); PG8_BAR; PG8_SCHED;
            PG8_LDB(B1, 0, 1); PG8_STAGE(PG8_SB(0, 0), b2, voffB);
            PG8_BAR; PG8_WAIT_L(0); PG8_MMA(0, 1, At, B1); PG8_BAR;
            PG8_LDA(At, 0, 1); PG8_STAGE(PG8_SA(0, 0), a2, voffA);
            PG8_BAR; PG8_WAIT_L(0); PG8_MMA(1, 0, At, B0); PG8_BAR; PG8_SCHED;
            PG8_STAGE(PG8_SB(0, 1), b2 + hstepB, voffB);
            PG8_WAIT_V(6); PG8_BAR; PG8_MMA(1, 1, At, B1); PG8_BAR;
            PG8_LDB(B0, 1, 0); PG8_SCHED; PG8_LDA(At, 1, 0); PG8_STAGE(PG8_SA(0, 1), a2 + hstepA, voffA);
            PG8_WAIT_L(8); PG8_BAR; PG8_WAIT_L(0); PG8_MMA(0, 0, At, B0); PG8_BAR; PG8_SCHED;
            PG8_LDB(B1, 1, 1); PG8_STAGE(PG8_SB(1, 0), b3, voffB);
            PG8_BAR; PG8_WAIT_L(0); PG8_MMA(0, 1, At, B1); PG8_BAR;
            PG8_LDA(At, 1, 1); PG8_STAGE(PG8_SA(1, 0), a3, voffA);
            PG8_BAR; PG8_WAIT_L(0); PG8_MMA(1, 0, At, B0); PG8_BAR; PG8_SCHED;
            PG8_STAGE(PG8_SB(1, 1), b3 + hstepB, voffB);
            PG8_WAIT_V(6); PG8_BAR; PG8_MMA(1, 1, At, B1); PG8_BAR;
        }
        E(acc, cur, wr, wc, fr, fq);
        if (!has_next) break;
#pragma unroll
        for (int a = 0; a < 2; ++a)
#pragma unroll
            for (int b = 0; b < 2; ++b)
#pragma unroll
                for (int m = 0; m < 4; ++m)
#pragma unroll
                    for (int n = 0; n < 2; ++n) acc[a][b][m][n] = (f32x4){0.f, 0.f, 0.f, 0.f};
        cur = nxt; cA = nA; cB = nB; ++ui;
    }
    PG8_WAIT_V(0);
    if (wr == 0) PG8_BAR;
    PG8_BAR;
#undef PG8_KA
#undef PG8_KB
#undef PG8_SA
#undef PG8_SB
#undef PG8_STAGE
#undef PG8_LDA
#undef PG8_LDB
#undef PG8_MMA
#undef PG8_WAIT_V
#undef PG8_WAIT_L
#undef PG8_BAR
#undef PG8_SCHED
}
}
using pg8::Unit; using pg8::Gemm;
#define ACC_T const f32x4 (&acc)[2][2][4][2]

enum { K_TOK = 0, K_HYIN = 1, K_F0 = 2, K_FNA = 3, K_FNB = 4, K_BR = 5, K_OUT = 6, K_IN = 7 };
struct SchedAny {
    int kind, G, c;
    __device__ __forceinline__ bool next(int i, Unit& u) const {
        const long Lx = (long)i * G + c;
        switch (kind) {
        case K_IN: {
            if (Lx < 3120) { int pn; pg8::tile_map((int)Lx, 65, 48, u.pm, pn); u.pn = pn < 4 ? 12 + pn : 16 + pn; u.aux = K_TOK;
                u.offA = OFF_XN + (size_t)u.pm * 256 * DM * 2; u.offB = OFF_WT + (size_t)u.pn * 256 * DM * 2; return true; }
            if (Lx < 3900) { pg8::tile_map((int)Lx - 3120, 12, 65, u.pm, u.pn); u.aux = K_HYIN;
                u.offA = OFF_WT + (size_t)u.pm * 256 * DM * 2; u.offB = OFF_XN + (size_t)u.pn * 256 * DM * 2; return true; }
            if (Lx < 4500) { pg8::tile_map((int)Lx - 3900, 8, 75, u.pm, u.pn); u.aux = K_F0;
                u.offA = OFF_WEFF + (size_t)u.pm * 256 * DM * 2; u.offB = OFF_XNP + (size_t)u.pn * 256 * DM * 2; return true; }
            return false; }
        case K_TOK: {
            if (Lx >= 65l * 48) return false; int pn; pg8::tile_map((int)Lx, 65, 48, u.pm, pn); u.pn = pn < 4 ? 12 + pn : 16 + pn; u.aux = 0;
            u.offA = OFF_XN + (size_t)u.pm * 256 * DM * 2; u.offB = OFF_WT + (size_t)u.pn * 256 * DM * 2; return true; }
        case K_HYIN: {
            if (Lx >= 12l * 65) return false; pg8::tile_map((int)Lx, 12, 65, u.pm, u.pn); u.aux = 0;
            u.offA = OFF_WT + (size_t)u.pm * 256 * DM * 2; u.offB = OFF_XN + (size_t)u.pn * 256 * DM * 2; return true; }
        case K_F0: {
            if (Lx >= 8l * 75) return false; pg8::tile_map((int)Lx, 8, 75, u.pm, u.pn); u.aux = 0;
            u.offA = OFF_WEFF + (size_t)u.pm * 256 * DM * 2; u.offB = OFF_XNP + (size_t)u.pn * 256 * DM * 2; return true; }
        case K_FNA: {
            if (Lx >= 2l * 400) return false; pg8::tile_map((int)Lx, 2, 400, u.pm, u.pn); u.aux = 0;
            u.offA = OFF_FA + (size_t)u.pm * 256 * 384 * 2; u.offB = OFF_ZT + (size_t)u.pn * 256 * FN1P * 2; return true; }
        case K_FNB: {
            if (Lx >= 164l * 4) return false; u.aux = (int)(Lx >> 2); u.pm = 0; u.pn = (int)(Lx & 3);
            u.offA = OFF_FB + (size_t)u.aux * 256 * 256 * 2; u.offB = OFF_A1 + (size_t)u.aux * 1024 * 256 * 2 + (size_t)u.pn * 256 * 256 * 2; return true; }
        case K_BR: {
            const int T = (i / 3) * G + c; if (T >= 64 * 8) return false; const int br = i % 3; pg8::tile_map(T, 64, 8, u.pm, u.pn); u.aux = br;
            u.offA = OFF_GATE + (size_t)br * SZ_GATE + (size_t)u.pm * 256 * 1024 * 2; u.offB = OFF_WA + (size_t)br * SZ_WBR + (size_t)u.pn * 256 * 1024 * 2; return true; }
        default: {
            if (Lx >= 64l * 8) return false; pg8::tile_map((int)Lx, 64, 8, u.pm, u.pn); u.aux = 0;
            u.offA = OFF_M + (size_t)u.pm * 256 * DM * 2; u.offB = OFF_WO + (size_t)u.pn * 256 * DM * 2; return true; }
        }
    }
};
#define ROWFENCE asm volatile("" ::: "memory")
#define HARDFENCE do { asm volatile("" ::: "memory"); __builtin_amdgcn_sched_barrier(0); } while (0)
struct EpiAny {
    int kind; unsigned char* ws;
    __device__ __forceinline__ void operator()(ACC_T, const Unit& u, int wr, int wc, int fr, int fq) const {
        const int rl0 = wr * 64 + fr, cl0 = wc * 32 + 8 * fq;
        const int ek = kind == K_IN ? u.aux : kind;
        if (ek == K_TOK) {
            const int t = u.pn; unsigned char* dst; unsigned ld; int c0, act;
            if (t < 16)      { dst = ws + OFF_GATE;               ld = 1024; c0 = (t - 12) * 256; act = 1; }
            else if (t < 24) { dst = ws + OFF_GATE + SZ_GATE;     ld = 1024; c0 = (t - 20) * 256; act = 1; }
            else if (t < 36) { dst = ws + OFF_QKV;                ld = 3072; c0 = (t - 24) * 256; act = 0; }
            else if (t < 40) { dst = ws + OFF_GATE + 2 * SZ_GATE; ld = 1024; c0 = (t - 36) * 256; act = 1; }
            else             { dst = ws + OFF_MERGE;              ld = 6144; c0 = (t - 40) * 256; act = 2; }
#pragma unroll
            for (int ai = 0; ai < 2; ++ai)
#pragma unroll
                for (int m = 0; m < 4; ++m) { const unsigned row = (unsigned)(u.pm * 256 + ai * 128 + m * 16 + rl0);
#pragma unroll
                    for (int bj = 0; bj < 2; ++bj) { const unsigned off = (row * ld + (unsigned)(c0 + bj * 128 + cl0)) * 2u; f32x4 v0 = acc[ai][bj][m][0], v1 = acc[ai][bj][m][1];
                        if (act == 1) {
#pragma unroll
                            for (int j = 0; j < 4; ++j) { v0[j] = silu_f(v0[j]); v1[j] = silu_f(v1[j]); } }
                        else if (act == 2) {
#pragma unroll
                            for (int j = 0; j < 4; ++j) { v0[j] = sigm_f(v0[j]); v1[j] = sigm_f(v1[j]); } }
                        u32x4 w; w.x = cvt_pk_bf16(v0[0], v0[1]); w.y = cvt_pk_bf16(v0[2], v0[3]); w.z = cvt_pk_bf16(v1[0], v1[1]); w.w = cvt_pk_bf16(v1[2], v1[3]);
                        *(u32x4*)(dst + off) = w; }
                    ROWFENCE; }
        } else if (ek == K_HYIN || ek == K_F0) {
            unsigned char* dst = ws + (ek == K_HYIN ? OFF_HYIN : OFF_ZT); const unsigned ld = ek == K_HYIN ? LP : PROWS;
#pragma unroll
            for (int ai = 0; ai < 2; ++ai)
#pragma unroll
                for (int m = 0; m < 4; ++m) { const unsigned row = (unsigned)(u.pm * 256 + ai * 128 + m * 16 + rl0);
#pragma unroll
                    for (int bj = 0; bj < 2; ++bj) { const unsigned off = (row * ld + (unsigned)(u.pn * 256 + bj * 128 + cl0)) * 2u; const f32x4 v0 = acc[ai][bj][m][0], v1 = acc[ai][bj][m][1];
                        u32x4 w; w.x = cvt_pk_bf16(v0[0], v0[1]); w.y = cvt_pk_bf16(v0[2], v0[3]); w.z = cvt_pk_bf16(v1[0], v1[1]); w.w = cvt_pk_bf16(v1[2], v1[3]);
                        *(u32x4*)(dst + off) = w; }
                    ROWFENCE; }
        } else if (ek == K_FNA) {
            unsigned char* dst = ws + OFF_A1;
#pragma unroll
            for (int ai = 0; ai < 2; ++ai)
#pragma unroll
                for (int m = 0; m < 4; ++m) { const int k1 = ai * 128 + m * 16 + rl0;
                    if (k1 < FN1) {
#pragma unroll
                        for (int bj = 0; bj < 2; ++bj)
#pragma unroll
                            for (int n = 0; n < 2; ++n) { const int col = u.pn * 256 + bj * 128 + cl0 + 4 * n; const int ch = col / FN2, l2 = col - ch * FN2; const f32x4 v = acc[ai][bj][m][n];
                                u32x2 w; w.x = cvt_pk_bf16(v[0], v[1]); w.y = cvt_pk_bf16(v[2], v[3]);
                                *(u32x2*)(dst + ((unsigned)((k1 * 1024 + ch) * 2 + u.pm) * 128u + (unsigned)l2) * 2u) = w; } }
                    ROWFENCE; }
        } else if (ek == K_FNB) {
            unsigned char* dst = ws + OFF_GATE + SZ_GATE; const float scale = 1.0f / sqrtf((float)L_TOK * 256.0f);
#pragma unroll
            for (int ai = 0; ai < 2; ++ai)
#pragma unroll
                for (int m = 0; m < 4; ++m) { const int k2 = ai * 128 + m * 16 + rl0;
                    if (k2 < FN2) { const unsigned row = (unsigned)(u.aux + FN1 * k2);
#pragma unroll
                        for (int bj = 0; bj < 2; ++bj) { const unsigned off = (row * 1024u + (unsigned)(u.pn * 256 + bj * 128 + cl0)) * 2u; const u32x4 g = *(const u32x4*)(dst + off);
                            const f32x4 v0 = acc[ai][bj][m][0] * scale, v1 = acc[ai][bj][m][1] * scale;
                            u32x4 w; w.x = cvt_pk_bf16(v0[0] * lo_bf(g.x), v0[1] * hi_bf(g.x)); w.y = cvt_pk_bf16(v0[2] * lo_bf(g.y), v0[3] * hi_bf(g.y));
                            w.z = cvt_pk_bf16(v1[0] * lo_bf(g.z), v1[1] * hi_bf(g.z)); w.w = cvt_pk_bf16(v1[2] * lo_bf(g.w), v1[3] * hi_bf(g.w));
                            *(u32x4*)(dst + off) = w; } }
                    ROWFENCE; }
        } else if (ek == K_BR) {
            unsigned char* dst = ws + OFF_M; const unsigned char* mg = ws + OFF_MERGE; const int br = u.aux;
#pragma unroll
            for (int ai = 0; ai < 2; ++ai) { u32x4 gq[4][2], oq[4][2];
#pragma unroll
                for (int m = 0; m < 4; ++m) { const unsigned row = (unsigned)(u.pm * 256 + ai * 128 + m * 16 + rl0);
#pragma unroll
                    for (int bj = 0; bj < 2; ++bj) { const unsigned col = (unsigned)(u.pn * 256 + bj * 128 + cl0);
                        gq[m][bj] = *(const u32x4*)(mg + (row * 6144u + (unsigned)br * 2048u + col) * 2u);
                        if (br > 0) oq[m][bj] = *(const u32x4*)(dst + (row * (unsigned)DM + col) * 2u); else oq[m][bj] = (u32x4){0u, 0u, 0u, 0u}; } }
#pragma unroll
                for (int m = 0; m < 4; ++m) { const unsigned row = (unsigned)(u.pm * 256 + ai * 128 + m * 16 + rl0);
#pragma unroll
                    for (int bj = 0; bj < 2; ++bj) { const unsigned col = (unsigned)(u.pn * 256 + bj * 128 + cl0); const unsigned off = (row * (unsigned)DM + col) * 2u;
                        const u32x4 g = gq[m][bj], o = oq[m][bj]; const f32x4 v0 = acc[ai][bj][m][0], v1 = acc[ai][bj][m][1];
                        const float r0 = v0[0] * lo_bf(g.x) + lo_bf(o.x), r1 = v0[1] * hi_bf(g.x) + hi_bf(o.x), r2 = v0[2] * lo_bf(g.y) + lo_bf(o.y), r3 = v0[3] * hi_bf(g.y) + hi_bf(o.y);
                        const float r4 = v1[0] * lo_bf(g.z) + lo_bf(o.z), r5 = v1[1] * hi_bf(g.z) + hi_bf(o.z), r6 = v1[2] * lo_bf(g.w) + lo_bf(o.w), r7 = v1[3] * hi_bf(g.w) + hi_bf(o.w);
                        u32x4 w; w.x = cvt_pk_bf16(r0, r1); w.y = cvt_pk_bf16(r2, r3); w.z = cvt_pk_bf16(r4, r5); w.w = cvt_pk_bf16(r6, r7);
                        *(u32x4*)(dst + off) = w; } }
                ROWFENCE; }
        } else {
            unsigned char* dst = ws + OFF_H;
#pragma unroll
            for (int ai = 0; ai < 2; ++ai) { f32x4 oq[4][2][2];
#pragma unroll
                for (int m = 0; m < 4; ++m) { const unsigned row = (unsigned)(u.pm * 256 + ai * 128 + m * 16 + rl0);
#pragma unroll
                    for (int bj = 0; bj < 2; ++bj) { const unsigned off = (row * (unsigned)DM + (unsigned)(u.pn * 256 + bj * 128 + cl0)) * 4u; oq[m][bj][0] = *(const f32x4*)(dst + off); oq[m][bj][1] = *(const f32x4*)(dst + off + 16); } }
#pragma unroll
                for (int m = 0; m < 4; ++m) { const unsigned row = (unsigned)(u.pm * 256 + ai * 128 + m * 16 + rl0);
#pragma unroll
                    for (int bj = 0; bj < 2; ++bj) { const unsigned off = (row * (unsigned)DM + (unsigned)(u.pn * 256 + bj * 128 + cl0)) * 4u;
                        *(f32x4*)(dst + off) = oq[m][bj][0] + acc[ai][bj][m][0]; *(f32x4*)(dst + off + 16) = oq[m][bj][1] + acc[ai][bj][m][1]; } }
                ROWFENCE; }
        }
    }
};

__device__ void phase_prep0(const Params& p, unsigned char* smem) {
    const int tid = opaque_tid(), bid = blockIdx.x, G = gridDim.x;
    const size_t gtid = (size_t)bid * NTHREADS + tid, gstride = (size_t)G * NTHREADS;
    { f32x4* h4 = (f32x4*)(p.ws + OFF_H); const f32x4* x4 = (const f32x4*)p.x; const f32x4* m4 = (const f32x4*)p.meta;
      for (size_t i = gtid; i < (size_t)LP * 512; i += gstride) { const size_t row = i >> 9; f32x4 v = (f32x4){0.f, 0.f, 0.f, 0.f};
          if (row < NMETA) v = m4[i]; else if (row < L_TOK) v = x4[i - (size_t)NMETA * 512]; h4[i] = v; } }
    { bf16_t* fa = (bf16_t*)(p.ws + OFF_FA);
      for (size_t i = gtid; i < (size_t)512 * 384; i += gstride) { const int row = (int)(i / 384), col = (int)(i % 384); const int po = row >> 8, k1 = row & 255, pi = col / 192, l1 = col % 192; float v = 0.f;
          if (k1 < FN1 && l1 < FN1) { const int r = (k1 * l1) % FN1; const float a = 2.0f * (float)r / (float)FN1; const float cs = cospif(a), sn = sinpif(a);
              v = (po == 0) ? (pi == 0 ? cs : sn) : (pi == 0 ? -sn : cs); }
          fa[i] = f2bf(v); } }
    { bf16_t* fb = (bf16_t*)(p.ws + OFF_FB);
      for (size_t i = gtid; i < (size_t)FN1 * 65536; i += gstride) { const int k1 = (int)(i >> 16), k2 = (int)((i >> 8) & 255), kk = (int)(i & 255), part = kk >> 7, l2 = kk & 127; float v = 0.f;
          if (k2 < FN2 && l2 < FN2) { const int lp = k1 + FN1 * k2; const int r = (l2 * lp) % L_TOK; const float a = 2.0f * (float)r / (float)L_TOK; v = part == 0 ? cospif(a) : sinpif(a); }
          fb[i] = f2bf(v); } }
    { float* w1s = (float*)smem;
      float* w2s = w1s + 33 * 64;
      float* w3s = w2s + 64 * 64;
      const int lane = tid & 63, wv = tid >> 6;
      for (int layer = 0; layer < 2; ++layer) {
          __syncthreads();
          for (int i = tid; i < 33 * 64; i += NTHREADS) w1s[i] = p.f_w1[layer * 33 * 64 + i];
          for (int i = tid; i < 64 * 64; i += NTHREADS) { w2s[i] = p.f_w2[layer * 4096 + i]; w3s[i] = p.f_w3[layer * 4096 + i]; }
          __syncthreads();
          const float b1 = p.f_b1[layer * 64 + lane], b2 = p.f_b2[layer * 64 + lane], b3 = p.f_b3[layer * 64 + lane], fr = p.f_freq[layer * 64 + lane];
          bf16_t* h3 = (bf16_t*)(p.ws + OFF_H3) + (size_t)layer * L_TOK * 64;
          for (int lag = bid * 8 + wv; lag < L_TOK; lag += G * 8) {
              const float tt = (float)lag / (float)(L_TOK - 1); const float w = 6.283185307179586f * (float)lag / (float)L_TOK;
              float z = 0.f;
              if (lane == 0) z = tt;
              else if (lane < 33) { const int j = (lane - 1) & 15; const float f = 1e-4f + (float)j * ((15.0f - 1e-4f) / 15.0f); const float a = f * w; z = lane < 17 ? cosf(a) : -sinf(a); }
              float a1 = b1;
#pragma unroll 3
              for (int i = 0; i < 33; ++i) a1 += __shfl(z, i) * w1s[i * 64 + lane];
              const float h1 = sinf(fr * a1);
              float a2 = b2;
#pragma unroll 8
              for (int i = 0; i < 64; ++i) a2 += __shfl(h1, i) * w2s[i * 64 + lane];
              const float h2 = sinf(fr * a2);
              float a3 = b3;
#pragma unroll 8
              for (int i = 0; i < 64; ++i) a3 += __shfl(h2, i) * w3s[i * 64 + lane];
              h3[(size_t)lag * 64 + lane] = f2bf(sinf(fr * a3));
          }
      }
      __syncthreads(); }
}

__device__ __forceinline__ void convert_tile(const float* src, int K, int N, bf16_t* dst, int kt, int nt_, float* tile  ) {
    const int tid = opaque_tid();
    __syncthreads();
#pragma unroll
    for (int ps = 0; ps < 2; ++ps) { const int kl = ps * 32 + (tid >> 4), n4 = (tid & 15) * 4;
        const f32x4 v = *(const f32x4*)(src + (size_t)(kt * 64 + kl) * N + nt_ * 64 + n4);
        tile[kl * 65 + n4] = v[0]; tile[kl * 65 + n4 + 1] = v[1]; tile[kl * 65 + n4 + 2] = v[2]; tile[kl * 65 + n4 + 3] = v[3]; }
    __syncthreads();
    const int nl = tid >> 3, k8 = (tid & 7) * 8;
    u32x4 w; w.x = cvt_pk_bf16(tile[(k8 + 0) * 65 + nl], tile[(k8 + 1) * 65 + nl]); w.y = cvt_pk_bf16(tile[(k8 + 2) * 65 + nl], tile[(k8 + 3) * 65 + nl]);
    w.z = cvt_pk_bf16(tile[(k8 + 4) * 65 + nl], tile[(k8 + 5) * 65 + nl]); w.w = cvt_pk_bf16(tile[(k8 + 6) * 65 + nl], tile[(k8 + 7) * 65 + nl]);
    *(u32x4*)(dst + (size_t)(nt_ * 64 + nl) * K + kt * 64 + k8) = w;
}

__device__ void phase_p1(const Params& p, int layer, unsigned char* smem) {
    const int tid = opaque_tid(), bid = blockIdx.x, G = gridDim.x;
    float* tile = (float*)smem;
    { const float* win = p.w_in + (size_t)layer * DM * NIN;
      for (int t = bid; t < 32 * 256; t += G) convert_tile(win, DM, NIN, (bf16_t*)(p.ws + OFF_WT), t & 31, t >> 5, tile);
      for (int br = 0; br < 3; ++br) { const float* wsrc = (br == 0 ? p.w_a : br == 1 ? p.w_b : p.w_c) + (size_t)layer * 1024 * DM;
          for (int t = bid; t < 16 * 32; t += G) convert_tile(wsrc, 1024, DM, (bf16_t*)(p.ws + OFF_WA + br * SZ_WBR), t & 15, t >> 4, tile); }
      const float* wo = p.w_out + (size_t)layer * DM * DM;
      for (int t = bid; t < 32 * 32; t += G) convert_tile(wo, DM, DM, (bf16_t*)(p.ws + OFF_WO), t & 31, t >> 5, tile);
      __syncthreads(); }
    { float* tileT = (float*)smem;
      float* ctab = tileT + 256 * 32;
      float* stab = ctab + 256;
      const float* win = p.w_in + (size_t)layer * DM * NIN;
      for (int t = bid; t < 256; t += G) { const int g = t >> 6, k0 = (t & 63) * 32;
          __syncthreads();
          if (tid < 256) { const float a = 2.0f * (float)tid / 256.0f; ctab[tid] = cospif(a); stab[tid] = sinpif(a); }
#pragma unroll
          for (int ps = 0; ps < 4; ++ps) { const int idx = ps * NTHREADS + tid; const int kl = idx >> 6, c4 = (idx & 63) * 4;
              const f32x4 v = *(const f32x4*)(win + (size_t)(k0 + kl) * NIN + 4096 + g * 256 + c4);
              tileT[(c4 + 0) * 32 + kl] = v[0]; tileT[(c4 + 1) * 32 + kl] = v[1]; tileT[(c4 + 2) * 32 + kl] = v[2]; tileT[(c4 + 3) * 32 + kl] = v[3]; }
          __syncthreads();
          const int cp = tid & 255, part = tid >> 8;
          float acc[32];
#pragma unroll
          for (int k = 0; k < 32; ++k) acc[k] = 0.f;
          for (int c = 0; c < 256; ++c) { const int r = (c * cp) & 255; const float tw = part == 0 ? ctab[r] : -stab[r];
#pragma unroll
              for (int k4 = 0; k4 < 8; ++k4) { const f32x4 v = *(const f32x4*)(tileT + c * 32 + k4 * 4); acc[k4 * 4 + 0] += v[0] * tw; acc[k4 * 4 + 1] += v[1] * tw; acc[k4 * 4 + 2] += v[2] * tw; acc[k4 * 4 + 3] += v[3] * tw; } }
          bf16_t* dst = (bf16_t*)(p.ws + OFF_WEFF) + (size_t)(part * 1024 + g * 256 + cp) * DM + k0;
#pragma unroll
          for (int k8 = 0; k8 < 4; ++k8) { u32x4 w; w.x = cvt_pk_bf16(acc[k8 * 8 + 0], acc[k8 * 8 + 1]); w.y = cvt_pk_bf16(acc[k8 * 8 + 2], acc[k8 * 8 + 3]); w.z = cvt_pk_bf16(acc[k8 * 8 + 4], acc[k8 * 8 + 5]); w.w = cvt_pk_bf16(acc[k8 * 8 + 6], acc[k8 * 8 + 7]);
              *(u32x4*)(dst + k8 * 8) = w; } }
      __syncthreads(); }
    { const int lane = tid & 63, wv = tid >> 6; const float* h = (const float*)(p.ws + OFF_H); const float* gam = p.norm_g + layer * DM;
      bf16_t* xn = (bf16_t*)(p.ws + OFF_XN); bf16_t* xnp = (bf16_t*)(p.ws + OFF_XNP);
      for (int l = bid * 8 + wv; l < LP; l += G * 8) {
          if (l < L_TOK) { const f32x4* row = (const f32x4*)(layer == 0 ? (l < NMETA ? p.meta + (size_t)l * DM : p.x + (size_t)(l - NMETA) * DM) : h + (size_t)l * DM); f32x4 v[8]; float ss = 0.f;
#pragma unroll
              for (int i = 0; i < 8; ++i) { v[i] = row[i * 64 + lane]; ss += v[i][0] * v[i][0] + v[i][1] * v[i][1] + v[i][2] * v[i][2] + v[i][3] * v[i][3]; }
              ss = wave_sum(ss); const float inv = rsqrtf(ss * (1.0f / DM) + 1e-6f);
              const int l1 = l / FN2, l2 = l - l1 * FN2; const size_t pr = (size_t)l2 * FN1P + l1;
#pragma unroll
              for (int i = 0; i < 8; ++i) { const f32x4 gg = ((const f32x4*)gam)[i * 64 + lane]; u32x2 w; w.x = cvt_pk_bf16(v[i][0] * inv * gg[0], v[i][1] * inv * gg[1]); w.y = cvt_pk_bf16(v[i][2] * inv * gg[2], v[i][3] * inv * gg[3]);
                  *(u32x2*)(xn + (size_t)l * DM + (i * 64 + lane) * 4) = w; *(u32x2*)(xnp + pr * DM + (i * 64 + lane) * 4) = w; } }
          else { const u32x2 z = (u32x2){0u, 0u};
#pragma unroll
              for (int i = 0; i < 8; ++i) *(u32x2*)(xn + (size_t)l * DM + (i * 64 + lane) * 4) = z; } }
      for (int idx = bid * 8 + wv; idx < FN2 * (FN1P - FN1); idx += G * 8) { const int l2 = idx / (FN1P - FN1), l1 = FN1 + idx % (FN1P - FN1); const size_t pr = (size_t)l2 * FN1P + l1; const u32x2 z = (u32x2){0u, 0u};
#pragma unroll
          for (int i = 0; i < 8; ++i) *(u32x2*)(xnp + pr * DM + (i * 64 + lane) * 4) = z; } }
}

__device__ void na_unit(const Params& p, int layer, int r, int hd, unsigned char* smem) {
    const int tid = opaque_tid(), wv = tid >> 6, lane = tid & 63, l15 = lane & 15, quad = lane >> 4;
    const bf16_t* qkv = (const bf16_t*)(p.ws + OFF_QKV);
    const int r0 = min(max(r - 4, 0), 248);
    unsigned char* sK = smem;
    bf16_t* sVT = (bf16_t*)(smem + 76032);
    float* sRPB = (float*)(smem + 144640);
    float* sMB = (float*)(smem + 146512);
    __syncthreads();
#pragma unroll
    for (int ps = 0; ps < 8; ++ps) { const int tok = ps * 64 + (tid >> 3), ch = tid & 7; const size_t g = (size_t)(NMETA + r0 * 64 + tok) * 3072 + hd * 64 + ch * 8;
        const u32x4 kv = *(const u32x4*)(qkv + g + 1024), vv = *(const u32x4*)(qkv + g + 2048);
        *(u32x4*)(sK + tok * 144 + ch * 16) = kv;
        bf16_t* vt = sVT + (ch * 8) * 536 + tok;
        vt[0] = (bf16_t)vv.x; vt[536] = (bf16_t)(vv.x >> 16); vt[2 * 536] = (bf16_t)vv.y; vt[3 * 536] = (bf16_t)(vv.y >> 16);
        vt[4 * 536] = (bf16_t)vv.z; vt[5 * 536] = (bf16_t)(vv.z >> 16); vt[6 * 536] = (bf16_t)vv.w; vt[7 * 536] = (bf16_t)(vv.w >> 16); }
    if (tid < 128) { const int tok = tid >> 3, ch = tid & 7; const size_t g = (size_t)tok * 3072 + hd * 64 + ch * 8;
        const u32x4 kv = *(const u32x4*)(qkv + g + 1024), vv = *(const u32x4*)(qkv + g + 2048);
        *(u32x4*)(sK + (512 + tok) * 144 + ch * 16) = kv;
        bf16_t* vt = sVT + (ch * 8) * 536 + 512 + tok;
        vt[0] = (bf16_t)vv.x; vt[536] = (bf16_t)(vv.x >> 16); vt[2 * 536] = (bf16_t)vv.y; vt[3 * 536] = (bf16_t)(vv.y >> 16);
        vt[4 * 536] = (bf16_t)vv.z; vt[5 * 536] = (bf16_t)(vv.z >> 16); vt[6 * 536] = (bf16_t)vv.w; vt[7 * 536] = (bf16_t)(vv.w >> 16); }
    if (tid < 465) sRPB[tid] = p.rpb[(size_t)(layer * 16 + hd) * 465 + tid];
    if (tid >= 480 && tid < 496) sMB[tid - 480] = p.meta_bias[(layer * 16 + hd) * 16 + tid - 480];
    const int cb = wv & 3, hf = wv >> 2, c = cb * 16 + l15;
    const bf16_t* qp = qkv + (size_t)(NMETA + r * 64 + c) * 3072 + hd * 64 + quad * 8;
    const bf16x8 bq0 = *(const bf16x8*)qp, bq1 = *(const bf16x8*)(qp + 32);
    __syncthreads();
    const int cu = cb == 0 ? 0 : (cb == 1 ? 8 : (cb == 2 ? 24 : 32)), cs = min(max(c - 8, 0), 48);
    float sc[9][4];
#pragma unroll
    for (int ti = 0; ti < 9; ++ti) { const int j = 4 * hf + (ti >> 1), tt = ti & 1; const int slot0 = ti < 8 ? j * 64 + cu + tt * 16 : 512;
        const unsigned char* kp = sK + (slot0 + l15) * 144 + quad * 16;
        const bf16x8 a0 = *(const bf16x8*)kp, a1 = *(const bf16x8*)(kp + 64);
        f32x4 acc = (f32x4){0.f, 0.f, 0.f, 0.f};
        acc = __builtin_amdgcn_mfma_f32_16x16x32_bf16(a0, bq0, acc, 0, 0, 0); acc = __builtin_amdgcn_mfma_f32_16x16x32_bf16(a1, bq1, acc, 0, 0, 0);
        if (ti < 8) { const float* rp = sRPB + (r0 + j - r + 7) * 31 + (15 - c);
#pragma unroll
            for (int rr = 0; rr < 4; ++rr) { const int kc = cu + tt * 16 + quad * 4 + rr; const bool ok = kc >= cs && kc < cs + 16; const int kcc = ok ? kc : cs;
                sc[ti][rr] = ok ? acc[rr] * 0.125f + rp[kcc] : -1.0e30f; } }
        else {
#pragma unroll
            for (int rr = 0; rr < 4; ++rr) sc[ti][rr] = hf == 0 ? acc[rr] * 0.125f + sMB[quad * 4 + rr] : -1.0e30f; } }
    float mx = -1.0e30f;
#pragma unroll
    for (int ti = 0; ti < 9; ++ti)
#pragma unroll
        for (int rr = 0; rr < 4; ++rr) mx = fmaxf(mx, sc[ti][rr]);
    mx = fmaxf(mx, __shfl_xor(mx, 16)); mx = fmaxf(mx, __shfl_xor(mx, 32));
    float lsum = 0.f;
#pragma unroll
    for (int ti = 0; ti < 9; ++ti)
#pragma unroll
        for (int rr = 0; rr < 4; ++rr) { sc[ti][rr] = __expf(sc[ti][rr] - mx); lsum += sc[ti][rr]; }
    lsum += __shfl_xor(lsum, 16); lsum += __shfl_xor(lsum, 32);
    f32x4 oacc[4];
#pragma unroll
    for (int dt = 0; dt < 4; ++dt) oacc[dt] = (f32x4){0.f, 0.f, 0.f, 0.f};
#pragma unroll
    for (int ks = 0; ks < 5; ++ks) { const int tA = 2 * ks, tB = 2 * ks + 1;
        const int jA = 4 * hf + (tA >> 1); const int slotA = tA < 8 ? jA * 64 + cu + (tA & 1) * 16 : 512; const int slotB = ks < 4 ? (4 * hf + (tB >> 1)) * 64 + cu + 16 : 512;
        u32x4 pa; pa.x = cvt_pk_bf16(sc[tA][0], sc[tA][1]); pa.y = cvt_pk_bf16(sc[tA][2], sc[tA][3]);
        if (ks < 4) { pa.z = cvt_pk_bf16(sc[tA + 1 < 9 ? tA + 1 : 8][0], sc[tA + 1 < 9 ? tA + 1 : 8][1]); pa.w = cvt_pk_bf16(sc[tA + 1 < 9 ? tA + 1 : 8][2], sc[tA + 1 < 9 ? tA + 1 : 8][3]); } else { pa.z = 0u; pa.w = 0u; }
        const bf16x8 af = __builtin_bit_cast(bf16x8, pa);
#pragma unroll
        for (int dt = 0; dt < 4; ++dt) { const bf16_t* vr = sVT + (dt * 16 + l15) * 536 + quad * 4;
            const u32x2 lo = *(const u32x2*)(vr + slotA), hi = *(const u32x2*)(vr + slotB);
            const u32x4 bb = (u32x4){lo.x, lo.y, hi.x, hi.y};
            oacc[dt] = __builtin_amdgcn_mfma_f32_16x16x32_bf16(af, __builtin_bit_cast(bf16x8, bb), oacc[dt], 0, 0, 0); } }
    __syncthreads();
    float* part = (float*)smem + cb * 1056;
    if (hf == 1) {
#pragma unroll
        for (int dt = 0; dt < 4; ++dt)
#pragma unroll
            for (int rr = 0; rr < 4; ++rr) part[(quad * 4 + rr) * 64 + dt * 16 + l15] = oacc[dt][rr];
        if (quad == 0) { part[1024 + l15] = mx; part[1040 + l15] = lsum; } }
    __syncthreads();
    if (hf == 0) { bf16_t* yc = (bf16_t*)(p.ws + OFF_GATE + 2 * SZ_GATE);
#pragma unroll
        for (int rr = 0; rr < 4; ++rr) { const int qy = quad * 4 + rr; const float m0 = __shfl(mx, qy), l0 = __shfl(lsum, qy); const float m1 = part[1024 + qy], l1 = part[1040 + qy];
            const float M = fmaxf(m0, m1), f0 = __expf(m0 - M), f1 = __expf(m1 - M); const float inv = 1.0f / (f0 * l0 + f1 * l1);
            bf16_t* gp = yc + (size_t)(NMETA + r * 64 + cb * 16 + qy) * 1024 + hd * 64 + l15;
#pragma unroll
            for (int dt = 0; dt < 4; ++dt) { const float o = (f0 * oacc[dt][rr] + f1 * part[qy * 64 + dt * 16 + l15]) * inv; gp[dt * 16] = f2bf(o * bf2f(gp[dt * 16])); } } }
}
__device__ void na_meta_unit(const Params& p, int layer) {
    const int tid = opaque_tid();
    if (tid < 256) { const int hd = tid >> 4, qi = tid & 15; const bf16_t* qkv = (const bf16_t*)(p.ws + OFF_QKV);
        float q[64];
        { const u32x4* qp = (const u32x4*)(qkv + (size_t)qi * 3072 + hd * 64);
#pragma unroll
          for (int i = 0; i < 8; ++i) { const u32x4 v = qp[i]; q[i * 8 + 0] = lo_bf(v.x) * 0.125f; q[i * 8 + 1] = hi_bf(v.x) * 0.125f; q[i * 8 + 2] = lo_bf(v.y) * 0.125f; q[i * 8 + 3] = hi_bf(v.y) * 0.125f;
              q[i * 8 + 4] = lo_bf(v.z) * 0.125f; q[i * 8 + 5] = hi_bf(v.z) * 0.125f; q[i * 8 + 6] = lo_bf(v.w) * 0.125f; q[i * 8 + 7] = hi_bf(v.w) * 0.125f; } }
        float o[64];
#pragma unroll
        for (int i = 0; i < 64; ++i) o[i] = 0.f;
        float mx = -3.0e38f, lsum = 0.f;
#pragma unroll 1
        for (int m = 0; m < 16; ++m) { const u32x4* kp = (const u32x4*)(qkv + (size_t)m * 3072 + 1024 + hd * 64); const u32x4* vp = (const u32x4*)(qkv + (size_t)m * 3072 + 2048 + hd * 64);
            float d0 = 0.f, d1 = 0.f;
#pragma unroll
            for (int e = 0; e < 8; ++e) { const u32x4 v = kp[e];
                d0 += q[e * 8 + 0] * lo_bf(v.x) + q[e * 8 + 2] * lo_bf(v.y) + q[e * 8 + 4] * lo_bf(v.z) + q[e * 8 + 6] * lo_bf(v.w);
                d1 += q[e * 8 + 1] * hi_bf(v.x) + q[e * 8 + 3] * hi_bf(v.y) + q[e * 8 + 5] * hi_bf(v.z) + q[e * 8 + 7] * hi_bf(v.w); }
            const float sc = d0 + d1 + p.meta_bias[(layer * 16 + hd) * 16 + m]; const float mnew = fmaxf(mx, sc); const float alpha = __expf(mx - mnew), pi = __expf(sc - mnew);
            lsum = lsum * alpha + pi; mx = mnew;
#pragma unroll
            for (int e = 0; e < 8; ++e) { const u32x4 v = vp[e];
                o[e * 8 + 0] = o[e * 8 + 0] * alpha + pi * lo_bf(v.x); o[e * 8 + 1] = o[e * 8 + 1] * alpha + pi * hi_bf(v.x); o[e * 8 + 2] = o[e * 8 + 2] * alpha + pi * lo_bf(v.y); o[e * 8 + 3] = o[e * 8 + 3] * alpha + pi * hi_bf(v.y);
                o[e * 8 + 4] = o[e * 8 + 4] * alpha + pi * lo_bf(v.z); o[e * 8 + 5] = o[e * 8 + 5] * alpha + pi * hi_bf(v.z); o[e * 8 + 6] = o[e * 8 + 6] * alpha + pi * lo_bf(v.w); o[e * 8 + 7] = o[e * 8 + 7] * alpha + pi * hi_bf(v.w); } }
        const float inv = 1.0f / lsum; u32x4* gp = (u32x4*)((bf16_t*)(p.ws + OFF_GATE + 2 * SZ_GATE) + (size_t)qi * 1024 + hd * 64);
#pragma unroll
        for (int e = 0; e < 8; ++e) { const u32x4 g = gp[e]; u32x4 w;
            w.x = cvt_pk_bf16(o[e * 8 + 0] * inv * lo_bf(g.x), o[e * 8 + 1] * inv * hi_bf(g.x)); w.y = cvt_pk_bf16(o[e * 8 + 2] * inv * lo_bf(g.y), o[e * 8 + 3] * inv * hi_bf(g.y));
            w.z = cvt_pk_bf16(o[e * 8 + 4] * inv * lo_bf(g.z), o[e * 8 + 5] * inv * hi_bf(g.z)); w.w = cvt_pk_bf16(o[e * 8 + 6] * inv * lo_bf(g.w), o[e * 8 + 7] * inv * hi_bf(g.w));
            gp[e] = w; } }
}

__device__ __forceinline__ unsigned rev4_14(unsigned k) { unsigned r = __brev(k) >> 18; return ((r & 0x1555u) << 1) | ((r >> 1) & 0x1555u); }
__device__ __forceinline__ float2 cmul(float2 a, float2 b) { return make_float2(a.x * b.x - a.y * b.y, a.x * b.y + a.y * b.x); }
#define PADI(i) ((i) + ((i) >> 4))
#define CFF(n) cff[2 * PADI((n) >> 1) + ((n) & 1)]
__device__ __forceinline__ void hw_sincos(float rev, float& sn, float& cs) { sn = __builtin_amdgcn_sinf(rev); cs = __builtin_amdgcn_cosf(rev); }
__device__ __forceinline__ float c16(int k) { const float t[10] = {1.0f, 0.9238795325f, 0.7071067812f, 0.3826834324f, 0.0f, -0.3826834324f, -0.7071067812f, -0.9238795325f, -1.0f, -0.9238795325f}; return t[k]; }
__device__ __forceinline__ float s16(int k) { const float t[10] = {0.0f, 0.3826834324f, 0.7071067812f, 0.9238795325f, 1.0f, 0.9238795325f, 0.7071067812f, 0.3826834324f, 0.0f, -0.3826834324f}; return t[k]; }
__device__ __forceinline__ float2 cadd(float2 a, float2 b) { return make_float2(a.x + b.x, a.y + b.y); }
__device__ __forceinline__ float2 csub(float2 a, float2 b) { return make_float2(a.x - b.x, a.y - b.y); }
template <int SGN> __device__ __forceinline__ void bf4(float2& a0, float2& a1, float2& a2, float2& a3) {
    const float2 t0 = cadd(a0, a2), t1 = csub(a0, a2), t2 = cadd(a1, a3), d = csub(a1, a3);
    const float2 t3 = SGN < 0 ? make_float2(d.y, -d.x) : make_float2(-d.y, d.x);
    a0 = cadd(t0, t2); a1 = cadd(t1, t3); a2 = csub(t0, t2); a3 = csub(t1, t3);
}
template <int S> __device__ __forceinline__ void r16_fwd_pass(float2* a) {
    constexpr int Q = S / 4;
    for (int u = opaque_tid(); u < 1024; u += NTHREADS) { const int j = u & (Q - 1); const int base = ((u - j) << 4) + j;
        float2 x[4][4];
#pragma unroll
        for (int aa = 0; aa < 4; ++aa)
#pragma unroll
            for (int bb = 0; bb < 4; ++bb) x[aa][bb] = a[PADI(base + aa * S + bb * Q)];
        float sn, cs; hw_sincos((float)j / (float)(4 * S), sn, cs); const float2 wb0 = make_float2(cs, -sn);
#pragma unroll
        for (int bb = 0; bb < 4; ++bb) { const float2 w1 = bb == 0 ? wb0 : cmul(wb0, make_float2(c16(bb), -s16(bb))); const float2 w2 = cmul(w1, w1), w3 = cmul(w2, w1);
            bf4<-1>(x[0][bb], x[1][bb], x[2][bb], x[3][bb]); x[1][bb] = cmul(x[1][bb], w1); x[2][bb] = cmul(x[2][bb], w2); x[3][bb] = cmul(x[3][bb], w3); }
        hw_sincos((float)j / (float)S, sn, cs); const float2 v1 = make_float2(cs, -sn), v2 = cmul(v1, v1), v3 = cmul(v2, v1);
#pragma unroll
        for (int aa = 0; aa < 4; ++aa) { bf4<-1>(x[aa][0], x[aa][1], x[aa][2], x[aa][3]); x[aa][1] = cmul(x[aa][1], v1); x[aa][2] = cmul(x[aa][2], v2); x[aa][3] = cmul(x[aa][3], v3); }
#pragma unroll
        for (int aa = 0; aa < 4; ++aa)
#pragma unroll
            for (int bb = 0; bb < 4; ++bb) a[PADI(base + aa * S + bb * Q)] = x[aa][bb]; }
    __syncthreads();
}
template <int S> __device__ __forceinline__ void r16_inv_pass(float2* a) {
    constexpr int Q = S / 4;
    for (int u = opaque_tid(); u < 1024; u += NTHREADS) { const int j = u & (Q - 1); const int base = ((u - j) << 4) + j;
        float2 x[4][4];
#pragma unroll
        for (int aa = 0; aa < 4; ++aa)
#pragma unroll
            for (int bb = 0; bb < 4; ++bb) x[aa][bb] = a[PADI(base + aa * S + bb * Q)];
        float sn, cs; hw_sincos((float)j / (float)S, sn, cs); const float2 v1 = make_float2(cs, sn), v2 = cmul(v1, v1), v3 = cmul(v2, v1);
#pragma unroll
        for (int aa = 0; aa < 4; ++aa) { x[aa][1] = cmul(x[aa][1], v1); x[aa][2] = cmul(x[aa][2], v2); x[aa][3] = cmul(x[aa][3], v3); bf4<1>(x[aa][0], x[aa][1], x[aa][2], x[aa][3]); }
        hw_sincos((float)j / (float)(4 * S), sn, cs); const float2 wb0 = make_float2(cs, sn);
#pragma unroll
        for (int bb = 0; bb < 4; ++bb) { const float2 w1 = bb == 0 ? wb0 : cmul(wb0, make_float2(c16(bb), s16(bb))); const float2 w2 = cmul(w1, w1), w3 = cmul(w2, w1);
            x[1][bb] = cmul(x[1][bb], w1); x[2][bb] = cmul(x[2][bb], w2); x[3][bb] = cmul(x[3][bb], w3); bf4<1>(x[0][bb], x[1][bb], x[2][bb], x[3][bb]); }
#pragma unroll
        for (int aa = 0; aa < 4; ++aa)
#pragma unroll
            for (int bb = 0; bb < 4; ++bb) a[PADI(base + aa * S + bb * Q)] = x[aa][bb]; }
    __syncthreads();
}
__device__ void fft_fwd(float2* a) {
    r16_fwd_pass<4096>(a);
    r16_fwd_pass<256>(a);
    { const int span = 16;
        for (int b = opaque_tid(); b < 4096; b += NTHREADS) { const int j = b & (span - 1); const int base = ((b - j) << 2) + j;
            const int i0 = PADI(base), i1 = PADI(base + span), i2 = PADI(base + 2 * span), i3 = PADI(base + 3 * span);
            float2 a0 = a[i0], a1 = a[i1], a2 = a[i2], a3 = a[i3];
            const float2 w1 = make_float2(c16(0) * 0.f + __builtin_amdgcn_cosf((float)j * (1.0f / 64.0f)), -__builtin_amdgcn_sinf((float)j * (1.0f / 64.0f))), w2 = cmul(w1, w1), w3 = cmul(w2, w1);
            bf4<-1>(a0, a1, a2, a3);
            a[i0] = a0; a[i1] = cmul(a1, w1); a[i2] = cmul(a2, w2); a[i3] = cmul(a3, w3); }
        __syncthreads(); }
    for (int blk = opaque_tid(); blk < 1024; blk += NTHREADS) { float2* pb = a + blk * 17; float2 x[16];
#pragma unroll
        for (int e = 0; e < 16; ++e) x[e] = pb[e];
#pragma unroll
        for (int j = 0; j < 4; ++j) { bf4<-1>(x[j], x[j + 4], x[j + 8], x[j + 12]);
            x[j + 4] = cmul(x[j + 4], make_float2(c16(j), -s16(j))); x[j + 8] = cmul(x[j + 8], make_float2(c16(2 * j), -s16(2 * j))); x[j + 12] = cmul(x[j + 12], make_float2(c16(3 * j), -s16(3 * j))); }
#pragma unroll
        for (int g = 0; g < 4; ++g) bf4<-1>(x[4 * g], x[4 * g + 1], x[4 * g + 2], x[4 * g + 3]);
#pragma unroll
        for (int e = 0; e < 16; ++e) pb[e] = x[e]; }
    __syncthreads();
}
__device__ void fft_inv(float2* a) {
    for (int blk = opaque_tid(); blk < 1024; blk += NTHREADS) { float2* pb = a + blk * 17; float2 x[16];
#pragma unroll
        for (int e = 0; e < 16; ++e) x[e] = pb[e];
#pragma unroll
        for (int g = 0; g < 4; ++g) bf4<1>(x[4 * g], x[4 * g + 1], x[4 * g + 2], x[4 * g + 3]);
#pragma unroll
        for (int j = 0; j < 4; ++j) { x[j + 4] = cmul(x[j + 4], make_float2(c16(j), s16(j))); x[j + 8] = cmul(x[j + 8], make_float2(c16(2 * j), s16(2 * j))); x[j + 12] = cmul(x[j + 12], make_float2(c16(3 * j), s16(3 * j)));
            bf4<1>(x[j], x[j + 4], x[j + 8], x[j + 12]); }
#pragma unroll
        for (int e = 0; e < 16; ++e) pb[e] = x[e]; }
    __syncthreads();
    { const int span = 16;
        for (int b = opaque_tid(); b < 4096; b += NTHREADS) { const int j = b & (span - 1); const int base = ((b - j) << 2) + j;
            const int i0 = PADI(base), i1 = PADI(base + span), i2 = PADI(base + 2 * span), i3 = PADI(base + 3 * span);
            const float2 w1 = make_float2(__builtin_amdgcn_cosf((float)j * (1.0f / 64.0f)), __builtin_amdgcn_sinf((float)j * (1.0f / 64.0f))), w2 = cmul(w1, w1), w3 = cmul(w2, w1);
            float2 a0 = a[i0], a1 = cmul(a[i1], w1), a2 = cmul(a[i2], w2), a3 = cmul(a[i3], w3);
            bf4<1>(a0, a1, a2, a3);
            a[i0] = a0; a[i1] = a1; a[i2] = a2; a[i3] = a3; }
        __syncthreads(); }
    r16_inv_pass<256>(a);
    r16_inv_pass<4096>(a);
}
__device__ __forceinline__ void hy_val8(const bf16_t* __restrict__ row, int t0, const float (&w)[4], float (&o)[8]) {
    const u32x4 v = *(const u32x4*)(row + t0);
    float x[10];
    x[0] = t0 > 0 ? bf2f(row[t0 - 1]) : 0.f; x[9] = (t0 + 8 < L_TOK) ? bf2f(row[t0 + 8]) : 0.f;
    x[1] = lo_bf(v.x); x[2] = hi_bf(v.x); x[3] = lo_bf(v.y); x[4] = hi_bf(v.y); x[5] = lo_bf(v.z); x[6] = hi_bf(v.z); x[7] = lo_bf(v.w); x[8] = hi_bf(v.w);
#pragma unroll
    for (int e = 0; e < 8; ++e) o[e] = w[0] * x[e] + w[1] * x[e + 1] + w[2] * x[e + 2] + w[3];
}
struct HyCh { const bf16_t* __restrict__ ru; const bf16_t* __restrict__ r1; const bf16_t* __restrict__ r2; float wu[4], w1[4], w2[4]; };

constexpr int SD_W4B = 0  , SD_GFX = 512, SD_GBX = 528, SD_EF = 544, SD_EB = 560, SD_VH = 576, SD_VT = 592, SD_END = 608;
constexpr int NCHUNK = L_TOK / 8;

template <int ORDER>
__device__ void hy_conv(const HyCh& hc, float2* cf, float* side, unsigned char* scratch) {
    const int tid = opaque_tid(); float* cff = (float*)cf;
    f32x4* __restrict__ heo = (f32x4*)(scratch + HS_HEO); const float* __restrict__ z2g = (const float*)(scratch + HS_Z2);
    if (tid < 15) side[SD_EF + tid] = CFF(16369 + tid); else if (tid >= 32 && tid < 47) side[SD_EB + tid - 32] = CFF(32768 - (16369 + tid - 32));
    __syncthreads();
    fft_fwd(cf);
    for (int k = tid; k <= 8192; k += NTHREADS) { const int kp = (16384 - k) & 16383; const float2 a = cf[PADI(rev4_14(k))], bq = cf[PADI(rev4_14(kp))];
        const float bx = bq.x, by = -bq.y; const float sc = 1.0f / 16384.0f;
        heo[k] = (f32x4){0.5f * (a.x + bx) * sc, 0.5f * (a.y + by) * sc, 0.5f * (a.y - by) * sc, -0.5f * (a.x - bx) * sc}; }
    __syncthreads();
    for (int c = tid; c < NCHUNK; c += NTHREADS) { float v[8];
        if (ORDER == 0) hy_val8(hc.ru, 8 * c, hc.wu, v);
        else { const f32x4 p0 = *(const f32x4*)(z2g + 8 * c), p1 = *(const f32x4*)(z2g + 8 * c + 4); v[0] = p0[0]; v[1] = p0[1]; v[2] = p0[2]; v[3] = p0[3]; v[4] = p1[0]; v[5] = p1[1]; v[6] = p1[2]; v[7] = p1[3]; }
        float2* d = cf + PADI(4 * c); d[0] = make_float2(v[0], v[1]); d[1] = make_float2(v[2], v[3]); d[2] = make_float2(v[4], v[5]); d[3] = make_float2(v[6], v[7]);
        if (c < 2) {
#pragma unroll
            for (int e = 0; e < 8; ++e) side[SD_VH + 8 * c + e] = v[e]; }
        if (c >= NCHUNK - 2) {
#pragma unroll
            for (int e = 0; e < 8; ++e) side[SD_VT + 8 * (c - (NCHUNK - 2)) + e] = v[e]; } }
    for (int i = L_TOK / 2 + tid; i < 16384; i += NTHREADS) cf[PADI(i)] = make_float2(0.f, 0.f);
    __syncthreads();
    fft_fwd(cf);
#pragma unroll 4
    for (int k = tid; k <= 8192; k += NTHREADS) { const int kp = (16384 - k) & 16383; const unsigned ik = PADI(rev4_14(k)), ikp = PADI(rev4_14(kp)); const float2 a = cf[ik], bq = cf[ikp];
        const float bx = bq.x, by = -bq.y;
        const float2 XE = make_float2(0.5f * (a.x + bx), 0.5f * (a.y + by)), XO = make_float2(0.5f * (a.y - by), -0.5f * (a.x - bx));
        const f32x4 hh = heo[k]; const float2 HE = make_float2(hh[0], hh[1]), HO = make_float2(hh[2], hh[3]);
        float sn, cs; hw_sincos((float)k / 16384.0f, sn, cs); const float2 w = make_float2(cs, -sn);
        const float2 xoho = cmul(XO, HO), wx = cmul(w, xoho), xehe = cmul(XE, HE), xeho = cmul(XE, HO), xohe = cmul(XO, HE);
        const float2 YE = make_float2(xehe.x + wx.x, xehe.y + wx.y), YO = make_float2(xeho.x + xohe.x, xeho.y + xohe.y);
        cf[ik] = make_float2(YE.x - YO.y, YE.y + YO.x); cf[ikp] = make_float2(YE.x + YO.y, -YE.y + YO.x); }
    __syncthreads();
    fft_inv(cf);
    if (tid < 16) { const int t = tid; float d = 0.f;
        for (int s = t + 16384; s < L_TOK; ++s) { const int l = s - t; const float wrong = l == 16384 ? 0.f : side[SD_EF + 16399 - l]; d += (side[SD_GBX + l - 16384] - wrong) * side[SD_VT + s - 16384]; }
        CFF(t) += d; }
    else if (tid >= 32 && tid < 48) { const int t = 16384 + tid - 32; float d = 0.f;
        for (int s = 0; s <= t - 16384; ++s) { const int l = t - s; const float wrong = l == 16384 ? 0.f : side[SD_EB + 16399 - l]; d += (side[SD_GFX + l - 16384] - wrong) * side[SD_VH + s]; }
        CFF(t) += d; }
    __syncthreads();
}

__device__ void hyena_unit(const Params& p, int layer, int ch, unsigned char* smem, unsigned char* scratch) {
    const int tid = opaque_tid(); float2* cf = (float2*)smem; float* cff = (float*)smem; float* side = (float*)(smem + 139264);
    const bf16_t* hyin = (const bf16_t*)(p.ws + OFF_HYIN);
    HyCh hc; hc.ru = hyin + (size_t)ch * LP; hc.r1 = hyin + (size_t)(1024 + ch) * LP; hc.r2 = hyin + (size_t)(2048 + ch) * LP;
    { const float* cw = p.conv_w + (size_t)layer * 3 * 3072; const float* cb = p.conv_b + (size_t)layer * 3072;
#pragma unroll
      for (int jj = 0; jj < 3; ++jj) { hc.wu[jj] = cw[jj * 3072 + ch]; hc.w1[jj] = cw[jj * 3072 + 1024 + ch]; hc.w2[jj] = cw[jj * 3072 + 2048 + ch]; }
      hc.wu[3] = cb[ch]; hc.w1[3] = cb[1024 + ch]; hc.w2[3] = cb[2048 + ch]; }
    const float sk0 = p.skip[(layer * 2 + 0) * 1024 + ch], sk1 = p.skip[(layer * 2 + 1) * 1024 + ch];
    float* __restrict__ z2g = (float*)(scratch + HS_Z2); float* __restrict__ g2f = (float*)(scratch + HS_G2F); float* __restrict__ g2b = (float*)(scratch + HS_G2B);
    bf16_t* __restrict__ hyout = (bf16_t*)(p.ws + OFF_HYOUT) + (size_t)ch * LP;
    __syncthreads();
    { bf16_t* w4b = (bf16_t*)(side + SD_W4B);
      for (int i = tid; i < 16 * 64; i += NTHREADS) { const int n = i >> 6, k = i & 63; w4b[i] = n < 4 ? f2bf(p.f_w4[((size_t)layer * 64 + k) * 4096 + n * 1024 + ch]) : (bf16_t)0; }
      __syncthreads();
      const bf16_t* __restrict__ h3b = (const bf16_t*)(p.ws + OFF_H3) + (size_t)layer * L_TOK * 64;
      const int lane = tid & 63, wv = tid >> 6, col = lane & 15, quad = lane >> 4;
      const float dk = col < 4 ? fabsf(p.decay[((layer * 2 + (col >> 1)) * 2 + (col & 1)) * 1024 + ch]) * (1.4426950408889634f / (float)(L_TOK - 1)) : 0.f;
      const bf16x8 b0 = *(const bf16x8*)(w4b + col * 64 + quad * 8), b1 = *(const bf16x8*)(w4b + col * 64 + 32 + quad * 8);
      for (int gb = wv; gb < L_TOK / 16; gb += 64) {
          bf16x8 a0[8], a1[8];
#pragma unroll
          for (int i = 0; i < 8; ++i) { const int g = min(gb + 8 * i, L_TOK / 16 - 1); const bf16_t* hr = h3b + (size_t)(g * 16 + col) * 64 + quad * 8; a0[i] = *(const bf16x8*)hr; a1[i] = *(const bf16x8*)(hr + 32); }
#pragma unroll
          for (int i = 0; i < 8; ++i) { const int g = gb + 8 * i;
              if (g < L_TOK / 16) {
                  f32x4 acc = (f32x4){0.f, 0.f, 0.f, 0.f};
                  acc = __builtin_amdgcn_mfma_f32_16x16x32_bf16(a0[i], b0, acc, 0, 0, 0); acc = __builtin_amdgcn_mfma_f32_16x16x32_bf16(a1[i], b1, acc, 0, 0, 0);
                  if (col < 4) { const int lag0 = g * 16 + quad * 4; float v[4];
#pragma unroll
                      for (int r = 0; r < 4; ++r) v[r] = acc[r] * __builtin_amdgcn_exp2f(-(float)(lag0 + r) * dk);
                      if (col == 2) *(f32x4*)(g2f + lag0) = (f32x4){v[0], v[1], v[2], v[3]};
                      else if (col == 3) *(f32x4*)(g2b + lag0) = (f32x4){v[0], v[1], v[2], v[3]};
                      else if (col == 0) { if (lag0 < NMAIN) { float2* d = cf + PADI(lag0 >> 1); d[0] = make_float2(v[0], v[1]); d[1] = make_float2(v[2], v[3]); }
                                           else { side[SD_GFX + lag0 - NMAIN] = v[0]; side[SD_GFX + lag0 - NMAIN + 1] = v[1]; side[SD_GFX + lag0 - NMAIN + 2] = v[2]; side[SD_GFX + lag0 - NMAIN + 3] = v[3]; } }
                      else { if (lag0 < NMAIN) {
#pragma unroll
                                 for (int r = 0; r < 4; ++r) if (lag0 + r >= 1) CFF(32768 - lag0 - r) = v[r]; }
                             else { side[SD_GBX + lag0 - NMAIN] = v[0]; side[SD_GBX + lag0 - NMAIN + 1] = v[1]; side[SD_GBX + lag0 - NMAIN + 2] = v[2]; side[SD_GBX + lag0 - NMAIN + 3] = v[3]; } } } } } }
      if (tid == 0) CFF(NMAIN) = 0.f;
      __syncthreads(); }
    hy_conv<0>(hc, cf, side, scratch);
    for (int c = tid; c < NCHUNK; c += NTHREADS) { float u8[8], x8[8]; hy_val8(hc.ru, 8 * c, hc.wu, u8); hy_val8(hc.r1, 8 * c, hc.w1, x8);
        const float2* s = cf + PADI(4 * c); const float2 y0 = s[0], y1 = s[1], y2 = s[2], y3 = s[3];
        const f32x4 o0 = (f32x4){x8[0] * (y0.x + sk0 * u8[0]), x8[1] * (y0.y + sk0 * u8[1]), x8[2] * (y1.x + sk0 * u8[2]), x8[3] * (y1.y + sk0 * u8[3])};
        const f32x4 o1 = (f32x4){x8[4] * (y2.x + sk0 * u8[4]), x8[5] * (y2.y + sk0 * u8[5]), x8[6] * (y3.x + sk0 * u8[6]), x8[7] * (y3.y + sk0 * u8[7])};
        *(f32x4*)(z2g + 8 * c) = o0; *(f32x4*)(z2g + 8 * c + 4) = o1; }
    __syncthreads();
    for (int q = tid; q < L_TOK / 4; q += NTHREADS) { const int lag0 = 4 * q; const f32x4 gf = *(const f32x4*)(g2f + lag0), gb = *(const f32x4*)(g2b + lag0);
        if (lag0 < NMAIN) { float2* d = cf + PADI(lag0 >> 1); d[0] = make_float2(gf[0], gf[1]); d[1] = make_float2(gf[2], gf[3]);
#pragma unroll
            for (int r = 0; r < 4; ++r) if (lag0 + r >= 1) CFF(32768 - lag0 - r) = gb[r]; }
        else {
#pragma unroll
            for (int r = 0; r < 4; ++r) { side[SD_GFX + lag0 - NMAIN + r] = gf[r]; side[SD_GBX + lag0 - NMAIN + r] = gb[r]; } } }
    if (tid == 0) CFF(NMAIN) = 0.f;
    __syncthreads();
    hy_conv<1>(hc, cf, side, scratch);
    for (int c = tid; c < NCHUNK; c += NTHREADS) { float x8[8]; hy_val8(hc.r2, 8 * c, hc.w2, x8);
        const f32x4 p0 = *(const f32x4*)(z2g + 8 * c), p1 = *(const f32x4*)(z2g + 8 * c + 4);
        const float2* s = cf + PADI(4 * c); const float2 y0 = s[0], y1 = s[1], y2 = s[2], y3 = s[3];
        u32x4 w; w.x = cvt_pk_bf16(x8[0] * (y0.x + sk1 * p0[0]), x8[1] * (y0.y + sk1 * p0[1])); w.y = cvt_pk_bf16(x8[2] * (y1.x + sk1 * p0[2]), x8[3] * (y1.y + sk1 * p0[3]));
        w.z = cvt_pk_bf16(x8[4] * (y2.x + sk1 * p1[0]), x8[5] * (y2.y + sk1 * p1[1])); w.w = cvt_pk_bf16(x8[6] * (y3.x + sk1 * p1[2]), x8[7] * (y3.y + sk1 * p1[3]));
        *(u32x4*)(hyout + 8 * c) = w; }
    __syncthreads();
}

__device__ void transpose_unit(const Params& p, int ct, int tt, unsigned char* smem) {
    const int tid = opaque_tid(); bf16_t* tile = (bf16_t*)smem;
    const bf16_t* hyout = (const bf16_t*)(p.ws + OFF_HYOUT); bf16_t* ya = (bf16_t*)(p.ws + OFF_GATE);
    __syncthreads();
    { const int cl = tid >> 3, t8 = (tid & 7) * 8; *(u32x4*)(tile + cl * 72 + t8) = *(const u32x4*)(hyout + (size_t)(ct * 64 + cl) * LP + tt * 64 + t8); }
    __syncthreads();
    { const int tl = tid >> 3, c8 = (tid & 7) * 8; const int t = tt * 64 + tl;
      if (t < L_TOK) { bf16_t* gp = ya + (size_t)t * 1024 + ct * 64 + c8; const u32x4 g = *(const u32x4*)gp;
          float v[8];
#pragma unroll
          for (int i = 0; i < 8; ++i) v[i] = bf2f(tile[(c8 + i) * 72 + tl]);
          u32x4 w; w.x = cvt_pk_bf16(v[0] * lo_bf(g.x), v[1] * hi_bf(g.x)); w.y = cvt_pk_bf16(v[2] * lo_bf(g.y), v[3] * hi_bf(g.y)); w.z = cvt_pk_bf16(v[4] * lo_bf(g.z), v[5] * hi_bf(g.z)); w.w = cvt_pk_bf16(v[6] * lo_bf(g.w), v[7] * hi_bf(g.w));
          *(u32x4*)gp = w; } }
}

__device__ void phase_final(const Params& p) {
    const int tid = opaque_tid(), lane = tid & 63, wv = tid >> 6; const float* h = (const float*)(p.ws + OFF_H);
    for (int l = NMETA + blockIdx.x * 8 + wv; l < L_TOK; l += gridDim.x * 8) { const f32x4* row = (const f32x4*)(h + (size_t)l * DM); f32x4 v[8]; float ss = 0.f;
#pragma unroll
        for (int i = 0; i < 8; ++i) { v[i] = row[i * 64 + lane]; ss += v[i][0] * v[i][0] + v[i][1] * v[i][1] + v[i][2] * v[i][2] + v[i][3] * v[i][3]; }
        ss = wave_sum(ss); const float inv = rsqrtf(ss * (1.0f / DM) + 1e-6f); f32x4* o = (f32x4*)(p.out + (size_t)(l - NMETA) * DM);
#pragma unroll
        for (int i = 0; i < 8; ++i) { const f32x4 gg = ((const f32x4*)p.final_g)[i * 64 + lane]; o[i * 64 + lane] = v[i] * inv * gg; } }
}

__device__ void mini_branch(const Params& p) {
    const int tid = opaque_tid(), lane = tid & 63, wv = tid >> 6, nt_ = blockIdx.x * 8 + wv;
    if (nt_ < 128) { const int rc = lane & 15, quad = lane >> 4; const int n0 = nt_ * 16;
        const bf16_t* mg = (const bf16_t*)(p.ws + OFF_MERGE); bf16_t* mb = (bf16_t*)(p.ws + OFF_M);
        float tot[4] = {0.f, 0.f, 0.f, 0.f};
#pragma unroll 1
        for (int br = 0; br < 3; ++br) { const bf16_t* A = (const bf16_t*)(p.ws + OFF_GATE + (size_t)br * SZ_GATE) + (size_t)(NMAIN + rc) * 1024 + quad * 8;
            const bf16_t* B = (const bf16_t*)(p.ws + OFF_WA + (size_t)br * SZ_WBR) + (size_t)(n0 + rc) * 1024 + quad * 8;
            f32x4 acc = (f32x4){0.f, 0.f, 0.f, 0.f};
#pragma unroll 1
            for (int kb = 0; kb < 32; kb += 8) { bf16x8 av[8], bv[8];
#pragma unroll
                for (int i = 0; i < 8; ++i) { av[i] = *(const bf16x8*)(A + (kb + i) * 32); bv[i] = *(const bf16x8*)(B + (kb + i) * 32); }
#pragma unroll
                for (int i = 0; i < 8; ++i) acc = __builtin_amdgcn_mfma_f32_16x16x32_bf16(av[i], bv[i], acc, 0, 0, 0); }
#pragma unroll
            for (int r = 0; r < 4; ++r) tot[r] += acc[r] * bf2f(mg[(size_t)(NMAIN + quad * 4 + r) * 6144 + br * 2048 + n0 + rc]); }
#pragma unroll
        for (int r = 0; r < 4; ++r) mb[(size_t)(NMAIN + quad * 4 + r) * DM + n0 + rc] = f2bf(tot[r]); }
}
__device__ void mini_out(const Params& p) {
    const int tid = opaque_tid(), lane = tid & 63, wv = tid >> 6, nt_ = blockIdx.x * 8 + wv;
    if (nt_ < 128) { const int rc = lane & 15, quad = lane >> 4; const int n0 = nt_ * 16;
        const bf16_t* A = (const bf16_t*)(p.ws + OFF_M) + (size_t)(NMAIN + rc) * DM + quad * 8; const bf16_t* B = (const bf16_t*)(p.ws + OFF_WO) + (size_t)(n0 + rc) * DM + quad * 8;
        f32x4 acc = (f32x4){0.f, 0.f, 0.f, 0.f};
#pragma unroll 1
        for (int kb = 0; kb < 64; kb += 8) { bf16x8 av[8], bv[8];
#pragma unroll
            for (int i = 0; i < 8; ++i) { av[i] = *(const bf16x8*)(A + (kb + i) * 32); bv[i] = *(const bf16x8*)(B + (kb + i) * 32); }
#pragma unroll
            for (int i = 0; i < 8; ++i) acc = __builtin_amdgcn_mfma_f32_16x16x32_bf16(av[i], bv[i], acc, 0, 0, 0); }
        float* h = (float*)(p.ws + OFF_H);
#pragma unroll
        for (int r = 0; r < 4; ++r) h[(size_t)(NMAIN + quad * 4 + r) * DM + n0 + rc] += acc[r]; }
}

enum { OP_P1 = 0, OP_SYNC, OP_GEMM, OP_NA, OP_HYENA, OP_TRANS, OP_NOP };
__global__ void __launch_bounds__(512, 2) hybrid_fwd(Params p) {
    extern __shared__ __attribute__((aligned(16))) unsigned char smem[];
    cg::grid_group grid = cg::this_grid();
    LAS unsigned char* lds = (LAS unsigned char*)smem;
    const int bid = blockIdx.x, G = gridDim.x;
    phase_prep0(p, smem);
    constexpr int NOPS = 17;
#pragma clang loop unroll(disable)
    for (int step = 0; step < 2 * NOPS; ++step) {
        const int layer = step / NOPS, s = step - layer * NOPS;
        int op, kind = 0;
        switch (s) {
        case 0: op = OP_P1; break;
        case 2: op = OP_GEMM; kind = K_IN; break;
        case 3: case 4: op = OP_NOP; break;
        case 6: op = OP_GEMM; kind = K_FNA; break;
        case 7: op = OP_NA; break;
        case 8: op = OP_HYENA; break;
        case 10: op = OP_GEMM; kind = K_FNB; break;
        case 11: op = OP_TRANS; break;
        case 13: op = OP_GEMM; kind = K_BR; break;
        case 15: op = OP_GEMM; kind = K_OUT; break;
        default: op = OP_SYNC; break;
        }
        if (op == OP_NOP) { }
        else if (op == OP_SYNC) { grid.sync(); }
        else if (op == OP_GEMM) {
            Gemm g; g.base = (const char*)p.ws; g.jumpA = 0; g.jumpB = 0;
            switch (kind) {
            case K_FNA: g.lda = 384; g.ldb = FN1P; g.nt = 6; g.ksplit = 3; g.jumpB = (long)((size_t)1024 * PROWS * 2) - 384l; break;
            case K_FNB: g.lda = 256; g.ldb = 256; g.nt = 4; g.ksplit = 4; break;
            case K_BR:  g.lda = 1024; g.ldb = 1024; g.nt = 16; g.ksplit = 16; break;
            default:    g.lda = DM; g.ldb = DM; g.nt = 32; g.ksplit = 32; break;
            }
            SchedAny S{kind, G, bid}; EpiAny E{kind, p.ws};
            pg8::gemm_phase(lds, g, S, E);
            if (kind == K_BR) mini_branch(p); else if (kind == K_OUT) mini_out(p);
        }
        else if (op == OP_P1) { phase_p1(p, layer, smem); }
        else if (op == OP_NA) { for (int u = bid; u < 4096; u += G) na_unit(p, layer, u >> 4, u & 15, smem); if (bid == G - 1) na_meta_unit(p, layer); }
        else if (op == OP_HYENA) { for (int ch = bid; ch < 1024; ch += G) hyena_unit(p, layer, ch, smem, (unsigned char*)p.out + (size_t)bid * HS_STRIDE); }
        else { for (int u = bid; u < 16 * 257; u += G) transpose_unit(p, u & 15, u >> 4, smem); }
    }
    phase_final(p);
}

extern "C" void kernel_launch(void* const* d_in, const int* in_sizes, int n_in, void* d_out, int out_size, void* d_ws, size_t ws_size, hipStream_t stream) {
    static int grid_blocks = 0;
    if (grid_blocks == 0) {
        if (n_in != 23 || ws_size < WS_END) { fprintf(stderr, "kernel_launch: need 23 inputs and %zu bytes of workspace (got %d, %zu)\n", (size_t)WS_END, n_in, ws_size); grid_blocks = -1; return; }
        int dev = 0, cus = 0, per_cu = 0;
        hipGetDevice(&dev); hipDeviceGetAttribute(&cus, hipDeviceAttributeMultiprocessorCount, dev);
        if (hipFuncSetAttribute((const void*)hybrid_fwd, hipFuncAttributeMaxDynamicSharedMemorySize, LDS_BYTES) != hipSuccess) { fprintf(stderr, "kernel_launch: hipFuncSetAttribute failed\n"); grid_blocks = -1; return; }
        hipOccupancyMaxActiveBlocksPerMultiprocessor(&per_cu, (const void*)hybrid_fwd, NTHREADS, LDS_BYTES);
        if (per_cu < 1) per_cu = 1;
        grid_blocks = cus * per_cu;
        if (grid_blocks > 256) grid_blocks = 256;
    }
    if (grid_blocks < 0) return;
    Params p{};
    const float** f = (const float**)&p;
    for (int i = 0; i < 23; ++i) f[i] = (const float*)d_in[i];
    p.out = (float*)d_out; p.ws = (unsigned char*)d_ws;
    void* args[] = {&p};
    hipError_t e = hipLaunchCooperativeKernel((const void*)hybrid_fwd, dim3(grid_blocks), dim3(NTHREADS), args, LDS_BYTES, stream);
    if (e != hipSuccess) fprintf(stderr, "cooperative launch failed: %s (grid %d)\n", hipGetErrorString(e), grid_blocks);
}
```

```cpp
#include <hip/hip_runtime.h>
#include <hip/hip_cooperative_groups.h>
#include <cstdio>
namespace cg = cooperative_groups;

#define LAS __attribute__((address_space(3)))
typedef unsigned short bf16_t;
typedef short bf16x8 __attribute__((ext_vector_type(8)));
typedef float f32x4 __attribute__((ext_vector_type(4)));
typedef unsigned u32x4 __attribute__((ext_vector_type(4)));
typedef unsigned u32x2 __attribute__((ext_vector_type(2)));

constexpr int L_TOK = 16400, LP = 16640, DM = 2048, NIN = 16384, NMETA = 16, NMAIN = 16384;
constexpr int FN1 = 164, FN2 = 100, FN1P = 192, PROWS = FN2 * FN1P;
constexpr int NTHREADS = 512, LDS_BYTES = 155648;

constexpr size_t SZ_H = (size_t)LP * DM * 4, SZ_XN = (size_t)LP * DM * 2, SZ_XNP = (size_t)PROWS * DM * 2;
constexpr size_t OFF_H = 0;
constexpr size_t OFF_XN = OFF_H + SZ_H;
constexpr size_t OFF_XNP = OFF_XN + SZ_XN;
constexpr size_t OFF_A1 = OFF_XN;
constexpr size_t SZ_A1 = (size_t)FN1 * 1024 * 2 * 128 * 2;
constexpr size_t OFF_HYOUT = OFF_A1 + SZ_A1;
constexpr size_t SZ_HYOUT = (size_t)1024 * LP * 2;
static_assert(OFF_HYOUT + SZ_HYOUT <= OFF_XNP + SZ_XNP, "alias overflow");
constexpr size_t OFF_WT = OFF_XNP + SZ_XNP;
constexpr size_t OFF_WEFF = OFF_WT + (size_t)NIN * DM * 2;
constexpr size_t OFF_WA = OFF_WEFF + (size_t)2048 * 2048 * 2;
constexpr size_t SZ_WBR = (size_t)2048 * 1024 * 2;
constexpr size_t OFF_WO = OFF_WA + 3 * SZ_WBR;
constexpr size_t OFF_HYIN = OFF_WO + (size_t)2048 * 2048 * 2;
constexpr size_t OFF_GATE = OFF_HYIN + (size_t)3072 * LP * 2;
constexpr size_t SZ_GATE = (size_t)LP * 1024 * 2;
constexpr size_t OFF_QKV = OFF_GATE + 3 * SZ_GATE;
constexpr size_t OFF_MERGE = OFF_QKV + (size_t)LP * 3072 * 2;
constexpr size_t OFF_ZT = OFF_MERGE + (size_t)LP * 6144 * 2;
constexpr size_t SZ_ZT = (size_t)2048 * PROWS * 2;
constexpr size_t OFF_M = OFF_ZT;
static_assert(SZ_XN <= SZ_ZT, "alias overflow");
constexpr size_t OFF_FA = OFF_ZT + SZ_ZT;
constexpr size_t OFF_FB = OFF_FA + (size_t)512 * 384 * 2;
constexpr size_t OFF_H3 = OFF_FB + (size_t)FN1 * 256 * 256 * 2;
constexpr size_t WS_END = OFF_H3 + (size_t)2 * L_TOK * 64 * 4;
constexpr size_t HS_HEO = 0, HS_CORR = 131328, HS_Z2 = HS_CORR + 65536, HS_G2F = HS_Z2 + 65792, HS_G2B = HS_G2F + 65792, HS_STRIDE = HS_G2B + 65792;
static_assert(HS_STRIDE * 256 <= (size_t)NMAIN * DM * 4, "scratch overflow");

struct Params {
    const float* x; const float* meta; const float* norm_g; const float* w_in; const float* conv_w; const float* conv_b;
    const float* f_w1; const float* f_b1; const float* f_w2; const float* f_b2; const float* f_w3; const float* f_b3; const float* f_w4;
    const float* f_freq; const float* decay; const float* skip; const float* rpb; const float* meta_bias;
    const float* w_a; const float* w_b; const float* w_c; const float* w_out; const float* final_g;
    float* out; unsigned char* ws;
};

__device__ __forceinline__ int opaque_tid() { int t = threadIdx.x; asm volatile("" : "+v"(t)); return t; }
__device__ __forceinline__ float bf2f(bf16_t b) { return __uint_as_float(((unsigned)b) << 16); }
__device__ __forceinline__ bf16_t f2bf(float f) { unsigned u = __float_as_uint(f); u += 0x7FFFu + ((u >> 16) & 1u); return (bf16_t)(u >> 16); }
__device__ __forceinline__ unsigned cvt_pk_bf16(float lo, float hi) { unsigned r; asm volatile("v_cvt_pk_bf16_f32 %0, %1, %2" : "=v"(r) : "v"(lo), "v"(hi)); return r; }
__device__ __forceinline__ float lo_bf(unsigned u) { return __uint_as_float(u << 16); }
__device__ __forceinline__ float hi_bf(unsigned u) { return __uint_as_float(u & 0xffff0000u); }
__device__ __forceinline__ float silu_f(float v) { return v * __builtin_amdgcn_rcpf(1.0f + __expf(-v)); }
__device__ __forceinline__ float sigm_f(float v) { return __builtin_amdgcn_rcpf(1.0f + __expf(-v)); }
__device__ __forceinline__ float wave_sum(float v) {
#pragma unroll
    for (int o = 32; o >= 1; o >>= 1) v += __shfl_xor(v, o);
    return v;
}

namespace pg8 {
constexpr int BM = 256, BK = 64, HALF = 128, HTB = HALF * BK * 2, STAGE_BYTES = 8 * HTB;
__device__ __forceinline__ int lds_byte(int r, int c) { const int st = (r >> 4) * 2 + (c >> 5), rr = r & 15, cc = c & 31, ob = rr * 64 + cc * 2; return st * 1024 + (ob ^ (((ob >> 9) & 1) << 5)); }
__device__ __forceinline__ void stage_rc(int b, int& R, int& C) { const int st = b / 1024, sb = b % 1024, swz = sb ^ (((sb >> 9) & 1) << 5); R = (st >> 1) * 16 + swz / 64; C = (st & 1) * 32 + (swz % 64) / 2; }
__device__ __forceinline__ int perm32(int rho) { const int n = rho >> 4, i = rho & 15; return 8 * (i >> 2) + 4 * n + (i & 3); }

struct Unit { int pm, pn, aux; size_t offA, offB; };
struct Gemm { const char* base; int lda, ldb, nt, ksplit; long jumpA, jumpB; };

__device__ __forceinline__ void tile_map(int wgid, int nM, int nN, int& pm, int& pn) {
    const int nwg = nM * nN;
    { const int q = nwg / 8, r = nwg % 8, xcd = wgid % 8, off = wgid / 8; wgid = (xcd < r ? xcd * (q + 1) : r * (q + 1) + (xcd - r) * q) + off; }
    const int nig = 8 * nN, gid = wgid / nig, fm = gid * 8, gsz = (nM - fm) < 8 ? (nM - fm) : 8;
    pm = fm + ((wgid % nig) % gsz); pn = (wgid % nig) / gsz;
}

template <class Epi, class Sched>
__device__ __forceinline__ void gemm_phase(LAS unsigned char* lds, const Gemm g, const Sched& S, const Epi& E) {
    const int tid = opaque_tid(), wid = __builtin_amdgcn_readfirstlane(tid >> 6), lane = tid & 63, wr = wid >> 2, wc = wid & 3, fr = lane & 15, fq = lane >> 4;
    const int nt = g.nt;
    unsigned voffA[2], voffB[2];
#pragma unroll
    for (int i = 0; i < 2; ++i) { int R, C; stage_rc(tid * 16 + i * 8192, R, C); const int Rb = (R & ~31) + perm32(R & 31);
        voffA[i] = (unsigned)(R * g.lda + C) * 2u; voffB[i] = (unsigned)(Rb * g.ldb + C) * 2u; }
    const size_t kstep = (size_t)(BK * 2);
    const size_t hstepA = (size_t)HALF * g.lda * 2, hstepB = (size_t)HALF * g.ldb * 2;
    const unsigned ldsw = (unsigned)wid * 1024u;
    const int aoff = lds_byte(wr * 64 + fr, fq * 8), boff = lds_byte(wc * 32 + fr, fq * 8);
#define PG8_KA(p, t) ((p) + (size_t)(t) * kstep + ((t) >= g.ksplit ? g.jumpA : 0l))
#define PG8_KB(p, t) ((p) + (size_t)(t) * kstep + ((t) >= g.ksplit ? g.jumpB : 0l))
#define PG8_SA(b, h) (((b) * 2 + (h)) * HTB)
#define PG8_SB(b, h) ((4 + (b) * 2 + (h)) * HTB)
#define PG8_STAGE(bufoff, gbase, voff) do { _Pragma("unroll") for (int _i = 0; _i < 2; ++_i) \
        __builtin_amdgcn_global_load_lds((const unsigned*)((const char*)(gbase) + (voff)[_i]), (LAS unsigned*)(lds + (bufoff) + ldsw + _i * 8192), 16, 0, 0); } while (0)
#define PG8_LDA(dst, b, h) do { _Pragma("unroll") for (int m = 0; m < 4; ++m) _Pragma("unroll") for (int k = 0; k < 2; ++k) dst[m][k] = *(const LAS bf16x8*)(lds + PG8_SA(b, h) + aoff + m * 2048 + k * 1024); } while (0)
#define PG8_LDB(dst, b, h) do { _Pragma("unroll") for (int n = 0; n < 2; ++n) _Pragma("unroll") for (int k = 0; k < 2; ++k) dst[n][k] = *(const LAS bf16x8*)(lds + PG8_SB(b, h) + boff + n * 2048 + k * 1024); } while (0)
#define PG8_MMA(ai, bj, At, Bt) do { __builtin_amdgcn_s_setprio(1); _Pragma("unroll") for (int m = 0; m < 4; ++m) _Pragma("unroll") for (int n = 0; n < 2; ++n) _Pragma("unroll") for (int k = 0; k < 2; ++k) \
        acc[ai][bj][m][n] = __builtin_amdgcn_mfma_f32_16x16x32_bf16(Bt[n][k], At[m][k], acc[ai][bj][m][n], 0, 0, 0); __builtin_amdgcn_s_setprio(0); } while (0)
#define PG8_WAIT_V(n) asm volatile("s_waitcnt vmcnt(" #n ")" ::: "memory")
#define PG8_WAIT_L(n) asm volatile("s_waitcnt lgkmcnt(" #n ")" ::: "memory")
#define PG8_BAR __builtin_amdgcn_s_barrier()
#define PG8_SCHED __builtin_amdgcn_sched_barrier(0)
    Unit cur, nxt; int ui = 0;
    if (!S.next(0, cur)) return;
    f32x4 acc[2][2][4][2];
#pragma unroll
    for (int a = 0; a < 2; ++a)
#pragma unroll
        for (int b = 0; b < 2; ++b)
#pragma unroll
            for (int m = 0; m < 4; ++m)
#pragma unroll
                for (int n = 0; n < 2; ++n) acc[a][b][m][n] = (f32x4){0.f, 0.f, 0.f, 0.f};
    bf16x8 At[4][2], B0[2][2], B1[2][2];
    const char* cA = g.base + cur.offA; const char* cB = g.base + cur.offB;
    PG8_STAGE(PG8_SB(0, 0), cB, voffB); PG8_STAGE(PG8_SA(0, 0), cA, voffA); PG8_STAGE(PG8_SB(0, 1), cB + hstepB, voffB); PG8_STAGE(PG8_SA(0, 1), cA + hstepA, voffA);
    if (wr == 1) PG8_BAR;
    PG8_WAIT_V(4); PG8_BAR;
    PG8_STAGE(PG8_SB(1, 0), PG8_KB(cB, 1), voffB); PG8_STAGE(PG8_SA(1, 0), PG8_KA(cA, 1), voffA); PG8_STAGE(PG8_SB(1, 1), PG8_KB(cB, 1) + hstepB, voffB);
    PG8_WAIT_V(6); PG8_BAR;
    for (;;) {
        const bool has_next = S.next(ui + 1, nxt);
        const char* nA = has_next ? g.base + nxt.offA : cA; const char* nB = has_next ? g.base + nxt.offB : cB;
        for (int t = 0; t < nt; t += 2) {
            const bool last = (t == nt - 2);
            const char* a1 = PG8_KA(cA, t + 1);
            const char* a2 = last ? nA : PG8_KA(cA, t + 2); const char* b2 = last ? nB : PG8_KB(cB, t + 2);
            const char* a3 = last ? PG8_KA(nA, 1) : PG8_KA(cA, t + 3); const char* b3 = last ? PG8_KB(nB, 1) : PG8_KB(cB, t + 3);
            PG8_LDB(B0, 0, 0); PG8_SCHED; PG8_LDA(At, 0, 0); PG8_STAGE(PG8_SA(1, 1), a1 + hstepA, voffA);
            PG8_WAIT_L(8); PG8_BAR; PG8_WAIT_L(0); PG8_MMA(0, 0, At, B0); PG8_BAR; PG8_SCHED;
            PG8_LDB(B1, 0, 1); PG8_STAGE(PG8_SB(0, 0), b2, voffB);
            PG8_BAR; PG8_WAIT_L(0); PG8_MMA(0, 1, At, B1); PG8_BAR;
            PG8_LDA(At, 0, 1); PG8_STAGE(PG8_SA(0, 0), a2, voffA);
            PG8_BAR; PG8_WAIT_L(0); PG8_MMA(1, 0, At, B0); PG8_BAR; PG8_SCHED;
            PG8_STAGE(PG8_SB(0, 1), b2 + hstepB, voffB);
            PG8_WAIT_V(6); PG8_BAR; PG8_MMA(1, 1, At, B1); PG8_BAR;
            PG8_LDB(B0, 1, 0); PG8_SCHED; PG8_LDA(At, 1, 0); PG8_STAGE(PG8_SA(0, 1), a2 + hstepA, voffA);
            PG8_WAIT_L(8); PG8_BAR; PG8_WAIT_L(0); PG8_MMA(0, 0, At, B0); PG8_BAR; PG8_SCHED;
            PG8_LDB(B1, 1, 1); PG8_STAGE(PG8_SB(1, 0), b3, voffB);
            PG8_BAR; PG8_WAIT_L(0); PG8_MMA(0, 1, At, B1); PG8_BAR;
            PG8_LDA(At, 1, 1); PG8_STAGE(PG8_SA(1, 0), a3, voffA);
            PG8_BAR; PG8_WAIT_L(0); PG8_MMA(1, 0, At, B0); PG8_BAR; PG8_SCHED;
            PG8_STAGE(PG8_SB(1, 1), b3 + hstepB, voffB);
            PG8_WAIT_V(6); PG8_BAR; PG8_MMA(1, 1, At, B1); PG8_BAR;
        }
        E(acc, cur, wr, wc, fr, fq);
        if (!has_next) break;
#pragma unroll
        for (int a = 0; a < 2; ++a)
#pragma unroll
            for (int b = 0; b < 2; ++b)
#pragma unroll
                for (int m = 0; m < 4; ++m)
#pragma unroll
                    for (int n = 0; n < 2; ++n) acc[a][b][m][n] = (f32x4){0.f, 0.f, 0.f, 0.f};
        cur = nxt; cA = nA; cB = nB; ++ui;
    }
    PG8_WAIT_V(0);
    if (wr == 0) PG8_BAR;
    PG8_BAR;
#undef PG8_KA
#undef PG8_KB
#undef PG8_SA
#undef PG8_SB
#undef PG8_STAGE
#undef PG8_LDA
#undef PG8_LDB
#undef PG8_MMA
#undef PG8_WAIT_V
#undef PG8_WAIT_L
#undef PG8_BAR
#undef PG8_SCHED
}
}
using pg8::Unit; using pg8::Gemm;
#define ACC_T const f32x4 (&acc)[2][2][4][2]

enum { K_TOK = 0, K_HYIN = 1, K_F0 = 2, K_FNA = 3, K_FNB = 4, K_BR = 5, K_OUT = 6, K_IN = 7 };
struct SchedAny {
    int kind, G, c;
    __device__ __forceinline__ bool next(int i, Unit& u) const {
        const long Lx = (long)i * G + c;
        switch (kind) {
        case K_IN: {
            if (Lx < 3120) { int pn; pg8::tile_map((int)Lx, 65, 48, u.pm, pn); u.pn = pn < 4 ? 12 + pn : 16 + pn; u.aux = K_TOK;
                u.offA = OFF_XN + (size_t)u.pm * 256 * DM * 2; u.offB = OFF_WT + (size_t)u.pn * 256 * DM * 2; return true; }
            if (Lx < 3900) { pg8::tile_map((int)Lx - 3120, 12, 65, u.pm, u.pn); u.aux = K_HYIN;
                u.offA = OFF_WT + (size_t)u.pm * 256 * DM * 2; u.offB = OFF_XN + (size_t)u.pn * 256 * DM * 2; return true; }
            if (Lx < 4500) { pg8::tile_map((int)Lx - 3900, 8, 75, u.pm, u.pn); u.aux = K_F0;
                u.offA = OFF_WEFF + (size_t)u.pm * 256 * DM * 2; u.offB = OFF_XNP + (size_t)u.pn * 256 * DM * 2; return true; }
            return false; }
        case K_TOK: {
            if (Lx >= 65l * 48) return false; int pn; pg8::tile_map((int)Lx, 65, 48, u.pm, pn); u.pn = pn < 4 ? 12 + pn : 16 + pn; u.aux = 0;
            u.offA = OFF_XN + (size_t)u.pm * 256 * DM * 2; u.offB = OFF_WT + (size_t)u.pn * 256 * DM * 2; return true; }
        case K_HYIN: {
            if (Lx >= 12l * 65) return false; pg8::tile_map((int)Lx, 12, 65, u.pm, u.pn); u.aux = 0;
            u.offA = OFF_WT + (size_t)u.pm * 256 * DM * 2; u.offB = OFF_XN + (size_t)u.pn * 256 * DM * 2; return true; }
        case K_F0: {
            if (Lx >= 8l * 75) return false; pg8::tile_map((int)Lx, 8, 75, u.pm, u.pn); u.aux = 0;
            u.offA = OFF_WEFF + (size_t)u.pm * 256 * DM * 2; u.offB = OFF_XNP + (size_t)u.pn * 256 * DM * 2; return true; }
        case K_FNA: {
            if (Lx >= 2l * 400) return false; pg8::tile_map((int)Lx, 2, 400, u.pm, u.pn); u.aux = 0;
            u.offA = OFF_FA + (size_t)u.pm * 256 * 384 * 2; u.offB = OFF_ZT + (size_t)u.pn * 256 * FN1P * 2; return true; }
        case K_FNB: {
            if (Lx >= 164l * 4) return false; u.aux = (int)(Lx >> 2); u.pm = 0; u.pn = (int)(Lx & 3);
            u.offA = OFF_FB + (size_t)u.aux * 256 * 256 * 2; u.offB = OFF_A1 + (size_t)u.aux * 1024 * 256 * 2 + (size_t)u.pn * 256 * 256 * 2; return true; }
        case K_BR: {
            const int T = (i / 3) * G + c; if (T >= 64 * 8) return false; const int br = i % 3; pg8::tile_map(T, 64, 8, u.pm, u.pn); u.aux = br;
            u.offA = OFF_GATE + (size_t)br * SZ_GATE + (size_t)u.pm * 256 * 1024 * 2; u.offB = OFF_WA + (size_t)br * SZ_WBR + (size_t)u.pn * 256 * 1024 * 2; return true; }
        default: {
            if (Lx >= 64l * 8) return false; pg8::tile_map((int)Lx, 64, 8, u.pm, u.pn); u.aux = 0;
            u.offA = OFF_M + (size_t)u.pm * 256 * DM * 2; u.offB = OFF_WO + (size_t)u.pn * 256 * DM * 2; return true; }
        }
    }
};
#define ROWFENCE asm volatile("" ::: "memory")
#define HARDFENCE do { asm volatile("" ::: "memory"); __builtin_amdgcn_sched_barrier(0); } while (0)
struct EpiAny {
    int kind; unsigned char* ws; int layer; const float* xin; const float* metain;
    __device__ __forceinline__ void operator()(ACC_T, const Unit& u, int wr, int wc, int fr, int fq) const {
        const int rl0 = wr * 64 + fr, cl0 = wc * 32 + 8 * fq;
        const int ek = kind == K_IN ? u.aux : kind;
        if (ek == K_TOK) {
            const int t = u.pn; unsigned char* dst; unsigned ld; int c0, act;
            if (t < 16)      { dst = ws + OFF_GATE;               ld = 1024; c0 = (t - 12) * 256; act = 1; }
            else if (t < 24) { dst = ws + OFF_GATE + SZ_GATE;     ld = 1024; c0 = (t - 20) * 256; act = 1; }
            else if (t < 36) { dst = ws + OFF_QKV;                ld = 3072; c0 = (t - 24) * 256; act = 0; }
            else if (t < 40) { dst = ws + OFF_GATE + 2 * SZ_GATE; ld = 1024; c0 = (t - 36) * 256; act = 1; }
            else             { dst = ws + OFF_MERGE;              ld = 6144; c0 = (t - 40) * 256; act = 2; }
#pragma unroll
            for (int ai = 0; ai < 2; ++ai)
#pragma unroll
                for (int m = 0; m < 4; ++m) { const unsigned row = (unsigned)(u.pm * 256 + ai * 128 + m * 16 + rl0);
#pragma unroll
                    for (int bj = 0; bj < 2; ++bj) { const unsigned off = (row * ld + (unsigned)(c0 + bj * 128 + cl0)) * 2u; f32x4 v0 = acc[ai][bj][m][0], v1 = acc[ai][bj][m][1];
                        if (act == 1) {
#pragma unroll
                            for (int j = 0; j < 4; ++j) { v0[j] = silu_f(v0[j]); v1[j] = silu_f(v1[j]); } }
                        else if (act == 2) {
#pragma unroll
                            for (int j = 0; j < 4; ++j) { v0[j] = sigm_f(v0[j]); v1[j] = sigm_f(v1[j]); } }
                        u32x4 w; w.x = cvt_pk_bf16(v0[0], v0[1]); w.y = cvt_pk_bf16(v0[2], v0[3]); w.z = cvt_pk_bf16(v1[0], v1[1]); w.w = cvt_pk_bf16(v1[2], v1[3]);
                        *(u32x4*)(dst + off) = w; }
                    ROWFENCE; }
        } else if (ek == K_HYIN || ek == K_F0) {
            unsigned char* dst = ws + (ek == K_HYIN ? OFF_HYIN : OFF_ZT); const unsigned ld = ek == K_HYIN ? LP : PROWS;
#pragma unroll
            for (int ai = 0; ai < 2; ++ai)
#pragma unroll
                for (int m = 0; m < 4; ++m) { const unsigned row = (unsigned)(u.pm * 256 + ai * 128 + m * 16 + rl0);
#pragma unroll
                    for (int bj = 0; bj < 2; ++bj) { const unsigned off = (row * ld + (unsigned)(u.pn * 256 + bj * 128 + cl0)) * 2u; const f32x4 v0 = acc[ai][bj][m][0], v1 = acc[ai][bj][m][1];
                        u32x4 w; w.x = cvt_pk_bf16(v0[0], v0[1]); w.y = cvt_pk_bf16(v0[2], v0[3]); w.z = cvt_pk_bf16(v1[0], v1[1]); w.w = cvt_pk_bf16(v1[2], v1[3]);
                        *(u32x4*)(dst + off) = w; }
                    ROWFENCE; }
        } else if (ek == K_FNA) {
            unsigned char* dst = ws + OFF_A1;
#pragma unroll
            for (int ai = 0; ai < 2; ++ai)
#pragma unroll
                for (int m = 0; m < 4; ++m) { const int k1 = ai * 128 + m * 16 + rl0;
                    if (k1 < FN1) {
#pragma unroll
                        for (int bj = 0; bj < 2; ++bj)
#pragma unroll
                            for (int n = 0; n < 2; ++n) { const int col = u.pn * 256 + bj * 128 + cl0 + 4 * n; const int ch = col / FN2, l2 = col - ch * FN2; const f32x4 v = acc[ai][bj][m][n];
                                u32x2 w; w.x = cvt_pk_bf16(v[0], v[1]); w.y = cvt_pk_bf16(v[2], v[3]);
                                *(u32x2*)(dst + ((unsigned)((k1 * 1024 + ch) * 2 + u.pm) * 128u + (unsigned)l2) * 2u) = w; } }
                    ROWFENCE; }
        } else if (ek == K_FNB) {
            unsigned char* dst = ws + OFF_GATE + SZ_GATE; const float scale = 1.0f / sqrtf((float)L_TOK * 256.0f);
#pragma unroll
            for (int ai = 0; ai < 2; ++ai)
#pragma unroll
                for (int m = 0; m < 4; ++m) { const int k2 = ai * 128 + m * 16 + rl0;
                    if (k2 < FN2) { const unsigned row = (unsigned)(u.aux + FN1 * k2);
#pragma unroll
                        for (int bj = 0; bj < 2; ++bj) { const unsigned off = (row * 1024u + (unsigned)(u.pn * 256 + bj * 128 + cl0)) * 2u; const u32x4 g = *(const u32x4*)(dst + off);
                            const f32x4 v0 = acc[ai][bj][m][0] * scale, v1 = acc[ai][bj][m][1] * scale;
                            u32x4 w; w.x = cvt_pk_bf16(v0[0] * lo_bf(g.x), v0[1] * hi_bf(g.x)); w.y = cvt_pk_bf16(v0[2] * lo_bf(g.y), v0[3] * hi_bf(g.y));
                            w.z = cvt_pk_bf16(v1[0] * lo_bf(g.z), v1[1] * hi_bf(g.z)); w.w = cvt_pk_bf16(v1[2] * lo_bf(g.w), v1[3] * hi_bf(g.w));
                            *(u32x4*)(dst + off) = w; } }
                    ROWFENCE; }
        } else if (ek == K_BR) {
            unsigned char* dst = ws + OFF_M; const unsigned char* mg = ws + OFF_MERGE; const int br = u.aux;
#pragma unroll
            for (int ai = 0; ai < 2; ++ai) { u32x4 gq[4][2], oq[4][2];
#pragma unroll
                for (int m = 0; m < 4; ++m) { const unsigned row = (unsigned)(u.pm * 256 + ai * 128 + m * 16 + rl0);
#pragma unroll
                    for (int bj = 0; bj < 2; ++bj) { const unsigned col = (unsigned)(u.pn * 256 + bj * 128 + cl0);
                        gq[m][bj] = *(const u32x4*)(mg + (row * 6144u + (unsigned)br * 2048u + col) * 2u);
                        if (br > 0) oq[m][bj] = *(const u32x4*)(dst + (row * (unsigned)DM + col) * 2u); else oq[m][bj] = (u32x4){0u, 0u, 0u, 0u}; } }
#pragma unroll
                for (int m = 0; m < 4; ++m) { const unsigned row = (unsigned)(u.pm * 256 + ai * 128 + m * 16 + rl0);
#pragma unroll
                    for (int bj = 0; bj < 2; ++bj) { const unsigned col = (unsigned)(u.pn * 256 + bj * 128 + cl0); const unsigned off = (row * (unsigned)DM + col) * 2u;
                        const u32x4 g = gq[m][bj], o = oq[m][bj]; const f32x4 v0 = acc[ai][bj][m][0], v1 = acc[ai][bj][m][1];
                        const float r0 = v0[0] * lo_bf(g.x) + lo_bf(o.x), r1 = v0[1] * hi_bf(g.x) + hi_bf(o.x), r2 = v0[2] * lo_bf(g.y) + lo_bf(o.y), r3 = v0[3] * hi_bf(g.y) + hi_bf(o.y);
                        const float r4 = v1[0] * lo_bf(g.z) + lo_bf(o.z), r5 = v1[1] * hi_bf(g.z) + hi_bf(o.z), r6 = v1[2] * lo_bf(g.w) + lo_bf(o.w), r7 = v1[3] * hi_bf(g.w) + hi_bf(o.w);
                        u32x4 w; w.x = cvt_pk_bf16(r0, r1); w.y = cvt_pk_bf16(r2, r3); w.z = cvt_pk_bf16(r4, r5); w.w = cvt_pk_bf16(r6, r7);
                        *(u32x4*)(dst + off) = w; } }
                ROWFENCE; }
        } else {
            unsigned char* dst = ws + OFF_H;
#pragma unroll
            for (int ai = 0; ai < 2; ++ai) { f32x4 oq[4][2][2];
#pragma unroll
                for (int m = 0; m < 4; ++m) { const unsigned row = (unsigned)(u.pm * 256 + ai * 128 + m * 16 + rl0);
                    const float* srow = layer == 0 ? (row < (unsigned)NMETA ? metain + (size_t)row * DM : xin + (size_t)(row - NMETA) * DM) : (const float*)(dst + (size_t)row * DM * 4);
#pragma unroll
                    for (int bj = 0; bj < 2; ++bj) { const unsigned col = (unsigned)(u.pn * 256 + bj * 128 + cl0); oq[m][bj][0] = *(const f32x4*)(srow + col); oq[m][bj][1] = *(const f32x4*)(srow + col + 4); } }
#pragma unroll
                for (int m = 0; m < 4; ++m) { const unsigned row = (unsigned)(u.pm * 256 + ai * 128 + m * 16 + rl0);
#pragma unroll
                    for (int bj = 0; bj < 2; ++bj) { const unsigned off = (row * (unsigned)DM + (unsigned)(u.pn * 256 + bj * 128 + cl0)) * 4u;
                        *(f32x4*)(dst + off) = oq[m][bj][0] + acc[ai][bj][m][0]; *(f32x4*)(dst + off + 16) = oq[m][bj][1] + acc[ai][bj][m][1]; } }
                ROWFENCE; }
        }
    }
};

__device__ void phase_prep0(const Params& p, unsigned char* smem) {
    const int tid = opaque_tid(), bid = blockIdx.x, G = gridDim.x;
    const size_t gtid = (size_t)bid * NTHREADS + tid, gstride = (size_t)G * NTHREADS;
    { bf16_t* fa = (bf16_t*)(p.ws + OFF_FA);
      for (size_t i = gtid; i < (size_t)512 * 384; i += gstride) { const int row = (int)(i / 384), col = (int)(i % 384); const int po = row >> 8, k1 = row & 255, pi = col / 192, l1 = col % 192; float v = 0.f;
          if (k1 < FN1 && l1 < FN1) { const int r = (k1 * l1) % FN1; const float a = 2.0f * (float)r / (float)FN1; const float cs = cospif(a), sn = sinpif(a);
              v = (po == 0) ? (pi == 0 ? cs : sn) : (pi == 0 ? -sn : cs); }
          fa[i] = f2bf(v); } }
    { bf16_t* fb = (bf16_t*)(p.ws + OFF_FB);
      for (size_t i = gtid; i < (size_t)FN1 * 65536; i += gstride) { const int k1 = (int)(i >> 16), k2 = (int)((i >> 8) & 255), kk = (int)(i & 255), part = kk >> 7, l2 = kk & 127; float v = 0.f;
          if (k2 < FN2 && l2 < FN2) { const int lp = k1 + FN1 * k2; const int r = (l2 * lp) % L_TOK; const float a = 2.0f * (float)r / (float)L_TOK; v = part == 0 ? cospif(a) : sinpif(a); }
          fb[i] = f2bf(v); } }
    { float* w1s = (float*)smem;
      float* w2s = w1s + 33 * 64;
      float* w3s = w2s + 64 * 64;
      const int lane = tid & 63, wv = tid >> 6;
      for (int layer = 0; layer < 2; ++layer) {
          __syncthreads();
          for (int i = tid; i < 33 * 64; i += NTHREADS) w1s[i] = p.f_w1[layer * 33 * 64 + i];
          for (int i = tid; i < 64 * 64; i += NTHREADS) { w2s[i] = p.f_w2[layer * 4096 + i]; w3s[i] = p.f_w3[layer * 4096 + i]; }
          __syncthreads();
          const float b1 = p.f_b1[layer * 64 + lane], b2 = p.f_b2[layer * 64 + lane], b3 = p.f_b3[layer * 64 + lane], fr = p.f_freq[layer * 64 + lane];
          bf16_t* h3 = (bf16_t*)(p.ws + OFF_H3) + (size_t)layer * L_TOK * 64;
          for (int lag = bid * 8 + wv; lag < L_TOK; lag += G * 8) {
              const float tt = (float)lag / (float)(L_TOK - 1); const float w = 6.283185307179586f * (float)lag / (float)L_TOK;
              float z = 0.f;
              if (lane == 0) z = tt;
              else if (lane < 33) { const int j = (lane - 1) & 15; const float f = 1e-4f + (float)j * ((15.0f - 1e-4f) / 15.0f); const float a = f * w; z = lane < 17 ? cosf(a) : -sinf(a); }
              float a1 = b1;
#pragma unroll 3
              for (int i = 0; i < 33; ++i) a1 += __shfl(z, i) * w1s[i * 64 + lane];
              const float h1 = sinf(fr * a1);
              float a2 = b2;
#pragma unroll 8
              for (int i = 0; i < 64; ++i) a2 += __shfl(h1, i) * w2s[i * 64 + lane];
              const float h2 = sinf(fr * a2);
              float a3 = b3;
#pragma unroll 8
              for (int i = 0; i < 64; ++i) a3 += __shfl(h2, i) * w3s[i * 64 + lane];
              h3[(size_t)lag * 64 + lane] = f2bf(sinf(fr * a3));
          }
      }
      __syncthreads(); }
}

__device__ __forceinline__ void convert_tile(const float* src, int K, int N, bf16_t* dst, int kt, int nt_, float* tile  ) {
    const int tid = opaque_tid();
    __syncthreads();
#pragma unroll
    for (int ps = 0; ps < 2; ++ps) { const int kl = ps * 32 + (tid >> 4), n4 = (tid & 15) * 4;
        const f32x4 v = *(const f32x4*)(src + (size_t)(kt * 64 + kl) * N + nt_ * 64 + n4);
        tile[kl * 65 + n4] = v[0]; tile[kl * 65 + n4 + 1] = v[1]; tile[kl * 65 + n4 + 2] = v[2]; tile[kl * 65 + n4 + 3] = v[3]; }
    __syncthreads();
    const int nl = tid >> 3, k8 = (tid & 7) * 8;
    u32x4 w; w.x = cvt_pk_bf16(tile[(k8 + 0) * 65 + nl], tile[(k8 + 1) * 65 + nl]); w.y = cvt_pk_bf16(tile[(k8 + 2) * 65 + nl], tile[(k8 + 3) * 65 + nl]);
    w.z = cvt_pk_bf16(tile[(k8 + 4) * 65 + nl], tile[(k8 + 5) * 65 + nl]); w.w = cvt_pk_bf16(tile[(k8 + 6) * 65 + nl], tile[(k8 + 7) * 65 + nl]);
    *(u32x4*)(dst + (size_t)(nt_ * 64 + nl) * K + kt * 64 + k8) = w;
}

__device__ void phase_p1(const Params& p, int layer, unsigned char* smem) {
    const int tid = opaque_tid(), bid = blockIdx.x, G = gridDim.x;
    float* tile = (float*)smem;
    { const float* win = p.w_in + (size_t)layer * DM * NIN;
      for (int t = bid; t < 32 * 256; t += G) convert_tile(win, DM, NIN, (bf16_t*)(p.ws + OFF_WT), t & 31, t >> 5, tile);
      for (int br = 0; br < 3; ++br) { const float* wsrc = (br == 0 ? p.w_a : br == 1 ? p.w_b : p.w_c) + (size_t)layer * 1024 * DM;
          for (int t = bid; t < 16 * 32; t += G) convert_tile(wsrc, 1024, DM, (bf16_t*)(p.ws + OFF_WA + br * SZ_WBR), t & 15, t >> 4, tile); }
      const float* wo = p.w_out + (size_t)layer * DM * DM;
      for (int t = bid; t < 32 * 32; t += G) convert_tile(wo, DM, DM, (bf16_t*)(p.ws + OFF_WO), t & 31, t >> 5, tile);
      __syncthreads(); }
    { float* tileT = (float*)smem;
      float* ctab = tileT + 256 * 32;
      float* stab = ctab + 256;
      const float* win = p.w_in + (size_t)layer * DM * NIN;
      for (int t = bid; t < 256; t += G) { const int g = t >> 6, k0 = (t & 63) * 32;
          __syncthreads();
          if (tid < 256) { const float a = 2.0f * (float)tid / 256.0f; ctab[tid] = cospif(a); stab[tid] = sinpif(a); }
#pragma unroll
          for (int ps = 0; ps < 4; ++ps) { const int idx = ps * NTHREADS + tid; const int kl = idx >> 6, c4 = (idx & 63) * 4;
              const f32x4 v = *(const f32x4*)(win + (size_t)(k0 + kl) * NIN + 4096 + g * 256 + c4);
              tileT[(c4 + 0) * 32 + kl] = v[0]; tileT[(c4 + 1) * 32 + kl] = v[1]; tileT[(c4 + 2) * 32 + kl] = v[2]; tileT[(c4 + 3) * 32 + kl] = v[3]; }
          __syncthreads();
          const int cp = tid & 255, part = tid >> 8;
          float acc[32];
#pragma unroll
          for (int k = 0; k < 32; ++k) acc[k] = 0.f;
          for (int c = 0; c < 256; ++c) { const int r = (c * cp) & 255; const float tw = part == 0 ? ctab[r] : -stab[r];
#pragma unroll
              for (int k4 = 0; k4 < 8; ++k4) { const f32x4 v = *(const f32x4*)(tileT + c * 32 + k4 * 4); acc[k4 * 4 + 0] += v[0] * tw; acc[k4 * 4 + 1] += v[1] * tw; acc[k4 * 4 + 2] += v[2] * tw; acc[k4 * 4 + 3] += v[3] * tw; } }
          bf16_t* dst = (bf16_t*)(p.ws + OFF_WEFF) + (size_t)(part * 1024 + g * 256 + cp) * DM + k0;
#pragma unroll
          for (int k8 = 0; k8 < 4; ++k8) { u32x4 w; w.x = cvt_pk_bf16(acc[k8 * 8 + 0], acc[k8 * 8 + 1]); w.y = cvt_pk_bf16(acc[k8 * 8 + 2], acc[k8 * 8 + 3]); w.z = cvt_pk_bf16(acc[k8 * 8 + 4], acc[k8 * 8 + 5]); w.w = cvt_pk_bf16(acc[k8 * 8 + 6], acc[k8 * 8 + 7]);
              *(u32x4*)(dst + k8 * 8) = w; } }
      __syncthreads(); }
    { const int lane = tid & 63, wv = tid >> 6; const float* h = (const float*)(p.ws + OFF_H); const float* gam = p.norm_g + layer * DM;
      bf16_t* xn = (bf16_t*)(p.ws + OFF_XN); bf16_t* xnp = (bf16_t*)(p.ws + OFF_XNP);
      for (int l = bid * 8 + wv; l < LP; l += G * 8) {
          if (l < L_TOK) { const f32x4* row = (const f32x4*)(layer == 0 ? (l < NMETA ? p.meta + (size_t)l * DM : p.x + (size_t)(l - NMETA) * DM) : h + (size_t)l * DM); f32x4 v[8]; float ss = 0.f;
#pragma unroll
              for (int i = 0; i < 8; ++i) { v[i] = row[i * 64 + lane]; ss += v[i][0] * v[i][0] + v[i][1] * v[i][1] + v[i][2] * v[i][2] + v[i][3] * v[i][3]; }
              ss = wave_sum(ss); const float inv = rsqrtf(ss * (1.0f / DM) + 1e-6f);
              const int l1 = l / FN2, l2 = l - l1 * FN2; const size_t pr = (size_t)l2 * FN1P + l1;
#pragma unroll
              for (int i = 0; i < 8; ++i) { const f32x4 gg = ((const f32x4*)gam)[i * 64 + lane]; u32x2 w; w.x = cvt_pk_bf16(v[i][0] * inv * gg[0], v[i][1] * inv * gg[1]); w.y = cvt_pk_bf16(v[i][2] * inv * gg[2], v[i][3] * inv * gg[3]);
                  *(u32x2*)(xn + (size_t)l * DM + (i * 64 + lane) * 4) = w; *(u32x2*)(xnp + pr * DM + (i * 64 + lane) * 4) = w; } }
          else { const u32x2 z = (u32x2){0u, 0u};
#pragma unroll
              for (int i = 0; i < 8; ++i) *(u32x2*)(xn + (size_t)l * DM + (i * 64 + lane) * 4) = z; } }
      for (int idx = bid * 8 + wv; idx < FN2 * (FN1P - FN1); idx += G * 8) { const int l2 = idx / (FN1P - FN1), l1 = FN1 + idx % (FN1P - FN1); const size_t pr = (size_t)l2 * FN1P + l1; const u32x2 z = (u32x2){0u, 0u};
#pragma unroll
          for (int i = 0; i < 8; ++i) *(u32x2*)(xnp + pr * DM + (i * 64 + lane) * 4) = z; } }
}

__device__ void na_unit(const Params& p, int layer, int r, int hd, unsigned char* smem) {
    const int tid = opaque_tid(), wv = tid >> 6, lane = tid & 63, l15 = lane & 15, quad = lane >> 4;
    const bf16_t* qkv = (const bf16_t*)(p.ws + OFF_QKV);
    const int r0 = min(max(r - 4, 0), 248);
    unsigned char* sK = smem;
    bf16_t* sVT = (bf16_t*)(smem + 76032);
    float* sRPB = (float*)(smem + 144640);
    float* sMB = (float*)(smem + 146512);
    __syncthreads();
#pragma unroll
    for (int ps = 0; ps < 8; ++ps) { const int tok = ps * 64 + (tid >> 3), ch = tid & 7; const size_t g = (size_t)(NMETA + r0 * 64 + tok) * 3072 + hd * 64 + ch * 8;
        const u32x4 kv = *(const u32x4*)(qkv + g + 1024), vv = *(const u32x4*)(qkv + g + 2048);
        *(u32x4*)(sK + tok * 144 + ch * 16) = kv;
        bf16_t* vt = sVT + (ch * 8) * 536 + tok;
        vt[0] = (bf16_t)vv.x; vt[536] = (bf16_t)(vv.x >> 16); vt[2 * 536] = (bf16_t)vv.y; vt[3 * 536] = (bf16_t)(vv.y >> 16);
        vt[4 * 536] = (bf16_t)vv.z; vt[5 * 536] = (bf16_t)(vv.z >> 16); vt[6 * 536] = (bf16_t)vv.w; vt[7 * 536] = (bf16_t)(vv.w >> 16); }
    if (tid < 128) { const int tok = tid >> 3, ch = tid & 7; const size_t g = (size_t)tok * 3072 + hd * 64 + ch * 8;
        const u32x4 kv = *(const u32x4*)(qkv + g + 1024), vv = *(const u32x4*)(qkv + g + 2048);
        *(u32x4*)(sK + (512 + tok) * 144 + ch * 16) = kv;
        bf16_t* vt = sVT + (ch * 8) * 536 + 512 + tok;
        vt[0] = (bf16_t)vv.x; vt[536] = (bf16_t)(vv.x >> 16); vt[2 * 536] = (bf16_t)vv.y; vt[3 * 536] = (bf16_t)(vv.y >> 16);
        vt[4 * 536] = (bf16_t)vv.z; vt[5 * 536] = (bf16_t)(vv.z >> 16); vt[6 * 536] = (bf16_t)vv.w; vt[7 * 536] = (bf16_t)(vv.w >> 16); }
    if (tid < 465) sRPB[tid] = p.rpb[(size_t)(layer * 16 + hd) * 465 + tid];
    if (tid >= 480 && tid < 496) sMB[tid - 480] = p.meta_bias[(layer * 16 + hd) * 16 + tid - 480];
    const int cb = wv & 3, hf = wv >> 2, c = cb * 16 + l15;
    const bf16_t* qp = qkv + (size_t)(NMETA + r * 64 + c) * 3072 + hd * 64 + quad * 8;
    const bf16x8 bq0 = *(const bf16x8*)qp, bq1 = *(const bf16x8*)(qp + 32);
    __syncthreads();
    const int cu = cb == 0 ? 0 : (cb == 1 ? 8 : (cb == 2 ? 24 : 32)), cs = min(max(c - 8, 0), 48);
    float sc[9][4];
#pragma unroll
    for (int ti = 0; ti < 9; ++ti) { const int j = 4 * hf + (ti >> 1), tt = ti & 1; const int slot0 = ti < 8 ? j * 64 + cu + tt * 16 : 512;
        const unsigned char* kp = sK + (slot0 + l15) * 144 + quad * 16;
        const bf16x8 a0 = *(const bf16x8*)kp, a1 = *(const bf16x8*)(kp + 64);
        f32x4 acc = (f32x4){0.f, 0.f, 0.f, 0.f};
        acc = __builtin_amdgcn_mfma_f32_16x16x32_bf16(a0, bq0, acc, 0, 0, 0); acc = __builtin_amdgcn_mfma_f32_16x16x32_bf16(a1, bq1, acc, 0, 0, 0);
        if (ti < 8) { const float* rp = sRPB + (r0 + j - r + 7) * 31 + (15 - c);
#pragma unroll
            for (int rr = 0; rr < 4; ++rr) { const int kc = cu + tt * 16 + quad * 4 + rr; const bool ok = kc >= cs && kc < cs + 16; const int kcc = ok ? kc : cs;
                sc[ti][rr] = ok ? acc[rr] * 0.125f + rp[kcc] : -1.0e30f; } }
        else {
#pragma unroll
            for (int rr = 0; rr < 4; ++rr) sc[ti][rr] = hf == 0 ? acc[rr] * 0.125f + sMB[quad * 4 + rr] : -1.0e30f; } }
    float mx = -1.0e30f;
#pragma unroll
    for (int ti = 0; ti < 9; ++ti)
#pragma unroll
        for (int rr = 0; rr < 4; ++rr) mx = fmaxf(mx, sc[ti][rr]);
    mx = fmaxf(mx, __shfl_xor(mx, 16)); mx = fmaxf(mx, __shfl_xor(mx, 32));
    float lsum = 0.f;
#pragma unroll
    for (int ti = 0; ti < 9; ++ti)
#pragma unroll
        for (int rr = 0; rr < 4; ++rr) { sc[ti][rr] = __expf(sc[ti][rr] - mx); lsum += sc[ti][rr]; }
    lsum += __shfl_xor(lsum, 16); lsum += __shfl_xor(lsum, 32);
    f32x4 oacc[4];
#pragma unroll
    for (int dt = 0; dt < 4; ++dt) oacc[dt] = (f32x4){0.f, 0.f, 0.f, 0.f};
#pragma unroll
    for (int ks = 0; ks < 5; ++ks) { const int tA = 2 * ks, tB = 2 * ks + 1;
        const int jA = 4 * hf + (tA >> 1); const int slotA = tA < 8 ? jA * 64 + cu + (tA & 1) * 16 : 512; const int slotB = ks < 4 ? (4 * hf + (tB >> 1)) * 64 + cu + 16 : 512;
        u32x4 pa; pa.x = cvt_pk_bf16(sc[tA][0], sc[tA][1]); pa.y = cvt_pk_bf16(sc[tA][2], sc[tA][3]);
        if (ks < 4) { pa.z = cvt_pk_bf16(sc[tA + 1 < 9 ? tA + 1 : 8][0], sc[tA + 1 < 9 ? tA + 1 : 8][1]); pa.w = cvt_pk_bf16(sc[tA + 1 < 9 ? tA + 1 : 8][2], sc[tA + 1 < 9 ? tA + 1 : 8][3]); } else { pa.z = 0u; pa.w = 0u; }
        const bf16x8 af = __builtin_bit_cast(bf16x8, pa);
#pragma unroll
        for (int dt = 0; dt < 4; ++dt) { const bf16_t* vr = sVT + (dt * 16 + l15) * 536 + quad * 4;
            const u32x2 lo = *(const u32x2*)(vr + slotA), hi = *(const u32x2*)(vr + slotB);
            const u32x4 bb = (u32x4){lo.x, lo.y, hi.x, hi.y};
            oacc[dt] = __builtin_amdgcn_mfma_f32_16x16x32_bf16(af, __builtin_bit_cast(bf16x8, bb), oacc[dt], 0, 0, 0); } }
    __syncthreads();
    float* part = (float*)smem + cb * 1056;
    if (hf == 1) {
#pragma unroll
        for (int dt = 0; dt < 4; ++dt)
#pragma unroll
            for (int rr = 0; rr < 4; ++rr) part[(quad * 4 + rr) * 64 + dt * 16 + l15] = oacc[dt][rr];
        if (quad == 0) { part[1024 + l15] = mx; part[1040 + l15] = lsum; } }
    __syncthreads();
    if (hf == 0) { bf16_t* yc = (bf16_t*)(p.ws + OFF_GATE + 2 * SZ_GATE);
#pragma unroll
        for (int rr = 0; rr < 4; ++rr) { const int qy = quad * 4 + rr; const float m0 = __shfl(mx, qy), l0 = __shfl(lsum, qy); const float m1 = part[1024 + qy], l1 = part[1040 + qy];
            const float M = fmaxf(m0, m1), f0 = __expf(m0 - M), f1 = __expf(m1 - M); const float inv = 1.0f / (f0 * l0 + f1 * l1);
            bf16_t* gp = yc + (size_t)(NMETA + r * 64 + cb * 16 + qy) * 1024 + hd * 64 + l15;
#pragma unroll
            for (int dt = 0; dt < 4; ++dt) { const float o = (f0 * oacc[dt][rr] + f1 * part[qy * 64 + dt * 16 + l15]) * inv; gp[dt * 16] = f2bf(o * bf2f(gp[dt * 16])); } } }
}
__device__ void na_meta_unit(const Params& p, int layer) {
    const int tid = opaque_tid();
    if (tid < 256) { const int hd = tid >> 4, qi = tid & 15; const bf16_t* qkv = (const bf16_t*)(p.ws + OFF_QKV);
        float q[64];
        { const u32x4* qp = (const u32x4*)(qkv + (size_t)qi * 3072 + hd * 64);
#pragma unroll
          for (int i = 0; i < 8; ++i) { const u32x4 v = qp[i]; q[i * 8 + 0] = lo_bf(v.x) * 0.125f; q[i * 8 + 1] = hi_bf(v.x) * 0.125f; q[i * 8 + 2] = lo_bf(v.y) * 0.125f; q[i * 8 + 3] = hi_bf(v.y) * 0.125f;
              q[i * 8 + 4] = lo_bf(v.z) * 0.125f; q[i * 8 + 5] = hi_bf(v.z) * 0.125f; q[i * 8 + 6] = lo_bf(v.w) * 0.125f; q[i * 8 + 7] = hi_bf(v.w) * 0.125f; } }
        float o[64];
#pragma unroll
        for (int i = 0; i < 64; ++i) o[i] = 0.f;
        float mx = -3.0e38f, lsum = 0.f;
#pragma unroll 1
        for (int m = 0; m < 16; ++m) { const u32x4* kp = (const u32x4*)(qkv + (size_t)m * 3072 + 1024 + hd * 64); const u32x4* vp = (const u32x4*)(qkv + (size_t)m * 3072 + 2048 + hd * 64);
            float d0 = 0.f, d1 = 0.f;
#pragma unroll
            for (int e = 0; e < 8; ++e) { const u32x4 v = kp[e];
                d0 += q[e * 8 + 0] * lo_bf(v.x) + q[e * 8 + 2] * lo_bf(v.y) + q[e * 8 + 4] * lo_bf(v.z) + q[e * 8 + 6] * lo_bf(v.w);
                d1 += q[e * 8 + 1] * hi_bf(v.x) + q[e * 8 + 3] * hi_bf(v.y) + q[e * 8 + 5] * hi_bf(v.z) + q[e * 8 + 7] * hi_bf(v.w); }
            const float sc = d0 + d1 + p.meta_bias[(layer * 16 + hd) * 16 + m]; const float mnew = fmaxf(mx, sc); const float alpha = __expf(mx - mnew), pi = __expf(sc - mnew);
            lsum = lsum * alpha + pi; mx = mnew;
#pragma unroll
            for (int e = 0; e < 8; ++e) { const u32x4 v = vp[e];
                o[e * 8 + 0] = o[e * 8 + 0] * alpha + pi * lo_bf(v.x); o[e * 8 + 1] = o[e * 8 + 1] * alpha + pi * hi_bf(v.x); o[e * 8 + 2] = o[e * 8 + 2] * alpha + pi * lo_bf(v.y); o[e * 8 + 3] = o[e * 8 + 3] * alpha + pi * hi_bf(v.y);
                o[e * 8 + 4] = o[e * 8 + 4] * alpha + pi * lo_bf(v.z); o[e * 8 + 5] = o[e * 8 + 5] * alpha + pi * hi_bf(v.z); o[e * 8 + 6] = o[e * 8 + 6] * alpha + pi * lo_bf(v.w); o[e * 8 + 7] = o[e * 8 + 7] * alpha + pi * hi_bf(v.w); } }
        const float inv = 1.0f / lsum; u32x4* gp = (u32x4*)((bf16_t*)(p.ws + OFF_GATE + 2 * SZ_GATE) + (size_t)qi * 1024 + hd * 64);
#pragma unroll
        for (int e = 0; e < 8; ++e) { const u32x4 g = gp[e]; u32x4 w;
            w.x = cvt_pk_bf16(o[e * 8 + 0] * inv * lo_bf(g.x), o[e * 8 + 1] * inv * hi_bf(g.x)); w.y = cvt_pk_bf16(o[e * 8 + 2] * inv * lo_bf(g.y), o[e * 8 + 3] * inv * hi_bf(g.y));
            w.z = cvt_pk_bf16(o[e * 8 + 4] * inv * lo_bf(g.z), o[e * 8 + 5] * inv * hi_bf(g.z)); w.w = cvt_pk_bf16(o[e * 8 + 6] * inv * lo_bf(g.w), o[e * 8 + 7] * inv * hi_bf(g.w));
            gp[e] = w; } }
}

__device__ __forceinline__ unsigned rev4_14(unsigned k) { unsigned r = __brev(k) >> 18; return ((r & 0x1555u) << 1) | ((r >> 1) & 0x1555u); }
__device__ __forceinline__ float2 cmul(float2 a, float2 b) { return make_float2(a.x * b.x - a.y * b.y, a.x * b.y + a.y * b.x); }
#define PADI(i) ((i) + ((i) >> 4))
#define CFF(n) cff[2 * PADI((n) >> 1) + ((n) & 1)]
__device__ __forceinline__ void hw_sincos(float rev, float& sn, float& cs) { sn = __builtin_amdgcn_sinf(rev); cs = __builtin_amdgcn_cosf(rev); }
__device__ __forceinline__ float c16(int k) { const float t[10] = {1.0f, 0.9238795325f, 0.7071067812f, 0.3826834324f, 0.0f, -0.3826834324f, -0.7071067812f, -0.9238795325f, -1.0f, -0.9238795325f}; return t[k]; }
__device__ __forceinline__ float s16(int k) { const float t[10] = {0.0f, 0.3826834324f, 0.7071067812f, 0.9238795325f, 1.0f, 0.9238795325f, 0.7071067812f, 0.3826834324f, 0.0f, -0.3826834324f}; return t[k]; }
__device__ __forceinline__ float2 cadd(float2 a, float2 b) { return make_float2(a.x + b.x, a.y + b.y); }
__device__ __forceinline__ float2 csub(float2 a, float2 b) { return make_float2(a.x - b.x, a.y - b.y); }
template <int SGN> __device__ __forceinline__ void bf4(float2& a0, float2& a1, float2& a2, float2& a3) {
    const float2 t0 = cadd(a0, a2), t1 = csub(a0, a2), t2 = cadd(a1, a3), d = csub(a1, a3);
    const float2 t3 = SGN < 0 ? make_float2(d.y, -d.x) : make_float2(-d.y, d.x);
    a0 = cadd(t0, t2); a1 = cadd(t1, t3); a2 = csub(t0, t2); a3 = csub(t1, t3);
}
template <int S> __device__ __forceinline__ void r16_fwd_pass(float2* a) {
    constexpr int Q = S / 4;
    for (int u = opaque_tid(); u < 1024; u += NTHREADS) { const int j = u & (Q - 1); const int base = ((u - j) << 4) + j;
        float2 x[4][4];
#pragma unroll
        for (int aa = 0; aa < 4; ++aa)
#pragma unroll
            for (int bb = 0; bb < 4; ++bb) x[aa][bb] = a[PADI(base + aa * S + bb * Q)];
        float sn, cs; hw_sincos((float)j / (float)(4 * S), sn, cs); const float2 wb0 = make_float2(cs, -sn);
#pragma unroll
        for (int bb = 0; bb < 4; ++bb) { const float2 w1 = bb == 0 ? wb0 : cmul(wb0, make_float2(c16(bb), -s16(bb))); const float2 w2 = cmul(w1, w1), w3 = cmul(w2, w1);
            bf4<-1>(x[0][bb], x[1][bb], x[2][bb], x[3][bb]); x[1][bb] = cmul(x[1][bb], w1); x[2][bb] = cmul(x[2][bb], w2); x[3][bb] = cmul(x[3][bb], w3); }
        hw_sincos((float)j / (float)S, sn, cs); const float2 v1 = make_float2(cs, -sn), v2 = cmul(v1, v1), v3 = cmul(v2, v1);
#pragma unroll
        for (int aa = 0; aa < 4; ++aa) { bf4<-1>(x[aa][0], x[aa][1], x[aa][2], x[aa][3]); x[aa][1] = cmul(x[aa][1], v1); x[aa][2] = cmul(x[aa][2], v2); x[aa][3] = cmul(x[aa][3], v3); }
#pragma unroll
        for (int aa = 0; aa < 4; ++aa)
#pragma unroll
            for (int bb = 0; bb < 4; ++bb) a[PADI(base + aa * S + bb * Q)] = x[aa][bb]; }
    __syncthreads();
}
template <int S> __device__ __forceinline__ void r16_inv_pass(float2* a) {
    constexpr int Q = S / 4;
    for (int u = opaque_tid(); u < 1024; u += NTHREADS) { const int j = u & (Q - 1); const int base = ((u - j) << 4) + j;
        float2 x[4][4];
#pragma unroll
        for (int aa = 0; aa < 4; ++aa)
#pragma unroll
            for (int bb = 0; bb < 4; ++bb) x[aa][bb] = a[PADI(base + aa * S + bb * Q)];
        float sn, cs; hw_sincos((float)j / (float)S, sn, cs); const float2 v1 = make_float2(cs, sn), v2 = cmul(v1, v1), v3 = cmul(v2, v1);
#pragma unroll
        for (int aa = 0; aa < 4; ++aa) { x[aa][1] = cmul(x[aa][1], v1); x[aa][2] = cmul(x[aa][2], v2); x[aa][3] = cmul(x[aa][3], v3); bf4<1>(x[aa][0], x[aa][1], x[aa][2], x[aa][3]); }
        hw_sincos((float)j / (float)(4 * S), sn, cs); const float2 wb0 = make_float2(cs, sn);
#pragma unroll
        for (int bb = 0; bb < 4; ++bb) { const float2 w1 = bb == 0 ? wb0 : cmul(wb0, make_float2(c16(bb), s16(bb))); const float2 w2 = cmul(w1, w1), w3 = cmul(w2, w1);
            x[1][bb] = cmul(x[1][bb], w1); x[2][bb] = cmul(x[2][bb], w2); x[3][bb] = cmul(x[3][bb], w3); bf4<1>(x[0][bb], x[1][bb], x[2][bb], x[3][bb]); }
#pragma unroll
        for (int aa = 0; aa < 4; ++aa)
#pragma unroll
            for (int bb = 0; bb < 4; ++bb) a[PADI(base + aa * S + bb * Q)] = x[aa][bb]; }
    __syncthreads();
}
__device__ void fft_fwd(float2* a) {
    r16_fwd_pass<4096>(a);
    r16_fwd_pass<256>(a);
    { const int span = 16;
        for (int b = opaque_tid(); b < 4096; b += NTHREADS) { const int j = b & (span - 1); const int base = ((b - j) << 2) + j;
            const int i0 = PADI(base), i1 = PADI(base + span), i2 = PADI(base + 2 * span), i3 = PADI(base + 3 * span);
            float2 a0 = a[i0], a1 = a[i1], a2 = a[i2], a3 = a[i3];
            const float2 w1 = make_float2(c16(0) * 0.f + __builtin_amdgcn_cosf((float)j * (1.0f / 64.0f)), -__builtin_amdgcn_sinf((float)j * (1.0f / 64.0f))), w2 = cmul(w1, w1), w3 = cmul(w2, w1);
            bf4<-1>(a0, a1, a2, a3);
            a[i0] = a0; a[i1] = cmul(a1, w1); a[i2] = cmul(a2, w2); a[i3] = cmul(a3, w3); }
        __syncthreads(); }
    for (int blk = opaque_tid(); blk < 1024; blk += NTHREADS) { float2* pb = a + blk * 17; float2 x[16];
#pragma unroll
        for (int e = 0; e < 16; ++e) x[e] = pb[e];
#pragma unroll
        for (int j = 0; j < 4; ++j) { bf4<-1>(x[j], x[j + 4], x[j + 8], x[j + 12]);
            x[j + 4] = cmul(x[j + 4], make_float2(c16(j), -s16(j))); x[j + 8] = cmul(x[j + 8], make_float2(c16(2 * j), -s16(2 * j))); x[j + 12] = cmul(x[j + 12], make_float2(c16(3 * j), -s16(3 * j))); }
#pragma unroll
        for (int g = 0; g < 4; ++g) bf4<-1>(x[4 * g], x[4 * g + 1], x[4 * g + 2], x[4 * g + 3]);
#pragma unroll
        for (int e = 0; e < 16; ++e) pb[e] = x[e]; }
    __syncthreads();
}
__device__ void fft_inv(float2* a) {
    for (int blk = opaque_tid(); blk < 1024; blk += NTHREADS) { float2* pb = a + blk * 17; float2 x[16];
#pragma unroll
        for (int e = 0; e < 16; ++e) x[e] = pb[e];
#pragma unroll
        for (int g = 0; g < 4; ++g) bf4<1>(x[4 * g], x[4 * g + 1], x[4 * g + 2], x[4 * g + 3]);
#pragma unroll
        for (int j = 0; j < 4; ++j) { x[j + 4] = cmul(x[j + 4], make_float2(c16(j), s16(j))); x[j + 8] = cmul(x[j + 8], make_float2(c16(2 * j), s16(2 * j))); x[j + 12] = cmul(x[j + 12], make_float2(c16(3 * j), s16(3 * j)));
            bf4<1>(x[j], x[j + 4], x[j + 8], x[j + 12]); }
#pragma unroll
        for (int e = 0; e < 16; ++e) pb[e] = x[e]; }
    __syncthreads();
    { const int span = 16;
        for (int b = opaque_tid(); b < 4096; b += NTHREADS) { const int j = b & (span - 1); const int base = ((b - j) << 2) + j;
            const int i0 = PADI(base), i1 = PADI(base + span), i2 = PADI(base + 2 * span), i3 = PADI(base + 3 * span);
            const float2 w1 = make_float2(__builtin_amdgcn_cosf((float)j * (1.0f / 64.0f)), __builtin_amdgcn_sinf((float)j * (1.0f / 64.0f))), w2 = cmul(w1, w1), w3 = cmul(w2, w1);
            float2 a0 = a[i0], a1 = cmul(a[i1], w1), a2 = cmul(a[i2], w2), a3 = cmul(a[i3], w3);
            bf4<1>(a0, a1, a2, a3);
            a[i0] = a0; a[i1] = a1; a[i2] = a2; a[i3] = a3; }
        __syncthreads(); }
    r16_inv_pass<256>(a);
    r16_inv_pass<4096>(a);
}
__device__ __forceinline__ void hy_load8(const bf16_t* __restrict__ row, int t0, u32x4& v, float& xl, float& xh) {
    v = *(const u32x4*)(row + t0); xl = t0 > 0 ? bf2f(row[t0 - 1]) : 0.f; xh = (t0 + 8 < L_TOK) ? bf2f(row[t0 + 8]) : 0.f;
}
__device__ __forceinline__ void hy_calc8(const u32x4 v, float xl, float xh, const float (&w)[4], float (&o)[8]) {
    float x[10];
    x[0] = xl; x[9] = xh;
    x[1] = lo_bf(v.x); x[2] = hi_bf(v.x); x[3] = lo_bf(v.y); x[4] = hi_bf(v.y); x[5] = lo_bf(v.z); x[6] = hi_bf(v.z); x[7] = lo_bf(v.w); x[8] = hi_bf(v.w);
#pragma unroll
    for (int e = 0; e < 8; ++e) o[e] = w[0] * x[e] + w[1] * x[e + 1] + w[2] * x[e + 2] + w[3];
}
__device__ __forceinline__ void hy_val8(const bf16_t* __restrict__ row, int t0, const float (&w)[4], float (&o)[8]) { u32x4 v; float xl, xh; hy_load8(row, t0, v, xl, xh); hy_calc8(v, xl, xh, w, o); }
struct HyCh { const bf16_t* __restrict__ ru; const bf16_t* __restrict__ r1; const bf16_t* __restrict__ r2; float wu[4], w1[4], w2[4]; };

constexpr int SD_W4B = 0  , SD_GFX = 512, SD_GBX = 528, SD_EF = 544, SD_EB = 560, SD_VH = 576, SD_VT = 592, SD_END = 608;
constexpr int NCHUNK = L_TOK / 8;

template <int ORDER>
__device__ void hy_conv(const HyCh& hc, float2* cf, float* side, unsigned char* scratch) {
    const int tid = opaque_tid(); float* cff = (float*)cf;
    f32x4* __restrict__ heo = (f32x4*)(scratch + HS_HEO); const float* __restrict__ z2g = (const float*)(scratch + HS_Z2);
    if (tid < 15) side[SD_EF + tid] = CFF(16369 + tid); else if (tid >= 32 && tid < 47) side[SD_EB + tid - 32] = CFF(32768 - (16369 + tid - 32));
    __syncthreads();
    fft_fwd(cf);
    for (int k = tid; k <= 8192; k += NTHREADS) { const int kp = (16384 - k) & 16383; const float2 a = cf[PADI(rev4_14(k))], bq = cf[PADI(rev4_14(kp))];
        const float bx = bq.x, by = -bq.y; const float sc = 1.0f / 16384.0f;
        heo[k] = (f32x4){0.5f * (a.x + bx) * sc, 0.5f * (a.y + by) * sc, 0.5f * (a.y - by) * sc, -0.5f * (a.x - bx) * sc}; }
    __syncthreads();
    {
        u32x4 rv[4]; float rl[4], rh[4]; f32x4 z0[4], z1[4];
#pragma unroll
        for (int i = 0; i < 4; ++i) { const int c = tid + NTHREADS * i;
            if (ORDER == 0) hy_load8(hc.ru, 8 * c, rv[i], rl[i], rh[i]); else { z0[i] = *(const f32x4*)(z2g + 8 * c); z1[i] = *(const f32x4*)(z2g + 8 * c + 4); } }
#pragma unroll
        for (int i = 0; i < 4; ++i) { const int c = tid + NTHREADS * i; float v[8];
            if (ORDER == 0) hy_calc8(rv[i], rl[i], rh[i], hc.wu, v);
            else { v[0] = z0[i][0]; v[1] = z0[i][1]; v[2] = z0[i][2]; v[3] = z0[i][3]; v[4] = z1[i][0]; v[5] = z1[i][1]; v[6] = z1[i][2]; v[7] = z1[i][3]; }
            float2* d = cf + PADI(4 * c); d[0] = make_float2(v[0], v[1]); d[1] = make_float2(v[2], v[3]); d[2] = make_float2(v[4], v[5]); d[3] = make_float2(v[6], v[7]);
            if (i == 0 && tid < 2) {
#pragma unroll
                for (int e = 0; e < 8; ++e) side[SD_VH + 8 * tid + e] = v[e]; } }
        if (tid < 2) { const int c = NCHUNK - 2 + tid; float v[8];
            if (ORDER == 0) hy_val8(hc.ru, 8 * c, hc.wu, v);
            else { const f32x4 p0 = *(const f32x4*)(z2g + 8 * c), p1 = *(const f32x4*)(z2g + 8 * c + 4); v[0] = p0[0]; v[1] = p0[1]; v[2] = p0[2]; v[3] = p0[3]; v[4] = p1[0]; v[5] = p1[1]; v[6] = p1[2]; v[7] = p1[3]; }
            float2* d = cf + PADI(4 * c); d[0] = make_float2(v[0], v[1]); d[1] = make_float2(v[2], v[3]); d[2] = make_float2(v[4], v[5]); d[3] = make_float2(v[6], v[7]);
#pragma unroll
            for (int e = 0; e < 8; ++e) side[SD_VT + 8 * tid + e] = v[e]; } }
    for (int i = L_TOK / 2 + tid; i < 16384; i += NTHREADS) cf[PADI(i)] = make_float2(0.f, 0.f);
    __syncthreads();
    fft_fwd(cf);
#pragma unroll 4
    for (int k = tid; k <= 8192; k += NTHREADS) { const int kp = (16384 - k) & 16383; const unsigned ik = PADI(rev4_14(k)), ikp = PADI(rev4_14(kp)); const float2 a = cf[ik], bq = cf[ikp];
        const float bx = bq.x, by = -bq.y;
        const float2 XE = make_float2(0.5f * (a.x + bx), 0.5f * (a.y + by)), XO = make_float2(0.5f * (a.y - by), -0.5f * (a.x - bx));
        const f32x4 hh = heo[k]; const float2 HE = make_float2(hh[0], hh[1]), HO = make_float2(hh[2], hh[3]);
        float sn, cs; hw_sincos((float)k / 16384.0f, sn, cs); const float2 w = make_float2(cs, -sn);
        const float2 xoho = cmul(XO, HO), wx = cmul(w, xoho), xehe = cmul(XE, HE), xeho = cmul(XE, HO), xohe = cmul(XO, HE);
        const float2 YE = make_float2(xehe.x + wx.x, xehe.y + wx.y), YO = make_float2(xeho.x + xohe.x, xeho.y + xohe.y);
        cf[ik] = make_float2(YE.x - YO.y, YE.y + YO.x); cf[ikp] = make_float2(YE.x + YO.y, -YE.y + YO.x); }
    __syncthreads();
    fft_inv(cf);
    if (tid < 16) { const int t = tid; float d = 0.f;
        for (int s = t + 16384; s < L_TOK; ++s) { const int l = s - t; const float wrong = l == 16384 ? 0.f : side[SD_EF + 16399 - l]; d += (side[SD_GBX + l - 16384] - wrong) * side[SD_VT + s - 16384]; }
        CFF(t) += d; }
    else if (tid >= 32 && tid < 48) { const int t = 16384 + tid - 32; float d = 0.f;
        for (int s = 0; s <= t - 16384; ++s) { const int l = t - s; const float wrong = l == 16384 ? 0.f : side[SD_EB + 16399 - l]; d += (side[SD_GFX + l - 16384] - wrong) * side[SD_VH + s]; }
        CFF(t) += d; }
    __syncthreads();
}

__device__ void hyena_unit(const Params& p, int layer, int ch, unsigned char* smem, unsigned char* scratch) {
    const int tid = opaque_tid(); float2* cf = (float2*)smem; float* cff = (float*)smem; float* side = (float*)(smem + 139264);
    const bf16_t* hyin = (const bf16_t*)(p.ws + OFF_HYIN);
    HyCh hc; hc.ru = hyin + (size_t)ch * LP; hc.r1 = hyin + (size_t)(1024 + ch) * LP; hc.r2 = hyin + (size_t)(2048 + ch) * LP;
    { const float* cw = p.conv_w + (size_t)layer * 3 * 3072; const float* cb = p.conv_b + (size_t)layer * 3072;
#pragma unroll
      for (int jj = 0; jj < 3; ++jj) { hc.wu[jj] = cw[jj * 3072 + ch]; hc.w1[jj] = cw[jj * 3072 + 1024 + ch]; hc.w2[jj] = cw[jj * 3072 + 2048 + ch]; }
      hc.wu[3] = cb[ch]; hc.w1[3] = cb[1024 + ch]; hc.w2[3] = cb[2048 + ch]; }
    const float sk0 = p.skip[(layer * 2 + 0) * 1024 + ch], sk1 = p.skip[(layer * 2 + 1) * 1024 + ch];
    float* __restrict__ z2g = (float*)(scratch + HS_Z2); float* __restrict__ g2f = (float*)(scratch + HS_G2F); float* __restrict__ g2b = (float*)(scratch + HS_G2B);
    bf16_t* __restrict__ hyout = (bf16_t*)(p.ws + OFF_HYOUT) + (size_t)ch * LP;
    __syncthreads();
    { bf16_t* w4b = (bf16_t*)(side + SD_W4B);
      for (int i = tid; i < 16 * 64; i += NTHREADS) { const int n = i >> 6, k = i & 63; w4b[i] = n < 4 ? f2bf(p.f_w4[((size_t)layer * 64 + k) * 4096 + n * 1024 + ch]) : (bf16_t)0; }
      __syncthreads();
      const bf16_t* __restrict__ h3b = (const bf16_t*)(p.ws + OFF_H3) + (size_t)layer * L_TOK * 64;
      const int lane = tid & 63, wv = tid >> 6, col = lane & 15, quad = lane >> 4;
      const float dk = col < 4 ? fabsf(p.decay[((layer * 2 + (col >> 1)) * 2 + (col & 1)) * 1024 + ch]) * (1.4426950408889634f / (float)(L_TOK - 1)) : 0.f;
      const bf16x8 b0 = *(const bf16x8*)(w4b + col * 64 + quad * 8), b1 = *(const bf16x8*)(w4b + col * 64 + 32 + quad * 8);
      for (int gb = wv; gb < L_TOK / 16; gb += 64) {
          bf16x8 a0[8], a1[8];
#pragma unroll
          for (int i = 0; i < 8; ++i) { const int g = min(gb + 8 * i, L_TOK / 16 - 1); const bf16_t* hr = h3b + (size_t)(g * 16 + col) * 64 + quad * 8; a0[i] = *(const bf16x8*)hr; a1[i] = *(const bf16x8*)(hr + 32); }
#pragma unroll
          for (int i = 0; i < 8; ++i) { const int g = gb + 8 * i;
              if (g < L_TOK / 16) {
                  f32x4 acc = (f32x4){0.f, 0.f, 0.f, 0.f};
                  acc = __builtin_amdgcn_mfma_f32_16x16x32_bf16(a0[i], b0, acc, 0, 0, 0); acc = __builtin_amdgcn_mfma_f32_16x16x32_bf16(a1[i], b1, acc, 0, 0, 0);
                  if (col < 4) { const int lag0 = g * 16 + quad * 4; float v[4];
#pragma unroll
                      for (int r = 0; r < 4; ++r) v[r] = acc[r] * __builtin_amdgcn_exp2f(-(float)(lag0 + r) * dk);
                      if (col == 2) *(f32x4*)(g2f + lag0) = (f32x4){v[0], v[1], v[2], v[3]};
                      else if (col == 3) *(f32x4*)(g2b + lag0) = (f32x4){v[0], v[1], v[2], v[3]};
                      else if (col == 0) { if (lag0 < NMAIN) { float2* d = cf + PADI(lag0 >> 1); d[0] = make_float2(v[0], v[1]); d[1] = make_float2(v[2], v[3]); }
                                           else { side[SD_GFX + lag0 - NMAIN] = v[0]; side[SD_GFX + lag0 - NMAIN + 1] = v[1]; side[SD_GFX + lag0 - NMAIN + 2] = v[2]; side[SD_GFX + lag0 - NMAIN + 3] = v[3]; } }
                      else { if (lag0 < NMAIN) {
#pragma unroll
                                 for (int r = 0; r < 4; ++r) if (lag0 + r >= 1) CFF(32768 - lag0 - r) = v[r]; }
                             else { side[SD_GBX + lag0 - NMAIN] = v[0]; side[SD_GBX + lag0 - NMAIN + 1] = v[1]; side[SD_GBX + lag0 - NMAIN + 2] = v[2]; side[SD_GBX + lag0 - NMAIN + 3] = v[3]; } } } } } }
      if (tid == 0) CFF(NMAIN) = 0.f;
      __syncthreads(); }
    hy_conv<0>(hc, cf, side, scratch);
    {   u32x4 ru_[4], r1_[4]; float ul[4], uh[4], xl[4], xh[4];
#pragma unroll
        for (int i = 0; i < 4; ++i) { const int c = tid + NTHREADS * i; hy_load8(hc.ru, 8 * c, ru_[i], ul[i], uh[i]); hy_load8(hc.r1, 8 * c, r1_[i], xl[i], xh[i]); }
#pragma unroll
        for (int i = 0; i < 5; ++i) { const int c = i < 4 ? tid + NTHREADS * i : NCHUNK - 2 + tid;
            if (i < 4 || tid < 2) { float u8[8], x8[8];
                if (i < 4) { hy_calc8(ru_[i], ul[i], uh[i], hc.wu, u8); hy_calc8(r1_[i], xl[i], xh[i], hc.w1, x8); } else { hy_val8(hc.ru, 8 * c, hc.wu, u8); hy_val8(hc.r1, 8 * c, hc.w1, x8); }
                const float2* s = cf + PADI(4 * c); const float2 y0 = s[0], y1 = s[1], y2 = s[2], y3 = s[3];
                const f32x4 o0 = (f32x4){x8[0] * (y0.x + sk0 * u8[0]), x8[1] * (y0.y + sk0 * u8[1]), x8[2] * (y1.x + sk0 * u8[2]), x8[3] * (y1.y + sk0 * u8[3])};
                const f32x4 o1 = (f32x4){x8[4] * (y2.x + sk0 * u8[4]), x8[5] * (y2.y + sk0 * u8[5]), x8[6] * (y3.x + sk0 * u8[6]), x8[7] * (y3.y + sk0 * u8[7])};
                *(f32x4*)(z2g + 8 * c) = o0; *(f32x4*)(z2g + 8 * c + 4) = o1; } } }
    __syncthreads();
    {   f32x4 gfq[8], gbq[8];
#pragma unroll
        for (int i = 0; i < 8; ++i) { const int lag0 = 4 * (tid + NTHREADS * i); gfq[i] = *(const f32x4*)(g2f + lag0); gbq[i] = *(const f32x4*)(g2b + lag0); }
#pragma unroll
        for (int i = 0; i < 8; ++i) { const int lag0 = 4 * (tid + NTHREADS * i); float2* d = cf + PADI(lag0 >> 1); d[0] = make_float2(gfq[i][0], gfq[i][1]); d[1] = make_float2(gfq[i][2], gfq[i][3]);
#pragma unroll
            for (int r = 0; r < 4; ++r) if (lag0 + r >= 1) CFF(32768 - lag0 - r) = gbq[i][r]; }
        if (tid < 4) { const int lag0 = NMAIN + 4 * tid; const f32x4 gf = *(const f32x4*)(g2f + lag0), gb = *(const f32x4*)(g2b + lag0);
#pragma unroll
            for (int r = 0; r < 4; ++r) { side[SD_GFX + lag0 - NMAIN + r] = gf[r]; side[SD_GBX + lag0 - NMAIN + r] = gb[r]; } } }
    if (tid == 0) CFF(NMAIN) = 0.f;
    __syncthreads();
    hy_conv<1>(hc, cf, side, scratch);
    {   u32x4 r2_[4]; float xl[4], xh[4]; f32x4 z0[4], z1[4];
#pragma unroll
        for (int i = 0; i < 4; ++i) { const int c = tid + NTHREADS * i; hy_load8(hc.r2, 8 * c, r2_[i], xl[i], xh[i]); z0[i] = *(const f32x4*)(z2g + 8 * c); z1[i] = *(const f32x4*)(z2g + 8 * c + 4); }
#pragma unroll
        for (int i = 0; i < 5; ++i) { const int c = i < 4 ? tid + NTHREADS * i : NCHUNK - 2 + tid;
            if (i < 4 || tid < 2) { float x8[8]; f32x4 p0, p1;
                if (i < 4) { hy_calc8(r2_[i], xl[i], xh[i], hc.w2, x8); p0 = z0[i]; p1 = z1[i]; } else { hy_val8(hc.r2, 8 * c, hc.w2, x8); p0 = *(const f32x4*)(z2g + 8 * c); p1 = *(const f32x4*)(z2g + 8 * c + 4); }
                const float2* s = cf + PADI(4 * c); const float2 y0 = s[0], y1 = s[1], y2 = s[2], y3 = s[3];
                u32x4 w; w.x = cvt_pk_bf16(x8[0] * (y0.x + sk1 * p0[0]), x8[1] * (y0.y + sk1 * p0[1])); w.y = cvt_pk_bf16(x8[2] * (y1.x + sk1 * p0[2]), x8[3] * (y1.y + sk1 * p0[3]));
                w.z = cvt_pk_bf16(x8[4] * (y2.x + sk1 * p1[0]), x8[5] * (y2.y + sk1 * p1[1])); w.w = cvt_pk_bf16(x8[6] * (y3.x + sk1 * p1[2]), x8[7] * (y3.y + sk1 * p1[3]));
                *(u32x4*)(hyout + 8 * c) = w; } } }
    __syncthreads();
}

__device__ void transpose_unit(const Params& p, int ct, int tt, unsigned char* smem) {
    const int tid = opaque_tid(); bf16_t* tile = (bf16_t*)smem;
    const bf16_t* hyout = (const bf16_t*)(p.ws + OFF_HYOUT); bf16_t* ya = (bf16_t*)(p.ws + OFF_GATE);
    __syncthreads();
    { const int cl = tid >> 3, t8 = (tid & 7) * 8; *(u32x4*)(tile + cl * 72 + t8) = *(const u32x4*)(hyout + (size_t)(ct * 64 + cl) * LP + tt * 64 + t8); }
    __syncthreads();
    { const int tl = tid >> 3, c8 = (tid & 7) * 8; const int t = tt * 64 + tl;
      if (t < L_TOK) { bf16_t* gp = ya + (size_t)t * 1024 + ct * 64 + c8; const u32x4 g = *(const u32x4*)gp;
          float v[8];
#pragma unroll
          for (int i = 0; i < 8; ++i) v[i] = bf2f(tile[(c8 + i) * 72 + tl]);
          u32x4 w; w.x = cvt_pk_bf16(v[0] * lo_bf(g.x), v[1] * hi_bf(g.x)); w.y = cvt_pk_bf16(v[2] * lo_bf(g.y), v[3] * hi_bf(g.y)); w.z = cvt_pk_bf16(v[4] * lo_bf(g.z), v[5] * hi_bf(g.z)); w.w = cvt_pk_bf16(v[6] * lo_bf(g.w), v[7] * hi_bf(g.w));
          *(u32x4*)gp = w; } }
}

__device__ void phase_final(const Params& p) {
    const int tid = opaque_tid(), lane = tid & 63, wv = tid >> 6; const float* h = (const float*)(p.ws + OFF_H);
    for (int l = NMETA + blockIdx.x * 8 + wv; l < L_TOK; l += gridDim.x * 8) { const f32x4* row = (const f32x4*)(h + (size_t)l * DM); f32x4 v[8]; float ss = 0.f;
#pragma unroll
        for (int i = 0; i < 8; ++i) { v[i] = row[i * 64 + lane]; ss += v[i][0] * v[i][0] + v[i][1] * v[i][1] + v[i][2] * v[i][2] + v[i][3] * v[i][3]; }
        ss = wave_sum(ss); const float inv = rsqrtf(ss * (1.0f / DM) + 1e-6f); f32x4* o = (f32x4*)(p.out + (size_t)(l - NMETA) * DM);
#pragma unroll
        for (int i = 0; i < 8; ++i) { const f32x4 gg = ((const f32x4*)p.final_g)[i * 64 + lane]; o[i * 64 + lane] = v[i] * inv * gg; } }
}

__device__ void mini_branch(const Params& p) {
    const int tid = opaque_tid(), lane = tid & 63, wv = tid >> 6, nt_ = blockIdx.x * 8 + wv;
    if (nt_ < 128) { const int rc = lane & 15, quad = lane >> 4; const int n0 = nt_ * 16;
        const bf16_t* mg = (const bf16_t*)(p.ws + OFF_MERGE); bf16_t* mb = (bf16_t*)(p.ws + OFF_M);
        float tot[4] = {0.f, 0.f, 0.f, 0.f};
#pragma unroll 1
        for (int br = 0; br < 3; ++br) { const bf16_t* A = (const bf16_t*)(p.ws + OFF_GATE + (size_t)br * SZ_GATE) + (size_t)(NMAIN + rc) * 1024 + quad * 8;
            const bf16_t* B = (const bf16_t*)(p.ws + OFF_WA + (size_t)br * SZ_WBR) + (size_t)(n0 + rc) * 1024 + quad * 8;
            f32x4 acc = (f32x4){0.f, 0.f, 0.f, 0.f};
#pragma unroll 1
            for (int kb = 0; kb < 32; kb += 8) { bf16x8 av[8], bv[8];
#pragma unroll
                for (int i = 0; i < 8; ++i) { av[i] = *(const bf16x8*)(A + (kb + i) * 32); bv[i] = *(const bf16x8*)(B + (kb + i) * 32); }
#pragma unroll
                for (int i = 0; i < 8; ++i) acc = __builtin_amdgcn_mfma_f32_16x16x32_bf16(av[i], bv[i], acc, 0, 0, 0); }
#pragma unroll
            for (int r = 0; r < 4; ++r) tot[r] += acc[r] * bf2f(mg[(size_t)(NMAIN + quad * 4 + r) * 6144 + br * 2048 + n0 + rc]); }
#pragma unroll
        for (int r = 0; r < 4; ++r) mb[(size_t)(NMAIN + quad * 4 + r) * DM + n0 + rc] = f2bf(tot[r]); }
}
__device__ void mini_out(const Params& p, int layer) {
    const int tid = opaque_tid(), lane = tid & 63, wv = tid >> 6, nt_ = blockIdx.x * 8 + wv;
    if (nt_ < 128) { const int rc = lane & 15, quad = lane >> 4; const int n0 = nt_ * 16;
        const bf16_t* A = (const bf16_t*)(p.ws + OFF_M) + (size_t)(NMAIN + rc) * DM + quad * 8; const bf16_t* B = (const bf16_t*)(p.ws + OFF_WO) + (size_t)(n0 + rc) * DM + quad * 8;
        f32x4 acc = (f32x4){0.f, 0.f, 0.f, 0.f};
#pragma unroll 1
        for (int kb = 0; kb < 64; kb += 8) { bf16x8 av[8], bv[8];
#pragma unroll
            for (int i = 0; i < 8; ++i) { av[i] = *(const bf16x8*)(A + (kb + i) * 32); bv[i] = *(const bf16x8*)(B + (kb + i) * 32); }
#pragma unroll
            for (int i = 0; i < 8; ++i) acc = __builtin_amdgcn_mfma_f32_16x16x32_bf16(av[i], bv[i], acc, 0, 0, 0); }
        float* h = (float*)(p.ws + OFF_H);
#pragma unroll
        for (int r = 0; r < 4; ++r) { const size_t row = NMAIN + quad * 4 + r; const float bs = layer == 0 ? p.x[(row - NMETA) * DM + n0 + rc] : h[row * DM + n0 + rc]; h[row * DM + n0 + rc] = bs + acc[r]; } }
}

enum { OP_P1 = 0, OP_SYNC, OP_GEMM, OP_NA, OP_HYENA, OP_TRANS, OP_NOP };
__global__ void __launch_bounds__(512, 2) hybrid_fwd(Params p) {
    extern __shared__ __attribute__((aligned(16))) unsigned char smem[];
    cg::grid_group grid = cg::this_grid();
    LAS unsigned char* lds = (LAS unsigned char*)smem;
    const int bid = blockIdx.x, G = gridDim.x;
    phase_prep0(p, smem);
    constexpr int NOPS = 17;
#pragma clang loop unroll(disable)
    for (int step = 0; step < 2 * NOPS; ++step) {
        const int layer = step / NOPS, s = step - layer * NOPS;
        int op, kind = 0;
        switch (s) {
        case 0: op = OP_P1; break;
        case 2: op = OP_GEMM; kind = K_IN; break;
        case 3: case 4: op = OP_NOP; break;
        case 6: op = OP_GEMM; kind = K_FNA; break;
        case 7: op = OP_NA; break;
        case 8: op = OP_HYENA; break;
        case 10: op = OP_GEMM; kind = K_FNB; break;
        case 11: op = OP_TRANS; break;
        case 13: op = OP_GEMM; kind = K_BR; break;
        case 15: op = OP_GEMM; kind = K_OUT; break;
        default: op = OP_SYNC; break;
        }
        if (op == OP_NOP) { }
        else if (op == OP_SYNC) { grid.sync(); }
        else if (op == OP_GEMM) {
            Gemm g; g.base = (const char*)p.ws; g.jumpA = 0; g.jumpB = 0;
            switch (kind) {
            case K_FNA: g.lda = 384; g.ldb = FN1P; g.nt = 6; g.ksplit = 3; g.jumpB = (long)((size_t)1024 * PROWS * 2) - 384l; break;
            case K_FNB: g.lda = 256; g.ldb = 256; g.nt = 4; g.ksplit = 4; break;
            case K_BR:  g.lda = 1024; g.ldb = 1024; g.nt = 16; g.ksplit = 16; break;
            default:    g.lda = DM; g.ldb = DM; g.nt = 32; g.ksplit = 32; break;
            }
            SchedAny S{kind, G, bid}; EpiAny E{kind, p.ws, layer, p.x, p.meta};
            pg8::gemm_phase(lds, g, S, E);
            if (kind == K_BR) mini_branch(p); else if (kind == K_OUT) mini_out(p, layer);
        }
        else if (op == OP_P1) { phase_p1(p, layer, smem); }
        else if (op == OP_NA) { for (int u = bid; u < 4096; u += G) na_unit(p, layer, u >> 4, u & 15, smem); if (bid == G - 1) na_meta_unit(p, layer); }
        else if (op == OP_HYENA) { for (int ch = bid; ch < 1024; ch += G) hyena_unit(p, layer, ch, smem, (unsigned char*)p.out + (size_t)bid * HS_STRIDE); }
        else { for (int u = bid; u < 16 * 257; u += G) transpose_unit(p, u & 15, u >> 4, smem); }
    }
    phase_final(p);
}

extern "C" void kernel_launch(void* const* d_in, const int* in_sizes, int n_in, void* d_out, int out_size, void* d_ws, size_t ws_size, hipStream_t stream) {
    static int grid_blocks = 0;
    if (grid_blocks == 0) {
        if (n_in != 23 || ws_size < WS_END) { fprintf(stderr, "kernel_launch: need 23 inputs and %zu bytes of workspace (got %d, %zu)\n", (size_t)WS_END, n_in, ws_size); grid_blocks = -1; return; }
        int dev = 0, cus = 0, per_cu = 0;
        hipGetDevice(&dev); hipDeviceGetAttribute(&cus, hipDeviceAttributeMultiprocessorCount, dev);
        if (hipFuncSetAttribute((const void*)hybrid_fwd, hipFuncAttributeMaxDynamicSharedMemorySize, LDS_BYTES) != hipSuccess) { fprintf(stderr, "kernel_launch: hipFuncSetAttribute failed\n"); grid_blocks = -1; return; }
        hipOccupancyMaxActiveBlocksPerMultiprocessor(&per_cu, (const void*)hybrid_fwd, NTHREADS, LDS_BYTES);
        if (per_cu < 1) per_cu = 1;
        grid_blocks = cus * per_cu;
        if (grid_blocks > 256) grid_blocks = 256;
    }
    if (grid_blocks < 0) return;
    Params p{};
    const float** f = (const float**)&p;
    for (int i = 0; i < 23; ++i) f[i] = (const float*)d_in[i];
    p.out = (float*)d_out; p.ws = (unsigned char*)d_ws;
    void* args[] = {&p};
    hipError_t e = hipLaunchCooperativeKernel((const void*)hybrid_fwd, dim3(grid_blocks), dim3(NTHREADS), args, LDS_BYTES, stream);
    if (e != hipSuccess) fprintf(stderr, "cooperative launch failed: %s (grid %d)\n", hipGetErrorString(e), grid_blocks);
}
```

```cpp
#include <hip/hip_runtime.h>
#include <hip/hip_cooperative_groups.h>
#include <cstdio>
namespace cg = cooperative_groups;

#define LAS __attribute__((address_space(3)))
typedef unsigned short bf16_t;
typedef short bf16x8 __attribute__((ext_vector_type(8)));
typedef float f32x4 __attribute__((ext_vector_type(4)));
typedef unsigned u32x4 __attribute__((ext_vector_type(4)));
typedef unsigned u32x2 __attribute__((ext_vector_type(2)));

constexpr int L_TOK = 16400, LP = 16640, DM = 2048, NIN = 16384, NMETA = 16, NMAIN = 16384;
constexpr int FN1 = 164, FN2 = 100, FN1P = 192, PROWS = FN2 * FN1P;
constexpr int NTHREADS = 512, LDS_BYTES = 155648;

constexpr size_t SZ_H = (size_t)LP * DM * 4, SZ_XN = (size_t)LP * DM * 2, SZ_XNP = (size_t)PROWS * DM * 2;
constexpr size_t OFF_H = 0;
constexpr size_t OFF_XN = OFF_H + SZ_H;
constexpr size_t OFF_XNP = OFF_XN + SZ_XN;
constexpr size_t OFF_A1 = OFF_XN;
constexpr size_t SZ_A1 = (size_t)FN1 * 1024 * 2 * 128 * 2;
constexpr size_t OFF_HYOUT = OFF_A1 + SZ_A1;
constexpr size_t SZ_HYOUT = (size_t)1024 * LP * 2;
static_assert(OFF_HYOUT + SZ_HYOUT <= OFF_XNP + SZ_XNP, "alias overflow");
constexpr size_t OFF_WT = OFF_XNP + SZ_XNP;
constexpr size_t OFF_WEFF = OFF_WT + (size_t)NIN * DM * 2;
constexpr size_t OFF_WA = OFF_WEFF + (size_t)2048 * 2048 * 2;
constexpr size_t SZ_WBR = (size_t)2048 * 1024 * 2;
constexpr size_t OFF_WO = OFF_WA + 3 * SZ_WBR;
constexpr size_t OFF_HYIN = OFF_WO + (size_t)2048 * 2048 * 2;
constexpr size_t OFF_GATE = OFF_HYIN + (size_t)3072 * LP * 2;
constexpr size_t SZ_GATE = (size_t)LP * 1024 * 2;
constexpr size_t OFF_QKV = OFF_GATE + 3 * SZ_GATE;
constexpr size_t OFF_MERGE = OFF_QKV + (size_t)LP * 3072 * 2;
constexpr size_t OFF_ZT = OFF_MERGE + (size_t)LP * 6144 * 2;
constexpr size_t SZ_ZT = (size_t)2048 * PROWS * 2;
constexpr size_t OFF_M = OFF_ZT;
static_assert(SZ_XN <= SZ_ZT, "alias overflow");
constexpr size_t OFF_FA = OFF_ZT + SZ_ZT;
constexpr size_t OFF_FB = OFF_FA + (size_t)512 * 384 * 2;
constexpr size_t OFF_H3 = OFF_FB + (size_t)FN1 * 256 * 256 * 2;
constexpr size_t WS_END = OFF_H3 + (size_t)2 * L_TOK * 64 * 4;
constexpr size_t HS_HEO = 0, HS_CORR = 131328, HS_Z2 = HS_CORR + 65536, HS_G2F = HS_Z2 + 65792, HS_G2B = HS_G2F + 65792, HS_STRIDE = HS_G2B + 65792;
static_assert(HS_STRIDE * 256 <= (size_t)NMAIN * DM * 4, "scratch overflow");

struct Params {
    const float* x; const float* meta; const float* norm_g; const float* w_in; const float* conv_w; const float* conv_b;
    const float* f_w1; const float* f_b1; const float* f_w2; const float* f_b2; const float* f_w3; const float* f_b3; const float* f_w4;
    const float* f_freq; const float* decay; const float* skip; const float* rpb; const float* meta_bias;
    const float* w_a; const float* w_b; const float* w_c; const float* w_out; const float* final_g;
    float* out; unsigned char* ws;
};

__device__ __forceinline__ int opaque_tid() { int t = threadIdx.x; asm volatile("" : "+v"(t)); return t; }
__device__ __forceinline__ float bf2f(bf16_t b) { return __uint_as_float(((unsigned)b) << 16); }
__device__ __forceinline__ bf16_t f2bf(float f) { unsigned u = __float_as_uint(f); u += 0x7FFFu + ((u >> 16) & 1u); return (bf16_t)(u >> 16); }
__device__ __forceinline__ unsigned cvt_pk_bf16(float lo, float hi) { unsigned r; asm volatile("v_cvt_pk_bf16_f32 %0, %1, %2" : "=v"(r) : "v"(lo), "v"(hi)); return r; }
__device__ __forceinline__ float lo_bf(unsigned u) { return __uint_as_float(u << 16); }
__device__ __forceinline__ float hi_bf(unsigned u) { return __uint_as_float(u & 0xffff0000u); }
__device__ __forceinline__ float silu_f(float v) { return v * __builtin_amdgcn_rcpf(1.0f + __expf(-v)); }
__device__ __forceinline__ float sigm_f(float v) { return __builtin_amdgcn_rcpf(1.0f + __expf(-v)); }
__device__ __forceinline__ float wave_sum(float v) {
#pragma unroll
    for (int o = 32; o >= 1; o >>= 1) v += __shfl_xor(v, o);
    return v;
}

namespace pg8 {
constexpr int BM = 256, BK = 64, HALF = 128, HTB = HALF * BK * 2, STAGE_BYTES = 8 * HTB;
__device__ __forceinline__ int lds_byte(int r, int c) { const int st = (r >> 4) * 2 + (c >> 5), rr = r & 15, cc = c & 31, ob = rr * 64 + cc * 2; return st * 1024 + (ob ^ (((ob >> 9) & 1) << 5)); }
__device__ __forceinline__ void stage_rc(int b, int& R, int& C) { const int st = b / 1024, sb = b % 1024, swz = sb ^ (((sb >> 9) & 1) << 5); R = (st >> 1) * 16 + swz / 64; C = (st & 1) * 32 + (swz % 64) / 2; }
__device__ __forceinline__ int perm32(int rho) { const int n = rho >> 4, i = rho & 15; return 8 * (i >> 2) + 4 * n + (i & 3); }

struct Unit { int pm, pn, aux; size_t offA, offB; };
struct Gemm { const char* base; int lda, ldb, nt, ksplit; long jumpA, jumpB; };

__device__ __forceinline__ void tile_map(int wgid, int nM, int nN, int& pm, int& pn) {
    const int nwg = nM * nN;
    { const int q = nwg / 8, r = nwg % 8, xcd = wgid % 8, off = wgid / 8; wgid = (xcd < r ? xcd * (q + 1) : r * (q + 1) + (xcd - r) * q) + off; }
    const int nig = 8 * nN, gid = wgid / nig, fm = gid * 8, gsz = (nM - fm) < 8 ? (nM - fm) : 8;
    pm = fm + ((wgid % nig) % gsz); pn = (wgid % nig) / gsz;
}

template <class Epi, class Sched>
__device__ __forceinline__ void gemm_phase(LAS unsigned char* lds, const Gemm g, const Sched& S, const Epi& E) {
    const int tid = opaque_tid(), wid = __builtin_amdgcn_readfirstlane(tid >> 6), lane = tid & 63, wr = wid >> 2, wc = wid & 3, fr = lane & 15, fq = lane >> 4;
    const int nt = g.nt;
    unsigned voffA[2], voffB[2];
#pragma unroll
    for (int i = 0; i < 2; ++i) { int R, C; stage_rc(tid * 16 + i * 8192, R, C); const int Rb = (R & ~31) + perm32(R & 31);
        voffA[i] = (unsigned)(R * g.lda + C) * 2u; voffB[i] = (unsigned)(Rb * g.ldb + C) * 2u; }
    const size_t kstep = (size_t)(BK * 2);
    const size_t hstepA = (size_t)HALF * g.lda * 2, hstepB = (size_t)HALF * g.ldb * 2;
    const unsigned ldsw = (unsigned)wid * 1024u;
    const int aoff = lds_byte(wr * 64 + fr, fq * 8), boff = lds_byte(wc * 32 + fr, fq * 8);
#define PG8_KA(p, t) ((p) + (size_t)(t) * kstep + ((t) >= g.ksplit ? g.jumpA : 0l))
#define PG8_KB(p, t) ((p) + (size_t)(t) * kstep + ((t) >= g.ksplit ? g.jumpB : 0l))
#define PG8_SA(b, h) (((b) * 2 + (h)) * HTB)
#define PG8_SB(b, h) ((4 + (b) * 2 + (h)) * HTB)
#define PG8_STAGE(bufoff, gbase, voff) do { _Pragma("unroll") for (int _i = 0; _i < 2; ++_i) \
        __builtin_amdgcn_global_load_lds((const unsigned*)((const char*)(gbase) + (voff)[_i]), (LAS unsigned*)(lds + (bufoff) + ldsw + _i * 8192), 16, 0, 0); } while (0)
#define PG8_LDA(dst, b, h) do { _Pragma("unroll") for (int m = 0; m < 4; ++m) _Pragma("unroll") for (int k = 0; k < 2; ++k) dst[m][k] = *(const LAS bf16x8*)(lds + PG8_SA(b, h) + aoff + m * 2048 + k * 1024); } while (0)
#define PG8_LDB(dst, b, h) do { _Pragma("unroll") for (int n = 0; n < 2; ++n) _Pragma("unroll") for (int k = 0; k < 2; ++k) dst[n][k] = *(const LAS bf16x8*)(lds + PG8_SB(b, h) + boff + n * 2048 + k * 1024); } while (0)
#define PG8_MMA(ai, bj, At, Bt) do { __builtin_amdgcn_s_setprio(1); _Pragma("unroll") for (int m = 0; m < 4; ++m) _Pragma("unroll") for (int n = 0; n < 2; ++n) _Pragma("unroll") for (int k = 0; k < 2; ++k) \
        acc[ai][bj][m][n] = __builtin_amdgcn_mfma_f32_16x16x32_bf16(Bt[n][k], At[m][k], acc[ai][bj][m][n], 0, 0, 0); __builtin_amdgcn_s_setprio(0); } while (0)
#define PG8_WAIT_V(n) asm volatile("s_waitcnt vmcnt(" #n ")" ::: "memory")
#define PG8_WAIT_L(n) asm volatile("s_waitcnt lgkmcnt(" #n ")" ::: "memory")
#define PG8_BAR __builtin_amdgcn_s_barrier()
#define PG8_SCHED __builtin_amdgcn_sched_barrier(0)
    Unit cur, nxt; int ui = 0;
    if (!S.next(0, cur)) return;
    f32x4 acc[2][2][4][2];
#pragma unroll
    for (int a = 0; a < 2; ++a)
#pragma unroll
        for (int b = 0; b < 2; ++b)
#pragma unroll
            for (int m = 0; m < 4; ++m)
#pragma unroll
                for (int n = 0; n < 2; ++n) acc[a][b][m][n] = (f32x4){0.f, 0.f, 0.f, 0.f};
    bf16x8 At[4][2], B0[2][2], B1[2][2];
    const char* cA = g.base + cur.offA; const char* cB = g.base + cur.offB;
    PG8_STAGE(PG8_SB(0, 0), cB, voffB); PG8_STAGE(PG8_SA(0, 0), cA, voffA); PG8_STAGE(PG8_SB(0, 1), cB + hstepB, voffB); PG8_STAGE(PG8_SA(0, 1), cA + hstepA, voffA);
    if (wr == 1) PG8_BAR;
    PG8_WAIT_V(4); PG8_BAR;
    PG8_STAGE(PG8_SB(1, 0), PG8_KB(cB, 1), voffB); PG8_STAGE(PG8_SA(1, 0), PG8_KA(cA, 1), voffA); PG8_STAGE(PG8_SB(1, 1), PG8_KB(cB, 1) + hstepB, voffB);
    PG8_WAIT_V(6); PG8_BAR;
    for (;;) {
        const bool has_next = S.next(ui + 1, nxt);
        const char* nA = has_next ? g.base + nxt.offA : cA; const char* nB = has_next ? g.base + nxt.offB : cB;
        for (int t = 0; t < nt; t += 2) {
            const bool last = (t == nt - 2);
            const char* a1 = PG8_KA(cA, t + 1);
            const char* a2 = last ? nA : PG8_KA(cA, t + 2); const char* b2 = last ? nB : PG8_KB(cB, t + 2);
            const char* a3 = last ? PG8_KA(nA, 1) : PG8_KA(cA, t + 3); const char* b3 = last ? PG8_KB(nB, 1) : PG8_KB(cB, t + 3);
            PG8_LDB(B0, 0, 0); PG8_SCHED; PG8_LDA(At, 0, 0); PG8_STAGE(PG8_SA(1, 1), a1 + hstepA, voffA);
            PG8_WAIT_L(8); PG8_BAR; PG8_WAIT_L(0); PG8_MMA(0, 0, At, B0); PG8_BAR; PG8_SCHED;
            PG8_LDB(B1, 0, 1); PG8_STAGE(PG8_SB(0, 0), b2, voffB);
            PG8_BAR; PG8_WAIT_L(0); PG8_MMA(0, 1, At, B1); PG8_BAR;
            PG8_LDA(At, 0, 1); PG8_STAGE(PG8_SA(0, 0), a2, voffA);
            PG8_BAR; PG8_WAIT_L(0); PG8_MMA(1, 0, At, B0); PG8_BAR; PG8_SCHED;
            PG8_STAGE(PG8_SB(0, 1), b2 + hstepB, voffB);
            PG8_WAIT_V(6); PG8_BAR; PG8_MMA(1, 1, At, B1); PG8_BAR;
            PG8_LDB(B0, 1, 0); PG8_SCHED; PG8_LDA(At, 1, 0); PG8_STAGE(PG8_SA(0, 1), a2 + hstepA, voffA);
            PG8_WAIT_L(8); PG8_BAR; PG8_WAIT_L(0); PG8_MMA(0, 0, At, B0); PG8_BAR; PG8_SCHED;
            PG8_LDB(B1, 1, 1); PG8_STAGE(PG8_SB(1, 0), b3, voffB);
            PG8_BAR; PG8_WAIT_L(0); PG8_MMA(0, 1, At, B1); PG8_BAR;
            PG8_LDA(At, 1, 1); PG8_STAGE(PG8_SA(1, 0), a3, voffA);
            PG8_BAR; PG8_WAIT_L(0); PG8_MMA(1, 0, At, B0); PG8_BAR; PG8_SCHED;
            PG8_STAGE(PG8_SB(1, 1), b3 + hstepB, voffB);
            PG8_WAIT_V(6); PG8_BAR; PG8_MMA(1, 1, At, B1); PG8_BAR;
        }
        E(acc, cur, wr, wc, fr, fq);
        if (!has_next) break;
#pragma unroll
        for (int a = 0; a < 2; ++a)
#pragma unroll
            for (int b = 0; b < 2; ++b)
#pragma unroll
                for (int m = 0; m < 4; ++m)
#pragma unroll
                    for (int n = 0; n < 2; ++n) acc[a][b][m][n] = (f32x4){0.f, 0.f, 0.f, 0.f};
        cur = nxt; cA = nA; cB = nB; ++ui;
    }
    PG8_WAIT_V(0);
    if (wr == 0) PG8_BAR;
    PG8_BAR;
#undef PG8_KA
#undef PG8_KB
#undef PG8_SA
#undef PG8_SB
#undef PG8_STAGE
#undef PG8_LDA
#undef PG8_LDB
#undef PG8_MMA
#undef PG8_WAIT_V
#undef PG8_WAIT_L
#undef PG8_BAR
#undef PG8_SCHED
}
}
using pg8::Unit; using pg8::Gemm;
#define ACC_T const f32x4 (&acc)[2][2][4][2]

enum { K_TOK = 0, K_HYIN = 1, K_F0 = 2, K_FNA = 3, K_FNB = 4, K_BR = 5, K_OUT = 6, K_IN = 7 };
struct SchedAny {
    int kind, G, c;
    __device__ __forceinline__ bool next(int i, Unit& u) const {
        const long Lx = (long)i * G + c;
        switch (kind) {
        case K_IN: {
            if (Lx < 3120) { int pn; pg8::tile_map((int)Lx, 65, 48, u.pm, pn); u.pn = pn < 4 ? 12 + pn : 16 + pn; u.aux = K_TOK;
                u.offA = OFF_XN + (size_t)u.pm * 256 * DM * 2; u.offB = OFF_WT + (size_t)u.pn * 256 * DM * 2; return true; }
            if (Lx < 3900) { pg8::tile_map((int)Lx - 3120, 12, 65, u.pm, u.pn); u.aux = K_HYIN;
                u.offA = OFF_WT + (size_t)u.pm * 256 * DM * 2; u.offB = OFF_XN + (size_t)u.pn * 256 * DM * 2; return true; }
            if (Lx < 4500) { pg8::tile_map((int)Lx - 3900, 8, 75, u.pm, u.pn); u.aux = K_F0;
                u.offA = OFF_WEFF + (size_t)u.pm * 256 * DM * 2; u.offB = OFF_XNP + (size_t)u.pn * 256 * DM * 2; return true; }
            return false; }
        case K_TOK: {
            if (Lx >= 65l * 48) return false; int pn; pg8::tile_map((int)Lx, 65, 48, u.pm, pn); u.pn = pn < 4 ? 12 + pn : 16 + pn; u.aux = 0;
            u.offA = OFF_XN + (size_t)u.pm * 256 * DM * 2; u.offB = OFF_WT + (size_t)u.pn * 256 * DM * 2; return true; }
        case K_HYIN: {
            if (Lx >= 12l * 65) return false; pg8::tile_map((int)Lx, 12, 65, u.pm, u.pn); u.aux = 0;
            u.offA = OFF_WT + (size_t)u.pm * 256 * DM * 2; u.offB = OFF_XN + (size_t)u.pn * 256 * DM * 2; return true; }
        case K_F0: {
            if (Lx >= 8l * 75) return false; pg8::tile_map((int)Lx, 8, 75, u.pm, u.pn); u.aux = 0;
            u.offA = OFF_WEFF + (size_t)u.pm * 256 * DM * 2; u.offB = OFF_XNP + (size_t)u.pn * 256 * DM * 2; return true; }
        case K_FNA: {
            if (Lx >= 2l * 400) return false; pg8::tile_map((int)Lx, 2, 400, u.pm, u.pn); u.aux = 0;
            u.offA = OFF_FA + (size_t)u.pm * 256 * 384 * 2; u.offB = OFF_ZT + (size_t)u.pn * 256 * FN1P * 2; return true; }
        case K_FNB: {
            if (Lx >= 164l * 4) return false; u.aux = (int)(Lx >> 2); u.pm = 0; u.pn = (int)(Lx & 3);
            u.offA = OFF_FB + (size_t)u.aux * 256 * 256 * 2; u.offB = OFF_A1 + (size_t)u.aux * 1024 * 256 * 2 + (size_t)u.pn * 256 * 256 * 2; return true; }
        case K_BR: {
            const int T = (i / 3) * G + c; if (T >= 64 * 8) return false; const int br = i % 3; pg8::tile_map(T, 64, 8, u.pm, u.pn); u.aux = br;
            u.offA = OFF_GATE + (size_t)br * SZ_GATE + (size_t)u.pm * 256 * 1024 * 2; u.offB = OFF_WA + (size_t)br * SZ_WBR + (size_t)u.pn * 256 * 1024 * 2; return true; }
        default: {
            if (Lx >= 64l * 8) return false; pg8::tile_map((int)Lx, 64, 8, u.pm, u.pn); u.aux = 0;
            u.offA = OFF_M + (size_t)u.pm * 256 * DM * 2; u.offB = OFF_WO + (size_t)u.pn * 256 * DM * 2; return true; }
        }
    }
};
#define ROWFENCE asm volatile("" ::: "memory")
#define HARDFENCE do { asm volatile("" ::: "memory"); __builtin_amdgcn_sched_barrier(0); } while (0)
struct EpiAny {
    int kind; unsigned char* ws; int layer; const float* xin; const float* metain;
    __device__ __forceinline__ void operator()(ACC_T, const Unit& u, int wr, int wc, int fr, int fq) const {
        const int rl0 = wr * 64 + fr, cl0 = wc * 32 + 8 * fq;
        const int ek = kind == K_IN ? u.aux : kind;
        if (ek == K_TOK) {
            const int t = u.pn; unsigned char* dst; unsigned ld; int c0, act;
            if (t < 16)      { dst = ws + OFF_GATE;               ld = 1024; c0 = (t - 12) * 256; act = 1; }
            else if (t < 24) { dst = ws + OFF_GATE + SZ_GATE;     ld = 1024; c0 = (t - 20) * 256; act = 1; }
            else if (t < 36) { dst = ws + OFF_QKV;                ld = 3072; c0 = (t - 24) * 256; act = 0; }
            else if (t < 40) { dst = ws + OFF_GATE + 2 * SZ_GATE; ld = 1024; c0 = (t - 36) * 256; act = 1; }
            else             { dst = ws + OFF_MERGE;              ld = 6144; c0 = (t - 40) * 256; act = 2; }
#pragma unroll
            for (int ai = 0; ai < 2; ++ai)
#pragma unroll
                for (int m = 0; m < 4; ++m) { const unsigned row = (unsigned)(u.pm * 256 + ai * 128 + m * 16 + rl0);
#pragma unroll
                    for (int bj = 0; bj < 2; ++bj) { const unsigned off = (row * ld + (unsigned)(c0 + bj * 128 + cl0)) * 2u; f32x4 v0 = acc[ai][bj][m][0], v1 = acc[ai][bj][m][1];
                        if (act == 1) {
#pragma unroll
                            for (int j = 0; j < 4; ++j) { v0[j] = silu_f(v0[j]); v1[j] = silu_f(v1[j]); } }
                        else if (act == 2) {
#pragma unroll
                            for (int j = 0; j < 4; ++j) { v0[j] = sigm_f(v0[j]); v1[j] = sigm_f(v1[j]); } }
                        u32x4 w; w.x = cvt_pk_bf16(v0[0], v0[1]); w.y = cvt_pk_bf16(v0[2], v0[3]); w.z = cvt_pk_bf16(v1[0], v1[1]); w.w = cvt_pk_bf16(v1[2], v1[3]);
                        *(u32x4*)(dst + off) = w; }
                    ROWFENCE; }
        } else if (ek == K_HYIN || ek == K_F0) {
            unsigned char* dst = ws + (ek == K_HYIN ? OFF_HYIN : OFF_ZT); const unsigned ld = ek == K_HYIN ? LP : PROWS;
#pragma unroll
            for (int ai = 0; ai < 2; ++ai)
#pragma unroll
                for (int m = 0; m < 4; ++m) { const unsigned row = (unsigned)(u.pm * 256 + ai * 128 + m * 16 + rl0);
#pragma unroll
                    for (int bj = 0; bj < 2; ++bj) { const unsigned off = (row * ld + (unsigned)(u.pn * 256 + bj * 128 + cl0)) * 2u; const f32x4 v0 = acc[ai][bj][m][0], v1 = acc[ai][bj][m][1];
                        u32x4 w; w.x = cvt_pk_bf16(v0[0], v0[1]); w.y = cvt_pk_bf16(v0[2], v0[3]); w.z = cvt_pk_bf16(v1[0], v1[1]); w.w = cvt_pk_bf16(v1[2], v1[3]);
                        *(u32x4*)(dst + off) = w; }
                    ROWFENCE; }
        } else if (ek == K_FNA) {
            unsigned char* dst = ws + OFF_A1;
#pragma unroll
            for (int ai = 0; ai < 2; ++ai)
#pragma unroll
                for (int m = 0; m < 4; ++m) { const int k1 = ai * 128 + m * 16 + rl0;
                    if (k1 < FN1) {
#pragma unroll
                        for (int bj = 0; bj < 2; ++bj)
#pragma unroll
                            for (int n = 0; n < 2; ++n) { const int col = u.pn * 256 + bj * 128 + cl0 + 4 * n; const int ch = col / FN2, l2 = col - ch * FN2; const f32x4 v = acc[ai][bj][m][n];
                                u32x2 w; w.x = cvt_pk_bf16(v[0], v[1]); w.y = cvt_pk_bf16(v[2], v[3]);
                                *(u32x2*)(dst + ((unsigned)((k1 * 1024 + ch) * 2 + u.pm) * 128u + (unsigned)l2) * 2u) = w; } }
                    ROWFENCE; }
        } else if (ek == K_FNB) {
            unsigned char* dst = ws + OFF_GATE + SZ_GATE; const float scale = 1.0f / sqrtf((float)L_TOK * 256.0f);
#pragma unroll
            for (int ai = 0; ai < 2; ++ai)
#pragma unroll
                for (int m = 0; m < 4; ++m) { const int k2 = ai * 128 + m * 16 + rl0;
                    if (k2 < FN2) { const unsigned row = (unsigned)(u.aux + FN1 * k2);
#pragma unroll
                        for (int bj = 0; bj < 2; ++bj) { const unsigned off = (row * 1024u + (unsigned)(u.pn * 256 + bj * 128 + cl0)) * 2u; const u32x4 g = *(const u32x4*)(dst + off);
                            const f32x4 v0 = acc[ai][bj][m][0] * scale, v1 = acc[ai][bj][m][1] * scale;
                            u32x4 w; w.x = cvt_pk_bf16(v0[0] * lo_bf(g.x), v0[1] * hi_bf(g.x)); w.y = cvt_pk_bf16(v0[2] * lo_bf(g.y), v0[3] * hi_bf(g.y));
                            w.z = cvt_pk_bf16(v1[0] * lo_bf(g.z), v1[1] * hi_bf(g.z)); w.w = cvt_pk_bf16(v1[2] * lo_bf(g.w), v1[3] * hi_bf(g.w));
                            *(u32x4*)(dst + off) = w; } }
                    ROWFENCE; }
        } else if (ek == K_BR) {
            unsigned char* dst = ws + OFF_M; const unsigned char* mg = ws + OFF_MERGE; const int br = u.aux;
#pragma unroll
            for (int ai = 0; ai < 2; ++ai) { u32x4 gq[4][2], oq[4][2];
#pragma unroll
                for (int m = 0; m < 4; ++m) { const unsigned row = (unsigned)(u.pm * 256 + ai * 128 + m * 16 + rl0);
#pragma unroll
                    for (int bj = 0; bj < 2; ++bj) { const unsigned col = (unsigned)(u.pn * 256 + bj * 128 + cl0);
                        gq[m][bj] = *(const u32x4*)(mg + (row * 6144u + (unsigned)br * 2048u + col) * 2u);
                        if (br > 0) oq[m][bj] = *(const u32x4*)(dst + (row * (unsigned)DM + col) * 2u); else oq[m][bj] = (u32x4){0u, 0u, 0u, 0u}; } }
#pragma unroll
                for (int m = 0; m < 4; ++m) { const unsigned row = (unsigned)(u.pm * 256 + ai * 128 + m * 16 + rl0);
#pragma unroll
                    for (int bj = 0; bj < 2; ++bj) { const unsigned col = (unsigned)(u.pn * 256 + bj * 128 + cl0); const unsigned off = (row * (unsigned)DM + col) * 2u;
                        const u32x4 g = gq[m][bj], o = oq[m][bj]; const f32x4 v0 = acc[ai][bj][m][0], v1 = acc[ai][bj][m][1];
                        const float r0 = v0[0] * lo_bf(g.x) + lo_bf(o.x), r1 = v0[1] * hi_bf(g.x) + hi_bf(o.x), r2 = v0[2] * lo_bf(g.y) + lo_bf(o.y), r3 = v0[3] * hi_bf(g.y) + hi_bf(o.y);
                        const float r4 = v1[0] * lo_bf(g.z) + lo_bf(o.z), r5 = v1[1] * hi_bf(g.z) + hi_bf(o.z), r6 = v1[2] * lo_bf(g.w) + lo_bf(o.w), r7 = v1[3] * hi_bf(g.w) + hi_bf(o.w);
                        u32x4 w; w.x = cvt_pk_bf16(r0, r1); w.y = cvt_pk_bf16(r2, r3); w.z = cvt_pk_bf16(r4, r5); w.w = cvt_pk_bf16(r6, r7);
                        *(u32x4*)(dst + off) = w; } }
                ROWFENCE; }
        } else {
            unsigned char* dst = ws + OFF_H;
#pragma unroll
            for (int ai = 0; ai < 2; ++ai) { f32x4 oq[4][2][2];
#pragma unroll
                for (int m = 0; m < 4; ++m) { const unsigned row = (unsigned)(u.pm * 256 + ai * 128 + m * 16 + rl0);
                    const float* srow = layer == 0 ? (row < (unsigned)NMETA ? metain + (size_t)row * DM : xin + (size_t)(row - NMETA) * DM) : (const float*)(dst + (size_t)row * DM * 4);
#pragma unroll
                    for (int bj = 0; bj < 2; ++bj) { const unsigned col = (unsigned)(u.pn * 256 + bj * 128 + cl0); oq[m][bj][0] = *(const f32x4*)(srow + col); oq[m][bj][1] = *(const f32x4*)(srow + col + 4); } }
#pragma unroll
                for (int m = 0; m < 4; ++m) { const unsigned row = (unsigned)(u.pm * 256 + ai * 128 + m * 16 + rl0);
#pragma unroll
                    for (int bj = 0; bj < 2; ++bj) { const unsigned off = (row * (unsigned)DM + (unsigned)(u.pn * 256 + bj * 128 + cl0)) * 4u;
                        *(f32x4*)(dst + off) = oq[m][bj][0] + acc[ai][bj][m][0]; *(f32x4*)(dst + off + 16) = oq[m][bj][1] + acc[ai][bj][m][1]; } }
                ROWFENCE; }
        }
    }
};

__device__ void phase_prep0(const Params& p, unsigned char* smem) {
    const int tid = opaque_tid(), bid = blockIdx.x, G = gridDim.x;
    const size_t gtid = (size_t)bid * NTHREADS + tid, gstride = (size_t)G * NTHREADS;
    { bf16_t* fa = (bf16_t*)(p.ws + OFF_FA);
      for (size_t i = gtid; i < (size_t)512 * 384; i += gstride) { const int row = (int)(i / 384), col = (int)(i % 384); const int po = row >> 8, k1 = row & 255, pi = col / 192, l1 = col % 192; float v = 0.f;
          if (k1 < FN1 && l1 < FN1) { const int r = (k1 * l1) % FN1; const float a = 2.0f * (float)r / (float)FN1; const float cs = cospif(a), sn = sinpif(a);
              v = (po == 0) ? (pi == 0 ? cs : sn) : (pi == 0 ? -sn : cs); }
          fa[i] = f2bf(v); } }
    { bf16_t* fb = (bf16_t*)(p.ws + OFF_FB);
      for (size_t i = gtid; i < (size_t)FN1 * 65536; i += gstride) { const int k1 = (int)(i >> 16), k2 = (int)((i >> 8) & 255), kk = (int)(i & 255), part = kk >> 7, l2 = kk & 127; float v = 0.f;
          if (k2 < FN2 && l2 < FN2) { const int lp = k1 + FN1 * k2; const int r = (l2 * lp) % L_TOK; const float a = 2.0f * (float)r / (float)L_TOK; v = part == 0 ? cospif(a) : sinpif(a); }
          fb[i] = f2bf(v); } }
    { float* w1s = (float*)smem;
      float* w2s = w1s + 33 * 64;
      float* w3s = w2s + 64 * 64;
      const int lane = tid & 63, wv = tid >> 6;
      for (int layer = 0; layer < 2; ++layer) {
          __syncthreads();
          for (int i = tid; i < 33 * 64; i += NTHREADS) w1s[i] = p.f_w1[layer * 33 * 64 + i];
          for (int i = tid; i < 64 * 64; i += NTHREADS) { w2s[i] = p.f_w2[layer * 4096 + i]; w3s[i] = p.f_w3[layer * 4096 + i]; }
          __syncthreads();
          const float b1 = p.f_b1[layer * 64 + lane], b2 = p.f_b2[layer * 64 + lane], b3 = p.f_b3[layer * 64 + lane], fr = p.f_freq[layer * 64 + lane];
          bf16_t* h3 = (bf16_t*)(p.ws + OFF_H3) + (size_t)layer * L_TOK * 64;
          for (int lag = bid * 8 + wv; lag < L_TOK; lag += G * 8) {
              const float tt = (float)lag / (float)(L_TOK - 1); const float w = 6.283185307179586f * (float)lag / (float)L_TOK;
              float z = 0.f;
              if (lane == 0) z = tt;
              else if (lane < 33) { const int j = (lane - 1) & 15; const float f = 1e-4f + (float)j * ((15.0f - 1e-4f) / 15.0f); const float a = f * w; z = lane < 17 ? cosf(a) : -sinf(a); }
              float a1 = b1;
#pragma unroll 3
              for (int i = 0; i < 33; ++i) a1 += __shfl(z, i) * w1s[i * 64 + lane];
              const float h1 = sinf(fr * a1);
              float a2 = b2;
#pragma unroll 8
              for (int i = 0; i < 64; ++i) a2 += __shfl(h1, i) * w2s[i * 64 + lane];
              const float h2 = sinf(fr * a2);
              float a3 = b3;
#pragma unroll 8
              for (int i = 0; i < 64; ++i) a3 += __shfl(h2, i) * w3s[i * 64 + lane];
              h3[(size_t)lag * 64 + lane] = f2bf(sinf(fr * a3));
          }
      }
      __syncthreads(); }
}

__device__ __forceinline__ void convert_tile(const float* src, int K, int N, bf16_t* dst, int kt, int nt_, float* tile  ) {
    const int tid = opaque_tid();
    __syncthreads();
#pragma unroll
    for (int ps = 0; ps < 2; ++ps) { const int kl = ps * 32 + (tid >> 4), n4 = (tid & 15) * 4;
        const f32x4 v = *(const f32x4*)(src + (size_t)(kt * 64 + kl) * N + nt_ * 64 + n4);
        tile[kl * 65 + n4] = v[0]; tile[kl * 65 + n4 + 1] = v[1]; tile[kl * 65 + n4 + 2] = v[2]; tile[kl * 65 + n4 + 3] = v[3]; }
    __syncthreads();
    const int nl = tid >> 3, k8 = (tid & 7) * 8;
    u32x4 w; w.x = cvt_pk_bf16(tile[(k8 + 0) * 65 + nl], tile[(k8 + 1) * 65 + nl]); w.y = cvt_pk_bf16(tile[(k8 + 2) * 65 + nl], tile[(k8 + 3) * 65 + nl]);
    w.z = cvt_pk_bf16(tile[(k8 + 4) * 65 + nl], tile[(k8 + 5) * 65 + nl]); w.w = cvt_pk_bf16(tile[(k8 + 6) * 65 + nl], tile[(k8 + 7) * 65 + nl]);
    *(u32x4*)(dst + (size_t)(nt_ * 64 + nl) * K + kt * 64 + k8) = w;
}

__device__ void phase_p1(const Params& p, int layer, unsigned char* smem) {
    const int tid = opaque_tid(), bid = blockIdx.x, G = gridDim.x;
    float* tile = (float*)smem;
    { const float* win = p.w_in + (size_t)layer * DM * NIN;
      for (int t = bid; t < 32 * 256; t += G) convert_tile(win, DM, NIN, (bf16_t*)(p.ws + OFF_WT), t & 31, t >> 5, tile);
      for (int br = 0; br < 3; ++br) { const float* wsrc = (br == 0 ? p.w_a : br == 1 ? p.w_b : p.w_c) + (size_t)layer * 1024 * DM;
          for (int t = bid; t < 16 * 32; t += G) convert_tile(wsrc, 1024, DM, (bf16_t*)(p.ws + OFF_WA + br * SZ_WBR), t & 15, t >> 4, tile); }
      const float* wo = p.w_out + (size_t)layer * DM * DM;
      for (int t = bid; t < 32 * 32; t += G) convert_tile(wo, DM, DM, (bf16_t*)(p.ws + OFF_WO), t & 31, t >> 5, tile);
      __syncthreads(); }
    { float* tileT = (float*)smem;
      float* ctab = tileT + 256 * 32;
      float* stab = ctab + 256;
      const float* win = p.w_in + (size_t)layer * DM * NIN;
      for (int t = bid; t < 256; t += G) { const int g = t >> 6, k0 = (t & 63) * 32;
          __syncthreads();
          if (tid < 256) { const float a = 2.0f * (float)tid / 256.0f; ctab[tid] = cospif(a); stab[tid] = sinpif(a); }
#pragma unroll
          for (int ps = 0; ps < 4; ++ps) { const int idx = ps * NTHREADS + tid; const int kl = idx >> 6, c4 = (idx & 63) * 4;
              const f32x4 v = *(const f32x4*)(win + (size_t)(k0 + kl) * NIN + 4096 + g * 256 + c4);
              tileT[(c4 + 0) * 32 + kl] = v[0]; tileT[(c4 + 1) * 32 + kl] = v[1]; tileT[(c4 + 2) * 32 + kl] = v[2]; tileT[(c4 + 3) * 32 + kl] = v[3]; }
          __syncthreads();
          const int cp = tid & 255, part = tid >> 8;
          float acc[32];
#pragma unroll
          for (int k = 0; k < 32; ++k) acc[k] = 0.f;
          for (int c = 0; c < 256; ++c) { const int r = (c * cp) & 255; const float tw = part == 0 ? ctab[r] : -stab[r];
#pragma unroll
              for (int k4 = 0; k4 < 8; ++k4) { const f32x4 v = *(const f32x4*)(tileT + c * 32 + k4 * 4); acc[k4 * 4 + 0] += v[0] * tw; acc[k4 * 4 + 1] += v[1] * tw; acc[k4 * 4 + 2] += v[2] * tw; acc[k4 * 4 + 3] += v[3] * tw; } }
          bf16_t* dst = (bf16_t*)(p.ws + OFF_WEFF) + (size_t)(part * 1024 + g * 256 + cp) * DM + k0;
#pragma unroll
          for (int k8 = 0; k8 < 4; ++k8) { u32x4 w; w.x = cvt_pk_bf16(acc[k8 * 8 + 0], acc[k8 * 8 + 1]); w.y = cvt_pk_bf16(acc[k8 * 8 + 2], acc[k8 * 8 + 3]); w.z = cvt_pk_bf16(acc[k8 * 8 + 4], acc[k8 * 8 + 5]); w.w = cvt_pk_bf16(acc[k8 * 8 + 6], acc[k8 * 8 + 7]);
              *(u32x4*)(dst + k8 * 8) = w; } }
      __syncthreads(); }
    { const int lane = tid & 63, wv = tid >> 6; const float* h = (const float*)(p.ws + OFF_H); const float* gam = p.norm_g + layer * DM;
      bf16_t* xn = (bf16_t*)(p.ws + OFF_XN); bf16_t* xnp = (bf16_t*)(p.ws + OFF_XNP);
      for (int l = bid * 8 + wv; l < LP; l += G * 8) {
          if (l < L_TOK) { const f32x4* row = (const f32x4*)(layer == 0 ? (l < NMETA ? p.meta + (size_t)l * DM : p.x + (size_t)(l - NMETA) * DM) : h + (size_t)l * DM); f32x4 v[8]; float ss = 0.f;
#pragma unroll
              for (int i = 0; i < 8; ++i) { v[i] = row[i * 64 + lane]; ss += v[i][0] * v[i][0] + v[i][1] * v[i][1] + v[i][2] * v[i][2] + v[i][3] * v[i][3]; }
              ss = wave_sum(ss); const float inv = rsqrtf(ss * (1.0f / DM) + 1e-6f);
              const int l1 = l / FN2, l2 = l - l1 * FN2; const size_t pr = (size_t)l2 * FN1P + l1;
#pragma unroll
              for (int i = 0; i < 8; ++i) { const f32x4 gg = ((const f32x4*)gam)[i * 64 + lane]; u32x2 w; w.x = cvt_pk_bf16(v[i][0] * inv * gg[0], v[i][1] * inv * gg[1]); w.y = cvt_pk_bf16(v[i][2] * inv * gg[2], v[i][3] * inv * gg[3]);
                  *(u32x2*)(xn + (size_t)l * DM + (i * 64 + lane) * 4) = w; *(u32x2*)(xnp + pr * DM + (i * 64 + lane) * 4) = w; } }
          else { const u32x2 z = (u32x2){0u, 0u};
#pragma unroll
              for (int i = 0; i < 8; ++i) *(u32x2*)(xn + (size_t)l * DM + (i * 64 + lane) * 4) = z; } }
      for (int idx = bid * 8 + wv; idx < FN2 * (FN1P - FN1); idx += G * 8) { const int l2 = idx / (FN1P - FN1), l1 = FN1 + idx % (FN1P - FN1); const size_t pr = (size_t)l2 * FN1P + l1; const u32x2 z = (u32x2){0u, 0u};
#pragma unroll
          for (int i = 0; i < 8; ++i) *(u32x2*)(xnp + pr * DM + (i * 64 + lane) * 4) = z; } }
}

__device__ void na_phase(const Params& p, int layer, unsigned char* smem) {
    const int tid = opaque_tid(), wv = tid >> 6, lane = tid & 63, l15 = lane & 15, quad = lane >> 4;
    const int G = gridDim.x;
    const bf16_t* qkv = (const bf16_t*)(p.ws + OFF_QKV);
    unsigned char* sK = smem;
    bf16_t* sVT = (bf16_t*)(smem + 76032);
    float* sRPB = (float*)(smem + 144640);
    float* sMB = (float*)(smem + 146512);
    const int cb = wv & 3, hf = wv >> 2, c = cb * 16 + l15;
    const int cu = cb == 0 ? 0 : (cb == 1 ? 8 : (cb == 2 ? 24 : 32)), cs = min(max(c - 8, 0), 48);
    u32x4 pk[8], pv[8], pmk = (u32x4){0u, 0u, 0u, 0u}, pmv = (u32x4){0u, 0u, 0u, 0u}; bf16x8 pq0, pq1; float prp = 0.f;
#define NA_LOADS(U) do { const int r_ = (U) >> 4, hd_ = (U) & 15, r0_ = min(max(r_ - 4, 0), 248); \
        _Pragma("unroll") for (int ps = 0; ps < 8; ++ps) { const int tok = ps * 64 + (tid >> 3), ch = tid & 7; const size_t g = (size_t)(NMETA + r0_ * 64 + tok) * 3072 + hd_ * 64 + ch * 8; \
            pk[ps] = *(const u32x4*)(qkv + g + 1024); pv[ps] = *(const u32x4*)(qkv + g + 2048); } \
        if (tid < 128) { const size_t g = (size_t)(tid >> 3) * 3072 + hd_ * 64 + (tid & 7) * 8; pmk = *(const u32x4*)(qkv + g + 1024); pmv = *(const u32x4*)(qkv + g + 2048); } \
        { const bf16_t* qp = qkv + (size_t)(NMETA + r_ * 64 + c) * 3072 + hd_ * 64 + quad * 8; pq0 = *(const bf16x8*)qp; pq1 = *(const bf16x8*)(qp + 32); } \
        if (tid < 465) prp = p.rpb[(size_t)(layer * 16 + hd_) * 465 + tid]; else if (tid >= 480 && tid < 496) prp = p.meta_bias[(layer * 16 + hd_) * 16 + tid - 480]; } while (0)
    int u = blockIdx.x;
    if (u < 4096) NA_LOADS(u);
    for (; u < 4096; u += G) {
        const int r = u >> 4, hd = u & 15, r0 = min(max(r - 4, 0), 248);
        __syncthreads();
#pragma unroll
        for (int ps = 0; ps < 8; ++ps) { const int tok = ps * 64 + (tid >> 3), ch = tid & 7; const u32x4 vv = pv[ps];
            *(u32x4*)(sK + tok * 144 + ch * 16) = pk[ps];
            bf16_t* vt = sVT + (ch * 8) * 536 + tok;
            vt[0] = (bf16_t)vv.x; vt[536] = (bf16_t)(vv.x >> 16); vt[2 * 536] = (bf16_t)vv.y; vt[3 * 536] = (bf16_t)(vv.y >> 16);
            vt[4 * 536] = (bf16_t)vv.z; vt[5 * 536] = (bf16_t)(vv.z >> 16); vt[6 * 536] = (bf16_t)vv.w; vt[7 * 536] = (bf16_t)(vv.w >> 16); }
        if (tid < 128) { const int tok = tid >> 3, ch = tid & 7; const u32x4 vv = pmv;
            *(u32x4*)(sK + (512 + tok) * 144 + ch * 16) = pmk;
            bf16_t* vt = sVT + (ch * 8) * 536 + 512 + tok;
            vt[0] = (bf16_t)vv.x; vt[536] = (bf16_t)(vv.x >> 16); vt[2 * 536] = (bf16_t)vv.y; vt[3 * 536] = (bf16_t)(vv.y >> 16);
            vt[4 * 536] = (bf16_t)vv.z; vt[5 * 536] = (bf16_t)(vv.z >> 16); vt[6 * 536] = (bf16_t)vv.w; vt[7 * 536] = (bf16_t)(vv.w >> 16); }
        if (tid < 465) sRPB[tid] = prp; else if (tid >= 480 && tid < 496) sMB[tid - 480] = prp;
        const bf16x8 bq0 = pq0, bq1 = pq1;
        { const int un = u + G; if (un < 4096) NA_LOADS(un); }
        __syncthreads();
        bf16_t* yc = (bf16_t*)(p.ws + OFF_GATE + 2 * SZ_GATE);
        float gatev[4][4];
        if (hf == 0) {
#pragma unroll
            for (int rr = 0; rr < 4; ++rr)
#pragma unroll
                for (int dt = 0; dt < 4; ++dt) gatev[rr][dt] = bf2f(yc[(size_t)(NMETA + r * 64 + cb * 16 + quad * 4 + rr) * 1024 + hd * 64 + l15 + dt * 16]); }
        float sc[9][4];
#pragma unroll
        for (int ti = 0; ti < 9; ++ti) { const int j = 4 * hf + (ti >> 1), tt = ti & 1; const int slot0 = ti < 8 ? j * 64 + cu + tt * 16 : 512;
            const unsigned char* kp = sK + (slot0 + l15) * 144 + quad * 16;
            const bf16x8 a0 = *(const bf16x8*)kp, a1 = *(const bf16x8*)(kp + 64);
            f32x4 acc = (f32x4){0.f, 0.f, 0.f, 0.f};
            acc = __builtin_amdgcn_mfma_f32_16x16x32_bf16(a0, bq0, acc, 0, 0, 0); acc = __builtin_amdgcn_mfma_f32_16x16x32_bf16(a1, bq1, acc, 0, 0, 0);
            if (ti < 8) { const float* rp = sRPB + (r0 + j - r + 7) * 31 + (15 - c);
#pragma unroll
                for (int rr = 0; rr < 4; ++rr) { const int kc = cu + tt * 16 + quad * 4 + rr; const bool ok = kc >= cs && kc < cs + 16; const int kcc = ok ? kc : cs;
                    sc[ti][rr] = ok ? acc[rr] * 0.125f + rp[kcc] : -1.0e30f; } }
            else {
#pragma unroll
                for (int rr = 0; rr < 4; ++rr) sc[ti][rr] = hf == 0 ? acc[rr] * 0.125f + sMB[quad * 4 + rr] : -1.0e30f; } }
        float mx = -1.0e30f;
#pragma unroll
        for (int ti = 0; ti < 9; ++ti)
#pragma unroll
            for (int rr = 0; rr < 4; ++rr) mx = fmaxf(mx, sc[ti][rr]);
        mx = fmaxf(mx, __shfl_xor(mx, 16)); mx = fmaxf(mx, __shfl_xor(mx, 32));
        float lsum = 0.f;
#pragma unroll
        for (int ti = 0; ti < 9; ++ti)
#pragma unroll
            for (int rr = 0; rr < 4; ++rr) { sc[ti][rr] = __expf(sc[ti][rr] - mx); lsum += sc[ti][rr]; }
        lsum += __shfl_xor(lsum, 16); lsum += __shfl_xor(lsum, 32);
        f32x4 oacc[4];
#pragma unroll
        for (int dt = 0; dt < 4; ++dt) oacc[dt] = (f32x4){0.f, 0.f, 0.f, 0.f};
#pragma unroll
        for (int ks = 0; ks < 5; ++ks) { const int tA = 2 * ks, tB = 2 * ks + 1;
            const int jA = 4 * hf + (tA >> 1); const int slotA = tA < 8 ? jA * 64 + cu + (tA & 1) * 16 : 512; const int slotB = ks < 4 ? (4 * hf + (tB >> 1)) * 64 + cu + 16 : 512;
            u32x4 pa; pa.x = cvt_pk_bf16(sc[tA][0], sc[tA][1]); pa.y = cvt_pk_bf16(sc[tA][2], sc[tA][3]);
            if (ks < 4) { pa.z = cvt_pk_bf16(sc[tA + 1 < 9 ? tA + 1 : 8][0], sc[tA + 1 < 9 ? tA + 1 : 8][1]); pa.w = cvt_pk_bf16(sc[tA + 1 < 9 ? tA + 1 : 8][2], sc[tA + 1 < 9 ? tA + 1 : 8][3]); } else { pa.z = 0u; pa.w = 0u; }
            const bf16x8 af = __builtin_bit_cast(bf16x8, pa);
#pragma unroll
            for (int dt = 0; dt < 4; ++dt) { const bf16_t* vr = sVT + (dt * 16 + l15) * 536 + quad * 4;
                const u32x2 lo = *(const u32x2*)(vr + slotA), hi = *(const u32x2*)(vr + slotB);
                const u32x4 bb = (u32x4){lo.x, lo.y, hi.x, hi.y};
                oacc[dt] = __builtin_amdgcn_mfma_f32_16x16x32_bf16(af, __builtin_bit_cast(bf16x8, bb), oacc[dt], 0, 0, 0); } }
        __syncthreads();
        float* part = (float*)smem + cb * 1056;
        if (hf == 1) {
#pragma unroll
            for (int dt = 0; dt < 4; ++dt)
#pragma unroll
                for (int rr = 0; rr < 4; ++rr) part[(quad * 4 + rr) * 64 + dt * 16 + l15] = oacc[dt][rr];
            if (quad == 0) { part[1024 + l15] = mx; part[1040 + l15] = lsum; } }
        __syncthreads();
        if (hf == 0) {
#pragma unroll
            for (int rr = 0; rr < 4; ++rr) { const int qy = quad * 4 + rr; const float m0 = __shfl(mx, qy), l0 = __shfl(lsum, qy); const float m1 = part[1024 + qy], l1 = part[1040 + qy];
                const float M = fmaxf(m0, m1), f0 = __expf(m0 - M), f1 = __expf(m1 - M); const float inv = 1.0f / (f0 * l0 + f1 * l1);
                bf16_t* gp = yc + (size_t)(NMETA + r * 64 + cb * 16 + qy) * 1024 + hd * 64 + l15;
#pragma unroll
                for (int dt = 0; dt < 4; ++dt) { const float o = (f0 * oacc[dt][rr] + f1 * part[qy * 64 + dt * 16 + l15]) * inv; gp[dt * 16] = f2bf(o * gatev[rr][dt]); } } }
    }
#undef NA_LOADS
}
__device__ void na_meta_unit(const Params& p, int layer) {
    const int tid = opaque_tid();
    if (tid < 256) { const int hd = tid >> 4, qi = tid & 15; const bf16_t* qkv = (const bf16_t*)(p.ws + OFF_QKV);
        float q[64];
        { const u32x4* qp = (const u32x4*)(qkv + (size_t)qi * 3072 + hd * 64);
#pragma unroll
          for (int i = 0; i < 8; ++i) { const u32x4 v = qp[i]; q[i * 8 + 0] = lo_bf(v.x) * 0.125f; q[i * 8 + 1] = hi_bf(v.x) * 0.125f; q[i * 8 + 2] = lo_bf(v.y) * 0.125f; q[i * 8 + 3] = hi_bf(v.y) * 0.125f;
              q[i * 8 + 4] = lo_bf(v.z) * 0.125f; q[i * 8 + 5] = hi_bf(v.z) * 0.125f; q[i * 8 + 6] = lo_bf(v.w) * 0.125f; q[i * 8 + 7] = hi_bf(v.w) * 0.125f; } }
        float o[64];
#pragma unroll
        for (int i = 0; i < 64; ++i) o[i] = 0.f;
        float mx = -3.0e38f, lsum = 0.f;
#pragma unroll 1
        for (int m = 0; m < 16; ++m) { const u32x4* kp = (const u32x4*)(qkv + (size_t)m * 3072 + 1024 + hd * 64); const u32x4* vp = (const u32x4*)(qkv + (size_t)m * 3072 + 2048 + hd * 64);
            float d0 = 0.f, d1 = 0.f;
#pragma unroll
            for (int e = 0; e < 8; ++e) { const u32x4 v = kp[e];
                d0 += q[e * 8 + 0] * lo_bf(v.x) + q[e * 8 + 2] * lo_bf(v.y) + q[e * 8 + 4] * lo_bf(v.z) + q[e * 8 + 6] * lo_bf(v.w);
                d1 += q[e * 8 + 1] * hi_bf(v.x) + q[e * 8 + 3] * hi_bf(v.y) + q[e * 8 + 5] * hi_bf(v.z) + q[e * 8 + 7] * hi_bf(v.w); }
            const float sc = d0 + d1 + p.meta_bias[(layer * 16 + hd) * 16 + m]; const float mnew = fmaxf(mx, sc); const float alpha = __expf(mx - mnew), pi = __expf(sc - mnew);
            lsum = lsum * alpha + pi; mx = mnew;
#pragma unroll
            for (int e = 0; e < 8; ++e) { const u32x4 v = vp[e];
                o[e * 8 + 0] = o[e * 8 + 0] * alpha + pi * lo_bf(v.x); o[e * 8 + 1] = o[e * 8 + 1] * alpha + pi * hi_bf(v.x); o[e * 8 + 2] = o[e * 8 + 2] * alpha + pi * lo_bf(v.y); o[e * 8 + 3] = o[e * 8 + 3] * alpha + pi * hi_bf(v.y);
                o[e * 8 + 4] = o[e * 8 + 4] * alpha + pi * lo_bf(v.z); o[e * 8 + 5] = o[e * 8 + 5] * alpha + pi * hi_bf(v.z); o[e * 8 + 6] = o[e * 8 + 6] * alpha + pi * lo_bf(v.w); o[e * 8 + 7] = o[e * 8 + 7] * alpha + pi * hi_bf(v.w); } }
        const float inv = 1.0f / lsum; u32x4* gp = (u32x4*)((bf16_t*)(p.ws + OFF_GATE + 2 * SZ_GATE) + (size_t)qi * 1024 + hd * 64);
#pragma unroll
        for (int e = 0; e < 8; ++e) { const u32x4 g = gp[e]; u32x4 w;
            w.x = cvt_pk_bf16(o[e * 8 + 0] * inv * lo_bf(g.x), o[e * 8 + 1] * inv * hi_bf(g.x)); w.y = cvt_pk_bf16(o[e * 8 + 2] * inv * lo_bf(g.y), o[e * 8 + 3] * inv * hi_bf(g.y));
            w.z = cvt_pk_bf16(o[e * 8 + 4] * inv * lo_bf(g.z), o[e * 8 + 5] * inv * hi_bf(g.z)); w.w = cvt_pk_bf16(o[e * 8 + 6] * inv * lo_bf(g.w), o[e * 8 + 7] * inv * hi_bf(g.w));
            gp[e] = w; } }
}

__device__ __forceinline__ unsigned rev4_14(unsigned k) { unsigned r = __brev(k) >> 18; return ((r & 0x1555u) << 1) | ((r >> 1) & 0x1555u); }
__device__ __forceinline__ float2 cmul(float2 a, float2 b) { return make_float2(a.x * b.x - a.y * b.y, a.x * b.y + a.y * b.x); }
#define PADI(i) ((i) + ((i) >> 4))
#define CFF(n) cff[2 * PADI((n) >> 1) + ((n) & 1)]
__device__ __forceinline__ void hw_sincos(float rev, float& sn, float& cs) { sn = __builtin_amdgcn_sinf(rev); cs = __builtin_amdgcn_cosf(rev); }
__device__ __forceinline__ float c16(int k) { const float t[10] = {1.0f, 0.9238795325f, 0.7071067812f, 0.3826834324f, 0.0f, -0.3826834324f, -0.7071067812f, -0.9238795325f, -1.0f, -0.9238795325f}; return t[k]; }
__device__ __forceinline__ float s16(int k) { const float t[10] = {0.0f, 0.3826834324f, 0.7071067812f, 0.9238795325f, 1.0f, 0.9238795325f, 0.7071067812f, 0.3826834324f, 0.0f, -0.3826834324f}; return t[k]; }
__device__ __forceinline__ float2 cadd(float2 a, float2 b) { return make_float2(a.x + b.x, a.y + b.y); }
__device__ __forceinline__ float2 csub(float2 a, float2 b) { return make_float2(a.x - b.x, a.y - b.y); }
template <int SGN> __device__ __forceinline__ void bf4(float2& a0, float2& a1, float2& a2, float2& a3) {
    const float2 t0 = cadd(a0, a2), t1 = csub(a0, a2), t2 = cadd(a1, a3), d = csub(a1, a3);
    const float2 t3 = SGN < 0 ? make_float2(d.y, -d.x) : make_float2(-d.y, d.x);
    a0 = cadd(t0, t2); a1 = cadd(t1, t3); a2 = csub(t0, t2); a3 = csub(t1, t3);
}
template <int S> __device__ __forceinline__ void r16_fwd_pass(float2* a) {
    constexpr int Q = S / 4;
    for (int u = opaque_tid(); u < 1024; u += NTHREADS) { const int j = u & (Q - 1); const int base = ((u - j) << 4) + j;
        float2 x[4][4];
#pragma unroll
        for (int aa = 0; aa < 4; ++aa)
#pragma unroll
            for (int bb = 0; bb < 4; ++bb) x[aa][bb] = a[PADI(base + aa * S + bb * Q)];
        float sn, cs; hw_sincos((float)j / (float)(4 * S), sn, cs); const float2 wb0 = make_float2(cs, -sn);
#pragma unroll
        for (int bb = 0; bb < 4; ++bb) { const float2 w1 = bb == 0 ? wb0 : cmul(wb0, make_float2(c16(bb), -s16(bb))); const float2 w2 = cmul(w1, w1), w3 = cmul(w2, w1);
            bf4<-1>(x[0][bb], x[1][bb], x[2][bb], x[3][bb]); x[1][bb] = cmul(x[1][bb], w1); x[2][bb] = cmul(x[2][bb], w2); x[3][bb] = cmul(x[3][bb], w3); }
        hw_sincos((float)j / (float)S, sn, cs); const float2 v1 = make_float2(cs, -sn), v2 = cmul(v1, v1), v3 = cmul(v2, v1);
#pragma unroll
        for (int aa = 0; aa < 4; ++aa) { bf4<-1>(x[aa][0], x[aa][1], x[aa][2], x[aa][3]); x[aa][1] = cmul(x[aa][1], v1); x[aa][2] = cmul(x[aa][2], v2); x[aa][3] = cmul(x[aa][3], v3); }
#pragma unroll
        for (int aa = 0; aa < 4; ++aa)
#pragma unroll
            for (int bb = 0; bb < 4; ++bb) a[PADI(base + aa * S + bb * Q)] = x[aa][bb]; }
    __syncthreads();
}
template <int S> __device__ __forceinline__ void r16_inv_pass(float2* a) {
    constexpr int Q = S / 4;
    for (int u = opaque_tid(); u < 1024; u += NTHREADS) { const int j = u & (Q - 1); const int base = ((u - j) << 4) + j;
        float2 x[4][4];
#pragma unroll
        for (int aa = 0; aa < 4; ++aa)
#pragma unroll
            for (int bb = 0; bb < 4; ++bb) x[aa][bb] = a[PADI(base + aa * S + bb * Q)];
        float sn, cs; hw_sincos((float)j / (float)S, sn, cs); const float2 v1 = make_float2(cs, sn), v2 = cmul(v1, v1), v3 = cmul(v2, v1);
#pragma unroll
        for (int aa = 0; aa < 4; ++aa) { x[aa][1] = cmul(x[aa][1], v1); x[aa][2] = cmul(x[aa][2], v2); x[aa][3] = cmul(x[aa][3], v3); bf4<1>(x[aa][0], x[aa][1], x[aa][2], x[aa][3]); }
        hw_sincos((float)j / (float)(4 * S), sn, cs); const float2 wb0 = make_float2(cs, sn);
#pragma unroll
        for (int bb = 0; bb < 4; ++bb) { const float2 w1 = bb == 0 ? wb0 : cmul(wb0, make_float2(c16(bb), s16(bb))); const float2 w2 = cmul(w1, w1), w3 = cmul(w2, w1);
            x[1][bb] = cmul(x[1][bb], w1); x[2][bb] = cmul(x[2][bb], w2); x[3][bb] = cmul(x[3][bb], w3); bf4<1>(x[0][bb], x[1][bb], x[2][bb], x[3][bb]); }
#pragma unroll
        for (int aa = 0; aa < 4; ++aa)
#pragma unroll
            for (int bb = 0; bb < 4; ++bb) a[PADI(base + aa * S + bb * Q)] = x[aa][bb]; }
    __syncthreads();
}
__device__ void fft_fwd(float2* a) {
    r16_fwd_pass<4096>(a);
    r16_fwd_pass<256>(a);
    { const int span = 16;
        for (int b = opaque_tid(); b < 4096; b += NTHREADS) { const int j = b & (span - 1); const int base = ((b - j) << 2) + j;
            const int i0 = PADI(base), i1 = PADI(base + span), i2 = PADI(base + 2 * span), i3 = PADI(base + 3 * span);
            float2 a0 = a[i0], a1 = a[i1], a2 = a[i2], a3 = a[i3];
            const float2 w1 = make_float2(c16(0) * 0.f + __builtin_amdgcn_cosf((float)j * (1.0f / 64.0f)), -__builtin_amdgcn_sinf((float)j * (1.0f / 64.0f))), w2 = cmul(w1, w1), w3 = cmul(w2, w1);
            bf4<-1>(a0, a1, a2, a3);
            a[i0] = a0; a[i1] = cmul(a1, w1); a[i2] = cmul(a2, w2); a[i3] = cmul(a3, w3); }
        __syncthreads(); }
    for (int blk = opaque_tid(); blk < 1024; blk += NTHREADS) { float2* pb = a + blk * 17; float2 x[16];
#pragma unroll
        for (int e = 0; e < 16; ++e) x[e] = pb[e];
#pragma unroll
        for (int j = 0; j < 4; ++j) { bf4<-1>(x[j], x[j + 4], x[j + 8], x[j + 12]);
            x[j + 4] = cmul(x[j + 4], make_float2(c16(j), -s16(j))); x[j + 8] = cmul(x[j + 8], make_float2(c16(2 * j), -s16(2 * j))); x[j + 12] = cmul(x[j + 12], make_float2(c16(3 * j), -s16(3 * j))); }
#pragma unroll
        for (int g = 0; g < 4; ++g) bf4<-1>(x[4 * g], x[4 * g + 1], x[4 * g + 2], x[4 * g + 3]);
#pragma unroll
        for (int e = 0; e < 16; ++e) pb[e] = x[e]; }
    __syncthreads();
}
__device__ void fft_inv(float2* a) {
    for (int blk = opaque_tid(); blk < 1024; blk += NTHREADS) { float2* pb = a + blk * 17; float2 x[16];
#pragma unroll
        for (int e = 0; e < 16; ++e) x[e] = pb[e];
#pragma unroll
        for (int g = 0; g < 4; ++g) bf4<1>(x[4 * g], x[4 * g + 1], x[4 * g + 2], x[4 * g + 3]);
#pragma unroll
        for (int j = 0; j < 4; ++j) { x[j + 4] = cmul(x[j + 4], make_float2(c16(j), s16(j))); x[j + 8] = cmul(x[j + 8], make_float2(c16(2 * j), s16(2 * j))); x[j + 12] = cmul(x[j + 12], make_float2(c16(3 * j), s16(3 * j)));
            bf4<1>(x[j], x[j + 4], x[j + 8], x[j + 12]); }
#pragma unroll
        for (int e = 0; e < 16; ++e) pb[e] = x[e]; }
    __syncthreads();
    { const int span = 16;
        for (int b = opaque_tid(); b < 4096; b += NTHREADS) { const int j = b & (span - 1); const int base = ((b - j) << 2) + j;
            const int i0 = PADI(base), i1 = PADI(base + span), i2 = PADI(base + 2 * span), i3 = PADI(base + 3 * span);
            const float2 w1 = make_float2(__builtin_amdgcn_cosf((float)j * (1.0f / 64.0f)), __builtin_amdgcn_sinf((float)j * (1.0f / 64.0f))), w2 = cmul(w1, w1), w3 = cmul(w2, w1);
            float2 a0 = a[i0], a1 = cmul(a[i1], w1), a2 = cmul(a[i2], w2), a3 = cmul(a[i3], w3);
            bf4<1>(a0, a1, a2, a3);
            a[i0] = a0; a[i1] = a1; a[i2] = a2; a[i3] = a3; }
        __syncthreads(); }
    r16_inv_pass<256>(a);
    r16_inv_pass<4096>(a);
}
__device__ __forceinline__ void hy_load8(const bf16_t* __restrict__ row, int t0, u32x4& v, float& xl, float& xh) {
    v = *(const u32x4*)(row + t0); xl = t0 > 0 ? bf2f(row[t0 - 1]) : 0.f; xh = (t0 + 8 < L_TOK) ? bf2f(row[t0 + 8]) : 0.f;
}
__device__ __forceinline__ void hy_calc8(const u32x4 v, float xl, float xh, const float (&w)[4], float (&o)[8]) {
    float x[10];
    x[0] = xl; x[9] = xh;
    x[1] = lo_bf(v.x); x[2] = hi_bf(v.x); x[3] = lo_bf(v.y); x[4] = hi_bf(v.y); x[5] = lo_bf(v.z); x[6] = hi_bf(v.z); x[7] = lo_bf(v.w); x[8] = hi_bf(v.w);
#pragma unroll
    for (int e = 0; e < 8; ++e) o[e] = w[0] * x[e] + w[1] * x[e + 1] + w[2] * x[e + 2] + w[3];
}
__device__ __forceinline__ void hy_val8(const bf16_t* __restrict__ row, int t0, const float (&w)[4], float (&o)[8]) { u32x4 v; float xl, xh; hy_load8(row, t0, v, xl, xh); hy_calc8(v, xl, xh, w, o); }
struct HyCh { const bf16_t* __restrict__ ru; const bf16_t* __restrict__ r1; const bf16_t* __restrict__ r2; float wu[4], w1[4], w2[4]; };

constexpr int SD_W4B = 0  , SD_GFX = 512, SD_GBX = 528, SD_EF = 544, SD_EB = 560, SD_VH = 576, SD_VT = 592, SD_END = 608;
constexpr int NCHUNK = L_TOK / 8;

template <int ORDER>
__device__ void hy_conv(const HyCh& hc, float2* cf, float* side, unsigned char* scratch) {
    const int tid = opaque_tid(); float* cff = (float*)cf;
    f32x4* __restrict__ heo = (f32x4*)(scratch + HS_HEO); const float* __restrict__ z2g = (const float*)(scratch + HS_Z2);
    if (tid < 15) side[SD_EF + tid] = CFF(16369 + tid); else if (tid >= 32 && tid < 47) side[SD_EB + tid - 32] = CFF(32768 - (16369 + tid - 32));
    __syncthreads();
    fft_fwd(cf);
    for (int k = tid; k <= 8192; k += NTHREADS) { const int kp = (16384 - k) & 16383; const float2 a = cf[PADI(rev4_14(k))], bq = cf[PADI(rev4_14(kp))];
        const float bx = bq.x, by = -bq.y; const float sc = 1.0f / 16384.0f;
        heo[k] = (f32x4){0.5f * (a.x + bx) * sc, 0.5f * (a.y + by) * sc, 0.5f * (a.y - by) * sc, -0.5f * (a.x - bx) * sc}; }
    __syncthreads();
    {
        u32x4 rv[4]; float rl[4], rh[4]; f32x4 z0[4], z1[4];
#pragma unroll
        for (int i = 0; i < 4; ++i) { const int c = tid + NTHREADS * i;
            if (ORDER == 0) hy_load8(hc.ru, 8 * c, rv[i], rl[i], rh[i]); else { z0[i] = *(const f32x4*)(z2g + 8 * c); z1[i] = *(const f32x4*)(z2g + 8 * c + 4); } }
#pragma unroll
        for (int i = 0; i < 4; ++i) { const int c = tid + NTHREADS * i; float v[8];
            if (ORDER == 0) hy_calc8(rv[i], rl[i], rh[i], hc.wu, v);
            else { v[0] = z0[i][0]; v[1] = z0[i][1]; v[2] = z0[i][2]; v[3] = z0[i][3]; v[4] = z1[i][0]; v[5] = z1[i][1]; v[6] = z1[i][2]; v[7] = z1[i][3]; }
            float2* d = cf + PADI(4 * c); d[0] = make_float2(v[0], v[1]); d[1] = make_float2(v[2], v[3]); d[2] = make_float2(v[4], v[5]); d[3] = make_float2(v[6], v[7]);
            if (i == 0 && tid < 2) {
#pragma unroll
                for (int e = 0; e < 8; ++e) side[SD_VH + 8 * tid + e] = v[e]; } }
        if (tid < 2) { const int c = NCHUNK - 2 + tid; float v[8];
            if (ORDER == 0) hy_val8(hc.ru, 8 * c, hc.wu, v);
            else { const f32x4 p0 = *(const f32x4*)(z2g + 8 * c), p1 = *(const f32x4*)(z2g + 8 * c + 4); v[0] = p0[0]; v[1] = p0[1]; v[2] = p0[2]; v[3] = p0[3]; v[4] = p1[0]; v[5] = p1[1]; v[6] = p1[2]; v[7] = p1[3]; }
            float2* d = cf + PADI(4 * c); d[0] = make_float2(v[0], v[1]); d[1] = make_float2(v[2], v[3]); d[2] = make_float2(v[4], v[5]); d[3] = make_float2(v[6], v[7]);
#pragma unroll
            for (int e = 0; e < 8; ++e) side[SD_VT + 8 * tid + e] = v[e]; } }
    for (int i = L_TOK / 2 + tid; i < 16384; i += NTHREADS) cf[PADI(i)] = make_float2(0.f, 0.f);
    __syncthreads();
    fft_fwd(cf);
#pragma unroll 4
    for (int k = tid; k <= 8192; k += NTHREADS) { const int kp = (16384 - k) & 16383; const unsigned ik = PADI(rev4_14(k)), ikp = PADI(rev4_14(kp)); const float2 a = cf[ik], bq = cf[ikp];
        const float bx = bq.x, by = -bq.y;
        const float2 XE = make_float2(0.5f * (a.x + bx), 0.5f * (a.y + by)), XO = make_float2(0.5f * (a.y - by), -0.5f * (a.x - bx));
        const f32x4 hh = heo[k]; const float2 HE = make_float2(hh[0], hh[1]), HO = make_float2(hh[2], hh[3]);
        float sn, cs; hw_sincos((float)k / 16384.0f, sn, cs); const float2 w = make_float2(cs, -sn);
        const float2 xoho = cmul(XO, HO), wx = cmul(w, xoho), xehe = cmul(XE, HE), xeho = cmul(XE, HO), xohe = cmul(XO, HE);
        const float2 YE = make_float2(xehe.x + wx.x, xehe.y + wx.y), YO = make_float2(xeho.x + xohe.x, xeho.y + xohe.y);
        cf[ik] = make_float2(YE.x - YO.y, YE.y + YO.x); cf[ikp] = make_float2(YE.x + YO.y, -YE.y + YO.x); }
    __syncthreads();
    fft_inv(cf);
    if (tid < 16) { const int t = tid; float d = 0.f;
        for (int s = t + 16384; s < L_TOK; ++s) { const int l = s - t; const float wrong = l == 16384 ? 0.f : side[SD_EF + 16399 - l]; d += (side[SD_GBX + l - 16384] - wrong) * side[SD_VT + s - 16384]; }
        CFF(t) += d; }
    else if (tid >= 32 && tid < 48) { const int t = 16384 + tid - 32; float d = 0.f;
        for (int s = 0; s <= t - 16384; ++s) { const int l = t - s; const float wrong = l == 16384 ? 0.f : side[SD_EB + 16399 - l]; d += (side[SD_GFX + l - 16384] - wrong) * side[SD_VH + s]; }
        CFF(t) += d; }
    __syncthreads();
}

__device__ void hyena_unit(const Params& p, int layer, int ch, unsigned char* smem, unsigned char* scratch) {
    const int tid = opaque_tid(); float2* cf = (float2*)smem; float* cff = (float*)smem; float* side = (float*)(smem + 139264);
    const bf16_t* hyin = (const bf16_t*)(p.ws + OFF_HYIN);
    HyCh hc; hc.ru = hyin + (size_t)ch * LP; hc.r1 = hyin + (size_t)(1024 + ch) * LP; hc.r2 = hyin + (size_t)(2048 + ch) * LP;
    { const float* cw = p.conv_w + (size_t)layer * 3 * 3072; const float* cb = p.conv_b + (size_t)layer * 3072;
#pragma unroll
      for (int jj = 0; jj < 3; ++jj) { hc.wu[jj] = cw[jj * 3072 + ch]; hc.w1[jj] = cw[jj * 3072 + 1024 + ch]; hc.w2[jj] = cw[jj * 3072 + 2048 + ch]; }
      hc.wu[3] = cb[ch]; hc.w1[3] = cb[1024 + ch]; hc.w2[3] = cb[2048 + ch]; }
    const float sk0 = p.skip[(layer * 2 + 0) * 1024 + ch], sk1 = p.skip[(layer * 2 + 1) * 1024 + ch];
    float* __restrict__ z2g = (float*)(scratch + HS_Z2); float* __restrict__ g2f = (float*)(scratch + HS_G2F); float* __restrict__ g2b = (float*)(scratch + HS_G2B);
    bf16_t* __restrict__ hyout = (bf16_t*)(p.ws + OFF_HYOUT) + (size_t)ch * LP;
    __syncthreads();
    { bf16_t* w4b = (bf16_t*)(side + SD_W4B);
      for (int i = tid; i < 16 * 64; i += NTHREADS) { const int n = i >> 6, k = i & 63; w4b[i] = n < 4 ? f2bf(p.f_w4[((size_t)layer * 64 + k) * 4096 + n * 1024 + ch]) : (bf16_t)0; }
      __syncthreads();
      const bf16_t* __restrict__ h3b = (const bf16_t*)(p.ws + OFF_H3) + (size_t)layer * L_TOK * 64;
      const int lane = tid & 63, wv = tid >> 6, col = lane & 15, quad = lane >> 4;
      const float dk = col < 4 ? fabsf(p.decay[((layer * 2 + (col >> 1)) * 2 + (col & 1)) * 1024 + ch]) * (1.4426950408889634f / (float)(L_TOK - 1)) : 0.f;
      const bf16x8 b0 = *(const bf16x8*)(w4b + col * 64 + quad * 8), b1 = *(const bf16x8*)(w4b + col * 64 + 32 + quad * 8);
      for (int gb = wv; gb < L_TOK / 16; gb += 64) {
          bf16x8 a0[8], a1[8];
#pragma unroll
          for (int i = 0; i < 8; ++i) { const int g = min(gb + 8 * i, L_TOK / 16 - 1); const bf16_t* hr = h3b + (size_t)(g * 16 + col) * 64 + quad * 8; a0[i] = *(const bf16x8*)hr; a1[i] = *(const bf16x8*)(hr + 32); }
#pragma unroll
          for (int i = 0; i < 8; ++i) { const int g = gb + 8 * i;
              if (g < L_TOK / 16) {
                  f32x4 acc = (f32x4){0.f, 0.f, 0.f, 0.f};
                  acc = __builtin_amdgcn_mfma_f32_16x16x32_bf16(a0[i], b0, acc, 0, 0, 0); acc = __builtin_amdgcn_mfma_f32_16x16x32_bf16(a1[i], b1, acc, 0, 0, 0);
                  if (col < 4) { const int lag0 = g * 16 + quad * 4; float v[4];
#pragma unroll
                      for (int r = 0; r < 4; ++r) v[r] = acc[r] * __builtin_amdgcn_exp2f(-(float)(lag0 + r) * dk);
                      if (col == 2) *(f32x4*)(g2f + lag0) = (f32x4){v[0], v[1], v[2], v[3]};
                      else if (col == 3) *(f32x4*)(g2b + lag0) = (f32x4){v[0], v[1], v[2], v[3]};
                      else if (col == 0) { if (lag0 < NMAIN) { float2* d = cf + PADI(lag0 >> 1); d[0] = make_float2(v[0], v[1]); d[1] = make_float2(v[2], v[3]); }
                                           else { side[SD_GFX + lag0 - NMAIN] = v[0]; side[SD_GFX + lag0 - NMAIN + 1] = v[1]; side[SD_GFX + lag0 - NMAIN + 2] = v[2]; side[SD_GFX + lag0 - NMAIN + 3] = v[3]; } }
                      else { if (lag0 < NMAIN) {
#pragma unroll
                                 for (int r = 0; r < 4; ++r) if (lag0 + r >= 1) CFF(32768 - lag0 - r) = v[r]; }
                             else { side[SD_GBX + lag0 - NMAIN] = v[0]; side[SD_GBX + lag0 - NMAIN + 1] = v[1]; side[SD_GBX + lag0 - NMAIN + 2] = v[2]; side[SD_GBX + lag0 - NMAIN + 3] = v[3]; } } } } } }
      if (tid == 0) CFF(NMAIN) = 0.f;
      __syncthreads(); }
    hy_conv<0>(hc, cf, side, scratch);
    {   u32x4 ru_[4], r1_[4]; float ul[4], uh[4], xl[4], xh[4];
#pragma unroll
        for (int i = 0; i < 4; ++i) { const int c = tid + NTHREADS * i; hy_load8(hc.ru, 8 * c, ru_[i], ul[i], uh[i]); hy_load8(hc.r1, 8 * c, r1_[i], xl[i], xh[i]); }
#pragma unroll
        for (int i = 0; i < 5; ++i) { const int c = i < 4 ? tid + NTHREADS * i : NCHUNK - 2 + tid;
            if (i < 4 || tid < 2) { float u8[8], x8[8];
                if (i < 4) { hy_calc8(ru_[i], ul[i], uh[i], hc.wu, u8); hy_calc8(r1_[i], xl[i], xh[i], hc.w1, x8); } else { hy_val8(hc.ru, 8 * c, hc.wu, u8); hy_val8(hc.r1, 8 * c, hc.w1, x8); }
                const float2* s = cf + PADI(4 * c); const float2 y0 = s[0], y1 = s[1], y2 = s[2], y3 = s[3];
                const f32x4 o0 = (f32x4){x8[0] * (y0.x + sk0 * u8[0]), x8[1] * (y0.y + sk0 * u8[1]), x8[2] * (y1.x + sk0 * u8[2]), x8[3] * (y1.y + sk0 * u8[3])};
                const f32x4 o1 = (f32x4){x8[4] * (y2.x + sk0 * u8[4]), x8[5] * (y2.y + sk0 * u8[5]), x8[6] * (y3.x + sk0 * u8[6]), x8[7] * (y3.y + sk0 * u8[7])};
                *(f32x4*)(z2g + 8 * c) = o0; *(f32x4*)(z2g + 8 * c + 4) = o1; } } }
    __syncthreads();
    {   f32x4 gfq[8], gbq[8];
#pragma unroll
        for (int i = 0; i < 8; ++i) { const int lag0 = 4 * (tid + NTHREADS * i); gfq[i] = *(const f32x4*)(g2f + lag0); gbq[i] = *(const f32x4*)(g2b + lag0); }
#pragma unroll
        for (int i = 0; i < 8; ++i) { const int lag0 = 4 * (tid + NTHREADS * i); float2* d = cf + PADI(lag0 >> 1); d[0] = make_float2(gfq[i][0], gfq[i][1]); d[1] = make_float2(gfq[i][2], gfq[i][3]);
#pragma unroll
            for (int r = 0; r < 4; ++r) if (lag0 + r >= 1) CFF(32768 - lag0 - r) = gbq[i][r]; }
        if (tid < 4) { const int lag0 = NMAIN + 4 * tid; const f32x4 gf = *(const f32x4*)(g2f + lag0), gb = *(const f32x4*)(g2b + lag0);
#pragma unroll
            for (int r = 0; r < 4; ++r) { side[SD_GFX + lag0 - NMAIN + r] = gf[r]; side[SD_GBX + lag0 - NMAIN + r] = gb[r]; } } }
    if (tid == 0) CFF(NMAIN) = 0.f;
    __syncthreads();
    hy_conv<1>(hc, cf, side, scratch);
    {   u32x4 r2_[4]; float xl[4], xh[4]; f32x4 z0[4], z1[4];
#pragma unroll
        for (int i = 0; i < 4; ++i) { const int c = tid + NTHREADS * i; hy_load8(hc.r2, 8 * c, r2_[i], xl[i], xh[i]); z0[i] = *(const f32x4*)(z2g + 8 * c); z1[i] = *(const f32x4*)(z2g + 8 * c + 4); }
#pragma unroll
        for (int i = 0; i < 5; ++i) { const int c = i < 4 ? tid + NTHREADS * i : NCHUNK - 2 + tid;
            if (i < 4 || tid < 2) { float x8[8]; f32x4 p0, p1;
                if (i < 4) { hy_calc8(r2_[i], xl[i], xh[i], hc.w2, x8); p0 = z0[i]; p1 = z1[i]; } else { hy_val8(hc.r2, 8 * c, hc.w2, x8); p0 = *(const f32x4*)(z2g + 8 * c); p1 = *(const f32x4*)(z2g + 8 * c + 4); }
                const float2* s = cf + PADI(4 * c); const float2 y0 = s[0], y1 = s[1], y2 = s[2], y3 = s[3];
                u32x4 w; w.x = cvt_pk_bf16(x8[0] * (y0.x + sk1 * p0[0]), x8[1] * (y0.y + sk1 * p0[1])); w.y = cvt_pk_bf16(x8[2] * (y1.x + sk1 * p0[2]), x8[3] * (y1.y + sk1 * p0[3]));
                w.z = cvt_pk_bf16(x8[4] * (y2.x + sk1 * p1[0]), x8[5] * (y2.y + sk1 * p1[1])); w.w = cvt_pk_bf16(x8[6] * (y3.x + sk1 * p1[2]), x8[7] * (y3.y + sk1 * p1[3]));
                *(u32x4*)(hyout + 8 * c) = w; } } }
    __syncthreads();
}

__device__ void transpose_unit(const Params& p, int ct, int tt, unsigned char* smem) {
    const int tid = opaque_tid(); bf16_t* tile = (bf16_t*)smem;
    const bf16_t* hyout = (const bf16_t*)(p.ws + OFF_HYOUT); bf16_t* ya = (bf16_t*)(p.ws + OFF_GATE);
    __syncthreads();
    { const int cl = tid >> 3, t8 = (tid & 7) * 8; *(u32x4*)(tile + cl * 72 + t8) = *(const u32x4*)(hyout + (size_t)(ct * 64 + cl) * LP + tt * 64 + t8); }
    __syncthreads();
    { const int tl = tid >> 3, c8 = (tid & 7) * 8; const int t = tt * 64 + tl;
      if (t < L_TOK) { bf16_t* gp = ya + (size_t)t * 1024 + ct * 64 + c8; const u32x4 g = *(const u32x4*)gp;
          float v[8];
#pragma unroll
          for (int i = 0; i < 8; ++i) v[i] = bf2f(tile[(c8 + i) * 72 + tl]);
          u32x4 w; w.x = cvt_pk_bf16(v[0] * lo_bf(g.x), v[1] * hi_bf(g.x)); w.y = cvt_pk_bf16(v[2] * lo_bf(g.y), v[3] * hi_bf(g.y)); w.z = cvt_pk_bf16(v[4] * lo_bf(g.z), v[5] * hi_bf(g.z)); w.w = cvt_pk_bf16(v[6] * lo_bf(g.w), v[7] * hi_bf(g.w));
          *(u32x4*)gp = w; } }
}

__device__ void phase_final(const Params& p) {
    const int tid = opaque_tid(), lane = tid & 63, wv = tid >> 6; const float* h = (const float*)(p.ws + OFF_H);
    for (int l = NMETA + blockIdx.x * 8 + wv; l < L_TOK; l += gridDim.x * 8) { const f32x4* row = (const f32x4*)(h + (size_t)l * DM); f32x4 v[8]; float ss = 0.f;
#pragma unroll
        for (int i = 0; i < 8; ++i) { v[i] = row[i * 64 + lane]; ss += v[i][0] * v[i][0] + v[i][1] * v[i][1] + v[i][2] * v[i][2] + v[i][3] * v[i][3]; }
        ss = wave_sum(ss); const float inv = rsqrtf(ss * (1.0f / DM) + 1e-6f); f32x4* o = (f32x4*)(p.out + (size_t)(l - NMETA) * DM);
#pragma unroll
        for (int i = 0; i < 8; ++i) { const f32x4 gg = ((const f32x4*)p.final_g)[i * 64 + lane]; o[i * 64 + lane] = v[i] * inv * gg; } }
}

__device__ void mini_branch(const Params& p) {
    const int tid = opaque_tid(), lane = tid & 63, wv = tid >> 6, nt_ = blockIdx.x * 8 + wv;
    if (nt_ < 128) { const int rc = lane & 15, quad = lane >> 4; const int n0 = nt_ * 16;
        const bf16_t* mg = (const bf16_t*)(p.ws + OFF_MERGE); bf16_t* mb = (bf16_t*)(p.ws + OFF_M);
        float tot[4] = {0.f, 0.f, 0.f, 0.f};
#pragma unroll 1
        for (int br = 0; br < 3; ++br) { const bf16_t* A = (const bf16_t*)(p.ws + OFF_GATE + (size_t)br * SZ_GATE) + (size_t)(NMAIN + rc) * 1024 + quad * 8;
            const bf16_t* B = (const bf16_t*)(p.ws + OFF_WA + (size_t)br * SZ_WBR) + (size_t)(n0 + rc) * 1024 + quad * 8;
            f32x4 acc = (f32x4){0.f, 0.f, 0.f, 0.f};
#pragma unroll 1
            for (int kb = 0; kb < 32; kb += 8) { bf16x8 av[8], bv[8];
#pragma unroll
                for (int i = 0; i < 8; ++i) { av[i] = *(const bf16x8*)(A + (kb + i) * 32); bv[i] = *(const bf16x8*)(B + (kb + i) * 32); }
#pragma unroll
                for (int i = 0; i < 8; ++i) acc = __builtin_amdgcn_mfma_f32_16x16x32_bf16(av[i], bv[i], acc, 0, 0, 0); }
#pragma unroll
            for (int r = 0; r < 4; ++r) tot[r] += acc[r] * bf2f(mg[(size_t)(NMAIN + quad * 4 + r) * 6144 + br * 2048 + n0 + rc]); }
#pragma unroll
        for (int r = 0; r < 4; ++r) mb[(size_t)(NMAIN + quad * 4 + r) * DM + n0 + rc] = f2bf(tot[r]); }
}
__device__ void mini_out(const Params& p, int layer) {
    const int tid = opaque_tid(), lane = tid & 63, wv = tid >> 6, nt_ = blockIdx.x * 8 + wv;
    if (nt_ < 128) { const int rc = lane & 15, quad = lane >> 4; const int n0 = nt_ * 16;
        const bf16_t* A = (const bf16_t*)(p.ws + OFF_M) + (size_t)(NMAIN + rc) * DM + quad * 8; const bf16_t* B = (const bf16_t*)(p.ws + OFF_WO) + (size_t)(n0 + rc) * DM + quad * 8;
        f32x4 acc = (f32x4){0.f, 0.f, 0.f, 0.f};
#pragma unroll 1
        for (int kb = 0; kb < 64; kb += 8) { bf16x8 av[8], bv[8];
#pragma unroll
            for (int i = 0; i < 8; ++i) { av[i] = *(const bf16x8*)(A + (kb + i) * 32); bv[i] = *(const bf16x8*)(B + (kb + i) * 32); }
#pragma unroll
            for (int i = 0; i < 8; ++i) acc = __builtin_amdgcn_mfma_f32_16x16x32_bf16(av[i], bv[i], acc, 0, 0, 0); }
        float* h = (float*)(p.ws + OFF_H);
#pragma unroll
        for (int r = 0; r < 4; ++r) { const size_t row = NMAIN + quad * 4 + r; const float bs = layer == 0 ? p.x[(row - NMETA) * DM + n0 + rc] : h[row * DM + n0 + rc]; h[row * DM + n0 + rc] = bs + acc[r]; } }
}

enum { OP_P1 = 0, OP_SYNC, OP_GEMM, OP_NA, OP_HYENA, OP_TRANS, OP_NOP };
__global__ void __launch_bounds__(512, 2) hybrid_fwd(Params p) {
    extern __shared__ __attribute__((aligned(16))) unsigned char smem[];
    cg::grid_group grid = cg::this_grid();
    LAS unsigned char* lds = (LAS unsigned char*)smem;
    const int bid = blockIdx.x, G = gridDim.x;
    phase_prep0(p, smem);
    constexpr int NOPS = 17;
#pragma clang loop unroll(disable)
    for (int step = 0; step < 2 * NOPS; ++step) {
        const int layer = step / NOPS, s = step - layer * NOPS;
        int op, kind = 0;
        switch (s) {
        case 0: op = OP_P1; break;
        case 2: op = OP_GEMM; kind = K_IN; break;
        case 3: case 4: op = OP_NOP; break;
        case 6: op = OP_GEMM; kind = K_FNA; break;
        case 7: op = OP_NA; break;
        case 8: op = OP_HYENA; break;
        case 10: op = OP_GEMM; kind = K_FNB; break;
        case 11: op = OP_TRANS; break;
        case 13: op = OP_GEMM; kind = K_BR; break;
        case 15: op = OP_GEMM; kind = K_OUT; break;
        default: op = OP_SYNC; break;
        }
        if (op == OP_NOP) { }
        else if (op == OP_SYNC) { grid.sync(); }
        else if (op == OP_GEMM) {
            Gemm g; g.base = (const char*)p.ws; g.jumpA = 0; g.jumpB = 0;
            switch (kind) {
            case K_FNA: g.lda = 384; g.ldb = FN1P; g.nt = 6; g.ksplit = 3; g.jumpB = (long)((size_t)1024 * PROWS * 2) - 384l; break;
            case K_FNB: g.lda = 256; g.ldb = 256; g.nt = 4; g.ksplit = 4; break;
            case K_BR:  g.lda = 1024; g.ldb = 1024; g.nt = 16; g.ksplit = 16; break;
            default:    g.lda = DM; g.ldb = DM; g.nt = 32; g.ksplit = 32; break;
            }
            SchedAny S{kind, G, bid}; EpiAny E{kind, p.ws, layer, p.x, p.meta};
            pg8::gemm_phase(lds, g, S, E);
            if (kind == K_BR) mini_branch(p); else if (kind == K_OUT) mini_out(p, layer);
        }
        else if (op == OP_P1) { phase_p1(p, layer, smem); }
        else if (op == OP_NA) { na_phase(p, layer, smem); if (bid == G - 1) na_meta_unit(p, layer); }
        else if (op == OP_HYENA) { for (int ch = bid; ch < 1024; ch += G) hyena_unit(p, layer, ch, smem, (unsigned char*)p.out + (size_t)bid * HS_STRIDE); }
        else { for (int u = bid; u < 16 * 257; u += G) transpose_unit(p, u & 15, u >> 4, smem); }
    }
    phase_final(p);
}

extern "C" void kernel_launch(void* const* d_in, const int* in_sizes, int n_in, void* d_out, int out_size, void* d_ws, size_t ws_size, hipStream_t stream) {
    static int grid_blocks = 0;
    if (grid_blocks == 0) {
        if (n_in != 23 || ws_size < WS_END) { fprintf(stderr, "kernel_launch: need 23 inputs and %zu bytes of workspace (got %d, %zu)\n", (size_t)WS_END, n_in, ws_size); grid_blocks = -1; return; }
        int dev = 0, cus = 0, per_cu = 0;
        hipGetDevice(&dev); hipDeviceGetAttribute(&cus, hipDeviceAttributeMultiprocessorCount, dev);
        if (hipFuncSetAttribute((const void*)hybrid_fwd, hipFuncAttributeMaxDynamicSharedMemorySize, LDS_BYTES) != hipSuccess) { fprintf(stderr, "kernel_launch: hipFuncSetAttribute failed\n"); grid_blocks = -1; return; }
        hipOccupancyMaxActiveBlocksPerMultiprocessor(&per_cu, (const void*)hybrid_fwd, NTHREADS, LDS_BYTES);
        if (per_cu < 1) per_cu = 1;
        grid_blocks = cus * per_cu;
        if (grid_blocks > 256) grid_blocks = 256;
    }
    if (grid_blocks < 0) return;
    Params p{};
    const float** f = (const float**)&p;
    for (int i = 0; i < 23; ++i) f[i] = (const float*)d_in[i];
    p.out = (float*)d_out; p.ws = (unsigned char*)d_ws;
    void* args[] = {&p};
    hipError_t e = hipLaunchCooperativeKernel((const void*)hybrid_fwd, dim3(grid_blocks), dim3(NTHREADS), args, LDS_BYTES, stream);
    if (e != hipSuccess) fprintf(stderr, "cooperative launch failed: %s (grid %d)\n", hipGetErrorString(e), grid_blocks);
}
```

```cpp
#include <hip/hip_runtime.h>
#include <hip/hip_cooperative_groups.h>
#include <cstdio>
namespace cg = cooperative_groups;

#define LAS __attribute__((address_space(3)))
typedef unsigned short bf16_t;
typedef short bf16x8 __attribute__((ext_vector_type(8)));
typedef float f32x4 __attribute__((ext_vector_type(4)));
typedef unsigned u32x4 __attribute__((ext_vector_type(4)));
typedef unsigned u32x2 __attribute__((ext_vector_type(2)));

constexpr int L_TOK = 16400, LP = 16640, DM = 2048, NIN = 16384, NMETA = 16, NMAIN = 16384;
constexpr int FN1 = 164, FN2 = 100, FN1P = 192, PROWS = FN2 * FN1P;
constexpr int NTHREADS = 512, LDS_BYTES = 155648;

constexpr size_t SZ_H = (size_t)LP * DM * 4, SZ_XN = (size_t)LP * DM * 2, SZ_XNP = (size_t)PROWS * DM * 2;
constexpr size_t OFF_H = 0;
constexpr size_t OFF_XN = OFF_H + SZ_H;
constexpr size_t OFF_XNP = OFF_XN + SZ_XN;
constexpr size_t OFF_A1 = OFF_XN;
constexpr size_t SZ_A1 = (size_t)FN1 * 1024 * 2 * 128 * 2;
constexpr size_t OFF_HYOUT = OFF_A1 + SZ_A1;
constexpr size_t SZ_HYOUT = (size_t)1024 * LP * 2;
static_assert(OFF_HYOUT + SZ_HYOUT <= OFF_XNP + SZ_XNP, "alias overflow");
constexpr size_t OFF_WT = OFF_XNP + SZ_XNP;
constexpr size_t OFF_WEFF = OFF_WT + (size_t)NIN * DM * 2;
constexpr size_t OFF_WA = OFF_WEFF + (size_t)2048 * 2048 * 2;
constexpr size_t SZ_WBR = (size_t)2048 * 1024 * 2;
constexpr size_t OFF_WO = OFF_WA + 3 * SZ_WBR;
constexpr size_t OFF_HYIN = OFF_WO + (size_t)2048 * 2048 * 2;
constexpr size_t OFF_GATE = OFF_HYIN + (size_t)3072 * LP * 2;
constexpr size_t SZ_GATE = (size_t)LP * 1024 * 2;
constexpr size_t OFF_QKV = OFF_GATE + 3 * SZ_GATE;
constexpr size_t OFF_MERGE = OFF_QKV + (size_t)LP * 3072 * 2;
constexpr size_t OFF_ZT = OFF_MERGE + (size_t)LP * 6144 * 2;
constexpr size_t SZ_ZT = (size_t)2048 * PROWS * 2;
constexpr size_t OFF_M = OFF_ZT;
static_assert(SZ_XN <= SZ_ZT, "alias overflow");
constexpr size_t OFF_FA = OFF_ZT + SZ_ZT;
constexpr size_t OFF_FB = OFF_FA + (size_t)512 * 384 * 2;
constexpr size_t OFF_H3 = OFF_FB + (size_t)FN1 * 256 * 256 * 2;
constexpr size_t WS_END = OFF_H3 + (size_t)2 * L_TOK * 64 * 4;
constexpr size_t HS_HEO = 0, HS_Z2 = 131328, HS_G2 = HS_Z2 + 65792, HSW_STRIDE = HS_G2 + 65792;
constexpr size_t FILT_BYTES = (size_t)L_TOK * 2, HSD_STRIDE = 393728;
constexpr size_t WS_END2 = WS_END + 256 * HSW_STRIDE;
static_assert(HSD_STRIDE >= 12 * FILT_BYTES && HSD_STRIDE * 256 <= (size_t)NMAIN * DM * 4, "scratch overflow");

struct Params {
    const float* x; const float* meta; const float* norm_g; const float* w_in; const float* conv_w; const float* conv_b;
    const float* f_w1; const float* f_b1; const float* f_w2; const float* f_b2; const float* f_w3; const float* f_b3; const float* f_w4;
    const float* f_freq; const float* decay; const float* skip; const float* rpb; const float* meta_bias;
    const float* w_a; const float* w_b; const float* w_c; const float* w_out; const float* final_g;
    float* out; unsigned char* ws;
};

__device__ __forceinline__ int opaque_tid() { int t = threadIdx.x; asm volatile("" : "+v"(t)); return t; }
__device__ __forceinline__ float bf2f(bf16_t b) { return __uint_as_float(((unsigned)b) << 16); }
__device__ __forceinline__ bf16_t f2bf(float f) { unsigned u = __float_as_uint(f); u += 0x7FFFu + ((u >> 16) & 1u); return (bf16_t)(u >> 16); }
__device__ __forceinline__ unsigned cvt_pk_bf16(float lo, float hi) { unsigned r; asm volatile("v_cvt_pk_bf16_f32 %0, %1, %2" : "=v"(r) : "v"(lo), "v"(hi)); return r; }
__device__ __forceinline__ float lo_bf(unsigned u) { return __uint_as_float(u << 16); }
__device__ __forceinline__ float hi_bf(unsigned u) { return __uint_as_float(u & 0xffff0000u); }
__device__ __forceinline__ float silu_f(float v) { return v * __builtin_amdgcn_rcpf(1.0f + __expf(-v)); }
__device__ __forceinline__ float sigm_f(float v) { return __builtin_amdgcn_rcpf(1.0f + __expf(-v)); }
__device__ __forceinline__ float wave_sum(float v) {
#pragma unroll
    for (int o = 32; o >= 1; o >>= 1) v += __shfl_xor(v, o);
    return v;
}

namespace pg8 {
constexpr int BM = 256, BK = 64, HALF = 128, HTB = HALF * BK * 2, STAGE_BYTES = 8 * HTB;
__device__ __forceinline__ int lds_byte(int r, int c) { const int st = (r >> 4) * 2 + (c >> 5), rr = r & 15, cc = c & 31, ob = rr * 64 + cc * 2; return st * 1024 + (ob ^ (((ob >> 9) & 1) << 5)); }
__device__ __forceinline__ void stage_rc(int b, int& R, int& C) { const int st = b / 1024, sb = b % 1024, swz = sb ^ (((sb >> 9) & 1) << 5); R = (st >> 1) * 16 + swz / 64; C = (st & 1) * 32 + (swz % 64) / 2; }
__device__ __forceinline__ int perm32(int rho) { const int n = rho >> 4, i = rho & 15; return 8 * (i >> 2) + 4 * n + (i & 3); }

struct Unit { int pm, pn, aux; size_t offA, offB; };
struct Gemm { const char* base; int lda, ldb, nt, ksplit; long jumpA, jumpB; };

__device__ __forceinline__ void tile_map(int wgid, int nM, int nN, int& pm, int& pn) {
    const int nwg = nM * nN;
    { const int q = nwg / 8, r = nwg % 8, xcd = wgid % 8, off = wgid / 8; wgid = (xcd < r ? xcd * (q + 1) : r * (q + 1) + (xcd - r) * q) + off; }
    const int nig = 8 * nN, gid = wgid / nig, fm = gid * 8, gsz = (nM - fm) < 8 ? (nM - fm) : 8;
    pm = fm + ((wgid % nig) % gsz); pn = (wgid % nig) / gsz;
}

template <class Epi, class Sched>
__device__ __forceinline__ void gemm_phase(LAS unsigned char* lds, const Gemm g, const Sched& S, const Epi& E) {
    const int tid = opaque_tid(), wid = __builtin_amdgcn_readfirstlane(tid >> 6), lane = tid & 63, wr = wid >> 2, wc = wid & 3, fr = lane & 15, fq = lane >> 4;
    const int nt = g.nt;
    unsigned voffA[2], voffB[2];
#pragma unroll
    for (int i = 0; i < 2; ++i) { int R, C; stage_rc(tid * 16 + i * 8192, R, C); const int Rb = (R & ~31) + perm32(R & 31);
        voffA[i] = (unsigned)(R * g.lda + C) * 2u; voffB[i] = (unsigned)(Rb * g.ldb + C) * 2u; }
    const size_t kstep = (size_t)(BK * 2);
    const size_t hstepA = (size_t)HALF * g.lda * 2, hstepB = (size_t)HALF * g.ldb * 2;
    const unsigned ldsw = (unsigned)wid * 1024u;
    const int aoff = lds_byte(wr * 64 + fr, fq * 8), boff = lds_byte(wc * 32 + fr, fq * 8);
#define PG8_KA(p, t) ((p) + (size_t)(t) * kstep + ((t) >= g.ksplit ? g.jumpA : 0l))
#define PG8_KB(p, t) ((p) + (size_t)(t) * kstep + ((t) >= g.ksplit ? g.jumpB : 0l))
#define PG8_SA(b, h) (((b) * 2 + (h)) * HTB)
#define PG8_SB(b, h) ((4 + (b) * 2 + (h)) * HTB)
#define PG8_STAGE(bufoff, gbase, voff) do { _Pragma("unroll") for (int _i = 0; _i < 2; ++_i) \
        __builtin_amdgcn_global_load_lds((const unsigned*)((const char*)(gbase) + (voff)[_i]), (LAS unsigned*)(lds + (bufoff) + ldsw + _i * 8192), 16, 0, 0); } while (0)
#define PG8_LDA(dst, b, h) do { _Pragma("unroll") for (int m = 0; m < 4; ++m) _Pragma("unroll") for (int k = 0; k < 2; ++k) dst[m][k] = *(const LAS bf16x8*)(lds + PG8_SA(b, h) + aoff + m * 2048 + k * 1024); } while (0)
#define PG8_LDB(dst, b, h) do { _Pragma("unroll") for (int n = 0; n < 2; ++n) _Pragma("unroll") for (int k = 0; k < 2; ++k) dst[n][k] = *(const LAS bf16x8*)(lds + PG8_SB(b, h) + boff + n * 2048 + k * 1024); } while (0)
#define PG8_MMA(ai, bj, At, Bt) do { __builtin_amdgcn_s_setprio(1); _Pragma("unroll") for (int m = 0; m < 4; ++m) _Pragma("unroll") for (int n = 0; n < 2; ++n) _Pragma("unroll") for (int k = 0; k < 2; ++k) \
        acc[ai][bj][m][n] = __builtin_amdgcn_mfma_f32_16x16x32_bf16(Bt[n][k], At[m][k], acc[ai][bj][m][n], 0, 0, 0); __builtin_amdgcn_s_setprio(0); } while (0)
#define PG8_WAIT_V(n) asm volatile("s_waitcnt vmcnt(" #n ")" ::: "memory")
#define PG8_WAIT_L(n) asm volatile("s_waitcnt lgkmcnt(" #n ")" ::: "memory")
#define PG8_BAR __builtin_amdgcn_s_barrier()
#define PG8_SCHED __builtin_amdgcn_sched_barrier(0)
    Unit cur, nxt; int ui = 0;
    if (!S.next(0, cur)) return;
    f32x4 acc[2][2][4][2];
#pragma unroll
    for (int a = 0; a < 2; ++a)
#pragma unroll
        for (int b = 0; b < 2; ++b)
#pragma unroll
            for (int m = 0; m < 4; ++m)
#pragma unroll
                for (int n = 0; n < 2; ++n) acc[a][b][m][n] = (f32x4){0.f, 0.f, 0.f, 0.f};
    bf16x8 At[4][2], B0[2][2], B1[2][2];
    const char* cA = g.base + cur.offA; const char* cB = g.base + cur.offB;
    PG8_STAGE(PG8_SB(0, 0), cB, voffB); PG8_STAGE(PG8_SA(0, 0), cA, voffA); PG8_STAGE(PG8_SB(0, 1), cB + hstepB, voffB); PG8_STAGE(PG8_SA(0, 1), cA + hstepA, voffA);
    if (wr == 1) PG8_BAR;
    PG8_WAIT_V(4); PG8_BAR;
    PG8_STAGE(PG8_SB(1, 0), PG8_KB(cB, 1), voffB); PG8_STAGE(PG8_SA(1, 0), PG8_KA(cA, 1), voffA); PG8_STAGE(PG8_SB(1, 1), PG8_KB(cB, 1) + hstepB, voffB);
    PG8_WAIT_V(6); PG8_BAR;
    for (;;) {
        const bool has_next = S.next(ui + 1, nxt);
        const char* nA = has_next ? g.base + nxt.offA : cA; const char* nB = has_next ? g.base + nxt.offB : cB;
        for (int t = 0; t < nt; t += 2) {
            const bool last = (t == nt - 2);
            const char* a1 = PG8_KA(cA, t + 1);
            const char* a2 = last ? nA : PG8_KA(cA, t + 2); const char* b2 = last ? nB : PG8_KB(cB, t + 2);
            const char* a3 = last ? PG8_KA(nA, 1) : PG8_KA(cA, t + 3); const char* b3 = last ? PG8_KB(nB, 1) : PG8_KB(cB, t + 3);
            PG8_LDB(B0, 0, 0); PG8_SCHED; PG8_LDA(At, 0, 0); PG8_STAGE(PG8_SA(1, 1), a1 + hstepA, voffA);
            PG8_WAIT_L(8); PG8_BAR; PG8_WAIT_L(0); PG8_MMA(0, 0, At, B0); PG8_BAR; PG8_SCHED;
            PG8_LDB(B1, 0, 1); PG8_STAGE(PG8_SB(0, 0), b2, voffB);
            PG8_BAR; PG8_WAIT_L(0); PG8_MMA(0, 1, At, B1); PG8_BAR;
            PG8_LDA(At, 0, 1); PG8_STAGE(PG8_SA(0, 0), a2, voffA);
            PG8_BAR; PG8_WAIT_L(0); PG8_MMA(1, 0, At, B0); PG8_BAR; PG8_SCHED;
            PG8_STAGE(PG8_SB(0, 1), b2 + hstepB, voffB);
            PG8_WAIT_V(6); PG8_BAR; PG8_MMA(1, 1, At, B1); PG8_BAR;
            PG8_LDB(B0, 1, 0); PG8_SCHED; PG8_LDA(At, 1, 0); PG8_STAGE(PG8_SA(0, 1), a2 + hstepA, voffA);
            PG8_WAIT_L(8); PG8_BAR; PG8_WAIT_L(0); PG8_MMA(0, 0, At, B0); PG8_BAR; PG8_SCHED;
            PG8_LDB(B1, 1, 1); PG8_STAGE(PG8_SB(1, 0), b3, voffB);
            PG8_BAR; PG8_WAIT_L(0); PG8_MMA(0, 1, At, B1); PG8_BAR;
            PG8_LDA(At, 1, 1); PG8_STAGE(PG8_SA(1, 0), a3, voffA);
            PG8_BAR; PG8_WAIT_L(0); PG8_MMA(1, 0, At, B0); PG8_BAR; PG8_SCHED;
            PG8_STAGE(PG8_SB(1, 1), b3 + hstepB, voffB);
            PG8_WAIT_V(6); PG8_BAR; PG8_MMA(1, 1, At, B1); PG8_BAR;
        }
        E(acc, cur, wr, wc, fr, fq);
        if (!has_next) break;
#pragma unroll
        for (int a = 0; a < 2; ++a)
#pragma unroll
            for (int b = 0; b < 2; ++b)
#pragma unroll
                for (int m = 0; m < 4; ++m)
#pragma unroll
                    for (int n = 0; n < 2; ++n) acc[a][b][m][n] = (f32x4){0.f, 0.f, 0.f, 0.f};
        cur = nxt; cA = nA; cB = nB; ++ui;
    }
    PG8_WAIT_V(0);
    if (wr == 0) PG8_BAR;
    PG8_BAR;
#undef PG8_KA
#undef PG8_KB
#undef PG8_SA
#undef PG8_SB
#undef PG8_STAGE
#undef PG8_LDA
#undef PG8_LDB
#undef PG8_MMA
#undef PG8_WAIT_V
#undef PG8_WAIT_L
#undef PG8_BAR
#undef PG8_SCHED
}
}
using pg8::Unit; using pg8::Gemm;
#define ACC_T const f32x4 (&acc)[2][2][4][2]

enum { K_TOK = 0, K_HYIN = 1, K_F0 = 2, K_FNA = 3, K_FNB = 4, K_BR = 5, K_OUT = 6, K_IN = 7 };
struct SchedAny {
    int kind, G, c;
    __device__ __forceinline__ bool next(int i, Unit& u) const {
        const long Lx = (long)i * G + c;
        switch (kind) {
        case K_IN: {
            if (Lx < 3120) { int pn; pg8::tile_map((int)Lx, 65, 48, u.pm, pn); u.pn = pn < 4 ? 12 + pn : 16 + pn; u.aux = K_TOK;
                u.offA = OFF_XN + (size_t)u.pm * 256 * DM * 2; u.offB = OFF_WT + (size_t)u.pn * 256 * DM * 2; return true; }
            if (Lx < 3900) { pg8::tile_map((int)Lx - 3120, 12, 65, u.pm, u.pn); u.aux = K_HYIN;
                u.offA = OFF_WT + (size_t)u.pm * 256 * DM * 2; u.offB = OFF_XN + (size_t)u.pn * 256 * DM * 2; return true; }
            if (Lx < 4500) { pg8::tile_map((int)Lx - 3900, 8, 75, u.pm, u.pn); u.aux = K_F0;
                u.offA = OFF_WEFF + (size_t)u.pm * 256 * DM * 2; u.offB = OFF_XNP + (size_t)u.pn * 256 * DM * 2; return true; }
            return false; }
        case K_TOK: {
            if (Lx >= 65l * 48) return false; int pn; pg8::tile_map((int)Lx, 65, 48, u.pm, pn); u.pn = pn < 4 ? 12 + pn : 16 + pn; u.aux = 0;
            u.offA = OFF_XN + (size_t)u.pm * 256 * DM * 2; u.offB = OFF_WT + (size_t)u.pn * 256 * DM * 2; return true; }
        case K_HYIN: {
            if (Lx >= 12l * 65) return false; pg8::tile_map((int)Lx, 12, 65, u.pm, u.pn); u.aux = 0;
            u.offA = OFF_WT + (size_t)u.pm * 256 * DM * 2; u.offB = OFF_XN + (size_t)u.pn * 256 * DM * 2; return true; }
        case K_F0: {
            if (Lx >= 8l * 75) return false; pg8::tile_map((int)Lx, 8, 75, u.pm, u.pn); u.aux = 0;
            u.offA = OFF_WEFF + (size_t)u.pm * 256 * DM * 2; u.offB = OFF_XNP + (size_t)u.pn * 256 * DM * 2; return true; }
        case K_FNA: {
            if (Lx >= 2l * 400) return false; pg8::tile_map((int)Lx, 2, 400, u.pm, u.pn); u.aux = 0;
            u.offA = OFF_FA + (size_t)u.pm * 256 * 384 * 2; u.offB = OFF_ZT + (size_t)u.pn * 256 * FN1P * 2; return true; }
        case K_FNB: {
            if (Lx >= 164l * 4) return false; u.aux = (int)(Lx >> 2); u.pm = 0; u.pn = (int)(Lx & 3);
            u.offA = OFF_FB + (size_t)u.aux * 256 * 256 * 2; u.offB = OFF_A1 + (size_t)u.aux * 1024 * 256 * 2 + (size_t)u.pn * 256 * 256 * 2; return true; }
        case K_BR: {
            const int T = (i / 3) * G + c; if (T >= 64 * 8) return false; const int br = i % 3; pg8::tile_map(T, 64, 8, u.pm, u.pn); u.aux = br;
            u.offA = OFF_GATE + (size_t)br * SZ_GATE + (size_t)u.pm * 256 * 1024 * 2; u.offB = OFF_WA + (size_t)br * SZ_WBR + (size_t)u.pn * 256 * 1024 * 2; return true; }
        default: {
            if (Lx >= 64l * 8) return false; pg8::tile_map((int)Lx, 64, 8, u.pm, u.pn); u.aux = 0;
            u.offA = OFF_M + (size_t)u.pm * 256 * DM * 2; u.offB = OFF_WO + (size_t)u.pn * 256 * DM * 2; return true; }
        }
    }
};
#define ROWFENCE asm volatile("" ::: "memory")
#define HARDFENCE do { asm volatile("" ::: "memory"); __builtin_amdgcn_sched_barrier(0); } while (0)
struct EpiAny {
    int kind; unsigned char* ws; int layer; const float* xin; const float* metain;
    __device__ __forceinline__ void operator()(ACC_T, const Unit& u, int wr, int wc, int fr, int fq) const {
        const int rl0 = wr * 64 + fr, cl0 = wc * 32 + 8 * fq;
        const int ek = kind == K_IN ? u.aux : kind;
        if (ek == K_TOK) {
            const int t = u.pn; unsigned char* dst; unsigned ld; int c0, act;
            if (t < 16)      { dst = ws + OFF_GATE;               ld = 1024; c0 = (t - 12) * 256; act = 1; }
            else if (t < 24) { dst = ws + OFF_GATE + SZ_GATE;     ld = 1024; c0 = (t - 20) * 256; act = 1; }
            else if (t < 36) { dst = ws + OFF_QKV;                ld = 3072; c0 = (t - 24) * 256; act = 0; }
            else if (t < 40) { dst = ws + OFF_GATE + 2 * SZ_GATE; ld = 1024; c0 = (t - 36) * 256; act = 1; }
            else             { dst = ws + OFF_MERGE;              ld = 6144; c0 = (t - 40) * 256; act = 2; }
#pragma unroll
            for (int ai = 0; ai < 2; ++ai)
#pragma unroll
                for (int m = 0; m < 4; ++m) { const unsigned row = (unsigned)(u.pm * 256 + ai * 128 + m * 16 + rl0);
#pragma unroll
                    for (int bj = 0; bj < 2; ++bj) { const unsigned off = (row * ld + (unsigned)(c0 + bj * 128 + cl0)) * 2u; f32x4 v0 = acc[ai][bj][m][0], v1 = acc[ai][bj][m][1];
                        if (act == 1) {
#pragma unroll
                            for (int j = 0; j < 4; ++j) { v0[j] = silu_f(v0[j]); v1[j] = silu_f(v1[j]); } }
                        else if (act == 2) {
#pragma unroll
                            for (int j = 0; j < 4; ++j) { v0[j] = sigm_f(v0[j]); v1[j] = sigm_f(v1[j]); } }
                        u32x4 w; w.x = cvt_pk_bf16(v0[0], v0[1]); w.y = cvt_pk_bf16(v0[2], v0[3]); w.z = cvt_pk_bf16(v1[0], v1[1]); w.w = cvt_pk_bf16(v1[2], v1[3]);
                        *(u32x4*)(dst + off) = w; }
                    ROWFENCE; }
        } else if (ek == K_HYIN || ek == K_F0) {
            unsigned char* dst = ws + (ek == K_HYIN ? OFF_HYIN : OFF_ZT); const unsigned ld = ek == K_HYIN ? LP : PROWS;
#pragma unroll
            for (int ai = 0; ai < 2; ++ai)
#pragma unroll
                for (int m = 0; m < 4; ++m) { const unsigned row = (unsigned)(u.pm * 256 + ai * 128 + m * 16 + rl0);
#pragma unroll
                    for (int bj = 0; bj < 2; ++bj) { const unsigned off = (row * ld + (unsigned)(u.pn * 256 + bj * 128 + cl0)) * 2u; const f32x4 v0 = acc[ai][bj][m][0], v1 = acc[ai][bj][m][1];
                        u32x4 w; w.x = cvt_pk_bf16(v0[0], v0[1]); w.y = cvt_pk_bf16(v0[2], v0[3]); w.z = cvt_pk_bf16(v1[0], v1[1]); w.w = cvt_pk_bf16(v1[2], v1[3]);
                        *(u32x4*)(dst + off) = w; }
                    ROWFENCE; }
        } else if (ek == K_FNA) {
            unsigned char* dst = ws + OFF_A1;
#pragma unroll
            for (int ai = 0; ai < 2; ++ai)
#pragma unroll
                for (int m = 0; m < 4; ++m) { const int k1 = ai * 128 + m * 16 + rl0;
                    if (k1 < FN1) {
#pragma unroll
                        for (int bj = 0; bj < 2; ++bj)
#pragma unroll
                            for (int n = 0; n < 2; ++n) { const int col = u.pn * 256 + bj * 128 + cl0 + 4 * n; const int ch = col / FN2, l2 = col - ch * FN2; const f32x4 v = acc[ai][bj][m][n];
                                u32x2 w; w.x = cvt_pk_bf16(v[0], v[1]); w.y = cvt_pk_bf16(v[2], v[3]);
                                *(u32x2*)(dst + ((unsigned)((k1 * 1024 + ch) * 2 + u.pm) * 128u + (unsigned)l2) * 2u) = w; } }
                    ROWFENCE; }
        } else if (ek == K_FNB) {
            unsigned char* dst = ws + OFF_GATE + SZ_GATE; const float scale = 1.0f / sqrtf((float)L_TOK * 256.0f);
#pragma unroll
            for (int ai = 0; ai < 2; ++ai)
#pragma unroll
                for (int m = 0; m < 4; ++m) { const int k2 = ai * 128 + m * 16 + rl0;
                    if (k2 < FN2) { const unsigned row = (unsigned)(u.aux + FN1 * k2);
#pragma unroll
                        for (int bj = 0; bj < 2; ++bj) { const unsigned off = (row * 1024u + (unsigned)(u.pn * 256 + bj * 128 + cl0)) * 2u; const u32x4 g = *(const u32x4*)(dst + off);
                            const f32x4 v0 = acc[ai][bj][m][0] * scale, v1 = acc[ai][bj][m][1] * scale;
                            u32x4 w; w.x = cvt_pk_bf16(v0[0] * lo_bf(g.x), v0[1] * hi_bf(g.x)); w.y = cvt_pk_bf16(v0[2] * lo_bf(g.y), v0[3] * hi_bf(g.y));
                            w.z = cvt_pk_bf16(v1[0] * lo_bf(g.z), v1[1] * hi_bf(g.z)); w.w = cvt_pk_bf16(v1[2] * lo_bf(g.w), v1[3] * hi_bf(g.w));
                            *(u32x4*)(dst + off) = w; } }
                    ROWFENCE; }
        } else if (ek == K_BR) {
            unsigned char* dst = ws + OFF_M; const unsigned char* mg = ws + OFF_MERGE; const int br = u.aux;
#pragma unroll
            for (int ai = 0; ai < 2; ++ai) { u32x4 gq[4][2], oq[4][2];
#pragma unroll
                for (int m = 0; m < 4; ++m) { const unsigned row = (unsigned)(u.pm * 256 + ai * 128 + m * 16 + rl0);
#pragma unroll
                    for (int bj = 0; bj < 2; ++bj) { const unsigned col = (unsigned)(u.pn * 256 + bj * 128 + cl0);
                        gq[m][bj] = *(const u32x4*)(mg + (row * 6144u + (unsigned)br * 2048u + col) * 2u);
                        if (br > 0) oq[m][bj] = *(const u32x4*)(dst + (row * (unsigned)DM + col) * 2u); else oq[m][bj] = (u32x4){0u, 0u, 0u, 0u}; } }
#pragma unroll
                for (int m = 0; m < 4; ++m) { const unsigned row = (unsigned)(u.pm * 256 + ai * 128 + m * 16 + rl0);
#pragma unroll
                    for (int bj = 0; bj < 2; ++bj) { const unsigned col = (unsigned)(u.pn * 256 + bj * 128 + cl0); const unsigned off = (row * (unsigned)DM + col) * 2u;
                        const u32x4 g = gq[m][bj], o = oq[m][bj]; const f32x4 v0 = acc[ai][bj][m][0], v1 = acc[ai][bj][m][1];
                        const float r0 = v0[0] * lo_bf(g.x) + lo_bf(o.x), r1 = v0[1] * hi_bf(g.x) + hi_bf(o.x), r2 = v0[2] * lo_bf(g.y) + lo_bf(o.y), r3 = v0[3] * hi_bf(g.y) + hi_bf(o.y);
                        const float r4 = v1[0] * lo_bf(g.z) + lo_bf(o.z), r5 = v1[1] * hi_bf(g.z) + hi_bf(o.z), r6 = v1[2] * lo_bf(g.w) + lo_bf(o.w), r7 = v1[3] * hi_bf(g.w) + hi_bf(o.w);
                        u32x4 w; w.x = cvt_pk_bf16(r0, r1); w.y = cvt_pk_bf16(r2, r3); w.z = cvt_pk_bf16(r4, r5); w.w = cvt_pk_bf16(r6, r7);
                        *(u32x4*)(dst + off) = w; } }
                ROWFENCE; }
        } else {
            unsigned char* dst = ws + OFF_H;
#pragma unroll
            for (int ai = 0; ai < 2; ++ai) { f32x4 oq[4][2][2];
#pragma unroll
                for (int m = 0; m < 4; ++m) { const unsigned row = (unsigned)(u.pm * 256 + ai * 128 + m * 16 + rl0);
                    const float* srow = layer == 0 ? (row < (unsigned)NMETA ? metain + (size_t)row * DM : xin + (size_t)(row - NMETA) * DM) : (const float*)(dst + (size_t)row * DM * 4);
#pragma unroll
                    for (int bj = 0; bj < 2; ++bj) { const unsigned col = (unsigned)(u.pn * 256 + bj * 128 + cl0); oq[m][bj][0] = *(const f32x4*)(srow + col); oq[m][bj][1] = *(const f32x4*)(srow + col + 4); } }
#pragma unroll
                for (int m = 0; m < 4; ++m) { const unsigned row = (unsigned)(u.pm * 256 + ai * 128 + m * 16 + rl0);
#pragma unroll
                    for (int bj = 0; bj < 2; ++bj) { const unsigned off = (row * (unsigned)DM + (unsigned)(u.pn * 256 + bj * 128 + cl0)) * 4u;
                        *(f32x4*)(dst + off) = oq[m][bj][0] + acc[ai][bj][m][0]; *(f32x4*)(dst + off + 16) = oq[m][bj][1] + acc[ai][bj][m][1]; } }
                ROWFENCE; }
        }
    }
};

__device__ void phase_prep0(const Params& p, unsigned char* smem) {
    const int tid = opaque_tid(), bid = blockIdx.x, G = gridDim.x;
    const size_t gtid = (size_t)bid * NTHREADS + tid, gstride = (size_t)G * NTHREADS;
    { bf16_t* fa = (bf16_t*)(p.ws + OFF_FA);
      for (size_t i = gtid; i < (size_t)512 * 384; i += gstride) { const int row = (int)(i / 384), col = (int)(i % 384); const int po = row >> 8, k1 = row & 255, pi = col / 192, l1 = col % 192; float v = 0.f;
          if (k1 < FN1 && l1 < FN1) { const int r = (k1 * l1) % FN1; const float a = 2.0f * (float)r / (float)FN1; const float cs = cospif(a), sn = sinpif(a);
              v = (po == 0) ? (pi == 0 ? cs : sn) : (pi == 0 ? -sn : cs); }
          fa[i] = f2bf(v); } }
    { bf16_t* fb = (bf16_t*)(p.ws + OFF_FB);
      for (size_t i = gtid; i < (size_t)FN1 * 65536; i += gstride) { const int k1 = (int)(i >> 16), k2 = (int)((i >> 8) & 255), kk = (int)(i & 255), part = kk >> 7, l2 = kk & 127; float v = 0.f;
          if (k2 < FN2 && l2 < FN2) { const int lp = k1 + FN1 * k2; const int r = (l2 * lp) % L_TOK; const float a = 2.0f * (float)r / (float)L_TOK; v = part == 0 ? cospif(a) : sinpif(a); }
          fb[i] = f2bf(v); } }
    { float* w1s = (float*)smem;
      float* w2s = w1s + 33 * 64;
      float* w3s = w2s + 64 * 64;
      const int lane = tid & 63, wv = tid >> 6;
      for (int layer = 0; layer < 2; ++layer) {
          __syncthreads();
          for (int i = tid; i < 33 * 64; i += NTHREADS) w1s[i] = p.f_w1[layer * 33 * 64 + i];
          for (int i = tid; i < 64 * 64; i += NTHREADS) { w2s[i] = p.f_w2[layer * 4096 + i]; w3s[i] = p.f_w3[layer * 4096 + i]; }
          __syncthreads();
          const float b1 = p.f_b1[layer * 64 + lane], b2 = p.f_b2[layer * 64 + lane], b3 = p.f_b3[layer * 64 + lane], fr = p.f_freq[layer * 64 + lane];
          bf16_t* h3 = (bf16_t*)(p.ws + OFF_H3) + (size_t)layer * L_TOK * 64;
          for (int lag = bid * 8 + wv; lag < L_TOK; lag += G * 8) {
              const float tt = (float)lag / (float)(L_TOK - 1); const float w = 6.283185307179586f * (float)lag / (float)L_TOK;
              float z = 0.f;
              if (lane == 0) z = tt;
              else if (lane < 33) { const int j = (lane - 1) & 15; const float f = 1e-4f + (float)j * ((15.0f - 1e-4f) / 15.0f); const float a = f * w; z = lane < 17 ? cosf(a) : -sinf(a); }
              float a1 = b1;
#pragma unroll 3
              for (int i = 0; i < 33; ++i) a1 += __shfl(z, i) * w1s[i * 64 + lane];
              const float h1 = sinf(fr * a1);
              float a2 = b2;
#pragma unroll 8
              for (int i = 0; i < 64; ++i) a2 += __shfl(h1, i) * w2s[i * 64 + lane];
              const float h2 = sinf(fr * a2);
              float a3 = b3;
#pragma unroll 8
              for (int i = 0; i < 64; ++i) a3 += __shfl(h2, i) * w3s[i * 64 + lane];
              h3[(size_t)lag * 64 + lane] = f2bf(sinf(fr * a3));
          }
      }
      __syncthreads(); }
}

__device__ void convert_matrix(const float* __restrict__ src, int K, int N, bf16_t* __restrict__ dst, int kshift  , int total, float* tile  ) {
    const int tid = opaque_tid(), G = gridDim.x; const int kl0 = tid >> 4, n4 = (tid & 15) * 4, nl = tid >> 3, k8 = (tid & 7) * 8;
    f32x4 pv0 = (f32x4){0.f, 0.f, 0.f, 0.f}, pv1 = pv0;
    int t = blockIdx.x;
    if (t < total) { const int kt = t & ((1 << kshift) - 1), nt_ = t >> kshift; const float* s = src + (size_t)(kt * 64 + kl0) * N + nt_ * 64 + n4; pv0 = *(const f32x4*)s; pv1 = *(const f32x4*)(s + (size_t)32 * N); }
    int buf = 0;
    for (; t < total; t += G) { float* tl = tile + buf * (64 * 65); const int kt = t & ((1 << kshift) - 1), nt_ = t >> kshift;
        tl[kl0 * 65 + n4] = pv0[0]; tl[kl0 * 65 + n4 + 1] = pv0[1]; tl[kl0 * 65 + n4 + 2] = pv0[2]; tl[kl0 * 65 + n4 + 3] = pv0[3];
        tl[(32 + kl0) * 65 + n4] = pv1[0]; tl[(32 + kl0) * 65 + n4 + 1] = pv1[1]; tl[(32 + kl0) * 65 + n4 + 2] = pv1[2]; tl[(32 + kl0) * 65 + n4 + 3] = pv1[3];
        { const int tn = t + G; if (tn < total) { const int kt2 = tn & ((1 << kshift) - 1), nt2 = tn >> kshift; const float* s = src + (size_t)(kt2 * 64 + kl0) * N + nt2 * 64 + n4; pv0 = *(const f32x4*)s; pv1 = *(const f32x4*)(s + (size_t)32 * N); } }
        __syncthreads();
        u32x4 w; w.x = cvt_pk_bf16(tl[(k8 + 0) * 65 + nl], tl[(k8 + 1) * 65 + nl]); w.y = cvt_pk_bf16(tl[(k8 + 2) * 65 + nl], tl[(k8 + 3) * 65 + nl]);
        w.z = cvt_pk_bf16(tl[(k8 + 4) * 65 + nl], tl[(k8 + 5) * 65 + nl]); w.w = cvt_pk_bf16(tl[(k8 + 6) * 65 + nl], tl[(k8 + 7) * 65 + nl]);
        *(u32x4*)(dst + (size_t)(nt_ * 64 + nl) * K + kt * 64 + k8) = w;
        buf ^= 1; }
    __syncthreads();
}

__device__ void phase_p1(const Params& p, int layer, unsigned char* smem) {
    const int tid = opaque_tid(), bid = blockIdx.x, G = gridDim.x;
    float* tile = (float*)smem;
    { const float* win = p.w_in + (size_t)layer * DM * NIN;
      convert_matrix(win, DM, NIN, (bf16_t*)(p.ws + OFF_WT), 5, 32 * 256, tile);
      for (int br = 0; br < 3; ++br) { const float* wsrc = (br == 0 ? p.w_a : br == 1 ? p.w_b : p.w_c) + (size_t)layer * 1024 * DM;
          convert_matrix(wsrc, 1024, DM, (bf16_t*)(p.ws + OFF_WA + br * SZ_WBR), 4, 16 * 32, tile); }
      const float* wo = p.w_out + (size_t)layer * DM * DM;
      convert_matrix(wo, DM, DM, (bf16_t*)(p.ws + OFF_WO), 5, 32 * 32, tile);
      __syncthreads(); }
    { float* tileT = (float*)smem;
      float* ctab = tileT + 256 * 32;
      float* stab = ctab + 256;
      const float* win = p.w_in + (size_t)layer * DM * NIN;
      for (int t = bid; t < 256; t += G) { const int g = t >> 6, k0 = (t & 63) * 32;
          __syncthreads();
          if (tid < 256) { const float a = 2.0f * (float)tid / 256.0f; ctab[tid] = cospif(a); stab[tid] = sinpif(a); }
#pragma unroll
          for (int ps = 0; ps < 4; ++ps) { const int idx = ps * NTHREADS + tid; const int kl = idx >> 6, c4 = (idx & 63) * 4;
              const f32x4 v = *(const f32x4*)(win + (size_t)(k0 + kl) * NIN + 4096 + g * 256 + c4);
              tileT[(c4 + 0) * 32 + kl] = v[0]; tileT[(c4 + 1) * 32 + kl] = v[1]; tileT[(c4 + 2) * 32 + kl] = v[2]; tileT[(c4 + 3) * 32 + kl] = v[3]; }
          __syncthreads();
          const int cp = tid & 255, part = tid >> 8;
          float acc[32];
#pragma unroll
          for (int k = 0; k < 32; ++k) acc[k] = 0.f;
          for (int c = 0; c < 256; ++c) { const int r = (c * cp) & 255; const float tw = part == 0 ? ctab[r] : -stab[r];
#pragma unroll
              for (int k4 = 0; k4 < 8; ++k4) { const f32x4 v = *(const f32x4*)(tileT + c * 32 + k4 * 4); acc[k4 * 4 + 0] += v[0] * tw; acc[k4 * 4 + 1] += v[1] * tw; acc[k4 * 4 + 2] += v[2] * tw; acc[k4 * 4 + 3] += v[3] * tw; } }
          bf16_t* dst = (bf16_t*)(p.ws + OFF_WEFF) + (size_t)(part * 1024 + g * 256 + cp) * DM + k0;
#pragma unroll
          for (int k8 = 0; k8 < 4; ++k8) { u32x4 w; w.x = cvt_pk_bf16(acc[k8 * 8 + 0], acc[k8 * 8 + 1]); w.y = cvt_pk_bf16(acc[k8 * 8 + 2], acc[k8 * 8 + 3]); w.z = cvt_pk_bf16(acc[k8 * 8 + 4], acc[k8 * 8 + 5]); w.w = cvt_pk_bf16(acc[k8 * 8 + 6], acc[k8 * 8 + 7]);
              *(u32x4*)(dst + k8 * 8) = w; } }
      __syncthreads(); }
    { const int lane = tid & 63, wv = tid >> 6; const float* h = (const float*)(p.ws + OFF_H); const float* gam = p.norm_g + layer * DM;
      bf16_t* xn = (bf16_t*)(p.ws + OFF_XN); bf16_t* xnp = (bf16_t*)(p.ws + OFF_XNP);
      for (int l = bid * 8 + wv; l < LP; l += G * 8) {
          if (l < L_TOK) { const f32x4* row = (const f32x4*)(layer == 0 ? (l < NMETA ? p.meta + (size_t)l * DM : p.x + (size_t)(l - NMETA) * DM) : h + (size_t)l * DM); f32x4 v[8]; float ss = 0.f;
#pragma unroll
              for (int i = 0; i < 8; ++i) { v[i] = row[i * 64 + lane]; ss += v[i][0] * v[i][0] + v[i][1] * v[i][1] + v[i][2] * v[i][2] + v[i][3] * v[i][3]; }
              ss = wave_sum(ss); const float inv = rsqrtf(ss * (1.0f / DM) + 1e-6f);
              const int l1 = l / FN2, l2 = l - l1 * FN2; const size_t pr = (size_t)l2 * FN1P + l1;
#pragma unroll
              for (int i = 0; i < 8; ++i) { const f32x4 gg = ((const f32x4*)gam)[i * 64 + lane]; u32x2 w; w.x = cvt_pk_bf16(v[i][0] * inv * gg[0], v[i][1] * inv * gg[1]); w.y = cvt_pk_bf16(v[i][2] * inv * gg[2], v[i][3] * inv * gg[3]);
                  *(u32x2*)(xn + (size_t)l * DM + (i * 64 + lane) * 4) = w; *(u32x2*)(xnp + pr * DM + (i * 64 + lane) * 4) = w; } }
          else { const u32x2 z = (u32x2){0u, 0u};
#pragma unroll
              for (int i = 0; i < 8; ++i) *(u32x2*)(xn + (size_t)l * DM + (i * 64 + lane) * 4) = z; } }
      for (int idx = bid * 8 + wv; idx < FN2 * (FN1P - FN1); idx += G * 8) { const int l2 = idx / (FN1P - FN1), l1 = FN1 + idx % (FN1P - FN1); const size_t pr = (size_t)l2 * FN1P + l1; const u32x2 z = (u32x2){0u, 0u};
#pragma unroll
          for (int i = 0; i < 8; ++i) *(u32x2*)(xnp + pr * DM + (i * 64 + lane) * 4) = z; } }
}

__device__ void na_phase(const Params& p, int layer, unsigned char* smem) {
    const int tid = opaque_tid(), wv = tid >> 6, lane = tid & 63, l15 = lane & 15, quad = lane >> 4;
    const int G = gridDim.x;
    const bf16_t* qkv = (const bf16_t*)(p.ws + OFF_QKV);
    unsigned char* sK = smem;
    bf16_t* sVT = (bf16_t*)(smem + 76032);
    float* sRPB = (float*)(smem + 144640);
    float* sMB = (float*)(smem + 146512);
    const int cb = wv & 3, hf = wv >> 2, c = cb * 16 + l15;
    const int cu = cb == 0 ? 0 : (cb == 1 ? 8 : (cb == 2 ? 24 : 32)), cs = min(max(c - 8, 0), 48);
    u32x4 pk[8], pv[8], pmk = (u32x4){0u, 0u, 0u, 0u}, pmv = (u32x4){0u, 0u, 0u, 0u}; bf16x8 pq0, pq1; float prp = 0.f;
#define NA_LOADS(U) do { const int r_ = (U) >> 4, hd_ = (U) & 15, r0_ = min(max(r_ - 4, 0), 248); \
        _Pragma("unroll") for (int ps = 0; ps < 8; ++ps) { const int tok = ps * 64 + (tid >> 3), ch = tid & 7; const size_t g = (size_t)(NMETA + r0_ * 64 + tok) * 3072 + hd_ * 64 + ch * 8; \
            pk[ps] = *(const u32x4*)(qkv + g + 1024); pv[ps] = *(const u32x4*)(qkv + g + 2048); } \
        if (tid < 128) { const size_t g = (size_t)(tid >> 3) * 3072 + hd_ * 64 + (tid & 7) * 8; pmk = *(const u32x4*)(qkv + g + 1024); pmv = *(const u32x4*)(qkv + g + 2048); } \
        { const bf16_t* qp = qkv + (size_t)(NMETA + r_ * 64 + c) * 3072 + hd_ * 64 + quad * 8; pq0 = *(const bf16x8*)qp; pq1 = *(const bf16x8*)(qp + 32); } \
        if (tid < 465) prp = p.rpb[(size_t)(layer * 16 + hd_) * 465 + tid]; else if (tid >= 480 && tid < 496) prp = p.meta_bias[(layer * 16 + hd_) * 16 + tid - 480]; } while (0)
    int u = blockIdx.x;
    if (u < 4096) NA_LOADS(u);
    for (; u < 4096; u += G) {
        const int r = u >> 4, hd = u & 15, r0 = min(max(r - 4, 0), 248);
        __syncthreads();
#pragma unroll
        for (int ps = 0; ps < 8; ++ps) { const int tok = ps * 64 + (tid >> 3), ch = tid & 7; const u32x4 vv = pv[ps];
            *(u32x4*)(sK + tok * 144 + ch * 16) = pk[ps];
            bf16_t* vt = sVT + (ch * 8) * 536 + tok;
            vt[0] = (bf16_t)vv.x; vt[536] = (bf16_t)(vv.x >> 16); vt[2 * 536] = (bf16_t)vv.y; vt[3 * 536] = (bf16_t)(vv.y >> 16);
            vt[4 * 536] = (bf16_t)vv.z; vt[5 * 536] = (bf16_t)(vv.z >> 16); vt[6 * 536] = (bf16_t)vv.w; vt[7 * 536] = (bf16_t)(vv.w >> 16); }
        if (tid < 128) { const int tok = tid >> 3, ch = tid & 7; const u32x4 vv = pmv;
            *(u32x4*)(sK + (512 + tok) * 144 + ch * 16) = pmk;
            bf16_t* vt = sVT + (ch * 8) * 536 + 512 + tok;
            vt[0] = (bf16_t)vv.x; vt[536] = (bf16_t)(vv.x >> 16); vt[2 * 536] = (bf16_t)vv.y; vt[3 * 536] = (bf16_t)(vv.y >> 16);
            vt[4 * 536] = (bf16_t)vv.z; vt[5 * 536] = (bf16_t)(vv.z >> 16); vt[6 * 536] = (bf16_t)vv.w; vt[7 * 536] = (bf16_t)(vv.w >> 16); }
        if (tid < 465) sRPB[tid] = prp; else if (tid >= 480 && tid < 496) sMB[tid - 480] = prp;
        const bf16x8 bq0 = pq0, bq1 = pq1;
        { const int un = u + G; if (un < 4096) NA_LOADS(un); }
        __syncthreads();
        bf16_t* yc = (bf16_t*)(p.ws + OFF_GATE + 2 * SZ_GATE);
        float gatev[4][4];
        if (hf == 0) {
#pragma unroll
            for (int rr = 0; rr < 4; ++rr)
#pragma unroll
                for (int dt = 0; dt < 4; ++dt) gatev[rr][dt] = bf2f(yc[(size_t)(NMETA + r * 64 + cb * 16 + quad * 4 + rr) * 1024 + hd * 64 + l15 + dt * 16]); }
        float sc[9][4];
#pragma unroll
        for (int ti = 0; ti < 9; ++ti) { const int j = 4 * hf + (ti >> 1), tt = ti & 1; const int slot0 = ti < 8 ? j * 64 + cu + tt * 16 : 512;
            const unsigned char* kp = sK + (slot0 + l15) * 144 + quad * 16;
            const bf16x8 a0 = *(const bf16x8*)kp, a1 = *(const bf16x8*)(kp + 64);
            f32x4 acc = (f32x4){0.f, 0.f, 0.f, 0.f};
            acc = __builtin_amdgcn_mfma_f32_16x16x32_bf16(a0, bq0, acc, 0, 0, 0); acc = __builtin_amdgcn_mfma_f32_16x16x32_bf16(a1, bq1, acc, 0, 0, 0);
            if (ti < 8) { const float* rp = sRPB + (r0 + j - r + 7) * 31 + (15 - c);
#pragma unroll
                for (int rr = 0; rr < 4; ++rr) { const int kc = cu + tt * 16 + quad * 4 + rr; const bool ok = kc >= cs && kc < cs + 16; const int kcc = ok ? kc : cs;
                    sc[ti][rr] = ok ? acc[rr] * 0.125f + rp[kcc] : -1.0e30f; } }
            else {
#pragma unroll
                for (int rr = 0; rr < 4; ++rr) sc[ti][rr] = hf == 0 ? acc[rr] * 0.125f + sMB[quad * 4 + rr] : -1.0e30f; } }
        float mx = -1.0e30f;
#pragma unroll
        for (int ti = 0; ti < 9; ++ti)
#pragma unroll
            for (int rr = 0; rr < 4; ++rr) mx = fmaxf(mx, sc[ti][rr]);
        mx = fmaxf(mx, __shfl_xor(mx, 16)); mx = fmaxf(mx, __shfl_xor(mx, 32));
        float lsum = 0.f;
#pragma unroll
        for (int ti = 0; ti < 9; ++ti)
#pragma unroll
            for (int rr = 0; rr < 4; ++rr) { sc[ti][rr] = __expf(sc[ti][rr] - mx); lsum += sc[ti][rr]; }
        lsum += __shfl_xor(lsum, 16); lsum += __shfl_xor(lsum, 32);
        f32x4 oacc[4];
#pragma unroll
        for (int dt = 0; dt < 4; ++dt) oacc[dt] = (f32x4){0.f, 0.f, 0.f, 0.f};
#pragma unroll
        for (int ks = 0; ks < 5; ++ks) { const int tA = 2 * ks, tB = 2 * ks + 1;
            const int jA = 4 * hf + (tA >> 1); const int slotA = tA < 8 ? jA * 64 + cu + (tA & 1) * 16 : 512; const int slotB = ks < 4 ? (4 * hf + (tB >> 1)) * 64 + cu + 16 : 512;
            u32x4 pa; pa.x = cvt_pk_bf16(sc[tA][0], sc[tA][1]); pa.y = cvt_pk_bf16(sc[tA][2], sc[tA][3]);
            if (ks < 4) { pa.z = cvt_pk_bf16(sc[tA + 1 < 9 ? tA + 1 : 8][0], sc[tA + 1 < 9 ? tA + 1 : 8][1]); pa.w = cvt_pk_bf16(sc[tA + 1 < 9 ? tA + 1 : 8][2], sc[tA + 1 < 9 ? tA + 1 : 8][3]); } else { pa.z = 0u; pa.w = 0u; }
            const bf16x8 af = __builtin_bit_cast(bf16x8, pa);
#pragma unroll
            for (int dt = 0; dt < 4; ++dt) { const bf16_t* vr = sVT + (dt * 16 + l15) * 536 + quad * 4;
                const u32x2 lo = *(const u32x2*)(vr + slotA), hi = *(const u32x2*)(vr + slotB);
                const u32x4 bb = (u32x4){lo.x, lo.y, hi.x, hi.y};
                oacc[dt] = __builtin_amdgcn_mfma_f32_16x16x32_bf16(af, __builtin_bit_cast(bf16x8, bb), oacc[dt], 0, 0, 0); } }
        __syncthreads();
        float* part = (float*)smem + cb * 1056;
        if (hf == 1) {
#pragma unroll
            for (int dt = 0; dt < 4; ++dt)
#pragma unroll
                for (int rr = 0; rr < 4; ++rr) part[(quad * 4 + rr) * 64 + dt * 16 + l15] = oacc[dt][rr];
            if (quad == 0) { part[1024 + l15] = mx; part[1040 + l15] = lsum; } }
        __syncthreads();
        if (hf == 0) {
#pragma unroll
            for (int rr = 0; rr < 4; ++rr) { const int qy = quad * 4 + rr; const float m0 = __shfl(mx, qy), l0 = __shfl(lsum, qy); const float m1 = part[1024 + qy], l1 = part[1040 + qy];
                const float M = fmaxf(m0, m1), f0 = __expf(m0 - M), f1 = __expf(m1 - M); const float inv = 1.0f / (f0 * l0 + f1 * l1);
                bf16_t* gp = yc + (size_t)(NMETA + r * 64 + cb * 16 + qy) * 1024 + hd * 64 + l15;
#pragma unroll
                for (int dt = 0; dt < 4; ++dt) { const float o = (f0 * oacc[dt][rr] + f1 * part[qy * 64 + dt * 16 + l15]) * inv; gp[dt * 16] = f2bf(o * gatev[rr][dt]); } } }
    }
#undef NA_LOADS
}
__device__ void na_meta_unit(const Params& p, int layer) {
    const int tid = opaque_tid();
    if (tid < 256) { const int hd = tid >> 4, qi = tid & 15; const bf16_t* qkv = (const bf16_t*)(p.ws + OFF_QKV);
        float q[64];
        { const u32x4* qp = (const u32x4*)(qkv + (size_t)qi * 3072 + hd * 64);
#pragma unroll
          for (int i = 0; i < 8; ++i) { const u32x4 v = qp[i]; q[i * 8 + 0] = lo_bf(v.x) * 0.125f; q[i * 8 + 1] = hi_bf(v.x) * 0.125f; q[i * 8 + 2] = lo_bf(v.y) * 0.125f; q[i * 8 + 3] = hi_bf(v.y) * 0.125f;
              q[i * 8 + 4] = lo_bf(v.z) * 0.125f; q[i * 8 + 5] = hi_bf(v.z) * 0.125f; q[i * 8 + 6] = lo_bf(v.w) * 0.125f; q[i * 8 + 7] = hi_bf(v.w) * 0.125f; } }
        float o[64];
#pragma unroll
        for (int i = 0; i < 64; ++i) o[i] = 0.f;
        float mx = -3.0e38f, lsum = 0.f;
#pragma unroll 1
        for (int m = 0; m < 16; ++m) { const u32x4* kp = (const u32x4*)(qkv + (size_t)m * 3072 + 1024 + hd * 64); const u32x4* vp = (const u32x4*)(qkv + (size_t)m * 3072 + 2048 + hd * 64);
            float d0 = 0.f, d1 = 0.f;
#pragma unroll
            for (int e = 0; e < 8; ++e) { const u32x4 v = kp[e];
                d0 += q[e * 8 + 0] * lo_bf(v.x) + q[e * 8 + 2] * lo_bf(v.y) + q[e * 8 + 4] * lo_bf(v.z) + q[e * 8 + 6] * lo_bf(v.w);
                d1 += q[e * 8 + 1] * hi_bf(v.x) + q[e * 8 + 3] * hi_bf(v.y) + q[e * 8 + 5] * hi_bf(v.z) + q[e * 8 + 7] * hi_bf(v.w); }
            const float sc = d0 + d1 + p.meta_bias[(layer * 16 + hd) * 16 + m]; const float mnew = fmaxf(mx, sc); const float alpha = __expf(mx - mnew), pi = __expf(sc - mnew);
            lsum = lsum * alpha + pi; mx = mnew;
#pragma unroll
            for (int e = 0; e < 8; ++e) { const u32x4 v = vp[e];
                o[e * 8 + 0] = o[e * 8 + 0] * alpha + pi * lo_bf(v.x); o[e * 8 + 1] = o[e * 8 + 1] * alpha + pi * hi_bf(v.x); o[e * 8 + 2] = o[e * 8 + 2] * alpha + pi * lo_bf(v.y); o[e * 8 + 3] = o[e * 8 + 3] * alpha + pi * hi_bf(v.y);
                o[e * 8 + 4] = o[e * 8 + 4] * alpha + pi * lo_bf(v.z); o[e * 8 + 5] = o[e * 8 + 5] * alpha + pi * hi_bf(v.z); o[e * 8 + 6] = o[e * 8 + 6] * alpha + pi * lo_bf(v.w); o[e * 8 + 7] = o[e * 8 + 7] * alpha + pi * hi_bf(v.w); } }
        const float inv = 1.0f / lsum; u32x4* gp = (u32x4*)((bf16_t*)(p.ws + OFF_GATE + 2 * SZ_GATE) + (size_t)qi * 1024 + hd * 64);
#pragma unroll
        for (int e = 0; e < 8; ++e) { const u32x4 g = gp[e]; u32x4 w;
            w.x = cvt_pk_bf16(o[e * 8 + 0] * inv * lo_bf(g.x), o[e * 8 + 1] * inv * hi_bf(g.x)); w.y = cvt_pk_bf16(o[e * 8 + 2] * inv * lo_bf(g.y), o[e * 8 + 3] * inv * hi_bf(g.y));
            w.z = cvt_pk_bf16(o[e * 8 + 4] * inv * lo_bf(g.z), o[e * 8 + 5] * inv * hi_bf(g.z)); w.w = cvt_pk_bf16(o[e * 8 + 6] * inv * lo_bf(g.w), o[e * 8 + 7] * inv * hi_bf(g.w));
            gp[e] = w; } }
}

__device__ __forceinline__ unsigned rev4_14(unsigned k) { unsigned r = __brev(k) >> 18; return ((r & 0x1555u) << 1) | ((r >> 1) & 0x1555u); }
__device__ __forceinline__ float2 cmul(float2 a, float2 b) { return make_float2(a.x * b.x - a.y * b.y, a.x * b.y + a.y * b.x); }
#define PADI(i) ((i) + ((i) >> 4))
#define CFF(n) cff[2 * PADI((n) >> 1) + ((n) & 1)]
__device__ __forceinline__ void hw_sincos(float rev, float& sn, float& cs) { sn = __builtin_amdgcn_sinf(rev); cs = __builtin_amdgcn_cosf(rev); }
__device__ __forceinline__ float c16(int k) { const float t[10] = {1.0f, 0.9238795325f, 0.7071067812f, 0.3826834324f, 0.0f, -0.3826834324f, -0.7071067812f, -0.9238795325f, -1.0f, -0.9238795325f}; return t[k]; }
__device__ __forceinline__ float s16(int k) { const float t[10] = {0.0f, 0.3826834324f, 0.7071067812f, 0.9238795325f, 1.0f, 0.9238795325f, 0.7071067812f, 0.3826834324f, 0.0f, -0.3826834324f}; return t[k]; }
__device__ __forceinline__ float2 cadd(float2 a, float2 b) { return make_float2(a.x + b.x, a.y + b.y); }
__device__ __forceinline__ float2 csub(float2 a, float2 b) { return make_float2(a.x - b.x, a.y - b.y); }
template <int SGN> __device__ __forceinline__ void bf4(float2& a0, float2& a1, float2& a2, float2& a3) {
    const float2 t0 = cadd(a0, a2), t1 = csub(a0, a2), t2 = cadd(a1, a3), d = csub(a1, a3);
    const float2 t3 = SGN < 0 ? make_float2(d.y, -d.x) : make_float2(-d.y, d.x);
    a0 = cadd(t0, t2); a1 = cadd(t1, t3); a2 = csub(t0, t2); a3 = csub(t1, t3);
}
template <int S> __device__ __forceinline__ void r16_fwd_pass(float2* a) {
    constexpr int Q = S / 4;
    for (int u = opaque_tid(); u < 1024; u += NTHREADS) { const int j = u & (Q - 1); const int base = ((u - j) << 4) + j;
        float2 x[4][4];
#pragma unroll
        for (int aa = 0; aa < 4; ++aa)
#pragma unroll
            for (int bb = 0; bb < 4; ++bb) x[aa][bb] = a[PADI(base + aa * S + bb * Q)];
        float sn, cs; hw_sincos((float)j / (float)(4 * S), sn, cs); const float2 wb0 = make_float2(cs, -sn);
#pragma unroll
        for (int bb = 0; bb < 4; ++bb) { const float2 w1 = bb == 0 ? wb0 : cmul(wb0, make_float2(c16(bb), -s16(bb))); const float2 w2 = cmul(w1, w1), w3 = cmul(w2, w1);
            bf4<-1>(x[0][bb], x[1][bb], x[2][bb], x[3][bb]); x[1][bb] = cmul(x[1][bb], w1); x[2][bb] = cmul(x[2][bb], w2); x[3][bb] = cmul(x[3][bb], w3); }
        hw_sincos((float)j / (float)S, sn, cs); const float2 v1 = make_float2(cs, -sn), v2 = cmul(v1, v1), v3 = cmul(v2, v1);
#pragma unroll
        for (int aa = 0; aa < 4; ++aa) { bf4<-1>(x[aa][0], x[aa][1], x[aa][2], x[aa][3]); x[aa][1] = cmul(x[aa][1], v1); x[aa][2] = cmul(x[aa][2], v2); x[aa][3] = cmul(x[aa][3], v3); }
#pragma unroll
        for (int aa = 0; aa < 4; ++aa)
#pragma unroll
            for (int bb = 0; bb < 4; ++bb) a[PADI(base + aa * S + bb * Q)] = x[aa][bb]; }
    __syncthreads();
}
template <int S> __device__ __forceinline__ void r16_inv_pass(float2* a) {
    constexpr int Q = S / 4;
    for (int u = opaque_tid(); u < 1024; u += NTHREADS) { const int j = u & (Q - 1); const int base = ((u - j) << 4) + j;
        float2 x[4][4];
#pragma unroll
        for (int aa = 0; aa < 4; ++aa)
#pragma unroll
            for (int bb = 0; bb < 4; ++bb) x[aa][bb] = a[PADI(base + aa * S + bb * Q)];
        float sn, cs; hw_sincos((float)j / (float)S, sn, cs); const float2 v1 = make_float2(cs, sn), v2 = cmul(v1, v1), v3 = cmul(v2, v1);
#pragma unroll
        for (int aa = 0; aa < 4; ++aa) { x[aa][1] = cmul(x[aa][1], v1); x[aa][2] = cmul(x[aa][2], v2); x[aa][3] = cmul(x[aa][3], v3); bf4<1>(x[aa][0], x[aa][1], x[aa][2], x[aa][3]); }
        hw_sincos((float)j / (float)(4 * S), sn, cs); const float2 wb0 = make_float2(cs, sn);
#pragma unroll
        for (int bb = 0; bb < 4; ++bb) { const float2 w1 = bb == 0 ? wb0 : cmul(wb0, make_float2(c16(bb), s16(bb))); const float2 w2 = cmul(w1, w1), w3 = cmul(w2, w1);
            x[1][bb] = cmul(x[1][bb], w1); x[2][bb] = cmul(x[2][bb], w2); x[3][bb] = cmul(x[3][bb], w3); bf4<1>(x[0][bb], x[1][bb], x[2][bb], x[3][bb]); }
#pragma unroll
        for (int aa = 0; aa < 4; ++aa)
#pragma unroll
            for (int bb = 0; bb < 4; ++bb) a[PADI(base + aa * S + bb * Q)] = x[aa][bb]; }
    __syncthreads();
}
__device__ void fft_fwd(float2* a) {
    r16_fwd_pass<4096>(a);
    r16_fwd_pass<256>(a);
    { const int span = 16;
        for (int b = opaque_tid(); b < 4096; b += NTHREADS) { const int j = b & (span - 1); const int base = ((b - j) << 2) + j;
            const int i0 = PADI(base), i1 = PADI(base + span), i2 = PADI(base + 2 * span), i3 = PADI(base + 3 * span);
            float2 a0 = a[i0], a1 = a[i1], a2 = a[i2], a3 = a[i3];
            const float2 w1 = make_float2(c16(0) * 0.f + __builtin_amdgcn_cosf((float)j * (1.0f / 64.0f)), -__builtin_amdgcn_sinf((float)j * (1.0f / 64.0f))), w2 = cmul(w1, w1), w3 = cmul(w2, w1);
            bf4<-1>(a0, a1, a2, a3);
            a[i0] = a0; a[i1] = cmul(a1, w1); a[i2] = cmul(a2, w2); a[i3] = cmul(a3, w3); }
        __syncthreads(); }
    for (int blk = opaque_tid(); blk < 1024; blk += NTHREADS) { float2* pb = a + blk * 17; float2 x[16];
#pragma unroll
        for (int e = 0; e < 16; ++e) x[e] = pb[e];
#pragma unroll
        for (int j = 0; j < 4; ++j) { bf4<-1>(x[j], x[j + 4], x[j + 8], x[j + 12]);
            x[j + 4] = cmul(x[j + 4], make_float2(c16(j), -s16(j))); x[j + 8] = cmul(x[j + 8], make_float2(c16(2 * j), -s16(2 * j))); x[j + 12] = cmul(x[j + 12], make_float2(c16(3 * j), -s16(3 * j))); }
#pragma unroll
        for (int g = 0; g < 4; ++g) bf4<-1>(x[4 * g], x[4 * g + 1], x[4 * g + 2], x[4 * g + 3]);
#pragma unroll
        for (int e = 0; e < 16; ++e) pb[e] = x[e]; }
    __syncthreads();
}
__device__ void fft_inv(float2* a) {
    for (int blk = opaque_tid(); blk < 1024; blk += NTHREADS) { float2* pb = a + blk * 17; float2 x[16];
#pragma unroll
        for (int e = 0; e < 16; ++e) x[e] = pb[e];
#pragma unroll
        for (int g = 0; g < 4; ++g) bf4<1>(x[4 * g], x[4 * g + 1], x[4 * g + 2], x[4 * g + 3]);
#pragma unroll
        for (int j = 0; j < 4; ++j) { x[j + 4] = cmul(x[j + 4], make_float2(c16(j), s16(j))); x[j + 8] = cmul(x[j + 8], make_float2(c16(2 * j), s16(2 * j))); x[j + 12] = cmul(x[j + 12], make_float2(c16(3 * j), s16(3 * j)));
            bf4<1>(x[j], x[j + 4], x[j + 8], x[j + 12]); }
#pragma unroll
        for (int e = 0; e < 16; ++e) pb[e] = x[e]; }
    __syncthreads();
    { const int span = 16;
        for (int b = opaque_tid(); b < 4096; b += NTHREADS) { const int j = b & (span - 1); const int base = ((b - j) << 2) + j;
            const int i0 = PADI(base), i1 = PADI(base + span), i2 = PADI(base + 2 * span), i3 = PADI(base + 3 * span);
            const float2 w1 = make_float2(__builtin_amdgcn_cosf((float)j * (1.0f / 64.0f)), __builtin_amdgcn_sinf((float)j * (1.0f / 64.0f))), w2 = cmul(w1, w1), w3 = cmul(w2, w1);
            float2 a0 = a[i0], a1 = cmul(a[i1], w1), a2 = cmul(a[i2], w2), a3 = cmul(a[i3], w3);
            bf4<1>(a0, a1, a2, a3);
            a[i0] = a0; a[i1] = a1; a[i2] = a2; a[i3] = a3; }
        __syncthreads(); }
    r16_inv_pass<256>(a);
    r16_inv_pass<4096>(a);
}
__device__ __forceinline__ void hy_load8(const bf16_t* __restrict__ row, int t0, u32x4& v, float& xl, float& xh) {
    v = *(const u32x4*)(row + t0); xl = t0 > 0 ? bf2f(row[t0 - 1]) : 0.f; xh = (t0 + 8 < L_TOK) ? bf2f(row[t0 + 8]) : 0.f;
}
__device__ __forceinline__ void hy_calc8(const u32x4 v, float xl, float xh, const float (&w)[4], float (&o)[8]) {
    float x[10];
    x[0] = xl; x[9] = xh;
    x[1] = lo_bf(v.x); x[2] = hi_bf(v.x); x[3] = lo_bf(v.y); x[4] = hi_bf(v.y); x[5] = lo_bf(v.z); x[6] = hi_bf(v.z); x[7] = lo_bf(v.w); x[8] = hi_bf(v.w);
#pragma unroll
    for (int e = 0; e < 8; ++e) o[e] = w[0] * x[e] + w[1] * x[e + 1] + w[2] * x[e + 2] + w[3];
}
__device__ __forceinline__ void hy_val8(const bf16_t* __restrict__ row, int t0, const float (&w)[4], float (&o)[8]) { u32x4 v; float xl, xh; hy_load8(row, t0, v, xl, xh); hy_calc8(v, xl, xh, w, o); }
struct HyCh { const bf16_t* __restrict__ ru; const bf16_t* __restrict__ r1; const bf16_t* __restrict__ r2; float wu[4], w1[4], w2[4]; };

constexpr int SD_W4B = 0  , SD_GFX = 512, SD_GBX = 528, SD_EF = 544, SD_EB = 560, SD_VH = 576, SD_VT = 592, SD_END = 608;
constexpr int NCHUNK = L_TOK / 8;

template <int ORDER>
__device__ void hy_conv(const HyCh& hc, float2* cf, float* side, unsigned char* scratch) {
    const int tid = opaque_tid(); float* cff = (float*)cf;
    f32x4* __restrict__ heo = (f32x4*)(scratch + HS_HEO); const float* __restrict__ z2g = (const float*)(scratch + HS_Z2);
    if (tid < 15) side[SD_EF + tid] = CFF(16369 + tid); else if (tid >= 32 && tid < 47) side[SD_EB + tid - 32] = CFF(32768 - (16369 + tid - 32));
    __syncthreads();
    fft_fwd(cf);
    for (int j = tid; j <= 8192; j += NTHREADS) { const unsigned i_ = j < 8192 ? ((((unsigned)j >> 1) << 2) | ((unsigned)j & 1u)) : 2u; const unsigned k = rev4_14(i_); const unsigned kp = (16384u - k) & 16383u; const float2 a = cf[PADI(i_)], bq = cf[PADI(rev4_14(kp))];
        const float bx = bq.x, by = -bq.y; const float sc = 1.0f / 16384.0f;
        heo[j] = (f32x4){0.5f * (a.x + bx) * sc, 0.5f * (a.y + by) * sc, 0.5f * (a.y - by) * sc, -0.5f * (a.x - bx) * sc}; }
    __syncthreads();
    {
        u32x4 rv[4]; float rl[4], rh[4]; f32x4 z0[4], z1[4];
#pragma unroll
        for (int i = 0; i < 4; ++i) { const int c = tid + NTHREADS * i;
            if (ORDER == 0) hy_load8(hc.ru, 8 * c, rv[i], rl[i], rh[i]); else { z0[i] = *(const f32x4*)(z2g + 8 * c); z1[i] = *(const f32x4*)(z2g + 8 * c + 4); } }
#pragma unroll
        for (int i = 0; i < 4; ++i) { const int c = tid + NTHREADS * i; float v[8];
            if (ORDER == 0) hy_calc8(rv[i], rl[i], rh[i], hc.wu, v);
            else { v[0] = z0[i][0]; v[1] = z0[i][1]; v[2] = z0[i][2]; v[3] = z0[i][3]; v[4] = z1[i][0]; v[5] = z1[i][1]; v[6] = z1[i][2]; v[7] = z1[i][3]; }
            float2* d = cf + PADI(4 * c); d[0] = make_float2(v[0], v[1]); d[1] = make_float2(v[2], v[3]); d[2] = make_float2(v[4], v[5]); d[3] = make_float2(v[6], v[7]);
            if (i == 0 && tid < 2) {
#pragma unroll
                for (int e = 0; e < 8; ++e) side[SD_VH + 8 * tid + e] = v[e]; } }
        if (tid < 2) { const int c = NCHUNK - 2 + tid; float v[8];
            if (ORDER == 0) hy_val8(hc.ru, 8 * c, hc.wu, v);
            else { const f32x4 p0 = *(const f32x4*)(z2g + 8 * c), p1 = *(const f32x4*)(z2g + 8 * c + 4); v[0] = p0[0]; v[1] = p0[1]; v[2] = p0[2]; v[3] = p0[3]; v[4] = p1[0]; v[5] = p1[1]; v[6] = p1[2]; v[7] = p1[3]; }
            float2* d = cf + PADI(4 * c); d[0] = make_float2(v[0], v[1]); d[1] = make_float2(v[2], v[3]); d[2] = make_float2(v[4], v[5]); d[3] = make_float2(v[6], v[7]);
#pragma unroll
            for (int e = 0; e < 8; ++e) side[SD_VT + 8 * tid + e] = v[e]; } }
    for (int i = L_TOK / 2 + tid; i < 16384; i += NTHREADS) cf[PADI(i)] = make_float2(0.f, 0.f);
    __syncthreads();
    fft_fwd(cf);
#pragma unroll 4
    for (int j = tid; j <= 8192; j += NTHREADS) { const unsigned i_ = j < 8192 ? ((((unsigned)j >> 1) << 2) | ((unsigned)j & 1u)) : 2u; const unsigned k = rev4_14(i_); const unsigned kp = (16384u - k) & 16383u; const unsigned ik = PADI(i_), ikp = PADI(rev4_14(kp)); const float2 a = cf[ik], bq = cf[ikp];
        const float bx = bq.x, by = -bq.y;
        const float2 XE = make_float2(0.5f * (a.x + bx), 0.5f * (a.y + by)), XO = make_float2(0.5f * (a.y - by), -0.5f * (a.x - bx));
        const f32x4 hh = heo[j]; const float2 HE = make_float2(hh[0], hh[1]), HO = make_float2(hh[2], hh[3]);
        float sn, cs; hw_sincos((float)k / 16384.0f, sn, cs); const float2 w = make_float2(cs, -sn);
        const float2 xoho = cmul(XO, HO), wx = cmul(w, xoho), xehe = cmul(XE, HE), xeho = cmul(XE, HO), xohe = cmul(XO, HE);
        const float2 YE = make_float2(xehe.x + wx.x, xehe.y + wx.y), YO = make_float2(xeho.x + xohe.x, xeho.y + xohe.y);
        cf[ik] = make_float2(YE.x - YO.y, YE.y + YO.x); cf[ikp] = make_float2(YE.x + YO.y, -YE.y + YO.x); }
    __syncthreads();
    fft_inv(cf);
    if (tid < 16) { const int t = tid; float d = 0.f;
        for (int s = t + 16384; s < L_TOK; ++s) { const int l = s - t; const float wrong = l == 16384 ? 0.f : side[SD_EF + 16399 - l]; d += (side[SD_GBX + l - 16384] - wrong) * side[SD_VT + s - 16384]; }
        CFF(t) += d; }
    else if (tid >= 32 && tid < 48) { const int t = 16384 + tid - 32; float d = 0.f;
        for (int s = 0; s <= t - 16384; ++s) { const int l = t - s; const float wrong = l == 16384 ? 0.f : side[SD_EB + 16399 - l]; d += (side[SD_GFX + l - 16384] - wrong) * side[SD_VH + s]; }
        CFF(t) += d; }
    __syncthreads();
}

__device__ void filt_to_lds(const bf16_t* __restrict__ gfp, const bf16_t* __restrict__ gbp, float2* cf, float* side) {
    const int tid = opaque_tid(); float* cff = (float*)cf;
    u32x4 qf[4], qb[4];
#pragma unroll
    for (int i = 0; i < 4; ++i) { const int c = tid + NTHREADS * i; qf[i] = *(const u32x4*)(gfp + 8 * c); qb[i] = *(const u32x4*)(gbp + 8 * c); }
#pragma unroll
    for (int i = 0; i < 4; ++i) { const int c = tid + NTHREADS * i, lag0 = 8 * c; const u32x4 f = qf[i], g = qb[i];
        float2* d = cf + PADI(4 * c); d[0] = make_float2(lo_bf(f.x), hi_bf(f.x)); d[1] = make_float2(lo_bf(f.y), hi_bf(f.y)); d[2] = make_float2(lo_bf(f.z), hi_bf(f.z)); d[3] = make_float2(lo_bf(f.w), hi_bf(f.w));
        if (lag0 >= 1) CFF(32768 - lag0) = lo_bf(g.x);
        CFF(32768 - lag0 - 1) = hi_bf(g.x); CFF(32768 - lag0 - 2) = lo_bf(g.y); CFF(32768 - lag0 - 3) = hi_bf(g.y); CFF(32768 - lag0 - 4) = lo_bf(g.z); CFF(32768 - lag0 - 5) = hi_bf(g.z); CFF(32768 - lag0 - 6) = lo_bf(g.w); CFF(32768 - lag0 - 7) = hi_bf(g.w); }
    if (tid < 2) { const int c = NCHUNK - 2 + tid; const u32x4 f = *(const u32x4*)(gfp + 8 * c), g = *(const u32x4*)(gbp + 8 * c); float* sf = side + SD_GFX + 8 * tid; float* sb = side + SD_GBX + 8 * tid;
        sf[0] = lo_bf(f.x); sf[1] = hi_bf(f.x); sf[2] = lo_bf(f.y); sf[3] = hi_bf(f.y); sf[4] = lo_bf(f.z); sf[5] = hi_bf(f.z); sf[6] = lo_bf(f.w); sf[7] = hi_bf(f.w);
        sb[0] = lo_bf(g.x); sb[1] = hi_bf(g.x); sb[2] = lo_bf(g.y); sb[3] = hi_bf(g.y); sb[4] = lo_bf(g.z); sb[5] = hi_bf(g.z); sb[6] = lo_bf(g.w); sb[7] = hi_bf(g.w); }
    if (tid == 0) CFF(NMAIN) = 0.f;
    __syncthreads();
}

__device__ void hyena_filters(const Params& p, int layer, unsigned char* smem, unsigned char* scrD, unsigned char* scrW) {
    const int tid = opaque_tid(); float2* cf = (float2*)smem; float* cff = (float*)smem; float* side = (float*)(smem + 139264);
    const int bid = blockIdx.x;
    __syncthreads();
    bf16_t* w4b = (bf16_t*)(side + SD_W4B);
    for (int i = tid; i < 16 * 64; i += NTHREADS) { const int row = i >> 6, k = i & 63; w4b[i] = f2bf(p.f_w4[((size_t)layer * 64 + k) * 4096 + (row & 3) * 1024 + bid + 256 * (row >> 2)]); }
    __syncthreads();
    const bf16_t* __restrict__ h3b = (const bf16_t*)(p.ws + OFF_H3) + (size_t)layer * L_TOK * 64;
    const int lane = tid & 63, wv = tid >> 6, col = lane & 15, quad = lane >> 4;
    const int chq = bid + 256 * quad;
    float dk[4];
#pragma unroll
    for (int f = 0; f < 4; ++f) dk[f] = fabsf(p.decay[((layer * 2 + (f >> 1)) * 2 + (f & 1)) * 1024 + chq]) * (1.4426950408889634f / (float)(L_TOK - 1));
    const bf16x8 b0 = *(const bf16x8*)(w4b + col * 64 + quad * 8), b1 = *(const bf16x8*)(w4b + col * 64 + 32 + quad * 8);
    bf16_t* __restrict__ g2 = (bf16_t*)(scrW + HS_G2);
    bf16_t* __restrict__ fq = (bf16_t*)(scrD) + (size_t)(quad > 0 ? quad - 1 : 0) * 4 * L_TOK;
#define FG_LOAD(A0, A1, GB) do { _Pragma("unroll") for (int i = 0; i < 8; ++i) { const bf16_t* hr = h3b + (size_t)(((GB) + 8 * i) * 16 + col) * 64 + quad * 8; A0[i] = *(const bf16x8*)hr; A1[i] = *(const bf16x8*)(hr + 32); } } while (0)
#define FG_GROUP(X0, X1, G_) do { f32x4 acc = (f32x4){0.f, 0.f, 0.f, 0.f}; \
        acc = __builtin_amdgcn_mfma_f32_16x16x32_bf16(b0, X0, acc, 0, 0, 0); acc = __builtin_amdgcn_mfma_f32_16x16x32_bf16(b1, X1, acc, 0, 0, 0); \
        const int lag = (G_) * 16 + col; const float fl = -(float)lag; \
        const float v0 = acc[0] * __builtin_amdgcn_exp2f(fl * dk[0]), v1 = acc[1] * __builtin_amdgcn_exp2f(fl * dk[1]), v2 = acc[2] * __builtin_amdgcn_exp2f(fl * dk[2]), v3 = acc[3] * __builtin_amdgcn_exp2f(fl * dk[3]); \
        if (quad == 0) { g2[lag] = f2bf(v2); g2[L_TOK + lag] = f2bf(v3); \
            if (lag < NMAIN) { CFF(lag) = v0; if (lag >= 1) CFF(32768 - lag) = v1; } else { side[SD_GFX + lag - NMAIN] = v0; side[SD_GBX + lag - NMAIN] = v1; } } \
        else { fq[lag] = f2bf(v0); fq[L_TOK + lag] = f2bf(v1); fq[2 * L_TOK + lag] = f2bf(v2); fq[3 * L_TOK + lag] = f2bf(v3); } } while (0)
#define FG_PROC(A0, A1, GB) do { _Pragma("unroll") for (int i = 0; i < 8; ++i) FG_GROUP(A0[i], A1[i], (GB) + 8 * i); } while (0)
    { bf16x8 pa0[8], pa1[8], pb0[8], pb1[8];
      FG_LOAD(pa0, pa1, wv);
#pragma unroll 1
      for (int m = 0; m < 16; m += 2) { const int gbA = wv + 64 * m, gbB = gbA + 64;
          FG_LOAD(pb0, pb1, gbB);
          FG_PROC(pa0, pa1, gbA);
          if (m + 2 < 16) FG_LOAD(pa0, pa1, gbB + 64);
          FG_PROC(pb0, pb1, gbB); }
      if (wv == 0) { const bf16_t* hr = h3b + (size_t)(1024 * 16 + col) * 64 + quad * 8; const bf16x8 x0 = *(const bf16x8*)hr, x1 = *(const bf16x8*)(hr + 32); FG_GROUP(x0, x1, 1024); } }
#undef FG_LOAD
#undef FG_GROUP
#undef FG_PROC
    if (tid == 0) CFF(NMAIN) = 0.f;
    __syncthreads();
}

__device__ void hyena_unit(const Params& p, int layer, int q, unsigned char* smem, unsigned char* scrD, unsigned char* scratch) {
    const int tid = opaque_tid(); float2* cf = (float2*)smem; float* cff = (float*)smem; float* side = (float*)(smem + 139264);
    const int ch = blockIdx.x + 256 * q;
    const bf16_t* hyin = (const bf16_t*)(p.ws + OFF_HYIN);
    HyCh hc; hc.ru = hyin + (size_t)ch * LP; hc.r1 = hyin + (size_t)(1024 + ch) * LP; hc.r2 = hyin + (size_t)(2048 + ch) * LP;
    { const float* cw = p.conv_w + (size_t)layer * 3 * 3072; const float* cb = p.conv_b + (size_t)layer * 3072;
#pragma unroll
      for (int jj = 0; jj < 3; ++jj) { hc.wu[jj] = cw[jj * 3072 + ch]; hc.w1[jj] = cw[jj * 3072 + 1024 + ch]; hc.w2[jj] = cw[jj * 3072 + 2048 + ch]; }
      hc.wu[3] = cb[ch]; hc.w1[3] = cb[1024 + ch]; hc.w2[3] = cb[2048 + ch]; }
    const float sk0 = p.skip[(layer * 2 + 0) * 1024 + ch], sk1 = p.skip[(layer * 2 + 1) * 1024 + ch];
    float* __restrict__ z2g = (float*)(scratch + HS_Z2);
    const bf16_t* filt = q == 0 ? (const bf16_t*)(scratch + HS_G2) - 2 * (size_t)L_TOK : (const bf16_t*)scrD + (size_t)(q - 1) * 4 * L_TOK;
    bf16_t* __restrict__ hyout = (bf16_t*)(p.ws + OFF_HYOUT) + (size_t)ch * LP;
    if (q > 0) { __syncthreads(); filt_to_lds(filt, filt + L_TOK, cf, side); }
    hy_conv<0>(hc, cf, side, scratch);
    {   u32x4 ru_[4], r1_[4]; float ul[4], uh[4], xl[4], xh[4];
#pragma unroll
        for (int i = 0; i < 4; ++i) { const int c = tid + NTHREADS * i; hy_load8(hc.ru, 8 * c, ru_[i], ul[i], uh[i]); hy_load8(hc.r1, 8 * c, r1_[i], xl[i], xh[i]); }
#pragma unroll
        for (int i = 0; i < 5; ++i) { const int c = i < 4 ? tid + NTHREADS * i : NCHUNK - 2 + tid;
            if (i < 4 || tid < 2) { float u8[8], x8[8];
                if (i < 4) { hy_calc8(ru_[i], ul[i], uh[i], hc.wu, u8); hy_calc8(r1_[i], xl[i], xh[i], hc.w1, x8); } else { hy_val8(hc.ru, 8 * c, hc.wu, u8); hy_val8(hc.r1, 8 * c, hc.w1, x8); }
                const float2* s = cf + PADI(4 * c); const float2 y0 = s[0], y1 = s[1], y2 = s[2], y3 = s[3];
                const f32x4 o0 = (f32x4){x8[0] * (y0.x + sk0 * u8[0]), x8[1] * (y0.y + sk0 * u8[1]), x8[2] * (y1.x + sk0 * u8[2]), x8[3] * (y1.y + sk0 * u8[3])};
                const f32x4 o1 = (f32x4){x8[4] * (y2.x + sk0 * u8[4]), x8[5] * (y2.y + sk0 * u8[5]), x8[6] * (y3.x + sk0 * u8[6]), x8[7] * (y3.y + sk0 * u8[7])};
                *(f32x4*)(z2g + 8 * c) = o0; *(f32x4*)(z2g + 8 * c + 4) = o1; } } }
    __syncthreads();
    filt_to_lds(filt + 2 * (size_t)L_TOK, filt + 3 * (size_t)L_TOK, cf, side);
    hy_conv<1>(hc, cf, side, scratch);
    {   u32x4 r2_[4]; float xl[4], xh[4]; f32x4 z0[4], z1[4];
#pragma unroll
        for (int i = 0; i < 4; ++i) { const int c = tid + NTHREADS * i; hy_load8(hc.r2, 8 * c, r2_[i], xl[i], xh[i]); z0[i] = *(const f32x4*)(z2g + 8 * c); z1[i] = *(const f32x4*)(z2g + 8 * c + 4); }
#pragma unroll
        for (int i = 0; i < 5; ++i) { const int c = i < 4 ? tid + NTHREADS * i : NCHUNK - 2 + tid;
            if (i < 4 || tid < 2) { float x8[8]; f32x4 p0, p1;
                if (i < 4) { hy_calc8(r2_[i], xl[i], xh[i], hc.w2, x8); p0 = z0[i]; p1 = z1[i]; } else { hy_val8(hc.r2, 8 * c, hc.w2, x8); p0 = *(const f32x4*)(z2g + 8 * c); p1 = *(const f32x4*)(z2g + 8 * c + 4); }
                const float2* s = cf + PADI(4 * c); const float2 y0 = s[0], y1 = s[1], y2 = s[2], y3 = s[3];
                u32x4 w; w.x = cvt_pk_bf16(x8[0] * (y0.x + sk1 * p0[0]), x8[1] * (y0.y + sk1 * p0[1])); w.y = cvt_pk_bf16(x8[2] * (y1.x + sk1 * p0[2]), x8[3] * (y1.y + sk1 * p0[3]));
                w.z = cvt_pk_bf16(x8[4] * (y2.x + sk1 * p1[0]), x8[5] * (y2.y + sk1 * p1[1])); w.w = cvt_pk_bf16(x8[6] * (y3.x + sk1 * p1[2]), x8[7] * (y3.y + sk1 * p1[3]));
                *(u32x4*)(hyout + 8 * c) = w; } } }
    __syncthreads();
}

__device__ void transpose_phase(const Params& p, unsigned char* smem) {
    const int tid = opaque_tid(), G = gridDim.x; bf16_t* tile0 = (bf16_t*)smem;
    const bf16_t* __restrict__ hyout = (const bf16_t*)(p.ws + OFF_HYOUT); bf16_t* ya = (bf16_t*)(p.ws + OFF_GATE);
    const int cl = tid >> 3, t8 = (tid & 7) * 8, tl = tid >> 3, c8 = (tid & 7) * 8;
    u32x4 ph = (u32x4){0u, 0u, 0u, 0u}, pg = ph;
    constexpr int TOT = 16 * 257;
    int u = blockIdx.x;
    __syncthreads();
    if (u < TOT) { const int ct = u & 15, tt = u >> 4; ph = *(const u32x4*)(hyout + (size_t)(ct * 64 + cl) * LP + tt * 64 + t8); const int t = tt * 64 + tl; if (t < L_TOK) pg = *(const u32x4*)(ya + (size_t)t * 1024 + ct * 64 + c8); }
    int buf = 0;
    for (; u < TOT; u += G) { bf16_t* tile = tile0 + buf * (64 * 72); const int ct = u & 15, tt = u >> 4;
        *(u32x4*)(tile + cl * 72 + t8) = ph; const u32x4 g = pg;
        { const int un = u + G; if (un < TOT) { const int ct2 = un & 15, tt2 = un >> 4; ph = *(const u32x4*)(hyout + (size_t)(ct2 * 64 + cl) * LP + tt2 * 64 + t8); const int t2 = tt2 * 64 + tl; if (t2 < L_TOK) pg = *(const u32x4*)(ya + (size_t)t2 * 1024 + ct2 * 64 + c8); } }
        __syncthreads();
        const int t = tt * 64 + tl;
        if (t < L_TOK) { float v[8];
#pragma unroll
            for (int i = 0; i < 8; ++i) v[i] = bf2f(tile[(c8 + i) * 72 + tl]);
            u32x4 w; w.x = cvt_pk_bf16(v[0] * lo_bf(g.x), v[1] * hi_bf(g.x)); w.y = cvt_pk_bf16(v[2] * lo_bf(g.y), v[3] * hi_bf(g.y)); w.z = cvt_pk_bf16(v[4] * lo_bf(g.z), v[5] * hi_bf(g.z)); w.w = cvt_pk_bf16(v[6] * lo_bf(g.w), v[7] * hi_bf(g.w));
            *(u32x4*)(ya + (size_t)t * 1024 + ct * 64 + c8) = w; }
        buf ^= 1; }
    __syncthreads();
}

__device__ void phase_final(const Params& p) {
    const int tid = opaque_tid(), lane = tid & 63, wv = tid >> 6; const float* h = (const float*)(p.ws + OFF_H);
    for (int l = NMETA + blockIdx.x * 8 + wv; l < L_TOK; l += gridDim.x * 8) { const f32x4* row = (const f32x4*)(h + (size_t)l * DM); f32x4 v[8]; float ss = 0.f;
#pragma unroll
        for (int i = 0; i < 8; ++i) { v[i] = row[i * 64 + lane]; ss += v[i][0] * v[i][0] + v[i][1] * v[i][1] + v[i][2] * v[i][2] + v[i][3] * v[i][3]; }
        ss = wave_sum(ss); const float inv = rsqrtf(ss * (1.0f / DM) + 1e-6f); f32x4* o = (f32x4*)(p.out + (size_t)(l - NMETA) * DM);
#pragma unroll
        for (int i = 0; i < 8; ++i) { const f32x4 gg = ((const f32x4*)p.final_g)[i * 64 + lane]; o[i * 64 + lane] = v[i] * inv * gg; } }
}

__device__ void mini_branch(const Params& p) {
    const int tid = opaque_tid(), lane = tid & 63, wv = tid >> 6, nt_ = blockIdx.x * 8 + wv;
    if (nt_ < 128) { const int rc = lane & 15, quad = lane >> 4; const int n0 = nt_ * 16;
        const bf16_t* mg = (const bf16_t*)(p.ws + OFF_MERGE); bf16_t* mb = (bf16_t*)(p.ws + OFF_M);
        float tot[4] = {0.f, 0.f, 0.f, 0.f};
#pragma unroll 1
        for (int br = 0; br < 3; ++br) { const bf16_t* A = (const bf16_t*)(p.ws + OFF_GATE + (size_t)br * SZ_GATE) + (size_t)(NMAIN + rc) * 1024 + quad * 8;
            const bf16_t* B = (const bf16_t*)(p.ws + OFF_WA + (size_t)br * SZ_WBR) + (size_t)(n0 + rc) * 1024 + quad * 8;
            f32x4 acc = (f32x4){0.f, 0.f, 0.f, 0.f};
#pragma unroll 1
            for (int kb = 0; kb < 32; kb += 8) { bf16x8 av[8], bv[8];
#pragma unroll
                for (int i = 0; i < 8; ++i) { av[i] = *(const bf16x8*)(A + (kb + i) * 32); bv[i] = *(const bf16x8*)(B + (kb + i) * 32); }
#pragma unroll
                for (int i = 0; i < 8; ++i) acc = __builtin_amdgcn_mfma_f32_16x16x32_bf16(av[i], bv[i], acc, 0, 0, 0); }
#pragma unroll
            for (int r = 0; r < 4; ++r) tot[r] += acc[r] * bf2f(mg[(size_t)(NMAIN + quad * 4 + r) * 6144 + br * 2048 + n0 + rc]); }
#pragma unroll
        for (int r = 0; r < 4; ++r) mb[(size_t)(NMAIN + quad * 4 + r) * DM + n0 + rc] = f2bf(tot[r]); }
}
__device__ void mini_out(const Params& p, int layer) {
    const int tid = opaque_tid(), lane = tid & 63, wv = tid >> 6, nt_ = blockIdx.x * 8 + wv;
    if (nt_ < 128) { const int rc = lane & 15, quad = lane >> 4; const int n0 = nt_ * 16;
        const bf16_t* A = (const bf16_t*)(p.ws + OFF_M) + (size_t)(NMAIN + rc) * DM + quad * 8; const bf16_t* B = (const bf16_t*)(p.ws + OFF_WO) + (size_t)(n0 + rc) * DM + quad * 8;
        f32x4 acc = (f32x4){0.f, 0.f, 0.f, 0.f};
#pragma unroll 1
        for (int kb = 0; kb < 64; kb += 8) { bf16x8 av[8], bv[8];
#pragma unroll
            for (int i = 0; i < 8; ++i) { av[i] = *(const bf16x8*)(A + (kb + i) * 32); bv[i] = *(const bf16x8*)(B + (kb + i) * 32); }
#pragma unroll
            for (int i = 0; i < 8; ++i) acc = __builtin_amdgcn_mfma_f32_16x16x32_bf16(av[i], bv[i], acc, 0, 0, 0); }
        float* h = (float*)(p.ws + OFF_H);
#pragma unroll
        for (int r = 0; r < 4; ++r) { const size_t row = NMAIN + quad * 4 + r; const float bs = layer == 0 ? p.x[(row - NMETA) * DM + n0 + rc] : h[row * DM + n0 + rc]; h[row * DM + n0 + rc] = bs + acc[r]; } }
}

enum { OP_P1 = 0, OP_SYNC, OP_GEMM, OP_NA, OP_HYENA, OP_TRANS, OP_NOP };
__global__ void __launch_bounds__(512, 2) hybrid_fwd(Params p) {
    extern __shared__ __attribute__((aligned(16))) unsigned char smem[];
    cg::grid_group grid = cg::this_grid();
    LAS unsigned char* lds = (LAS unsigned char*)smem;
    const int bid = blockIdx.x, G = gridDim.x;
    phase_prep0(p, smem);
    constexpr int NOPS = 17;
#pragma clang loop unroll(disable)
    for (int step = 0; step < 2 * NOPS; ++step) {
        const int layer = step / NOPS, s = step - layer * NOPS;
        int op, kind = 0;
        switch (s) {
        case 0: op = OP_P1; break;
        case 2: op = OP_GEMM; kind = K_IN; break;
        case 3: case 4: op = OP_NOP; break;
        case 6: op = OP_GEMM; kind = K_FNA; break;
        case 7: op = OP_NA; break;
        case 8: op = OP_HYENA; break;
        case 10: op = OP_GEMM; kind = K_FNB; break;
        case 11: op = OP_TRANS; break;
        case 13: op = OP_GEMM; kind = K_BR; break;
        case 15: op = OP_GEMM; kind = K_OUT; break;
        default: op = OP_SYNC; break;
        }
        if (op == OP_NOP) { }
        else if (op == OP_SYNC) { grid.sync(); }
        else if (op == OP_GEMM) {
            Gemm g; g.base = (const char*)p.ws; g.jumpA = 0; g.jumpB = 0;
            switch (kind) {
            case K_FNA: g.lda = 384; g.ldb = FN1P; g.nt = 6; g.ksplit = 3; g.jumpB = (long)((size_t)1024 * PROWS * 2) - 384l; break;
            case K_FNB: g.lda = 256; g.ldb = 256; g.nt = 4; g.ksplit = 4; break;
            case K_BR:  g.lda = 1024; g.ldb = 1024; g.nt = 16; g.ksplit = 16; break;
            default:    g.lda = DM; g.ldb = DM; g.nt = 32; g.ksplit = 32; break;
            }
            SchedAny S{kind, G, bid}; EpiAny E{kind, p.ws, layer, p.x, p.meta};
            pg8::gemm_phase(lds, g, S, E);
            if (kind == K_BR) mini_branch(p); else if (kind == K_OUT) mini_out(p, layer);
        }
        else if (op == OP_P1) { phase_p1(p, layer, smem); }
        else if (op == OP_NA) { na_phase(p, layer, smem); if (bid == G - 1) na_meta_unit(p, layer); }
        else if (op == OP_HYENA) { unsigned char* scrD = (unsigned char*)p.out + (size_t)bid * HSD_STRIDE; unsigned char* scrW = p.ws + WS_END + (size_t)bid * HSW_STRIDE;
            hyena_filters(p, layer, smem, scrD, scrW);
#pragma clang loop unroll(disable)
            for (int q = 0; q < 4; ++q) hyena_unit(p, layer, q, smem, scrD, scrW); }
        else { transpose_phase(p, smem); }
    }
    phase_final(p);
}

extern "C" void kernel_launch(void* const* d_in, const int* in_sizes, int n_in, void* d_out, int out_size, void* d_ws, size_t ws_size, hipStream_t stream) {
    static int grid_blocks = 0;
    if (grid_blocks == 0) {
        if (n_in != 23 || ws_size < WS_END2) { fprintf(stderr, "kernel_launch: need 23 inputs and %zu bytes of workspace (got %d, %zu)\n", (size_t)WS_END2, n_in, ws_size); grid_blocks = -1; return; }
        int dev = 0, cus = 0, per_cu = 0;
        hipGetDevice(&dev); hipDeviceGetAttribute(&cus, hipDeviceAttributeMultiprocessorCount, dev);
        if (hipFuncSetAttribute((const void*)hybrid_fwd, hipFuncAttributeMaxDynamicSharedMemorySize, LDS_BYTES) != hipSuccess) { fprintf(stderr, "kernel_launch: hipFuncSetAttribute failed\n"); grid_blocks = -1; return; }
        hipOccupancyMaxActiveBlocksPerMultiprocessor(&per_cu, (const void*)hybrid_fwd, NTHREADS, LDS_BYTES);
        if (per_cu < 1) per_cu = 1;
        grid_blocks = cus * per_cu;
        if (grid_blocks > 256) grid_blocks = 256;
        if (grid_blocks != 256) { fprintf(stderr, "kernel_launch: this kernel needs 256 co-resident workgroups (got %d)\n", grid_blocks); grid_blocks = -1; return; }
    }
    if (grid_blocks < 0) return;
    Params p{};
    const float** f = (const float**)&p;
    for (int i = 0; i < 23; ++i) f[i] = (const float*)d_in[i];
    p.out = (float*)d_out; p.ws = (unsigned char*)d_ws;
    void* args[] = {&p};
    hipError_t e = hipLaunchCooperativeKernel((const void*)hybrid_fwd, dim3(grid_blocks), dim3(NTHREADS), args, LDS_BYTES, stream);
    if (e != hipSuccess) fprintf(stderr, "cooperative launch failed: %s (grid %d)\n", hipGetErrorString(e), grid_blocks);
}
```

```cpp
#include <hip/hip_runtime.h>
#include <hip/hip_cooperative_groups.h>
#include <cstdio>
namespace cg = cooperative_groups;

#define LAS __attribute__((address_space(3)))
typedef unsigned short bf16_t;
typedef short bf16x8 __attribute__((ext_vector_type(8)));
typedef float f32x4 __attribute__((ext_vector_type(4)));
typedef unsigned u32x4 __attribute__((ext_vector_type(4)));
typedef unsigned u32x2 __attribute__((ext_vector_type(2)));

constexpr int L_TOK = 16400, LP = 16640, DM = 2048, NIN = 16384, NMETA = 16, NMAIN = 16384;
constexpr int FN1 = 164, FN2 = 100, FN1P = 192, PROWS = FN2 * FN1P;
constexpr int NTHREADS = 512, LDS_BYTES = 155648;

constexpr size_t SZ_H = (size_t)LP * DM * 4, SZ_XN = (size_t)LP * DM * 2, SZ_XNP = (size_t)PROWS * DM * 2;
constexpr size_t OFF_H = 0;
constexpr size_t OFF_XN = OFF_H + SZ_H;
constexpr size_t OFF_XNP = OFF_XN + SZ_XN;
constexpr size_t OFF_A1 = OFF_XN;
constexpr size_t SZ_A1 = (size_t)FN1 * 1024 * 2 * 128 * 2;
constexpr size_t OFF_HYOUT = OFF_A1 + SZ_A1;
constexpr size_t SZ_HYOUT = (size_t)1024 * LP * 2;
static_assert(OFF_HYOUT + SZ_HYOUT <= OFF_XNP + SZ_XNP, "alias overflow");
constexpr size_t OFF_WT = OFF_XNP + SZ_XNP;
constexpr size_t OFF_WEFF = OFF_WT + (size_t)NIN * DM * 2;
constexpr size_t OFF_WA = OFF_WEFF + (size_t)2048 * 2048 * 2;
constexpr size_t SZ_WBR = (size_t)2048 * 1024 * 2;
constexpr size_t OFF_WO = OFF_WA + 3 * SZ_WBR;
constexpr size_t OFF_HYIN = OFF_WO + (size_t)2048 * 2048 * 2;
constexpr size_t OFF_GATE = OFF_HYIN + (size_t)3072 * LP * 2;
constexpr size_t SZ_GATE = (size_t)LP * 1024 * 2;
constexpr size_t OFF_QKV = OFF_GATE + 3 * SZ_GATE;
constexpr size_t OFF_MERGE = OFF_QKV + (size_t)LP * 3072 * 2;
constexpr size_t OFF_ZT = OFF_MERGE + (size_t)LP * 6144 * 2;
constexpr size_t SZ_ZT = (size_t)2048 * PROWS * 2;
constexpr size_t OFF_M = OFF_ZT;
static_assert(SZ_XN <= SZ_ZT, "alias overflow");
constexpr size_t OFF_FA = OFF_ZT + SZ_ZT;
constexpr size_t OFF_FB = OFF_FA + (size_t)512 * 384 * 2;
constexpr size_t OFF_H3 = OFF_FB + (size_t)FN1 * 256 * 256 * 2;
constexpr size_t WS_END = OFF_H3 + (size_t)2 * L_TOK * 64 * 4;
constexpr size_t HS_HEO = 0, HS_Z2 = 131328, HS_G2 = HS_Z2 + 65792, HSW_STRIDE = HS_G2 + 65792;
constexpr size_t FILT_BYTES = (size_t)L_TOK * 2, HSD_STRIDE = 393728;
constexpr size_t WS_END2 = WS_END + 256 * HSW_STRIDE;
static_assert(HSD_STRIDE >= 12 * FILT_BYTES && HSD_STRIDE * 256 <= (size_t)NMAIN * DM * 4, "scratch overflow");

struct Params {
    const float* x; const float* meta; const float* norm_g; const float* w_in; const float* conv_w; const float* conv_b;
    const float* f_w1; const float* f_b1; const float* f_w2; const float* f_b2; const float* f_w3; const float* f_b3; const float* f_w4;
    const float* f_freq; const float* decay; const float* skip; const float* rpb; const float* meta_bias;
    const float* w_a; const float* w_b; const float* w_c; const float* w_out; const float* final_g;
    float* out; unsigned char* ws;
};

__device__ __forceinline__ int opaque_tid() { int t = threadIdx.x; asm volatile("" : "+v"(t)); return t; }
__device__ __forceinline__ float bf2f(bf16_t b) { return __uint_as_float(((unsigned)b) << 16); }
__device__ __forceinline__ bf16_t f2bf(float f) { unsigned u = __float_as_uint(f); u += 0x7FFFu + ((u >> 16) & 1u); return (bf16_t)(u >> 16); }
__device__ __forceinline__ unsigned cvt_pk_bf16(float lo, float hi) { unsigned r; asm volatile("v_cvt_pk_bf16_f32 %0, %1, %2" : "=v"(r) : "v"(lo), "v"(hi)); return r; }
__device__ __forceinline__ float lo_bf(unsigned u) { return __uint_as_float(u << 16); }
__device__ __forceinline__ float hi_bf(unsigned u) { return __uint_as_float(u & 0xffff0000u); }
__device__ __forceinline__ float silu_f(float v) { return v * __builtin_amdgcn_rcpf(1.0f + __expf(-v)); }
__device__ __forceinline__ float sigm_f(float v) { return __builtin_amdgcn_rcpf(1.0f + __expf(-v)); }
__device__ __forceinline__ float wave_sum(float v) {
#pragma unroll
    for (int o = 32; o >= 1; o >>= 1) v += __shfl_xor(v, o);
    return v;
}

namespace pg8 {
constexpr int BM = 256, BK = 64, HALF = 128, HTB = HALF * BK * 2, STAGE_BYTES = 8 * HTB;
__device__ __forceinline__ int lds_byte(int r, int c) { const int st = (r >> 4) * 2 + (c >> 5), rr = r & 15, cc = c & 31, ob = rr * 64 + cc * 2; return st * 1024 + (ob ^ (((ob >> 9) & 1) << 5)); }
__device__ __forceinline__ void stage_rc(int b, int& R, int& C) { const int st = b / 1024, sb = b % 1024, swz = sb ^ (((sb >> 9) & 1) << 5); R = (st >> 1) * 16 + swz / 64; C = (st & 1) * 32 + (swz % 64) / 2; }
__device__ __forceinline__ int perm32(int rho) { const int n = rho >> 4, i = rho & 15; return 8 * (i >> 2) + 4 * n + (i & 3); }

struct Unit { int pm, pn, aux; size_t offA, offB; };
struct Gemm { const char* base; int lda, ldb, nt, ksplit; long jumpA, jumpB; };

__device__ __forceinline__ void tile_map(int wgid, int nM, int nN, int& pm, int& pn) {
    const int nwg = nM * nN;
    { const int q = nwg / 8, r = nwg % 8, xcd = wgid % 8, off = wgid / 8; wgid = (xcd < r ? xcd * (q + 1) : r * (q + 1) + (xcd - r) * q) + off; }
    const int nig = 8 * nN, gid = wgid / nig, fm = gid * 8, gsz = (nM - fm) < 8 ? (nM - fm) : 8;
    pm = fm + ((wgid % nig) % gsz); pn = (wgid % nig) / gsz;
}

template <class Epi, class Sched>
__device__ __forceinline__ void gemm_phase(LAS unsigned char* lds, const Gemm g, const Sched& S, const Epi& E) {
    const int tid = opaque_tid(), wid = __builtin_amdgcn_readfirstlane(tid >> 6), lane = tid & 63, wr = wid >> 2, wc = wid & 3, fr = lane & 15, fq = lane >> 4;
    const int nt = g.nt;
    unsigned voffA[2], voffB[2];
#pragma unroll
    for (int i = 0; i < 2; ++i) { int R, C; stage_rc(tid * 16 + i * 8192, R, C); const int Rb = (R & ~31) + perm32(R & 31);
        voffA[i] = (unsigned)(R * g.lda + C) * 2u; voffB[i] = (unsigned)(Rb * g.ldb + C) * 2u; }
    const size_t kstep = (size_t)(BK * 2);
    const size_t hstepA = (size_t)HALF * g.lda * 2, hstepB = (size_t)HALF * g.ldb * 2;
    const unsigned ldsw = (unsigned)wid * 1024u;
    const int aoff = lds_byte(wr * 64 + fr, fq * 8), boff = lds_byte(wc * 32 + fr, fq * 8);
#define PG8_KA(p, t) ((p) + (size_t)(t) * kstep + ((t) >= g.ksplit ? g.jumpA : 0l))
#define PG8_KB(p, t) ((p) + (size_t)(t) * kstep + ((t) >= g.ksplit ? g.jumpB : 0l))
#define PG8_SA(b, h) (((b) * 2 + (h)) * HTB)
#define PG8_SB(b, h) ((4 + (b) * 2 + (h)) * HTB)
#define PG8_STAGE(bufoff, gbase, voff) do { _Pragma("unroll") for (int _i = 0; _i < 2; ++_i) \
        __builtin_amdgcn_global_load_lds((const unsigned*)((const char*)(gbase) + (voff)[_i]), (LAS unsigned*)(lds + (bufoff) + ldsw + _i * 8192), 16, 0, 0); } while (0)
#define PG8_LDA(dst, b, h) do { _Pragma("unroll") for (int m = 0; m < 4; ++m) _Pragma("unroll") for (int k = 0; k < 2; ++k) dst[m][k] = *(const LAS bf16x8*)(lds + PG8_SA(b, h) + aoff + m * 2048 + k * 1024); } while (0)
#define PG8_LDB(dst, b, h) do { _Pragma("unroll") for (int n = 0; n < 2; ++n) _Pragma("unroll") for (int k = 0; k < 2; ++k) dst[n][k] = *(const LAS bf16x8*)(lds + PG8_SB(b, h) + boff + n * 2048 + k * 1024); } while (0)
#define PG8_MMA(ai, bj, At, Bt) do { __builtin_amdgcn_s_setprio(1); _Pragma("unroll") for (int m = 0; m < 4; ++m) _Pragma("unroll") for (int n = 0; n < 2; ++n) _Pragma("unroll") for (int k = 0; k < 2; ++k) \
        acc[ai][bj][m][n] = __builtin_amdgcn_mfma_f32_16x16x32_bf16(Bt[n][k], At[m][k], acc[ai][bj][m][n], 0, 0, 0); __builtin_amdgcn_s_setprio(0); } while (0)
#define PG8_WAIT_V(n) asm volatile("s_waitcnt vmcnt(" #n ")" ::: "memory")
#define PG8_WAIT_L(n) asm volatile("s_waitcnt lgkmcnt(" #n ")" ::: "memory")
#define PG8_BAR __builtin_amdgcn_s_barrier()
#define PG8_SCHED __builtin_amdgcn_sched_barrier(0)
    Unit cur, nxt; int ui = 0;
    if (!S.next(0, cur)) return;
    f32x4 acc[2][2][4][2];
#pragma unroll
    for (int a = 0; a < 2; ++a)
#pragma unroll
        for (int b = 0; b < 2; ++b)
#pragma unroll
            for (int m = 0; m < 4; ++m)
#pragma unroll
                for (int n = 0; n < 2; ++n) acc[a][b][m][n] = (f32x4){0.f, 0.f, 0.f, 0.f};
    bf16x8 At[4][2], B0[2][2], B1[2][2];
    const char* cA = g.base + cur.offA; const char* cB = g.base + cur.offB;
    PG8_STAGE(PG8_SB(0, 0), cB, voffB); PG8_STAGE(PG8_SA(0, 0), cA, voffA); PG8_STAGE(PG8_SB(0, 1), cB + hstepB, voffB); PG8_STAGE(PG8_SA(0, 1), cA + hstepA, voffA);
    if (wr == 1) PG8_BAR;
    PG8_WAIT_V(4); PG8_BAR;
    PG8_STAGE(PG8_SB(1, 0), PG8_KB(cB, 1), voffB); PG8_STAGE(PG8_SA(1, 0), PG8_KA(cA, 1), voffA); PG8_STAGE(PG8_SB(1, 1), PG8_KB(cB, 1) + hstepB, voffB);
    PG8_WAIT_V(6); PG8_BAR;
    for (;;) {
        const bool has_next = S.next(ui + 1, nxt);
        const char* nA = has_next ? g.base + nxt.offA : cA; const char* nB = has_next ? g.base + nxt.offB : cB;
        for (int t = 0; t < nt; t += 2) {
            const bool last = (t == nt - 2);
            const char* a1 = PG8_KA(cA, t + 1);
            const char* a2 = last ? nA : PG8_KA(cA, t + 2); const char* b2 = last ? nB : PG8_KB(cB, t + 2);
            const char* a3 = last ? PG8_KA(nA, 1) : PG8_KA(cA, t + 3); const char* b3 = last ? PG8_KB(nB, 1) : PG8_KB(cB, t + 3);
            PG8_LDB(B0, 0, 0); PG8_SCHED; PG8_LDA(At, 0, 0); PG8_STAGE(PG8_SA(1, 1), a1 + hstepA, voffA);
            PG8_WAIT_L(8); PG8_BAR; PG8_WAIT_L(0); PG8_MMA(0, 0, At, B0); PG8_BAR; PG8_SCHED;
            PG8_LDB(B1, 0, 1); PG8_STAGE(PG8_SB(0, 0), b2, voffB);
            PG8_BAR; PG8_WAIT_L(0); PG8_MMA(0, 1, At, B1); PG8_BAR;
            PG8_LDA(At, 0, 1); PG8_STAGE(PG8_SA(0, 0), a2, voffA);
            PG8_BAR; PG8_WAIT_L(0); PG8_MMA(1, 0, At, B0); PG8_BAR; PG8_SCHED;
            PG8_STAGE(PG8_SB(0, 1), b2 + hstepB, voffB);
            PG8_WAIT_V(6); PG8_BAR; PG8_MMA(1, 1, At, B1); PG8_BAR;
            PG8_LDB(B0, 1, 0); PG8_SCHED; PG8_LDA(At, 1, 0); PG8_STAGE(PG8_SA(0, 1), a2 + hstepA, voffA);
            PG8_WAIT_L(8); PG8_BAR; PG8_WAIT_L(0); PG8_MMA(0, 0, At, B0); PG8_BAR; PG8_SCHED;
            PG8_LDB(B1, 1, 1); PG8_STAGE(PG8_SB(1, 0), b3, voffB);
            PG8_BAR; PG8_WAIT_L(0); PG8_MMA(0, 1, At, B1); PG8_BAR;
            PG8_LDA(At, 1, 1); PG8_STAGE(PG8_SA(1, 0), a3, voffA);
            PG8_BAR; PG8_WAIT_L(0); PG8_MMA(1, 0, At, B0); PG8_BAR; PG8_SCHED;
            PG8_STAGE(PG8_SB(1, 1), b3 + hstepB, voffB);
            PG8_WAIT_V(6); PG8_BAR; PG8_MMA(1, 1, At, B1); PG8_BAR;
        }
        E(acc, cur, wr, wc, fr, fq);
        if (!has_next) break;
#pragma unroll
        for (int a = 0; a < 2; ++a)
#pragma unroll
            for (int b = 0; b < 2; ++b)
#pragma unroll
                for (int m = 0; m < 4; ++m)
#pragma unroll
                    for (int n = 0; n < 2; ++n) acc[a][b][m][n] = (f32x4){0.f, 0.f, 0.f, 0.f};
        cur = nxt; cA = nA; cB = nB; ++ui;
    }
    PG8_WAIT_V(0);
    if (wr == 0) PG8_BAR;
    PG8_BAR;
#undef PG8_KA
#undef PG8_KB
#undef PG8_SA
#undef PG8_SB
#undef PG8_STAGE
#undef PG8_LDA
#undef PG8_LDB
#undef PG8_MMA
#undef PG8_WAIT_V
#undef PG8_WAIT_L
#undef PG8_BAR
#undef PG8_SCHED
}
}
using pg8::Unit; using pg8::Gemm;
#define ACC_T const f32x4 (&acc)[2][2][4][2]

enum { K_TOK = 0, K_HYIN = 1, K_F0 = 2, K_FNA = 3, K_FNB = 4, K_BR = 5, K_OUT = 6, K_IN = 7 };
struct SchedAny {
    int kind, G, c;
    __device__ __forceinline__ bool next(int i, Unit& u) const {
        const long Lx = (long)i * G + c;
        switch (kind) {
        case K_IN: {
            if (Lx < 3120) { int pn; pg8::tile_map((int)Lx, 65, 48, u.pm, pn); u.pn = pn < 4 ? 12 + pn : 16 + pn; u.aux = K_TOK;
                u.offA = OFF_XN + (size_t)u.pm * 256 * DM * 2; u.offB = OFF_WT + (size_t)u.pn * 256 * DM * 2; return true; }
            if (Lx < 3900) { pg8::tile_map((int)Lx - 3120, 12, 65, u.pm, u.pn); u.aux = K_HYIN;
                u.offA = OFF_WT + (size_t)u.pm * 256 * DM * 2; u.offB = OFF_XN + (size_t)u.pn * 256 * DM * 2; return true; }
            if (Lx < 4200) { pg8::tile_map((int)Lx - 3900, 4, 75, u.pm, u.pn); u.aux = K_F0;
                u.offA = OFF_WEFF + (size_t)u.pm * 256 * DM * 2; u.offB = OFF_XNP + (size_t)u.pn * 256 * DM * 2; return true; }
            return false; }
        case K_TOK: {
            if (Lx >= 65l * 48) return false; int pn; pg8::tile_map((int)Lx, 65, 48, u.pm, pn); u.pn = pn < 4 ? 12 + pn : 16 + pn; u.aux = 0;
            u.offA = OFF_XN + (size_t)u.pm * 256 * DM * 2; u.offB = OFF_WT + (size_t)u.pn * 256 * DM * 2; return true; }
        case K_HYIN: {
            if (Lx >= 12l * 65) return false; pg8::tile_map((int)Lx, 12, 65, u.pm, u.pn); u.aux = 0;
            u.offA = OFF_WT + (size_t)u.pm * 256 * DM * 2; u.offB = OFF_XN + (size_t)u.pn * 256 * DM * 2; return true; }
        case K_F0: {
            if (Lx >= 8l * 75) return false; pg8::tile_map((int)Lx, 8, 75, u.pm, u.pn); u.aux = 0;
            u.offA = OFF_WEFF + (size_t)u.pm * 256 * DM * 2; u.offB = OFF_XNP + (size_t)u.pn * 256 * DM * 2; return true; }
        case K_FNA: {
            if (Lx >= 2l * 400) return false; pg8::tile_map((int)Lx, 2, 400, u.pm, u.pn); u.aux = 0;
            u.offA = OFF_FA + (size_t)u.pm * 256 * 384 * 2; u.offB = OFF_ZT + (size_t)u.pn * 256 * FN1P * 2; return true; }
        case K_FNB: {
            if (Lx >= 164l * 4) return false; u.aux = (int)(Lx >> 2); u.pm = 0; u.pn = (int)(Lx & 3);
            u.offA = OFF_FB + (size_t)u.aux * 256 * 256 * 2; u.offB = OFF_A1 + (size_t)u.aux * 1024 * 256 * 2 + (size_t)u.pn * 256 * 256 * 2; return true; }
        case K_BR: {
            const int T = (i / 3) * G + c; if (T >= 64 * 8) return false; const int br = i % 3; pg8::tile_map(T, 64, 8, u.pm, u.pn); u.aux = br;
            u.offA = OFF_GATE + (size_t)br * SZ_GATE + (size_t)u.pm * 256 * 1024 * 2; u.offB = OFF_WA + (size_t)br * SZ_WBR + (size_t)u.pn * 256 * 1024 * 2; return true; }
        default: {
            if (Lx >= 64l * 8) return false; pg8::tile_map((int)Lx, 64, 8, u.pm, u.pn); u.aux = 0;
            u.offA = OFF_M + (size_t)u.pm * 256 * DM * 2; u.offB = OFF_WO + (size_t)u.pn * 256 * DM * 2; return true; }
        }
    }
};
#define ROWFENCE asm volatile("" ::: "memory")
#define HARDFENCE do { asm volatile("" ::: "memory"); __builtin_amdgcn_sched_barrier(0); } while (0)
struct EpiAny {
    int kind; unsigned char* ws; int layer; const float* xin; const float* metain;
    __device__ __forceinline__ void operator()(ACC_T, const Unit& u, int wr, int wc, int fr, int fq) const {
        const int rl0 = wr * 64 + fr, cl0 = wc * 32 + 8 * fq;
        const int ek = kind == K_IN ? u.aux : kind;
        if (ek == K_TOK) {
            const int t = u.pn; unsigned char* dst; unsigned ld; int c0, act;
            if (t < 16)      { dst = ws + OFF_GATE;               ld = 1024; c0 = (t - 12) * 256; act = 1; }
            else if (t < 24) { dst = ws + OFF_GATE + SZ_GATE;     ld = 1024; c0 = (t - 20) * 256; act = 1; }
            else if (t < 36) { dst = ws + OFF_QKV;                ld = 3072; c0 = (t - 24) * 256; act = 0; }
            else if (t < 40) { dst = ws + OFF_GATE + 2 * SZ_GATE; ld = 1024; c0 = (t - 36) * 256; act = 1; }
            else             { dst = ws + OFF_MERGE;              ld = 6144; c0 = (t - 40) * 256; act = 2; }
#pragma unroll
            for (int ai = 0; ai < 2; ++ai)
#pragma unroll
                for (int m = 0; m < 4; ++m) { const unsigned row = (unsigned)(u.pm * 256 + ai * 128 + m * 16 + rl0);
#pragma unroll
                    for (int bj = 0; bj < 2; ++bj) { const unsigned off = (row * ld + (unsigned)(c0 + bj * 128 + cl0)) * 2u; f32x4 v0 = acc[ai][bj][m][0], v1 = acc[ai][bj][m][1];
                        if (act == 1) {
#pragma unroll
                            for (int j = 0; j < 4; ++j) { v0[j] = silu_f(v0[j]); v1[j] = silu_f(v1[j]); } }
                        else if (act == 2) {
#pragma unroll
                            for (int j = 0; j < 4; ++j) { v0[j] = sigm_f(v0[j]); v1[j] = sigm_f(v1[j]); } }
                        u32x4 w; w.x = cvt_pk_bf16(v0[0], v0[1]); w.y = cvt_pk_bf16(v0[2], v0[3]); w.z = cvt_pk_bf16(v1[0], v1[1]); w.w = cvt_pk_bf16(v1[2], v1[3]);
                        *(u32x4*)(dst + off) = w; }
                    ROWFENCE; }
        } else if (ek == K_HYIN) {
            unsigned char* dst = ws + OFF_HYIN; const unsigned ld = LP;
#pragma unroll
            for (int ai = 0; ai < 2; ++ai)
#pragma unroll
                for (int m = 0; m < 4; ++m) { const unsigned row = (unsigned)(u.pm * 256 + ai * 128 + m * 16 + rl0);
#pragma unroll
                    for (int bj = 0; bj < 2; ++bj) { const unsigned off = (row * ld + (unsigned)(u.pn * 256 + bj * 128 + cl0)) * 2u; const f32x4 v0 = acc[ai][bj][m][0], v1 = acc[ai][bj][m][1];
                        u32x4 w; w.x = cvt_pk_bf16(v0[0], v0[1]); w.y = cvt_pk_bf16(v0[2], v0[3]); w.z = cvt_pk_bf16(v1[0], v1[1]); w.w = cvt_pk_bf16(v1[2], v1[3]);
                        *(u32x4*)(dst + off) = w; }
                    ROWFENCE; }
        } else if (ek == K_F0) {
            int rlx = rl0, clx = cl0; asm volatile("" : "+v"(rlx), "+v"(clx));
            unsigned char* dst = ws + OFF_ZT; const int g = u.pm; const unsigned colb0 = (unsigned)(u.pn * 256 + clx) * 2u;
#pragma unroll
            for (int ai = 0; ai < 2; ++ai)
#pragma unroll
                for (int m = 0; m < 4; ++m) { const int j = ai * 128 + m * 16 + rlx; const int part = j <= 128 ? 0 : 1; const int cp = j - 128 * part;
                    const unsigned o1 = (unsigned)(part * 1024 + g * 256 + cp) * (unsigned)(PROWS * 2) + colb0;
                    const bool mir = cp >= 1 && cp <= 127; const bool zim = part == 0 && !mir;
                    const unsigned o2 = (unsigned)((mir ? part : 1) * 1024 + g * 256 + (mir ? 256 - cp : cp)) * (unsigned)(PROWS * 2) + colb0;
                    const unsigned sgn = part == 1 ? 0x80008000u : 0u, msk = zim ? 0u : 0xffffffffu;
#pragma unroll
                    for (int bj = 0; bj < 2; ++bj) { const f32x4 v0 = acc[ai][bj][m][0], v1 = acc[ai][bj][m][1];
                        u32x4 w; w.x = cvt_pk_bf16(v0[0], v0[1]); w.y = cvt_pk_bf16(v0[2], v0[3]); w.z = cvt_pk_bf16(v1[0], v1[1]); w.w = cvt_pk_bf16(v1[2], v1[3]);
                        *(u32x4*)(dst + o1 + bj * 256) = w;
                        u32x4 wm; wm.x = (w.x ^ sgn) & msk; wm.y = (w.y ^ sgn) & msk; wm.z = (w.z ^ sgn) & msk; wm.w = (w.w ^ sgn) & msk;
                        *(u32x4*)(dst + o2 + bj * 256) = wm; }
                    ROWFENCE; }
        } else if (ek == K_FNA) {
            unsigned char* dst = ws + OFF_A1;
#pragma unroll
            for (int ai = 0; ai < 2; ++ai)
#pragma unroll
                for (int m = 0; m < 4; ++m) { const int k1 = ai * 128 + m * 16 + rl0;
                    if (k1 < FN1) {
#pragma unroll
                        for (int bj = 0; bj < 2; ++bj)
#pragma unroll
                            for (int n = 0; n < 2; ++n) { const int col = u.pn * 256 + bj * 128 + cl0 + 4 * n; const int ch = col / FN2, l2 = col - ch * FN2; const f32x4 v = acc[ai][bj][m][n];
                                u32x2 w; w.x = cvt_pk_bf16(v[0], v[1]); w.y = cvt_pk_bf16(v[2], v[3]);
                                *(u32x2*)(dst + ((unsigned)((k1 * 1024 + ch) * 2 + u.pm) * 128u + (unsigned)l2) * 2u) = w; } }
                    ROWFENCE; }
        } else if (ek == K_FNB) {
            unsigned char* dst = ws + OFF_GATE + SZ_GATE; const float scale = 1.0f / sqrtf((float)L_TOK * 256.0f);
#pragma unroll
            for (int ai = 0; ai < 2; ++ai)
#pragma unroll
                for (int m = 0; m < 4; ++m) { const int k2 = ai * 128 + m * 16 + rl0;
                    if (k2 < FN2) { const unsigned row = (unsigned)(u.aux + FN1 * k2);
#pragma unroll
                        for (int bj = 0; bj < 2; ++bj) { const unsigned off = (row * 1024u + (unsigned)(u.pn * 256 + bj * 128 + cl0)) * 2u; const u32x4 g = *(const u32x4*)(dst + off);
                            const f32x4 v0 = acc[ai][bj][m][0] * scale, v1 = acc[ai][bj][m][1] * scale;
                            u32x4 w; w.x = cvt_pk_bf16(v0[0] * lo_bf(g.x), v0[1] * hi_bf(g.x)); w.y = cvt_pk_bf16(v0[2] * lo_bf(g.y), v0[3] * hi_bf(g.y));
                            w.z = cvt_pk_bf16(v1[0] * lo_bf(g.z), v1[1] * hi_bf(g.z)); w.w = cvt_pk_bf16(v1[2] * lo_bf(g.w), v1[3] * hi_bf(g.w));
                            *(u32x4*)(dst + off) = w; } }
                    ROWFENCE; }
        } else if (ek == K_BR) {
            unsigned char* dst = ws + OFF_M; const unsigned char* mg = ws + OFF_MERGE; const int br = u.aux;
#pragma unroll
            for (int ai = 0; ai < 2; ++ai) { u32x4 gq[4][2], oq[4][2];
#pragma unroll
                for (int m = 0; m < 4; ++m) { const unsigned row = (unsigned)(u.pm * 256 + ai * 128 + m * 16 + rl0);
#pragma unroll
                    for (int bj = 0; bj < 2; ++bj) { const unsigned col = (unsigned)(u.pn * 256 + bj * 128 + cl0);
                        gq[m][bj] = *(const u32x4*)(mg + (row * 6144u + (unsigned)br * 2048u + col) * 2u);
                        if (br > 0) oq[m][bj] = *(const u32x4*)(dst + (row * (unsigned)DM + col) * 2u); else oq[m][bj] = (u32x4){0u, 0u, 0u, 0u}; } }
#pragma unroll
                for (int m = 0; m < 4; ++m) { const unsigned row = (unsigned)(u.pm * 256 + ai * 128 + m * 16 + rl0);
#pragma unroll
                    for (int bj = 0; bj < 2; ++bj) { const unsigned col = (unsigned)(u.pn * 256 + bj * 128 + cl0); const unsigned off = (row * (unsigned)DM + col) * 2u;
                        const u32x4 g = gq[m][bj], o = oq[m][bj]; const f32x4 v0 = acc[ai][bj][m][0], v1 = acc[ai][bj][m][1];
                        const float r0 = v0[0] * lo_bf(g.x) + lo_bf(o.x), r1 = v0[1] * hi_bf(g.x) + hi_bf(o.x), r2 = v0[2] * lo_bf(g.y) + lo_bf(o.y), r3 = v0[3] * hi_bf(g.y) + hi_bf(o.y);
                        const float r4 = v1[0] * lo_bf(g.z) + lo_bf(o.z), r5 = v1[1] * hi_bf(g.z) + hi_bf(o.z), r6 = v1[2] * lo_bf(g.w) + lo_bf(o.w), r7 = v1[3] * hi_bf(g.w) + hi_bf(o.w);
                        u32x4 w; w.x = cvt_pk_bf16(r0, r1); w.y = cvt_pk_bf16(r2, r3); w.z = cvt_pk_bf16(r4, r5); w.w = cvt_pk_bf16(r6, r7);
                        *(u32x4*)(dst + off) = w; } }
                ROWFENCE; }
        } else {
            unsigned char* dst = ws + OFF_H;
#pragma unroll
            for (int ai = 0; ai < 2; ++ai) { f32x4 oq[4][2][2];
#pragma unroll
                for (int m = 0; m < 4; ++m) { const unsigned row = (unsigned)(u.pm * 256 + ai * 128 + m * 16 + rl0);
                    const float* srow = layer == 0 ? (row < (unsigned)NMETA ? metain + (size_t)row * DM : xin + (size_t)(row - NMETA) * DM) : (const float*)(dst + (size_t)row * DM * 4);
#pragma unroll
                    for (int bj = 0; bj < 2; ++bj) { const unsigned col = (unsigned)(u.pn * 256 + bj * 128 + cl0); oq[m][bj][0] = *(const f32x4*)(srow + col); oq[m][bj][1] = *(const f32x4*)(srow + col + 4); } }
#pragma unroll
                for (int m = 0; m < 4; ++m) { const unsigned row = (unsigned)(u.pm * 256 + ai * 128 + m * 16 + rl0);
#pragma unroll
                    for (int bj = 0; bj < 2; ++bj) { const unsigned off = (row * (unsigned)DM + (unsigned)(u.pn * 256 + bj * 128 + cl0)) * 4u;
                        *(f32x4*)(dst + off) = oq[m][bj][0] + acc[ai][bj][m][0]; *(f32x4*)(dst + off + 16) = oq[m][bj][1] + acc[ai][bj][m][1]; } }
                ROWFENCE; }
        }
    }
};

__device__ void phase_prep0(const Params& p, unsigned char* smem) {
    const int tid = opaque_tid(), bid = blockIdx.x, G = gridDim.x;
    const size_t gtid = (size_t)bid * NTHREADS + tid, gstride = (size_t)G * NTHREADS;
    { bf16_t* fa = (bf16_t*)(p.ws + OFF_FA);
      for (size_t i = gtid; i < (size_t)512 * 384; i += gstride) { const int row = (int)(i / 384), col = (int)(i % 384); const int po = row >> 8, k1 = row & 255, pi = col / 192, l1 = col % 192; float v = 0.f;
          if (k1 < FN1 && l1 < FN1) { const int r = (k1 * l1) % FN1; const float a = 2.0f * (float)r / (float)FN1; const float cs = cospif(a), sn = sinpif(a);
              v = (po == 0) ? (pi == 0 ? cs : sn) : (pi == 0 ? -sn : cs); }
          fa[i] = f2bf(v); } }
    { bf16_t* fb = (bf16_t*)(p.ws + OFF_FB);
      for (size_t i = gtid; i < (size_t)FN1 * 65536; i += gstride) { const int k1 = (int)(i >> 16), k2 = (int)((i >> 8) & 255), kk = (int)(i & 255), part = kk >> 7, l2 = kk & 127; float v = 0.f;
          if (k2 < FN2 && l2 < FN2) { const int lp = k1 + FN1 * k2; const int r = (l2 * lp) % L_TOK; const float a = 2.0f * (float)r / (float)L_TOK; v = part == 0 ? cospif(a) : sinpif(a); }
          fb[i] = f2bf(v); } }
    { float* w1s = (float*)smem;
      float* w2s = w1s + 33 * 64;
      float* w3s = w2s + 64 * 64;
      const int lane = tid & 63, wv = tid >> 6;
      for (int layer = 0; layer < 2; ++layer) {
          __syncthreads();
          for (int i = tid; i < 33 * 64; i += NTHREADS) w1s[i] = p.f_w1[layer * 33 * 64 + i];
          for (int i = tid; i < 64 * 64; i += NTHREADS) { w2s[i] = p.f_w2[layer * 4096 + i]; w3s[i] = p.f_w3[layer * 4096 + i]; }
          __syncthreads();
          const float b1 = p.f_b1[layer * 64 + lane], b2 = p.f_b2[layer * 64 + lane], b3 = p.f_b3[layer * 64 + lane], fr = p.f_freq[layer * 64 + lane];
          bf16_t* h3 = (bf16_t*)(p.ws + OFF_H3) + (size_t)layer * L_TOK * 64;
          for (int lag = bid * 8 + wv; lag < L_TOK; lag += G * 8) {
              const float tt = (float)lag / (float)(L_TOK - 1); const float w = 6.283185307179586f * (float)lag / (float)L_TOK;
              float z = 0.f;
              if (lane == 0) z = tt;
              else if (lane < 33) { const int j = (lane - 1) & 15; const float f = 1e-4f + (float)j * ((15.0f - 1e-4f) / 15.0f); const float a = f * w; z = lane < 17 ? cosf(a) : -sinf(a); }
              float a1 = b1;
#pragma unroll 3
              for (int i = 0; i < 33; ++i) a1 += __shfl(z, i) * w1s[i * 64 + lane];
              const float h1 = sinf(fr * a1);
              float a2 = b2;
#pragma unroll 8
              for (int i = 0; i < 64; ++i) a2 += __shfl(h1, i) * w2s[i * 64 + lane];
              const float h2 = sinf(fr * a2);
              float a3 = b3;
#pragma unroll 8
              for (int i = 0; i < 64; ++i) a3 += __shfl(h2, i) * w3s[i * 64 + lane];
              h3[(size_t)lag * 64 + lane] = f2bf(sinf(fr * a3));
          }
      }
      __syncthreads(); }
}

__device__ void convert_matrix(const float* __restrict__ src, int K, int N, bf16_t* __restrict__ dst, int kshift  , int total, float* tile  ) {
    const int tid = opaque_tid(), G = gridDim.x; const int kl0 = tid >> 4, n4 = (tid & 15) * 4, nl = tid >> 3, k8 = (tid & 7) * 8;
    f32x4 pv0 = (f32x4){0.f, 0.f, 0.f, 0.f}, pv1 = pv0;
    int t = blockIdx.x;
    if (t < total) { const int kt = t & ((1 << kshift) - 1), nt_ = t >> kshift; const float* s = src + (size_t)(kt * 64 + kl0) * N + nt_ * 64 + n4; pv0 = *(const f32x4*)s; pv1 = *(const f32x4*)(s + (size_t)32 * N); }
    int buf = 0;
    for (; t < total; t += G) { float* tl = tile + buf * (64 * 65); const int kt = t & ((1 << kshift) - 1), nt_ = t >> kshift;
        tl[kl0 * 65 + n4] = pv0[0]; tl[kl0 * 65 + n4 + 1] = pv0[1]; tl[kl0 * 65 + n4 + 2] = pv0[2]; tl[kl0 * 65 + n4 + 3] = pv0[3];
        tl[(32 + kl0) * 65 + n4] = pv1[0]; tl[(32 + kl0) * 65 + n4 + 1] = pv1[1]; tl[(32 + kl0) * 65 + n4 + 2] = pv1[2]; tl[(32 + kl0) * 65 + n4 + 3] = pv1[3];
        { const int tn = t + G; if (tn < total) { const int kt2 = tn & ((1 << kshift) - 1), nt2 = tn >> kshift; const float* s = src + (size_t)(kt2 * 64 + kl0) * N + nt2 * 64 + n4; pv0 = *(const f32x4*)s; pv1 = *(const f32x4*)(s + (size_t)32 * N); } }
        __syncthreads();
        u32x4 w; w.x = cvt_pk_bf16(tl[(k8 + 0) * 65 + nl], tl[(k8 + 1) * 65 + nl]); w.y = cvt_pk_bf16(tl[(k8 + 2) * 65 + nl], tl[(k8 + 3) * 65 + nl]);
        w.z = cvt_pk_bf16(tl[(k8 + 4) * 65 + nl], tl[(k8 + 5) * 65 + nl]); w.w = cvt_pk_bf16(tl[(k8 + 6) * 65 + nl], tl[(k8 + 7) * 65 + nl]);
        *(u32x4*)(dst + (size_t)(nt_ * 64 + nl) * K + kt * 64 + k8) = w;
        buf ^= 1; }
    __syncthreads();
}

__device__ void phase_p1(const Params& p, int layer, unsigned char* smem) {
    const int tid = opaque_tid(), bid = blockIdx.x, G = gridDim.x;
    float* tile = (float*)smem;
    { const float* win = p.w_in + (size_t)layer * DM * NIN;
      convert_matrix(win, DM, NIN, (bf16_t*)(p.ws + OFF_WT), 5, 32 * 256, tile);
      for (int br = 0; br < 3; ++br) { const float* wsrc = (br == 0 ? p.w_a : br == 1 ? p.w_b : p.w_c) + (size_t)layer * 1024 * DM;
          convert_matrix(wsrc, 1024, DM, (bf16_t*)(p.ws + OFF_WA + br * SZ_WBR), 4, 16 * 32, tile); }
      const float* wo = p.w_out + (size_t)layer * DM * DM;
      convert_matrix(wo, DM, DM, (bf16_t*)(p.ws + OFF_WO), 5, 32 * 32, tile);
      __syncthreads(); }
    { float* tileT = (float*)smem;
      float* ctab = tileT + 256 * 32;
      float* stab = ctab + 256;
      const float* win = p.w_in + (size_t)layer * DM * NIN;
      for (int t = bid; t < 256; t += G) { const int g = t >> 6, k0 = (t & 63) * 32;
          __syncthreads();
          if (tid < 256) { const float a = 2.0f * (float)tid / 256.0f; ctab[tid] = cospif(a); stab[tid] = sinpif(a); }
#pragma unroll
          for (int ps = 0; ps < 4; ++ps) { const int idx = ps * NTHREADS + tid; const int kl = idx >> 6, c4 = (idx & 63) * 4;
              const f32x4 v = *(const f32x4*)(win + (size_t)(k0 + kl) * NIN + 4096 + g * 256 + c4);
              tileT[(c4 + 0) * 32 + kl] = v[0]; tileT[(c4 + 1) * 32 + kl] = v[1]; tileT[(c4 + 2) * 32 + kl] = v[2]; tileT[(c4 + 3) * 32 + kl] = v[3]; }
          __syncthreads();
          const int jrow = tid & 255, kh = tid >> 8; const int part = jrow <= 128 ? 0 : 1; const int cp = part == 0 ? jrow : jrow - 128;
          float acc[16];
#pragma unroll
          for (int k = 0; k < 16; ++k) acc[k] = 0.f;
          for (int c = 0; c < 256; ++c) { const int r = (c * cp) & 255; const float tw = part == 0 ? ctab[r] : -stab[r];
#pragma unroll
              for (int k4 = 0; k4 < 4; ++k4) { const f32x4 v = *(const f32x4*)(tileT + c * 32 + kh * 16 + k4 * 4); acc[k4 * 4 + 0] += v[0] * tw; acc[k4 * 4 + 1] += v[1] * tw; acc[k4 * 4 + 2] += v[2] * tw; acc[k4 * 4 + 3] += v[3] * tw; } }
          bf16_t* dst = (bf16_t*)(p.ws + OFF_WEFF) + (size_t)(g * 256 + jrow) * DM + k0 + kh * 16;
#pragma unroll
          for (int k8 = 0; k8 < 2; ++k8) { u32x4 w; w.x = cvt_pk_bf16(acc[k8 * 8 + 0], acc[k8 * 8 + 1]); w.y = cvt_pk_bf16(acc[k8 * 8 + 2], acc[k8 * 8 + 3]); w.z = cvt_pk_bf16(acc[k8 * 8 + 4], acc[k8 * 8 + 5]); w.w = cvt_pk_bf16(acc[k8 * 8 + 6], acc[k8 * 8 + 7]);
              *(u32x4*)(dst + k8 * 8) = w; } }
      __syncthreads(); }
    { const int lane = tid & 63, wv = tid >> 6; const float* h = (const float*)(p.ws + OFF_H); const float* gam = p.norm_g + layer * DM;
      bf16_t* xn = (bf16_t*)(p.ws + OFF_XN); bf16_t* xnp = (bf16_t*)(p.ws + OFF_XNP);
      for (int l = bid * 8 + wv; l < LP; l += G * 8) {
          if (l < L_TOK) { const f32x4* row = (const f32x4*)(layer == 0 ? (l < NMETA ? p.meta + (size_t)l * DM : p.x + (size_t)(l - NMETA) * DM) : h + (size_t)l * DM); f32x4 v[8]; float ss = 0.f;
#pragma unroll
              for (int i = 0; i < 8; ++i) { v[i] = row[i * 64 + lane]; ss += v[i][0] * v[i][0] + v[i][1] * v[i][1] + v[i][2] * v[i][2] + v[i][3] * v[i][3]; }
              ss = wave_sum(ss); const float inv = rsqrtf(ss * (1.0f / DM) + 1e-6f);
              const int l1 = l / FN2, l2 = l - l1 * FN2; const size_t pr = (size_t)l2 * FN1P + l1;
#pragma unroll
              for (int i = 0; i < 8; ++i) { const f32x4 gg = ((const f32x4*)gam)[i * 64 + lane]; u32x2 w; w.x = cvt_pk_bf16(v[i][0] * inv * gg[0], v[i][1] * inv * gg[1]); w.y = cvt_pk_bf16(v[i][2] * inv * gg[2], v[i][3] * inv * gg[3]);
                  *(u32x2*)(xn + (size_t)l * DM + (i * 64 + lane) * 4) = w; *(u32x2*)(xnp + pr * DM + (i * 64 + lane) * 4) = w; } }
          else { const u32x2 z = (u32x2){0u, 0u};
#pragma unroll
              for (int i = 0; i < 8; ++i) *(u32x2*)(xn + (size_t)l * DM + (i * 64 + lane) * 4) = z; } }
      for (int idx = bid * 8 + wv; idx < FN2 * (FN1P - FN1); idx += G * 8) { const int l2 = idx / (FN1P - FN1), l1 = FN1 + idx % (FN1P - FN1); const size_t pr = (size_t)l2 * FN1P + l1; const u32x2 z = (u32x2){0u, 0u};
#pragma unroll
          for (int i = 0; i < 8; ++i) *(u32x2*)(xnp + pr * DM + (i * 64 + lane) * 4) = z; } }
}

__device__ void na_phase(const Params& p, int layer, unsigned char* smem) {
    const int tid = opaque_tid(), wv = tid >> 6, lane = tid & 63, l15 = lane & 15, quad = lane >> 4;
    const int G = gridDim.x;
    const bf16_t* qkv = (const bf16_t*)(p.ws + OFF_QKV);
    unsigned char* sK = smem;
    bf16_t* sVT = (bf16_t*)(smem + 76032);
    float* sRPB = (float*)(smem + 144640);
    float* sMB = (float*)(smem + 146512);
    const int cb = wv & 3, hf = wv >> 2, c = cb * 16 + l15;
    const int cu = cb == 0 ? 0 : (cb == 1 ? 8 : (cb == 2 ? 24 : 32)), cs = min(max(c - 8, 0), 48);
    u32x4 pk[8], pv[8], pmk = (u32x4){0u, 0u, 0u, 0u}, pmv = (u32x4){0u, 0u, 0u, 0u}; bf16x8 pq0, pq1; float prp = 0.f;
#define NA_LOADS(U) do { const int r_ = (U) >> 4, hd_ = (U) & 15, r0_ = min(max(r_ - 4, 0), 248); \
        _Pragma("unroll") for (int ps = 0; ps < 8; ++ps) { const int tok = ps * 64 + (tid >> 3), ch = tid & 7; const size_t g = (size_t)(NMETA + r0_ * 64 + tok) * 3072 + hd_ * 64 + ch * 8; \
            pk[ps] = *(const u32x4*)(qkv + g + 1024); pv[ps] = *(const u32x4*)(qkv + g + 2048); } \
        if (tid < 128) { const size_t g = (size_t)(tid >> 3) * 3072 + hd_ * 64 + (tid & 7) * 8; pmk = *(const u32x4*)(qkv + g + 1024); pmv = *(const u32x4*)(qkv + g + 2048); } \
        { const bf16_t* qp = qkv + (size_t)(NMETA + r_ * 64 + c) * 3072 + hd_ * 64 + quad * 8; pq0 = *(const bf16x8*)qp; pq1 = *(const bf16x8*)(qp + 32); } \
        if (tid < 465) prp = p.rpb[(size_t)(layer * 16 + hd_) * 465 + tid]; else if (tid >= 480 && tid < 496) prp = p.meta_bias[(layer * 16 + hd_) * 16 + tid - 480]; } while (0)
    int u = blockIdx.x;
    if (u < 4096) NA_LOADS(u);
    for (; u < 4096; u += G) {
        const int r = u >> 4, hd = u & 15, r0 = min(max(r - 4, 0), 248);
        __syncthreads();
#pragma unroll
        for (int ps = 0; ps < 8; ++ps) { const int tok = ps * 64 + (tid >> 3), ch = tid & 7; const u32x4 vv = pv[ps];
            *(u32x4*)(sK + tok * 144 + ch * 16) = pk[ps];
            bf16_t* vt = sVT + (ch * 8) * 536 + tok;
            vt[0] = (bf16_t)vv.x; vt[536] = (bf16_t)(vv.x >> 16); vt[2 * 536] = (bf16_t)vv.y; vt[3 * 536] = (bf16_t)(vv.y >> 16);
            vt[4 * 536] = (bf16_t)vv.z; vt[5 * 536] = (bf16_t)(vv.z >> 16); vt[6 * 536] = (bf16_t)vv.w; vt[7 * 536] = (bf16_t)(vv.w >> 16); }
        if (tid < 128) { const int tok = tid >> 3, ch = tid & 7; const u32x4 vv = pmv;
            *(u32x4*)(sK + (512 + tok) * 144 + ch * 16) = pmk;
            bf16_t* vt = sVT + (ch * 8) * 536 + 512 + tok;
            vt[0] = (bf16_t)vv.x; vt[536] = (bf16_t)(vv.x >> 16); vt[2 * 536] = (bf16_t)vv.y; vt[3 * 536] = (bf16_t)(vv.y >> 16);
            vt[4 * 536] = (bf16_t)vv.z; vt[5 * 536] = (bf16_t)(vv.z >> 16); vt[6 * 536] = (bf16_t)vv.w; vt[7 * 536] = (bf16_t)(vv.w >> 16); }
        if (tid < 465) sRPB[tid] = prp; else if (tid >= 480 && tid < 496) sMB[tid - 480] = prp;
        const bf16x8 bq0 = pq0, bq1 = pq1;
        { const int un = u + G; if (un < 4096) NA_LOADS(un); }
        __syncthreads();
        bf16_t* yc = (bf16_t*)(p.ws + OFF_GATE + 2 * SZ_GATE);
        float gatev[4][4];
        if (hf == 0) {
#pragma unroll
            for (int rr = 0; rr < 4; ++rr)
#pragma unroll
                for (int dt = 0; dt < 4; ++dt) gatev[rr][dt] = bf2f(yc[(size_t)(NMETA + r * 64 + cb * 16 + quad * 4 + rr) * 1024 + hd * 64 + l15 + dt * 16]); }
        float sc[9][4];
#pragma unroll
        for (int ti = 0; ti < 9; ++ti) { const int j = 4 * hf + (ti >> 1), tt = ti & 1; const int slot0 = ti < 8 ? j * 64 + cu + tt * 16 : 512;
            const unsigned char* kp = sK + (slot0 + l15) * 144 + quad * 16;
            const bf16x8 a0 = *(const bf16x8*)kp, a1 = *(const bf16x8*)(kp + 64);
            f32x4 acc = (f32x4){0.f, 0.f, 0.f, 0.f};
            acc = __builtin_amdgcn_mfma_f32_16x16x32_bf16(a0, bq0, acc, 0, 0, 0); acc = __builtin_amdgcn_mfma_f32_16x16x32_bf16(a1, bq1, acc, 0, 0, 0);
            if (ti < 8) { const float* rp = sRPB + (r0 + j - r + 7) * 31 + (15 - c);
#pragma unroll
                for (int rr = 0; rr < 4; ++rr) { const int kc = cu + tt * 16 + quad * 4 + rr; const bool ok = kc >= cs && kc < cs + 16; const int kcc = ok ? kc : cs;
                    sc[ti][rr] = ok ? acc[rr] * 0.125f + rp[kcc] : -1.0e30f; } }
            else {
#pragma unroll
                for (int rr = 0; rr < 4; ++rr) sc[ti][rr] = hf == 0 ? acc[rr] * 0.125f + sMB[quad * 4 + rr] : -1.0e30f; } }
        float mx = -1.0e30f;
#pragma unroll
        for (int ti = 0; ti < 9; ++ti)
#pragma unroll
            for (int rr = 0; rr < 4; ++rr) mx = fmaxf(mx, sc[ti][rr]);
        mx = fmaxf(mx, __shfl_xor(mx, 16)); mx = fmaxf(mx, __shfl_xor(mx, 32));
        float lsum = 0.f;
#pragma unroll
        for (int ti = 0; ti < 9; ++ti)
#pragma unroll
            for (int rr = 0; rr < 4; ++rr) { sc[ti][rr] = __expf(sc[ti][rr] - mx); lsum += sc[ti][rr]; }
        lsum += __shfl_xor(lsum, 16); lsum += __shfl_xor(lsum, 32);
        f32x4 oacc[4];
#pragma unroll
        for (int dt = 0; dt < 4; ++dt) oacc[dt] = (f32x4){0.f, 0.f, 0.f, 0.f};
#pragma unroll
        for (int ks = 0; ks < 5; ++ks) { const int tA = 2 * ks, tB = 2 * ks + 1;
            const int jA = 4 * hf + (tA >> 1); const int slotA = tA < 8 ? jA * 64 + cu + (tA & 1) * 16 : 512; const int slotB = ks < 4 ? (4 * hf + (tB >> 1)) * 64 + cu + 16 : 512;
            u32x4 pa; pa.x = cvt_pk_bf16(sc[tA][0], sc[tA][1]); pa.y = cvt_pk_bf16(sc[tA][2], sc[tA][3]);
            if (ks < 4) { pa.z = cvt_pk_bf16(sc[tA + 1 < 9 ? tA + 1 : 8][0], sc[tA + 1 < 9 ? tA + 1 : 8][1]); pa.w = cvt_pk_bf16(sc[tA + 1 < 9 ? tA + 1 : 8][2], sc[tA + 1 < 9 ? tA + 1 : 8][3]); } else { pa.z = 0u; pa.w = 0u; }
            const bf16x8 af = __builtin_bit_cast(bf16x8, pa);
#pragma unroll
            for (int dt = 0; dt < 4; ++dt) { const bf16_t* vr = sVT + (dt * 16 + l15) * 536 + quad * 4;
                const u32x2 lo = *(const u32x2*)(vr + slotA), hi = *(const u32x2*)(vr + slotB);
                const u32x4 bb = (u32x4){lo.x, lo.y, hi.x, hi.y};
                oacc[dt] = __builtin_amdgcn_mfma_f32_16x16x32_bf16(af, __builtin_bit_cast(bf16x8, bb), oacc[dt], 0, 0, 0); } }
        __syncthreads();
        float* part = (float*)smem + cb * 1056;
        if (hf == 1) {
#pragma unroll
            for (int dt = 0; dt < 4; ++dt)
#pragma unroll
                for (int rr = 0; rr < 4; ++rr) part[(quad * 4 + rr) * 64 + dt * 16 + l15] = oacc[dt][rr];
            if (quad == 0) { part[1024 + l15] = mx; part[1040 + l15] = lsum; } }
        __syncthreads();
        if (hf == 0) {
#pragma unroll
            for (int rr = 0; rr < 4; ++rr) { const int qy = quad * 4 + rr; const float m0 = __shfl(mx, qy), l0 = __shfl(lsum, qy); const float m1 = part[1024 + qy], l1 = part[1040 + qy];
                const float M = fmaxf(m0, m1), f0 = __expf(m0 - M), f1 = __expf(m1 - M); const float inv = 1.0f / (f0 * l0 + f1 * l1);
                bf16_t* gp = yc + (size_t)(NMETA + r * 64 + cb * 16 + qy) * 1024 + hd * 64 + l15;
#pragma unroll
                for (int dt = 0; dt < 4; ++dt) { const float o = (f0 * oacc[dt][rr] + f1 * part[qy * 64 + dt * 16 + l15]) * inv; gp[dt * 16] = f2bf(o * gatev[rr][dt]); } } }
    }
#undef NA_LOADS
}
__device__ void na_meta_unit(const Params& p, int layer) {
    const int tid = opaque_tid();
    if (tid < 256) { const int hd = tid >> 4, qi = tid & 15; const bf16_t* qkv = (const bf16_t*)(p.ws + OFF_QKV);
        float q[64];
        { const u32x4* qp = (const u32x4*)(qkv + (size_t)qi * 3072 + hd * 64);
#pragma unroll
          for (int i = 0; i < 8; ++i) { const u32x4 v = qp[i]; q[i * 8 + 0] = lo_bf(v.x) * 0.125f; q[i * 8 + 1] = hi_bf(v.x) * 0.125f; q[i * 8 + 2] = lo_bf(v.y) * 0.125f; q[i * 8 + 3] = hi_bf(v.y) * 0.125f;
              q[i * 8 + 4] = lo_bf(v.z) * 0.125f; q[i * 8 + 5] = hi_bf(v.z) * 0.125f; q[i * 8 + 6] = lo_bf(v.w) * 0.125f; q[i * 8 + 7] = hi_bf(v.w) * 0.125f; } }
        float o[64];
#pragma unroll
        for (int i = 0; i < 64; ++i) o[i] = 0.f;
        float mx = -3.0e38f, lsum = 0.f;
#pragma unroll 1
        for (int m = 0; m < 16; ++m) { const u32x4* kp = (const u32x4*)(qkv + (size_t)m * 3072 + 1024 + hd * 64); const u32x4* vp = (const u32x4*)(qkv + (size_t)m * 3072 + 2048 + hd * 64);
            float d0 = 0.f, d1 = 0.f;
#pragma unroll
            for (int e = 0; e < 8; ++e) { const u32x4 v = kp[e];
                d0 += q[e * 8 + 0] * lo_bf(v.x) + q[e * 8 + 2] * lo_bf(v.y) + q[e * 8 + 4] * lo_bf(v.z) + q[e * 8 + 6] * lo_bf(v.w);
                d1 += q[e * 8 + 1] * hi_bf(v.x) + q[e * 8 + 3] * hi_bf(v.y) + q[e * 8 + 5] * hi_bf(v.z) + q[e * 8 + 7] * hi_bf(v.w); }
            const float sc = d0 + d1 + p.meta_bias[(layer * 16 + hd) * 16 + m]; const float mnew = fmaxf(mx, sc); const float alpha = __expf(mx - mnew), pi = __expf(sc - mnew);
            lsum = lsum * alpha + pi; mx = mnew;
#pragma unroll
            for (int e = 0; e < 8; ++e) { const u32x4 v = vp[e];
                o[e * 8 + 0] = o[e * 8 + 0] * alpha + pi * lo_bf(v.x); o[e * 8 + 1] = o[e * 8 + 1] * alpha + pi * hi_bf(v.x); o[e * 8 + 2] = o[e * 8 + 2] * alpha + pi * lo_bf(v.y); o[e * 8 + 3] = o[e * 8 + 3] * alpha + pi * hi_bf(v.y);
                o[e * 8 + 4] = o[e * 8 + 4] * alpha + pi * lo_bf(v.z); o[e * 8 + 5] = o[e * 8 + 5] * alpha + pi * hi_bf(v.z); o[e * 8 + 6] = o[e * 8 + 6] * alpha + pi * lo_bf(v.w); o[e * 8 + 7] = o[e * 8 + 7] * alpha + pi * hi_bf(v.w); } }
        const float inv = 1.0f / lsum; u32x4* gp = (u32x4*)((bf16_t*)(p.ws + OFF_GATE + 2 * SZ_GATE) + (size_t)qi * 1024 + hd * 64);
#pragma unroll
        for (int e = 0; e < 8; ++e) { const u32x4 g = gp[e]; u32x4 w;
            w.x = cvt_pk_bf16(o[e * 8 + 0] * inv * lo_bf(g.x), o[e * 8 + 1] * inv * hi_bf(g.x)); w.y = cvt_pk_bf16(o[e * 8 + 2] * inv * lo_bf(g.y), o[e * 8 + 3] * inv * hi_bf(g.y));
            w.z = cvt_pk_bf16(o[e * 8 + 4] * inv * lo_bf(g.z), o[e * 8 + 5] * inv * hi_bf(g.z)); w.w = cvt_pk_bf16(o[e * 8 + 6] * inv * lo_bf(g.w), o[e * 8 + 7] * inv * hi_bf(g.w));
            gp[e] = w; } }
}

__device__ __forceinline__ unsigned rev4_14(unsigned k) { unsigned r = __brev(k) >> 18; return ((r & 0x1555u) << 1) | ((r >> 1) & 0x1555u); }
__device__ __forceinline__ float2 cmul(float2 a, float2 b) { return make_float2(a.x * b.x - a.y * b.y, a.x * b.y + a.y * b.x); }
#define PADI(i) ((i) + ((i) >> 4))
#define CFF(n) cff[2 * PADI((n) >> 1) + ((n) & 1)]
__device__ __forceinline__ void hw_sincos(float rev, float& sn, float& cs) { sn = __builtin_amdgcn_sinf(rev); cs = __builtin_amdgcn_cosf(rev); }
__device__ __forceinline__ float c16(int k) { const float t[10] = {1.0f, 0.9238795325f, 0.7071067812f, 0.3826834324f, 0.0f, -0.3826834324f, -0.7071067812f, -0.9238795325f, -1.0f, -0.9238795325f}; return t[k]; }
__device__ __forceinline__ float s16(int k) { const float t[10] = {0.0f, 0.3826834324f, 0.7071067812f, 0.9238795325f, 1.0f, 0.9238795325f, 0.7071067812f, 0.3826834324f, 0.0f, -0.3826834324f}; return t[k]; }
__device__ __forceinline__ float2 cadd(float2 a, float2 b) { return make_float2(a.x + b.x, a.y + b.y); }
__device__ __forceinline__ float2 csub(float2 a, float2 b) { return make_float2(a.x - b.x, a.y - b.y); }
template <int SGN> __device__ __forceinline__ void bf4(float2& a0, float2& a1, float2& a2, float2& a3) {
    const float2 t0 = cadd(a0, a2), t1 = csub(a0, a2), t2 = cadd(a1, a3), d = csub(a1, a3);
    const float2 t3 = SGN < 0 ? make_float2(d.y, -d.x) : make_float2(-d.y, d.x);
    a0 = cadd(t0, t2); a1 = cadd(t1, t3); a2 = csub(t0, t2); a3 = csub(t1, t3);
}
template <int S> __device__ __forceinline__ void r16_fwd_pass(float2* a) {
    constexpr int Q = S / 4;
    for (int u = opaque_tid(); u < 1024; u += NTHREADS) { const int j = u & (Q - 1); const int base = ((u - j) << 4) + j;
        float2 x[4][4];
#pragma unroll
        for (int aa = 0; aa < 4; ++aa)
#pragma unroll
            for (int bb = 0; bb < 4; ++bb) x[aa][bb] = a[PADI(base + aa * S + bb * Q)];
        float sn, cs; hw_sincos((float)j / (float)(4 * S), sn, cs); const float2 wb0 = make_float2(cs, -sn);
#pragma unroll
        for (int bb = 0; bb < 4; ++bb) { const float2 w1 = bb == 0 ? wb0 : cmul(wb0, make_float2(c16(bb), -s16(bb))); const float2 w2 = cmul(w1, w1), w3 = cmul(w2, w1);
            bf4<-1>(x[0][bb], x[1][bb], x[2][bb], x[3][bb]); x[1][bb] = cmul(x[1][bb], w1); x[2][bb] = cmul(x[2][bb], w2); x[3][bb] = cmul(x[3][bb], w3); }
        hw_sincos((float)j / (float)S, sn, cs); const float2 v1 = make_float2(cs, -sn), v2 = cmul(v1, v1), v3 = cmul(v2, v1);
#pragma unroll
        for (int aa = 0; aa < 4; ++aa) { bf4<-1>(x[aa][0], x[aa][1], x[aa][2], x[aa][3]); x[aa][1] = cmul(x[aa][1], v1); x[aa][2] = cmul(x[aa][2], v2); x[aa][3] = cmul(x[aa][3], v3); }
#pragma unroll
        for (int aa = 0; aa < 4; ++aa)
#pragma unroll
            for (int bb = 0; bb < 4; ++bb) a[PADI(base + aa * S + bb * Q)] = x[aa][bb]; }
    __syncthreads();
}
template <int S> __device__ __forceinline__ void r16_inv_pass(float2* a) {
    constexpr int Q = S / 4;
    for (int u = opaque_tid(); u < 1024; u += NTHREADS) { const int j = u & (Q - 1); const int base = ((u - j) << 4) + j;
        float2 x[4][4];
#pragma unroll
        for (int aa = 0; aa < 4; ++aa)
#pragma unroll
            for (int bb = 0; bb < 4; ++bb) x[aa][bb] = a[PADI(base + aa * S + bb * Q)];
        float sn, cs; hw_sincos((float)j / (float)S, sn, cs); const float2 v1 = make_float2(cs, sn), v2 = cmul(v1, v1), v3 = cmul(v2, v1);
#pragma unroll
        for (int aa = 0; aa < 4; ++aa) { x[aa][1] = cmul(x[aa][1], v1); x[aa][2] = cmul(x[aa][2], v2); x[aa][3] = cmul(x[aa][3], v3); bf4<1>(x[aa][0], x[aa][1], x[aa][2], x[aa][3]); }
        hw_sincos((float)j / (float)(4 * S), sn, cs); const float2 wb0 = make_float2(cs, sn);
#pragma unroll
        for (int bb = 0; bb < 4; ++bb) { const float2 w1 = bb == 0 ? wb0 : cmul(wb0, make_float2(c16(bb), s16(bb))); const float2 w2 = cmul(w1, w1), w3 = cmul(w2, w1);
            x[1][bb] = cmul(x[1][bb], w1); x[2][bb] = cmul(x[2][bb], w2); x[3][bb] = cmul(x[3][bb], w3); bf4<1>(x[0][bb], x[1][bb], x[2][bb], x[3][bb]); }
#pragma unroll
        for (int aa = 0; aa < 4; ++aa)
#pragma unroll
            for (int bb = 0; bb < 4; ++bb) a[PADI(base + aa * S + bb * Q)] = x[aa][bb]; }
    __syncthreads();
}
__device__ void fft_fwd(float2* a) {
    r16_fwd_pass<4096>(a);
    r16_fwd_pass<256>(a);
    { const int span = 16;
        for (int b = opaque_tid(); b < 4096; b += NTHREADS) { const int j = b & (span - 1); const int base = ((b - j) << 2) + j;
            const int i0 = PADI(base), i1 = PADI(base + span), i2 = PADI(base + 2 * span), i3 = PADI(base + 3 * span);
            float2 a0 = a[i0], a1 = a[i1], a2 = a[i2], a3 = a[i3];
            const float2 w1 = make_float2(c16(0) * 0.f + __builtin_amdgcn_cosf((float)j * (1.0f / 64.0f)), -__builtin_amdgcn_sinf((float)j * (1.0f / 64.0f))), w2 = cmul(w1, w1), w3 = cmul(w2, w1);
            bf4<-1>(a0, a1, a2, a3);
            a[i0] = a0; a[i1] = cmul(a1, w1); a[i2] = cmul(a2, w2); a[i3] = cmul(a3, w3); }
        __syncthreads(); }
    for (int blk = opaque_tid(); blk < 1024; blk += NTHREADS) { float2* pb = a + blk * 17; float2 x[16];
#pragma unroll
        for (int e = 0; e < 16; ++e) x[e] = pb[e];
#pragma unroll
        for (int j = 0; j < 4; ++j) { bf4<-1>(x[j], x[j + 4], x[j + 8], x[j + 12]);
            x[j + 4] = cmul(x[j + 4], make_float2(c16(j), -s16(j))); x[j + 8] = cmul(x[j + 8], make_float2(c16(2 * j), -s16(2 * j))); x[j + 12] = cmul(x[j + 12], make_float2(c16(3 * j), -s16(3 * j))); }
#pragma unroll
        for (int g = 0; g < 4; ++g) bf4<-1>(x[4 * g], x[4 * g + 1], x[4 * g + 2], x[4 * g + 3]);
#pragma unroll
        for (int e = 0; e < 16; ++e) pb[e] = x[e]; }
    __syncthreads();
}
__device__ void fft_inv(float2* a) {
    for (int blk = opaque_tid(); blk < 1024; blk += NTHREADS) { float2* pb = a + blk * 17; float2 x[16];
#pragma unroll
        for (int e = 0; e < 16; ++e) x[e] = pb[e];
#pragma unroll
        for (int g = 0; g < 4; ++g) bf4<1>(x[4 * g], x[4 * g + 1], x[4 * g + 2], x[4 * g + 3]);
#pragma unroll
        for (int j = 0; j < 4; ++j) { x[j + 4] = cmul(x[j + 4], make_float2(c16(j), s16(j))); x[j + 8] = cmul(x[j + 8], make_float2(c16(2 * j), s16(2 * j))); x[j + 12] = cmul(x[j + 12], make_float2(c16(3 * j), s16(3 * j)));
            bf4<1>(x[j], x[j + 4], x[j + 8], x[j + 12]); }
#pragma unroll
        for (int e = 0; e < 16; ++e) pb[e] = x[e]; }
    __syncthreads();
    { const int span = 16;
        for (int b = opaque_tid(); b < 4096; b += NTHREADS) { const int j = b & (span - 1); const int base = ((b - j) << 2) + j;
            const int i0 = PADI(base), i1 = PADI(base + span), i2 = PADI(base + 2 * span), i3 = PADI(base + 3 * span);
            const float2 w1 = make_float2(__builtin_amdgcn_cosf((float)j * (1.0f / 64.0f)), __builtin_amdgcn_sinf((float)j * (1.0f / 64.0f))), w2 = cmul(w1, w1), w3 = cmul(w2, w1);
            float2 a0 = a[i0], a1 = cmul(a[i1], w1), a2 = cmul(a[i2], w2), a3 = cmul(a[i3], w3);
            bf4<1>(a0, a1, a2, a3);
            a[i0] = a0; a[i1] = a1; a[i2] = a2; a[i3] = a3; }
        __syncthreads(); }
    r16_inv_pass<256>(a);
    r16_inv_pass<4096>(a);
}
__device__ __forceinline__ void hy_load8(const bf16_t* __restrict__ row, int t0, u32x4& v, float& xl, float& xh) {
    v = *(const u32x4*)(row + t0); xl = t0 > 0 ? bf2f(row[t0 - 1]) : 0.f; xh = (t0 + 8 < L_TOK) ? bf2f(row[t0 + 8]) : 0.f;
}
__device__ __forceinline__ void hy_calc8(const u32x4 v, float xl, float xh, const float (&w)[4], float (&o)[8]) {
    float x[10];
    x[0] = xl; x[9] = xh;
    x[1] = lo_bf(v.x); x[2] = hi_bf(v.x); x[3] = lo_bf(v.y); x[4] = hi_bf(v.y); x[5] = lo_bf(v.z); x[6] = hi_bf(v.z); x[7] = lo_bf(v.w); x[8] = hi_bf(v.w);
#pragma unroll
    for (int e = 0; e < 8; ++e) o[e] = w[0] * x[e] + w[1] * x[e + 1] + w[2] * x[e + 2] + w[3];
}
__device__ __forceinline__ void hy_val8(const bf16_t* __restrict__ row, int t0, const float (&w)[4], float (&o)[8]) { u32x4 v; float xl, xh; hy_load8(row, t0, v, xl, xh); hy_calc8(v, xl, xh, w, o); }
struct HyCh { const bf16_t* __restrict__ ru; const bf16_t* __restrict__ r1; const bf16_t* __restrict__ r2; float wu[4], w1[4], w2[4]; };

constexpr int SD_W4B = 0  , SD_GFX = 512, SD_GBX = 528, SD_EF = 544, SD_EB = 560, SD_VH = 576, SD_VT = 592, SD_END = 608;
constexpr int NCHUNK = L_TOK / 8;

template <int ORDER>
__device__ void hy_conv(const HyCh& hc, float2* cf, float* side, unsigned char* scratch) {
    const int tid = opaque_tid(); float* cff = (float*)cf;
    f32x4* __restrict__ heo = (f32x4*)(scratch + HS_HEO); const float* __restrict__ z2g = (const float*)(scratch + HS_Z2);
    if (tid < 15) side[SD_EF + tid] = CFF(16369 + tid); else if (tid >= 32 && tid < 47) side[SD_EB + tid - 32] = CFF(32768 - (16369 + tid - 32));
    __syncthreads();
    fft_fwd(cf);
    for (int j = tid; j <= 8192; j += NTHREADS) { const unsigned i_ = j < 8192 ? ((((unsigned)j >> 1) << 2) | ((unsigned)j & 1u)) : 2u; const unsigned k = rev4_14(i_); const unsigned kp = (16384u - k) & 16383u; const float2 a = cf[PADI(i_)], bq = cf[PADI(rev4_14(kp))];
        const float bx = bq.x, by = -bq.y; const float sc = 1.0f / 16384.0f;
        heo[j] = (f32x4){0.5f * (a.x + bx) * sc, 0.5f * (a.y + by) * sc, 0.5f * (a.y - by) * sc, -0.5f * (a.x - bx) * sc}; }
    __syncthreads();
    {
        u32x4 rv[4]; float rl[4], rh[4]; f32x4 z0[4], z1[4];
#pragma unroll
        for (int i = 0; i < 4; ++i) { const int c = tid + NTHREADS * i;
            if (ORDER == 0) hy_load8(hc.ru, 8 * c, rv[i], rl[i], rh[i]); else { z0[i] = *(const f32x4*)(z2g + 8 * c); z1[i] = *(const f32x4*)(z2g + 8 * c + 4); } }
#pragma unroll
        for (int i = 0; i < 4; ++i) { const int c = tid + NTHREADS * i; float v[8];
            if (ORDER == 0) hy_calc8(rv[i], rl[i], rh[i], hc.wu, v);
            else { v[0] = z0[i][0]; v[1] = z0[i][1]; v[2] = z0[i][2]; v[3] = z0[i][3]; v[4] = z1[i][0]; v[5] = z1[i][1]; v[6] = z1[i][2]; v[7] = z1[i][3]; }
            float2* d = cf + PADI(4 * c); d[0] = make_float2(v[0], v[1]); d[1] = make_float2(v[2], v[3]); d[2] = make_float2(v[4], v[5]); d[3] = make_float2(v[6], v[7]);
            if (i == 0 && tid < 2) {
#pragma unroll
                for (int e = 0; e < 8; ++e) side[SD_VH + 8 * tid + e] = v[e]; } }
        if (tid < 2) { const int c = NCHUNK - 2 + tid; float v[8];
            if (ORDER == 0) hy_val8(hc.ru, 8 * c, hc.wu, v);
            else { const f32x4 p0 = *(const f32x4*)(z2g + 8 * c), p1 = *(const f32x4*)(z2g + 8 * c + 4); v[0] = p0[0]; v[1] = p0[1]; v[2] = p0[2]; v[3] = p0[3]; v[4] = p1[0]; v[5] = p1[1]; v[6] = p1[2]; v[7] = p1[3]; }
            float2* d = cf + PADI(4 * c); d[0] = make_float2(v[0], v[1]); d[1] = make_float2(v[2], v[3]); d[2] = make_float2(v[4], v[5]); d[3] = make_float2(v[6], v[7]);
#pragma unroll
            for (int e = 0; e < 8; ++e) side[SD_VT + 8 * tid + e] = v[e]; } }
    for (int i = L_TOK / 2 + tid; i < 16384; i += NTHREADS) cf[PADI(i)] = make_float2(0.f, 0.f);
    __syncthreads();
    fft_fwd(cf);
#pragma unroll 4
    for (int j = tid; j <= 8192; j += NTHREADS) { const unsigned i_ = j < 8192 ? ((((unsigned)j >> 1) << 2) | ((unsigned)j & 1u)) : 2u; const unsigned k = rev4_14(i_); const unsigned kp = (16384u - k) & 16383u; const unsigned ik = PADI(i_), ikp = PADI(rev4_14(kp)); const float2 a = cf[ik], bq = cf[ikp];
        const float bx = bq.x, by = -bq.y;
        const float2 XE = make_float2(0.5f * (a.x + bx), 0.5f * (a.y + by)), XO = make_float2(0.5f * (a.y - by), -0.5f * (a.x - bx));
        const f32x4 hh = heo[j]; const float2 HE = make_float2(hh[0], hh[1]), HO = make_float2(hh[2], hh[3]);
        float sn, cs; hw_sincos((float)k / 16384.0f, sn, cs); const float2 w = make_float2(cs, -sn);
        const float2 xoho = cmul(XO, HO), wx = cmul(w, xoho), xehe = cmul(XE, HE), xeho = cmul(XE, HO), xohe = cmul(XO, HE);
        const float2 YE = make_float2(xehe.x + wx.x, xehe.y + wx.y), YO = make_float2(xeho.x + xohe.x, xeho.y + xohe.y);
        cf[ik] = make_float2(YE.x - YO.y, YE.y + YO.x); cf[ikp] = make_float2(YE.x + YO.y, -YE.y + YO.x); }
    __syncthreads();
    fft_inv(cf);
    if (tid < 16) { const int t = tid; float d = 0.f;
        for (int s = t + 16384; s < L_TOK; ++s) { const int l = s - t; const float wrong = l == 16384 ? 0.f : side[SD_EF + 16399 - l]; d += (side[SD_GBX + l - 16384] - wrong) * side[SD_VT + s - 16384]; }
        CFF(t) += d; }
    else if (tid >= 32 && tid < 48) { const int t = 16384 + tid - 32; float d = 0.f;
        for (int s = 0; s <= t - 16384; ++s) { const int l = t - s; const float wrong = l == 16384 ? 0.f : side[SD_EB + 16399 - l]; d += (side[SD_GFX + l - 16384] - wrong) * side[SD_VH + s]; }
        CFF(t) += d; }
    __syncthreads();
}

__device__ void filt_to_lds(const bf16_t* __restrict__ gfp, const bf16_t* __restrict__ gbp, float2* cf, float* side) {
    const int tid = opaque_tid(); float* cff = (float*)cf;
    u32x4 qf[4], qb[4];
#pragma unroll
    for (int i = 0; i < 4; ++i) { const int c = tid + NTHREADS * i; qf[i] = *(const u32x4*)(gfp + 8 * c); qb[i] = *(const u32x4*)(gbp + 8 * c); }
#pragma unroll
    for (int i = 0; i < 4; ++i) { const int c = tid + NTHREADS * i, lag0 = 8 * c; const u32x4 f = qf[i], g = qb[i];
        float2* d = cf + PADI(4 * c); d[0] = make_float2(lo_bf(f.x), hi_bf(f.x)); d[1] = make_float2(lo_bf(f.y), hi_bf(f.y)); d[2] = make_float2(lo_bf(f.z), hi_bf(f.z)); d[3] = make_float2(lo_bf(f.w), hi_bf(f.w));
        if (lag0 >= 1) CFF(32768 - lag0) = lo_bf(g.x);
        CFF(32768 - lag0 - 1) = hi_bf(g.x); CFF(32768 - lag0 - 2) = lo_bf(g.y); CFF(32768 - lag0 - 3) = hi_bf(g.y); CFF(32768 - lag0 - 4) = lo_bf(g.z); CFF(32768 - lag0 - 5) = hi_bf(g.z); CFF(32768 - lag0 - 6) = lo_bf(g.w); CFF(32768 - lag0 - 7) = hi_bf(g.w); }
    if (tid < 2) { const int c = NCHUNK - 2 + tid; const u32x4 f = *(const u32x4*)(gfp + 8 * c), g = *(const u32x4*)(gbp + 8 * c); float* sf = side + SD_GFX + 8 * tid; float* sb = side + SD_GBX + 8 * tid;
        sf[0] = lo_bf(f.x); sf[1] = hi_bf(f.x); sf[2] = lo_bf(f.y); sf[3] = hi_bf(f.y); sf[4] = lo_bf(f.z); sf[5] = hi_bf(f.z); sf[6] = lo_bf(f.w); sf[7] = hi_bf(f.w);
        sb[0] = lo_bf(g.x); sb[1] = hi_bf(g.x); sb[2] = lo_bf(g.y); sb[3] = hi_bf(g.y); sb[4] = lo_bf(g.z); sb[5] = hi_bf(g.z); sb[6] = lo_bf(g.w); sb[7] = hi_bf(g.w); }
    if (tid == 0) CFF(NMAIN) = 0.f;
    __syncthreads();
}

__device__ void hyena_filters(const Params& p, int layer, unsigned char* smem, unsigned char* scrD, unsigned char* scrW) {
    const int tid = opaque_tid(); float2* cf = (float2*)smem; float* cff = (float*)smem; float* side = (float*)(smem + 139264);
    const int bid = blockIdx.x;
    __syncthreads();
    bf16_t* w4b = (bf16_t*)(side + SD_W4B);
    for (int i = tid; i < 16 * 64; i += NTHREADS) { const int row = i >> 6, k = i & 63; w4b[i] = f2bf(p.f_w4[((size_t)layer * 64 + k) * 4096 + (row & 3) * 1024 + bid + 256 * (row >> 2)]); }
    __syncthreads();
    const bf16_t* __restrict__ h3b = (const bf16_t*)(p.ws + OFF_H3) + (size_t)layer * L_TOK * 64;
    const int lane = tid & 63, wv = tid >> 6, col = lane & 15, quad = lane >> 4;
    const int chq = bid + 256 * quad;
    float dk[4];
#pragma unroll
    for (int f = 0; f < 4; ++f) dk[f] = fabsf(p.decay[((layer * 2 + (f >> 1)) * 2 + (f & 1)) * 1024 + chq]) * (1.4426950408889634f / (float)(L_TOK - 1));
    const bf16x8 b0 = *(const bf16x8*)(w4b + col * 64 + quad * 8), b1 = *(const bf16x8*)(w4b + col * 64 + 32 + quad * 8);
    bf16_t* __restrict__ g2 = (bf16_t*)(scrW + HS_G2);
    bf16_t* __restrict__ fq = (bf16_t*)(scrD) + (size_t)(quad > 0 ? quad - 1 : 0) * 4 * L_TOK;
#define FG_LOAD(A0, A1, GB) do { _Pragma("unroll") for (int i = 0; i < 8; ++i) { const bf16_t* hr = h3b + (size_t)(((GB) + 8 * i) * 16 + col) * 64 + quad * 8; A0[i] = *(const bf16x8*)hr; A1[i] = *(const bf16x8*)(hr + 32); } } while (0)
#define FG_GROUP(X0, X1, G_) do { f32x4 acc = (f32x4){0.f, 0.f, 0.f, 0.f}; \
        acc = __builtin_amdgcn_mfma_f32_16x16x32_bf16(b0, X0, acc, 0, 0, 0); acc = __builtin_amdgcn_mfma_f32_16x16x32_bf16(b1, X1, acc, 0, 0, 0); \
        const int lag = (G_) * 16 + col; const float fl = -(float)lag; \
        const float v0 = acc[0] * __builtin_amdgcn_exp2f(fl * dk[0]), v1 = acc[1] * __builtin_amdgcn_exp2f(fl * dk[1]), v2 = acc[2] * __builtin_amdgcn_exp2f(fl * dk[2]), v3 = acc[3] * __builtin_amdgcn_exp2f(fl * dk[3]); \
        if (quad == 0) { g2[lag] = f2bf(v2); g2[L_TOK + lag] = f2bf(v3); \
            if (lag < NMAIN) { CFF(lag) = v0; if (lag >= 1) CFF(32768 - lag) = v1; } else { side[SD_GFX + lag - NMAIN] = v0; side[SD_GBX + lag - NMAIN] = v1; } } \
        else { fq[lag] = f2bf(v0); fq[L_TOK + lag] = f2bf(v1); fq[2 * L_TOK + lag] = f2bf(v2); fq[3 * L_TOK + lag] = f2bf(v3); } } while (0)
#define FG_PROC(A0, A1, GB) do { _Pragma("unroll") for (int i = 0; i < 8; ++i) FG_GROUP(A0[i], A1[i], (GB) + 8 * i); } while (0)
    { bf16x8 pa0[8], pa1[8], pb0[8], pb1[8];
      FG_LOAD(pa0, pa1, wv);
#pragma unroll 1
      for (int m = 0; m < 16; m += 2) { const int gbA = wv + 64 * m, gbB = gbA + 64;
          FG_LOAD(pb0, pb1, gbB);
          FG_PROC(pa0, pa1, gbA);
          if (m + 2 < 16) FG_LOAD(pa0, pa1, gbB + 64);
          FG_PROC(pb0, pb1, gbB); }
      if (wv == 0) { const bf16_t* hr = h3b + (size_t)(1024 * 16 + col) * 64 + quad * 8; const bf16x8 x0 = *(const bf16x8*)hr, x1 = *(const bf16x8*)(hr + 32); FG_GROUP(x0, x1, 1024); } }
#undef FG_LOAD
#undef FG_GROUP
#undef FG_PROC
    if (tid == 0) CFF(NMAIN) = 0.f;
    __syncthreads();
}

__device__ void hyena_unit(const Params& p, int layer, int q, unsigned char* smem, unsigned char* scrD, unsigned char* scratch) {
    const int tid = opaque_tid(); float2* cf = (float2*)smem; float* cff = (float*)smem; float* side = (float*)(smem + 139264);
    const int ch = blockIdx.x + 256 * q;
    const bf16_t* hyin = (const bf16_t*)(p.ws + OFF_HYIN);
    HyCh hc; hc.ru = hyin + (size_t)ch * LP; hc.r1 = hyin + (size_t)(1024 + ch) * LP; hc.r2 = hyin + (size_t)(2048 + ch) * LP;
    { const float* cw = p.conv_w + (size_t)layer * 3 * 3072; const float* cb = p.conv_b + (size_t)layer * 3072;
#pragma unroll
      for (int jj = 0; jj < 3; ++jj) { hc.wu[jj] = cw[jj * 3072 + ch]; hc.w1[jj] = cw[jj * 3072 + 1024 + ch]; hc.w2[jj] = cw[jj * 3072 + 2048 + ch]; }
      hc.wu[3] = cb[ch]; hc.w1[3] = cb[1024 + ch]; hc.w2[3] = cb[2048 + ch]; }
    const float sk0 = p.skip[(layer * 2 + 0) * 1024 + ch], sk1 = p.skip[(layer * 2 + 1) * 1024 + ch];
    float* __restrict__ z2g = (float*)(scratch + HS_Z2);
    const bf16_t* filt = q == 0 ? (const bf16_t*)(scratch + HS_G2) - 2 * (size_t)L_TOK : (const bf16_t*)scrD + (size_t)(q - 1) * 4 * L_TOK;
    bf16_t* __restrict__ hyout = (bf16_t*)(p.ws + OFF_HYOUT) + (size_t)ch * LP;
    if (q > 0) { __syncthreads(); filt_to_lds(filt, filt + L_TOK, cf, side); }
    hy_conv<0>(hc, cf, side, scratch);
    {   u32x4 ru_[4], r1_[4]; float ul[4], uh[4], xl[4], xh[4];
#pragma unroll
        for (int i = 0; i < 4; ++i) { const int c = tid + NTHREADS * i; hy_load8(hc.ru, 8 * c, ru_[i], ul[i], uh[i]); hy_load8(hc.r1, 8 * c, r1_[i], xl[i], xh[i]); }
#pragma unroll
        for (int i = 0; i < 5; ++i) { const int c = i < 4 ? tid + NTHREADS * i : NCHUNK - 2 + tid;
            if (i < 4 || tid < 2) { float u8[8], x8[8];
                if (i < 4) { hy_calc8(ru_[i], ul[i], uh[i], hc.wu, u8); hy_calc8(r1_[i], xl[i], xh[i], hc.w1, x8); } else { hy_val8(hc.ru, 8 * c, hc.wu, u8); hy_val8(hc.r1, 8 * c, hc.w1, x8); }
                const float2* s = cf + PADI(4 * c); const float2 y0 = s[0], y1 = s[1], y2 = s[2], y3 = s[3];
                const f32x4 o0 = (f32x4){x8[0] * (y0.x + sk0 * u8[0]), x8[1] * (y0.y + sk0 * u8[1]), x8[2] * (y1.x + sk0 * u8[2]), x8[3] * (y1.y + sk0 * u8[3])};
                const f32x4 o1 = (f32x4){x8[4] * (y2.x + sk0 * u8[4]), x8[5] * (y2.y + sk0 * u8[5]), x8[6] * (y3.x + sk0 * u8[6]), x8[7] * (y3.y + sk0 * u8[7])};
                *(f32x4*)(z2g + 8 * c) = o0; *(f32x4*)(z2g + 8 * c + 4) = o1; } } }
    __syncthreads();
    filt_to_lds(filt + 2 * (size_t)L_TOK, filt + 3 * (size_t)L_TOK, cf, side);
    hy_conv<1>(hc, cf, side, scratch);
    {   u32x4 r2_[4]; float xl[4], xh[4]; f32x4 z0[4], z1[4];
#pragma unroll
        for (int i = 0; i < 4; ++i) { const int c = tid + NTHREADS * i; hy_load8(hc.r2, 8 * c, r2_[i], xl[i], xh[i]); z0[i] = *(const f32x4*)(z2g + 8 * c); z1[i] = *(const f32x4*)(z2g + 8 * c + 4); }
#pragma unroll
        for (int i = 0; i < 5; ++i) { const int c = i < 4 ? tid + NTHREADS * i : NCHUNK - 2 + tid;
            if (i < 4 || tid < 2) { float x8[8]; f32x4 p0, p1;
                if (i < 4) { hy_calc8(r2_[i], xl[i], xh[i], hc.w2, x8); p0 = z0[i]; p1 = z1[i]; } else { hy_val8(hc.r2, 8 * c, hc.w2, x8); p0 = *(const f32x4*)(z2g + 8 * c); p1 = *(const f32x4*)(z2g + 8 * c + 4); }
                const float2* s = cf + PADI(4 * c); const float2 y0 = s[0], y1 = s[1], y2 = s[2], y3 = s[3];
                u32x4 w; w.x = cvt_pk_bf16(x8[0] * (y0.x + sk1 * p0[0]), x8[1] * (y0.y + sk1 * p0[1])); w.y = cvt_pk_bf16(x8[2] * (y1.x + sk1 * p0[2]), x8[3] * (y1.y + sk1 * p0[3]));
                w.z = cvt_pk_bf16(x8[4] * (y2.x + sk1 * p1[0]), x8[5] * (y2.y + sk1 * p1[1])); w.w = cvt_pk_bf16(x8[6] * (y3.x + sk1 * p1[2]), x8[7] * (y3.y + sk1 * p1[3]));
                *(u32x4*)(hyout + 8 * c) = w; } } }
    __syncthreads();
}

__device__ void transpose_phase(const Params& p, unsigned char* smem) {
    const int tid = opaque_tid(), G = gridDim.x; bf16_t* tile0 = (bf16_t*)smem;
    const bf16_t* __restrict__ hyout = (const bf16_t*)(p.ws + OFF_HYOUT); bf16_t* ya = (bf16_t*)(p.ws + OFF_GATE);
    const int cl = tid >> 3, t8 = (tid & 7) * 8, tl = tid >> 3, c8 = (tid & 7) * 8;
    u32x4 ph = (u32x4){0u, 0u, 0u, 0u}, pg = ph;
    constexpr int TOT = 16 * 257;
    int u = blockIdx.x;
    __syncthreads();
    if (u < TOT) { const int ct = u & 15, tt = u >> 4; ph = *(const u32x4*)(hyout + (size_t)(ct * 64 + cl) * LP + tt * 64 + t8); const int t = tt * 64 + tl; if (t < L_TOK) pg = *(const u32x4*)(ya + (size_t)t * 1024 + ct * 64 + c8); }
    int buf = 0;
    for (; u < TOT; u += G) { bf16_t* tile = tile0 + buf * (64 * 72); const int ct = u & 15, tt = u >> 4;
        *(u32x4*)(tile + cl * 72 + t8) = ph; const u32x4 g = pg;
        { const int un = u + G; if (un < TOT) { const int ct2 = un & 15, tt2 = un >> 4; ph = *(const u32x4*)(hyout + (size_t)(ct2 * 64 + cl) * LP + tt2 * 64 + t8); const int t2 = tt2 * 64 + tl; if (t2 < L_TOK) pg = *(const u32x4*)(ya + (size_t)t2 * 1024 + ct2 * 64 + c8); } }
        __syncthreads();
        const int t = tt * 64 + tl;
        if (t < L_TOK) { float v[8];
#pragma unroll
            for (int i = 0; i < 8; ++i) v[i] = bf2f(tile[(c8 + i) * 72 + tl]);
            u32x4 w; w.x = cvt_pk_bf16(v[0] * lo_bf(g.x), v[1] * hi_bf(g.x)); w.y = cvt_pk_bf16(v[2] * lo_bf(g.y), v[3] * hi_bf(g.y)); w.z = cvt_pk_bf16(v[4] * lo_bf(g.z), v[5] * hi_bf(g.z)); w.w = cvt_pk_bf16(v[6] * lo_bf(g.w), v[7] * hi_bf(g.w));
            *(u32x4*)(ya + (size_t)t * 1024 + ct * 64 + c8) = w; }
        buf ^= 1; }
    __syncthreads();
}

__device__ void phase_final(const Params& p) {
    const int tid = opaque_tid(), lane = tid & 63, wv = tid >> 6; const float* h = (const float*)(p.ws + OFF_H);
    for (int l = NMETA + blockIdx.x * 8 + wv; l < L_TOK; l += gridDim.x * 8) { const f32x4* row = (const f32x4*)(h + (size_t)l * DM); f32x4 v[8]; float ss = 0.f;
#pragma unroll
        for (int i = 0; i < 8; ++i) { v[i] = row[i * 64 + lane]; ss += v[i][0] * v[i][0] + v[i][1] * v[i][1] + v[i][2] * v[i][2] + v[i][3] * v[i][3]; }
        ss = wave_sum(ss); const float inv = rsqrtf(ss * (1.0f / DM) + 1e-6f); f32x4* o = (f32x4*)(p.out + (size_t)(l - NMETA) * DM);
#pragma unroll
        for (int i = 0; i < 8; ++i) { const f32x4 gg = ((const f32x4*)p.final_g)[i * 64 + lane]; o[i * 64 + lane] = v[i] * inv * gg; } }
}

__device__ void mini_branch(const Params& p) {
    const int tid = opaque_tid(), lane = tid & 63, wv = tid >> 6, nt_ = blockIdx.x * 8 + wv;
    if (nt_ < 128) { const int rc = lane & 15, quad = lane >> 4; const int n0 = nt_ * 16;
        const bf16_t* mg = (const bf16_t*)(p.ws + OFF_MERGE); bf16_t* mb = (bf16_t*)(p.ws + OFF_M);
        float tot[4] = {0.f, 0.f, 0.f, 0.f};
#pragma unroll 1
        for (int br = 0; br < 3; ++br) { const bf16_t* A = (const bf16_t*)(p.ws + OFF_GATE + (size_t)br * SZ_GATE) + (size_t)(NMAIN + rc) * 1024 + quad * 8;
            const bf16_t* B = (const bf16_t*)(p.ws + OFF_WA + (size_t)br * SZ_WBR) + (size_t)(n0 + rc) * 1024 + quad * 8;
            f32x4 acc = (f32x4){0.f, 0.f, 0.f, 0.f};
#pragma unroll 1
            for (int kb = 0; kb < 32; kb += 8) { bf16x8 av[8], bv[8];
#pragma unroll
                for (int i = 0; i < 8; ++i) { av[i] = *(const bf16x8*)(A + (kb + i) * 32); bv[i] = *(const bf16x8*)(B + (kb + i) * 32); }
#pragma unroll
                for (int i = 0; i < 8; ++i) acc = __builtin_amdgcn_mfma_f32_16x16x32_bf16(av[i], bv[i], acc, 0, 0, 0); }
#pragma unroll
            for (int r = 0; r < 4; ++r) tot[r] += acc[r] * bf2f(mg[(size_t)(NMAIN + quad * 4 + r) * 6144 + br * 2048 + n0 + rc]); }
#pragma unroll
        for (int r = 0; r < 4; ++r) mb[(size_t)(NMAIN + quad * 4 + r) * DM + n0 + rc] = f2bf(tot[r]); }
}
__device__ void mini_out(const Params& p, int layer) {
    const int tid = opaque_tid(), lane = tid & 63, wv = tid >> 6, nt_ = blockIdx.x * 8 + wv;
    if (nt_ < 128) { const int rc = lane & 15, quad = lane >> 4; const int n0 = nt_ * 16;
        const bf16_t* A = (const bf16_t*)(p.ws + OFF_M) + (size_t)(NMAIN + rc) * DM + quad * 8; const bf16_t* B = (const bf16_t*)(p.ws + OFF_WO) + (size_t)(n0 + rc) * DM + quad * 8;
        f32x4 acc = (f32x4){0.f, 0.f, 0.f, 0.f};
#pragma unroll 1
        for (int kb = 0; kb < 64; kb += 8) { bf16x8 av[8], bv[8];
#pragma unroll
            for (int i = 0; i < 8; ++i) { av[i] = *(const bf16x8*)(A + (kb + i) * 32); bv[i] = *(const bf16x8*)(B + (kb + i) * 32); }
#pragma unroll
            for (int i = 0; i < 8; ++i) acc = __builtin_amdgcn_mfma_f32_16x16x32_bf16(av[i], bv[i], acc, 0, 0, 0); }
        float* h = (float*)(p.ws + OFF_H);
#pragma unroll
        for (int r = 0; r < 4; ++r) { const size_t row = NMAIN + quad * 4 + r; const float bs = layer == 0 ? p.x[(row - NMETA) * DM + n0 + rc] : h[row * DM + n0 + rc]; h[row * DM + n0 + rc] = bs + acc[r]; } }
}

enum { OP_P1 = 0, OP_SYNC, OP_GEMM, OP_NA, OP_HYENA, OP_TRANS, OP_NOP };
__global__ void __launch_bounds__(512, 2) hybrid_fwd(Params p) {
    extern __shared__ __attribute__((aligned(16))) unsigned char smem[];
    cg::grid_group grid = cg::this_grid();
    LAS unsigned char* lds = (LAS unsigned char*)smem;
    const int bid = blockIdx.x, G = gridDim.x;
    phase_prep0(p, smem);
    constexpr int NOPS = 17;
#pragma clang loop unroll(disable)
    for (int step = 0; step < 2 * NOPS; ++step) {
        const int layer = step / NOPS, s = step - layer * NOPS;
        int op, kind = 0;
        switch (s) {
        case 0: op = OP_P1; break;
        case 2: op = OP_GEMM; kind = K_IN; break;
        case 3: case 4: op = OP_NOP; break;
        case 6: op = OP_GEMM; kind = K_FNA; break;
        case 7: op = OP_NA; break;
        case 8: op = OP_HYENA; break;
        case 10: op = OP_GEMM; kind = K_FNB; break;
        case 11: op = OP_TRANS; break;
        case 13: op = OP_GEMM; kind = K_BR; break;
        case 15: op = OP_GEMM; kind = K_OUT; break;
        default: op = OP_SYNC; break;
        }
        if (op == OP_NOP) { }
        else if (op == OP_SYNC) { grid.sync(); }
        else if (op == OP_GEMM) {
            Gemm g; g.base = (const char*)p.ws; g.jumpA = 0; g.jumpB = 0;
            switch (kind) {
            case K_FNA: g.lda = 384; g.ldb = FN1P; g.nt = 6; g.ksplit = 3; g.jumpB = (long)((size_t)1024 * PROWS * 2) - 384l; break;
            case K_FNB: g.lda = 256; g.ldb = 256; g.nt = 4; g.ksplit = 4; break;
            case K_BR:  g.lda = 1024; g.ldb = 1024; g.nt = 16; g.ksplit = 16; break;
            default:    g.lda = DM; g.ldb = DM; g.nt = 32; g.ksplit = 32; break;
            }
            SchedAny S{kind, G, bid}; EpiAny E{kind, p.ws, layer, p.x, p.meta};
            pg8::gemm_phase(lds, g, S, E);
            if (kind == K_BR) mini_branch(p); else if (kind == K_OUT) mini_out(p, layer);
        }
        else if (op == OP_P1) { phase_p1(p, layer, smem); }
        else if (op == OP_NA) { na_phase(p, layer, smem); if (bid == G - 1) na_meta_unit(p, layer); }
        else if (op == OP_HYENA) { unsigned char* scrD = (unsigned char*)p.out + (size_t)bid * HSD_STRIDE; unsigned char* scrW = p.ws + WS_END + (size_t)bid * HSW_STRIDE;
            hyena_filters(p, layer, smem, scrD, scrW);
#pragma clang loop unroll(disable)
            for (int q = 0; q < 4; ++q) hyena_unit(p, layer, q, smem, scrD, scrW); }
        else { transpose_phase(p, smem); }
    }
    phase_final(p);
}

extern "C" void kernel_launch(void* const* d_in, const int* in_sizes, int n_in, void* d_out, int out_size, void* d_ws, size_t ws_size, hipStream_t stream) {
    static int grid_blocks = 0;
    if (grid_blocks == 0) {
        if (n_in != 23 || ws_size < WS_END2) { fprintf(stderr, "kernel_launch: need 23 inputs and %zu bytes of workspace (got %d, %zu)\n", (size_t)WS_END2, n_in, ws_size); grid_blocks = -1; return; }
        int dev = 0, cus = 0, per_cu = 0;
        hipGetDevice(&dev); hipDeviceGetAttribute(&cus, hipDeviceAttributeMultiprocessorCount, dev);
        if (hipFuncSetAttribute((const void*)hybrid_fwd, hipFuncAttributeMaxDynamicSharedMemorySize, LDS_BYTES) != hipSuccess) { fprintf(stderr, "kernel_launch: hipFuncSetAttribute failed\n"); grid_blocks = -1; return; }
        hipOccupancyMaxActiveBlocksPerMultiprocessor(&per_cu, (const void*)hybrid_fwd, NTHREADS, LDS_BYTES);
        if (per_cu < 1) per_cu = 1;
        grid_blocks = cus * per_cu;
        if (grid_blocks > 256) grid_blocks = 256;
        if (grid_blocks != 256) { fprintf(stderr, "kernel_launch: this kernel needs 256 co-resident workgroups (got %d)\n", grid_blocks); grid_blocks = -1; return; }
    }
    if (grid_blocks < 0) return;
    Params p{};
    const float** f = (const float**)&p;
    for (int i = 0; i < 23; ++i) f[i] = (const float*)d_in[i];
    p.out = (float*)d_out; p.ws = (unsigned char*)d_ws;
    void* args[] = {&p};
    hipError_t e = hipLaunchCooperativeKernel((const void*)hybrid_fwd, dim3(grid_blocks), dim3(NTHREADS), args, LDS_BYTES, stream);
    if (e != hipSuccess) fprintf(stderr, "cooperative launch failed: %s (grid %d)\n", hipGetErrorString(e), grid_blocks);
}
```

```cpp
#include <hip/hip_runtime.h>
#include <hip/hip_cooperative_groups.h>
#include <cstdio>
namespace cg = cooperative_groups;

#define LAS __attribute__((address_space(3)))
typedef unsigned short bf16_t;
typedef short bf16x8 __attribute__((ext_vector_type(8)));
typedef float f32x4 __attribute__((ext_vector_type(4)));
typedef unsigned u32x4 __attribute__((ext_vector_type(4)));
typedef unsigned u32x2 __attribute__((ext_vector_type(2)));

constexpr int L_TOK = 16400, LP = 16640, DM = 2048, NIN = 16384, NMETA = 16, NMAIN = 16384;
constexpr int FN1 = 164, FN2 = 100, FN1P = 192, PROWS = FN2 * FN1P;
constexpr int NTHREADS = 512, LDS_PHASE_BYTES = 155648, LDS_BYTES = LDS_PHASE_BYTES + 16;

constexpr size_t SZ_H = (size_t)LP * DM * 4, SZ_XN = (size_t)LP * DM * 2, SZ_XNP = (size_t)PROWS * DM * 2;
constexpr size_t OFF_H = 0;
constexpr size_t OFF_XN = OFF_H + SZ_H;
constexpr size_t OFF_XNP = OFF_XN + SZ_XN;
constexpr size_t OFF_A1 = OFF_XN;
constexpr size_t SZ_A1 = (size_t)FN1 * 1024 * 2 * 128 * 2;
constexpr size_t OFF_HYOUT = OFF_A1 + SZ_A1;
constexpr size_t SZ_HYOUT = (size_t)1024 * LP * 2;
static_assert(OFF_HYOUT + SZ_HYOUT <= OFF_XNP + SZ_XNP, "alias overflow");
constexpr size_t OFF_WT = OFF_XNP + SZ_XNP;
constexpr size_t OFF_WEFF = OFF_WT + (size_t)NIN * DM * 2;
constexpr size_t OFF_WA = OFF_WEFF + (size_t)2048 * 2048 * 2;
constexpr size_t SZ_WBR = (size_t)2048 * 1024 * 2;
constexpr size_t OFF_WO = OFF_WA + 3 * SZ_WBR;
constexpr size_t OFF_HYIN = OFF_WO + (size_t)2048 * 2048 * 2;
constexpr size_t OFF_GATE = OFF_HYIN + (size_t)3072 * LP * 2;
constexpr size_t SZ_GATE = (size_t)LP * 1024 * 2;
constexpr size_t OFF_QKV = OFF_GATE + 3 * SZ_GATE;
constexpr size_t OFF_MERGE = OFF_QKV + (size_t)LP * 3072 * 2;
constexpr size_t OFF_ZT = OFF_MERGE + (size_t)LP * 6144 * 2;
constexpr size_t SZ_ZT = (size_t)2048 * PROWS * 2;
constexpr size_t OFF_M = OFF_ZT;
static_assert(SZ_XN <= SZ_ZT, "alias overflow");
constexpr size_t OFF_FA = OFF_ZT + SZ_ZT;
constexpr size_t OFF_FB = OFF_FA + (size_t)512 * 384 * 2;
constexpr size_t OFF_H3 = OFF_FB + (size_t)FN1 * 256 * 256 * 2;
constexpr size_t WS_END = OFF_H3 + (size_t)2 * L_TOK * 64 * 4;
constexpr size_t HS_HEO = 0, HS_Z2 = 131328, HS_G2 = HS_Z2 + 65792, HSW_STRIDE = HS_G2 + 65792;
constexpr size_t FILT_BYTES = (size_t)L_TOK * 2, HSD_STRIDE = 393728;
constexpr size_t OFF_BAR = WS_END + 256 * HSW_STRIDE;
constexpr size_t WS_END2 = OFF_BAR + 16384;
static_assert(HSD_STRIDE >= 12 * FILT_BYTES && HSD_STRIDE * 256 <= (size_t)NMAIN * DM * 4, "scratch overflow");

struct Params {
    const float* x; const float* meta; const float* norm_g; const float* w_in; const float* conv_w; const float* conv_b;
    const float* f_w1; const float* f_b1; const float* f_w2; const float* f_b2; const float* f_w3; const float* f_b3; const float* f_w4;
    const float* f_freq; const float* decay; const float* skip; const float* rpb; const float* meta_bias;
    const float* w_a; const float* w_b; const float* w_c; const float* w_out; const float* final_g;
    float* out; unsigned char* ws;
};

__device__ __forceinline__ int opaque_tid() { int t = threadIdx.x; asm volatile("" : "+v"(t)); return t; }
__device__ __forceinline__ float bf2f(bf16_t b) { return __uint_as_float(((unsigned)b) << 16); }
__device__ __forceinline__ bf16_t f2bf(float f) { unsigned u = __float_as_uint(f); u += 0x7FFFu + ((u >> 16) & 1u); return (bf16_t)(u >> 16); }
__device__ __forceinline__ unsigned cvt_pk_bf16(float lo, float hi) { unsigned r; asm volatile("v_cvt_pk_bf16_f32 %0, %1, %2" : "=v"(r) : "v"(lo), "v"(hi)); return r; }
__device__ __forceinline__ float lo_bf(unsigned u) { return __uint_as_float(u << 16); }
__device__ __forceinline__ float hi_bf(unsigned u) { return __uint_as_float(u & 0xffff0000u); }
__device__ __forceinline__ float silu_f(float v) { return v * __builtin_amdgcn_rcpf(1.0f + __expf(-v)); }
__device__ __forceinline__ float sigm_f(float v) { return __builtin_amdgcn_rcpf(1.0f + __expf(-v)); }
__device__ __forceinline__ float wave_sum(float v) {
#pragma unroll
    for (int o = 32; o >= 1; o >>= 1) v += __shfl_xor(v, o);
    return v;
}

namespace pg8 {
constexpr int BM = 256, BK = 64, HALF = 128, HTB = HALF * BK * 2, STAGE_BYTES = 8 * HTB;
__device__ __forceinline__ int lds_byte(int r, int c) { const int st = (r >> 4) * 2 + (c >> 5), rr = r & 15, cc = c & 31, ob = rr * 64 + cc * 2; return st * 1024 + (ob ^ (((ob >> 9) & 1) << 5)); }
__device__ __forceinline__ void stage_rc(int b, int& R, int& C) { const int st = b / 1024, sb = b % 1024, swz = sb ^ (((sb >> 9) & 1) << 5); R = (st >> 1) * 16 + swz / 64; C = (st & 1) * 32 + (swz % 64) / 2; }
__device__ __forceinline__ int perm32(int rho) { const int n = rho >> 4, i = rho & 15; return 8 * (i >> 2) + 4 * n + (i & 3); }

struct Unit { int pm, pn, aux; size_t offA, offB; };
struct Gemm { const char* base; int lda, ldb, nt, ksplit; long jumpA, jumpB; };

__device__ __forceinline__ void tile_map(int wgid, int nM, int nN, int& pm, int& pn) {
    const int nwg = nM * nN;
    { const int q = nwg / 8, r = nwg % 8, xcd = wgid % 8, off = wgid / 8; wgid = (xcd < r ? xcd * (q + 1) : r * (q + 1) + (xcd - r) * q) + off; }
    const int nig = 8 * nN, gid = wgid / nig, fm = gid * 8, gsz = (nM - fm) < 8 ? (nM - fm) : 8;
    pm = fm + ((wgid % nig) % gsz); pn = (wgid % nig) / gsz;
}

template <class Epi, class Sched>
__device__ __forceinline__ void gemm_phase(LAS unsigned char* lds, const Gemm g, const Sched& S, const Epi& E) {
    const int tid = opaque_tid(), wid = __builtin_amdgcn_readfirstlane(tid >> 6), lane = tid & 63, wr = wid >> 2, wc = wid & 3, fr = lane & 15, fq = lane >> 4;
    const int nt = g.nt;
    unsigned voffA[2], voffB[2];
#pragma unroll
    for (int i = 0; i < 2; ++i) { int R, C; stage_rc(tid * 16 + i * 8192, R, C); const int Rb = (R & ~31) + perm32(R & 31);
        voffA[i] = (unsigned)(R * g.lda + C) * 2u; voffB[i] = (unsigned)(Rb * g.ldb + C) * 2u; }
    const size_t kstep = (size_t)(BK * 2);
    const size_t hstepA = (size_t)HALF * g.lda * 2, hstepB = (size_t)HALF * g.ldb * 2;
    const unsigned ldsw = (unsigned)wid * 1024u;
    const int aoff = lds_byte(wr * 64 + fr, fq * 8), boff = lds_byte(wc * 32 + fr, fq * 8);
#define PG8_KA(p, t) ((p) + (size_t)(t) * kstep + ((t) >= g.ksplit ? g.jumpA : 0l))
#define PG8_KB(p, t) ((p) + (size_t)(t) * kstep + ((t) >= g.ksplit ? g.jumpB : 0l))
#define PG8_SA(b, h) (((b) * 2 + (h)) * HTB)
#define PG8_SB(b, h) ((4 + (b) * 2 + (h)) * HTB)
#define PG8_STAGE(bufoff, gbase, voff) do { _Pragma("unroll") for (int _i = 0; _i < 2; ++_i) \
        __builtin_amdgcn_global_load_lds((const unsigned*)((const char*)(gbase) + (voff)[_i]), (LAS unsigned*)(lds + (bufoff) + ldsw + _i * 8192), 16, 0, 0); } while (0)
#define PG8_LDA(dst, b, h) do { _Pragma("unroll") for (int m = 0; m < 4; ++m) _Pragma("unroll") for (int k = 0; k < 2; ++k) dst[m][k] = *(const LAS bf16x8*)(lds + PG8_SA(b, h) + aoff + m * 2048 + k * 1024); } while (0)
#define PG8_LDB(dst, b, h) do { _Pragma("unroll") for (int n = 0; n < 2; ++n) _Pragma("unroll") for (int k = 0; k < 2; ++k) dst[n][k] = *(const LAS bf16x8*)(lds + PG8_SB(b, h) + boff + n * 2048 + k * 1024); } while (0)
#define PG8_MMA(ai, bj, At, Bt) do { __builtin_amdgcn_s_setprio(1); _Pragma("unroll") for (int m = 0; m < 4; ++m) _Pragma("unroll") for (int n = 0; n < 2; ++n) _Pragma("unroll") for (int k = 0; k < 2; ++k) \
        acc[ai][bj][m][n] = __builtin_amdgcn_mfma_f32_16x16x32_bf16(Bt[n][k], At[m][k], acc[ai][bj][m][n], 0, 0, 0); __builtin_amdgcn_s_setprio(0); } while (0)
#define PG8_WAIT_V(n) asm volatile("s_waitcnt vmcnt(" #n ")" ::: "memory")
#define PG8_WAIT_L(n) asm volatile("s_waitcnt lgkmcnt(" #n ")" ::: "memory")
#define PG8_BAR __builtin_amdgcn_s_barrier()
#define PG8_SCHED __builtin_amdgcn_sched_barrier(0)
    Unit cur, nxt; int ui = 0;
    if (!S.next(0, cur)) return;
    f32x4 acc[2][2][4][2];
#pragma unroll
    for (int a = 0; a < 2; ++a)
#pragma unroll
        for (int b = 0; b < 2; ++b)
#pragma unroll
            for (int m = 0; m < 4; ++m)
#pragma unroll
                for (int n = 0; n < 2; ++n) acc[a][b][m][n] = (f32x4){0.f, 0.f, 0.f, 0.f};
    bf16x8 At[4][2], B0[2][2], B1[2][2];
    const char* cA = g.base + cur.offA; const char* cB = g.base + cur.offB;
    PG8_STAGE(PG8_SB(0, 0), cB, voffB); PG8_STAGE(PG8_SA(0, 0), cA, voffA); PG8_STAGE(PG8_SB(0, 1), cB + hstepB, voffB); PG8_STAGE(PG8_SA(0, 1), cA + hstepA, voffA);
    if (wr == 1) PG8_BAR;
    PG8_WAIT_V(4); PG8_BAR;
    PG8_STAGE(PG8_SB(1, 0), PG8_KB(cB, 1), voffB); PG8_STAGE(PG8_SA(1, 0), PG8_KA(cA, 1), voffA); PG8_STAGE(PG8_SB(1, 1), PG8_KB(cB, 1) + hstepB, voffB);
    PG8_WAIT_V(6); PG8_BAR;
    for (;;) {
        const bool has_next = S.next(ui + 1, nxt);
        const char* nA = has_next ? g.base + nxt.offA : cA; const char* nB = has_next ? g.base + nxt.offB : cB;
        for (int t = 0; t < nt; t += 2) {
            const bool last = (t == nt - 2);
            const char* a1 = PG8_KA(cA, t + 1);
            const char* a2 = last ? nA : PG8_KA(cA, t + 2); const char* b2 = last ? nB : PG8_KB(cB, t + 2);
            const char* a3 = last ? PG8_KA(nA, 1) : PG8_KA(cA, t + 3); const char* b3 = last ? PG8_KB(nB, 1) : PG8_KB(cB, t + 3);
            PG8_LDB(B0, 0, 0); PG8_SCHED; PG8_LDA(At, 0, 0); PG8_STAGE(PG8_SA(1, 1), a1 + hstepA, voffA);
            PG8_WAIT_L(8); PG8_BAR; PG8_WAIT_L(0); PG8_MMA(0, 0, At, B0); PG8_BAR; PG8_SCHED;
            PG8_LDB(B1, 0, 1); PG8_STAGE(PG8_SB(0, 0), b2, voffB);
            PG8_BAR; PG8_WAIT_L(0); PG8_MMA(0, 1, At, B1); PG8_BAR;
            PG8_LDA(At, 0, 1); PG8_STAGE(PG8_SA(0, 0), a2, voffA);
            PG8_BAR; PG8_WAIT_L(0); PG8_MMA(1, 0, At, B0); PG8_BAR; PG8_SCHED;
            PG8_STAGE(PG8_SB(0, 1), b2 + hstepB, voffB);
            PG8_WAIT_V(6); PG8_BAR; PG8_MMA(1, 1, At, B1); PG8_BAR;
            PG8_LDB(B0, 1, 0); PG8_SCHED; PG8_LDA(At, 1, 0); PG8_STAGE(PG8_SA(0, 1), a2 + hstepA, voffA);
            PG8_WAIT_L(8); PG8_BAR; PG8_WAIT_L(0); PG8_MMA(0, 0, At, B0); PG8_BAR; PG8_SCHED;
            PG8_LDB(B1, 1, 1); PG8_STAGE(PG8_SB(1, 0), b3, voffB);
            PG8_BAR; PG8_WAIT_L(0); PG8_MMA(0, 1, At, B1); PG8_BAR;
            PG8_LDA(At, 1, 1); PG8_STAGE(PG8_SA(1, 0), a3, voffA);
            PG8_BAR; PG8_WAIT_L(0); PG8_MMA(1, 0, At, B0); PG8_BAR; PG8_SCHED;
            PG8_STAGE(PG8_SB(1, 1), b3 + hstepB, voffB);
            PG8_WAIT_V(6); PG8_BAR; PG8_MMA(1, 1, At, B1); PG8_BAR;
        }
        E(acc, cur, wr, wc, fr, fq);
        if (!has_next) break;
#pragma unroll
        for (int a = 0; a < 2; ++a)
#pragma unroll
            for (int b = 0; b < 2; ++b)
#pragma unroll
                for (int m = 0; m < 4; ++m)
#pragma unroll
                    for (int n = 0; n < 2; ++n) acc[a][b][m][n] = (f32x4){0.f, 0.f, 0.f, 0.f};
        cur = nxt; cA = nA; cB = nB; ++ui;
    }
    PG8_WAIT_V(0);
    if (wr == 0) PG8_BAR;
    PG8_BAR;
#undef PG8_KA
#undef PG8_KB
#undef PG8_SA
#undef PG8_SB
#undef PG8_STAGE
#undef PG8_LDA
#undef PG8_LDB
#undef PG8_MMA
#undef PG8_WAIT_V
#undef PG8_WAIT_L
#undef PG8_BAR
#undef PG8_SCHED
}
}
using pg8::Unit; using pg8::Gemm;
#define ACC_T const f32x4 (&acc)[2][2][4][2]

enum { K_TOK = 0, K_HYIN = 1, K_F0 = 2, K_FNA = 3, K_FNB = 4, K_BR = 5, K_OUT = 6, K_IN = 7 };
struct SchedAny {
    int kind, G, c;
    __device__ __forceinline__ bool next(int i, Unit& u) const {
        const long Lx = (long)i * G + c;
        switch (kind) {
        case K_IN: {
            if (Lx < 3120) { int pn; pg8::tile_map((int)Lx, 65, 48, u.pm, pn); u.pn = pn < 4 ? 12 + pn : 16 + pn; u.aux = K_TOK;
                u.offA = OFF_XN + (size_t)u.pm * 256 * DM * 2; u.offB = OFF_WT + (size_t)u.pn * 256 * DM * 2; return true; }
            if (Lx < 3900) { pg8::tile_map((int)Lx - 3120, 12, 65, u.pm, u.pn); u.aux = K_HYIN;
                u.offA = OFF_WT + (size_t)u.pm * 256 * DM * 2; u.offB = OFF_XN + (size_t)u.pn * 256 * DM * 2; return true; }
            if (Lx < 4200) { pg8::tile_map((int)Lx - 3900, 4, 75, u.pm, u.pn); u.aux = K_F0;
                u.offA = OFF_WEFF + (size_t)u.pm * 256 * DM * 2; u.offB = OFF_XNP + (size_t)u.pn * 256 * DM * 2; return true; }
            return false; }
        case K_TOK: {
            if (Lx >= 65l * 48) return false; int pn; pg8::tile_map((int)Lx, 65, 48, u.pm, pn); u.pn = pn < 4 ? 12 + pn : 16 + pn; u.aux = 0;
            u.offA = OFF_XN + (size_t)u.pm * 256 * DM * 2; u.offB = OFF_WT + (size_t)u.pn * 256 * DM * 2; return true; }
        case K_HYIN: {
            if (Lx >= 12l * 65) return false; pg8::tile_map((int)Lx, 12, 65, u.pm, u.pn); u.aux = 0;
            u.offA = OFF_WT + (size_t)u.pm * 256 * DM * 2; u.offB = OFF_XN + (size_t)u.pn * 256 * DM * 2; return true; }
        case K_F0: {
            if (Lx >= 8l * 75) return false; pg8::tile_map((int)Lx, 8, 75, u.pm, u.pn); u.aux = 0;
            u.offA = OFF_WEFF + (size_t)u.pm * 256 * DM * 2; u.offB = OFF_XNP + (size_t)u.pn * 256 * DM * 2; return true; }
        case K_FNA: {
            if (Lx >= 2l * 400) return false; pg8::tile_map((int)Lx, 2, 400, u.pm, u.pn); u.aux = 0;
            u.offA = OFF_FA + (size_t)u.pm * 256 * 384 * 2; u.offB = OFF_ZT + (size_t)u.pn * 256 * FN1P * 2; return true; }
        case K_FNB: {
            if (Lx >= 164l * 4) return false; u.aux = (int)(Lx >> 2); u.pm = 0; u.pn = (int)(Lx & 3);
            u.offA = OFF_FB + (size_t)u.aux * 256 * 256 * 2; u.offB = OFF_A1 + (size_t)u.aux * 1024 * 256 * 2 + (size_t)u.pn * 256 * 256 * 2; return true; }
        case K_BR: {
            const int T = (i / 3) * G + c; if (T >= 64 * 8) return false; const int br = i % 3; pg8::tile_map(T, 64, 8, u.pm, u.pn); u.aux = br;
            u.offA = OFF_GATE + (size_t)br * SZ_GATE + (size_t)u.pm * 256 * 1024 * 2; u.offB = OFF_WA + (size_t)br * SZ_WBR + (size_t)u.pn * 256 * 1024 * 2; return true; }
        default: {
            if (Lx >= 64l * 8) return false; pg8::tile_map((int)Lx, 64, 8, u.pm, u.pn); u.aux = 0;
            u.offA = OFF_M + (size_t)u.pm * 256 * DM * 2; u.offB = OFF_WO + (size_t)u.pn * 256 * DM * 2; return true; }
        }
    }
};
#define ROWFENCE asm volatile("" ::: "memory")
#define HARDFENCE do { asm volatile("" ::: "memory"); __builtin_amdgcn_sched_barrier(0); } while (0)
struct EpiAny {
    int kind; unsigned char* ws; int layer; const float* xin; const float* metain;
    __device__ __forceinline__ void operator()(ACC_T, const Unit& u, int wr, int wc, int fr, int fq) const {
        const int rl0 = wr * 64 + fr, cl0 = wc * 32 + 8 * fq;
        const int ek = kind == K_IN ? u.aux : kind;
        if (ek == K_TOK) {
            const int t = u.pn; unsigned char* dst; unsigned ld; int c0, act;
            if (t < 16)      { dst = ws + OFF_GATE;               ld = 1024; c0 = (t - 12) * 256; act = 1; }
            else if (t < 24) { dst = ws + OFF_GATE + SZ_GATE;     ld = 1024; c0 = (t - 20) * 256; act = 1; }
            else if (t < 36) { dst = ws + OFF_QKV;                ld = 3072; c0 = (t - 24) * 256; act = 0; }
            else if (t < 40) { dst = ws + OFF_GATE + 2 * SZ_GATE; ld = 1024; c0 = (t - 36) * 256; act = 1; }
            else             { dst = ws + OFF_MERGE;              ld = 6144; c0 = (t - 40) * 256; act = 2; }
#pragma unroll
            for (int ai = 0; ai < 2; ++ai)
#pragma unroll
                for (int m = 0; m < 4; ++m) { const unsigned row = (unsigned)(u.pm * 256 + ai * 128 + m * 16 + rl0);
#pragma unroll
                    for (int bj = 0; bj < 2; ++bj) { const unsigned off = (row * ld + (unsigned)(c0 + bj * 128 + cl0)) * 2u; f32x4 v0 = acc[ai][bj][m][0], v1 = acc[ai][bj][m][1];
                        if (act == 1) {
#pragma unroll
                            for (int j = 0; j < 4; ++j) { v0[j] = silu_f(v0[j]); v1[j] = silu_f(v1[j]); } }
                        else if (act == 2) {
#pragma unroll
                            for (int j = 0; j < 4; ++j) { v0[j] = sigm_f(v0[j]); v1[j] = sigm_f(v1[j]); } }
                        u32x4 w; w.x = cvt_pk_bf16(v0[0], v0[1]); w.y = cvt_pk_bf16(v0[2], v0[3]); w.z = cvt_pk_bf16(v1[0], v1[1]); w.w = cvt_pk_bf16(v1[2], v1[3]);
                        *(u32x4*)(dst + off) = w; }
                    ROWFENCE; }
        } else if (ek == K_HYIN) {
            unsigned char* dst = ws + OFF_HYIN; const unsigned ld = LP;
#pragma unroll
            for (int ai = 0; ai < 2; ++ai)
#pragma unroll
                for (int m = 0; m < 4; ++m) { const unsigned row = (unsigned)(u.pm * 256 + ai * 128 + m * 16 + rl0);
#pragma unroll
                    for (int bj = 0; bj < 2; ++bj) { const unsigned off = (row * ld + (unsigned)(u.pn * 256 + bj * 128 + cl0)) * 2u; const f32x4 v0 = acc[ai][bj][m][0], v1 = acc[ai][bj][m][1];
                        u32x4 w; w.x = cvt_pk_bf16(v0[0], v0[1]); w.y = cvt_pk_bf16(v0[2], v0[3]); w.z = cvt_pk_bf16(v1[0], v1[1]); w.w = cvt_pk_bf16(v1[2], v1[3]);
                        *(u32x4*)(dst + off) = w; }
                    ROWFENCE; }
        } else if (ek == K_F0) {
            int rlx = rl0, clx = cl0; asm volatile("" : "+v"(rlx), "+v"(clx));
            unsigned char* dst = ws + OFF_ZT; const int g = u.pm; const unsigned colb0 = (unsigned)(u.pn * 256 + clx) * 2u;
#pragma unroll
            for (int ai = 0; ai < 2; ++ai)
#pragma unroll
                for (int m = 0; m < 4; ++m) { const int j = ai * 128 + m * 16 + rlx; const int part = j <= 128 ? 0 : 1; const int cp = j - 128 * part;
                    const unsigned o1 = (unsigned)(part * 1024 + g * 256 + cp) * (unsigned)(PROWS * 2) + colb0;
                    const bool mir = cp >= 1 && cp <= 127; const bool zim = part == 0 && !mir;
                    const unsigned o2 = (unsigned)((mir ? part : 1) * 1024 + g * 256 + (mir ? 256 - cp : cp)) * (unsigned)(PROWS * 2) + colb0;
                    const unsigned sgn = part == 1 ? 0x80008000u : 0u, msk = zim ? 0u : 0xffffffffu;
#pragma unroll
                    for (int bj = 0; bj < 2; ++bj) { const f32x4 v0 = acc[ai][bj][m][0], v1 = acc[ai][bj][m][1];
                        u32x4 w; w.x = cvt_pk_bf16(v0[0], v0[1]); w.y = cvt_pk_bf16(v0[2], v0[3]); w.z = cvt_pk_bf16(v1[0], v1[1]); w.w = cvt_pk_bf16(v1[2], v1[3]);
                        *(u32x4*)(dst + o1 + bj * 256) = w;
                        u32x4 wm; wm.x = (w.x ^ sgn) & msk; wm.y = (w.y ^ sgn) & msk; wm.z = (w.z ^ sgn) & msk; wm.w = (w.w ^ sgn) & msk;
                        *(u32x4*)(dst + o2 + bj * 256) = wm; }
                    ROWFENCE; }
        } else if (ek == K_FNA) {
            unsigned char* dst = ws + OFF_A1;
#pragma unroll
            for (int ai = 0; ai < 2; ++ai)
#pragma unroll
                for (int m = 0; m < 4; ++m) { const int k1 = ai * 128 + m * 16 + rl0;
                    if (k1 < FN1) {
#pragma unroll
                        for (int bj = 0; bj < 2; ++bj)
#pragma unroll
                            for (int n = 0; n < 2; ++n) { const int col = u.pn * 256 + bj * 128 + cl0 + 4 * n; const int ch = col / FN2, l2 = col - ch * FN2; const f32x4 v = acc[ai][bj][m][n];
                                u32x2 w; w.x = cvt_pk_bf16(v[0], v[1]); w.y = cvt_pk_bf16(v[2], v[3]);
                                *(u32x2*)(dst + ((unsigned)((k1 * 1024 + ch) * 2 + u.pm) * 128u + (unsigned)l2) * 2u) = w; } }
                    ROWFENCE; }
        } else if (ek == K_FNB) {
            unsigned char* dst = ws + OFF_GATE + SZ_GATE; const float scale = 1.0f / sqrtf((float)L_TOK * 256.0f);
#pragma unroll
            for (int ai = 0; ai < 2; ++ai)
#pragma unroll
                for (int m = 0; m < 4; ++m) { const int k2 = ai * 128 + m * 16 + rl0;
                    if (k2 < FN2) { const unsigned row = (unsigned)(u.aux + FN1 * k2);
#pragma unroll
                        for (int bj = 0; bj < 2; ++bj) { const unsigned off = (row * 1024u + (unsigned)(u.pn * 256 + bj * 128 + cl0)) * 2u; const u32x4 g = *(const u32x4*)(dst + off);
                            const f32x4 v0 = acc[ai][bj][m][0] * scale, v1 = acc[ai][bj][m][1] * scale;
                            u32x4 w; w.x = cvt_pk_bf16(v0[0] * lo_bf(g.x), v0[1] * hi_bf(g.x)); w.y = cvt_pk_bf16(v0[2] * lo_bf(g.y), v0[3] * hi_bf(g.y));
                            w.z = cvt_pk_bf16(v1[0] * lo_bf(g.z), v1[1] * hi_bf(g.z)); w.w = cvt_pk_bf16(v1[2] * lo_bf(g.w), v1[3] * hi_bf(g.w));
                            *(u32x4*)(dst + off) = w; } }
                    ROWFENCE; }
        } else if (ek == K_BR) {
            unsigned char* dst = ws + OFF_M; const unsigned char* mg = ws + OFF_MERGE; const int br = u.aux;
#pragma unroll
            for (int ai = 0; ai < 2; ++ai) { u32x4 gq[4][2], oq[4][2];
#pragma unroll
                for (int m = 0; m < 4; ++m) { const unsigned row = (unsigned)(u.pm * 256 + ai * 128 + m * 16 + rl0);
#pragma unroll
                    for (int bj = 0; bj < 2; ++bj) { const unsigned col = (unsigned)(u.pn * 256 + bj * 128 + cl0);
                        gq[m][bj] = *(const u32x4*)(mg + (row * 6144u + (unsigned)br * 2048u + col) * 2u);
                        if (br > 0) oq[m][bj] = *(const u32x4*)(dst + (row * (unsigned)DM + col) * 2u); else oq[m][bj] = (u32x4){0u, 0u, 0u, 0u}; } }
#pragma unroll
                for (int m = 0; m < 4; ++m) { const unsigned row = (unsigned)(u.pm * 256 + ai * 128 + m * 16 + rl0);
#pragma unroll
                    for (int bj = 0; bj < 2; ++bj) { const unsigned col = (unsigned)(u.pn * 256 + bj * 128 + cl0); const unsigned off = (row * (unsigned)DM + col) * 2u;
                        const u32x4 g = gq[m][bj], o = oq[m][bj]; const f32x4 v0 = acc[ai][bj][m][0], v1 = acc[ai][bj][m][1];
                        const float r0 = v0[0] * lo_bf(g.x) + lo_bf(o.x), r1 = v0[1] * hi_bf(g.x) + hi_bf(o.x), r2 = v0[2] * lo_bf(g.y) + lo_bf(o.y), r3 = v0[3] * hi_bf(g.y) + hi_bf(o.y);
                        const float r4 = v1[0] * lo_bf(g.z) + lo_bf(o.z), r5 = v1[1] * hi_bf(g.z) + hi_bf(o.z), r6 = v1[2] * lo_bf(g.w) + lo_bf(o.w), r7 = v1[3] * hi_bf(g.w) + hi_bf(o.w);
                        u32x4 w; w.x = cvt_pk_bf16(r0, r1); w.y = cvt_pk_bf16(r2, r3); w.z = cvt_pk_bf16(r4, r5); w.w = cvt_pk_bf16(r6, r7);
                        *(u32x4*)(dst + off) = w; } }
                ROWFENCE; }
        } else {
            unsigned char* dst = ws + OFF_H;
#pragma unroll
            for (int ai = 0; ai < 2; ++ai) { f32x4 oq[4][2][2];
#pragma unroll
                for (int m = 0; m < 4; ++m) { const unsigned row = (unsigned)(u.pm * 256 + ai * 128 + m * 16 + rl0);
                    const float* srow = layer == 0 ? (row < (unsigned)NMETA ? metain + (size_t)row * DM : xin + (size_t)(row - NMETA) * DM) : (const float*)(dst + (size_t)row * DM * 4);
#pragma unroll
                    for (int bj = 0; bj < 2; ++bj) { const unsigned col = (unsigned)(u.pn * 256 + bj * 128 + cl0); oq[m][bj][0] = *(const f32x4*)(srow + col); oq[m][bj][1] = *(const f32x4*)(srow + col + 4); } }
#pragma unroll
                for (int m = 0; m < 4; ++m) { const unsigned row = (unsigned)(u.pm * 256 + ai * 128 + m * 16 + rl0);
#pragma unroll
                    for (int bj = 0; bj < 2; ++bj) { const unsigned off = (row * (unsigned)DM + (unsigned)(u.pn * 256 + bj * 128 + cl0)) * 4u;
                        *(f32x4*)(dst + off) = oq[m][bj][0] + acc[ai][bj][m][0]; *(f32x4*)(dst + off + 16) = oq[m][bj][1] + acc[ai][bj][m][1]; } }
                ROWFENCE; }
        }
    }
};

__device__ void phase_prep0(const Params& p, unsigned char* smem) {
    const int tid = opaque_tid(), bid = blockIdx.x, G = gridDim.x;
    const size_t gtid = (size_t)bid * NTHREADS + tid, gstride = (size_t)G * NTHREADS;
    { bf16_t* fa = (bf16_t*)(p.ws + OFF_FA);
      for (size_t i = gtid; i < (size_t)512 * 384; i += gstride) { const int row = (int)(i / 384), col = (int)(i % 384); const int po = row >> 8, k1 = row & 255, pi = col / 192, l1 = col % 192; float v = 0.f;
          if (k1 < FN1 && l1 < FN1) { const int r = (k1 * l1) % FN1; const float a = 2.0f * (float)r / (float)FN1; const float cs = cospif(a), sn = sinpif(a);
              v = (po == 0) ? (pi == 0 ? cs : sn) : (pi == 0 ? -sn : cs); }
          fa[i] = f2bf(v); } }
    { bf16_t* fb = (bf16_t*)(p.ws + OFF_FB);
      for (size_t i = gtid; i < (size_t)FN1 * 65536; i += gstride) { const int k1 = (int)(i >> 16), k2 = (int)((i >> 8) & 255), kk = (int)(i & 255), part = kk >> 7, l2 = kk & 127; float v = 0.f;
          if (k2 < FN2 && l2 < FN2) { const int lp = k1 + FN1 * k2; const int r = (l2 * lp) % L_TOK; const float a = 2.0f * (float)r / (float)L_TOK; v = part == 0 ? cospif(a) : sinpif(a); }
          fb[i] = f2bf(v); } }
    { float* w1s = (float*)smem;
      float* w2s = w1s + 33 * 64;
      float* w3s = w2s + 64 * 64;
      const int lane = tid & 63, wv = tid >> 6;
      for (int layer = 0; layer < 2; ++layer) {
          __syncthreads();
          for (int i = tid; i < 33 * 64; i += NTHREADS) w1s[i] = p.f_w1[layer * 33 * 64 + i];
          for (int i = tid; i < 64 * 64; i += NTHREADS) { w2s[i] = p.f_w2[layer * 4096 + i]; w3s[i] = p.f_w3[layer * 4096 + i]; }
          __syncthreads();
          const float b1 = p.f_b1[layer * 64 + lane], b2 = p.f_b2[layer * 64 + lane], b3 = p.f_b3[layer * 64 + lane], fr = p.f_freq[layer * 64 + lane];
          bf16_t* h3 = (bf16_t*)(p.ws + OFF_H3) + (size_t)layer * L_TOK * 64;
          for (int lag = bid * 8 + wv; lag < L_TOK; lag += G * 8) {
              const float tt = (float)lag / (float)(L_TOK - 1); const float w = 6.283185307179586f * (float)lag / (float)L_TOK;
              float z = 0.f;
              if (lane == 0) z = tt;
              else if (lane < 33) { const int j = (lane - 1) & 15; const float f = 1e-4f + (float)j * ((15.0f - 1e-4f) / 15.0f); const float a = f * w; z = lane < 17 ? cosf(a) : -sinf(a); }
              float a1 = b1;
#pragma unroll 3
              for (int i = 0; i < 33; ++i) a1 += __shfl(z, i) * w1s[i * 64 + lane];
              const float h1 = sinf(fr * a1);
              float a2 = b2;
#pragma unroll 8
              for (int i = 0; i < 64; ++i) a2 += __shfl(h1, i) * w2s[i * 64 + lane];
              const float h2 = sinf(fr * a2);
              float a3 = b3;
#pragma unroll 8
              for (int i = 0; i < 64; ++i) a3 += __shfl(h2, i) * w3s[i * 64 + lane];
              h3[(size_t)lag * 64 + lane] = f2bf(sinf(fr * a3));
          }
      }
      __syncthreads(); }
}

__device__ void convert_matrix(const float* __restrict__ src, int K, int N, bf16_t* __restrict__ dst, int kshift  , int total, float* tile  ) {
    const int tid = opaque_tid(), G = gridDim.x; const int kl0 = tid >> 4, n4 = (tid & 15) * 4, nl = tid >> 3, k8 = (tid & 7) * 8;
    f32x4 pv0 = (f32x4){0.f, 0.f, 0.f, 0.f}, pv1 = pv0;
    int t = blockIdx.x;
    if (t < total) { const int kt = t & ((1 << kshift) - 1), nt_ = t >> kshift; const float* s = src + (size_t)(kt * 64 + kl0) * N + nt_ * 64 + n4; pv0 = *(const f32x4*)s; pv1 = *(const f32x4*)(s + (size_t)32 * N); }
    int buf = 0;
    for (; t < total; t += G) { float* tl = tile + buf * (64 * 65); const int kt = t & ((1 << kshift) - 1), nt_ = t >> kshift;
        tl[kl0 * 65 + n4] = pv0[0]; tl[kl0 * 65 + n4 + 1] = pv0[1]; tl[kl0 * 65 + n4 + 2] = pv0[2]; tl[kl0 * 65 + n4 + 3] = pv0[3];
        tl[(32 + kl0) * 65 + n4] = pv1[0]; tl[(32 + kl0) * 65 + n4 + 1] = pv1[1]; tl[(32 + kl0) * 65 + n4 + 2] = pv1[2]; tl[(32 + kl0) * 65 + n4 + 3] = pv1[3];
        { const int tn = t + G; if (tn < total) { const int kt2 = tn & ((1 << kshift) - 1), nt2 = tn >> kshift; const float* s = src + (size_t)(kt2 * 64 + kl0) * N + nt2 * 64 + n4; pv0 = *(const f32x4*)s; pv1 = *(const f32x4*)(s + (size_t)32 * N); } }
        __syncthreads();
        u32x4 w; w.x = cvt_pk_bf16(tl[(k8 + 0) * 65 + nl], tl[(k8 + 1) * 65 + nl]); w.y = cvt_pk_bf16(tl[(k8 + 2) * 65 + nl], tl[(k8 + 3) * 65 + nl]);
        w.z = cvt_pk_bf16(tl[(k8 + 4) * 65 + nl], tl[(k8 + 5) * 65 + nl]); w.w = cvt_pk_bf16(tl[(k8 + 6) * 65 + nl], tl[(k8 + 7) * 65 + nl]);
        *(u32x4*)(dst + (size_t)(nt_ * 64 + nl) * K + kt * 64 + k8) = w;
        buf ^= 1; }
    __syncthreads();
}

__device__ void phase_p1(const Params& p, int layer, unsigned char* smem) {
    const int tid = opaque_tid(), bid = blockIdx.x, G = gridDim.x;
    float* tile = (float*)smem;
    { const float* win = p.w_in + (size_t)layer * DM * NIN;
      convert_matrix(win, DM, NIN, (bf16_t*)(p.ws + OFF_WT), 5, 32 * 256, tile);
      for (int br = 0; br < 3; ++br) { const float* wsrc = (br == 0 ? p.w_a : br == 1 ? p.w_b : p.w_c) + (size_t)layer * 1024 * DM;
          convert_matrix(wsrc, 1024, DM, (bf16_t*)(p.ws + OFF_WA + br * SZ_WBR), 4, 16 * 32, tile); }
      const float* wo = p.w_out + (size_t)layer * DM * DM;
      convert_matrix(wo, DM, DM, (bf16_t*)(p.ws + OFF_WO), 5, 32 * 32, tile);
      __syncthreads(); }
    { float* tileT = (float*)smem;
      float* ctab = tileT + 256 * 32;
      float* stab = ctab + 256;
      const float* win = p.w_in + (size_t)layer * DM * NIN;
      for (int t = bid; t < 256; t += G) { const int g = t >> 6, k0 = (t & 63) * 32;
          __syncthreads();
          if (tid < 256) { const float a = 2.0f * (float)tid / 256.0f; ctab[tid] = cospif(a); stab[tid] = sinpif(a); }
#pragma unroll
          for (int ps = 0; ps < 4; ++ps) { const int idx = ps * NTHREADS + tid; const int kl = idx >> 6, c4 = (idx & 63) * 4;
              const f32x4 v = *(const f32x4*)(win + (size_t)(k0 + kl) * NIN + 4096 + g * 256 + c4);
              tileT[(c4 + 0) * 32 + kl] = v[0]; tileT[(c4 + 1) * 32 + kl] = v[1]; tileT[(c4 + 2) * 32 + kl] = v[2]; tileT[(c4 + 3) * 32 + kl] = v[3]; }
          __syncthreads();
          const int jrow = tid & 255, kh = tid >> 8; const int part = jrow <= 128 ? 0 : 1; const int cp = part == 0 ? jrow : jrow - 128;
          float acc[16];
#pragma unroll
          for (int k = 0; k < 16; ++k) acc[k] = 0.f;
          for (int c = 0; c < 256; ++c) { const int r = (c * cp) & 255; const float tw = part == 0 ? ctab[r] : -stab[r];
#pragma unroll
              for (int k4 = 0; k4 < 4; ++k4) { const f32x4 v = *(const f32x4*)(tileT + c * 32 + kh * 16 + k4 * 4); acc[k4 * 4 + 0] += v[0] * tw; acc[k4 * 4 + 1] += v[1] * tw; acc[k4 * 4 + 2] += v[2] * tw; acc[k4 * 4 + 3] += v[3] * tw; } }
          bf16_t* dst = (bf16_t*)(p.ws + OFF_WEFF) + (size_t)(g * 256 + jrow) * DM + k0 + kh * 16;
#pragma unroll
          for (int k8 = 0; k8 < 2; ++k8) { u32x4 w; w.x = cvt_pk_bf16(acc[k8 * 8 + 0], acc[k8 * 8 + 1]); w.y = cvt_pk_bf16(acc[k8 * 8 + 2], acc[k8 * 8 + 3]); w.z = cvt_pk_bf16(acc[k8 * 8 + 4], acc[k8 * 8 + 5]); w.w = cvt_pk_bf16(acc[k8 * 8 + 6], acc[k8 * 8 + 7]);
              *(u32x4*)(dst + k8 * 8) = w; } }
      __syncthreads(); }
    { const int lane = tid & 63, wv = tid >> 6; const float* h = (const float*)(p.ws + OFF_H); const float* gam = p.norm_g + layer * DM;
      bf16_t* xn = (bf16_t*)(p.ws + OFF_XN); bf16_t* xnp = (bf16_t*)(p.ws + OFF_XNP);
      for (int l = bid * 8 + wv; l < LP; l += G * 8) {
          if (l < L_TOK) { const f32x4* row = (const f32x4*)(layer == 0 ? (l < NMETA ? p.meta + (size_t)l * DM : p.x + (size_t)(l - NMETA) * DM) : h + (size_t)l * DM); f32x4 v[8]; float ss = 0.f;
#pragma unroll
              for (int i = 0; i < 8; ++i) { v[i] = row[i * 64 + lane]; ss += v[i][0] * v[i][0] + v[i][1] * v[i][1] + v[i][2] * v[i][2] + v[i][3] * v[i][3]; }
              ss = wave_sum(ss); const float inv = rsqrtf(ss * (1.0f / DM) + 1e-6f);
              const int l1 = l / FN2, l2 = l - l1 * FN2; const size_t pr = (size_t)l2 * FN1P + l1;
#pragma unroll
              for (int i = 0; i < 8; ++i) { const f32x4 gg = ((const f32x4*)gam)[i * 64 + lane]; u32x2 w; w.x = cvt_pk_bf16(v[i][0] * inv * gg[0], v[i][1] * inv * gg[1]); w.y = cvt_pk_bf16(v[i][2] * inv * gg[2], v[i][3] * inv * gg[3]);
                  *(u32x2*)(xn + (size_t)l * DM + (i * 64 + lane) * 4) = w; *(u32x2*)(xnp + pr * DM + (i * 64 + lane) * 4) = w; } }
          else { const u32x2 z = (u32x2){0u, 0u};
#pragma unroll
              for (int i = 0; i < 8; ++i) *(u32x2*)(xn + (size_t)l * DM + (i * 64 + lane) * 4) = z; } }
      for (int idx = bid * 8 + wv; idx < FN2 * (FN1P - FN1); idx += G * 8) { const int l2 = idx / (FN1P - FN1), l1 = FN1 + idx % (FN1P - FN1); const size_t pr = (size_t)l2 * FN1P + l1; const u32x2 z = (u32x2){0u, 0u};
#pragma unroll
          for (int i = 0; i < 8; ++i) *(u32x2*)(xnp + pr * DM + (i * 64 + lane) * 4) = z; } }
}

__device__ void na_phase(const Params& p, int layer, unsigned char* smem) {
    const int tid = opaque_tid(), wv = tid >> 6, lane = tid & 63, l15 = lane & 15, quad = lane >> 4;
    const int G = gridDim.x;
    const bf16_t* qkv = (const bf16_t*)(p.ws + OFF_QKV);
    unsigned char* sK = smem;
    bf16_t* sVT = (bf16_t*)(smem + 76032);
    float* sRPB = (float*)(smem + 144640);
    float* sMB = (float*)(smem + 146512);
    const int cb = wv & 3, hf = wv >> 2, c = cb * 16 + l15;
    const int cu = cb == 0 ? 0 : (cb == 1 ? 8 : (cb == 2 ? 24 : 32)), cs = min(max(c - 8, 0), 48);
    u32x4 pk[8], pv[8], pmk = (u32x4){0u, 0u, 0u, 0u}, pmv = (u32x4){0u, 0u, 0u, 0u}; bf16x8 pq0, pq1; float prp = 0.f;
#define NA_LOADS(U) do { const int r_ = (U) >> 4, hd_ = (U) & 15, r0_ = min(max(r_ - 4, 0), 248); \
        _Pragma("unroll") for (int ps = 0; ps < 8; ++ps) { const int tok = ps * 64 + (tid >> 3), ch = tid & 7; const size_t g = (size_t)(NMETA + r0_ * 64 + tok) * 3072 + hd_ * 64 + ch * 8; \
            pk[ps] = *(const u32x4*)(qkv + g + 1024); pv[ps] = *(const u32x4*)(qkv + g + 2048); } \
        if (tid < 128) { const size_t g = (size_t)(tid >> 3) * 3072 + hd_ * 64 + (tid & 7) * 8; pmk = *(const u32x4*)(qkv + g + 1024); pmv = *(const u32x4*)(qkv + g + 2048); } \
        { const bf16_t* qp = qkv + (size_t)(NMETA + r_ * 64 + c) * 3072 + hd_ * 64 + quad * 8; pq0 = *(const bf16x8*)qp; pq1 = *(const bf16x8*)(qp + 32); } \
        if (tid < 465) prp = p.rpb[(size_t)(layer * 16 + hd_) * 465 + tid]; else if (tid >= 480 && tid < 496) prp = p.meta_bias[(layer * 16 + hd_) * 16 + tid - 480]; } while (0)
    int u = blockIdx.x;
    if (u < 4096) NA_LOADS(u);
    for (; u < 4096; u += G) {
        const int r = u >> 4, hd = u & 15, r0 = min(max(r - 4, 0), 248);
        __syncthreads();
#pragma unroll
        for (int ps = 0; ps < 8; ++ps) { const int tok = ps * 64 + (tid >> 3), ch = tid & 7; const u32x4 vv = pv[ps];
            *(u32x4*)(sK + tok * 144 + ch * 16) = pk[ps];
            bf16_t* vt = sVT + (ch * 8) * 536 + tok;
            vt[0] = (bf16_t)vv.x; vt[536] = (bf16_t)(vv.x >> 16); vt[2 * 536] = (bf16_t)vv.y; vt[3 * 536] = (bf16_t)(vv.y >> 16);
            vt[4 * 536] = (bf16_t)vv.z; vt[5 * 536] = (bf16_t)(vv.z >> 16); vt[6 * 536] = (bf16_t)vv.w; vt[7 * 536] = (bf16_t)(vv.w >> 16); }
        if (tid < 128) { const int tok = tid >> 3, ch = tid & 7; const u32x4 vv = pmv;
            *(u32x4*)(sK + (512 + tok) * 144 + ch * 16) = pmk;
            bf16_t* vt = sVT + (ch * 8) * 536 + 512 + tok;
            vt[0] = (bf16_t)vv.x; vt[536] = (bf16_t)(vv.x >> 16); vt[2 * 536] = (bf16_t)vv.y; vt[3 * 536] = (bf16_t)(vv.y >> 16);
            vt[4 * 536] = (bf16_t)vv.z; vt[5 * 536] = (bf16_t)(vv.z >> 16); vt[6 * 536] = (bf16_t)vv.w; vt[7 * 536] = (bf16_t)(vv.w >> 16); }
        if (tid < 465) sRPB[tid] = prp; else if (tid >= 480 && tid < 496) sMB[tid - 480] = prp;
        const bf16x8 bq0 = pq0, bq1 = pq1;
        { const int un = u + G; if (un < 4096) NA_LOADS(un); }
        __syncthreads();
        bf16_t* yc = (bf16_t*)(p.ws + OFF_GATE + 2 * SZ_GATE);
        float gatev[4][4];
        if (hf == 0) {
#pragma unroll
            for (int rr = 0; rr < 4; ++rr)
#pragma unroll
                for (int dt = 0; dt < 4; ++dt) gatev[rr][dt] = bf2f(yc[(size_t)(NMETA + r * 64 + cb * 16 + quad * 4 + rr) * 1024 + hd * 64 + l15 + dt * 16]); }
        float sc[9][4];
#pragma unroll
        for (int ti = 0; ti < 9; ++ti) { const int j = 4 * hf + (ti >> 1), tt = ti & 1; const int slot0 = ti < 8 ? j * 64 + cu + tt * 16 : 512;
            const unsigned char* kp = sK + (slot0 + l15) * 144 + quad * 16;
            const bf16x8 a0 = *(const bf16x8*)kp, a1 = *(const bf16x8*)(kp + 64);
            f32x4 acc = (f32x4){0.f, 0.f, 0.f, 0.f};
            acc = __builtin_amdgcn_mfma_f32_16x16x32_bf16(a0, bq0, acc, 0, 0, 0); acc = __builtin_amdgcn_mfma_f32_16x16x32_bf16(a1, bq1, acc, 0, 0, 0);
            if (ti < 8) { const float* rp = sRPB + (r0 + j - r + 7) * 31 + (15 - c);
#pragma unroll
                for (int rr = 0; rr < 4; ++rr) { const int kc = cu + tt * 16 + quad * 4 + rr; const bool ok = kc >= cs && kc < cs + 16; const int kcc = ok ? kc : cs;
                    sc[ti][rr] = ok ? acc[rr] * 0.125f + rp[kcc] : -1.0e30f; } }
            else {
#pragma unroll
                for (int rr = 0; rr < 4; ++rr) sc[ti][rr] = hf == 0 ? acc[rr] * 0.125f + sMB[quad * 4 + rr] : -1.0e30f; } }
        float mx = -1.0e30f;
#pragma unroll
        for (int ti = 0; ti < 9; ++ti)
#pragma unroll
            for (int rr = 0; rr < 4; ++rr) mx = fmaxf(mx, sc[ti][rr]);
        mx = fmaxf(mx, __shfl_xor(mx, 16)); mx = fmaxf(mx, __shfl_xor(mx, 32));
        float lsum = 0.f;
#pragma unroll
        for (int ti = 0; ti < 9; ++ti)
#pragma unroll
            for (int rr = 0; rr < 4; ++rr) { sc[ti][rr] = __expf(sc[ti][rr] - mx); lsum += sc[ti][rr]; }
        lsum += __shfl_xor(lsum, 16); lsum += __shfl_xor(lsum, 32);
        f32x4 oacc[4];
#pragma unroll
        for (int dt = 0; dt < 4; ++dt) oacc[dt] = (f32x4){0.f, 0.f, 0.f, 0.f};
#pragma unroll
        for (int ks = 0; ks < 5; ++ks) { const int tA = 2 * ks, tB = 2 * ks + 1;
            const int jA = 4 * hf + (tA >> 1); const int slotA = tA < 8 ? jA * 64 + cu + (tA & 1) * 16 : 512; const int slotB = ks < 4 ? (4 * hf + (tB >> 1)) * 64 + cu + 16 : 512;
            u32x4 pa; pa.x = cvt_pk_bf16(sc[tA][0], sc[tA][1]); pa.y = cvt_pk_bf16(sc[tA][2], sc[tA][3]);
            if (ks < 4) { pa.z = cvt_pk_bf16(sc[tA + 1 < 9 ? tA + 1 : 8][0], sc[tA + 1 < 9 ? tA + 1 : 8][1]); pa.w = cvt_pk_bf16(sc[tA + 1 < 9 ? tA + 1 : 8][2], sc[tA + 1 < 9 ? tA + 1 : 8][3]); } else { pa.z = 0u; pa.w = 0u; }
            const bf16x8 af = __builtin_bit_cast(bf16x8, pa);
#pragma unroll
            for (int dt = 0; dt < 4; ++dt) { const bf16_t* vr = sVT + (dt * 16 + l15) * 536 + quad * 4;
                const u32x2 lo = *(const u32x2*)(vr + slotA), hi = *(const u32x2*)(vr + slotB);
                const u32x4 bb = (u32x4){lo.x, lo.y, hi.x, hi.y};
                oacc[dt] = __builtin_amdgcn_mfma_f32_16x16x32_bf16(af, __builtin_bit_cast(bf16x8, bb), oacc[dt], 0, 0, 0); } }
        __syncthreads();
        float* part = (float*)smem + cb * 1056;
        if (hf == 1) {
#pragma unroll
            for (int dt = 0; dt < 4; ++dt)
#pragma unroll
                for (int rr = 0; rr < 4; ++rr) part[(quad * 4 + rr) * 64 + dt * 16 + l15] = oacc[dt][rr];
            if (quad == 0) { part[1024 + l15] = mx; part[1040 + l15] = lsum; } }
        __syncthreads();
        if (hf == 0) {
#pragma unroll
            for (int rr = 0; rr < 4; ++rr) { const int qy = quad * 4 + rr; const float m0 = __shfl(mx, qy), l0 = __shfl(lsum, qy); const float m1 = part[1024 + qy], l1 = part[1040 + qy];
                const float M = fmaxf(m0, m1), f0 = __expf(m0 - M), f1 = __expf(m1 - M); const float inv = 1.0f / (f0 * l0 + f1 * l1);
                bf16_t* gp = yc + (size_t)(NMETA + r * 64 + cb * 16 + qy) * 1024 + hd * 64 + l15;
#pragma unroll
                for (int dt = 0; dt < 4; ++dt) { const float o = (f0 * oacc[dt][rr] + f1 * part[qy * 64 + dt * 16 + l15]) * inv; gp[dt * 16] = f2bf(o * gatev[rr][dt]); } } }
    }
#undef NA_LOADS
}
__device__ void na_meta_unit(const Params& p, int layer) {
    const int tid = opaque_tid();
    if (tid < 256) { const int hd = tid >> 4, qi = tid & 15; const bf16_t* qkv = (const bf16_t*)(p.ws + OFF_QKV);
        float q[64];
        { const u32x4* qp = (const u32x4*)(qkv + (size_t)qi * 3072 + hd * 64);
#pragma unroll
          for (int i = 0; i < 8; ++i) { const u32x4 v = qp[i]; q[i * 8 + 0] = lo_bf(v.x) * 0.125f; q[i * 8 + 1] = hi_bf(v.x) * 0.125f; q[i * 8 + 2] = lo_bf(v.y) * 0.125f; q[i * 8 + 3] = hi_bf(v.y) * 0.125f;
              q[i * 8 + 4] = lo_bf(v.z) * 0.125f; q[i * 8 + 5] = hi_bf(v.z) * 0.125f; q[i * 8 + 6] = lo_bf(v.w) * 0.125f; q[i * 8 + 7] = hi_bf(v.w) * 0.125f; } }
        float o[64];
#pragma unroll
        for (int i = 0; i < 64; ++i) o[i] = 0.f;
        float mx = -3.0e38f, lsum = 0.f;
#pragma unroll 1
        for (int m = 0; m < 16; ++m) { const u32x4* kp = (const u32x4*)(qkv + (size_t)m * 3072 + 1024 + hd * 64); const u32x4* vp = (const u32x4*)(qkv + (size_t)m * 3072 + 2048 + hd * 64);
            float d0 = 0.f, d1 = 0.f;
#pragma unroll
            for (int e = 0; e < 8; ++e) { const u32x4 v = kp[e];
                d0 += q[e * 8 + 0] * lo_bf(v.x) + q[e * 8 + 2] * lo_bf(v.y) + q[e * 8 + 4] * lo_bf(v.z) + q[e * 8 + 6] * lo_bf(v.w);
                d1 += q[e * 8 + 1] * hi_bf(v.x) + q[e * 8 + 3] * hi_bf(v.y) + q[e * 8 + 5] * hi_bf(v.z) + q[e * 8 + 7] * hi_bf(v.w); }
            const float sc = d0 + d1 + p.meta_bias[(layer * 16 + hd) * 16 + m]; const float mnew = fmaxf(mx, sc); const float alpha = __expf(mx - mnew), pi = __expf(sc - mnew);
            lsum = lsum * alpha + pi; mx = mnew;
#pragma unroll
            for (int e = 0; e < 8; ++e) { const u32x4 v = vp[e];
                o[e * 8 + 0] = o[e * 8 + 0] * alpha + pi * lo_bf(v.x); o[e * 8 + 1] = o[e * 8 + 1] * alpha + pi * hi_bf(v.x); o[e * 8 + 2] = o[e * 8 + 2] * alpha + pi * lo_bf(v.y); o[e * 8 + 3] = o[e * 8 + 3] * alpha + pi * hi_bf(v.y);
                o[e * 8 + 4] = o[e * 8 + 4] * alpha + pi * lo_bf(v.z); o[e * 8 + 5] = o[e * 8 + 5] * alpha + pi * hi_bf(v.z); o[e * 8 + 6] = o[e * 8 + 6] * alpha + pi * lo_bf(v.w); o[e * 8 + 7] = o[e * 8 + 7] * alpha + pi * hi_bf(v.w); } }
        const float inv = 1.0f / lsum; u32x4* gp = (u32x4*)((bf16_t*)(p.ws + OFF_GATE + 2 * SZ_GATE) + (size_t)qi * 1024 + hd * 64);
#pragma unroll
        for (int e = 0; e < 8; ++e) { const u32x4 g = gp[e]; u32x4 w;
            w.x = cvt_pk_bf16(o[e * 8 + 0] * inv * lo_bf(g.x), o[e * 8 + 1] * inv * hi_bf(g.x)); w.y = cvt_pk_bf16(o[e * 8 + 2] * inv * lo_bf(g.y), o[e * 8 + 3] * inv * hi_bf(g.y));
            w.z = cvt_pk_bf16(o[e * 8 + 4] * inv * lo_bf(g.z), o[e * 8 + 5] * inv * hi_bf(g.z)); w.w = cvt_pk_bf16(o[e * 8 + 6] * inv * lo_bf(g.w), o[e * 8 + 7] * inv * hi_bf(g.w));
            gp[e] = w; } }
}

__device__ __forceinline__ unsigned rev4_14(unsigned k) { unsigned r = __brev(k) >> 18; return ((r & 0x1555u) << 1) | ((r >> 1) & 0x1555u); }
__device__ __forceinline__ float2 cmul(float2 a, float2 b) { return make_float2(a.x * b.x - a.y * b.y, a.x * b.y + a.y * b.x); }
#define PADI(i) ((i) + ((i) >> 4))
#define CFF(n) cff[2 * PADI((n) >> 1) + ((n) & 1)]
__device__ __forceinline__ void hw_sincos(float rev, float& sn, float& cs) { sn = __builtin_amdgcn_sinf(rev); cs = __builtin_amdgcn_cosf(rev); }
__device__ __forceinline__ float c16(int k) { const float t[10] = {1.0f, 0.9238795325f, 0.7071067812f, 0.3826834324f, 0.0f, -0.3826834324f, -0.7071067812f, -0.9238795325f, -1.0f, -0.9238795325f}; return t[k]; }
__device__ __forceinline__ float s16(int k) { const float t[10] = {0.0f, 0.3826834324f, 0.7071067812f, 0.9238795325f, 1.0f, 0.9238795325f, 0.7071067812f, 0.3826834324f, 0.0f, -0.3826834324f}; return t[k]; }
__device__ __forceinline__ float2 cadd(float2 a, float2 b) { return make_float2(a.x + b.x, a.y + b.y); }
__device__ __forceinline__ float2 csub(float2 a, float2 b) { return make_float2(a.x - b.x, a.y - b.y); }
template <int SGN> __device__ __forceinline__ void bf4(float2& a0, float2& a1, float2& a2, float2& a3) {
    const float2 t0 = cadd(a0, a2), t1 = csub(a0, a2), t2 = cadd(a1, a3), d = csub(a1, a3);
    const float2 t3 = SGN < 0 ? make_float2(d.y, -d.x) : make_float2(-d.y, d.x);
    a0 = cadd(t0, t2); a1 = cadd(t1, t3); a2 = csub(t0, t2); a3 = csub(t1, t3);
}
template <int S> __device__ __forceinline__ void r16_fwd_pass(float2* a) {
    constexpr int Q = S / 4;
    for (int u = opaque_tid(); u < 1024; u += NTHREADS) { const int j = u & (Q - 1); const int base = ((u - j) << 4) + j;
        float2 x[4][4];
#pragma unroll
        for (int aa = 0; aa < 4; ++aa)
#pragma unroll
            for (int bb = 0; bb < 4; ++bb) x[aa][bb] = a[PADI(base + aa * S + bb * Q)];
        float sn, cs; hw_sincos((float)j / (float)(4 * S), sn, cs); const float2 wb0 = make_float2(cs, -sn);
#pragma unroll
        for (int bb = 0; bb < 4; ++bb) { const float2 w1 = bb == 0 ? wb0 : cmul(wb0, make_float2(c16(bb), -s16(bb))); const float2 w2 = cmul(w1, w1), w3 = cmul(w2, w1);
            bf4<-1>(x[0][bb], x[1][bb], x[2][bb], x[3][bb]); x[1][bb] = cmul(x[1][bb], w1); x[2][bb] = cmul(x[2][bb], w2); x[3][bb] = cmul(x[3][bb], w3); }
        hw_sincos((float)j / (float)S, sn, cs); const float2 v1 = make_float2(cs, -sn), v2 = cmul(v1, v1), v3 = cmul(v2, v1);
#pragma unroll
        for (int aa = 0; aa < 4; ++aa) { bf4<-1>(x[aa][0], x[aa][1], x[aa][2], x[aa][3]); x[aa][1] = cmul(x[aa][1], v1); x[aa][2] = cmul(x[aa][2], v2); x[aa][3] = cmul(x[aa][3], v3); }
#pragma unroll
        for (int aa = 0; aa < 4; ++aa)
#pragma unroll
            for (int bb = 0; bb < 4; ++bb) a[PADI(base + aa * S + bb * Q)] = x[aa][bb]; }
    __syncthreads();
}
template <int S> __device__ __forceinline__ void r16_inv_pass(float2* a) {
    constexpr int Q = S / 4;
    for (int u = opaque_tid(); u < 1024; u += NTHREADS) { const int j = u & (Q - 1); const int base = ((u - j) << 4) + j;
        float2 x[4][4];
#pragma unroll
        for (int aa = 0; aa < 4; ++aa)
#pragma unroll
            for (int bb = 0; bb < 4; ++bb) x[aa][bb] = a[PADI(base + aa * S + bb * Q)];
        float sn, cs; hw_sincos((float)j / (float)S, sn, cs); const float2 v1 = make_float2(cs, sn), v2 = cmul(v1, v1), v3 = cmul(v2, v1);
#pragma unroll
        for (int aa = 0; aa < 4; ++aa) { x[aa][1] = cmul(x[aa][1], v1); x[aa][2] = cmul(x[aa][2], v2); x[aa][3] = cmul(x[aa][3], v3); bf4<1>(x[aa][0], x[aa][1], x[aa][2], x[aa][3]); }
        hw_sincos((float)j / (float)(4 * S), sn, cs); const float2 wb0 = make_float2(cs, sn);
#pragma unroll
        for (int bb = 0; bb < 4; ++bb) { const float2 w1 = bb == 0 ? wb0 : cmul(wb0, make_float2(c16(bb), s16(bb))); const float2 w2 = cmul(w1, w1), w3 = cmul(w2, w1);
            x[1][bb] = cmul(x[1][bb], w1); x[2][bb] = cmul(x[2][bb], w2); x[3][bb] = cmul(x[3][bb], w3); bf4<1>(x[0][bb], x[1][bb], x[2][bb], x[3][bb]); }
#pragma unroll
        for (int aa = 0; aa < 4; ++aa)
#pragma unroll
            for (int bb = 0; bb < 4; ++bb) a[PADI(base + aa * S + bb * Q)] = x[aa][bb]; }
    __syncthreads();
}
__device__ void fft_fwd(float2* a) {
    r16_fwd_pass<4096>(a);
    r16_fwd_pass<256>(a);
    { const int span = 16;
        for (int b = opaque_tid(); b < 4096; b += NTHREADS) { const int j = b & (span - 1); const int base = ((b - j) << 2) + j;
            const int i0 = PADI(base), i1 = PADI(base + span), i2 = PADI(base + 2 * span), i3 = PADI(base + 3 * span);
            float2 a0 = a[i0], a1 = a[i1], a2 = a[i2], a3 = a[i3];
            const float2 w1 = make_float2(c16(0) * 0.f + __builtin_amdgcn_cosf((float)j * (1.0f / 64.0f)), -__builtin_amdgcn_sinf((float)j * (1.0f / 64.0f))), w2 = cmul(w1, w1), w3 = cmul(w2, w1);
            bf4<-1>(a0, a1, a2, a3);
            a[i0] = a0; a[i1] = cmul(a1, w1); a[i2] = cmul(a2, w2); a[i3] = cmul(a3, w3); }
        __syncthreads(); }
    for (int blk = opaque_tid(); blk < 1024; blk += NTHREADS) { float2* pb = a + blk * 17; float2 x[16];
#pragma unroll
        for (int e = 0; e < 16; ++e) x[e] = pb[e];
#pragma unroll
        for (int j = 0; j < 4; ++j) { bf4<-1>(x[j], x[j + 4], x[j + 8], x[j + 12]);
            x[j + 4] = cmul(x[j + 4], make_float2(c16(j), -s16(j))); x[j + 8] = cmul(x[j + 8], make_float2(c16(2 * j), -s16(2 * j))); x[j + 12] = cmul(x[j + 12], make_float2(c16(3 * j), -s16(3 * j))); }
#pragma unroll
        for (int g = 0; g < 4; ++g) bf4<-1>(x[4 * g], x[4 * g + 1], x[4 * g + 2], x[4 * g + 3]);
#pragma unroll
        for (int e = 0; e < 16; ++e) pb[e] = x[e]; }
    __syncthreads();
}
__device__ void fft_inv(float2* a) {
    for (int blk = opaque_tid(); blk < 1024; blk += NTHREADS) { float2* pb = a + blk * 17; float2 x[16];
#pragma unroll
        for (int e = 0; e < 16; ++e) x[e] = pb[e];
#pragma unroll
        for (int g = 0; g < 4; ++g) bf4<1>(x[4 * g], x[4 * g + 1], x[4 * g + 2], x[4 * g + 3]);
#pragma unroll
        for (int j = 0; j < 4; ++j) { x[j + 4] = cmul(x[j + 4], make_float2(c16(j), s16(j))); x[j + 8] = cmul(x[j + 8], make_float2(c16(2 * j), s16(2 * j))); x[j + 12] = cmul(x[j + 12], make_float2(c16(3 * j), s16(3 * j)));
            bf4<1>(x[j], x[j + 4], x[j + 8], x[j + 12]); }
#pragma unroll
        for (int e = 0; e < 16; ++e) pb[e] = x[e]; }
    __syncthreads();
    { const int span = 16;
        for (int b = opaque_tid(); b < 4096; b += NTHREADS) { const int j = b & (span - 1); const int base = ((b - j) << 2) + j;
            const int i0 = PADI(base), i1 = PADI(base + span), i2 = PADI(base + 2 * span), i3 = PADI(base + 3 * span);
            const float2 w1 = make_float2(__builtin_amdgcn_cosf((float)j * (1.0f / 64.0f)), __builtin_amdgcn_sinf((float)j * (1.0f / 64.0f))), w2 = cmul(w1, w1), w3 = cmul(w2, w1);
            float2 a0 = a[i0], a1 = cmul(a[i1], w1), a2 = cmul(a[i2], w2), a3 = cmul(a[i3], w3);
            bf4<1>(a0, a1, a2, a3);
            a[i0] = a0; a[i1] = a1; a[i2] = a2; a[i3] = a3; }
        __syncthreads(); }
    r16_inv_pass<256>(a);
    r16_inv_pass<4096>(a);
}
__device__ __forceinline__ void hy_load8(const bf16_t* __restrict__ row, int t0, u32x4& v, float& xl, float& xh) {
    v = *(const u32x4*)(row + t0); xl = t0 > 0 ? bf2f(row[t0 - 1]) : 0.f; xh = (t0 + 8 < L_TOK) ? bf2f(row[t0 + 8]) : 0.f;
}
__device__ __forceinline__ void hy_calc8(const u32x4 v, float xl, float xh, const float (&w)[4], float (&o)[8]) {
    float x[10];
    x[0] = xl; x[9] = xh;
    x[1] = lo_bf(v.x); x[2] = hi_bf(v.x); x[3] = lo_bf(v.y); x[4] = hi_bf(v.y); x[5] = lo_bf(v.z); x[6] = hi_bf(v.z); x[7] = lo_bf(v.w); x[8] = hi_bf(v.w);
#pragma unroll
    for (int e = 0; e < 8; ++e) o[e] = w[0] * x[e] + w[1] * x[e + 1] + w[2] * x[e + 2] + w[3];
}
__device__ __forceinline__ void hy_val8(const bf16_t* __restrict__ row, int t0, const float (&w)[4], float (&o)[8]) { u32x4 v; float xl, xh; hy_load8(row, t0, v, xl, xh); hy_calc8(v, xl, xh, w, o); }
struct HyCh { const bf16_t* __restrict__ ru; const bf16_t* __restrict__ r1; const bf16_t* __restrict__ r2; float wu[4], w1[4], w2[4]; };

constexpr int SD_W4B = 0  , SD_GFX = 512, SD_GBX = 528, SD_EF = 544, SD_EB = 560, SD_VH = 576, SD_VT = 592, SD_END = 608;
constexpr int NCHUNK = L_TOK / 8;

template <int ORDER>
__device__ void hy_conv(const HyCh& hc, float2* cf, float* side, unsigned char* scratch) {
    const int tid = opaque_tid(); float* cff = (float*)cf;
    f32x4* __restrict__ heo = (f32x4*)(scratch + HS_HEO); const float* __restrict__ z2g = (const float*)(scratch + HS_Z2);
    if (tid < 15) side[SD_EF + tid] = CFF(16369 + tid); else if (tid >= 32 && tid < 47) side[SD_EB + tid - 32] = CFF(32768 - (16369 + tid - 32));
    __syncthreads();
    fft_fwd(cf);
    for (int j = tid; j <= 8192; j += NTHREADS) { const unsigned i_ = j < 8192 ? ((((unsigned)j >> 1) << 2) | ((unsigned)j & 1u)) : 2u; const unsigned k = rev4_14(i_); const unsigned kp = (16384u - k) & 16383u; const float2 a = cf[PADI(i_)], bq = cf[PADI(rev4_14(kp))];
        const float bx = bq.x, by = -bq.y; const float sc = 1.0f / 16384.0f;
        heo[j] = (f32x4){0.5f * (a.x + bx) * sc, 0.5f * (a.y + by) * sc, 0.5f * (a.y - by) * sc, -0.5f * (a.x - bx) * sc}; }
    __syncthreads();
    {
        u32x4 rv[4]; float rl[4], rh[4]; f32x4 z0[4], z1[4];
#pragma unroll
        for (int i = 0; i < 4; ++i) { const int c = tid + NTHREADS * i;
            if (ORDER == 0) hy_load8(hc.ru, 8 * c, rv[i], rl[i], rh[i]); else { z0[i] = *(const f32x4*)(z2g + 8 * c); z1[i] = *(const f32x4*)(z2g + 8 * c + 4); } }
#pragma unroll
        for (int i = 0; i < 4; ++i) { const int c = tid + NTHREADS * i; float v[8];
            if (ORDER == 0) hy_calc8(rv[i], rl[i], rh[i], hc.wu, v);
            else { v[0] = z0[i][0]; v[1] = z0[i][1]; v[2] = z0[i][2]; v[3] = z0[i][3]; v[4] = z1[i][0]; v[5] = z1[i][1]; v[6] = z1[i][2]; v[7] = z1[i][3]; }
            float2* d = cf + PADI(4 * c); d[0] = make_float2(v[0], v[1]); d[1] = make_float2(v[2], v[3]); d[2] = make_float2(v[4], v[5]); d[3] = make_float2(v[6], v[7]);
            if (i == 0 && tid < 2) {
#pragma unroll
                for (int e = 0; e < 8; ++e) side[SD_VH + 8 * tid + e] = v[e]; } }
        if (tid < 2) { const int c = NCHUNK - 2 + tid; float v[8];
            if (ORDER == 0) hy_val8(hc.ru, 8 * c, hc.wu, v);
            else { const f32x4 p0 = *(const f32x4*)(z2g + 8 * c), p1 = *(const f32x4*)(z2g + 8 * c + 4); v[0] = p0[0]; v[1] = p0[1]; v[2] = p0[2]; v[3] = p0[3]; v[4] = p1[0]; v[5] = p1[1]; v[6] = p1[2]; v[7] = p1[3]; }
            float2* d = cf + PADI(4 * c); d[0] = make_float2(v[0], v[1]); d[1] = make_float2(v[2], v[3]); d[2] = make_float2(v[4], v[5]); d[3] = make_float2(v[6], v[7]);
#pragma unroll
            for (int e = 0; e < 8; ++e) side[SD_VT + 8 * tid + e] = v[e]; } }
    for (int i = L_TOK / 2 + tid; i < 16384; i += NTHREADS) cf[PADI(i)] = make_float2(0.f, 0.f);
    __syncthreads();
    fft_fwd(cf);
#pragma unroll 4
    for (int j = tid; j <= 8192; j += NTHREADS) { const unsigned i_ = j < 8192 ? ((((unsigned)j >> 1) << 2) | ((unsigned)j & 1u)) : 2u; const unsigned k = rev4_14(i_); const unsigned kp = (16384u - k) & 16383u; const unsigned ik = PADI(i_), ikp = PADI(rev4_14(kp)); const float2 a = cf[ik], bq = cf[ikp];
        const float bx = bq.x, by = -bq.y;
        const float2 XE = make_float2(0.5f * (a.x + bx), 0.5f * (a.y + by)), XO = make_float2(0.5f * (a.y - by), -0.5f * (a.x - bx));
        const f32x4 hh = heo[j]; const float2 HE = make_float2(hh[0], hh[1]), HO = make_float2(hh[2], hh[3]);
        float sn, cs; hw_sincos((float)k / 16384.0f, sn, cs); const float2 w = make_float2(cs, -sn);
        const float2 xoho = cmul(XO, HO), wx = cmul(w, xoho), xehe = cmul(XE, HE), xeho = cmul(XE, HO), xohe = cmul(XO, HE);
        const float2 YE = make_float2(xehe.x + wx.x, xehe.y + wx.y), YO = make_float2(xeho.x + xohe.x, xeho.y + xohe.y);
        cf[ik] = make_float2(YE.x - YO.y, YE.y + YO.x); cf[ikp] = make_float2(YE.x + YO.y, -YE.y + YO.x); }
    __syncthreads();
    fft_inv(cf);
    if (tid < 16) { const int t = tid; float d = 0.f;
        for (int s = t + 16384; s < L_TOK; ++s) { const int l = s - t; const float wrong = l == 16384 ? 0.f : side[SD_EF + 16399 - l]; d += (side[SD_GBX + l - 16384] - wrong) * side[SD_VT + s - 16384]; }
        CFF(t) += d; }
    else if (tid >= 32 && tid < 48) { const int t = 16384 + tid - 32; float d = 0.f;
        for (int s = 0; s <= t - 16384; ++s) { const int l = t - s; const float wrong = l == 16384 ? 0.f : side[SD_EB + 16399 - l]; d += (side[SD_GFX + l - 16384] - wrong) * side[SD_VH + s]; }
        CFF(t) += d; }
    __syncthreads();
}

__device__ void filt_to_lds(const bf16_t* __restrict__ gfp, const bf16_t* __restrict__ gbp, float2* cf, float* side) {
    const int tid = opaque_tid(); float* cff = (float*)cf;
    u32x4 qf[4], qb[4];
#pragma unroll
    for (int i = 0; i < 4; ++i) { const int c = tid + NTHREADS * i; qf[i] = *(const u32x4*)(gfp + 8 * c); qb[i] = *(const u32x4*)(gbp + 8 * c); }
#pragma unroll
    for (int i = 0; i < 4; ++i) { const int c = tid + NTHREADS * i, lag0 = 8 * c; const u32x4 f = qf[i], g = qb[i];
        float2* d = cf + PADI(4 * c); d[0] = make_float2(lo_bf(f.x), hi_bf(f.x)); d[1] = make_float2(lo_bf(f.y), hi_bf(f.y)); d[2] = make_float2(lo_bf(f.z), hi_bf(f.z)); d[3] = make_float2(lo_bf(f.w), hi_bf(f.w));
        if (lag0 >= 1) CFF(32768 - lag0) = lo_bf(g.x);
        CFF(32768 - lag0 - 1) = hi_bf(g.x); CFF(32768 - lag0 - 2) = lo_bf(g.y); CFF(32768 - lag0 - 3) = hi_bf(g.y); CFF(32768 - lag0 - 4) = lo_bf(g.z); CFF(32768 - lag0 - 5) = hi_bf(g.z); CFF(32768 - lag0 - 6) = lo_bf(g.w); CFF(32768 - lag0 - 7) = hi_bf(g.w); }
    if (tid < 2) { const int c = NCHUNK - 2 + tid; const u32x4 f = *(const u32x4*)(gfp + 8 * c), g = *(const u32x4*)(gbp + 8 * c); float* sf = side + SD_GFX + 8 * tid; float* sb = side + SD_GBX + 8 * tid;
        sf[0] = lo_bf(f.x); sf[1] = hi_bf(f.x); sf[2] = lo_bf(f.y); sf[3] = hi_bf(f.y); sf[4] = lo_bf(f.z); sf[5] = hi_bf(f.z); sf[6] = lo_bf(f.w); sf[7] = hi_bf(f.w);
        sb[0] = lo_bf(g.x); sb[1] = hi_bf(g.x); sb[2] = lo_bf(g.y); sb[3] = hi_bf(g.y); sb[4] = lo_bf(g.z); sb[5] = hi_bf(g.z); sb[6] = lo_bf(g.w); sb[7] = hi_bf(g.w); }
    if (tid == 0) CFF(NMAIN) = 0.f;
    __syncthreads();
}

__device__ void hyena_filters(const Params& p, int layer, unsigned char* smem, unsigned char* scrD, unsigned char* scrW) {
    const int tid = opaque_tid(); float2* cf = (float2*)smem; float* cff = (float*)smem; float* side = (float*)(smem + 139264);
    const int bid = blockIdx.x;
    __syncthreads();
    bf16_t* w4b = (bf16_t*)(side + SD_W4B);
    for (int i = tid; i < 16 * 64; i += NTHREADS) { const int row = i >> 6, k = i & 63; w4b[i] = f2bf(p.f_w4[((size_t)layer * 64 + k) * 4096 + (row & 3) * 1024 + bid + 256 * (row >> 2)]); }
    __syncthreads();
    const bf16_t* __restrict__ h3b = (const bf16_t*)(p.ws + OFF_H3) + (size_t)layer * L_TOK * 64;
    const int lane = tid & 63, wv = tid >> 6, col = lane & 15, quad = lane >> 4;
    const int chq = bid + 256 * quad;
    float dk[4];
#pragma unroll
    for (int f = 0; f < 4; ++f) dk[f] = fabsf(p.decay[((layer * 2 + (f >> 1)) * 2 + (f & 1)) * 1024 + chq]) * (1.4426950408889634f / (float)(L_TOK - 1));
    const bf16x8 b0 = *(const bf16x8*)(w4b + col * 64 + quad * 8), b1 = *(const bf16x8*)(w4b + col * 64 + 32 + quad * 8);
    bf16_t* __restrict__ g2 = (bf16_t*)(scrW + HS_G2);
    bf16_t* __restrict__ fq = (bf16_t*)(scrD) + (size_t)(quad > 0 ? quad - 1 : 0) * 4 * L_TOK;
#define FG_LOAD(A0, A1, GB) do { _Pragma("unroll") for (int i = 0; i < 8; ++i) { const bf16_t* hr = h3b + (size_t)(((GB) + 8 * i) * 16 + col) * 64 + quad * 8; A0[i] = *(const bf16x8*)hr; A1[i] = *(const bf16x8*)(hr + 32); } } while (0)
#define FG_GROUP(X0, X1, G_) do { f32x4 acc = (f32x4){0.f, 0.f, 0.f, 0.f}; \
        acc = __builtin_amdgcn_mfma_f32_16x16x32_bf16(b0, X0, acc, 0, 0, 0); acc = __builtin_amdgcn_mfma_f32_16x16x32_bf16(b1, X1, acc, 0, 0, 0); \
        const int lag = (G_) * 16 + col; const float fl = -(float)lag; \
        const float v0 = acc[0] * __builtin_amdgcn_exp2f(fl * dk[0]), v1 = acc[1] * __builtin_amdgcn_exp2f(fl * dk[1]), v2 = acc[2] * __builtin_amdgcn_exp2f(fl * dk[2]), v3 = acc[3] * __builtin_amdgcn_exp2f(fl * dk[3]); \
        if (quad == 0) { g2[lag] = f2bf(v2); g2[L_TOK + lag] = f2bf(v3); \
            if (lag < NMAIN) { CFF(lag) = v0; if (lag >= 1) CFF(32768 - lag) = v1; } else { side[SD_GFX + lag - NMAIN] = v0; side[SD_GBX + lag - NMAIN] = v1; } } \
        else { fq[lag] = f2bf(v0); fq[L_TOK + lag] = f2bf(v1); fq[2 * L_TOK + lag] = f2bf(v2); fq[3 * L_TOK + lag] = f2bf(v3); } } while (0)
#define FG_PROC(A0, A1, GB) do { _Pragma("unroll") for (int i = 0; i < 8; ++i) FG_GROUP(A0[i], A1[i], (GB) + 8 * i); } while (0)
    { bf16x8 pa0[8], pa1[8], pb0[8], pb1[8];
      FG_LOAD(pa0, pa1, wv);
#pragma unroll 1
      for (int m = 0; m < 16; m += 2) { const int gbA = wv + 64 * m, gbB = gbA + 64;
          FG_LOAD(pb0, pb1, gbB);
          FG_PROC(pa0, pa1, gbA);
          if (m + 2 < 16) FG_LOAD(pa0, pa1, gbB + 64);
          FG_PROC(pb0, pb1, gbB); }
      if (wv == 0) { const bf16_t* hr = h3b + (size_t)(1024 * 16 + col) * 64 + quad * 8; const bf16x8 x0 = *(const bf16x8*)hr, x1 = *(const bf16x8*)(hr + 32); FG_GROUP(x0, x1, 1024); } }
#undef FG_LOAD
#undef FG_GROUP
#undef FG_PROC
    if (tid == 0) CFF(NMAIN) = 0.f;
    __syncthreads();
}

__device__ void hyena_unit(const Params& p, int layer, int q, unsigned char* smem, unsigned char* scrD, unsigned char* scratch) {
    const int tid = opaque_tid(); float2* cf = (float2*)smem; float* cff = (float*)smem; float* side = (float*)(smem + 139264);
    const int ch = blockIdx.x + 256 * q;
    const bf16_t* hyin = (const bf16_t*)(p.ws + OFF_HYIN);
    HyCh hc; hc.ru = hyin + (size_t)ch * LP; hc.r1 = hyin + (size_t)(1024 + ch) * LP; hc.r2 = hyin + (size_t)(2048 + ch) * LP;
    { const float* cw = p.conv_w + (size_t)layer * 3 * 3072; const float* cb = p.conv_b + (size_t)layer * 3072;
#pragma unroll
      for (int jj = 0; jj < 3; ++jj) { hc.wu[jj] = cw[jj * 3072 + ch]; hc.w1[jj] = cw[jj * 3072 + 1024 + ch]; hc.w2[jj] = cw[jj * 3072 + 2048 + ch]; }
      hc.wu[3] = cb[ch]; hc.w1[3] = cb[1024 + ch]; hc.w2[3] = cb[2048 + ch]; }
    const float sk0 = p.skip[(layer * 2 + 0) * 1024 + ch], sk1 = p.skip[(layer * 2 + 1) * 1024 + ch];
    float* __restrict__ z2g = (float*)(scratch + HS_Z2);
    const bf16_t* filt = q == 0 ? (const bf16_t*)(scratch + HS_G2) - 2 * (size_t)L_TOK : (const bf16_t*)scrD + (size_t)(q - 1) * 4 * L_TOK;
    bf16_t* __restrict__ hyout = (bf16_t*)(p.ws + OFF_HYOUT) + (size_t)ch * LP;
    if (q > 0) { __syncthreads(); filt_to_lds(filt, filt + L_TOK, cf, side); }
    hy_conv<0>(hc, cf, side, scratch);
    {   u32x4 ru_[4], r1_[4]; float ul[4], uh[4], xl[4], xh[4];
#pragma unroll
        for (int i = 0; i < 4; ++i) { const int c = tid + NTHREADS * i; hy_load8(hc.ru, 8 * c, ru_[i], ul[i], uh[i]); hy_load8(hc.r1, 8 * c, r1_[i], xl[i], xh[i]); }
#pragma unroll
        for (int i = 0; i < 5; ++i) { const int c = i < 4 ? tid + NTHREADS * i : NCHUNK - 2 + tid;
            if (i < 4 || tid < 2) { float u8[8], x8[8];
                if (i < 4) { hy_calc8(ru_[i], ul[i], uh[i], hc.wu, u8); hy_calc8(r1_[i], xl[i], xh[i], hc.w1, x8); } else { hy_val8(hc.ru, 8 * c, hc.wu, u8); hy_val8(hc.r1, 8 * c, hc.w1, x8); }
                const float2* s = cf + PADI(4 * c); const float2 y0 = s[0], y1 = s[1], y2 = s[2], y3 = s[3];
                const f32x4 o0 = (f32x4){x8[0] * (y0.x + sk0 * u8[0]), x8[1] * (y0.y + sk0 * u8[1]), x8[2] * (y1.x + sk0 * u8[2]), x8[3] * (y1.y + sk0 * u8[3])};
                const f32x4 o1 = (f32x4){x8[4] * (y2.x + sk0 * u8[4]), x8[5] * (y2.y + sk0 * u8[5]), x8[6] * (y3.x + sk0 * u8[6]), x8[7] * (y3.y + sk0 * u8[7])};
                *(f32x4*)(z2g + 8 * c) = o0; *(f32x4*)(z2g + 8 * c + 4) = o1; } } }
    __syncthreads();
    filt_to_lds(filt + 2 * (size_t)L_TOK, filt + 3 * (size_t)L_TOK, cf, side);
    hy_conv<1>(hc, cf, side, scratch);
    {   u32x4 r2_[4]; float xl[4], xh[4]; f32x4 z0[4], z1[4];
#pragma unroll
        for (int i = 0; i < 4; ++i) { const int c = tid + NTHREADS * i; hy_load8(hc.r2, 8 * c, r2_[i], xl[i], xh[i]); z0[i] = *(const f32x4*)(z2g + 8 * c); z1[i] = *(const f32x4*)(z2g + 8 * c + 4); }
#pragma unroll
        for (int i = 0; i < 5; ++i) { const int c = i < 4 ? tid + NTHREADS * i : NCHUNK - 2 + tid;
            if (i < 4 || tid < 2) { float x8[8]; f32x4 p0, p1;
                if (i < 4) { hy_calc8(r2_[i], xl[i], xh[i], hc.w2, x8); p0 = z0[i]; p1 = z1[i]; } else { hy_val8(hc.r2, 8 * c, hc.w2, x8); p0 = *(const f32x4*)(z2g + 8 * c); p1 = *(const f32x4*)(z2g + 8 * c + 4); }
                const float2* s = cf + PADI(4 * c); const float2 y0 = s[0], y1 = s[1], y2 = s[2], y3 = s[3];
                u32x4 w; w.x = cvt_pk_bf16(x8[0] * (y0.x + sk1 * p0[0]), x8[1] * (y0.y + sk1 * p0[1])); w.y = cvt_pk_bf16(x8[2] * (y1.x + sk1 * p0[2]), x8[3] * (y1.y + sk1 * p0[3]));
                w.z = cvt_pk_bf16(x8[4] * (y2.x + sk1 * p1[0]), x8[5] * (y2.y + sk1 * p1[1])); w.w = cvt_pk_bf16(x8[6] * (y3.x + sk1 * p1[2]), x8[7] * (y3.y + sk1 * p1[3]));
                *(u32x4*)(hyout + 8 * c) = w; } } }
    __syncthreads();
}

__device__ void transpose_phase(const Params& p, unsigned char* smem) {
    const int tid = opaque_tid(), G = gridDim.x; bf16_t* tile0 = (bf16_t*)smem;
    const bf16_t* __restrict__ hyout = (const bf16_t*)(p.ws + OFF_HYOUT); bf16_t* ya = (bf16_t*)(p.ws + OFF_GATE);
    const int cl = tid >> 3, t8 = (tid & 7) * 8, tl = tid >> 3, c8 = (tid & 7) * 8;
    u32x4 ph = (u32x4){0u, 0u, 0u, 0u}, pg = ph;
    constexpr int TOT = 16 * 257;
    int u = blockIdx.x;
    __syncthreads();
    if (u < TOT) { const int ct = u & 15, tt = u >> 4; ph = *(const u32x4*)(hyout + (size_t)(ct * 64 + cl) * LP + tt * 64 + t8); const int t = tt * 64 + tl; if (t < L_TOK) pg = *(const u32x4*)(ya + (size_t)t * 1024 + ct * 64 + c8); }
    int buf = 0;
    for (; u < TOT; u += G) { bf16_t* tile = tile0 + buf * (64 * 72); const int ct = u & 15, tt = u >> 4;
        *(u32x4*)(tile + cl * 72 + t8) = ph; const u32x4 g = pg;
        { const int un = u + G; if (un < TOT) { const int ct2 = un & 15, tt2 = un >> 4; ph = *(const u32x4*)(hyout + (size_t)(ct2 * 64 + cl) * LP + tt2 * 64 + t8); const int t2 = tt2 * 64 + tl; if (t2 < L_TOK) pg = *(const u32x4*)(ya + (size_t)t2 * 1024 + ct2 * 64 + c8); } }
        __syncthreads();
        const int t = tt * 64 + tl;
        if (t < L_TOK) { float v[8];
#pragma unroll
            for (int i = 0; i < 8; ++i) v[i] = bf2f(tile[(c8 + i) * 72 + tl]);
            u32x4 w; w.x = cvt_pk_bf16(v[0] * lo_bf(g.x), v[1] * hi_bf(g.x)); w.y = cvt_pk_bf16(v[2] * lo_bf(g.y), v[3] * hi_bf(g.y)); w.z = cvt_pk_bf16(v[4] * lo_bf(g.z), v[5] * hi_bf(g.z)); w.w = cvt_pk_bf16(v[6] * lo_bf(g.w), v[7] * hi_bf(g.w));
            *(u32x4*)(ya + (size_t)t * 1024 + ct * 64 + c8) = w; }
        buf ^= 1; }
    __syncthreads();
}

__device__ void phase_final(const Params& p) {
    const int tid = opaque_tid(), lane = tid & 63, wv = tid >> 6; const float* h = (const float*)(p.ws + OFF_H);
    for (int l = NMETA + blockIdx.x * 8 + wv; l < L_TOK; l += gridDim.x * 8) { const f32x4* row = (const f32x4*)(h + (size_t)l * DM); f32x4 v[8]; float ss = 0.f;
#pragma unroll
        for (int i = 0; i < 8; ++i) { v[i] = row[i * 64 + lane]; ss += v[i][0] * v[i][0] + v[i][1] * v[i][1] + v[i][2] * v[i][2] + v[i][3] * v[i][3]; }
        ss = wave_sum(ss); const float inv = rsqrtf(ss * (1.0f / DM) + 1e-6f); f32x4* o = (f32x4*)(p.out + (size_t)(l - NMETA) * DM);
#pragma unroll
        for (int i = 0; i < 8; ++i) { const f32x4 gg = ((const f32x4*)p.final_g)[i * 64 + lane]; o[i * 64 + lane] = v[i] * inv * gg; } }
}

__device__ void mini_branch(const Params& p) {
    const int tid = opaque_tid(), lane = tid & 63, wv = tid >> 6, nt_ = blockIdx.x * 8 + wv;
    if (nt_ < 128) { const int rc = lane & 15, quad = lane >> 4; const int n0 = nt_ * 16;
        const bf16_t* mg = (const bf16_t*)(p.ws + OFF_MERGE); bf16_t* mb = (bf16_t*)(p.ws + OFF_M);
        float tot[4] = {0.f, 0.f, 0.f, 0.f};
#pragma unroll 1
        for (int br = 0; br < 3; ++br) { const bf16_t* A = (const bf16_t*)(p.ws + OFF_GATE + (size_t)br * SZ_GATE) + (size_t)(NMAIN + rc) * 1024 + quad * 8;
            const bf16_t* B = (const bf16_t*)(p.ws + OFF_WA + (size_t)br * SZ_WBR) + (size_t)(n0 + rc) * 1024 + quad * 8;
            f32x4 acc = (f32x4){0.f, 0.f, 0.f, 0.f};
#pragma unroll 1
            for (int kb = 0; kb < 32; kb += 8) { bf16x8 av[8], bv[8];
#pragma unroll
                for (int i = 0; i < 8; ++i) { av[i] = *(const bf16x8*)(A + (kb + i) * 32); bv[i] = *(const bf16x8*)(B + (kb + i) * 32); }
#pragma unroll
                for (int i = 0; i < 8; ++i) acc = __builtin_amdgcn_mfma_f32_16x16x32_bf16(av[i], bv[i], acc, 0, 0, 0); }
#pragma unroll
            for (int r = 0; r < 4; ++r) tot[r] += acc[r] * bf2f(mg[(size_t)(NMAIN + quad * 4 + r) * 6144 + br * 2048 + n0 + rc]); }
#pragma unroll
        for (int r = 0; r < 4; ++r) mb[(size_t)(NMAIN + quad * 4 + r) * DM + n0 + rc] = f2bf(tot[r]); }
}
__device__ void mini_out(const Params& p, int layer) {
    const int tid = opaque_tid(), lane = tid & 63, wv = tid >> 6, nt_ = blockIdx.x * 8 + wv;
    if (nt_ < 128) { const int rc = lane & 15, quad = lane >> 4; const int n0 = nt_ * 16;
        const bf16_t* A = (const bf16_t*)(p.ws + OFF_M) + (size_t)(NMAIN + rc) * DM + quad * 8; const bf16_t* B = (const bf16_t*)(p.ws + OFF_WO) + (size_t)(n0 + rc) * DM + quad * 8;
        f32x4 acc = (f32x4){0.f, 0.f, 0.f, 0.f};
#pragma unroll 1
        for (int kb = 0; kb < 64; kb += 8) { bf16x8 av[8], bv[8];
#pragma unroll
            for (int i = 0; i < 8; ++i) { av[i] = *(const bf16x8*)(A + (kb + i) * 32); bv[i] = *(const bf16x8*)(B + (kb + i) * 32); }
#pragma unroll
            for (int i = 0; i < 8; ++i) acc = __builtin_amdgcn_mfma_f32_16x16x32_bf16(av[i], bv[i], acc, 0, 0, 0); }
        float* h = (float*)(p.ws + OFF_H);
#pragma unroll
        for (int r = 0; r < 4; ++r) { const size_t row = NMAIN + quad * 4 + r; const float bs = layer == 0 ? p.x[(row - NMETA) * DM + n0 + rc] : h[row * DM + n0 + rc]; h[row * DM + n0 + rc] = bs + acc[r]; } }
}

#define XB_TMO      128
#define XB_XCNT(j)  (256  + 64 * (j))
#define XB_XSUB(j)  (1280 + 64 * (j))
#define XB_XGEN(j)  (2304 + 64 * (j))
#define XB_TOP      3328
#define XB_TOPGEN   3392
#define XCD_BAR_WORDS 3456
#define XB_SPIN_CAP (1u << 18)
__device__ __forceinline__ unsigned xb_ld(unsigned* p)              { return __hip_atomic_load(p, __ATOMIC_RELAXED, __HIP_MEMORY_SCOPE_AGENT); }
__device__ __forceinline__ unsigned xb_add(unsigned* p, unsigned v) { return __hip_atomic_fetch_add(p, v, __ATOMIC_RELAXED, __HIP_MEMORY_SCOPE_AGENT); }
__device__ __forceinline__ unsigned xb_xcc_id() { return (unsigned)__builtin_amdgcn_s_getreg((3 << 11) | 20) & 0xFu; }
#define XB_SPIN(cond, bar) do { unsigned _sp = 0; while (cond) { __builtin_amdgcn_s_sleep(1); \
    if ((++_sp & 255u) == 0u) { if (xb_ld(&(bar)[XB_TMO])) break; if (_sp > XB_SPIN_CAP) { atomicAdd(&(bar)[XB_TMO], 1u); break; } } } } while (0)
struct XcdBarrier { unsigned* bar; unsigned x; volatile LAS unsigned* st; };
__device__ __forceinline__ void xcd_barrier_complete(unsigned* bar, unsigned x, unsigned& nloc, unsigned& nx) {
    const unsigned G = gridDim.x * gridDim.y * gridDim.z;
    unsigned sum, cnt, mine, sp = 0u;
    for (;;) {
        sum = 0u; cnt = 0u; mine = 0u;
#pragma unroll
        for (unsigned j = 0; j < 16; ++j) { const unsigned c = xb_ld(&bar[XB_XCNT(j)]); sum += c; cnt += (c > 0u) ? 1u : 0u; mine = (j == x) ? c : mine; }
        if (sum == G) break;
        __builtin_amdgcn_s_sleep(1);
        if ((++sp & 255u) == 0u) { if (xb_ld(&bar[XB_TMO])) break; if (sp > XB_SPIN_CAP) { atomicAdd(&bar[XB_TMO], 1u); break; } }
    }
    nloc = mine > 0u ? mine : 1u; nx = cnt > 0u ? cnt : 1u;
}
__device__ __forceinline__ void xcd_barrier(const XcdBarrier& b) {
    asm volatile("s_waitcnt vmcnt(0)" ::: "memory");
    __syncthreads();
    if (threadIdx.x == 0) {
        unsigned* bar = b.bar;
        __builtin_amdgcn_s_waitcnt(0);
        unsigned nloc = b.st[0], nx = b.st[1];
        if (nloc == 0u) { xcd_barrier_complete(bar, b.x, nloc, nx); b.st[0] = nloc; b.st[1] = nx; }
        const unsigned old = xb_add(&bar[XB_XSUB(b.x)], 1u);
        const unsigned gen = old / nloc;
        if (old + 1u == (gen + 1u) * nloc) {
            __builtin_amdgcn_fence(__ATOMIC_RELEASE, "agent");
            asm volatile("s_waitcnt vmcnt(0)" ::: "memory");
            const unsigned og = xb_add(&bar[XB_TOP], 1u);
            const unsigned tg = og / nx;
            if (og + 1u == (tg + 1u) * nx) xb_add(&bar[XB_TOPGEN], 1u);
            else XB_SPIN(xb_ld(&bar[XB_TOPGEN]) == tg, bar);
            __builtin_amdgcn_fence(__ATOMIC_ACQUIRE, "agent");
            xb_add(&bar[XB_XGEN(b.x)], 1u);
            asm volatile("s_waitcnt vmcnt(0)" ::: "memory");
        } else {
            XB_SPIN(xb_ld(&bar[XB_XGEN(b.x)]) == gen, bar);
            __builtin_amdgcn_fence(__ATOMIC_ACQUIRE, "agent");
            asm volatile("s_waitcnt vmcnt(0)" ::: "memory");
        }
    }
    __syncthreads();
}

enum { OP_P1 = 0, OP_SYNC, OP_GEMM, OP_NA, OP_HYENA, OP_TRANS, OP_NOP };
__global__ void __launch_bounds__(512, 2) hybrid_fwd(Params p) {
    extern __shared__ __attribute__((aligned(16))) unsigned char smem[];
    cg::grid_group grid = cg::this_grid();
    LAS unsigned char* lds = (LAS unsigned char*)smem;
    const int bid = blockIdx.x, G = gridDim.x;
    XcdBarrier xb; xb.bar = (unsigned*)(p.ws + OFF_BAR); xb.x = xb_xcc_id(); xb.st = (volatile LAS unsigned*)(lds + LDS_PHASE_BYTES);
    if (bid == 0) for (int i = opaque_tid(); i < XCD_BAR_WORDS; i += NTHREADS) xb.bar[i] = 0u;
    if (opaque_tid() == 0) { xb.st[0] = 0u; xb.st[1] = 0u; }
    __syncthreads();
    phase_prep0(p, smem);
    constexpr int NOPS = 17;
#pragma clang loop unroll(disable)
    for (int step = 0; step < 2 * NOPS; ++step) {
        const int layer = step / NOPS, s = step - layer * NOPS;
        int op, kind = 0;
        switch (s) {
        case 0: op = OP_P1; break;
        case 2: op = OP_GEMM; kind = K_IN; break;
        case 3: case 4: op = OP_NOP; break;
        case 6: op = OP_GEMM; kind = K_FNA; break;
        case 7: op = OP_NA; break;
        case 8: op = OP_HYENA; break;
        case 10: op = OP_GEMM; kind = K_FNB; break;
        case 11: op = OP_TRANS; break;
        case 13: op = OP_GEMM; kind = K_BR; break;
        case 15: op = OP_GEMM; kind = K_OUT; break;
        default: op = OP_SYNC; break;
        }
        if (op == OP_NOP) { }
        else if (op == OP_SYNC) { if (step == 1) { grid.sync(); if (opaque_tid() == 0) (void)xb_add(&xb.bar[XB_XCNT(xb.x)], 1u); } else xcd_barrier(xb); }
        else if (op == OP_GEMM) {
            Gemm g; g.base = (const char*)p.ws; g.jumpA = 0; g.jumpB = 0;
            switch (kind) {
            case K_FNA: g.lda = 384; g.ldb = FN1P; g.nt = 6; g.ksplit = 3; g.jumpB = (long)((size_t)1024 * PROWS * 2) - 384l; break;
            case K_FNB: g.lda = 256; g.ldb = 256; g.nt = 4; g.ksplit = 4; break;
            case K_BR:  g.lda = 1024; g.ldb = 1024; g.nt = 16; g.ksplit = 16; break;
            default:    g.lda = DM; g.ldb = DM; g.nt = 32; g.ksplit = 32; break;
            }
            SchedAny S{kind, G, bid}; EpiAny E{kind, p.ws, layer, p.x, p.meta};
            pg8::gemm_phase(lds, g, S, E);
            if (kind == K_BR) mini_branch(p); else if (kind == K_OUT) mini_out(p, layer);
        }
        else if (op == OP_P1) { phase_p1(p, layer, smem); }
        else if (op == OP_NA) { na_phase(p, layer, smem); if (bid == G - 1) na_meta_unit(p, layer); }
        else if (op == OP_HYENA) { unsigned char* scrD = (unsigned char*)p.out + (size_t)bid * HSD_STRIDE; unsigned char* scrW = p.ws + WS_END + (size_t)bid * HSW_STRIDE;
            hyena_filters(p, layer, smem, scrD, scrW);
#pragma clang loop unroll(disable)
            for (int q = 0; q < 4; ++q) hyena_unit(p, layer, q, smem, scrD, scrW); }
        else { transpose_phase(p, smem); }
    }
    phase_final(p);
}

extern "C" void kernel_launch(void* const* d_in, const int* in_sizes, int n_in, void* d_out, int out_size, void* d_ws, size_t ws_size, hipStream_t stream) {
    static int grid_blocks = 0;
    if (grid_blocks == 0) {
        if (n_in != 23 || ws_size < WS_END2) { fprintf(stderr, "kernel_launch: need 23 inputs and %zu bytes of workspace (got %d, %zu)\n", (size_t)WS_END2, n_in, ws_size); grid_blocks = -1; return; }
        int dev = 0, cus = 0, per_cu = 0;
        hipGetDevice(&dev); hipDeviceGetAttribute(&cus, hipDeviceAttributeMultiprocessorCount, dev);
        if (hipFuncSetAttribute((const void*)hybrid_fwd, hipFuncAttributeMaxDynamicSharedMemorySize, LDS_BYTES) != hipSuccess) { fprintf(stderr, "kernel_launch: hipFuncSetAttribute failed\n"); grid_blocks = -1; return; }
        hipOccupancyMaxActiveBlocksPerMultiprocessor(&per_cu, (const void*)hybrid_fwd, NTHREADS, LDS_BYTES);
        if (per_cu < 1) per_cu = 1;
        grid_blocks = cus * per_cu;
        if (grid_blocks > 256) grid_blocks = 256;
        if (grid_blocks != 256) { fprintf(stderr, "kernel_launch: this kernel needs 256 co-resident workgroups (got %d)\n", grid_blocks); grid_blocks = -1; return; }
    }
    if (grid_blocks < 0) return;
    Params p{};
    const float** f = (const float**)&p;
    for (int i = 0; i < 23; ++i) f[i] = (const float*)d_in[i];
    p.out = (float*)d_out; p.ws = (unsigned char*)d_ws;
    void* args[] = {&p};
    hipError_t e = hipLaunchCooperativeKernel((const void*)hybrid_fwd, dim3(grid_blocks), dim3(NTHREADS), args, LDS_BYTES, stream);
    if (e != hipSuccess) fprintf(stderr, "cooperative launch failed: %s (grid %d)\n", hipGetErrorString(e), grid_blocks);
}
```

```cpp
#include <hip/hip_runtime.h>
#include <hip/hip_cooperative_groups.h>
#include <cstdio>
namespace cg = cooperative_groups;

#define LAS __attribute__((address_space(3)))
typedef unsigned short bf16_t;
typedef short bf16x8 __attribute__((ext_vector_type(8)));
typedef float f32x4 __attribute__((ext_vector_type(4)));
typedef unsigned u32x4 __attribute__((ext_vector_type(4)));
typedef unsigned u32x2 __attribute__((ext_vector_type(2)));

constexpr int L_TOK = 16400, LP = 16640, DM = 2048, NIN = 16384, NMETA = 16, NMAIN = 16384;
constexpr int FN1 = 164, FN2 = 100, FN1P = 192, PROWS = FN2 * FN1P;
constexpr int NTHREADS = 512, LDS_PHASE_BYTES = 155648, LDS_BYTES = LDS_PHASE_BYTES + 16;

constexpr size_t SZ_H = (size_t)LP * DM * 4, SZ_XN = (size_t)LP * DM * 2, SZ_XNP = (size_t)PROWS * DM * 2;
constexpr size_t OFF_H = 0;
constexpr size_t OFF_XN = OFF_H + SZ_H;
constexpr size_t OFF_XNP = OFF_XN + SZ_XN;
constexpr size_t OFF_A1 = OFF_XN;
constexpr size_t SZ_A1 = (size_t)FN1 * 1024 * 2 * 128 * 2;
constexpr size_t OFF_HYOUT = OFF_A1 + SZ_A1;
constexpr size_t SZ_HYOUT = (size_t)1024 * LP * 2;
static_assert(OFF_HYOUT + SZ_HYOUT <= OFF_XNP + SZ_XNP, "alias overflow");
constexpr size_t OFF_WT = OFF_XNP + SZ_XNP;
constexpr size_t OFF_WEFF = OFF_WT + (size_t)NIN * DM * 2;
constexpr size_t OFF_WA = OFF_WEFF + (size_t)2048 * 2048 * 2;
constexpr size_t SZ_WBR = (size_t)2048 * 1024 * 2;
constexpr size_t OFF_WO = OFF_WA + 3 * SZ_WBR;
constexpr size_t OFF_HYIN = OFF_WO + (size_t)2048 * 2048 * 2;
constexpr size_t OFF_GATE = OFF_HYIN + (size_t)3072 * LP * 2;
constexpr size_t SZ_GATE = (size_t)LP * 1024 * 2;
constexpr size_t OFF_QKV = OFF_GATE + 3 * SZ_GATE;
constexpr size_t OFF_MERGE = OFF_QKV + (size_t)LP * 3072 * 2;
constexpr size_t OFF_ZT = OFF_MERGE + (size_t)LP * 6144 * 2;
constexpr size_t SZ_ZT = (size_t)2048 * PROWS * 2;
constexpr size_t OFF_M = OFF_ZT;
static_assert(SZ_XN <= SZ_ZT, "alias overflow");
constexpr size_t OFF_FA = OFF_ZT + SZ_ZT;
constexpr size_t OFF_FB = OFF_FA + (size_t)512 * 384 * 2;
constexpr size_t OFF_H3 = OFF_FB + (size_t)FN1 * 256 * 256 * 2;
constexpr size_t WS_END = OFF_H3 + (size_t)2 * L_TOK * 64 * 4;
constexpr size_t HS_HEO = 0, HS_Z2 = 131328, HS_G2 = HS_Z2 + 65792, HSW_STRIDE = HS_G2 + 65792;
constexpr size_t FILT_BYTES = (size_t)L_TOK * 2, HSD_STRIDE = 393728;
constexpr size_t OFF_BAR = WS_END + 256 * HSW_STRIDE;
constexpr size_t WS_END2 = OFF_BAR + 16384;
static_assert(HSD_STRIDE >= 12 * FILT_BYTES && HSD_STRIDE * 256 <= (size_t)NMAIN * DM * 4, "scratch overflow");

struct Params {
    const float* x; const float* meta; const float* norm_g; const float* w_in; const float* conv_w; const float* conv_b;
    const float* f_w1; const float* f_b1; const float* f_w2; const float* f_b2; const float* f_w3; const float* f_b3; const float* f_w4;
    const float* f_freq; const float* decay; const float* skip; const float* rpb; const float* meta_bias;
    const float* w_a; const float* w_b; const float* w_c; const float* w_out; const float* final_g;
    float* out; unsigned char* ws;
};

__device__ __forceinline__ int opaque_tid() { int t = threadIdx.x; asm volatile("" : "+v"(t)); return t; }
__device__ __forceinline__ float bf2f(bf16_t b) { return __uint_as_float(((unsigned)b) << 16); }
__device__ __forceinline__ bf16_t f2bf(float f) { unsigned u = __float_as_uint(f); u += 0x7FFFu + ((u >> 16) & 1u); return (bf16_t)(u >> 16); }
__device__ __forceinline__ unsigned cvt_pk_bf16(float lo, float hi) { unsigned r; asm volatile("v_cvt_pk_bf16_f32 %0, %1, %2" : "=v"(r) : "v"(lo), "v"(hi)); return r; }
__device__ __forceinline__ float lo_bf(unsigned u) { return __uint_as_float(u << 16); }
__device__ __forceinline__ float hi_bf(unsigned u) { return __uint_as_float(u & 0xffff0000u); }
__device__ __forceinline__ float silu_f(float v) { return v * __builtin_amdgcn_rcpf(1.0f + __expf(-v)); }
__device__ __forceinline__ float sigm_f(float v) { return __builtin_amdgcn_rcpf(1.0f + __expf(-v)); }
__device__ __forceinline__ float wave_sum(float v) {
#pragma unroll
    for (int o = 32; o >= 1; o >>= 1) v += __shfl_xor(v, o);
    return v;
}

namespace pg8 {
constexpr int BM = 256, BK = 64, HALF = 128, HTB = HALF * BK * 2, STAGE_BYTES = 8 * HTB;
__device__ __forceinline__ int lds_byte(int r, int c) { const int st = (r >> 4) * 2 + (c >> 5), rr = r & 15, cc = c & 31, ob = rr * 64 + cc * 2; return st * 1024 + (ob ^ (((ob >> 9) & 1) << 5)); }
__device__ __forceinline__ void stage_rc(int b, int& R, int& C) { const int st = b / 1024, sb = b % 1024, swz = sb ^ (((sb >> 9) & 1) << 5); R = (st >> 1) * 16 + swz / 64; C = (st & 1) * 32 + (swz % 64) / 2; }
__device__ __forceinline__ int perm32(int rho) { const int n = rho >> 4, i = rho & 15; return 8 * (i >> 2) + 4 * n + (i & 3); }

struct Unit { int pm, pn, aux; size_t offA, offB; };
struct Gemm { const char* base; int lda, ldb, nt, ksplit; long jumpA, jumpB; };

__device__ __forceinline__ void tile_map(int wgid, int nM, int nN, int& pm, int& pn) {
    const int nwg = nM * nN;
    { const int q = nwg / 8, r = nwg % 8, xcd = wgid % 8, off = wgid / 8; wgid = (xcd < r ? xcd * (q + 1) : r * (q + 1) + (xcd - r) * q) + off; }
    const int nig = 8 * nN, gid = wgid / nig, fm = gid * 8, gsz = (nM - fm) < 8 ? (nM - fm) : 8;
    pm = fm + ((wgid % nig) % gsz); pn = (wgid % nig) / gsz;
}

template <class Epi, class Sched>
__device__ __forceinline__ void gemm_phase(LAS unsigned char* lds, const Gemm g, const Sched& S, const Epi& E) {
    const int tid = opaque_tid(), wid = __builtin_amdgcn_readfirstlane(tid >> 6), lane = tid & 63, wr = wid >> 2, wc = wid & 3, fr = lane & 15, fq = lane >> 4;
    const int nt = g.nt;
    unsigned voffA[2], voffB[2];
#pragma unroll
    for (int i = 0; i < 2; ++i) { int R, C; stage_rc(tid * 16 + i * 8192, R, C); const int Rb = (R & ~31) + perm32(R & 31);
        voffA[i] = (unsigned)(R * g.lda + C) * 2u; voffB[i] = (unsigned)(Rb * g.ldb + C) * 2u; }
    const size_t kstep = (size_t)(BK * 2);
    const size_t hstepA = (size_t)HALF * g.lda * 2, hstepB = (size_t)HALF * g.ldb * 2;
    const unsigned ldsw = (unsigned)wid * 1024u;
    const int aoff = lds_byte(wr * 64 + fr, fq * 8), boff = lds_byte(wc * 32 + fr, fq * 8);
#define PG8_KA(p, t) ((p) + (size_t)(t) * kstep + ((t) >= g.ksplit ? g.jumpA : 0l))
#define PG8_KB(p, t) ((p) + (size_t)(t) * kstep + ((t) >= g.ksplit ? g.jumpB : 0l))
#define PG8_SA(b, h) (((b) * 2 + (h)) * HTB)
#define PG8_SB(b, h) ((4 + (b) * 2 + (h)) * HTB)
#define PG8_STAGE(bufoff, gbase, voff) do { _Pragma("unroll") for (int _i = 0; _i < 2; ++_i) \
        __builtin_amdgcn_global_load_lds((const unsigned*)((const char*)(gbase) + (voff)[_i]), (LAS unsigned*)(lds + (bufoff) + ldsw + _i * 8192), 16, 0, 0); } while (0)
#define PG8_LDA(dst, b, h) do { _Pragma("unroll") for (int m = 0; m < 4; ++m) _Pragma("unroll") for (int k = 0; k < 2; ++k) dst[m][k] = *(const LAS bf16x8*)(lds + PG8_SA(b, h) + aoff + m * 2048 + k * 1024); } while (0)
#define PG8_LDB(dst, b, h) do { _Pragma("unroll") for (int n = 0; n < 2; ++n) _Pragma("unroll") for (int k = 0; k < 2; ++k) dst[n][k] = *(const LAS bf16x8*)(lds + PG8_SB(b, h) + boff + n * 2048 + k * 1024); } while (0)
#define PG8_MMA(ai, bj, At, Bt) do { __builtin_amdgcn_s_setprio(1); _Pragma("unroll") for (int m = 0; m < 4; ++m) _Pragma("unroll") for (int n = 0; n < 2; ++n) _Pragma("unroll") for (int k = 0; k < 2; ++k) \
        acc[ai][bj][m][n] = __builtin_amdgcn_mfma_f32_16x16x32_bf16(Bt[n][k], At[m][k], acc[ai][bj][m][n], 0, 0, 0); __builtin_amdgcn_s_setprio(0); } while (0)
#define PG8_WAIT_V(n) asm volatile("s_waitcnt vmcnt(" #n ")" ::: "memory")
#define PG8_WAIT_L(n) asm volatile("s_waitcnt lgkmcnt(" #n ")" ::: "memory")
#define PG8_BAR __builtin_amdgcn_s_barrier()
#define PG8_SCHED __builtin_amdgcn_sched_barrier(0)
    Unit cur, nxt; int ui = 0;
    if (!S.next(0, cur)) return;
    f32x4 acc[2][2][4][2];
#pragma unroll
    for (int a = 0; a < 2; ++a)
#pragma unroll
        for (int b = 0; b < 2; ++b)
#pragma unroll
            for (int m = 0; m < 4; ++m)
#pragma unroll
                for (int n = 0; n < 2; ++n) acc[a][b][m][n] = (f32x4){0.f, 0.f, 0.f, 0.f};
    bf16x8 At[4][2], B0[2][2], B1[2][2];
    const char* cA = g.base + cur.offA; const char* cB = g.base + cur.offB;
    PG8_STAGE(PG8_SB(0, 0), cB, voffB); PG8_STAGE(PG8_SA(0, 0), cA, voffA); PG8_STAGE(PG8_SB(0, 1), cB + hstepB, voffB); PG8_STAGE(PG8_SA(0, 1), cA + hstepA, voffA);
    if (wr == 1) PG8_BAR;
    PG8_WAIT_V(4); PG8_BAR;
    PG8_STAGE(PG8_SB(1, 0), PG8_KB(cB, 1), voffB); PG8_STAGE(PG8_SA(1, 0), PG8_KA(cA, 1), voffA); PG8_STAGE(PG8_SB(1, 1), PG8_KB(cB, 1) + hstepB, voffB);
    PG8_WAIT_V(6); PG8_BAR;
    for (;;) {
        const bool has_next = S.next(ui + 1, nxt);
        const char* nA = has_next ? g.base + nxt.offA : cA; const char* nB = has_next ? g.base + nxt.offB : cB;
        for (int t = 0; t < nt; t += 2) {
            const bool last = (t == nt - 2);
            const char* a1 = PG8_KA(cA, t + 1);
            const char* a2 = last ? nA : PG8_KA(cA, t + 2); const char* b2 = last ? nB : PG8_KB(cB, t + 2);
            const char* a3 = last ? PG8_KA(nA, 1) : PG8_KA(cA, t + 3); const char* b3 = last ? PG8_KB(nB, 1) : PG8_KB(cB, t + 3);
            PG8_LDB(B0, 0, 0); PG8_SCHED; PG8_LDA(At, 0, 0); PG8_STAGE(PG8_SA(1, 1), a1 + hstepA, voffA);
            PG8_WAIT_L(8); PG8_BAR; PG8_WAIT_L(0); PG8_MMA(0, 0, At, B0); PG8_BAR; PG8_SCHED;
            PG8_LDB(B1, 0, 1); PG8_STAGE(PG8_SB(0, 0), b2, voffB);
            PG8_BAR; PG8_WAIT_L(0); PG8_MMA(0, 1, At, B1); PG8_BAR;
            PG8_LDA(At, 0, 1); PG8_STAGE(PG8_SA(0, 0), a2, voffA);
            PG8_BAR; PG8_WAIT_L(0); PG8_MMA(1, 0, At, B0); PG8_BAR; PG8_SCHED;
            PG8_STAGE(PG8_SB(0, 1), b2 + hstepB, voffB);
            PG8_WAIT_V(6); PG8_BAR; PG8_MMA(1, 1, At, B1); PG8_BAR;
            PG8_LDB(B0, 1, 0); PG8_SCHED; PG8_LDA(At, 1, 0); PG8_STAGE(PG8_SA(0, 1), a2 + hstepA, voffA);
            PG8_WAIT_L(8); PG8_BAR; PG8_WAIT_L(0); PG8_MMA(0, 0, At, B0); PG8_BAR; PG8_SCHED;
            PG8_LDB(B1, 1, 1); PG8_STAGE(PG8_SB(1, 0), b3, voffB);
            PG8_BAR; PG8_WAIT_L(0); PG8_MMA(0, 1, At, B1); PG8_BAR;
            PG8_LDA(At, 1, 1); PG8_STAGE(PG8_SA(1, 0), a3, voffA);
            PG8_BAR; PG8_WAIT_L(0); PG8_MMA(1, 0, At, B0); PG8_BAR; PG8_SCHED;
            PG8_STAGE(PG8_SB(1, 1), b3 + hstepB, voffB);
            PG8_WAIT_V(6); PG8_BAR; PG8_MMA(1, 1, At, B1); PG8_BAR;
        }
        E(acc, cur, wr, wc, fr, fq);
        if (!has_next) break;
        { const float zf = E.keep(cur) ? 1.0f : 0.0f;
#pragma unroll
        for (int a = 0; a < 2; ++a)
#pragma unroll
            for (int b = 0; b < 2; ++b)
#pragma unroll
                for (int m = 0; m < 4; ++m)
#pragma unroll
                    for (int n = 0; n < 2; ++n) acc[a][b][m][n] *= zf; }
        cur = nxt; cA = nA; cB = nB; ++ui;
    }
    PG8_WAIT_V(0);
    if (wr == 0) PG8_BAR;
    PG8_BAR;
#undef PG8_KA
#undef PG8_KB
#undef PG8_SA
#undef PG8_SB
#undef PG8_STAGE
#undef PG8_LDA
#undef PG8_LDB
#undef PG8_MMA
#undef PG8_WAIT_V
#undef PG8_WAIT_L
#undef PG8_BAR
#undef PG8_SCHED
}
}
using pg8::Unit; using pg8::Gemm;
#define ACC_T f32x4 (&acc)[2][2][4][2]

enum { K_TOK = 0, K_HYIN = 1, K_F0 = 2, K_FNA = 3, K_FNB = 4, K_BR = 5, K_OUT = 6, K_IN = 7 };
struct SchedAny {
    int kind, G, c;
    __device__ __forceinline__ bool next(int i, Unit& u) const {
        const long Lx = (long)i * G + c;
        switch (kind) {
        case K_IN: {
            if (Lx < 3120) { int pn; pg8::tile_map((int)Lx, 65, 48, u.pm, pn); u.pn = pn < 4 ? 12 + pn : 16 + pn; u.aux = K_TOK;
                u.offA = OFF_XN + (size_t)u.pm * 256 * DM * 2; u.offB = OFF_WT + (size_t)u.pn * 256 * DM * 2; return true; }
            if (Lx < 3900) { pg8::tile_map((int)Lx - 3120, 12, 65, u.pm, u.pn); u.aux = K_HYIN;
                u.offA = OFF_WT + (size_t)u.pm * 256 * DM * 2; u.offB = OFF_XN + (size_t)u.pn * 256 * DM * 2; return true; }
            if (Lx < 4200) { pg8::tile_map((int)Lx - 3900, 4, 75, u.pm, u.pn); u.aux = K_F0;
                u.offA = OFF_WEFF + (size_t)u.pm * 256 * DM * 2; u.offB = OFF_XNP + (size_t)u.pn * 256 * DM * 2; return true; }
            return false; }
        case K_TOK: {
            if (Lx >= 65l * 48) return false; int pn; pg8::tile_map((int)Lx, 65, 48, u.pm, pn); u.pn = pn < 4 ? 12 + pn : 16 + pn; u.aux = 0;
            u.offA = OFF_XN + (size_t)u.pm * 256 * DM * 2; u.offB = OFF_WT + (size_t)u.pn * 256 * DM * 2; return true; }
        case K_HYIN: {
            if (Lx >= 12l * 65) return false; pg8::tile_map((int)Lx, 12, 65, u.pm, u.pn); u.aux = 0;
            u.offA = OFF_WT + (size_t)u.pm * 256 * DM * 2; u.offB = OFF_XN + (size_t)u.pn * 256 * DM * 2; return true; }
        case K_F0: {
            if (Lx >= 8l * 75) return false; pg8::tile_map((int)Lx, 8, 75, u.pm, u.pn); u.aux = 0;
            u.offA = OFF_WEFF + (size_t)u.pm * 256 * DM * 2; u.offB = OFF_XNP + (size_t)u.pn * 256 * DM * 2; return true; }
        case K_FNA: {
            if (Lx >= 2l * 400) return false; pg8::tile_map((int)Lx, 2, 400, u.pm, u.pn); u.aux = 0;
            u.offA = OFF_FA + (size_t)u.pm * 256 * 384 * 2; u.offB = OFF_ZT + (size_t)u.pn * 256 * FN1P * 2; return true; }
        case K_FNB: {
            if (Lx >= 164l * 4) return false; u.aux = (int)(Lx >> 2); u.pm = 0; u.pn = (int)(Lx & 3);
            u.offA = OFF_FB + (size_t)u.aux * 256 * 256 * 2; u.offB = OFF_A1 + (size_t)u.aux * 1024 * 256 * 2 + (size_t)u.pn * 256 * 256 * 2; return true; }
        case K_BR: {
            const int T = (i / 3) * G + c; if (T >= 64 * 8) return false; const int br = i % 3; pg8::tile_map(T, 64, 8, u.pm, u.pn); u.aux = br;
            u.offA = OFF_GATE + (size_t)br * SZ_GATE + (size_t)u.pm * 256 * 1024 * 2; u.offB = OFF_WA + (size_t)br * SZ_WBR + (size_t)u.pn * 256 * 1024 * 2; return true; }
        default: {
            if (Lx >= 64l * 8) return false; pg8::tile_map((int)Lx, 64, 8, u.pm, u.pn); u.aux = 0;
            u.offA = OFF_M + (size_t)u.pm * 256 * DM * 2; u.offB = OFF_WO + (size_t)u.pn * 256 * DM * 2; return true; }
        }
    }
};
#define ROWFENCE asm volatile("" ::: "memory")
#define HARDFENCE do { asm volatile("" ::: "memory"); __builtin_amdgcn_sched_barrier(0); } while (0)
struct EpiAny {
    int kind; unsigned char* ws; int layer; const float* xin; const float* metain;
    __device__ __forceinline__ bool keep(const Unit&) const { return false; }
    __device__ __forceinline__ void operator()(ACC_T, const Unit& u, int wr, int wc, int fr, int fq) const {
        const int rl0 = wr * 64 + fr, cl0 = wc * 32 + 8 * fq;
        const int ek = kind == K_IN ? u.aux : kind;
        if (ek == K_TOK) {
            const int t = u.pn; unsigned char* dst; unsigned ld; int c0, act;
            if (t < 16)      { dst = ws + OFF_GATE;               ld = 1024; c0 = (t - 12) * 256; act = 1; }
            else if (t < 24) { dst = ws + OFF_GATE + SZ_GATE;     ld = 1024; c0 = (t - 20) * 256; act = 1; }
            else if (t < 36) { dst = ws + OFF_QKV;                ld = 3072; c0 = (t - 24) * 256; act = 0; }
            else if (t < 40) { dst = ws + OFF_GATE + 2 * SZ_GATE; ld = 1024; c0 = (t - 36) * 256; act = 1; }
            else             { dst = ws + OFF_MERGE;              ld = 6144; c0 = (t - 40) * 256; act = 2; }
#pragma unroll
            for (int ai = 0; ai < 2; ++ai)
#pragma unroll
                for (int m = 0; m < 4; ++m) { const unsigned row = (unsigned)(u.pm * 256 + ai * 128 + m * 16 + rl0);
#pragma unroll
                    for (int bj = 0; bj < 2; ++bj) { const unsigned off = (row * ld + (unsigned)(c0 + bj * 128 + cl0)) * 2u; f32x4 v0 = acc[ai][bj][m][0], v1 = acc[ai][bj][m][1];
                        if (act == 1) {
#pragma unroll
                            for (int j = 0; j < 4; ++j) { v0[j] = silu_f(v0[j]); v1[j] = silu_f(v1[j]); } }
                        else if (act == 2) {
#pragma unroll
                            for (int j = 0; j < 4; ++j) { v0[j] = sigm_f(v0[j]); v1[j] = sigm_f(v1[j]); } }
                        u32x4 w; w.x = cvt_pk_bf16(v0[0], v0[1]); w.y = cvt_pk_bf16(v0[2], v0[3]); w.z = cvt_pk_bf16(v1[0], v1[1]); w.w = cvt_pk_bf16(v1[2], v1[3]);
                        *(u32x4*)(dst + off) = w; }
                    ROWFENCE; }
        } else if (ek == K_HYIN) {
            unsigned char* dst = ws + OFF_HYIN; const unsigned ld = LP;
#pragma unroll
            for (int ai = 0; ai < 2; ++ai)
#pragma unroll
                for (int m = 0; m < 4; ++m) { const unsigned row = (unsigned)(u.pm * 256 + ai * 128 + m * 16 + rl0);
#pragma unroll
                    for (int bj = 0; bj < 2; ++bj) { const unsigned off = (row * ld + (unsigned)(u.pn * 256 + bj * 128 + cl0)) * 2u; const f32x4 v0 = acc[ai][bj][m][0], v1 = acc[ai][bj][m][1];
                        u32x4 w; w.x = cvt_pk_bf16(v0[0], v0[1]); w.y = cvt_pk_bf16(v0[2], v0[3]); w.z = cvt_pk_bf16(v1[0], v1[1]); w.w = cvt_pk_bf16(v1[2], v1[3]);
                        *(u32x4*)(dst + off) = w; }
                    ROWFENCE; }
        } else if (ek == K_F0) {
            int rlx = rl0, clx = cl0; asm volatile("" : "+v"(rlx), "+v"(clx));
            unsigned char* dst = ws + OFF_ZT; const int g = u.pm; const unsigned colb0 = (unsigned)(u.pn * 256 + clx) * 2u;
#pragma unroll
            for (int ai = 0; ai < 2; ++ai)
#pragma unroll
                for (int m = 0; m < 4; ++m) { const int j = ai * 128 + m * 16 + rlx; const int part = j <= 128 ? 0 : 1; const int cp = j - 128 * part;
                    const unsigned o1 = (unsigned)(part * 1024 + g * 256 + cp) * (unsigned)(PROWS * 2) + colb0;
                    const bool mir = cp >= 1 && cp <= 127; const bool zim = part == 0 && !mir;
                    const unsigned o2 = (unsigned)((mir ? part : 1) * 1024 + g * 256 + (mir ? 256 - cp : cp)) * (unsigned)(PROWS * 2) + colb0;
                    const unsigned sgn = part == 1 ? 0x80008000u : 0u, msk = zim ? 0u : 0xffffffffu;
#pragma unroll
                    for (int bj = 0; bj < 2; ++bj) { const f32x4 v0 = acc[ai][bj][m][0], v1 = acc[ai][bj][m][1];
                        u32x4 w; w.x = cvt_pk_bf16(v0[0], v0[1]); w.y = cvt_pk_bf16(v0[2], v0[3]); w.z = cvt_pk_bf16(v1[0], v1[1]); w.w = cvt_pk_bf16(v1[2], v1[3]);
                        *(u32x4*)(dst + o1 + bj * 256) = w;
                        u32x4 wm; wm.x = (w.x ^ sgn) & msk; wm.y = (w.y ^ sgn) & msk; wm.z = (w.z ^ sgn) & msk; wm.w = (w.w ^ sgn) & msk;
                        *(u32x4*)(dst + o2 + bj * 256) = wm; }
                    ROWFENCE; }
        } else if (ek == K_FNA) {
            unsigned char* dst = ws + OFF_A1;
#pragma unroll
            for (int ai = 0; ai < 2; ++ai)
#pragma unroll
                for (int m = 0; m < 4; ++m) { const int k1 = ai * 128 + m * 16 + rl0;
                    if (k1 < FN1) {
#pragma unroll
                        for (int bj = 0; bj < 2; ++bj)
#pragma unroll
                            for (int n = 0; n < 2; ++n) { const int col = u.pn * 256 + bj * 128 + cl0 + 4 * n; const int ch = col / FN2, l2 = col - ch * FN2; const f32x4 v = acc[ai][bj][m][n];
                                u32x2 w; w.x = cvt_pk_bf16(v[0], v[1]); w.y = cvt_pk_bf16(v[2], v[3]);
                                *(u32x2*)(dst + ((unsigned)((k1 * 1024 + ch) * 2 + u.pm) * 128u + (unsigned)l2) * 2u) = w; } }
                    ROWFENCE; }
        } else if (ek == K_FNB) {
            unsigned char* dst = ws + OFF_GATE + SZ_GATE; const float scale = 1.0f / sqrtf((float)L_TOK * 256.0f);
#pragma unroll
            for (int ai = 0; ai < 2; ++ai)
#pragma unroll
                for (int m = 0; m < 4; ++m) { const int k2 = ai * 128 + m * 16 + rl0;
                    if (k2 < FN2) { const unsigned row = (unsigned)(u.aux + FN1 * k2);
#pragma unroll
                        for (int bj = 0; bj < 2; ++bj) { const unsigned off = (row * 1024u + (unsigned)(u.pn * 256 + bj * 128 + cl0)) * 2u; const u32x4 g = *(const u32x4*)(dst + off);
                            const f32x4 v0 = acc[ai][bj][m][0] * scale, v1 = acc[ai][bj][m][1] * scale;
                            u32x4 w; w.x = cvt_pk_bf16(v0[0] * lo_bf(g.x), v0[1] * hi_bf(g.x)); w.y = cvt_pk_bf16(v0[2] * lo_bf(g.y), v0[3] * hi_bf(g.y));
                            w.z = cvt_pk_bf16(v1[0] * lo_bf(g.z), v1[1] * hi_bf(g.z)); w.w = cvt_pk_bf16(v1[2] * lo_bf(g.w), v1[3] * hi_bf(g.w));
                            *(u32x4*)(dst + off) = w; } }
                    ROWFENCE; }
        } else {
            unsigned char* dst = ws + OFF_H;
#pragma unroll
            for (int ai = 0; ai < 2; ++ai) { f32x4 oq[4][2][2];
#pragma unroll
                for (int m = 0; m < 4; ++m) { const unsigned row = (unsigned)(u.pm * 256 + ai * 128 + m * 16 + rl0);
                    const float* srow = layer == 0 ? (row < (unsigned)NMETA ? metain + (size_t)row * DM : xin + (size_t)(row - NMETA) * DM) : (const float*)(dst + (size_t)row * DM * 4);
#pragma unroll
                    for (int bj = 0; bj < 2; ++bj) { const unsigned col = (unsigned)(u.pn * 256 + bj * 128 + cl0); oq[m][bj][0] = *(const f32x4*)(srow + col); oq[m][bj][1] = *(const f32x4*)(srow + col + 4); } }
#pragma unroll
                for (int m = 0; m < 4; ++m) { const unsigned row = (unsigned)(u.pm * 256 + ai * 128 + m * 16 + rl0);
#pragma unroll
                    for (int bj = 0; bj < 2; ++bj) { const unsigned off = (row * (unsigned)DM + (unsigned)(u.pn * 256 + bj * 128 + cl0)) * 4u;
                        *(f32x4*)(dst + off) = oq[m][bj][0] + acc[ai][bj][m][0]; *(f32x4*)(dst + off + 16) = oq[m][bj][1] + acc[ai][bj][m][1]; } }
                ROWFENCE; }
        }
    }
};

struct EpiBr {
    unsigned char* ws;
    __device__ __forceinline__ bool keep(const Unit& u) const { return u.aux < 2; }
    __device__ __forceinline__ void operator()(ACC_T, const Unit& u, int wr, int wc, int fr, int fq) const {
        const int rl0 = wr * 64 + fr, cl0 = wc * 32 + 8 * fq;
            unsigned char* dst = ws + OFF_M; const unsigned char* mg = ws + OFF_MERGE; const int br = u.aux;
#pragma unroll
            for (int ai = 0; ai < 2; ++ai)
#pragma unroll
              for (int mh = 0; mh < 4; mh += 2) { u32x4 gn[2][2], gd[2][2];
#pragma unroll
                for (int mm = 0; mm < 2; ++mm) { const unsigned row = (unsigned)(u.pm * 256 + ai * 128 + (mh + mm) * 16 + rl0);
#pragma unroll
                    for (int bj = 0; bj < 2; ++bj) { const unsigned col = (unsigned)(u.pn * 256 + bj * 128 + cl0);
                        gn[mm][bj] = *(const u32x4*)(mg + (row * 6144u + (unsigned)br * 2048u + col) * 2u);
                        if (br < 2) gd[mm][bj] = *(const u32x4*)(mg + (row * 6144u + (unsigned)(br + 1) * 2048u + col) * 2u); else gd[mm][bj] = (u32x4){0x3f803f80u, 0x3f803f80u, 0x3f803f80u, 0x3f803f80u}; } }
#pragma unroll
                for (int mm = 0; mm < 2; ++mm) { const int m = mh + mm; const unsigned row = (unsigned)(u.pm * 256 + ai * 128 + m * 16 + rl0);
#pragma unroll
                    for (int bj = 0; bj < 2; ++bj) { const u32x4 g = gn[mm][bj], d = gd[mm][bj];
                        const float s0 = lo_bf(g.x) * __builtin_amdgcn_rcpf(fmaxf(lo_bf(d.x), 1e-30f)), s1 = hi_bf(g.x) * __builtin_amdgcn_rcpf(fmaxf(hi_bf(d.x), 1e-30f));
                        const float s2 = lo_bf(g.y) * __builtin_amdgcn_rcpf(fmaxf(lo_bf(d.y), 1e-30f)), s3 = hi_bf(g.y) * __builtin_amdgcn_rcpf(fmaxf(hi_bf(d.y), 1e-30f));
                        const float s4 = lo_bf(g.z) * __builtin_amdgcn_rcpf(fmaxf(lo_bf(d.z), 1e-30f)), s5 = hi_bf(g.z) * __builtin_amdgcn_rcpf(fmaxf(hi_bf(d.z), 1e-30f));
                        const float s6 = lo_bf(g.w) * __builtin_amdgcn_rcpf(fmaxf(lo_bf(d.w), 1e-30f)), s7 = hi_bf(g.w) * __builtin_amdgcn_rcpf(fmaxf(hi_bf(d.w), 1e-30f));
                        f32x4 v0 = acc[ai][bj][m][0], v1 = acc[ai][bj][m][1];
                        v0[0] *= s0; v0[1] *= s1; v0[2] *= s2; v0[3] *= s3; v1[0] *= s4; v1[1] *= s5; v1[2] *= s6; v1[3] *= s7;
                        acc[ai][bj][m][0] = v0; acc[ai][bj][m][1] = v1;
                        if (br == 2) { const unsigned col = (unsigned)(u.pn * 256 + bj * 128 + cl0);
                            u32x4 w; w.x = cvt_pk_bf16(v0[0], v0[1]); w.y = cvt_pk_bf16(v0[2], v0[3]); w.z = cvt_pk_bf16(v1[0], v1[1]); w.w = cvt_pk_bf16(v1[2], v1[3]);
                            *(u32x4*)(dst + (row * (unsigned)DM + col) * 2u) = w; } } }
                ROWFENCE; }
    }
};

__device__ void phase_prep0(const Params& p, unsigned char* smem) {
    const int tid = opaque_tid(), bid = blockIdx.x, G = gridDim.x;
    const size_t gtid = (size_t)bid * NTHREADS + tid, gstride = (size_t)G * NTHREADS;
    { bf16_t* fa = (bf16_t*)(p.ws + OFF_FA);
      for (size_t i = gtid; i < (size_t)512 * 384; i += gstride) { const int row = (int)(i / 384), col = (int)(i % 384); const int po = row >> 8, k1 = row & 255, pi = col / 192, l1 = col % 192; float v = 0.f;
          if (k1 < FN1 && l1 < FN1) { const int r = (k1 * l1) % FN1; const float a = 2.0f * (float)r / (float)FN1; const float cs = cospif(a), sn = sinpif(a);
              v = (po == 0) ? (pi == 0 ? cs : sn) : (pi == 0 ? -sn : cs); }
          fa[i] = f2bf(v); } }
    { bf16_t* fb = (bf16_t*)(p.ws + OFF_FB);
      for (size_t i = gtid; i < (size_t)FN1 * 65536; i += gstride) { const int k1 = (int)(i >> 16), k2 = (int)((i >> 8) & 255), kk = (int)(i & 255), part = kk >> 7, l2 = kk & 127; float v = 0.f;
          if (k2 < FN2 && l2 < FN2) { const int lp = k1 + FN1 * k2; const int r = (l2 * lp) % L_TOK; const float a = 2.0f * (float)r / (float)L_TOK; v = part == 0 ? cospif(a) : sinpif(a); }
          fb[i] = f2bf(v); } }
    { float* w1s = (float*)smem;
      float* w2s = w1s + 33 * 64;
      float* w3s = w2s + 64 * 64;
      const int lane = tid & 63, wv = tid >> 6;
      for (int layer = 0; layer < 2; ++layer) {
          __syncthreads();
          for (int i = tid; i < 33 * 64; i += NTHREADS) w1s[i] = p.f_w1[layer * 33 * 64 + i];
          for (int i = tid; i < 64 * 64; i += NTHREADS) { w2s[i] = p.f_w2[layer * 4096 + i]; w3s[i] = p.f_w3[layer * 4096 + i]; }
          __syncthreads();
          const float b1 = p.f_b1[layer * 64 + lane], b2 = p.f_b2[layer * 64 + lane], b3 = p.f_b3[layer * 64 + lane], fr = p.f_freq[layer * 64 + lane];
          bf16_t* h3 = (bf16_t*)(p.ws + OFF_H3) + (size_t)layer * L_TOK * 64;
          for (int lag = bid * 8 + wv; lag < L_TOK; lag += G * 8) {
              const float tt = (float)lag / (float)(L_TOK - 1); const float w = 6.283185307179586f * (float)lag / (float)L_TOK;
              float z = 0.f;
              if (lane == 0) z = tt;
              else if (lane < 33) { const int j = (lane - 1) & 15; const float f = 1e-4f + (float)j * ((15.0f - 1e-4f) / 15.0f); const float a = f * w; z = lane < 17 ? cosf(a) : -sinf(a); }
              float a1 = b1;
#pragma unroll 3
              for (int i = 0; i < 33; ++i) a1 += __shfl(z, i) * w1s[i * 64 + lane];
              const float h1 = sinf(fr * a1);
              float a2 = b2;
#pragma unroll 8
              for (int i = 0; i < 64; ++i) a2 += __shfl(h1, i) * w2s[i * 64 + lane];
              const float h2 = sinf(fr * a2);
              float a3 = b3;
#pragma unroll 8
              for (int i = 0; i < 64; ++i) a3 += __shfl(h2, i) * w3s[i * 64 + lane];
              h3[(size_t)lag * 64 + lane] = f2bf(sinf(fr * a3));
          }
      }
      __syncthreads(); }
}

__device__ void convert_matrix(const float* __restrict__ src, int K, int N, bf16_t* __restrict__ dst, int kshift  , int total, float* tile  ) {
    const int tid = opaque_tid(), G = gridDim.x; const int kl0 = tid >> 4, n4 = (tid & 15) * 4, nl = tid >> 3, k8 = (tid & 7) * 8;
    f32x4 pv0 = (f32x4){0.f, 0.f, 0.f, 0.f}, pv1 = pv0;
    int t = blockIdx.x;
    if (t < total) { const int kt = t & ((1 << kshift) - 1), nt_ = t >> kshift; const float* s = src + (size_t)(kt * 64 + kl0) * N + nt_ * 64 + n4; pv0 = *(const f32x4*)s; pv1 = *(const f32x4*)(s + (size_t)32 * N); }
    int buf = 0;
    for (; t < total; t += G) { float* tl = tile + buf * (64 * 65); const int kt = t & ((1 << kshift) - 1), nt_ = t >> kshift;
        tl[kl0 * 65 + n4] = pv0[0]; tl[kl0 * 65 + n4 + 1] = pv0[1]; tl[kl0 * 65 + n4 + 2] = pv0[2]; tl[kl0 * 65 + n4 + 3] = pv0[3];
        tl[(32 + kl0) * 65 + n4] = pv1[0]; tl[(32 + kl0) * 65 + n4 + 1] = pv1[1]; tl[(32 + kl0) * 65 + n4 + 2] = pv1[2]; tl[(32 + kl0) * 65 + n4 + 3] = pv1[3];
        { const int tn = t + G; if (tn < total) { const int kt2 = tn & ((1 << kshift) - 1), nt2 = tn >> kshift; const float* s = src + (size_t)(kt2 * 64 + kl0) * N + nt2 * 64 + n4; pv0 = *(const f32x4*)s; pv1 = *(const f32x4*)(s + (size_t)32 * N); } }
        __syncthreads();
        u32x4 w; w.x = cvt_pk_bf16(tl[(k8 + 0) * 65 + nl], tl[(k8 + 1) * 65 + nl]); w.y = cvt_pk_bf16(tl[(k8 + 2) * 65 + nl], tl[(k8 + 3) * 65 + nl]);
        w.z = cvt_pk_bf16(tl[(k8 + 4) * 65 + nl], tl[(k8 + 5) * 65 + nl]); w.w = cvt_pk_bf16(tl[(k8 + 6) * 65 + nl], tl[(k8 + 7) * 65 + nl]);
        *(u32x4*)(dst + (size_t)(nt_ * 64 + nl) * K + kt * 64 + k8) = w;
        buf ^= 1; }
    __syncthreads();
}

__device__ void phase_p1(const Params& p, int layer, unsigned char* smem) {
    const int tid = opaque_tid(), bid = blockIdx.x, G = gridDim.x;
    float* tile = (float*)smem;
    { const float* win = p.w_in + (size_t)layer * DM * NIN;
      convert_matrix(win, DM, NIN, (bf16_t*)(p.ws + OFF_WT), 5, 32 * 256, tile);
      for (int br = 0; br < 3; ++br) { const float* wsrc = (br == 0 ? p.w_a : br == 1 ? p.w_b : p.w_c) + (size_t)layer * 1024 * DM;
          convert_matrix(wsrc, 1024, DM, (bf16_t*)(p.ws + OFF_WA + br * SZ_WBR), 4, 16 * 32, tile); }
      const float* wo = p.w_out + (size_t)layer * DM * DM;
      convert_matrix(wo, DM, DM, (bf16_t*)(p.ws + OFF_WO), 5, 32 * 32, tile);
      __syncthreads(); }
    { float* tileT = (float*)smem;
      float* ctab = tileT + 256 * 32;
      float* stab = ctab + 256;
      const float* win = p.w_in + (size_t)layer * DM * NIN;
      for (int t = bid; t < 256; t += G) { const int g = t >> 6, k0 = (t & 63) * 32;
          __syncthreads();
          if (tid < 256) { const float a = 2.0f * (float)tid / 256.0f; ctab[tid] = cospif(a); stab[tid] = sinpif(a); }
#pragma unroll
          for (int ps = 0; ps < 4; ++ps) { const int idx = ps * NTHREADS + tid; const int kl = idx >> 6, c4 = (idx & 63) * 4;
              const f32x4 v = *(const f32x4*)(win + (size_t)(k0 + kl) * NIN + 4096 + g * 256 + c4);
              tileT[(c4 + 0) * 32 + kl] = v[0]; tileT[(c4 + 1) * 32 + kl] = v[1]; tileT[(c4 + 2) * 32 + kl] = v[2]; tileT[(c4 + 3) * 32 + kl] = v[3]; }
          __syncthreads();
          const int jrow = tid & 255, kh = tid >> 8; const int part = jrow <= 128 ? 0 : 1; const int cp = part == 0 ? jrow : jrow - 128;
          float acc[16];
#pragma unroll
          for (int k = 0; k < 16; ++k) acc[k] = 0.f;
          for (int c = 0; c < 256; ++c) { const int r = (c * cp) & 255; const float tw = part == 0 ? ctab[r] : -stab[r];
#pragma unroll
              for (int k4 = 0; k4 < 4; ++k4) { const f32x4 v = *(const f32x4*)(tileT + c * 32 + kh * 16 + k4 * 4); acc[k4 * 4 + 0] += v[0] * tw; acc[k4 * 4 + 1] += v[1] * tw; acc[k4 * 4 + 2] += v[2] * tw; acc[k4 * 4 + 3] += v[3] * tw; } }
          bf16_t* dst = (bf16_t*)(p.ws + OFF_WEFF) + (size_t)(g * 256 + jrow) * DM + k0 + kh * 16;
#pragma unroll
          for (int k8 = 0; k8 < 2; ++k8) { u32x4 w; w.x = cvt_pk_bf16(acc[k8 * 8 + 0], acc[k8 * 8 + 1]); w.y = cvt_pk_bf16(acc[k8 * 8 + 2], acc[k8 * 8 + 3]); w.z = cvt_pk_bf16(acc[k8 * 8 + 4], acc[k8 * 8 + 5]); w.w = cvt_pk_bf16(acc[k8 * 8 + 6], acc[k8 * 8 + 7]);
              *(u32x4*)(dst + k8 * 8) = w; } }
      __syncthreads(); }
    { const int lane = tid & 63, wv = tid >> 6; const float* h = (const float*)(p.ws + OFF_H); const float* gam = p.norm_g + layer * DM;
      bf16_t* xn = (bf16_t*)(p.ws + OFF_XN); bf16_t* xnp = (bf16_t*)(p.ws + OFF_XNP);
      for (int l = bid * 8 + wv; l < LP; l += G * 8) {
          if (l < L_TOK) { const f32x4* row = (const f32x4*)(layer == 0 ? (l < NMETA ? p.meta + (size_t)l * DM : p.x + (size_t)(l - NMETA) * DM) : h + (size_t)l * DM); f32x4 v[8]; float ss = 0.f;
#pragma unroll
              for (int i = 0; i < 8; ++i) { v[i] = row[i * 64 + lane]; ss += v[i][0] * v[i][0] + v[i][1] * v[i][1] + v[i][2] * v[i][2] + v[i][3] * v[i][3]; }
              ss = wave_sum(ss); const float inv = rsqrtf(ss * (1.0f / DM) + 1e-6f);
              const int l1 = l / FN2, l2 = l - l1 * FN2; const size_t pr = (size_t)l2 * FN1P + l1;
#pragma unroll
              for (int i = 0; i < 8; ++i) { const f32x4 gg = ((const f32x4*)gam)[i * 64 + lane]; u32x2 w; w.x = cvt_pk_bf16(v[i][0] * inv * gg[0], v[i][1] * inv * gg[1]); w.y = cvt_pk_bf16(v[i][2] * inv * gg[2], v[i][3] * inv * gg[3]);
                  *(u32x2*)(xn + (size_t)l * DM + (i * 64 + lane) * 4) = w; *(u32x2*)(xnp + pr * DM + (i * 64 + lane) * 4) = w; } }
          else { const u32x2 z = (u32x2){0u, 0u};
#pragma unroll
              for (int i = 0; i < 8; ++i) *(u32x2*)(xn + (size_t)l * DM + (i * 64 + lane) * 4) = z; } }
      for (int idx = bid * 8 + wv; idx < FN2 * (FN1P - FN1); idx += G * 8) { const int l2 = idx / (FN1P - FN1), l1 = FN1 + idx % (FN1P - FN1); const size_t pr = (size_t)l2 * FN1P + l1; const u32x2 z = (u32x2){0u, 0u};
#pragma unroll
          for (int i = 0; i < 8; ++i) *(u32x2*)(xnp + pr * DM + (i * 64 + lane) * 4) = z; } }
}

__device__ void na_phase(const Params& p, int layer, unsigned char* smem) {
    const int tid = opaque_tid(), wv = tid >> 6, lane = tid & 63, l15 = lane & 15, quad = lane >> 4;
    const int G = gridDim.x;
    const bf16_t* qkv = (const bf16_t*)(p.ws + OFF_QKV);
    unsigned char* sK = smem;
    bf16_t* sVT = (bf16_t*)(smem + 76032);
    float* sRPB = (float*)(smem + 144640);
    float* sMB = (float*)(smem + 146512);
    const int cb = wv & 3, hf = wv >> 2, c = cb * 16 + l15;
    const int cu = cb == 0 ? 0 : (cb == 1 ? 8 : (cb == 2 ? 24 : 32)), cs = min(max(c - 8, 0), 48);
    u32x4 pk[8], pv[8], pmk = (u32x4){0u, 0u, 0u, 0u}, pmv = (u32x4){0u, 0u, 0u, 0u}; bf16x8 pq0, pq1; float prp = 0.f;
#define NA_LOADS(U) do { const int r_ = (U) >> 4, hd_ = (U) & 15, r0_ = min(max(r_ - 4, 0), 248); \
        _Pragma("unroll") for (int ps = 0; ps < 8; ++ps) { const int tok = ps * 64 + (tid >> 3), ch = tid & 7; const size_t g = (size_t)(NMETA + r0_ * 64 + tok) * 3072 + hd_ * 64 + ch * 8; \
            pk[ps] = *(const u32x4*)(qkv + g + 1024); pv[ps] = *(const u32x4*)(qkv + g + 2048); } \
        if (tid < 128) { const size_t g = (size_t)(tid >> 3) * 3072 + hd_ * 64 + (tid & 7) * 8; pmk = *(const u32x4*)(qkv + g + 1024); pmv = *(const u32x4*)(qkv + g + 2048); } \
        { const bf16_t* qp = qkv + (size_t)(NMETA + r_ * 64 + c) * 3072 + hd_ * 64 + quad * 8; pq0 = *(const bf16x8*)qp; pq1 = *(const bf16x8*)(qp + 32); } \
        if (tid < 465) prp = p.rpb[(size_t)(layer * 16 + hd_) * 465 + tid]; else if (tid >= 480 && tid < 496) prp = p.meta_bias[(layer * 16 + hd_) * 16 + tid - 480]; } while (0)
    int u = blockIdx.x;
    if (u < 4096) NA_LOADS(u);
    for (; u < 4096; u += G) {
        const int r = u >> 4, hd = u & 15, r0 = min(max(r - 4, 0), 248);
        __syncthreads();
#pragma unroll
        for (int ps = 0; ps < 8; ++ps) { const int tok = ps * 64 + (tid >> 3), ch = tid & 7; const u32x4 vv = pv[ps];
            *(u32x4*)(sK + tok * 144 + ch * 16) = pk[ps];
            bf16_t* vt = sVT + (ch * 8) * 536 + tok;
            vt[0] = (bf16_t)vv.x; vt[536] = (bf16_t)(vv.x >> 16); vt[2 * 536] = (bf16_t)vv.y; vt[3 * 536] = (bf16_t)(vv.y >> 16);
            vt[4 * 536] = (bf16_t)vv.z; vt[5 * 536] = (bf16_t)(vv.z >> 16); vt[6 * 536] = (bf16_t)vv.w; vt[7 * 536] = (bf16_t)(vv.w >> 16); }
        if (tid < 128) { const int tok = tid >> 3, ch = tid & 7; const u32x4 vv = pmv;
            *(u32x4*)(sK + (512 + tok) * 144 + ch * 16) = pmk;
            bf16_t* vt = sVT + (ch * 8) * 536 + 512 + tok;
            vt[0] = (bf16_t)vv.x; vt[536] = (bf16_t)(vv.x >> 16); vt[2 * 536] = (bf16_t)vv.y; vt[3 * 536] = (bf16_t)(vv.y >> 16);
            vt[4 * 536] = (bf16_t)vv.z; vt[5 * 536] = (bf16_t)(vv.z >> 16); vt[6 * 536] = (bf16_t)vv.w; vt[7 * 536] = (bf16_t)(vv.w >> 16); }
        if (tid < 465) sRPB[tid] = prp; else if (tid >= 480 && tid < 496) sMB[tid - 480] = prp;
        const bf16x8 bq0 = pq0, bq1 = pq1;
        { const int un = u + G; if (un < 4096) NA_LOADS(un); }
        __syncthreads();
        bf16_t* yc = (bf16_t*)(p.ws + OFF_GATE + 2 * SZ_GATE);
        float gatev[4][4];
        if (hf == 0) {
#pragma unroll
            for (int rr = 0; rr < 4; ++rr)
#pragma unroll
                for (int dt = 0; dt < 4; ++dt) gatev[rr][dt] = bf2f(yc[(size_t)(NMETA + r * 64 + cb * 16 + quad * 4 + rr) * 1024 + hd * 64 + l15 + dt * 16]); }
        float sc[9][4];
#pragma unroll
        for (int ti = 0; ti < 9; ++ti) { const int j = 4 * hf + (ti >> 1), tt = ti & 1; const int slot0 = ti < 8 ? j * 64 + cu + tt * 16 : 512;
            const unsigned char* kp = sK + (slot0 + l15) * 144 + quad * 16;
            const bf16x8 a0 = *(const bf16x8*)kp, a1 = *(const bf16x8*)(kp + 64);
            f32x4 acc = (f32x4){0.f, 0.f, 0.f, 0.f};
            acc = __builtin_amdgcn_mfma_f32_16x16x32_bf16(a0, bq0, acc, 0, 0, 0); acc = __builtin_amdgcn_mfma_f32_16x16x32_bf16(a1, bq1, acc, 0, 0, 0);
            if (ti < 8) { const float* rp = sRPB + (r0 + j - r + 7) * 31 + (15 - c);
#pragma unroll
                for (int rr = 0; rr < 4; ++rr) { const int kc = cu + tt * 16 + quad * 4 + rr; const bool ok = kc >= cs && kc < cs + 16; const int kcc = ok ? kc : cs;
                    sc[ti][rr] = ok ? acc[rr] * 0.125f + rp[kcc] : -1.0e30f; } }
            else {
#pragma unroll
                for (int rr = 0; rr < 4; ++rr) sc[ti][rr] = hf == 0 ? acc[rr] * 0.125f + sMB[quad * 4 + rr] : -1.0e30f; } }
        float mx = -1.0e30f;
#pragma unroll
        for (int ti = 0; ti < 9; ++ti)
#pragma unroll
            for (int rr = 0; rr < 4; ++rr) mx = fmaxf(mx, sc[ti][rr]);
        mx = fmaxf(mx, __shfl_xor(mx, 16)); mx = fmaxf(mx, __shfl_xor(mx, 32));
        float lsum = 0.f;
#pragma unroll
        for (int ti = 0; ti < 9; ++ti)
#pragma unroll
            for (int rr = 0; rr < 4; ++rr) { sc[ti][rr] = __expf(sc[ti][rr] - mx); lsum += sc[ti][rr]; }
        lsum += __shfl_xor(lsum, 16); lsum += __shfl_xor(lsum, 32);
        f32x4 oacc[4];
#pragma unroll
        for (int dt = 0; dt < 4; ++dt) oacc[dt] = (f32x4){0.f, 0.f, 0.f, 0.f};
#pragma unroll
        for (int ks = 0; ks < 5; ++ks) { const int tA = 2 * ks, tB = 2 * ks + 1;
            const int jA = 4 * hf + (tA >> 1); const int slotA = tA < 8 ? jA * 64 + cu + (tA & 1) * 16 : 512; const int slotB = ks < 4 ? (4 * hf + (tB >> 1)) * 64 + cu + 16 : 512;
            u32x4 pa; pa.x = cvt_pk_bf16(sc[tA][0], sc[tA][1]); pa.y = cvt_pk_bf16(sc[tA][2], sc[tA][3]);
            if (ks < 4) { pa.z = cvt_pk_bf16(sc[tA + 1 < 9 ? tA + 1 : 8][0], sc[tA + 1 < 9 ? tA + 1 : 8][1]); pa.w = cvt_pk_bf16(sc[tA + 1 < 9 ? tA + 1 : 8][2], sc[tA + 1 < 9 ? tA + 1 : 8][3]); } else { pa.z = 0u; pa.w = 0u; }
            const bf16x8 af = __builtin_bit_cast(bf16x8, pa);
#pragma unroll
            for (int dt = 0; dt < 4; ++dt) { const bf16_t* vr = sVT + (dt * 16 + l15) * 536 + quad * 4;
                const u32x2 lo = *(const u32x2*)(vr + slotA), hi = *(const u32x2*)(vr + slotB);
                const u32x4 bb = (u32x4){lo.x, lo.y, hi.x, hi.y};
                oacc[dt] = __builtin_amdgcn_mfma_f32_16x16x32_bf16(af, __builtin_bit_cast(bf16x8, bb), oacc[dt], 0, 0, 0); } }
        __syncthreads();
        float* part = (float*)smem + cb * 1056;
        if (hf == 1) {
#pragma unroll
            for (int dt = 0; dt < 4; ++dt)
#pragma unroll
                for (int rr = 0; rr < 4; ++rr) part[(quad * 4 + rr) * 64 + dt * 16 + l15] = oacc[dt][rr];
            if (quad == 0) { part[1024 + l15] = mx; part[1040 + l15] = lsum; } }
        __syncthreads();
        if (hf == 0) {
#pragma unroll
            for (int rr = 0; rr < 4; ++rr) { const int qy = quad * 4 + rr; const float m0 = __shfl(mx, qy), l0 = __shfl(lsum, qy); const float m1 = part[1024 + qy], l1 = part[1040 + qy];
                const float M = fmaxf(m0, m1), f0 = __expf(m0 - M), f1 = __expf(m1 - M); const float inv = 1.0f / (f0 * l0 + f1 * l1);
                bf16_t* gp = yc + (size_t)(NMETA + r * 64 + cb * 16 + qy) * 1024 + hd * 64 + l15;
#pragma unroll
                for (int dt = 0; dt < 4; ++dt) { const float o = (f0 * oacc[dt][rr] + f1 * part[qy * 64 + dt * 16 + l15]) * inv; gp[dt * 16] = f2bf(o * gatev[rr][dt]); } } }
    }
#undef NA_LOADS
}
__device__ void na_meta_unit(const Params& p, int layer) {
    const int tid = opaque_tid();
    if (tid < 256) { const int hd = tid >> 4, qi = tid & 15; const bf16_t* qkv = (const bf16_t*)(p.ws + OFF_QKV);
        float q[64];
        { const u32x4* qp = (const u32x4*)(qkv + (size_t)qi * 3072 + hd * 64);
#pragma unroll
          for (int i = 0; i < 8; ++i) { const u32x4 v = qp[i]; q[i * 8 + 0] = lo_bf(v.x) * 0.125f; q[i * 8 + 1] = hi_bf(v.x) * 0.125f; q[i * 8 + 2] = lo_bf(v.y) * 0.125f; q[i * 8 + 3] = hi_bf(v.y) * 0.125f;
              q[i * 8 + 4] = lo_bf(v.z) * 0.125f; q[i * 8 + 5] = hi_bf(v.z) * 0.125f; q[i * 8 + 6] = lo_bf(v.w) * 0.125f; q[i * 8 + 7] = hi_bf(v.w) * 0.125f; } }
        float o[64];
#pragma unroll
        for (int i = 0; i < 64; ++i) o[i] = 0.f;
        float mx = -3.0e38f, lsum = 0.f;
#pragma unroll 1
        for (int m = 0; m < 16; ++m) { const u32x4* kp = (const u32x4*)(qkv + (size_t)m * 3072 + 1024 + hd * 64); const u32x4* vp = (const u32x4*)(qkv + (size_t)m * 3072 + 2048 + hd * 64);
            float d0 = 0.f, d1 = 0.f;
#pragma unroll
            for (int e = 0; e < 8; ++e) { const u32x4 v = kp[e];
                d0 += q[e * 8 + 0] * lo_bf(v.x) + q[e * 8 + 2] * lo_bf(v.y) + q[e * 8 + 4] * lo_bf(v.z) + q[e * 8 + 6] * lo_bf(v.w);
                d1 += q[e * 8 + 1] * hi_bf(v.x) + q[e * 8 + 3] * hi_bf(v.y) + q[e * 8 + 5] * hi_bf(v.z) + q[e * 8 + 7] * hi_bf(v.w); }
            const float sc = d0 + d1 + p.meta_bias[(layer * 16 + hd) * 16 + m]; const float mnew = fmaxf(mx, sc); const float alpha = __expf(mx - mnew), pi = __expf(sc - mnew);
            lsum = lsum * alpha + pi; mx = mnew;
#pragma unroll
            for (int e = 0; e < 8; ++e) { const u32x4 v = vp[e];
                o[e * 8 + 0] = o[e * 8 + 0] * alpha + pi * lo_bf(v.x); o[e * 8 + 1] = o[e * 8 + 1] * alpha + pi * hi_bf(v.x); o[e * 8 + 2] = o[e * 8 + 2] * alpha + pi * lo_bf(v.y); o[e * 8 + 3] = o[e * 8 + 3] * alpha + pi * hi_bf(v.y);
                o[e * 8 + 4] = o[e * 8 + 4] * alpha + pi * lo_bf(v.z); o[e * 8 + 5] = o[e * 8 + 5] * alpha + pi * hi_bf(v.z); o[e * 8 + 6] = o[e * 8 + 6] * alpha + pi * lo_bf(v.w); o[e * 8 + 7] = o[e * 8 + 7] * alpha + pi * hi_bf(v.w); } }
        const float inv = 1.0f / lsum; u32x4* gp = (u32x4*)((bf16_t*)(p.ws + OFF_GATE + 2 * SZ_GATE) + (size_t)qi * 1024 + hd * 64);
#pragma unroll
        for (int e = 0; e < 8; ++e) { const u32x4 g = gp[e]; u32x4 w;
            w.x = cvt_pk_bf16(o[e * 8 + 0] * inv * lo_bf(g.x), o[e * 8 + 1] * inv * hi_bf(g.x)); w.y = cvt_pk_bf16(o[e * 8 + 2] * inv * lo_bf(g.y), o[e * 8 + 3] * inv * hi_bf(g.y));
            w.z = cvt_pk_bf16(o[e * 8 + 4] * inv * lo_bf(g.z), o[e * 8 + 5] * inv * hi_bf(g.z)); w.w = cvt_pk_bf16(o[e * 8 + 6] * inv * lo_bf(g.w), o[e * 8 + 7] * inv * hi_bf(g.w));
            gp[e] = w; } }
}

__device__ __forceinline__ unsigned rev4_14(unsigned k) { unsigned r = __brev(k) >> 18; return ((r & 0x1555u) << 1) | ((r >> 1) & 0x1555u); }
__device__ __forceinline__ float2 cmul(float2 a, float2 b) { return make_float2(a.x * b.x - a.y * b.y, a.x * b.y + a.y * b.x); }
#define PADI(i) ((i) + ((i) >> 4))
#define CFF(n) cff[2 * PADI((n) >> 1) + ((n) & 1)]
__device__ __forceinline__ void hw_sincos(float rev, float& sn, float& cs) { sn = __builtin_amdgcn_sinf(rev); cs = __builtin_amdgcn_cosf(rev); }
__device__ __forceinline__ float c16(int k) { const float t[10] = {1.0f, 0.9238795325f, 0.7071067812f, 0.3826834324f, 0.0f, -0.3826834324f, -0.7071067812f, -0.9238795325f, -1.0f, -0.9238795325f}; return t[k]; }
__device__ __forceinline__ float s16(int k) { const float t[10] = {0.0f, 0.3826834324f, 0.7071067812f, 0.9238795325f, 1.0f, 0.9238795325f, 0.7071067812f, 0.3826834324f, 0.0f, -0.3826834324f}; return t[k]; }
__device__ __forceinline__ float2 cadd(float2 a, float2 b) { return make_float2(a.x + b.x, a.y + b.y); }
__device__ __forceinline__ float2 csub(float2 a, float2 b) { return make_float2(a.x - b.x, a.y - b.y); }
template <int SGN> __device__ __forceinline__ void bf4(float2& a0, float2& a1, float2& a2, float2& a3) {
    const float2 t0 = cadd(a0, a2), t1 = csub(a0, a2), t2 = cadd(a1, a3), d = csub(a1, a3);
    const float2 t3 = SGN < 0 ? make_float2(d.y, -d.x) : make_float2(-d.y, d.x);
    a0 = cadd(t0, t2); a1 = cadd(t1, t3); a2 = csub(t0, t2); a3 = csub(t1, t3);
}
template <int S> __device__ __forceinline__ void r16_fwd_pass(float2* a) {
    constexpr int Q = S / 4;
    for (int u = opaque_tid(); u < 1024; u += NTHREADS) { const int j = u & (Q - 1); const int base = ((u - j) << 4) + j;
        float2 x[4][4];
#pragma unroll
        for (int aa = 0; aa < 4; ++aa)
#pragma unroll
            for (int bb = 0; bb < 4; ++bb) x[aa][bb] = a[PADI(base + aa * S + bb * Q)];
        float sn, cs; hw_sincos((float)j / (float)(4 * S), sn, cs); const float2 wb0 = make_float2(cs, -sn);
#pragma unroll
        for (int bb = 0; bb < 4; ++bb) { const float2 w1 = bb == 0 ? wb0 : cmul(wb0, make_float2(c16(bb), -s16(bb))); const float2 w2 = cmul(w1, w1), w3 = cmul(w2, w1);
            bf4<-1>(x[0][bb], x[1][bb], x[2][bb], x[3][bb]); x[1][bb] = cmul(x[1][bb], w1); x[2][bb] = cmul(x[2][bb], w2); x[3][bb] = cmul(x[3][bb], w3); }
        hw_sincos((float)j / (float)S, sn, cs); const float2 v1 = make_float2(cs, -sn), v2 = cmul(v1, v1), v3 = cmul(v2, v1);
#pragma unroll
        for (int aa = 0; aa < 4; ++aa) { bf4<-1>(x[aa][0], x[aa][1], x[aa][2], x[aa][3]); x[aa][1] = cmul(x[aa][1], v1); x[aa][2] = cmul(x[aa][2], v2); x[aa][3] = cmul(x[aa][3], v3); }
#pragma unroll
        for (int aa = 0; aa < 4; ++aa)
#pragma unroll
            for (int bb = 0; bb < 4; ++bb) a[PADI(base + aa * S + bb * Q)] = x[aa][bb]; }
    __syncthreads();
}
template <int S> __device__ __forceinline__ void r16_inv_pass(float2* a) {
    constexpr int Q = S / 4;
    for (int u = opaque_tid(); u < 1024; u += NTHREADS) { const int j = u & (Q - 1); const int base = ((u - j) << 4) + j;
        float2 x[4][4];
#pragma unroll
        for (int aa = 0; aa < 4; ++aa)
#pragma unroll
            for (int bb = 0; bb < 4; ++bb) x[aa][bb] = a[PADI(base + aa * S + bb * Q)];
        float sn, cs; hw_sincos((float)j / (float)S, sn, cs); const float2 v1 = make_float2(cs, sn), v2 = cmul(v1, v1), v3 = cmul(v2, v1);
#pragma unroll
        for (int aa = 0; aa < 4; ++aa) { x[aa][1] = cmul(x[aa][1], v1); x[aa][2] = cmul(x[aa][2], v2); x[aa][3] = cmul(x[aa][3], v3); bf4<1>(x[aa][0], x[aa][1], x[aa][2], x[aa][3]); }
        hw_sincos((float)j / (float)(4 * S), sn, cs); const float2 wb0 = make_float2(cs, sn);
#pragma unroll
        for (int bb = 0; bb < 4; ++bb) { const float2 w1 = bb == 0 ? wb0 : cmul(wb0, make_float2(c16(bb), s16(bb))); const float2 w2 = cmul(w1, w1), w3 = cmul(w2, w1);
            x[1][bb] = cmul(x[1][bb], w1); x[2][bb] = cmul(x[2][bb], w2); x[3][bb] = cmul(x[3][bb], w3); bf4<1>(x[0][bb], x[1][bb], x[2][bb], x[3][bb]); }
#pragma unroll
        for (int aa = 0; aa < 4; ++aa)
#pragma unroll
            for (int bb = 0; bb < 4; ++bb) a[PADI(base + aa * S + bb * Q)] = x[aa][bb]; }
    __syncthreads();
}
__device__ void fft_fwd(float2* a) {
    r16_fwd_pass<4096>(a);
    r16_fwd_pass<256>(a);
    { const int span = 16;
        for (int b = opaque_tid(); b < 4096; b += NTHREADS) { const int j = b & (span - 1); const int base = ((b - j) << 2) + j;
            const int i0 = PADI(base), i1 = PADI(base + span), i2 = PADI(base + 2 * span), i3 = PADI(base + 3 * span);
            float2 a0 = a[i0], a1 = a[i1], a2 = a[i2], a3 = a[i3];
            const float2 w1 = make_float2(c16(0) * 0.f + __builtin_amdgcn_cosf((float)j * (1.0f / 64.0f)), -__builtin_amdgcn_sinf((float)j * (1.0f / 64.0f))), w2 = cmul(w1, w1), w3 = cmul(w2, w1);
            bf4<-1>(a0, a1, a2, a3);
            a[i0] = a0; a[i1] = cmul(a1, w1); a[i2] = cmul(a2, w2); a[i3] = cmul(a3, w3); }
        __syncthreads(); }
    for (int blk = opaque_tid(); blk < 1024; blk += NTHREADS) { float2* pb = a + blk * 17; float2 x[16];
#pragma unroll
        for (int e = 0; e < 16; ++e) x[e] = pb[e];
#pragma unroll
        for (int j = 0; j < 4; ++j) { bf4<-1>(x[j], x[j + 4], x[j + 8], x[j + 12]);
            x[j + 4] = cmul(x[j + 4], make_float2(c16(j), -s16(j))); x[j + 8] = cmul(x[j + 8], make_float2(c16(2 * j), -s16(2 * j))); x[j + 12] = cmul(x[j + 12], make_float2(c16(3 * j), -s16(3 * j))); }
#pragma unroll
        for (int g = 0; g < 4; ++g) bf4<-1>(x[4 * g], x[4 * g + 1], x[4 * g + 2], x[4 * g + 3]);
#pragma unroll
        for (int e = 0; e < 16; ++e) pb[e] = x[e]; }
    __syncthreads();
}
__device__ void fft_inv(float2* a) {
    for (int blk = opaque_tid(); blk < 1024; blk += NTHREADS) { float2* pb = a + blk * 17; float2 x[16];
#pragma unroll
        for (int e = 0; e < 16; ++e) x[e] = pb[e];
#pragma unroll
        for (int g = 0; g < 4; ++g) bf4<1>(x[4 * g], x[4 * g + 1], x[4 * g + 2], x[4 * g + 3]);
#pragma unroll
        for (int j = 0; j < 4; ++j) { x[j + 4] = cmul(x[j + 4], make_float2(c16(j), s16(j))); x[j + 8] = cmul(x[j + 8], make_float2(c16(2 * j), s16(2 * j))); x[j + 12] = cmul(x[j + 12], make_float2(c16(3 * j), s16(3 * j)));
            bf4<1>(x[j], x[j + 4], x[j + 8], x[j + 12]); }
#pragma unroll
        for (int e = 0; e < 16; ++e) pb[e] = x[e]; }
    __syncthreads();
    { const int span = 16;
        for (int b = opaque_tid(); b < 4096; b += NTHREADS) { const int j = b & (span - 1); const int base = ((b - j) << 2) + j;
            const int i0 = PADI(base), i1 = PADI(base + span), i2 = PADI(base + 2 * span), i3 = PADI(base + 3 * span);
            const float2 w1 = make_float2(__builtin_amdgcn_cosf((float)j * (1.0f / 64.0f)), __builtin_amdgcn_sinf((float)j * (1.0f / 64.0f))), w2 = cmul(w1, w1), w3 = cmul(w2, w1);
            float2 a0 = a[i0], a1 = cmul(a[i1], w1), a2 = cmul(a[i2], w2), a3 = cmul(a[i3], w3);
            bf4<1>(a0, a1, a2, a3);
            a[i0] = a0; a[i1] = a1; a[i2] = a2; a[i3] = a3; }
        __syncthreads(); }
    r16_inv_pass<256>(a);
    r16_inv_pass<4096>(a);
}
__device__ __forceinline__ void hy_load8(const bf16_t* __restrict__ row, int t0, u32x4& v, float& xl, float& xh) {
    v = *(const u32x4*)(row + t0); xl = t0 > 0 ? bf2f(row[t0 - 1]) : 0.f; xh = (t0 + 8 < L_TOK) ? bf2f(row[t0 + 8]) : 0.f;
}
__device__ __forceinline__ void hy_calc8(const u32x4 v, float xl, float xh, const float (&w)[4], float (&o)[8]) {
    float x[10];
    x[0] = xl; x[9] = xh;
    x[1] = lo_bf(v.x); x[2] = hi_bf(v.x); x[3] = lo_bf(v.y); x[4] = hi_bf(v.y); x[5] = lo_bf(v.z); x[6] = hi_bf(v.z); x[7] = lo_bf(v.w); x[8] = hi_bf(v.w);
#pragma unroll
    for (int e = 0; e < 8; ++e) o[e] = w[0] * x[e] + w[1] * x[e + 1] + w[2] * x[e + 2] + w[3];
}
__device__ __forceinline__ void hy_val8(const bf16_t* __restrict__ row, int t0, const float (&w)[4], float (&o)[8]) { u32x4 v; float xl, xh; hy_load8(row, t0, v, xl, xh); hy_calc8(v, xl, xh, w, o); }
struct HyCh { const bf16_t* __restrict__ ru; const bf16_t* __restrict__ r1; const bf16_t* __restrict__ r2; float wu[4], w1[4], w2[4]; };

constexpr int SD_W4B = 0  , SD_GFX = 512, SD_GBX = 528, SD_EF = 544, SD_EB = 560, SD_VH = 576, SD_VT = 592, SD_END = 608;
constexpr int NCHUNK = L_TOK / 8;

template <int ORDER>
__device__ void hy_conv(const HyCh& hc, float2* cf, float* side, unsigned char* scratch) {
    const int tid = opaque_tid(); float* cff = (float*)cf;
    f32x4* __restrict__ heo = (f32x4*)(scratch + HS_HEO); const float* __restrict__ z2g = (const float*)(scratch + HS_Z2);
    if (tid < 15) side[SD_EF + tid] = CFF(16369 + tid); else if (tid >= 32 && tid < 47) side[SD_EB + tid - 32] = CFF(32768 - (16369 + tid - 32));
    __syncthreads();
    fft_fwd(cf);
    for (int j = tid; j <= 8192; j += NTHREADS) { const unsigned i_ = j < 8192 ? ((((unsigned)j >> 1) << 2) | ((unsigned)j & 1u)) : 2u; const unsigned k = rev4_14(i_); const unsigned kp = (16384u - k) & 16383u; const float2 a = cf[PADI(i_)], bq = cf[PADI(rev4_14(kp))];
        const float bx = bq.x, by = -bq.y; const float sc = 1.0f / 16384.0f;
        heo[j] = (f32x4){0.5f * (a.x + bx) * sc, 0.5f * (a.y + by) * sc, 0.5f * (a.y - by) * sc, -0.5f * (a.x - bx) * sc}; }
    __syncthreads();
    {
        u32x4 rv[4]; float rl[4], rh[4]; f32x4 z0[4], z1[4];
#pragma unroll
        for (int i = 0; i < 4; ++i) { const int c = tid + NTHREADS * i;
            if (ORDER == 0) hy_load8(hc.ru, 8 * c, rv[i], rl[i], rh[i]); else { z0[i] = *(const f32x4*)(z2g + 8 * c); z1[i] = *(const f32x4*)(z2g + 8 * c + 4); } }
#pragma unroll
        for (int i = 0; i < 4; ++i) { const int c = tid + NTHREADS * i; float v[8];
            if (ORDER == 0) hy_calc8(rv[i], rl[i], rh[i], hc.wu, v);
            else { v[0] = z0[i][0]; v[1] = z0[i][1]; v[2] = z0[i][2]; v[3] = z0[i][3]; v[4] = z1[i][0]; v[5] = z1[i][1]; v[6] = z1[i][2]; v[7] = z1[i][3]; }
            float2* d = cf + PADI(4 * c); d[0] = make_float2(v[0], v[1]); d[1] = make_float2(v[2], v[3]); d[2] = make_float2(v[4], v[5]); d[3] = make_float2(v[6], v[7]);
            if (i == 0 && tid < 2) {
#pragma unroll
                for (int e = 0; e < 8; ++e) side[SD_VH + 8 * tid + e] = v[e]; } }
        if (tid < 2) { const int c = NCHUNK - 2 + tid; float v[8];
            if (ORDER == 0) hy_val8(hc.ru, 8 * c, hc.wu, v);
            else { const f32x4 p0 = *(const f32x4*)(z2g + 8 * c), p1 = *(const f32x4*)(z2g + 8 * c + 4); v[0] = p0[0]; v[1] = p0[1]; v[2] = p0[2]; v[3] = p0[3]; v[4] = p1[0]; v[5] = p1[1]; v[6] = p1[2]; v[7] = p1[3]; }
            float2* d = cf + PADI(4 * c); d[0] = make_float2(v[0], v[1]); d[1] = make_float2(v[2], v[3]); d[2] = make_float2(v[4], v[5]); d[3] = make_float2(v[6], v[7]);
#pragma unroll
            for (int e = 0; e < 8; ++e) side[SD_VT + 8 * tid + e] = v[e]; } }
    for (int i = L_TOK / 2 + tid; i < 16384; i += NTHREADS) cf[PADI(i)] = make_float2(0.f, 0.f);
    __syncthreads();
    fft_fwd(cf);
#pragma unroll 4
    for (int j = tid; j <= 8192; j += NTHREADS) { const unsigned i_ = j < 8192 ? ((((unsigned)j >> 1) << 2) | ((unsigned)j & 1u)) : 2u; const unsigned k = rev4_14(i_); const unsigned kp = (16384u - k) & 16383u; const unsigned ik = PADI(i_), ikp = PADI(rev4_14(kp)); const float2 a = cf[ik], bq = cf[ikp];
        const float bx = bq.x, by = -bq.y;
        const float2 XE = make_float2(0.5f * (a.x + bx), 0.5f * (a.y + by)), XO = make_float2(0.5f * (a.y - by), -0.5f * (a.x - bx));
        const f32x4 hh = heo[j]; const float2 HE = make_float2(hh[0], hh[1]), HO = make_float2(hh[2], hh[3]);
        float sn, cs; hw_sincos((float)k / 16384.0f, sn, cs); const float2 w = make_float2(cs, -sn);
        const float2 xoho = cmul(XO, HO), wx = cmul(w, xoho), xehe = cmul(XE, HE), xeho = cmul(XE, HO), xohe = cmul(XO, HE);
        const float2 YE = make_float2(xehe.x + wx.x, xehe.y + wx.y), YO = make_float2(xeho.x + xohe.x, xeho.y + xohe.y);
        cf[ik] = make_float2(YE.x - YO.y, YE.y + YO.x); cf[ikp] = make_float2(YE.x + YO.y, -YE.y + YO.x); }
    __syncthreads();
    fft_inv(cf);
    if (tid < 16) { const int t = tid; float d = 0.f;
        for (int s = t + 16384; s < L_TOK; ++s) { const int l = s - t; const float wrong = l == 16384 ? 0.f : side[SD_EF + 16399 - l]; d += (side[SD_GBX + l - 16384] - wrong) * side[SD_VT + s - 16384]; }
        CFF(t) += d; }
    else if (tid >= 32 && tid < 48) { const int t = 16384 + tid - 32; float d = 0.f;
        for (int s = 0; s <= t - 16384; ++s) { const int l = t - s; const float wrong = l == 16384 ? 0.f : side[SD_EB + 16399 - l]; d += (side[SD_GFX + l - 16384] - wrong) * side[SD_VH + s]; }
        CFF(t) += d; }
    __syncthreads();
}

__device__ void filt_to_lds(const bf16_t* __restrict__ gfp, const bf16_t* __restrict__ gbp, float2* cf, float* side) {
    const int tid = opaque_tid(); float* cff = (float*)cf;
    u32x4 qf[4], qb[4];
#pragma unroll
    for (int i = 0; i < 4; ++i) { const int c = tid + NTHREADS * i; qf[i] = *(const u32x4*)(gfp + 8 * c); qb[i] = *(const u32x4*)(gbp + 8 * c); }
#pragma unroll
    for (int i = 0; i < 4; ++i) { const int c = tid + NTHREADS * i, lag0 = 8 * c; const u32x4 f = qf[i], g = qb[i];
        float2* d = cf + PADI(4 * c); d[0] = make_float2(lo_bf(f.x), hi_bf(f.x)); d[1] = make_float2(lo_bf(f.y), hi_bf(f.y)); d[2] = make_float2(lo_bf(f.z), hi_bf(f.z)); d[3] = make_float2(lo_bf(f.w), hi_bf(f.w));
        if (lag0 >= 1) CFF(32768 - lag0) = lo_bf(g.x);
        CFF(32768 - lag0 - 1) = hi_bf(g.x); CFF(32768 - lag0 - 2) = lo_bf(g.y); CFF(32768 - lag0 - 3) = hi_bf(g.y); CFF(32768 - lag0 - 4) = lo_bf(g.z); CFF(32768 - lag0 - 5) = hi_bf(g.z); CFF(32768 - lag0 - 6) = lo_bf(g.w); CFF(32768 - lag0 - 7) = hi_bf(g.w); }
    if (tid < 2) { const int c = NCHUNK - 2 + tid; const u32x4 f = *(const u32x4*)(gfp + 8 * c), g = *(const u32x4*)(gbp + 8 * c); float* sf = side + SD_GFX + 8 * tid; float* sb = side + SD_GBX + 8 * tid;
        sf[0] = lo_bf(f.x); sf[1] = hi_bf(f.x); sf[2] = lo_bf(f.y); sf[3] = hi_bf(f.y); sf[4] = lo_bf(f.z); sf[5] = hi_bf(f.z); sf[6] = lo_bf(f.w); sf[7] = hi_bf(f.w);
        sb[0] = lo_bf(g.x); sb[1] = hi_bf(g.x); sb[2] = lo_bf(g.y); sb[3] = hi_bf(g.y); sb[4] = lo_bf(g.z); sb[5] = hi_bf(g.z); sb[6] = lo_bf(g.w); sb[7] = hi_bf(g.w); }
    if (tid == 0) CFF(NMAIN) = 0.f;
    __syncthreads();
}

__device__ void hyena_filters(const Params& p, int layer, unsigned char* smem, unsigned char* scrD, unsigned char* scrW) {
    const int tid = opaque_tid(); float2* cf = (float2*)smem; float* cff = (float*)smem; float* side = (float*)(smem + 139264);
    const int bid = blockIdx.x;
    __syncthreads();
    bf16_t* w4b = (bf16_t*)(side + SD_W4B);
    for (int i = tid; i < 16 * 64; i += NTHREADS) { const int row = i >> 6, k = i & 63; w4b[i] = f2bf(p.f_w4[((size_t)layer * 64 + k) * 4096 + (row & 3) * 1024 + bid + 256 * (row >> 2)]); }
    __syncthreads();
    const bf16_t* __restrict__ h3b = (const bf16_t*)(p.ws + OFF_H3) + (size_t)layer * L_TOK * 64;
    const int lane = tid & 63, wv = tid >> 6, col = lane & 15, quad = lane >> 4;
    const int chq = bid + 256 * quad;
    float dk[4];
#pragma unroll
    for (int f = 0; f < 4; ++f) dk[f] = fabsf(p.decay[((layer * 2 + (f >> 1)) * 2 + (f & 1)) * 1024 + chq]) * (1.4426950408889634f / (float)(L_TOK - 1));
    const bf16x8 b0 = *(const bf16x8*)(w4b + col * 64 + quad * 8), b1 = *(const bf16x8*)(w4b + col * 64 + 32 + quad * 8);
    bf16_t* __restrict__ g2 = (bf16_t*)(scrW + HS_G2);
    bf16_t* __restrict__ fq = (bf16_t*)(scrD) + (size_t)(quad > 0 ? quad - 1 : 0) * 4 * L_TOK;
#define FG_LOAD(A0, A1, GB) do { _Pragma("unroll") for (int i = 0; i < 8; ++i) { const bf16_t* hr = h3b + (size_t)(((GB) + 8 * i) * 16 + col) * 64 + quad * 8; A0[i] = *(const bf16x8*)hr; A1[i] = *(const bf16x8*)(hr + 32); } } while (0)
#define FG_GROUP(X0, X1, G_) do { f32x4 acc = (f32x4){0.f, 0.f, 0.f, 0.f}; \
        acc = __builtin_amdgcn_mfma_f32_16x16x32_bf16(b0, X0, acc, 0, 0, 0); acc = __builtin_amdgcn_mfma_f32_16x16x32_bf16(b1, X1, acc, 0, 0, 0); \
        const int lag = (G_) * 16 + col; const float fl = -(float)lag; \
        const float v0 = acc[0] * __builtin_amdgcn_exp2f(fl * dk[0]), v1 = acc[1] * __builtin_amdgcn_exp2f(fl * dk[1]), v2 = acc[2] * __builtin_amdgcn_exp2f(fl * dk[2]), v3 = acc[3] * __builtin_amdgcn_exp2f(fl * dk[3]); \
        if (quad == 0) { g2[lag] = f2bf(v2); g2[L_TOK + lag] = f2bf(v3); \
            if (lag < NMAIN) { CFF(lag) = v0; if (lag >= 1) CFF(32768 - lag) = v1; } else { side[SD_GFX + lag - NMAIN] = v0; side[SD_GBX + lag - NMAIN] = v1; } } \
        else { fq[lag] = f2bf(v0); fq[L_TOK + lag] = f2bf(v1); fq[2 * L_TOK + lag] = f2bf(v2); fq[3 * L_TOK + lag] = f2bf(v3); } } while (0)
#define FG_PROC(A0, A1, GB) do { _Pragma("unroll") for (int i = 0; i < 8; ++i) FG_GROUP(A0[i], A1[i], (GB) + 8 * i); } while (0)
    { bf16x8 pa0[8], pa1[8], pb0[8], pb1[8];
      FG_LOAD(pa0, pa1, wv);
#pragma unroll 1
      for (int m = 0; m < 16; m += 2) { const int gbA = wv + 64 * m, gbB = gbA + 64;
          FG_LOAD(pb0, pb1, gbB);
          FG_PROC(pa0, pa1, gbA);
          if (m + 2 < 16) FG_LOAD(pa0, pa1, gbB + 64);
          FG_PROC(pb0, pb1, gbB); }
      if (wv == 0) { const bf16_t* hr = h3b + (size_t)(1024 * 16 + col) * 64 + quad * 8; const bf16x8 x0 = *(const bf16x8*)hr, x1 = *(const bf16x8*)(hr + 32); FG_GROUP(x0, x1, 1024); } }
#undef FG_LOAD
#undef FG_GROUP
#undef FG_PROC
    if (tid == 0) CFF(NMAIN) = 0.f;
    __syncthreads();
}

__device__ void hyena_unit(const Params& p, int layer, int q, unsigned char* smem, unsigned char* scrD, unsigned char* scratch) {
    const int tid = opaque_tid(); float2* cf = (float2*)smem; float* cff = (float*)smem; float* side = (float*)(smem + 139264);
    const int ch = blockIdx.x + 256 * q;
    const bf16_t* hyin = (const bf16_t*)(p.ws + OFF_HYIN);
    HyCh hc; hc.ru = hyin + (size_t)ch * LP; hc.r1 = hyin + (size_t)(1024 + ch) * LP; hc.r2 = hyin + (size_t)(2048 + ch) * LP;
    { const float* cw = p.conv_w + (size_t)layer * 3 * 3072; const float* cb = p.conv_b + (size_t)layer * 3072;
#pragma unroll
      for (int jj = 0; jj < 3; ++jj) { hc.wu[jj] = cw[jj * 3072 + ch]; hc.w1[jj] = cw[jj * 3072 + 1024 + ch]; hc.w2[jj] = cw[jj * 3072 + 2048 + ch]; }
      hc.wu[3] = cb[ch]; hc.w1[3] = cb[1024 + ch]; hc.w2[3] = cb[2048 + ch]; }
    const float sk0 = p.skip[(layer * 2 + 0) * 1024 + ch], sk1 = p.skip[(layer * 2 + 1) * 1024 + ch];
    float* __restrict__ z2g = (float*)(scratch + HS_Z2);
    const bf16_t* filt = q == 0 ? (const bf16_t*)(scratch + HS_G2) - 2 * (size_t)L_TOK : (const bf16_t*)scrD + (size_t)(q - 1) * 4 * L_TOK;
    bf16_t* __restrict__ hyout = (bf16_t*)(p.ws + OFF_HYOUT) + (size_t)ch * LP;
    if (q > 0) { __syncthreads(); filt_to_lds(filt, filt + L_TOK, cf, side); }
    hy_conv<0>(hc, cf, side, scratch);
    {   u32x4 ru_[4], r1_[4]; float ul[4], uh[4], xl[4], xh[4];
#pragma unroll
        for (int i = 0; i < 4; ++i) { const int c = tid + NTHREADS * i; hy_load8(hc.ru, 8 * c, ru_[i], ul[i], uh[i]); hy_load8(hc.r1, 8 * c, r1_[i], xl[i], xh[i]); }
#pragma unroll
        for (int i = 0; i < 5; ++i) { const int c = i < 4 ? tid + NTHREADS * i : NCHUNK - 2 + tid;
            if (i < 4 || tid < 2) { float u8[8], x8[8];
                if (i < 4) { hy_calc8(ru_[i], ul[i], uh[i], hc.wu, u8); hy_calc8(r1_[i], xl[i], xh[i], hc.w1, x8); } else { hy_val8(hc.ru, 8 * c, hc.wu, u8); hy_val8(hc.r1, 8 * c, hc.w1, x8); }
                const float2* s = cf + PADI(4 * c); const float2 y0 = s[0], y1 = s[1], y2 = s[2], y3 = s[3];
                const f32x4 o0 = (f32x4){x8[0] * (y0.x + sk0 * u8[0]), x8[1] * (y0.y + sk0 * u8[1]), x8[2] * (y1.x + sk0 * u8[2]), x8[3] * (y1.y + sk0 * u8[3])};
                const f32x4 o1 = (f32x4){x8[4] * (y2.x + sk0 * u8[4]), x8[5] * (y2.y + sk0 * u8[5]), x8[6] * (y3.x + sk0 * u8[6]), x8[7] * (y3.y + sk0 * u8[7])};
                *(f32x4*)(z2g + 8 * c) = o0; *(f32x4*)(z2g + 8 * c + 4) = o1; } } }
    __syncthreads();
    filt_to_lds(filt + 2 * (size_t)L_TOK, filt + 3 * (size_t)L_TOK, cf, side);
    hy_conv<1>(hc, cf, side, scratch);
    {   u32x4 r2_[4]; float xl[4], xh[4]; f32x4 z0[4], z1[4];
#pragma unroll
        for (int i = 0; i < 4; ++i) { const int c = tid + NTHREADS * i; hy_load8(hc.r2, 8 * c, r2_[i], xl[i], xh[i]); z0[i] = *(const f32x4*)(z2g + 8 * c); z1[i] = *(const f32x4*)(z2g + 8 * c + 4); }
#pragma unroll
        for (int i = 0; i < 5; ++i) { const int c = i < 4 ? tid + NTHREADS * i : NCHUNK - 2 + tid;
            if (i < 4 || tid < 2) { float x8[8]; f32x4 p0, p1;
                if (i < 4) { hy_calc8(r2_[i], xl[i], xh[i], hc.w2, x8); p0 = z0[i]; p1 = z1[i]; } else { hy_val8(hc.r2, 8 * c, hc.w2, x8); p0 = *(const f32x4*)(z2g + 8 * c); p1 = *(const f32x4*)(z2g + 8 * c + 4); }
                const float2* s = cf + PADI(4 * c); const float2 y0 = s[0], y1 = s[1], y2 = s[2], y3 = s[3];
                u32x4 w; w.x = cvt_pk_bf16(x8[0] * (y0.x + sk1 * p0[0]), x8[1] * (y0.y + sk1 * p0[1])); w.y = cvt_pk_bf16(x8[2] * (y1.x + sk1 * p0[2]), x8[3] * (y1.y + sk1 * p0[3]));
                w.z = cvt_pk_bf16(x8[4] * (y2.x + sk1 * p1[0]), x8[5] * (y2.y + sk1 * p1[1])); w.w = cvt_pk_bf16(x8[6] * (y3.x + sk1 * p1[2]), x8[7] * (y3.y + sk1 * p1[3]));
                *(u32x4*)(hyout + 8 * c) = w; } } }
    __syncthreads();
}

__device__ void transpose_phase(const Params& p, unsigned char* smem) {
    const int tid = opaque_tid(), G = gridDim.x; bf16_t* tile0 = (bf16_t*)smem;
    const bf16_t* __restrict__ hyout = (const bf16_t*)(p.ws + OFF_HYOUT); bf16_t* ya = (bf16_t*)(p.ws + OFF_GATE);
    const int cl = tid >> 3, t8 = (tid & 7) * 8, tl = tid >> 3, c8 = (tid & 7) * 8;
    u32x4 ph = (u32x4){0u, 0u, 0u, 0u}, pg = ph;
    constexpr int TOT = 16 * 257;
    int u = blockIdx.x;
    __syncthreads();
    if (u < TOT) { const int ct = u & 15, tt = u >> 4; ph = *(const u32x4*)(hyout + (size_t)(ct * 64 + cl) * LP + tt * 64 + t8); const int t = tt * 64 + tl; if (t < L_TOK) pg = *(const u32x4*)(ya + (size_t)t * 1024 + ct * 64 + c8); }
    int buf = 0;
    for (; u < TOT; u += G) { bf16_t* tile = tile0 + buf * (64 * 72); const int ct = u & 15, tt = u >> 4;
        *(u32x4*)(tile + cl * 72 + t8) = ph; const u32x4 g = pg;
        { const int un = u + G; if (un < TOT) { const int ct2 = un & 15, tt2 = un >> 4; ph = *(const u32x4*)(hyout + (size_t)(ct2 * 64 + cl) * LP + tt2 * 64 + t8); const int t2 = tt2 * 64 + tl; if (t2 < L_TOK) pg = *(const u32x4*)(ya + (size_t)t2 * 1024 + ct2 * 64 + c8); } }
        __syncthreads();
        const int t = tt * 64 + tl;
        if (t < L_TOK) { float v[8];
#pragma unroll
            for (int i = 0; i < 8; ++i) v[i] = bf2f(tile[(c8 + i) * 72 + tl]);
            u32x4 w; w.x = cvt_pk_bf16(v[0] * lo_bf(g.x), v[1] * hi_bf(g.x)); w.y = cvt_pk_bf16(v[2] * lo_bf(g.y), v[3] * hi_bf(g.y)); w.z = cvt_pk_bf16(v[4] * lo_bf(g.z), v[5] * hi_bf(g.z)); w.w = cvt_pk_bf16(v[6] * lo_bf(g.w), v[7] * hi_bf(g.w));
            *(u32x4*)(ya + (size_t)t * 1024 + ct * 64 + c8) = w; }
        buf ^= 1; }
    __syncthreads();
}

__device__ void phase_final(const Params& p) {
    const int tid = opaque_tid(), lane = tid & 63, wv = tid >> 6; const float* h = (const float*)(p.ws + OFF_H);
    for (int l = NMETA + blockIdx.x * 8 + wv; l < L_TOK; l += gridDim.x * 8) { const f32x4* row = (const f32x4*)(h + (size_t)l * DM); f32x4 v[8]; float ss = 0.f;
#pragma unroll
        for (int i = 0; i < 8; ++i) { v[i] = row[i * 64 + lane]; ss += v[i][0] * v[i][0] + v[i][1] * v[i][1] + v[i][2] * v[i][2] + v[i][3] * v[i][3]; }
        ss = wave_sum(ss); const float inv = rsqrtf(ss * (1.0f / DM) + 1e-6f); f32x4* o = (f32x4*)(p.out + (size_t)(l - NMETA) * DM);
#pragma unroll
        for (int i = 0; i < 8; ++i) { const f32x4 gg = ((const f32x4*)p.final_g)[i * 64 + lane]; o[i * 64 + lane] = v[i] * inv * gg; } }
}

__device__ void mini_branch(const Params& p) {
    const int tid = opaque_tid(), lane = tid & 63, wv = tid >> 6, nt_ = blockIdx.x * 8 + wv;
    if (nt_ < 128) { const int rc = lane & 15, quad = lane >> 4; const int n0 = nt_ * 16;
        const bf16_t* mg = (const bf16_t*)(p.ws + OFF_MERGE); bf16_t* mb = (bf16_t*)(p.ws + OFF_M);
        float tot[4] = {0.f, 0.f, 0.f, 0.f};
#pragma unroll 1
        for (int br = 0; br < 3; ++br) { const bf16_t* A = (const bf16_t*)(p.ws + OFF_GATE + (size_t)br * SZ_GATE) + (size_t)(NMAIN + rc) * 1024 + quad * 8;
            const bf16_t* B = (const bf16_t*)(p.ws + OFF_WA + (size_t)br * SZ_WBR) + (size_t)(n0 + rc) * 1024 + quad * 8;
            f32x4 acc = (f32x4){0.f, 0.f, 0.f, 0.f};
#pragma unroll 1
            for (int kb = 0; kb < 32; kb += 8) { bf16x8 av[8], bv[8];
#pragma unroll
                for (int i = 0; i < 8; ++i) { av[i] = *(const bf16x8*)(A + (kb + i) * 32); bv[i] = *(const bf16x8*)(B + (kb + i) * 32); }
#pragma unroll
                for (int i = 0; i < 8; ++i) acc = __builtin_amdgcn_mfma_f32_16x16x32_bf16(av[i], bv[i], acc, 0, 0, 0); }
#pragma unroll
            for (int r = 0; r < 4; ++r) tot[r] += acc[r] * bf2f(mg[(size_t)(NMAIN + quad * 4 + r) * 6144 + br * 2048 + n0 + rc]); }
#pragma unroll
        for (int r = 0; r < 4; ++r) mb[(size_t)(NMAIN + quad * 4 + r) * DM + n0 + rc] = f2bf(tot[r]); }
}
__device__ void mini_out(const Params& p, int layer) {
    const int tid = opaque_tid(), lane = tid & 63, wv = tid >> 6, nt_ = blockIdx.x * 8 + wv;
    if (nt_ < 128) { const int rc = lane & 15, quad = lane >> 4; const int n0 = nt_ * 16;
        const bf16_t* A = (const bf16_t*)(p.ws + OFF_M) + (size_t)(NMAIN + rc) * DM + quad * 8; const bf16_t* B = (const bf16_t*)(p.ws + OFF_WO) + (size_t)(n0 + rc) * DM + quad * 8;
        f32x4 acc = (f32x4){0.f, 0.f, 0.f, 0.f};
#pragma unroll 1
        for (int kb = 0; kb < 64; kb += 8) { bf16x8 av[8], bv[8];
#pragma unroll
            for (int i = 0; i < 8; ++i) { av[i] = *(const bf16x8*)(A + (kb + i) * 32); bv[i] = *(const bf16x8*)(B + (kb + i) * 32); }
#pragma unroll
            for (int i = 0; i < 8; ++i) acc = __builtin_amdgcn_mfma_f32_16x16x32_bf16(av[i], bv[i], acc, 0, 0, 0); }
        float* h = (float*)(p.ws + OFF_H);
#pragma unroll
        for (int r = 0; r < 4; ++r) { const size_t row = NMAIN + quad * 4 + r; const float bs = layer == 0 ? p.x[(row - NMETA) * DM + n0 + rc] : h[row * DM + n0 + rc]; h[row * DM + n0 + rc] = bs + acc[r]; } }
}

#define XB_TMO      128
#define XB_XCNT(j)  (256  + 64 * (j))
#define XB_XSUB(j)  (1280 + 64 * (j))
#define XB_XGEN(j)  (2304 + 64 * (j))
#define XB_TOP      3328
#define XB_TOPGEN   3392
#define XCD_BAR_WORDS 3456
#define XB_SPIN_CAP (1u << 18)
__device__ __forceinline__ unsigned xb_ld(unsigned* p)              { return __hip_atomic_load(p, __ATOMIC_RELAXED, __HIP_MEMORY_SCOPE_AGENT); }
__device__ __forceinline__ unsigned xb_add(unsigned* p, unsigned v) { return __hip_atomic_fetch_add(p, v, __ATOMIC_RELAXED, __HIP_MEMORY_SCOPE_AGENT); }
__device__ __forceinline__ unsigned xb_xcc_id() { return (unsigned)__builtin_amdgcn_s_getreg((3 << 11) | 20) & 0xFu; }
#define XB_SPIN(cond, bar) do { unsigned _sp = 0; while (cond) { __builtin_amdgcn_s_sleep(1); \
    if ((++_sp & 255u) == 0u) { if (xb_ld(&(bar)[XB_TMO])) break; if (_sp > XB_SPIN_CAP) { atomicAdd(&(bar)[XB_TMO], 1u); break; } } } } while (0)
struct XcdBarrier { unsigned* bar; unsigned x; volatile LAS unsigned* st; };
__device__ __forceinline__ void xcd_barrier_complete(unsigned* bar, unsigned x, unsigned& nloc, unsigned& nx) {
    const unsigned G = gridDim.x * gridDim.y * gridDim.z;
    unsigned sum, cnt, mine, sp = 0u;
    for (;;) {
        sum = 0u; cnt = 0u; mine = 0u;
#pragma unroll
        for (unsigned j = 0; j < 16; ++j) { const unsigned c = xb_ld(&bar[XB_XCNT(j)]); sum += c; cnt += (c > 0u) ? 1u : 0u; mine = (j == x) ? c : mine; }
        if (sum == G) break;
        __builtin_amdgcn_s_sleep(1);
        if ((++sp & 255u) == 0u) { if (xb_ld(&bar[XB_TMO])) break; if (sp > XB_SPIN_CAP) { atomicAdd(&bar[XB_TMO], 1u); break; } }
    }
    nloc = mine > 0u ? mine : 1u; nx = cnt > 0u ? cnt : 1u;
}
__device__ __forceinline__ void xcd_barrier(const XcdBarrier& b) {
    asm volatile("s_waitcnt vmcnt(0)" ::: "memory");
    __syncthreads();
    if (threadIdx.x == 0) {
        unsigned* bar = b.bar;
        __builtin_amdgcn_s_waitcnt(0);
        unsigned nloc = b.st[0], nx = b.st[1];
        if (nloc == 0u) { xcd_barrier_complete(bar, b.x, nloc, nx); b.st[0] = nloc; b.st[1] = nx; }
        const unsigned old = xb_add(&bar[XB_XSUB(b.x)], 1u);
        const unsigned gen = old / nloc;
        if (old + 1u == (gen + 1u) * nloc) {
            __builtin_amdgcn_fence(__ATOMIC_RELEASE, "agent");
            asm volatile("s_waitcnt vmcnt(0)" ::: "memory");
            const unsigned og = xb_add(&bar[XB_TOP], 1u);
            const unsigned tg = og / nx;
            if (og + 1u == (tg + 1u) * nx) xb_add(&bar[XB_TOPGEN], 1u);
            else XB_SPIN(xb_ld(&bar[XB_TOPGEN]) == tg, bar);
            __builtin_amdgcn_fence(__ATOMIC_ACQUIRE, "agent");
            xb_add(&bar[XB_XGEN(b.x)], 1u);
            asm volatile("s_waitcnt vmcnt(0)" ::: "memory");
        } else {
            XB_SPIN(xb_ld(&bar[XB_XGEN(b.x)]) == gen, bar);
            __builtin_amdgcn_fence(__ATOMIC_ACQUIRE, "agent");
            asm volatile("s_waitcnt vmcnt(0)" ::: "memory");
        }
    }
    __syncthreads();
}

enum { OP_P1 = 0, OP_SYNC, OP_GEMM, OP_NA, OP_HYENA, OP_TRANS, OP_NOP };
__global__ void __launch_bounds__(512, 2) hybrid_fwd(Params p) {
    extern __shared__ __attribute__((aligned(16))) unsigned char smem[];
    cg::grid_group grid = cg::this_grid();
    LAS unsigned char* lds = (LAS unsigned char*)smem;
    const int bid = blockIdx.x, G = gridDim.x;
    XcdBarrier xb; xb.bar = (unsigned*)(p.ws + OFF_BAR); xb.x = xb_xcc_id(); xb.st = (volatile LAS unsigned*)(lds + LDS_PHASE_BYTES);
    if (bid == 0) for (int i = opaque_tid(); i < XCD_BAR_WORDS; i += NTHREADS) xb.bar[i] = 0u;
    if (opaque_tid() == 0) { xb.st[0] = 0u; xb.st[1] = 0u; }
    __syncthreads();
    phase_prep0(p, smem);
    constexpr int NOPS = 17;
#pragma clang loop unroll(disable)
    for (int step = 0; step < 2 * NOPS; ++step) {
        const int layer = step / NOPS, s = step - layer * NOPS;
        int op, kind = 0;
        switch (s) {
        case 0: op = OP_P1; break;
        case 2: op = OP_GEMM; kind = K_IN; break;
        case 3: case 4: op = OP_NOP; break;
        case 6: op = OP_GEMM; kind = K_FNA; break;
        case 7: op = OP_NA; break;
        case 8: op = OP_HYENA; break;
        case 10: op = OP_GEMM; kind = K_FNB; break;
        case 11: op = OP_TRANS; break;
        case 13: op = OP_GEMM; kind = K_BR; break;
        case 15: op = OP_GEMM; kind = K_OUT; break;
        default: op = OP_SYNC; break;
        }
        if (op == OP_NOP) { }
        else if (op == OP_SYNC) { if (step == 1) { grid.sync(); if (opaque_tid() == 0) (void)xb_add(&xb.bar[XB_XCNT(xb.x)], 1u); } else xcd_barrier(xb); }
        else if (op == OP_GEMM) {
            Gemm g; g.base = (const char*)p.ws; g.jumpA = 0; g.jumpB = 0;
            switch (kind) {
            case K_FNA: g.lda = 384; g.ldb = FN1P; g.nt = 6; g.ksplit = 3; g.jumpB = (long)((size_t)1024 * PROWS * 2) - 384l; break;
            case K_FNB: g.lda = 256; g.ldb = 256; g.nt = 4; g.ksplit = 4; break;
            case K_BR:  g.lda = 1024; g.ldb = 1024; g.nt = 16; g.ksplit = 16; break;
            default:    g.lda = DM; g.ldb = DM; g.nt = 32; g.ksplit = 32; break;
            }
            SchedAny S{kind, G, bid}; EpiAny E{kind, p.ws, layer, p.x, p.meta};
            if (kind == K_BR) { EpiBr EB{p.ws}; pg8::gemm_phase(lds, g, S, EB); } else pg8::gemm_phase(lds, g, S, E);
            if (kind == K_BR) mini_branch(p); else if (kind == K_OUT) mini_out(p, layer);
        }
        else if (op == OP_P1) { phase_p1(p, layer, smem); }
        else if (op == OP_NA) { na_phase(p, layer, smem); if (bid == G - 1) na_meta_unit(p, layer); }
        else if (op == OP_HYENA) { unsigned char* scrD = (unsigned char*)p.out + (size_t)bid * HSD_STRIDE; unsigned char* scrW = p.ws + WS_END + (size_t)bid * HSW_STRIDE;
            hyena_filters(p, layer, smem, scrD, scrW);
#pragma clang loop unroll(disable)
            for (int q = 0; q < 4; ++q) hyena_unit(p, layer, q, smem, scrD, scrW); }
        else { transpose_phase(p, smem); }
    }
    phase_final(p);
}

extern "C" void kernel_launch(void* const* d_in, const int* in_sizes, int n_in, void* d_out, int out_size, void* d_ws, size_t ws_size, hipStream_t stream) {
    static int grid_blocks = 0;
    if (grid_blocks == 0) {
        if (n_in != 23 || ws_size < WS_END2) { fprintf(stderr, "kernel_launch: need 23 inputs and %zu bytes of workspace (got %d, %zu)\n", (size_t)WS_END2, n_in, ws_size); grid_blocks = -1; return; }
        int dev = 0, cus = 0, per_cu = 0;
        hipGetDevice(&dev); hipDeviceGetAttribute(&cus, hipDeviceAttributeMultiprocessorCount, dev);
        if (hipFuncSetAttribute((const void*)hybrid_fwd, hipFuncAttributeMaxDynamicSharedMemorySize, LDS_BYTES) != hipSuccess) { fprintf(stderr, "kernel_launch: hipFuncSetAttribute failed\n"); grid_blocks = -1; return; }
        hipOccupancyMaxActiveBlocksPerMultiprocessor(&per_cu, (const void*)hybrid_fwd, NTHREADS, LDS_BYTES);
        if (per_cu < 1) per_cu = 1;
        grid_blocks = cus * per_cu;
        if (grid_blocks > 256) grid_blocks = 256;
        if (grid_blocks != 256) { fprintf(stderr, "kernel_launch: this kernel needs 256 co-resident workgroups (got %d)\n", grid_blocks); grid_blocks = -1; return; }
    }
    if (grid_blocks < 0) return;
    Params p{};
    const float** f = (const float**)&p;
    for (int i = 0; i < 23; ++i) f[i] = (const float*)d_in[i];
    p.out = (float*)d_out; p.ws = (unsigned char*)d_ws;
    void* args[] = {&p};
    hipError_t e = hipLaunchCooperativeKernel((const void*)hybrid_fwd, dim3(grid_blocks), dim3(NTHREADS), args, LDS_BYTES, stream);
    if (e != hipSuccess) fprintf(stderr, "cooperative launch failed: %s (grid %d)\n", hipGetErrorString(e), grid_blocks);
}
```

```cpp
#include <hip/hip_runtime.h>
#include <hip/hip_cooperative_groups.h>
#include <cstdio>
namespace cg = cooperative_groups;

#define LAS __attribute__((address_space(3)))
typedef unsigned short bf16_t;
typedef short bf16x8 __attribute__((ext_vector_type(8)));
typedef float f32x4 __attribute__((ext_vector_type(4)));
typedef unsigned u32x4 __attribute__((ext_vector_type(4)));
typedef unsigned u32x2 __attribute__((ext_vector_type(2)));

constexpr int L_TOK = 16400, LP = 16640, DM = 2048, NIN = 16384, NMETA = 16, NMAIN = 16384;
constexpr int FN1 = 164, FN2 = 100, FN1P = 192, PROWS = FN2 * FN1P;
constexpr int NTHREADS = 512, LDS_PHASE_BYTES = 155648, LDS_BYTES = LDS_PHASE_BYTES + 16;

constexpr size_t SZ_H = (size_t)LP * DM * 4, SZ_XN = (size_t)LP * DM * 2, SZ_XNP = (size_t)PROWS * DM * 2;
constexpr size_t OFF_H = 0;
constexpr size_t OFF_XN = OFF_H + SZ_H;
constexpr size_t OFF_XNP = OFF_XN + SZ_XN;
constexpr size_t OFF_A1 = OFF_XN;
constexpr size_t SZ_A1 = (size_t)FN1 * 1024 * 2 * 128 * 2;
constexpr size_t OFF_HYOUT = OFF_A1 + SZ_A1;
constexpr size_t SZ_HYOUT = (size_t)1024 * LP * 2;
static_assert(OFF_HYOUT + SZ_HYOUT <= OFF_XNP + SZ_XNP, "alias overflow");
constexpr size_t OFF_WT = OFF_XNP + SZ_XNP;
constexpr size_t OFF_WEFF = OFF_WT + (size_t)NIN * DM * 2;
constexpr size_t OFF_WA = OFF_WEFF + (size_t)2048 * 2048 * 2;
constexpr size_t SZ_WBR = (size_t)2048 * 1024 * 2;
constexpr size_t OFF_WO = OFF_WA + 3 * SZ_WBR;
constexpr size_t OFF_HYIN = OFF_WO + (size_t)2048 * 2048 * 2;
constexpr size_t OFF_GATE = OFF_HYIN + (size_t)3072 * LP * 2;
constexpr size_t SZ_GATE = (size_t)LP * 1024 * 2;
constexpr size_t OFF_QKV = OFF_GATE + 3 * SZ_GATE;
constexpr size_t OFF_MERGE = OFF_QKV + (size_t)LP * 3072 * 2;
constexpr size_t OFF_ZT = OFF_MERGE + (size_t)LP * 6144 * 2;
constexpr size_t SZ_ZT = (size_t)2048 * PROWS * 2;
constexpr size_t OFF_M = OFF_ZT;
static_assert(SZ_XN <= SZ_ZT, "alias overflow");
constexpr size_t OFF_FA = OFF_ZT + SZ_ZT;
constexpr size_t OFF_FB = OFF_FA + (size_t)512 * 384 * 2;
constexpr size_t OFF_H3 = OFF_FB + (size_t)FN1 * 256 * 256 * 2;
constexpr size_t WS_END = OFF_H3 + (size_t)2 * L_TOK * 64 * 4;
constexpr size_t HS_HEO = 0, HS_Z2 = 131328, HS_G2 = HS_Z2 + 65792, HSW_STRIDE = HS_G2 + 65792;
constexpr size_t FILT_BYTES = (size_t)L_TOK * 2, HSD_STRIDE = 393728;
constexpr size_t OFF_BAR = WS_END + 256 * HSW_STRIDE;
constexpr size_t WS_END2 = OFF_BAR + 16384;
static_assert(HSD_STRIDE >= 12 * FILT_BYTES && HSD_STRIDE * 256 <= (size_t)NMAIN * DM * 4, "scratch overflow");

struct Params {
    const float* x; const float* meta; const float* norm_g; const float* w_in; const float* conv_w; const float* conv_b;
    const float* f_w1; const float* f_b1; const float* f_w2; const float* f_b2; const float* f_w3; const float* f_b3; const float* f_w4;
    const float* f_freq; const float* decay; const float* skip; const float* rpb; const float* meta_bias;
    const float* w_a; const float* w_b; const float* w_c; const float* w_out; const float* final_g;
    float* out; unsigned char* ws;
};

__device__ __forceinline__ int opaque_tid() { int t = threadIdx.x; asm volatile("" : "+v"(t)); return t; }
__device__ __forceinline__ float bf2f(bf16_t b) { return __uint_as_float(((unsigned)b) << 16); }
__device__ __forceinline__ bf16_t f2bf(float f) { unsigned u = __float_as_uint(f); u += 0x7FFFu + ((u >> 16) & 1u); return (bf16_t)(u >> 16); }
__device__ __forceinline__ unsigned cvt_pk_bf16(float lo, float hi) { unsigned r; asm volatile("v_cvt_pk_bf16_f32 %0, %1, %2" : "=v"(r) : "v"(lo), "v"(hi)); return r; }
__device__ __forceinline__ float lo_bf(unsigned u) { return __uint_as_float(u << 16); }
__device__ __forceinline__ float hi_bf(unsigned u) { return __uint_as_float(u & 0xffff0000u); }
__device__ __forceinline__ float silu_f(float v) { return v * __builtin_amdgcn_rcpf(1.0f + __expf(-v)); }
__device__ __forceinline__ float sigm_f(float v) { return __builtin_amdgcn_rcpf(1.0f + __expf(-v)); }
__device__ __forceinline__ float wave_sum(float v) {
#pragma unroll
    for (int o = 32; o >= 1; o >>= 1) v += __shfl_xor(v, o);
    return v;
}

namespace pg8 {
constexpr int BM = 256, BK = 64, HALF = 128, HTB = HALF * BK * 2, STAGE_BYTES = 8 * HTB;
__device__ __forceinline__ int lds_byte(int r, int c) { const int st = (r >> 4) * 2 + (c >> 5), rr = r & 15, cc = c & 31, ob = rr * 64 + cc * 2; return st * 1024 + (ob ^ (((ob >> 9) & 1) << 5)); }
__device__ __forceinline__ void stage_rc(int b, int& R, int& C) { const int st = b / 1024, sb = b % 1024, swz = sb ^ (((sb >> 9) & 1) << 5); R = (st >> 1) * 16 + swz / 64; C = (st & 1) * 32 + (swz % 64) / 2; }
__device__ __forceinline__ int perm32(int rho) { const int n = rho >> 4, i = rho & 15; return 8 * (i >> 2) + 4 * n + (i & 3); }

struct Unit { int pm, pn, aux; size_t offA, offB; };
struct Gemm { const char* base; int lda, ldb, nt, ksplit; long jumpA, jumpB; };

__device__ __forceinline__ void tile_map(int wgid, int nM, int nN, int& pm, int& pn) {
    const int nwg = nM * nN;
    { const int q = nwg / 8, r = nwg % 8, xcd = wgid % 8, off = wgid / 8; wgid = (xcd < r ? xcd * (q + 1) : r * (q + 1) + (xcd - r) * q) + off; }
    const int nig = 8 * nN, gid = wgid / nig, fm = gid * 8, gsz = (nM - fm) < 8 ? (nM - fm) : 8;
    pm = fm + ((wgid % nig) % gsz); pn = (wgid % nig) / gsz;
}

template <class Epi, class Sched>
__device__ __forceinline__ void gemm_phase(LAS unsigned char* lds, const Gemm g, const Sched& S, const Epi& E) {
    const int tid = opaque_tid(), wid = __builtin_amdgcn_readfirstlane(tid >> 6), lane = tid & 63, wr = wid >> 2, wc = wid & 3, fr = lane & 15, fq = lane >> 4;
    const int nt = g.nt;
    unsigned voffA[2], voffB[2];
#pragma unroll
    for (int i = 0; i < 2; ++i) { int R, C; stage_rc(tid * 16 + i * 8192, R, C); const int Rb = (R & ~31) + perm32(R & 31);
        voffA[i] = (unsigned)(R * g.lda + C) * 2u; voffB[i] = (unsigned)(Rb * g.ldb + C) * 2u; }
    const size_t kstep = (size_t)(BK * 2);
    const size_t hstepA = (size_t)HALF * g.lda * 2, hstepB = (size_t)HALF * g.ldb * 2;
    const unsigned ldsw = (unsigned)wid * 1024u;
    const int aoff = lds_byte(wr * 64 + fr, fq * 8), boff = lds_byte(wc * 32 + fr, fq * 8);
#define PG8_KA(p, t) ((p) + (size_t)(t) * kstep + ((t) >= g.ksplit ? g.jumpA : 0l))
#define PG8_KB(p, t) ((p) + (size_t)(t) * kstep + ((t) >= g.ksplit ? g.jumpB : 0l))
#define PG8_SA(b, h) (((b) * 2 + (h)) * HTB)
#define PG8_SB(b, h) ((4 + (b) * 2 + (h)) * HTB)
#define PG8_STAGE(bufoff, gbase, voff) do { _Pragma("unroll") for (int _i = 0; _i < 2; ++_i) \
        __builtin_amdgcn_global_load_lds((const unsigned*)((const char*)(gbase) + (voff)[_i]), (LAS unsigned*)(lds + (bufoff) + ldsw + _i * 8192), 16, 0, 0); } while (0)
#define PG8_LDA(dst, b, h) do { _Pragma("unroll") for (int m = 0; m < 4; ++m) _Pragma("unroll") for (int k = 0; k < 2; ++k) dst[m][k] = *(const LAS bf16x8*)(lds + PG8_SA(b, h) + aoff + m * 2048 + k * 1024); } while (0)
#define PG8_LDB(dst, b, h) do { _Pragma("unroll") for (int n = 0; n < 2; ++n) _Pragma("unroll") for (int k = 0; k < 2; ++k) dst[n][k] = *(const LAS bf16x8*)(lds + PG8_SB(b, h) + boff + n * 2048 + k * 1024); } while (0)
#define PG8_MMA(ai, bj, At, Bt) do { __builtin_amdgcn_s_setprio(1); _Pragma("unroll") for (int m = 0; m < 4; ++m) _Pragma("unroll") for (int n = 0; n < 2; ++n) _Pragma("unroll") for (int k = 0; k < 2; ++k) \
        acc[ai][bj][m][n] = __builtin_amdgcn_mfma_f32_16x16x32_bf16(Bt[n][k], At[m][k], acc[ai][bj][m][n], 0, 0, 0); __builtin_amdgcn_s_setprio(0); } while (0)
#define PG8_WAIT_V(n) asm volatile("s_waitcnt vmcnt(" #n ")" ::: "memory")
#define PG8_WAIT_L(n) asm volatile("s_waitcnt lgkmcnt(" #n ")" ::: "memory")
#define PG8_BAR __builtin_amdgcn_s_barrier()
#define PG8_SCHED __builtin_amdgcn_sched_barrier(0)
    Unit cur, nxt; int ui = 0;
    if (!S.next(0, cur)) return;
    f32x4 acc[2][2][4][2];
#pragma unroll
    for (int a = 0; a < 2; ++a)
#pragma unroll
        for (int b = 0; b < 2; ++b)
#pragma unroll
            for (int m = 0; m < 4; ++m)
#pragma unroll
                for (int n = 0; n < 2; ++n) acc[a][b][m][n] = (f32x4){0.f, 0.f, 0.f, 0.f};
    bf16x8 At[4][2], B0[2][2], B1[2][2];
    const char* cA = g.base + cur.offA; const char* cB = g.base + cur.offB;
    PG8_STAGE(PG8_SB(0, 0), cB, voffB); PG8_STAGE(PG8_SA(0, 0), cA, voffA); PG8_STAGE(PG8_SB(0, 1), cB + hstepB, voffB); PG8_STAGE(PG8_SA(0, 1), cA + hstepA, voffA);
    if (wr == 1) PG8_BAR;
    PG8_WAIT_V(4); PG8_BAR;
    PG8_STAGE(PG8_SB(1, 0), PG8_KB(cB, 1), voffB); PG8_STAGE(PG8_SA(1, 0), PG8_KA(cA, 1), voffA); PG8_STAGE(PG8_SB(1, 1), PG8_KB(cB, 1) + hstepB, voffB);
    PG8_WAIT_V(6); PG8_BAR;
    for (;;) {
        const bool has_next = S.next(ui + 1, nxt);
        const char* nA = has_next ? g.base + nxt.offA : cA; const char* nB = has_next ? g.base + nxt.offB : cB;
        for (int t = 0; t < nt; t += 2) {
            const bool last = (t == nt - 2);
            const char* a1 = PG8_KA(cA, t + 1);
            const char* a2 = last ? nA : PG8_KA(cA, t + 2); const char* b2 = last ? nB : PG8_KB(cB, t + 2);
            const char* a3 = last ? PG8_KA(nA, 1) : PG8_KA(cA, t + 3); const char* b3 = last ? PG8_KB(nB, 1) : PG8_KB(cB, t + 3);
            PG8_LDB(B0, 0, 0); PG8_SCHED; PG8_LDA(At, 0, 0); PG8_STAGE(PG8_SA(1, 1), a1 + hstepA, voffA);
            PG8_WAIT_L(8); PG8_BAR; PG8_WAIT_L(0); PG8_MMA(0, 0, At, B0); PG8_BAR; PG8_SCHED;
            PG8_LDB(B1, 0, 1); PG8_STAGE(PG8_SB(0, 0), b2, voffB);
            PG8_BAR; PG8_WAIT_L(0); PG8_MMA(0, 1, At, B1); PG8_BAR;
            PG8_LDA(At, 0, 1); PG8_STAGE(PG8_SA(0, 0), a2, voffA);
            PG8_BAR; PG8_WAIT_L(0); PG8_MMA(1, 0, At, B0); PG8_BAR; PG8_SCHED;
            PG8_STAGE(PG8_SB(0, 1), b2 + hstepB, voffB);
            PG8_WAIT_V(6); PG8_BAR; PG8_MMA(1, 1, At, B1); PG8_BAR;
            PG8_LDB(B0, 1, 0); PG8_SCHED; PG8_LDA(At, 1, 0); PG8_STAGE(PG8_SA(0, 1), a2 + hstepA, voffA);
            PG8_WAIT_L(8); PG8_BAR; PG8_WAIT_L(0); PG8_MMA(0, 0, At, B0); PG8_BAR; PG8_SCHED;
            PG8_LDB(B1, 1, 1); PG8_STAGE(PG8_SB(1, 0), b3, voffB);
            PG8_BAR; PG8_WAIT_L(0); PG8_MMA(0, 1, At, B1); PG8_BAR;
            PG8_LDA(At, 1, 1); PG8_STAGE(PG8_SA(1, 0), a3, voffA);
            PG8_BAR; PG8_WAIT_L(0); PG8_MMA(1, 0, At, B0); PG8_BAR; PG8_SCHED;
            PG8_STAGE(PG8_SB(1, 1), b3 + hstepB, voffB);
            PG8_WAIT_V(6); PG8_BAR; PG8_MMA(1, 1, At, B1); PG8_BAR;
        }
        E(acc, cur, wr, wc, fr, fq);
        if (!has_next) break;
        { const float zf = E.keep(cur) ? 1.0f : 0.0f;
#pragma unroll
        for (int a = 0; a < 2; ++a)
#pragma unroll
            for (int b = 0; b < 2; ++b)
#pragma unroll
                for (int m = 0; m < 4; ++m)
#pragma unroll
                    for (int n = 0; n < 2; ++n) acc[a][b][m][n] *= zf; }
        cur = nxt; cA = nA; cB = nB; ++ui;
    }
    PG8_WAIT_V(0);
    if (wr == 0) PG8_BAR;
    PG8_BAR;
#undef PG8_KA
#undef PG8_KB
#undef PG8_SA
#undef PG8_SB
#undef PG8_STAGE
#undef PG8_LDA
#undef PG8_LDB
#undef PG8_MMA
#undef PG8_WAIT_V
#undef PG8_WAIT_L
#undef PG8_BAR
#undef PG8_SCHED
}
}
using pg8::Unit; using pg8::Gemm;
#define ACC_T f32x4 (&acc)[2][2][4][2]

enum { K_TOK = 0, K_HYIN = 1, K_F0 = 2, K_FNA = 3, K_FNB = 4, K_BR = 5, K_OUT = 6, K_IN = 7 };
struct SchedAny {
    int kind, G, c;
    __device__ __forceinline__ bool next(int i, Unit& u) const {
        const long Lx = (long)i * G + c;
        switch (kind) {
        case K_IN: {
            if (Lx < 3120) { int pn; pg8::tile_map((int)Lx, 65, 48, u.pm, pn); u.pn = pn < 4 ? 12 + pn : 16 + pn; u.aux = K_TOK;
                u.offA = OFF_XN + (size_t)u.pm * 256 * DM * 2; u.offB = OFF_WT + (size_t)u.pn * 256 * DM * 2; return true; }
            if (Lx < 3900) { pg8::tile_map((int)Lx - 3120, 12, 65, u.pm, u.pn); u.aux = K_HYIN;
                u.offA = OFF_WT + (size_t)u.pm * 256 * DM * 2; u.offB = OFF_XN + (size_t)u.pn * 256 * DM * 2; return true; }
            if (Lx < 4200) { pg8::tile_map((int)Lx - 3900, 4, 75, u.pm, u.pn); u.aux = K_F0;
                u.offA = OFF_WEFF + (size_t)u.pm * 256 * DM * 2; u.offB = OFF_XNP + (size_t)u.pn * 256 * DM * 2; return true; }
            return false; }
        case K_TOK: {
            if (Lx >= 65l * 48) return false; int pn; pg8::tile_map((int)Lx, 65, 48, u.pm, pn); u.pn = pn < 4 ? 12 + pn : 16 + pn; u.aux = 0;
            u.offA = OFF_XN + (size_t)u.pm * 256 * DM * 2; u.offB = OFF_WT + (size_t)u.pn * 256 * DM * 2; return true; }
        case K_HYIN: {
            if (Lx >= 12l * 65) return false; pg8::tile_map((int)Lx, 12, 65, u.pm, u.pn); u.aux = 0;
            u.offA = OFF_WT + (size_t)u.pm * 256 * DM * 2; u.offB = OFF_XN + (size_t)u.pn * 256 * DM * 2; return true; }
        case K_F0: {
            if (Lx >= 8l * 75) return false; pg8::tile_map((int)Lx, 8, 75, u.pm, u.pn); u.aux = 0;
            u.offA = OFF_WEFF + (size_t)u.pm * 256 * DM * 2; u.offB = OFF_XNP + (size_t)u.pn * 256 * DM * 2; return true; }
        case K_FNA: {
            if (Lx >= 2l * 400) return false; pg8::tile_map((int)Lx, 2, 400, u.pm, u.pn); u.aux = 0;
            u.offA = OFF_FA + (size_t)u.pm * 256 * 384 * 2; u.offB = OFF_ZT + (size_t)u.pn * 256 * FN1P * 2; return true; }
        case K_FNB: {
            if (Lx >= 164l * 4) return false; u.aux = (int)(Lx >> 2); u.pm = 0; u.pn = (int)(Lx & 3);
            u.offA = OFF_FB + (size_t)u.aux * 256 * 256 * 2; u.offB = OFF_A1 + (size_t)u.aux * 1024 * 256 * 2 + (size_t)u.pn * 256 * 256 * 2; return true; }
        case K_BR: {
            const int T = (i / 3) * G + c; if (T >= 64 * 8) return false; const int br = i % 3; pg8::tile_map(T, 64, 8, u.pm, u.pn); u.aux = br;
            u.offA = OFF_GATE + (size_t)br * SZ_GATE + (size_t)u.pm * 256 * 1024 * 2; u.offB = OFF_WA + (size_t)br * SZ_WBR + (size_t)u.pn * 256 * 1024 * 2; return true; }
        default: {
            if (Lx >= 64l * 8) return false; pg8::tile_map((int)Lx, 64, 8, u.pm, u.pn); u.aux = 0;
            u.offA = OFF_M + (size_t)u.pm * 256 * DM * 2; u.offB = OFF_WO + (size_t)u.pn * 256 * DM * 2; return true; }
        }
    }
};
#define ROWFENCE asm volatile("" ::: "memory")
#define HARDFENCE do { asm volatile("" ::: "memory"); __builtin_amdgcn_sched_barrier(0); } while (0)
struct EpiAny {
    int kind; unsigned char* ws; int layer; const float* xin; const float* metain;
    __device__ __forceinline__ bool keep(const Unit&) const { return false; }
    __device__ __forceinline__ void operator()(ACC_T, const Unit& u, int wr, int wc, int fr, int fq) const {
        const int rl0 = wr * 64 + fr, cl0 = wc * 32 + 8 * fq;
        const int ek = kind == K_IN ? u.aux : kind;
        if (ek == K_TOK) {
            const int t = u.pn; unsigned char* dst; unsigned ld; int c0, act;
            if (t < 16)      { dst = ws + OFF_GATE;               ld = 1024; c0 = (t - 12) * 256; act = 1; }
            else if (t < 24) { dst = ws + OFF_GATE + SZ_GATE;     ld = 1024; c0 = (t - 20) * 256; act = 1; }
            else if (t < 36) { dst = ws + OFF_QKV;                ld = 3072; c0 = (t - 24) * 256; act = 0; }
            else if (t < 40) { dst = ws + OFF_GATE + 2 * SZ_GATE; ld = 1024; c0 = (t - 36) * 256; act = 1; }
            else             { dst = ws + OFF_MERGE;              ld = 6144; c0 = (t - 40) * 256; act = 2; }
#pragma unroll
            for (int ai = 0; ai < 2; ++ai)
#pragma unroll
                for (int m = 0; m < 4; ++m) { const unsigned row = (unsigned)(u.pm * 256 + ai * 128 + m * 16 + rl0);
#pragma unroll
                    for (int bj = 0; bj < 2; ++bj) { const unsigned off = (row * ld + (unsigned)(c0 + bj * 128 + cl0)) * 2u; f32x4 v0 = acc[ai][bj][m][0], v1 = acc[ai][bj][m][1];
                        if (act == 1) {
#pragma unroll
                            for (int j = 0; j < 4; ++j) { v0[j] = silu_f(v0[j]); v1[j] = silu_f(v1[j]); } }
                        else if (act == 2) {
#pragma unroll
                            for (int j = 0; j < 4; ++j) { v0[j] = sigm_f(v0[j]); v1[j] = sigm_f(v1[j]); } }
                        u32x4 w; w.x = cvt_pk_bf16(v0[0], v0[1]); w.y = cvt_pk_bf16(v0[2], v0[3]); w.z = cvt_pk_bf16(v1[0], v1[1]); w.w = cvt_pk_bf16(v1[2], v1[3]);
                        *(u32x4*)(dst + off) = w; }
                    ROWFENCE; }
        } else if (ek == K_HYIN) {
            unsigned char* dst = ws + OFF_HYIN; const unsigned ld = LP;
#pragma unroll
            for (int ai = 0; ai < 2; ++ai)
#pragma unroll
                for (int m = 0; m < 4; ++m) { const unsigned row = (unsigned)(u.pm * 256 + ai * 128 + m * 16 + rl0);
#pragma unroll
                    for (int bj = 0; bj < 2; ++bj) { const unsigned off = (row * ld + (unsigned)(u.pn * 256 + bj * 128 + cl0)) * 2u; const f32x4 v0 = acc[ai][bj][m][0], v1 = acc[ai][bj][m][1];
                        u32x4 w; w.x = cvt_pk_bf16(v0[0], v0[1]); w.y = cvt_pk_bf16(v0[2], v0[3]); w.z = cvt_pk_bf16(v1[0], v1[1]); w.w = cvt_pk_bf16(v1[2], v1[3]);
                        *(u32x4*)(dst + off) = w; }
                    ROWFENCE; }
        } else if (ek == K_F0) {
            int rlx = rl0, clx = cl0; asm volatile("" : "+v"(rlx), "+v"(clx));
            unsigned char* dst = ws + OFF_ZT; const int g = u.pm; const unsigned colb0 = (unsigned)(u.pn * 256 + clx) * 2u;
#pragma unroll
            for (int ai = 0; ai < 2; ++ai)
#pragma unroll
                for (int m = 0; m < 4; ++m) { const int j = ai * 128 + m * 16 + rlx; const int part = j <= 128 ? 0 : 1; const int cp = j - 128 * part;
                    const unsigned o1 = (unsigned)(part * 1024 + g * 256 + cp) * (unsigned)(PROWS * 2) + colb0;
                    const bool mir = cp >= 1 && cp <= 127; const bool zim = part == 0 && !mir;
                    const unsigned o2 = (unsigned)((mir ? part : 1) * 1024 + g * 256 + (mir ? 256 - cp : cp)) * (unsigned)(PROWS * 2) + colb0;
                    const unsigned sgn = part == 1 ? 0x80008000u : 0u, msk = zim ? 0u : 0xffffffffu;
#pragma unroll
                    for (int bj = 0; bj < 2; ++bj) { const f32x4 v0 = acc[ai][bj][m][0], v1 = acc[ai][bj][m][1];
                        u32x4 w; w.x = cvt_pk_bf16(v0[0], v0[1]); w.y = cvt_pk_bf16(v0[2], v0[3]); w.z = cvt_pk_bf16(v1[0], v1[1]); w.w = cvt_pk_bf16(v1[2], v1[3]);
                        *(u32x4*)(dst + o1 + bj * 256) = w;
                        u32x4 wm; wm.x = (w.x ^ sgn) & msk; wm.y = (w.y ^ sgn) & msk; wm.z = (w.z ^ sgn) & msk; wm.w = (w.w ^ sgn) & msk;
                        *(u32x4*)(dst + o2 + bj * 256) = wm; }
                    ROWFENCE; }
        } else if (ek == K_FNA) {
            unsigned char* dst = ws + OFF_A1;
#pragma unroll
            for (int ai = 0; ai < 2; ++ai)
#pragma unroll
                for (int m = 0; m < 4; ++m) { const int k1 = ai * 128 + m * 16 + rl0;
                    if (k1 < FN1) {
#pragma unroll
                        for (int bj = 0; bj < 2; ++bj)
#pragma unroll
                            for (int n = 0; n < 2; ++n) { const int col = u.pn * 256 + bj * 128 + cl0 + 4 * n; const int ch = col / FN2, l2 = col - ch * FN2; const f32x4 v = acc[ai][bj][m][n];
                                u32x2 w; w.x = cvt_pk_bf16(v[0], v[1]); w.y = cvt_pk_bf16(v[2], v[3]);
                                *(u32x2*)(dst + ((unsigned)((k1 * 1024 + ch) * 2 + u.pm) * 128u + (unsigned)l2) * 2u) = w; } }
                    ROWFENCE; }
        } else if (ek == K_FNB) {
            unsigned char* dst = ws + OFF_GATE + SZ_GATE; const float scale = 1.0f / sqrtf((float)L_TOK * 256.0f);
#pragma unroll
            for (int ai = 0; ai < 2; ++ai)
#pragma unroll
                for (int m = 0; m < 4; ++m) { const int k2 = ai * 128 + m * 16 + rl0;
                    if (k2 < FN2) { const unsigned row = (unsigned)(u.aux + FN1 * k2);
#pragma unroll
                        for (int bj = 0; bj < 2; ++bj) { const unsigned off = (row * 1024u + (unsigned)(u.pn * 256 + bj * 128 + cl0)) * 2u; const u32x4 g = *(const u32x4*)(dst + off);
                            const f32x4 v0 = acc[ai][bj][m][0] * scale, v1 = acc[ai][bj][m][1] * scale;
                            u32x4 w; w.x = cvt_pk_bf16(v0[0] * lo_bf(g.x), v0[1] * hi_bf(g.x)); w.y = cvt_pk_bf16(v0[2] * lo_bf(g.y), v0[3] * hi_bf(g.y));
                            w.z = cvt_pk_bf16(v1[0] * lo_bf(g.z), v1[1] * hi_bf(g.z)); w.w = cvt_pk_bf16(v1[2] * lo_bf(g.w), v1[3] * hi_bf(g.w));
                            *(u32x4*)(dst + off) = w; } }
                    ROWFENCE; }
        } else {
            unsigned char* dst = ws + OFF_H;
#pragma unroll
            for (int ai = 0; ai < 2; ++ai) { f32x4 oq[4][2][2];
#pragma unroll
                for (int m = 0; m < 4; ++m) { const unsigned row = (unsigned)(u.pm * 256 + ai * 128 + m * 16 + rl0);
                    const float* srow = layer == 0 ? (row < (unsigned)NMETA ? metain + (size_t)row * DM : xin + (size_t)(row - NMETA) * DM) : (const float*)(dst + (size_t)row * DM * 4);
#pragma unroll
                    for (int bj = 0; bj < 2; ++bj) { const unsigned col = (unsigned)(u.pn * 256 + bj * 128 + cl0); oq[m][bj][0] = *(const f32x4*)(srow + col); oq[m][bj][1] = *(const f32x4*)(srow + col + 4); } }
#pragma unroll
                for (int m = 0; m < 4; ++m) { const unsigned row = (unsigned)(u.pm * 256 + ai * 128 + m * 16 + rl0);
#pragma unroll
                    for (int bj = 0; bj < 2; ++bj) { const unsigned off = (row * (unsigned)DM + (unsigned)(u.pn * 256 + bj * 128 + cl0)) * 4u;
                        *(f32x4*)(dst + off) = oq[m][bj][0] + acc[ai][bj][m][0]; *(f32x4*)(dst + off + 16) = oq[m][bj][1] + acc[ai][bj][m][1]; } }
                ROWFENCE; }
        }
    }
};

struct EpiBr {
    unsigned char* ws;
    __device__ __forceinline__ bool keep(const Unit& u) const { return u.aux < 2; }
    __device__ __forceinline__ void operator()(ACC_T, const Unit& u, int wr, int wc, int fr, int fq) const {
        const int rl0 = wr * 64 + fr, cl0 = wc * 32 + 8 * fq;
            unsigned char* dst = ws + OFF_M; const unsigned char* mg = ws + OFF_MERGE; const int br = u.aux;
#pragma unroll
            for (int ai = 0; ai < 2; ++ai)
#pragma unroll
              for (int mh = 0; mh < 4; mh += 2) { u32x4 gn[2][2], gd[2][2];
#pragma unroll
                for (int mm = 0; mm < 2; ++mm) { const unsigned row = (unsigned)(u.pm * 256 + ai * 128 + (mh + mm) * 16 + rl0);
#pragma unroll
                    for (int bj = 0; bj < 2; ++bj) { const unsigned col = (unsigned)(u.pn * 256 + bj * 128 + cl0);
                        gn[mm][bj] = *(const u32x4*)(mg + (row * 6144u + (unsigned)br * 2048u + col) * 2u);
                        if (br < 2) gd[mm][bj] = *(const u32x4*)(mg + (row * 6144u + (unsigned)(br + 1) * 2048u + col) * 2u); else gd[mm][bj] = (u32x4){0x3f803f80u, 0x3f803f80u, 0x3f803f80u, 0x3f803f80u}; } }
#pragma unroll
                for (int mm = 0; mm < 2; ++mm) { const int m = mh + mm; const unsigned row = (unsigned)(u.pm * 256 + ai * 128 + m * 16 + rl0);
#pragma unroll
                    for (int bj = 0; bj < 2; ++bj) { const u32x4 g = gn[mm][bj], d = gd[mm][bj];
                        const float s0 = lo_bf(g.x) * __builtin_amdgcn_rcpf(fmaxf(lo_bf(d.x), 1e-30f)), s1 = hi_bf(g.x) * __builtin_amdgcn_rcpf(fmaxf(hi_bf(d.x), 1e-30f));
                        const float s2 = lo_bf(g.y) * __builtin_amdgcn_rcpf(fmaxf(lo_bf(d.y), 1e-30f)), s3 = hi_bf(g.y) * __builtin_amdgcn_rcpf(fmaxf(hi_bf(d.y), 1e-30f));
                        const float s4 = lo_bf(g.z) * __builtin_amdgcn_rcpf(fmaxf(lo_bf(d.z), 1e-30f)), s5 = hi_bf(g.z) * __builtin_amdgcn_rcpf(fmaxf(hi_bf(d.z), 1e-30f));
                        const float s6 = lo_bf(g.w) * __builtin_amdgcn_rcpf(fmaxf(lo_bf(d.w), 1e-30f)), s7 = hi_bf(g.w) * __builtin_amdgcn_rcpf(fmaxf(hi_bf(d.w), 1e-30f));
                        f32x4 v0 = acc[ai][bj][m][0], v1 = acc[ai][bj][m][1];
                        v0[0] *= s0; v0[1] *= s1; v0[2] *= s2; v0[3] *= s3; v1[0] *= s4; v1[1] *= s5; v1[2] *= s6; v1[3] *= s7;
                        acc[ai][bj][m][0] = v0; acc[ai][bj][m][1] = v1;
                        if (br == 2) { const unsigned col = (unsigned)(u.pn * 256 + bj * 128 + cl0);
                            u32x4 w; w.x = cvt_pk_bf16(v0[0], v0[1]); w.y = cvt_pk_bf16(v0[2], v0[3]); w.z = cvt_pk_bf16(v1[0], v1[1]); w.w = cvt_pk_bf16(v1[2], v1[3]);
                            *(u32x4*)(dst + (row * (unsigned)DM + col) * 2u) = w; } } }
                ROWFENCE; }
    }
};

__device__ void phase_prep0(const Params& p, unsigned char* smem) {
    const int tid = opaque_tid(), bid = blockIdx.x, G = gridDim.x;
    const size_t gtid = (size_t)bid * NTHREADS + tid, gstride = (size_t)G * NTHREADS;
    { bf16_t* fa = (bf16_t*)(p.ws + OFF_FA);
      for (size_t i = gtid; i < (size_t)512 * 384; i += gstride) { const int row = (int)(i / 384), col = (int)(i % 384); const int po = row >> 8, k1 = row & 255, pi = col / 192, l1 = col % 192; float v = 0.f;
          if (k1 < FN1 && l1 < FN1) { const int r = (k1 * l1) % FN1; const float a = (float)r / (float)FN1; const float cs = __builtin_amdgcn_cosf(a), sn = __builtin_amdgcn_sinf(a);
              v = (po == 0) ? (pi == 0 ? cs : sn) : (pi == 0 ? -sn : cs); }
          fa[i] = f2bf(v); } }
    { bf16_t* fb = (bf16_t*)(p.ws + OFF_FB);
      for (size_t i = gtid; i < (size_t)FN1 * 65536; i += gstride) { const int k1 = (int)(i >> 16), k2 = (int)((i >> 8) & 255), kk = (int)(i & 255), part = kk >> 7, l2 = kk & 127; float v = 0.f;
          if (k2 < FN2 && l2 < FN2) { const int lp = k1 + FN1 * k2; const int r = (l2 * lp) % L_TOK; const float a = (float)r / (float)L_TOK; v = part == 0 ? __builtin_amdgcn_cosf(a) : __builtin_amdgcn_sinf(a); }
          fb[i] = f2bf(v); } }
    { float* w1s = (float*)smem;
      float* w2s = w1s + 33 * 64;
      float* w3s = w2s + 64 * 64;
      const int lane = tid & 63, wv = tid >> 6;
      for (int layer = 0; layer < 2; ++layer) {
          __syncthreads();
          for (int i = tid; i < 33 * 64; i += NTHREADS) w1s[i] = p.f_w1[layer * 33 * 64 + i];
          for (int i = tid; i < 64 * 64; i += NTHREADS) { w2s[i] = p.f_w2[layer * 4096 + i]; w3s[i] = p.f_w3[layer * 4096 + i]; }
          __syncthreads();
          const float b1 = p.f_b1[layer * 64 + lane], b2 = p.f_b2[layer * 64 + lane], b3 = p.f_b3[layer * 64 + lane], fr = p.f_freq[layer * 64 + lane];
          bf16_t* h3 = (bf16_t*)(p.ws + OFF_H3) + (size_t)layer * L_TOK * 64;
          constexpr float INV2PI = 0.15915494309189535f;
          for (int lag0 = bid * 8 + wv; lag0 < L_TOK; lag0 += G * 16) {
              const int lagA = lag0, lagB = lag0 + G * 8; const bool hasB = lagB < L_TOK; const int lagBc = hasB ? lagB : lagA;
              float zA = 0.f, zB = 0.f;
              if (lane == 0) { zA = (float)lagA / (float)(L_TOK - 1); zB = (float)lagBc / (float)(L_TOK - 1); }
              else if (lane < 33) { const int j = (lane - 1) & 15; const float f = 1e-4f + (float)j * ((15.0f - 1e-4f) / 15.0f);
                  const float rA = f * ((float)lagA / (float)L_TOK), rB = f * ((float)lagBc / (float)L_TOK);
                  zA = lane < 17 ? __builtin_amdgcn_cosf(rA) : -__builtin_amdgcn_sinf(rA); zB = lane < 17 ? __builtin_amdgcn_cosf(rB) : -__builtin_amdgcn_sinf(rB); }
              float aA = b1, aB = b1;
#pragma unroll 3
              for (int i = 0; i < 33; ++i) { const float wgt = w1s[i * 64 + lane]; aA += __int_as_float(__builtin_amdgcn_readlane(__float_as_int(zA), i)) * wgt; aB += __int_as_float(__builtin_amdgcn_readlane(__float_as_int(zB), i)) * wgt; }
              const float h1A = __builtin_amdgcn_sinf(fr * aA * INV2PI), h1B = __builtin_amdgcn_sinf(fr * aB * INV2PI);
              aA = b2; aB = b2;
#pragma unroll 8
              for (int i = 0; i < 64; ++i) { const float wgt = w2s[i * 64 + lane]; aA += __int_as_float(__builtin_amdgcn_readlane(__float_as_int(h1A), i)) * wgt; aB += __int_as_float(__builtin_amdgcn_readlane(__float_as_int(h1B), i)) * wgt; }
              const float h2A = __builtin_amdgcn_sinf(fr * aA * INV2PI), h2B = __builtin_amdgcn_sinf(fr * aB * INV2PI);
              aA = b3; aB = b3;
#pragma unroll 8
              for (int i = 0; i < 64; ++i) { const float wgt = w3s[i * 64 + lane]; aA += __int_as_float(__builtin_amdgcn_readlane(__float_as_int(h2A), i)) * wgt; aB += __int_as_float(__builtin_amdgcn_readlane(__float_as_int(h2B), i)) * wgt; }
              h3[(size_t)lagA * 64 + lane] = f2bf(__builtin_amdgcn_sinf(fr * aA * INV2PI));
              if (hasB) h3[(size_t)lagB * 64 + lane] = f2bf(__builtin_amdgcn_sinf(fr * aB * INV2PI));
          }
      }
      __syncthreads(); }
}

__device__ void convert_matrix(const float* __restrict__ src, int K, int N, bf16_t* __restrict__ dst, int kshift  , int total, float* tile  ) {
    const int tid = opaque_tid(), G = gridDim.x; const int kl0 = tid >> 4, n4 = (tid & 15) * 4, nl = tid >> 3, k8 = (tid & 7) * 8;
    f32x4 pv0 = (f32x4){0.f, 0.f, 0.f, 0.f}, pv1 = pv0;
    int t = blockIdx.x;
    if (t < total) { const int kt = t & ((1 << kshift) - 1), nt_ = t >> kshift; const float* s = src + (size_t)(kt * 64 + kl0) * N + nt_ * 64 + n4; pv0 = *(const f32x4*)s; pv1 = *(const f32x4*)(s + (size_t)32 * N); }
    int buf = 0;
    for (; t < total; t += G) { float* tl = tile + buf * (64 * 65); const int kt = t & ((1 << kshift) - 1), nt_ = t >> kshift;
        tl[kl0 * 65 + n4] = pv0[0]; tl[kl0 * 65 + n4 + 1] = pv0[1]; tl[kl0 * 65 + n4 + 2] = pv0[2]; tl[kl0 * 65 + n4 + 3] = pv0[3];
        tl[(32 + kl0) * 65 + n4] = pv1[0]; tl[(32 + kl0) * 65 + n4 + 1] = pv1[1]; tl[(32 + kl0) * 65 + n4 + 2] = pv1[2]; tl[(32 + kl0) * 65 + n4 + 3] = pv1[3];
        { const int tn = t + G; if (tn < total) { const int kt2 = tn & ((1 << kshift) - 1), nt2 = tn >> kshift; const float* s = src + (size_t)(kt2 * 64 + kl0) * N + nt2 * 64 + n4; pv0 = *(const f32x4*)s; pv1 = *(const f32x4*)(s + (size_t)32 * N); } }
        __syncthreads();
        u32x4 w; w.x = cvt_pk_bf16(tl[(k8 + 0) * 65 + nl], tl[(k8 + 1) * 65 + nl]); w.y = cvt_pk_bf16(tl[(k8 + 2) * 65 + nl], tl[(k8 + 3) * 65 + nl]);
        w.z = cvt_pk_bf16(tl[(k8 + 4) * 65 + nl], tl[(k8 + 5) * 65 + nl]); w.w = cvt_pk_bf16(tl[(k8 + 6) * 65 + nl], tl[(k8 + 7) * 65 + nl]);
        *(u32x4*)(dst + (size_t)(nt_ * 64 + nl) * K + kt * 64 + k8) = w;
        buf ^= 1; }
    __syncthreads();
}

__device__ void phase_p1(const Params& p, int layer, unsigned char* smem) {
    const int tid = opaque_tid(), bid = blockIdx.x, G = gridDim.x;
    float* tile = (float*)smem;
    { const float* win = p.w_in + (size_t)layer * DM * NIN;
      convert_matrix(win, DM, NIN, (bf16_t*)(p.ws + OFF_WT), 5, 32 * 256, tile);
      for (int br = 0; br < 3; ++br) { const float* wsrc = (br == 0 ? p.w_a : br == 1 ? p.w_b : p.w_c) + (size_t)layer * 1024 * DM;
          convert_matrix(wsrc, 1024, DM, (bf16_t*)(p.ws + OFF_WA + br * SZ_WBR), 4, 16 * 32, tile); }
      const float* wo = p.w_out + (size_t)layer * DM * DM;
      convert_matrix(wo, DM, DM, (bf16_t*)(p.ws + OFF_WO), 5, 32 * 32, tile);
      __syncthreads(); }
    { float* tileT = (float*)smem;
      float* ctab = tileT + 256 * 32;
      float* stab = ctab + 256;
      const float* win = p.w_in + (size_t)layer * DM * NIN;
      for (int t = bid; t < 256; t += G) { const int g = t >> 6, k0 = (t & 63) * 32;
          __syncthreads();
          if (tid < 256) { const float a = 2.0f * (float)tid / 256.0f; ctab[tid] = cospif(a); stab[tid] = sinpif(a); }
#pragma unroll
          for (int ps = 0; ps < 4; ++ps) { const int idx = ps * NTHREADS + tid; const int kl = idx >> 6, c4 = (idx & 63) * 4;
              const f32x4 v = *(const f32x4*)(win + (size_t)(k0 + kl) * NIN + 4096 + g * 256 + c4);
              tileT[(c4 + 0) * 32 + kl] = v[0]; tileT[(c4 + 1) * 32 + kl] = v[1]; tileT[(c4 + 2) * 32 + kl] = v[2]; tileT[(c4 + 3) * 32 + kl] = v[3]; }
          __syncthreads();
          const int jrow = tid & 255, kh = tid >> 8; const int part = jrow <= 128 ? 0 : 1; const int cp = part == 0 ? jrow : jrow - 128;
          float acc[16];
#pragma unroll
          for (int k = 0; k < 16; ++k) acc[k] = 0.f;
          for (int c = 0; c < 256; ++c) { const int r = (c * cp) & 255; const float tw = part == 0 ? ctab[r] : -stab[r];
#pragma unroll
              for (int k4 = 0; k4 < 4; ++k4) { const f32x4 v = *(const f32x4*)(tileT + c * 32 + kh * 16 + k4 * 4); acc[k4 * 4 + 0] += v[0] * tw; acc[k4 * 4 + 1] += v[1] * tw; acc[k4 * 4 + 2] += v[2] * tw; acc[k4 * 4 + 3] += v[3] * tw; } }
          bf16_t* dst = (bf16_t*)(p.ws + OFF_WEFF) + (size_t)(g * 256 + jrow) * DM + k0 + kh * 16;
#pragma unroll
          for (int k8 = 0; k8 < 2; ++k8) { u32x4 w; w.x = cvt_pk_bf16(acc[k8 * 8 + 0], acc[k8 * 8 + 1]); w.y = cvt_pk_bf16(acc[k8 * 8 + 2], acc[k8 * 8 + 3]); w.z = cvt_pk_bf16(acc[k8 * 8 + 4], acc[k8 * 8 + 5]); w.w = cvt_pk_bf16(acc[k8 * 8 + 6], acc[k8 * 8 + 7]);
              *(u32x4*)(dst + k8 * 8) = w; } }
      __syncthreads(); }
    { const int lane = tid & 63, wv = tid >> 6; const float* h = (const float*)(p.ws + OFF_H); const float* gam = p.norm_g + layer * DM;
      bf16_t* xn = (bf16_t*)(p.ws + OFF_XN); bf16_t* xnp = (bf16_t*)(p.ws + OFF_XNP);
      for (int l = bid * 8 + wv; l < LP; l += G * 8) {
          if (l < L_TOK) { const f32x4* row = (const f32x4*)(layer == 0 ? (l < NMETA ? p.meta + (size_t)l * DM : p.x + (size_t)(l - NMETA) * DM) : h + (size_t)l * DM); f32x4 v[8]; float ss = 0.f;
#pragma unroll
              for (int i = 0; i < 8; ++i) { v[i] = row[i * 64 + lane]; ss += v[i][0] * v[i][0] + v[i][1] * v[i][1] + v[i][2] * v[i][2] + v[i][3] * v[i][3]; }
              ss = wave_sum(ss); const float inv = rsqrtf(ss * (1.0f / DM) + 1e-6f);
              const int l1 = l / FN2, l2 = l - l1 * FN2; const size_t pr = (size_t)l2 * FN1P + l1;
#pragma unroll
              for (int i = 0; i < 8; ++i) { const f32x4 gg = ((const f32x4*)gam)[i * 64 + lane]; u32x2 w; w.x = cvt_pk_bf16(v[i][0] * inv * gg[0], v[i][1] * inv * gg[1]); w.y = cvt_pk_bf16(v[i][2] * inv * gg[2], v[i][3] * inv * gg[3]);
                  *(u32x2*)(xn + (size_t)l * DM + (i * 64 + lane) * 4) = w; *(u32x2*)(xnp + pr * DM + (i * 64 + lane) * 4) = w; } }
          else { const u32x2 z = (u32x2){0u, 0u};
#pragma unroll
              for (int i = 0; i < 8; ++i) *(u32x2*)(xn + (size_t)l * DM + (i * 64 + lane) * 4) = z; } }
      for (int idx = bid * 8 + wv; idx < FN2 * (FN1P - FN1); idx += G * 8) { const int l2 = idx / (FN1P - FN1), l1 = FN1 + idx % (FN1P - FN1); const size_t pr = (size_t)l2 * FN1P + l1; const u32x2 z = (u32x2){0u, 0u};
#pragma unroll
          for (int i = 0; i < 8; ++i) *(u32x2*)(xnp + pr * DM + (i * 64 + lane) * 4) = z; } }
}

__device__ void na_phase(const Params& p, int layer, unsigned char* smem) {
    const int tid = opaque_tid(), wv = tid >> 6, lane = tid & 63, l15 = lane & 15, quad = lane >> 4;
    const int G = gridDim.x;
    const bf16_t* qkv = (const bf16_t*)(p.ws + OFF_QKV);
    unsigned char* sK = smem;
    bf16_t* sVT = (bf16_t*)(smem + 76032);
    float* sRPB = (float*)(smem + 144640);
    float* sMB = (float*)(smem + 146512);
    const int cb = wv & 3, hf = wv >> 2, c = cb * 16 + l15;
    const int cu = cb == 0 ? 0 : (cb == 1 ? 8 : (cb == 2 ? 24 : 32)), cs = min(max(c - 8, 0), 48);
    u32x4 pk[8], pv[8], pmk = (u32x4){0u, 0u, 0u, 0u}, pmv = (u32x4){0u, 0u, 0u, 0u}; bf16x8 pq0, pq1; float prp = 0.f;
#define NA_LOADS(U) do { const int r_ = (U) >> 4, hd_ = (U) & 15, r0_ = min(max(r_ - 4, 0), 248); \
        _Pragma("unroll") for (int ps = 0; ps < 8; ++ps) { const int tok = ps * 64 + (tid >> 3), ch = tid & 7; const size_t g = (size_t)(NMETA + r0_ * 64 + tok) * 3072 + hd_ * 64 + ch * 8; \
            pk[ps] = *(const u32x4*)(qkv + g + 1024); pv[ps] = *(const u32x4*)(qkv + g + 2048); } \
        if (tid < 128) { const size_t g = (size_t)(tid >> 3) * 3072 + hd_ * 64 + (tid & 7) * 8; pmk = *(const u32x4*)(qkv + g + 1024); pmv = *(const u32x4*)(qkv + g + 2048); } \
        { const bf16_t* qp = qkv + (size_t)(NMETA + r_ * 64 + c) * 3072 + hd_ * 64 + quad * 8; pq0 = *(const bf16x8*)qp; pq1 = *(const bf16x8*)(qp + 32); } \
        if (tid < 465) prp = p.rpb[(size_t)(layer * 16 + hd_) * 465 + tid]; else if (tid >= 480 && tid < 496) prp = p.meta_bias[(layer * 16 + hd_) * 16 + tid - 480]; } while (0)
    int u = blockIdx.x;
    if (u < 4096) NA_LOADS(u);
    for (; u < 4096; u += G) {
        const int r = u >> 4, hd = u & 15, r0 = min(max(r - 4, 0), 248);
        __syncthreads();
#pragma unroll
        for (int ps = 0; ps < 8; ++ps) { const int tok = ps * 64 + (tid >> 3), ch = tid & 7; const u32x4 vv = pv[ps];
            *(u32x4*)(sK + tok * 144 + ch * 16) = pk[ps];
            bf16_t* vt = sVT + (ch * 8) * 536 + tok;
            vt[0] = (bf16_t)vv.x; vt[536] = (bf16_t)(vv.x >> 16); vt[2 * 536] = (bf16_t)vv.y; vt[3 * 536] = (bf16_t)(vv.y >> 16);
            vt[4 * 536] = (bf16_t)vv.z; vt[5 * 536] = (bf16_t)(vv.z >> 16); vt[6 * 536] = (bf16_t)vv.w; vt[7 * 536] = (bf16_t)(vv.w >> 16); }
        if (tid < 128) { const int tok = tid >> 3, ch = tid & 7; const u32x4 vv = pmv;
            *(u32x4*)(sK + (512 + tok) * 144 + ch * 16) = pmk;
            bf16_t* vt = sVT + (ch * 8) * 536 + 512 + tok;
            vt[0] = (bf16_t)vv.x; vt[536] = (bf16_t)(vv.x >> 16); vt[2 * 536] = (bf16_t)vv.y; vt[3 * 536] = (bf16_t)(vv.y >> 16);
            vt[4 * 536] = (bf16_t)vv.z; vt[5 * 536] = (bf16_t)(vv.z >> 16); vt[6 * 536] = (bf16_t)vv.w; vt[7 * 536] = (bf16_t)(vv.w >> 16); }
        if (tid < 465) sRPB[tid] = prp; else if (tid >= 480 && tid < 496) sMB[tid - 480] = prp;
        const bf16x8 bq0 = pq0, bq1 = pq1;
        { const int un = u + G; if (un < 4096) NA_LOADS(un); }
        __syncthreads();
        bf16_t* yc = (bf16_t*)(p.ws + OFF_GATE + 2 * SZ_GATE);
        float gatev[4][4];
        if (hf == 0) {
#pragma unroll
            for (int rr = 0; rr < 4; ++rr)
#pragma unroll
                for (int dt = 0; dt < 4; ++dt) gatev[rr][dt] = bf2f(yc[(size_t)(NMETA + r * 64 + cb * 16 + quad * 4 + rr) * 1024 + hd * 64 + l15 + dt * 16]); }
        float sc[9][4];
#pragma unroll
        for (int ti = 0; ti < 9; ++ti) { const int j = 4 * hf + (ti >> 1), tt = ti & 1; const int slot0 = ti < 8 ? j * 64 + cu + tt * 16 : 512;
            const unsigned char* kp = sK + (slot0 + l15) * 144 + quad * 16;
            const bf16x8 a0 = *(const bf16x8*)kp, a1 = *(const bf16x8*)(kp + 64);
            f32x4 acc = (f32x4){0.f, 0.f, 0.f, 0.f};
            acc = __builtin_amdgcn_mfma_f32_16x16x32_bf16(a0, bq0, acc, 0, 0, 0); acc = __builtin_amdgcn_mfma_f32_16x16x32_bf16(a1, bq1, acc, 0, 0, 0);
            if (ti < 8) { const float* rp = sRPB + (r0 + j - r + 7) * 31 + (15 - c);
#pragma unroll
                for (int rr = 0; rr < 4; ++rr) { const int kc = cu + tt * 16 + quad * 4 + rr; const bool ok = kc >= cs && kc < cs + 16; const int kcc = ok ? kc : cs;
                    sc[ti][rr] = ok ? acc[rr] * 0.125f + rp[kcc] : -1.0e30f; } }
            else {
#pragma unroll
                for (int rr = 0; rr < 4; ++rr) sc[ti][rr] = hf == 0 ? acc[rr] * 0.125f + sMB[quad * 4 + rr] : -1.0e30f; } }
        float mx = -1.0e30f;
#pragma unroll
        for (int ti = 0; ti < 9; ++ti)
#pragma unroll
            for (int rr = 0; rr < 4; ++rr) mx = fmaxf(mx, sc[ti][rr]);
        mx = fmaxf(mx, __shfl_xor(mx, 16)); mx = fmaxf(mx, __shfl_xor(mx, 32));
        float lsum = 0.f;
#pragma unroll
        for (int ti = 0; ti < 9; ++ti)
#pragma unroll
            for (int rr = 0; rr < 4; ++rr) { sc[ti][rr] = __expf(sc[ti][rr] - mx); lsum += sc[ti][rr]; }
        lsum += __shfl_xor(lsum, 16); lsum += __shfl_xor(lsum, 32);
        f32x4 oacc[4];
#pragma unroll
        for (int dt = 0; dt < 4; ++dt) oacc[dt] = (f32x4){0.f, 0.f, 0.f, 0.f};
#pragma unroll
        for (int ks = 0; ks < 5; ++ks) { const int tA = 2 * ks, tB = 2 * ks + 1;
            const int jA = 4 * hf + (tA >> 1); const int slotA = tA < 8 ? jA * 64 + cu + (tA & 1) * 16 : 512; const int slotB = ks < 4 ? (4 * hf + (tB >> 1)) * 64 + cu + 16 : 512;
            u32x4 pa; pa.x = cvt_pk_bf16(sc[tA][0], sc[tA][1]); pa.y = cvt_pk_bf16(sc[tA][2], sc[tA][3]);
            if (ks < 4) { pa.z = cvt_pk_bf16(sc[tA + 1 < 9 ? tA + 1 : 8][0], sc[tA + 1 < 9 ? tA + 1 : 8][1]); pa.w = cvt_pk_bf16(sc[tA + 1 < 9 ? tA + 1 : 8][2], sc[tA + 1 < 9 ? tA + 1 : 8][3]); } else { pa.z = 0u; pa.w = 0u; }
            const bf16x8 af = __builtin_bit_cast(bf16x8, pa);
#pragma unroll
            for (int dt = 0; dt < 4; ++dt) { const bf16_t* vr = sVT + (dt * 16 + l15) * 536 + quad * 4;
                const u32x2 lo = *(const u32x2*)(vr + slotA), hi = *(const u32x2*)(vr + slotB);
                const u32x4 bb = (u32x4){lo.x, lo.y, hi.x, hi.y};
                oacc[dt] = __builtin_amdgcn_mfma_f32_16x16x32_bf16(af, __builtin_bit_cast(bf16x8, bb), oacc[dt], 0, 0, 0); } }
        __syncthreads();
        float* part = (float*)smem + cb * 1056;
        if (hf == 1) {
#pragma unroll
            for (int dt = 0; dt < 4; ++dt)
#pragma unroll
                for (int rr = 0; rr < 4; ++rr) part[(quad * 4 + rr) * 64 + dt * 16 + l15] = oacc[dt][rr];
            if (quad == 0) { part[1024 + l15] = mx; part[1040 + l15] = lsum; } }
        __syncthreads();
        if (hf == 0) {
#pragma unroll
            for (int rr = 0; rr < 4; ++rr) { const int qy = quad * 4 + rr; const float m0 = __shfl(mx, qy), l0 = __shfl(lsum, qy); const float m1 = part[1024 + qy], l1 = part[1040 + qy];
                const float M = fmaxf(m0, m1), f0 = __expf(m0 - M), f1 = __expf(m1 - M); const float inv = 1.0f / (f0 * l0 + f1 * l1);
                bf16_t* gp = yc + (size_t)(NMETA + r * 64 + cb * 16 + qy) * 1024 + hd * 64 + l15;
#pragma unroll
                for (int dt = 0; dt < 4; ++dt) { const float o = (f0 * oacc[dt][rr] + f1 * part[qy * 64 + dt * 16 + l15]) * inv; gp[dt * 16] = f2bf(o * gatev[rr][dt]); } } }
    }
#undef NA_LOADS
}
__device__ void na_meta_unit(const Params& p, int layer) {
    const int tid = opaque_tid();
    if (tid < 256) { const int hd = tid >> 4, qi = tid & 15; const bf16_t* qkv = (const bf16_t*)(p.ws + OFF_QKV);
        float q[64];
        { const u32x4* qp = (const u32x4*)(qkv + (size_t)qi * 3072 + hd * 64);
#pragma unroll
          for (int i = 0; i < 8; ++i) { const u32x4 v = qp[i]; q[i * 8 + 0] = lo_bf(v.x) * 0.125f; q[i * 8 + 1] = hi_bf(v.x) * 0.125f; q[i * 8 + 2] = lo_bf(v.y) * 0.125f; q[i * 8 + 3] = hi_bf(v.y) * 0.125f;
              q[i * 8 + 4] = lo_bf(v.z) * 0.125f; q[i * 8 + 5] = hi_bf(v.z) * 0.125f; q[i * 8 + 6] = lo_bf(v.w) * 0.125f; q[i * 8 + 7] = hi_bf(v.w) * 0.125f; } }
        float o[64];
#pragma unroll
        for (int i = 0; i < 64; ++i) o[i] = 0.f;
        float mx = -3.0e38f, lsum = 0.f;
#pragma unroll 1
        for (int m = 0; m < 16; ++m) { const u32x4* kp = (const u32x4*)(qkv + (size_t)m * 3072 + 1024 + hd * 64); const u32x4* vp = (const u32x4*)(qkv + (size_t)m * 3072 + 2048 + hd * 64);
            float d0 = 0.f, d1 = 0.f;
#pragma unroll
            for (int e = 0; e < 8; ++e) { const u32x4 v = kp[e];
                d0 += q[e * 8 + 0] * lo_bf(v.x) + q[e * 8 + 2] * lo_bf(v.y) + q[e * 8 + 4] * lo_bf(v.z) + q[e * 8 + 6] * lo_bf(v.w);
                d1 += q[e * 8 + 1] * hi_bf(v.x) + q[e * 8 + 3] * hi_bf(v.y) + q[e * 8 + 5] * hi_bf(v.z) + q[e * 8 + 7] * hi_bf(v.w); }
            const float sc = d0 + d1 + p.meta_bias[(layer * 16 + hd) * 16 + m]; const float mnew = fmaxf(mx, sc); const float alpha = __expf(mx - mnew), pi = __expf(sc - mnew);
            lsum = lsum * alpha + pi; mx = mnew;
#pragma unroll
            for (int e = 0; e < 8; ++e) { const u32x4 v = vp[e];
                o[e * 8 + 0] = o[e * 8 + 0] * alpha + pi * lo_bf(v.x); o[e * 8 + 1] = o[e * 8 + 1] * alpha + pi * hi_bf(v.x); o[e * 8 + 2] = o[e * 8 + 2] * alpha + pi * lo_bf(v.y); o[e * 8 + 3] = o[e * 8 + 3] * alpha + pi * hi_bf(v.y);
                o[e * 8 + 4] = o[e * 8 + 4] * alpha + pi * lo_bf(v.z); o[e * 8 + 5] = o[e * 8 + 5] * alpha + pi * hi_bf(v.z); o[e * 8 + 6] = o[e * 8 + 6] * alpha + pi * lo_bf(v.w); o[e * 8 + 7] = o[e * 8 + 7] * alpha + pi * hi_bf(v.w); } }
        const float inv = 1.0f / lsum; u32x4* gp = (u32x4*)((bf16_t*)(p.ws + OFF_GATE + 2 * SZ_GATE) + (size_t)qi * 1024 + hd * 64);
#pragma unroll
        for (int e = 0; e < 8; ++e) { const u32x4 g = gp[e]; u32x4 w;
            w.x = cvt_pk_bf16(o[e * 8 + 0] * inv * lo_bf(g.x), o[e * 8 + 1] * inv * hi_bf(g.x)); w.y = cvt_pk_bf16(o[e * 8 + 2] * inv * lo_bf(g.y), o[e * 8 + 3] * inv * hi_bf(g.y));
            w.z = cvt_pk_bf16(o[e * 8 + 4] * inv * lo_bf(g.z), o[e * 8 + 5] * inv * hi_bf(g.z)); w.w = cvt_pk_bf16(o[e * 8 + 6] * inv * lo_bf(g.w), o[e * 8 + 7] * inv * hi_bf(g.w));
            gp[e] = w; } }
}

__device__ __forceinline__ unsigned rev4_14(unsigned k) { unsigned r = __brev(k) >> 18; return ((r & 0x1555u) << 1) | ((r >> 1) & 0x1555u); }
__device__ __forceinline__ float2 cmul(float2 a, float2 b) { return make_float2(a.x * b.x - a.y * b.y, a.x * b.y + a.y * b.x); }
#define PADI(i) ((i) + ((i) >> 4))
#define CFF(n) cff[2 * PADI((n) >> 1) + ((n) & 1)]
__device__ __forceinline__ void hw_sincos(float rev, float& sn, float& cs) { sn = __builtin_amdgcn_sinf(rev); cs = __builtin_amdgcn_cosf(rev); }
__device__ __forceinline__ float c16(int k) { const float t[10] = {1.0f, 0.9238795325f, 0.7071067812f, 0.3826834324f, 0.0f, -0.3826834324f, -0.7071067812f, -0.9238795325f, -1.0f, -0.9238795325f}; return t[k]; }
__device__ __forceinline__ float s16(int k) { const float t[10] = {0.0f, 0.3826834324f, 0.7071067812f, 0.9238795325f, 1.0f, 0.9238795325f, 0.7071067812f, 0.3826834324f, 0.0f, -0.3826834324f}; return t[k]; }
__device__ __forceinline__ float2 cadd(float2 a, float2 b) { return make_float2(a.x + b.x, a.y + b.y); }
__device__ __forceinline__ float2 csub(float2 a, float2 b) { return make_float2(a.x - b.x, a.y - b.y); }
template <int SGN> __device__ __forceinline__ void bf4(float2& a0, float2& a1, float2& a2, float2& a3) {
    const float2 t0 = cadd(a0, a2), t1 = csub(a0, a2), t2 = cadd(a1, a3), d = csub(a1, a3);
    const float2 t3 = SGN < 0 ? make_float2(d.y, -d.x) : make_float2(-d.y, d.x);
    a0 = cadd(t0, t2); a1 = cadd(t1, t3); a2 = csub(t0, t2); a3 = csub(t1, t3);
}
template <int S> __device__ __forceinline__ void r16_fwd_pass(float2* a) {
    constexpr int Q = S / 4;
    for (int u = opaque_tid(); u < 1024; u += NTHREADS) { const int j = u & (Q - 1); const int base = ((u - j) << 4) + j;
        float2 x[4][4];
#pragma unroll
        for (int aa = 0; aa < 4; ++aa)
#pragma unroll
            for (int bb = 0; bb < 4; ++bb) x[aa][bb] = a[PADI(base + aa * S + bb * Q)];
        float sn, cs; hw_sincos((float)j / (float)(4 * S), sn, cs); const float2 wb0 = make_float2(cs, -sn);
#pragma unroll
        for (int bb = 0; bb < 4; ++bb) { const float2 w1 = bb == 0 ? wb0 : cmul(wb0, make_float2(c16(bb), -s16(bb))); const float2 w2 = cmul(w1, w1), w3 = cmul(w2, w1);
            bf4<-1>(x[0][bb], x[1][bb], x[2][bb], x[3][bb]); x[1][bb] = cmul(x[1][bb], w1); x[2][bb] = cmul(x[2][bb], w2); x[3][bb] = cmul(x[3][bb], w3); }
        hw_sincos((float)j / (float)S, sn, cs); const float2 v1 = make_float2(cs, -sn), v2 = cmul(v1, v1), v3 = cmul(v2, v1);
#pragma unroll
        for (int aa = 0; aa < 4; ++aa) { bf4<-1>(x[aa][0], x[aa][1], x[aa][2], x[aa][3]); x[aa][1] = cmul(x[aa][1], v1); x[aa][2] = cmul(x[aa][2], v2); x[aa][3] = cmul(x[aa][3], v3); }
#pragma unroll
        for (int aa = 0; aa < 4; ++aa)
#pragma unroll
            for (int bb = 0; bb < 4; ++bb) a[PADI(base + aa * S + bb * Q)] = x[aa][bb]; }
    __syncthreads();
}
template <int S> __device__ __forceinline__ void r16_inv_pass(float2* a) {
    constexpr int Q = S / 4;
    for (int u = opaque_tid(); u < 1024; u += NTHREADS) { const int j = u & (Q - 1); const int base = ((u - j) << 4) + j;
        float2 x[4][4];
#pragma unroll
        for (int aa = 0; aa < 4; ++aa)
#pragma unroll
            for (int bb = 0; bb < 4; ++bb) x[aa][bb] = a[PADI(base + aa * S + bb * Q)];
        float sn, cs; hw_sincos((float)j / (float)S, sn, cs); const float2 v1 = make_float2(cs, sn), v2 = cmul(v1, v1), v3 = cmul(v2, v1);
#pragma unroll
        for (int aa = 0; aa < 4; ++aa) { x[aa][1] = cmul(x[aa][1], v1); x[aa][2] = cmul(x[aa][2], v2); x[aa][3] = cmul(x[aa][3], v3); bf4<1>(x[aa][0], x[aa][1], x[aa][2], x[aa][3]); }
        hw_sincos((float)j / (float)(4 * S), sn, cs); const float2 wb0 = make_float2(cs, sn);
#pragma unroll
        for (int bb = 0; bb < 4; ++bb) { const float2 w1 = bb == 0 ? wb0 : cmul(wb0, make_float2(c16(bb), s16(bb))); const float2 w2 = cmul(w1, w1), w3 = cmul(w2, w1);
            x[1][bb] = cmul(x[1][bb], w1); x[2][bb] = cmul(x[2][bb], w2); x[3][bb] = cmul(x[3][bb], w3); bf4<1>(x[0][bb], x[1][bb], x[2][bb], x[3][bb]); }
#pragma unroll
        for (int aa = 0; aa < 4; ++aa)
#pragma unroll
            for (int bb = 0; bb < 4; ++bb) a[PADI(base + aa * S + bb * Q)] = x[aa][bb]; }
    __syncthreads();
}
__device__ void fft_fwd(float2* a) {
    r16_fwd_pass<4096>(a);
    r16_fwd_pass<256>(a);
    { const int span = 16;
        for (int b = opaque_tid(); b < 4096; b += NTHREADS) { const int j = b & (span - 1); const int base = ((b - j) << 2) + j;
            const int i0 = PADI(base), i1 = PADI(base + span), i2 = PADI(base + 2 * span), i3 = PADI(base + 3 * span);
            float2 a0 = a[i0], a1 = a[i1], a2 = a[i2], a3 = a[i3];
            const float2 w1 = make_float2(c16(0) * 0.f + __builtin_amdgcn_cosf((float)j * (1.0f / 64.0f)), -__builtin_amdgcn_sinf((float)j * (1.0f / 64.0f))), w2 = cmul(w1, w1), w3 = cmul(w2, w1);
            bf4<-1>(a0, a1, a2, a3);
            a[i0] = a0; a[i1] = cmul(a1, w1); a[i2] = cmul(a2, w2); a[i3] = cmul(a3, w3); }
        __syncthreads(); }
    for (int blk = opaque_tid(); blk < 1024; blk += NTHREADS) { float2* pb = a + blk * 17; float2 x[16];
#pragma unroll
        for (int e = 0; e < 16; ++e) x[e] = pb[e];
#pragma unroll
        for (int j = 0; j < 4; ++j) { bf4<-1>(x[j], x[j + 4], x[j + 8], x[j + 12]);
            x[j + 4] = cmul(x[j + 4], make_float2(c16(j), -s16(j))); x[j + 8] = cmul(x[j + 8], make_float2(c16(2 * j), -s16(2 * j))); x[j + 12] = cmul(x[j + 12], make_float2(c16(3 * j), -s16(3 * j))); }
#pragma unroll
        for (int g = 0; g < 4; ++g) bf4<-1>(x[4 * g], x[4 * g + 1], x[4 * g + 2], x[4 * g + 3]);
#pragma unroll
        for (int e = 0; e < 16; ++e) pb[e] = x[e]; }
    __syncthreads();
}
__device__ void fft_inv(float2* a) {
    for (int blk = opaque_tid(); blk < 1024; blk += NTHREADS) { float2* pb = a + blk * 17; float2 x[16];
#pragma unroll
        for (int e = 0; e < 16; ++e) x[e] = pb[e];
#pragma unroll
        for (int g = 0; g < 4; ++g) bf4<1>(x[4 * g], x[4 * g + 1], x[4 * g + 2], x[4 * g + 3]);
#pragma unroll
        for (int j = 0; j < 4; ++j) { x[j + 4] = cmul(x[j + 4], make_float2(c16(j), s16(j))); x[j + 8] = cmul(x[j + 8], make_float2(c16(2 * j), s16(2 * j))); x[j + 12] = cmul(x[j + 12], make_float2(c16(3 * j), s16(3 * j)));
            bf4<1>(x[j], x[j + 4], x[j + 8], x[j + 12]); }
#pragma unroll
        for (int e = 0; e < 16; ++e) pb[e] = x[e]; }
    __syncthreads();
    { const int span = 16;
        for (int b = opaque_tid(); b < 4096; b += NTHREADS) { const int j = b & (span - 1); const int base = ((b - j) << 2) + j;
            const int i0 = PADI(base), i1 = PADI(base + span), i2 = PADI(base + 2 * span), i3 = PADI(base + 3 * span);
            const float2 w1 = make_float2(__builtin_amdgcn_cosf((float)j * (1.0f / 64.0f)), __builtin_amdgcn_sinf((float)j * (1.0f / 64.0f))), w2 = cmul(w1, w1), w3 = cmul(w2, w1);
            float2 a0 = a[i0], a1 = cmul(a[i1], w1), a2 = cmul(a[i2], w2), a3 = cmul(a[i3], w3);
            bf4<1>(a0, a1, a2, a3);
            a[i0] = a0; a[i1] = a1; a[i2] = a2; a[i3] = a3; }
        __syncthreads(); }
    r16_inv_pass<256>(a);
    r16_inv_pass<4096>(a);
}
__device__ __forceinline__ void hy_load8(const bf16_t* __restrict__ row, int t0, u32x4& v, float& xl, float& xh) {
    v = *(const u32x4*)(row + t0); xl = t0 > 0 ? bf2f(row[t0 - 1]) : 0.f; xh = (t0 + 8 < L_TOK) ? bf2f(row[t0 + 8]) : 0.f;
}
__device__ __forceinline__ void hy_calc8(const u32x4 v, float xl, float xh, const float (&w)[4], float (&o)[8]) {
    float x[10];
    x[0] = xl; x[9] = xh;
    x[1] = lo_bf(v.x); x[2] = hi_bf(v.x); x[3] = lo_bf(v.y); x[4] = hi_bf(v.y); x[5] = lo_bf(v.z); x[6] = hi_bf(v.z); x[7] = lo_bf(v.w); x[8] = hi_bf(v.w);
#pragma unroll
    for (int e = 0; e < 8; ++e) o[e] = w[0] * x[e] + w[1] * x[e + 1] + w[2] * x[e + 2] + w[3];
}
__device__ __forceinline__ void hy_val8(const bf16_t* __restrict__ row, int t0, const float (&w)[4], float (&o)[8]) { u32x4 v; float xl, xh; hy_load8(row, t0, v, xl, xh); hy_calc8(v, xl, xh, w, o); }
struct HyCh { const bf16_t* __restrict__ ru; const bf16_t* __restrict__ r1; const bf16_t* __restrict__ r2; float wu[4], w1[4], w2[4]; };

constexpr int SD_W4B = 0  , SD_GFX = 512, SD_GBX = 528, SD_EF = 544, SD_EB = 560, SD_VH = 576, SD_VT = 592, SD_END = 608;
constexpr int NCHUNK = L_TOK / 8;

template <int ORDER>
__device__ void hy_conv(const HyCh& hc, float2* cf, float* side, unsigned char* scratch) {
    const int tid = opaque_tid(); float* cff = (float*)cf;
    f32x4* __restrict__ heo = (f32x4*)(scratch + HS_HEO); const float* __restrict__ z2g = (const float*)(scratch + HS_Z2);
    if (tid < 15) side[SD_EF + tid] = CFF(16369 + tid); else if (tid >= 32 && tid < 47) side[SD_EB + tid - 32] = CFF(32768 - (16369 + tid - 32));
    __syncthreads();
    fft_fwd(cf);
    for (int j = tid; j <= 8192; j += NTHREADS) { const unsigned i_ = j < 8192 ? ((((unsigned)j >> 1) << 2) | ((unsigned)j & 1u)) : 2u; const unsigned k = rev4_14(i_); const unsigned kp = (16384u - k) & 16383u; const float2 a = cf[PADI(i_)], bq = cf[PADI(rev4_14(kp))];
        const float bx = bq.x, by = -bq.y; const float sc = 1.0f / 16384.0f;
        heo[j] = (f32x4){0.5f * (a.x + bx) * sc, 0.5f * (a.y + by) * sc, 0.5f * (a.y - by) * sc, -0.5f * (a.x - bx) * sc}; }
    __syncthreads();
    {
        u32x4 rv[4]; float rl[4], rh[4]; f32x4 z0[4], z1[4];
#pragma unroll
        for (int i = 0; i < 4; ++i) { const int c = tid + NTHREADS * i;
            if (ORDER == 0) hy_load8(hc.ru, 8 * c, rv[i], rl[i], rh[i]); else { z0[i] = *(const f32x4*)(z2g + 8 * c); z1[i] = *(const f32x4*)(z2g + 8 * c + 4); } }
#pragma unroll
        for (int i = 0; i < 4; ++i) { const int c = tid + NTHREADS * i; float v[8];
            if (ORDER == 0) hy_calc8(rv[i], rl[i], rh[i], hc.wu, v);
            else { v[0] = z0[i][0]; v[1] = z0[i][1]; v[2] = z0[i][2]; v[3] = z0[i][3]; v[4] = z1[i][0]; v[5] = z1[i][1]; v[6] = z1[i][2]; v[7] = z1[i][3]; }
            float2* d = cf + PADI(4 * c); d[0] = make_float2(v[0], v[1]); d[1] = make_float2(v[2], v[3]); d[2] = make_float2(v[4], v[5]); d[3] = make_float2(v[6], v[7]);
            if (i == 0 && tid < 2) {
#pragma unroll
                for (int e = 0; e < 8; ++e) side[SD_VH + 8 * tid + e] = v[e]; } }
        if (tid < 2) { const int c = NCHUNK - 2 + tid; float v[8];
            if (ORDER == 0) hy_val8(hc.ru, 8 * c, hc.wu, v);
            else { const f32x4 p0 = *(const f32x4*)(z2g + 8 * c), p1 = *(const f32x4*)(z2g + 8 * c + 4); v[0] = p0[0]; v[1] = p0[1]; v[2] = p0[2]; v[3] = p0[3]; v[4] = p1[0]; v[5] = p1[1]; v[6] = p1[2]; v[7] = p1[3]; }
            float2* d = cf + PADI(4 * c); d[0] = make_float2(v[0], v[1]); d[1] = make_float2(v[2], v[3]); d[2] = make_float2(v[4], v[5]); d[3] = make_float2(v[6], v[7]);
#pragma unroll
            for (int e = 0; e < 8; ++e) side[SD_VT + 8 * tid + e] = v[e]; } }
    for (int i = L_TOK / 2 + tid; i < 16384; i += NTHREADS) cf[PADI(i)] = make_float2(0.f, 0.f);
    __syncthreads();
    fft_fwd(cf);
#pragma unroll 4
    for (int j = tid; j <= 8192; j += NTHREADS) { const unsigned i_ = j < 8192 ? ((((unsigned)j >> 1) << 2) | ((unsigned)j & 1u)) : 2u; const unsigned k = rev4_14(i_); const unsigned kp = (16384u - k) & 16383u; const unsigned ik = PADI(i_), ikp = PADI(rev4_14(kp)); const float2 a = cf[ik], bq = cf[ikp];
        const float bx = bq.x, by = -bq.y;
        const float2 XE = make_float2(0.5f * (a.x + bx), 0.5f * (a.y + by)), XO = make_float2(0.5f * (a.y - by), -0.5f * (a.x - bx));
        const f32x4 hh = heo[j]; const float2 HE = make_float2(hh[0], hh[1]), HO = make_float2(hh[2], hh[3]);
        float sn, cs; hw_sincos((float)k / 16384.0f, sn, cs); const float2 w = make_float2(cs, -sn);
        const float2 xoho = cmul(XO, HO), wx = cmul(w, xoho), xehe = cmul(XE, HE), xeho = cmul(XE, HO), xohe = cmul(XO, HE);
        const float2 YE = make_float2(xehe.x + wx.x, xehe.y + wx.y), YO = make_float2(xeho.x + xohe.x, xeho.y + xohe.y);
        cf[ik] = make_float2(YE.x - YO.y, YE.y + YO.x); cf[ikp] = make_float2(YE.x + YO.y, -YE.y + YO.x); }
    __syncthreads();
    fft_inv(cf);
    if (tid < 16) { const int t = tid; float d = 0.f;
        for (int s = t + 16384; s < L_TOK; ++s) { const int l = s - t; const float wrong = l == 16384 ? 0.f : side[SD_EF + 16399 - l]; d += (side[SD_GBX + l - 16384] - wrong) * side[SD_VT + s - 16384]; }
        CFF(t) += d; }
    else if (tid >= 32 && tid < 48) { const int t = 16384 + tid - 32; float d = 0.f;
        for (int s = 0; s <= t - 16384; ++s) { const int l = t - s; const float wrong = l == 16384 ? 0.f : side[SD_EB + 16399 - l]; d += (side[SD_GFX + l - 16384] - wrong) * side[SD_VH + s]; }
        CFF(t) += d; }
    __syncthreads();
}

__device__ void filt_to_lds(const bf16_t* __restrict__ gfp, const bf16_t* __restrict__ gbp, float2* cf, float* side) {
    const int tid = opaque_tid(); float* cff = (float*)cf;
    u32x4 qf[4], qb[4];
#pragma unroll
    for (int i = 0; i < 4; ++i) { const int c = tid + NTHREADS * i; qf[i] = *(const u32x4*)(gfp + 8 * c); qb[i] = *(const u32x4*)(gbp + 8 * c); }
#pragma unroll
    for (int i = 0; i < 4; ++i) { const int c = tid + NTHREADS * i, lag0 = 8 * c; const u32x4 f = qf[i], g = qb[i];
        float2* d = cf + PADI(4 * c); d[0] = make_float2(lo_bf(f.x), hi_bf(f.x)); d[1] = make_float2(lo_bf(f.y), hi_bf(f.y)); d[2] = make_float2(lo_bf(f.z), hi_bf(f.z)); d[3] = make_float2(lo_bf(f.w), hi_bf(f.w));
        if (lag0 >= 1) CFF(32768 - lag0) = lo_bf(g.x);
        CFF(32768 - lag0 - 1) = hi_bf(g.x); CFF(32768 - lag0 - 2) = lo_bf(g.y); CFF(32768 - lag0 - 3) = hi_bf(g.y); CFF(32768 - lag0 - 4) = lo_bf(g.z); CFF(32768 - lag0 - 5) = hi_bf(g.z); CFF(32768 - lag0 - 6) = lo_bf(g.w); CFF(32768 - lag0 - 7) = hi_bf(g.w); }
    if (tid < 2) { const int c = NCHUNK - 2 + tid; const u32x4 f = *(const u32x4*)(gfp + 8 * c), g = *(const u32x4*)(gbp + 8 * c); float* sf = side + SD_GFX + 8 * tid; float* sb = side + SD_GBX + 8 * tid;
        sf[0] = lo_bf(f.x); sf[1] = hi_bf(f.x); sf[2] = lo_bf(f.y); sf[3] = hi_bf(f.y); sf[4] = lo_bf(f.z); sf[5] = hi_bf(f.z); sf[6] = lo_bf(f.w); sf[7] = hi_bf(f.w);
        sb[0] = lo_bf(g.x); sb[1] = hi_bf(g.x); sb[2] = lo_bf(g.y); sb[3] = hi_bf(g.y); sb[4] = lo_bf(g.z); sb[5] = hi_bf(g.z); sb[6] = lo_bf(g.w); sb[7] = hi_bf(g.w); }
    if (tid == 0) CFF(NMAIN) = 0.f;
    __syncthreads();
}

__device__ void hyena_filters(const Params& p, int layer, unsigned char* smem, unsigned char* scrD, unsigned char* scrW) {
    const int tid = opaque_tid(); float2* cf = (float2*)smem; float* cff = (float*)smem; float* side = (float*)(smem + 139264);
    const int bid = blockIdx.x;
    __syncthreads();
    bf16_t* w4b = (bf16_t*)(side + SD_W4B);
    for (int i = tid; i < 16 * 64; i += NTHREADS) { const int row = i >> 6, k = i & 63; w4b[i] = f2bf(p.f_w4[((size_t)layer * 64 + k) * 4096 + (row & 3) * 1024 + bid + 256 * (row >> 2)]); }
    __syncthreads();
    const bf16_t* __restrict__ h3b = (const bf16_t*)(p.ws + OFF_H3) + (size_t)layer * L_TOK * 64;
    const int lane = tid & 63, wv = tid >> 6, col = lane & 15, quad = lane >> 4;
    const int chq = bid + 256 * quad;
    float dk[4];
#pragma unroll
    for (int f = 0; f < 4; ++f) dk[f] = fabsf(p.decay[((layer * 2 + (f >> 1)) * 2 + (f & 1)) * 1024 + chq]) * (1.4426950408889634f / (float)(L_TOK - 1));
    const bf16x8 b0 = *(const bf16x8*)(w4b + col * 64 + quad * 8), b1 = *(const bf16x8*)(w4b + col * 64 + 32 + quad * 8);
    bf16_t* __restrict__ g2 = (bf16_t*)(scrW + HS_G2);
    bf16_t* __restrict__ fq = (bf16_t*)(scrD) + (size_t)(quad > 0 ? quad - 1 : 0) * 4 * L_TOK;
#define FG_LOAD(A0, A1, GB) do { _Pragma("unroll") for (int i = 0; i < 8; ++i) { const bf16_t* hr = h3b + (size_t)(((GB) + 8 * i) * 16 + col) * 64 + quad * 8; A0[i] = *(const bf16x8*)hr; A1[i] = *(const bf16x8*)(hr + 32); } } while (0)
#define FG_GROUP(X0, X1, G_) do { f32x4 acc = (f32x4){0.f, 0.f, 0.f, 0.f}; \
        acc = __builtin_amdgcn_mfma_f32_16x16x32_bf16(b0, X0, acc, 0, 0, 0); acc = __builtin_amdgcn_mfma_f32_16x16x32_bf16(b1, X1, acc, 0, 0, 0); \
        const int lag = (G_) * 16 + col; const float fl = -(float)lag; \
        const float v0 = acc[0] * __builtin_amdgcn_exp2f(fl * dk[0]), v1 = acc[1] * __builtin_amdgcn_exp2f(fl * dk[1]), v2 = acc[2] * __builtin_amdgcn_exp2f(fl * dk[2]), v3 = acc[3] * __builtin_amdgcn_exp2f(fl * dk[3]); \
        if (quad == 0) { g2[lag] = f2bf(v2); g2[L_TOK + lag] = f2bf(v3); \
            if (lag < NMAIN) { CFF(lag) = v0; if (lag >= 1) CFF(32768 - lag) = v1; } else { side[SD_GFX + lag - NMAIN] = v0; side[SD_GBX + lag - NMAIN] = v1; } } \
        else { fq[lag] = f2bf(v0); fq[L_TOK + lag] = f2bf(v1); fq[2 * L_TOK + lag] = f2bf(v2); fq[3 * L_TOK + lag] = f2bf(v3); } } while (0)
#define FG_PROC(A0, A1, GB) do { _Pragma("unroll") for (int i = 0; i < 8; ++i) FG_GROUP(A0[i], A1[i], (GB) + 8 * i); } while (0)
    { bf16x8 pa0[8], pa1[8], pb0[8], pb1[8];
      FG_LOAD(pa0, pa1, wv);
#pragma unroll 1
      for (int m = 0; m < 16; m += 2) { const int gbA = wv + 64 * m, gbB = gbA + 64;
          FG_LOAD(pb0, pb1, gbB);
          FG_PROC(pa0, pa1, gbA);
          if (m + 2 < 16) FG_LOAD(pa0, pa1, gbB + 64);
          FG_PROC(pb0, pb1, gbB); }
      if (wv == 0) { const bf16_t* hr = h3b + (size_t)(1024 * 16 + col) * 64 + quad * 8; const bf16x8 x0 = *(const bf16x8*)hr, x1 = *(const bf16x8*)(hr + 32); FG_GROUP(x0, x1, 1024); } }
#undef FG_LOAD
#undef FG_GROUP
#undef FG_PROC
    if (tid == 0) CFF(NMAIN) = 0.f;
    __syncthreads();
}

__device__ void hyena_unit(const Params& p, int layer, int q, unsigned char* smem, unsigned char* scrD, unsigned char* scratch) {
    const int tid = opaque_tid(); float2* cf = (float2*)smem; float* cff = (float*)smem; float* side = (float*)(smem + 139264);
    const int ch = blockIdx.x + 256 * q;
    const bf16_t* hyin = (const bf16_t*)(p.ws + OFF_HYIN);
    HyCh hc; hc.ru = hyin + (size_t)ch * LP; hc.r1 = hyin + (size_t)(1024 + ch) * LP; hc.r2 = hyin + (size_t)(2048 + ch) * LP;
    { const float* cw = p.conv_w + (size_t)layer * 3 * 3072; const float* cb = p.conv_b + (size_t)layer * 3072;
#pragma unroll
      for (int jj = 0; jj < 3; ++jj) { hc.wu[jj] = cw[jj * 3072 + ch]; hc.w1[jj] = cw[jj * 3072 + 1024 + ch]; hc.w2[jj] = cw[jj * 3072 + 2048 + ch]; }
      hc.wu[3] = cb[ch]; hc.w1[3] = cb[1024 + ch]; hc.w2[3] = cb[2048 + ch]; }
    const float sk0 = p.skip[(layer * 2 + 0) * 1024 + ch], sk1 = p.skip[(layer * 2 + 1) * 1024 + ch];
    float* __restrict__ z2g = (float*)(scratch + HS_Z2);
    const bf16_t* filt = q == 0 ? (const bf16_t*)(scratch + HS_G2) - 2 * (size_t)L_TOK : (const bf16_t*)scrD + (size_t)(q - 1) * 4 * L_TOK;
    bf16_t* __restrict__ hyout = (bf16_t*)(p.ws + OFF_HYOUT) + (size_t)ch * LP;
    if (q > 0) { __syncthreads(); filt_to_lds(filt, filt + L_TOK, cf, side); }
    hy_conv<0>(hc, cf, side, scratch);
    {   u32x4 ru_[4], r1_[4]; float ul[4], uh[4], xl[4], xh[4];
#pragma unroll
        for (int i = 0; i < 4; ++i) { const int c = tid + NTHREADS * i; hy_load8(hc.ru, 8 * c, ru_[i], ul[i], uh[i]); hy_load8(hc.r1, 8 * c, r1_[i], xl[i], xh[i]); }
#pragma unroll
        for (int i = 0; i < 5; ++i) { const int c = i < 4 ? tid + NTHREADS * i : NCHUNK - 2 + tid;
            if (i < 4 || tid < 2) { float u8[8], x8[8];
                if (i < 4) { hy_calc8(ru_[i], ul[i], uh[i], hc.wu, u8); hy_calc8(r1_[i], xl[i], xh[i], hc.w1, x8); } else { hy_val8(hc.ru, 8 * c, hc.wu, u8); hy_val8(hc.r1, 8 * c, hc.w1, x8); }
                const float2* s = cf + PADI(4 * c); const float2 y0 = s[0], y1 = s[1], y2 = s[2], y3 = s[3];
                const f32x4 o0 = (f32x4){x8[0] * (y0.x + sk0 * u8[0]), x8[1] * (y0.y + sk0 * u8[1]), x8[2] * (y1.x + sk0 * u8[2]), x8[3] * (y1.y + sk0 * u8[3])};
                const f32x4 o1 = (f32x4){x8[4] * (y2.x + sk0 * u8[4]), x8[5] * (y2.y + sk0 * u8[5]), x8[6] * (y3.x + sk0 * u8[6]), x8[7] * (y3.y + sk0 * u8[7])};
                *(f32x4*)(z2g + 8 * c) = o0; *(f32x4*)(z2g + 8 * c + 4) = o1; } } }
    __syncthreads();
    filt_to_lds(filt + 2 * (size_t)L_TOK, filt + 3 * (size_t)L_TOK, cf, side);
    hy_conv<1>(hc, cf, side, scratch);
    {   u32x4 r2_[4]; float xl[4], xh[4]; f32x4 z0[4], z1[4];
#pragma unroll
        for (int i = 0; i < 4; ++i) { const int c = tid + NTHREADS * i; hy_load8(hc.r2, 8 * c, r2_[i], xl[i], xh[i]); z0[i] = *(const f32x4*)(z2g + 8 * c); z1[i] = *(const f32x4*)(z2g + 8 * c + 4); }
#pragma unroll
        for (int i = 0; i < 5; ++i) { const int c = i < 4 ? tid + NTHREADS * i : NCHUNK - 2 + tid;
            if (i < 4 || tid < 2) { float x8[8]; f32x4 p0, p1;
                if (i < 4) { hy_calc8(r2_[i], xl[i], xh[i], hc.w2, x8); p0 = z0[i]; p1 = z1[i]; } else { hy_val8(hc.r2, 8 * c, hc.w2, x8); p0 = *(const f32x4*)(z2g + 8 * c); p1 = *(const f32x4*)(z2g + 8 * c + 4); }
                const float2* s = cf + PADI(4 * c); const float2 y0 = s[0], y1 = s[1], y2 = s[2], y3 = s[3];
                u32x4 w; w.x = cvt_pk_bf16(x8[0] * (y0.x + sk1 * p0[0]), x8[1] * (y0.y + sk1 * p0[1])); w.y = cvt_pk_bf16(x8[2] * (y1.x + sk1 * p0[2]), x8[3] * (y1.y + sk1 * p0[3]));
                w.z = cvt_pk_bf16(x8[4] * (y2.x + sk1 * p1[0]), x8[5] * (y2.y + sk1 * p1[1])); w.w = cvt_pk_bf16(x8[6] * (y3.x + sk1 * p1[2]), x8[7] * (y3.y + sk1 * p1[3]));
                *(u32x4*)(hyout + 8 * c) = w; } } }
    __syncthreads();
}

__device__ void transpose_phase(const Params& p, unsigned char* smem) {
    const int tid = opaque_tid(), G = gridDim.x; bf16_t* tile0 = (bf16_t*)smem;
    const bf16_t* __restrict__ hyout = (const bf16_t*)(p.ws + OFF_HYOUT); bf16_t* ya = (bf16_t*)(p.ws + OFF_GATE);
    const int cl = tid >> 3, t8 = (tid & 7) * 8, tl = tid >> 3, c8 = (tid & 7) * 8;
    u32x4 ph = (u32x4){0u, 0u, 0u, 0u}, pg = ph;
    constexpr int TOT = 16 * 257;
    int u = blockIdx.x;
    __syncthreads();
    if (u < TOT) { const int ct = u & 15, tt = u >> 4; ph = *(const u32x4*)(hyout + (size_t)(ct * 64 + cl) * LP + tt * 64 + t8); const int t = tt * 64 + tl; if (t < L_TOK) pg = *(const u32x4*)(ya + (size_t)t * 1024 + ct * 64 + c8); }
    int buf = 0;
    for (; u < TOT; u += G) { bf16_t* tile = tile0 + buf * (64 * 72); const int ct = u & 15, tt = u >> 4;
        *(u32x4*)(tile + cl * 72 + t8) = ph; const u32x4 g = pg;
        { const int un = u + G; if (un < TOT) { const int ct2 = un & 15, tt2 = un >> 4; ph = *(const u32x4*)(hyout + (size_t)(ct2 * 64 + cl) * LP + tt2 * 64 + t8); const int t2 = tt2 * 64 + tl; if (t2 < L_TOK) pg = *(const u32x4*)(ya + (size_t)t2 * 1024 + ct2 * 64 + c8); } }
        __syncthreads();
        const int t = tt * 64 + tl;
        if (t < L_TOK) { float v[8];
#pragma unroll
            for (int i = 0; i < 8; ++i) v[i] = bf2f(tile[(c8 + i) * 72 + tl]);
            u32x4 w; w.x = cvt_pk_bf16(v[0] * lo_bf(g.x), v[1] * hi_bf(g.x)); w.y = cvt_pk_bf16(v[2] * lo_bf(g.y), v[3] * hi_bf(g.y)); w.z = cvt_pk_bf16(v[4] * lo_bf(g.z), v[5] * hi_bf(g.z)); w.w = cvt_pk_bf16(v[6] * lo_bf(g.w), v[7] * hi_bf(g.w));
            *(u32x4*)(ya + (size_t)t * 1024 + ct * 64 + c8) = w; }
        buf ^= 1; }
    __syncthreads();
}

__device__ void phase_final(const Params& p) {
    const int tid = opaque_tid(), lane = tid & 63, wv = tid >> 6; const float* h = (const float*)(p.ws + OFF_H);
    for (int l = NMETA + blockIdx.x * 8 + wv; l < L_TOK; l += gridDim.x * 8) { const f32x4* row = (const f32x4*)(h + (size_t)l * DM); f32x4 v[8]; float ss = 0.f;
#pragma unroll
        for (int i = 0; i < 8; ++i) { v[i] = row[i * 64 + lane]; ss += v[i][0] * v[i][0] + v[i][1] * v[i][1] + v[i][2] * v[i][2] + v[i][3] * v[i][3]; }
        ss = wave_sum(ss); const float inv = rsqrtf(ss * (1.0f / DM) + 1e-6f); f32x4* o = (f32x4*)(p.out + (size_t)(l - NMETA) * DM);
#pragma unroll
        for (int i = 0; i < 8; ++i) { const f32x4 gg = ((const f32x4*)p.final_g)[i * 64 + lane]; o[i * 64 + lane] = v[i] * inv * gg; } }
}

__device__ void mini_branch(const Params& p) {
    const int tid = opaque_tid(), lane = tid & 63, wv = tid >> 6, nt_ = blockIdx.x * 8 + wv;
    if (nt_ < 128) { const int rc = lane & 15, quad = lane >> 4; const int n0 = nt_ * 16;
        const bf16_t* mg = (const bf16_t*)(p.ws + OFF_MERGE); bf16_t* mb = (bf16_t*)(p.ws + OFF_M);
        float tot[4] = {0.f, 0.f, 0.f, 0.f};
#pragma unroll 1
        for (int br = 0; br < 3; ++br) { const bf16_t* A = (const bf16_t*)(p.ws + OFF_GATE + (size_t)br * SZ_GATE) + (size_t)(NMAIN + rc) * 1024 + quad * 8;
            const bf16_t* B = (const bf16_t*)(p.ws + OFF_WA + (size_t)br * SZ_WBR) + (size_t)(n0 + rc) * 1024 + quad * 8;
            f32x4 acc = (f32x4){0.f, 0.f, 0.f, 0.f};
#pragma unroll 1
            for (int kb = 0; kb < 32; kb += 8) { bf16x8 av[8], bv[8];
#pragma unroll
                for (int i = 0; i < 8; ++i) { av[i] = *(const bf16x8*)(A + (kb + i) * 32); bv[i] = *(const bf16x8*)(B + (kb + i) * 32); }
#pragma unroll
                for (int i = 0; i < 8; ++i) acc = __builtin_amdgcn_mfma_f32_16x16x32_bf16(av[i], bv[i], acc, 0, 0, 0); }
#pragma unroll
            for (int r = 0; r < 4; ++r) tot[r] += acc[r] * bf2f(mg[(size_t)(NMAIN + quad * 4 + r) * 6144 + br * 2048 + n0 + rc]); }
#pragma unroll
        for (int r = 0; r < 4; ++r) mb[(size_t)(NMAIN + quad * 4 + r) * DM + n0 + rc] = f2bf(tot[r]); }
}
__device__ void mini_out(const Params& p, int layer) {
    const int tid = opaque_tid(), lane = tid & 63, wv = tid >> 6, nt_ = blockIdx.x * 8 + wv;
    if (nt_ < 128) { const int rc = lane & 15, quad = lane >> 4; const int n0 = nt_ * 16;
        const bf16_t* A = (const bf16_t*)(p.ws + OFF_M) + (size_t)(NMAIN + rc) * DM + quad * 8; const bf16_t* B = (const bf16_t*)(p.ws + OFF_WO) + (size_t)(n0 + rc) * DM + quad * 8;
        f32x4 acc = (f32x4){0.f, 0.f, 0.f, 0.f};
#pragma unroll 1
        for (int kb = 0; kb < 64; kb += 8) { bf16x8 av[8], bv[8];
#pragma unroll
            for (int i = 0; i < 8; ++i) { av[i] = *(const bf16x8*)(A + (kb + i) * 32); bv[i] = *(const bf16x8*)(B + (kb + i) * 32); }
#pragma unroll
            for (int i = 0; i < 8; ++i) acc = __builtin_amdgcn_mfma_f32_16x16x32_bf16(av[i], bv[i], acc, 0, 0, 0); }
        float* h = (float*)(p.ws + OFF_H);
#pragma unroll
        for (int r = 0; r < 4; ++r) { const size_t row = NMAIN + quad * 4 + r; const float bs = layer == 0 ? p.x[(row - NMETA) * DM + n0 + rc] : h[row * DM + n0 + rc]; h[row * DM + n0 + rc] = bs + acc[r]; } }
}

#define XB_TMO      128
#define XB_XCNT(j)  (256  + 64 * (j))
#define XB_XSUB(j)  (1280 + 64 * (j))
#define XB_XGEN(j)  (2304 + 64 * (j))
#define XB_TOP      3328
#define XB_TOPGEN   3392
#define XCD_BAR_WORDS 3456
#define XB_SPIN_CAP (1u << 18)
__device__ __forceinline__ unsigned xb_ld(unsigned* p)              { return __hip_atomic_load(p, __ATOMIC_RELAXED, __HIP_MEMORY_SCOPE_AGENT); }
__device__ __forceinline__ unsigned xb_add(unsigned* p, unsigned v) { return __hip_atomic_fetch_add(p, v, __ATOMIC_RELAXED, __HIP_MEMORY_SCOPE_AGENT); }
__device__ __forceinline__ unsigned xb_xcc_id() { return (unsigned)__builtin_amdgcn_s_getreg((3 << 11) | 20) & 0xFu; }
#define XB_SPIN(cond, bar) do { unsigned _sp = 0; while (cond) { __builtin_amdgcn_s_sleep(1); \
    if ((++_sp & 255u) == 0u) { if (xb_ld(&(bar)[XB_TMO])) break; if (_sp > XB_SPIN_CAP) { atomicAdd(&(bar)[XB_TMO], 1u); break; } } } } while (0)
struct XcdBarrier { unsigned* bar; unsigned x; volatile LAS unsigned* st; };
__device__ __forceinline__ void xcd_barrier_complete(unsigned* bar, unsigned x, unsigned& nloc, unsigned& nx) {
    const unsigned G = gridDim.x * gridDim.y * gridDim.z;
    unsigned sum, cnt, mine, sp = 0u;
    for (;;) {
        sum = 0u; cnt = 0u; mine = 0u;
#pragma unroll
        for (unsigned j = 0; j < 16; ++j) { const unsigned c = xb_ld(&bar[XB_XCNT(j)]); sum += c; cnt += (c > 0u) ? 1u : 0u; mine = (j == x) ? c : mine; }
        if (sum == G) break;
        __builtin_amdgcn_s_sleep(1);
        if ((++sp & 255u) == 0u) { if (xb_ld(&bar[XB_TMO])) break; if (sp > XB_SPIN_CAP) { atomicAdd(&bar[XB_TMO], 1u); break; } }
    }
    nloc = mine > 0u ? mine : 1u; nx = cnt > 0u ? cnt : 1u;
}
__device__ __forceinline__ void xcd_barrier(const XcdBarrier& b) {
    asm volatile("s_waitcnt vmcnt(0)" ::: "memory");
    __syncthreads();
    if (threadIdx.x == 0) {
        unsigned* bar = b.bar;
        __builtin_amdgcn_s_waitcnt(0);
        unsigned nloc = b.st[0], nx = b.st[1];
        if (nloc == 0u) { xcd_barrier_complete(bar, b.x, nloc, nx); b.st[0] = nloc; b.st[1] = nx; }
        const unsigned old = xb_add(&bar[XB_XSUB(b.x)], 1u);
        const unsigned gen = old / nloc;
        if (old + 1u == (gen + 1u) * nloc) {
            __builtin_amdgcn_fence(__ATOMIC_RELEASE, "agent");
            asm volatile("s_waitcnt vmcnt(0)" ::: "memory");
            const unsigned og = xb_add(&bar[XB_TOP], 1u);
            const unsigned tg = og / nx;
            if (og + 1u == (tg + 1u) * nx) xb_add(&bar[XB_TOPGEN], 1u);
            else XB_SPIN(xb_ld(&bar[XB_TOPGEN]) == tg, bar);
            __builtin_amdgcn_fence(__ATOMIC_ACQUIRE, "agent");
            xb_add(&bar[XB_XGEN(b.x)], 1u);
            asm volatile("s_waitcnt vmcnt(0)" ::: "memory");
        } else {
            XB_SPIN(xb_ld(&bar[XB_XGEN(b.x)]) == gen, bar);
            __builtin_amdgcn_fence(__ATOMIC_ACQUIRE, "agent");
            asm volatile("s_waitcnt vmcnt(0)" ::: "memory");
        }
    }
    __syncthreads();
}

enum { OP_P1 = 0, OP_SYNC, OP_GEMM, OP_NA, OP_HYENA, OP_TRANS, OP_NOP };
__global__ void __launch_bounds__(512, 2) hybrid_fwd(Params p) {
    extern __shared__ __attribute__((aligned(16))) unsigned char smem[];
    cg::grid_group grid = cg::this_grid();
    LAS unsigned char* lds = (LAS unsigned char*)smem;
    const int bid = blockIdx.x, G = gridDim.x;
    XcdBarrier xb; xb.bar = (unsigned*)(p.ws + OFF_BAR); xb.x = xb_xcc_id(); xb.st = (volatile LAS unsigned*)(lds + LDS_PHASE_BYTES);
    if (bid == 0) for (int i = opaque_tid(); i < XCD_BAR_WORDS; i += NTHREADS) xb.bar[i] = 0u;
    if (opaque_tid() == 0) { xb.st[0] = 0u; xb.st[1] = 0u; }
    __syncthreads();
    phase_prep0(p, smem);
    constexpr int NOPS = 17;
#pragma clang loop unroll(disable)
    for (int step = 0; step < 2 * NOPS; ++step) {
        const int layer = step / NOPS, s = step - layer * NOPS;
        int op, kind = 0;
        switch (s) {
        case 0: op = OP_P1; break;
        case 2: op = OP_GEMM; kind = K_IN; break;
        case 3: case 4: op = OP_NOP; break;
        case 6: op = OP_GEMM; kind = K_FNA; break;
        case 7: op = OP_NA; break;
        case 8: op = OP_HYENA; break;
        case 10: op = OP_GEMM; kind = K_FNB; break;
        case 11: op = OP_TRANS; break;
        case 13: op = OP_GEMM; kind = K_BR; break;
        case 15: op = OP_GEMM; kind = K_OUT; break;
        default: op = OP_SYNC; break;
        }
        if (op == OP_NOP) { }
        else if (op == OP_SYNC) { if (step == 1) { grid.sync(); if (opaque_tid() == 0) (void)xb_add(&xb.bar[XB_XCNT(xb.x)], 1u); } else xcd_barrier(xb); }
        else if (op == OP_GEMM) {
            Gemm g; g.base = (const char*)p.ws; g.jumpA = 0; g.jumpB = 0;
            switch (kind) {
            case K_FNA: g.lda = 384; g.ldb = FN1P; g.nt = 6; g.ksplit = 3; g.jumpB = (long)((size_t)1024 * PROWS * 2) - 384l; break;
            case K_FNB: g.lda = 256; g.ldb = 256; g.nt = 4; g.ksplit = 4; break;
            case K_BR:  g.lda = 1024; g.ldb = 1024; g.nt = 16; g.ksplit = 16; break;
            default:    g.lda = DM; g.ldb = DM; g.nt = 32; g.ksplit = 32; break;
            }
            SchedAny S{kind, G, bid}; EpiAny E{kind, p.ws, layer, p.x, p.meta};
            if (kind == K_BR) { EpiBr EB{p.ws}; pg8::gemm_phase(lds, g, S, EB); } else pg8::gemm_phase(lds, g, S, E);
            if (kind == K_BR) mini_branch(p); else if (kind == K_OUT) mini_out(p, layer);
        }
        else if (op == OP_P1) { phase_p1(p, layer, smem); }
        else if (op == OP_NA) { na_phase(p, layer, smem); if (bid == G - 1) na_meta_unit(p, layer); }
        else if (op == OP_HYENA) { unsigned char* scrD = (unsigned char*)p.out + (size_t)bid * HSD_STRIDE; unsigned char* scrW = p.ws + WS_END + (size_t)bid * HSW_STRIDE;
            hyena_filters(p, layer, smem, scrD, scrW);
#pragma clang loop unroll(disable)
            for (int q = 0; q < 4; ++q) hyena_unit(p, layer, q, smem, scrD, scrW); }
        else { transpose_phase(p, smem); }
    }
    phase_final(p);
}

extern "C" void kernel_launch(void* const* d_in, const int* in_sizes, int n_in, void* d_out, int out_size, void* d_ws, size_t ws_size, hipStream_t stream) {
    static int grid_blocks = 0;
    if (grid_blocks == 0) {
        if (n_in != 23 || ws_size < WS_END2) { fprintf(stderr, "kernel_launch: need 23 inputs and %zu bytes of workspace (got %d, %zu)\n", (size_t)WS_END2, n_in, ws_size); grid_blocks = -1; return; }
        int dev = 0, cus = 0, per_cu = 0;
        hipGetDevice(&dev); hipDeviceGetAttribute(&cus, hipDeviceAttributeMultiprocessorCount, dev);
        if (hipFuncSetAttribute((const void*)hybrid_fwd, hipFuncAttributeMaxDynamicSharedMemorySize, LDS_BYTES) != hipSuccess) { fprintf(stderr, "kernel_launch: hipFuncSetAttribute failed\n"); grid_blocks = -1; return; }
        hipOccupancyMaxActiveBlocksPerMultiprocessor(&per_cu, (const void*)hybrid_fwd, NTHREADS, LDS_BYTES);
        if (per_cu < 1) per_cu = 1;
        grid_blocks = cus * per_cu;
        if (grid_blocks > 256) grid_blocks = 256;
        if (grid_blocks != 256) { fprintf(stderr, "kernel_launch: this kernel needs 256 co-resident workgroups (got %d)\n", grid_blocks); grid_blocks = -1; return; }
    }
    if (grid_blocks < 0) return;
    Params p{};
    const float** f = (const float**)&p;
    for (int i = 0; i < 23; ++i) f[i] = (const float*)d_in[i];
    p.out = (float*)d_out; p.ws = (unsigned char*)d_ws;
    void* args[] = {&p};
    hipError_t e = hipLaunchCooperativeKernel((const void*)hybrid_fwd, dim3(grid_blocks), dim3(NTHREADS), args, LDS_BYTES, stream);
    if (e != hipSuccess) fprintf(stderr, "cooperative launch failed: %s (grid %d)\n", hipGetErrorString(e), grid_blocks);
}
```

```cpp
#include <hip/hip_runtime.h>
#include <hip/hip_cooperative_groups.h>
#include <cstdio>
namespace cg = cooperative_groups;

#define LAS __attribute__((address_space(3)))
typedef unsigned short bf16_t;
typedef short bf16x8 __attribute__((ext_vector_type(8)));
typedef float f32x4 __attribute__((ext_vector_type(4)));
typedef unsigned u32x4 __attribute__((ext_vector_type(4)));
typedef unsigned u32x2 __attribute__((ext_vector_type(2)));

constexpr int L_TOK = 16400, LP = 16640, DM = 2048, NIN = 16384, NMETA = 16, NMAIN = 16384;
constexpr int FN1 = 164, FN2 = 100, FN1P = 192, PROWS = FN2 * FN1P;
constexpr int NTHREADS = 512, LDS_PHASE_BYTES = 155648, LDS_BYTES = LDS_PHASE_BYTES + 16;

constexpr size_t SZ_H = (size_t)LP * DM * 4, SZ_XN = (size_t)LP * DM * 2, SZ_XNP = (size_t)PROWS * DM * 2;
constexpr size_t OFF_H = 0;
constexpr size_t OFF_XN = OFF_H + SZ_H;
constexpr size_t OFF_XNP = OFF_XN + SZ_XN;
constexpr size_t OFF_A1 = OFF_XN;
constexpr size_t SZ_A1 = (size_t)FN1 * 1024 * 2 * 128 * 2;
constexpr size_t OFF_HYOUT = OFF_A1 + SZ_A1;
constexpr size_t SZ_HYOUT = (size_t)1024 * LP * 2;
static_assert(OFF_HYOUT + SZ_HYOUT <= OFF_XNP + SZ_XNP, "alias overflow");
constexpr size_t OFF_WT = OFF_XNP + SZ_XNP;
constexpr size_t OFF_WEFF = OFF_WT + (size_t)NIN * DM * 2;
constexpr size_t OFF_WA = OFF_WEFF + (size_t)2048 * 2048 * 2;
constexpr size_t SZ_WBR = (size_t)2048 * 1024 * 2;
constexpr size_t OFF_WO = OFF_WA + 3 * SZ_WBR;
constexpr size_t OFF_HYIN = OFF_WO + (size_t)2048 * 2048 * 2;
constexpr size_t OFF_GATE = OFF_HYIN + (size_t)3072 * LP * 2;
constexpr size_t SZ_GATE = (size_t)LP * 1024 * 2;
constexpr size_t OFF_QKV = OFF_GATE + 3 * SZ_GATE;
constexpr size_t OFF_MERGE = OFF_QKV + (size_t)LP * 3072 * 2;
constexpr size_t OFF_ZT = OFF_MERGE + (size_t)LP * 6144 * 2;
constexpr size_t SZ_ZT = (size_t)2048 * PROWS * 2;
constexpr size_t OFF_M = OFF_ZT;
static_assert(SZ_XN <= SZ_ZT, "alias overflow");
constexpr size_t OFF_FA = OFF_ZT + SZ_ZT;
constexpr size_t OFF_FB = OFF_FA + (size_t)512 * 384 * 2;
constexpr size_t OFF_H3 = OFF_FB + (size_t)FN1 * 256 * 256 * 2;
constexpr size_t WS_END = OFF_H3 + (size_t)2 * L_TOK * 64 * 4;
constexpr size_t HS_HEO = 0, HS_Z2 = 131328, HS_G2 = HS_Z2 + 65792, HSW_STRIDE = HS_G2 + 65792;
constexpr size_t FILT_BYTES = (size_t)L_TOK * 2, HSD_STRIDE = 393728;
constexpr size_t OFF_BAR = WS_END + 256 * HSW_STRIDE;
constexpr size_t WS_END2 = OFF_BAR + 16384;
static_assert(HSD_STRIDE >= 12 * FILT_BYTES && HSD_STRIDE * 256 <= (size_t)NMAIN * DM * 4, "scratch overflow");

struct Params {
    const float* x; const float* meta; const float* norm_g; const float* w_in; const float* conv_w; const float* conv_b;
    const float* f_w1; const float* f_b1; const float* f_w2; const float* f_b2; const float* f_w3; const float* f_b3; const float* f_w4;
    const float* f_freq; const float* decay; const float* skip; const float* rpb; const float* meta_bias;
    const float* w_a; const float* w_b; const float* w_c; const float* w_out; const float* final_g;
    float* out; unsigned char* ws;
};

__device__ __forceinline__ int opaque_tid() { int t = threadIdx.x; asm volatile("" : "+v"(t)); return t; }
__device__ __forceinline__ float bf2f(bf16_t b) { return __uint_as_float(((unsigned)b) << 16); }
__device__ __forceinline__ bf16_t f2bf(float f) { unsigned u = __float_as_uint(f); u += 0x7FFFu + ((u >> 16) & 1u); return (bf16_t)(u >> 16); }
__device__ __forceinline__ unsigned cvt_pk_bf16(float lo, float hi) { unsigned r; asm volatile("v_cvt_pk_bf16_f32 %0, %1, %2" : "=v"(r) : "v"(lo), "v"(hi)); return r; }
__device__ __forceinline__ float lo_bf(unsigned u) { return __uint_as_float(u << 16); }
__device__ __forceinline__ float hi_bf(unsigned u) { return __uint_as_float(u & 0xffff0000u); }
__device__ __forceinline__ float silu_f(float v) { return v * __builtin_amdgcn_rcpf(1.0f + __expf(-v)); }
__device__ __forceinline__ float sigm_f(float v) { return __builtin_amdgcn_rcpf(1.0f + __expf(-v)); }
__device__ __forceinline__ float wave_sum(float v) {
#pragma unroll
    for (int o = 32; o >= 1; o >>= 1) v += __shfl_xor(v, o);
    return v;
}

namespace pg8 {
constexpr int BM = 256, BK = 64, HALF = 128, HTB = HALF * BK * 2, STAGE_BYTES = 8 * HTB;
__device__ __forceinline__ int lds_byte(int r, int c) { const int st = (r >> 4) * 2 + (c >> 5), rr = r & 15, cc = c & 31, ob = rr * 64 + cc * 2; return st * 1024 + (ob ^ (((ob >> 9) & 1) << 5)); }
__device__ __forceinline__ void stage_rc(int b, int& R, int& C) { const int st = b / 1024, sb = b % 1024, swz = sb ^ (((sb >> 9) & 1) << 5); R = (st >> 1) * 16 + swz / 64; C = (st & 1) * 32 + (swz % 64) / 2; }
__device__ __forceinline__ int perm32(int rho) { const int n = rho >> 4, i = rho & 15; return 8 * (i >> 2) + 4 * n + (i & 3); }

struct Unit { int pm, pn, aux; size_t offA, offB; };
struct Gemm { const char* base; int lda, ldb, nt, ksplit; long jumpA, jumpB; };

__device__ __forceinline__ void tile_map(int wgid, int nM, int nN, int& pm, int& pn) {
    const int nwg = nM * nN;
    { const int q = nwg / 8, r = nwg % 8, xcd = wgid % 8, off = wgid / 8; wgid = (xcd < r ? xcd * (q + 1) : r * (q + 1) + (xcd - r) * q) + off; }
    const int nig = 8 * nN, gid = wgid / nig, fm = gid * 8, gsz = (nM - fm) < 8 ? (nM - fm) : 8;
    pm = fm + ((wgid % nig) % gsz); pn = (wgid % nig) / gsz;
}

template <class Epi, class Sched>
__device__ __forceinline__ void gemm_phase(LAS unsigned char* lds, const Gemm g, const Sched& S, const Epi& E) {
    const int tid = opaque_tid(), wid = __builtin_amdgcn_readfirstlane(tid >> 6), lane = tid & 63, wr = wid >> 2, wc = wid & 3, fr = lane & 15, fq = lane >> 4;
    const int nt = g.nt;
    unsigned voffA[2], voffB[2];
#pragma unroll
    for (int i = 0; i < 2; ++i) { int R, C; stage_rc(tid * 16 + i * 8192, R, C); const int Rb = (R & ~31) + perm32(R & 31);
        voffA[i] = (unsigned)(R * g.lda + C) * 2u; voffB[i] = (unsigned)(Rb * g.ldb + C) * 2u; }
    const size_t kstep = (size_t)(BK * 2);
    const size_t hstepA = (size_t)HALF * g.lda * 2, hstepB = (size_t)HALF * g.ldb * 2;
    const unsigned ldsw = (unsigned)wid * 1024u;
    const int aoff = lds_byte(wr * 64 + fr, fq * 8), boff = lds_byte(wc * 32 + fr, fq * 8);
#define PG8_KA(p, t) ((p) + (size_t)(t) * kstep + ((t) >= g.ksplit ? g.jumpA : 0l))
#define PG8_KB(p, t) ((p) + (size_t)(t) * kstep + ((t) >= g.ksplit ? g.jumpB : 0l))
#define PG8_SA(b, h) (((b) * 2 + (h)) * HTB)
#define PG8_SB(b, h) ((4 + (b) * 2 + (h)) * HTB)
#define PG8_STAGE(bufoff, gbase, voff) do { _Pragma("unroll") for (int _i = 0; _i < 2; ++_i) \
        __builtin_amdgcn_global_load_lds((const unsigned*)((const char*)(gbase) + (voff)[_i]), (LAS unsigned*)(lds + (bufoff) + ldsw + _i * 8192), 16, 0, 0); } while (0)
#define PG8_LDA(dst, b, h) do { _Pragma("unroll") for (int m = 0; m < 4; ++m) _Pragma("unroll") for (int k = 0; k < 2; ++k) dst[m][k] = *(const LAS bf16x8*)(lds + PG8_SA(b, h) + aoff + m * 2048 + k * 1024); } while (0)
#define PG8_LDB(dst, b, h) do { _Pragma("unroll") for (int n = 0; n < 2; ++n) _Pragma("unroll") for (int k = 0; k < 2; ++k) dst[n][k] = *(const LAS bf16x8*)(lds + PG8_SB(b, h) + boff + n * 2048 + k * 1024); } while (0)
#define PG8_MMA(ai, bj, At, Bt) do { __builtin_amdgcn_s_setprio(1); _Pragma("unroll") for (int m = 0; m < 4; ++m) _Pragma("unroll") for (int n = 0; n < 2; ++n) _Pragma("unroll") for (int k = 0; k < 2; ++k) \
        acc[ai][bj][m][n] = __builtin_amdgcn_mfma_f32_16x16x32_bf16(Bt[n][k], At[m][k], acc[ai][bj][m][n], 0, 0, 0); __builtin_amdgcn_s_setprio(0); } while (0)
#define PG8_WAIT_V(n) asm volatile("s_waitcnt vmcnt(" #n ")" ::: "memory")
#define PG8_WAIT_L(n) asm volatile("s_waitcnt lgkmcnt(" #n ")" ::: "memory")
#define PG8_BAR __builtin_amdgcn_s_barrier()
#define PG8_SCHED __builtin_amdgcn_sched_barrier(0)
    Unit cur, nxt; int ui = 0;
    if (!S.next(0, cur)) return;
    f32x4 acc[2][2][4][2];
#pragma unroll
    for (int a = 0; a < 2; ++a)
#pragma unroll
        for (int b = 0; b < 2; ++b)
#pragma unroll
            for (int m = 0; m < 4; ++m)
#pragma unroll
                for (int n = 0; n < 2; ++n) acc[a][b][m][n] = (f32x4){0.f, 0.f, 0.f, 0.f};
    bf16x8 At[4][2], B0[2][2], B1[2][2];
    const char* cA = g.base + cur.offA; const char* cB = g.base + cur.offB;
    PG8_STAGE(PG8_SB(0, 0), cB, voffB); PG8_STAGE(PG8_SA(0, 0), cA, voffA); PG8_STAGE(PG8_SB(0, 1), cB + hstepB, voffB); PG8_STAGE(PG8_SA(0, 1), cA + hstepA, voffA);
    if (wr == 1) PG8_BAR;
    PG8_WAIT_V(4); PG8_BAR;
    PG8_STAGE(PG8_SB(1, 0), PG8_KB(cB, 1), voffB); PG8_STAGE(PG8_SA(1, 0), PG8_KA(cA, 1), voffA); PG8_STAGE(PG8_SB(1, 1), PG8_KB(cB, 1) + hstepB, voffB);
    PG8_WAIT_V(6); PG8_BAR;
    for (;;) {
        const bool has_next = S.next(ui + 1, nxt);
        const char* nA = has_next ? g.base + nxt.offA : cA; const char* nB = has_next ? g.base + nxt.offB : cB;
        for (int t = 0; t < nt; t += 2) {
            const bool last = (t == nt - 2);
            const char* a1 = PG8_KA(cA, t + 1);
            const char* a2 = last ? nA : PG8_KA(cA, t + 2); const char* b2 = last ? nB : PG8_KB(cB, t + 2);
            const char* a3 = last ? PG8_KA(nA, 1) : PG8_KA(cA, t + 3); const char* b3 = last ? PG8_KB(nB, 1) : PG8_KB(cB, t + 3);
            PG8_LDB(B0, 0, 0); PG8_SCHED; PG8_LDA(At, 0, 0); PG8_STAGE(PG8_SA(1, 1), a1 + hstepA, voffA);
            PG8_WAIT_L(8); PG8_BAR; PG8_WAIT_L(0); PG8_MMA(0, 0, At, B0); PG8_BAR; PG8_SCHED;
            PG8_LDB(B1, 0, 1); PG8_STAGE(PG8_SB(0, 0), b2, voffB);
            PG8_BAR; PG8_WAIT_L(0); PG8_MMA(0, 1, At, B1); PG8_BAR;
            PG8_LDA(At, 0, 1); PG8_STAGE(PG8_SA(0, 0), a2, voffA);
            PG8_BAR; PG8_WAIT_L(0); PG8_MMA(1, 0, At, B0); PG8_BAR; PG8_SCHED;
            PG8_STAGE(PG8_SB(0, 1), b2 + hstepB, voffB);
            PG8_WAIT_V(6); PG8_BAR; PG8_MMA(1, 1, At, B1); PG8_BAR;
            PG8_LDB(B0, 1, 0); PG8_SCHED; PG8_LDA(At, 1, 0); PG8_STAGE(PG8_SA(0, 1), a2 + hstepA, voffA);
            PG8_WAIT_L(8); PG8_BAR; PG8_WAIT_L(0); PG8_MMA(0, 0, At, B0); PG8_BAR; PG8_SCHED;
            PG8_LDB(B1, 1, 1); PG8_STAGE(PG8_SB(1, 0), b3, voffB);
            PG8_BAR; PG8_WAIT_L(0); PG8_MMA(0, 1, At, B1); PG8_BAR;
            PG8_LDA(At, 1, 1); PG8_STAGE(PG8_SA(1, 0), a3, voffA);
            PG8_BAR; PG8_WAIT_L(0); PG8_MMA(1, 0, At, B0); PG8_BAR; PG8_SCHED;
            PG8_STAGE(PG8_SB(1, 1), b3 + hstepB, voffB);
            PG8_WAIT_V(6); PG8_BAR; PG8_MMA(1, 1, At, B1); PG8_BAR;
        }
        E(acc, cur, wr, wc, fr, fq);
        if (!has_next) break;
        { const float zf = E.keep(cur) ? 1.0f : 0.0f;
#pragma unroll
        for (int a = 0; a < 2; ++a)
#pragma unroll
            for (int b = 0; b < 2; ++b)
#pragma unroll
                for (int m = 0; m < 4; ++m)
#pragma unroll
                    for (int n = 0; n < 2; ++n) acc[a][b][m][n] *= zf; }
        cur = nxt; cA = nA; cB = nB; ++ui;
    }
    PG8_WAIT_V(0);
    if (wr == 0) PG8_BAR;
    PG8_BAR;
#undef PG8_KA
#undef PG8_KB
#undef PG8_SA
#undef PG8_SB
#undef PG8_STAGE
#undef PG8_LDA
#undef PG8_LDB
#undef PG8_MMA
#undef PG8_WAIT_V
#undef PG8_WAIT_L
#undef PG8_BAR
#undef PG8_SCHED
}
}
using pg8::Unit; using pg8::Gemm;
#define ACC_T f32x4 (&acc)[2][2][4][2]

enum { K_TOK = 0, K_HYIN = 1, K_F0 = 2, K_FNA = 3, K_FNB = 4, K_BR = 5, K_OUT = 6, K_IN = 7 };
struct SchedAny {
    int kind, G, c;
    __device__ __forceinline__ bool next(int i, Unit& u) const {
        const long Lx = (long)i * G + c;
        switch (kind) {
        case K_IN: {
            if (Lx < 3120) { int pn; pg8::tile_map((int)Lx, 65, 48, u.pm, pn); u.pn = pn < 4 ? 12 + pn : 16 + pn; u.aux = K_TOK;
                u.offA = OFF_XN + (size_t)u.pm * 256 * DM * 2; u.offB = OFF_WT + (size_t)u.pn * 256 * DM * 2; return true; }
            if (Lx < 3900) { pg8::tile_map((int)Lx - 3120, 12, 65, u.pm, u.pn); u.aux = K_HYIN;
                u.offA = OFF_WT + (size_t)u.pm * 256 * DM * 2; u.offB = OFF_XN + (size_t)u.pn * 256 * DM * 2; return true; }
            if (Lx < 4200) { pg8::tile_map((int)Lx - 3900, 4, 75, u.pm, u.pn); u.aux = K_F0;
                u.offA = OFF_WEFF + (size_t)u.pm * 256 * DM * 2; u.offB = OFF_XNP + (size_t)u.pn * 256 * DM * 2; return true; }
            return false; }
        case K_TOK: {
            if (Lx >= 65l * 48) return false; int pn; pg8::tile_map((int)Lx, 65, 48, u.pm, pn); u.pn = pn < 4 ? 12 + pn : 16 + pn; u.aux = 0;
            u.offA = OFF_XN + (size_t)u.pm * 256 * DM * 2; u.offB = OFF_WT + (size_t)u.pn * 256 * DM * 2; return true; }
        case K_HYIN: {
            if (Lx >= 12l * 65) return false; pg8::tile_map((int)Lx, 12, 65, u.pm, u.pn); u.aux = 0;
            u.offA = OFF_WT + (size_t)u.pm * 256 * DM * 2; u.offB = OFF_XN + (size_t)u.pn * 256 * DM * 2; return true; }
        case K_F0: {
            if (Lx >= 8l * 75) return false; pg8::tile_map((int)Lx, 8, 75, u.pm, u.pn); u.aux = 0;
            u.offA = OFF_WEFF + (size_t)u.pm * 256 * DM * 2; u.offB = OFF_XNP + (size_t)u.pn * 256 * DM * 2; return true; }
        case K_FNA: {
            if (Lx >= 2l * 400) return false; pg8::tile_map((int)Lx, 2, 400, u.pm, u.pn); u.aux = 0;
            u.offA = OFF_FA + (size_t)u.pm * 256 * 384 * 2; u.offB = OFF_ZT + (size_t)u.pn * 256 * FN1P * 2; return true; }
        case K_FNB: {
            if (Lx >= 164l * 4) return false; u.aux = (int)(Lx >> 2); u.pm = 0; u.pn = (int)(Lx & 3);
            u.offA = OFF_FB + (size_t)u.aux * 256 * 256 * 2; u.offB = OFF_A1 + (size_t)u.aux * 1024 * 256 * 2 + (size_t)u.pn * 256 * 256 * 2; return true; }
        case K_BR: {
            const int T = (i / 3) * G + c; if (T >= 64 * 8) return false; const int br = i % 3; pg8::tile_map(T, 64, 8, u.pm, u.pn); u.aux = br;
            u.offA = OFF_GATE + (size_t)br * SZ_GATE + (size_t)u.pm * 256 * 1024 * 2; u.offB = OFF_WA + (size_t)br * SZ_WBR + (size_t)u.pn * 256 * 1024 * 2; return true; }
        default: {
            if (Lx >= 64l * 8) return false; pg8::tile_map((int)Lx, 64, 8, u.pm, u.pn); u.aux = 0;
            u.offA = OFF_M + (size_t)u.pm * 256 * DM * 2; u.offB = OFF_WO + (size_t)u.pn * 256 * DM * 2; return true; }
        }
    }
};
#define ROWFENCE asm volatile("" ::: "memory")
#define HARDFENCE do { asm volatile("" ::: "memory"); __builtin_amdgcn_sched_barrier(0); } while (0)
struct EpiAny {
    int kind; unsigned char* ws; int layer; const float* xin; const float* metain;
    __device__ __forceinline__ bool keep(const Unit&) const { return false; }
    __device__ __forceinline__ void operator()(ACC_T, const Unit& u, int wr, int wc, int fr, int fq) const {
        const int rl0 = wr * 64 + fr, cl0 = wc * 32 + 8 * fq;
        const int ek = kind == K_IN ? u.aux : kind;
        if (ek == K_TOK) {
            const int t = u.pn; unsigned char* dst; unsigned ld; int c0, act;
            if (t < 16)      { dst = ws + OFF_GATE;               ld = 1024; c0 = (t - 12) * 256; act = 1; }
            else if (t < 24) { dst = ws + OFF_GATE + SZ_GATE;     ld = 1024; c0 = (t - 20) * 256; act = 1; }
            else if (t < 36) { dst = ws + OFF_QKV;                ld = 3072; c0 = (t - 24) * 256; act = 0; }
            else if (t < 40) { dst = ws + OFF_GATE + 2 * SZ_GATE; ld = 1024; c0 = (t - 36) * 256; act = 1; }
            else             { dst = ws + OFF_MERGE;              ld = 6144; c0 = (t - 40) * 256; act = 2; }
#pragma unroll
            for (int ai = 0; ai < 2; ++ai)
#pragma unroll
                for (int m = 0; m < 4; ++m) { const unsigned row = (unsigned)(u.pm * 256 + ai * 128 + m * 16 + rl0);
#pragma unroll
                    for (int bj = 0; bj < 2; ++bj) { const unsigned off = (row * ld + (unsigned)(c0 + bj * 128 + cl0)) * 2u; f32x4 v0 = acc[ai][bj][m][0], v1 = acc[ai][bj][m][1];
                        if (act == 1) {
#pragma unroll
                            for (int j = 0; j < 4; ++j) { v0[j] = silu_f(v0[j]); v1[j] = silu_f(v1[j]); } }
                        else if (act == 2) {
#pragma unroll
                            for (int j = 0; j < 4; ++j) { v0[j] = sigm_f(v0[j]); v1[j] = sigm_f(v1[j]); } }
                        u32x4 w; w.x = cvt_pk_bf16(v0[0], v0[1]); w.y = cvt_pk_bf16(v0[2], v0[3]); w.z = cvt_pk_bf16(v1[0], v1[1]); w.w = cvt_pk_bf16(v1[2], v1[3]);
                        *(u32x4*)(dst + off) = w; }
                    ROWFENCE; }
        } else if (ek == K_HYIN) {
            unsigned char* dst = ws + OFF_HYIN; const unsigned ld = LP;
#pragma unroll
            for (int ai = 0; ai < 2; ++ai)
#pragma unroll
                for (int m = 0; m < 4; ++m) { const unsigned row = (unsigned)(u.pm * 256 + ai * 128 + m * 16 + rl0);
#pragma unroll
                    for (int bj = 0; bj < 2; ++bj) { const unsigned off = (row * ld + (unsigned)(u.pn * 256 + bj * 128 + cl0)) * 2u; const f32x4 v0 = acc[ai][bj][m][0], v1 = acc[ai][bj][m][1];
                        u32x4 w; w.x = cvt_pk_bf16(v0[0], v0[1]); w.y = cvt_pk_bf16(v0[2], v0[3]); w.z = cvt_pk_bf16(v1[0], v1[1]); w.w = cvt_pk_bf16(v1[2], v1[3]);
                        *(u32x4*)(dst + off) = w; }
                    ROWFENCE; }
        } else if (ek == K_F0) {
            int rlx = rl0, clx = cl0; asm volatile("" : "+v"(rlx), "+v"(clx));
            unsigned char* dst = ws + OFF_ZT; const int g = u.pm; const unsigned colb0 = (unsigned)(u.pn * 256 + clx) * 2u;
#pragma unroll
            for (int ai = 0; ai < 2; ++ai)
#pragma unroll
                for (int m = 0; m < 4; ++m) { const int j = ai * 128 + m * 16 + rlx; const int part = j <= 128 ? 0 : 1; const int cp = j - 128 * part;
                    const unsigned o1 = (unsigned)(part * 1024 + g * 256 + cp) * (unsigned)(PROWS * 2) + colb0;
                    const bool mir = cp >= 1 && cp <= 127; const bool zim = part == 0 && !mir;
                    const unsigned o2 = (unsigned)((mir ? part : 1) * 1024 + g * 256 + (mir ? 256 - cp : cp)) * (unsigned)(PROWS * 2) + colb0;
                    const unsigned sgn = part == 1 ? 0x80008000u : 0u, msk = zim ? 0u : 0xffffffffu;
#pragma unroll
                    for (int bj = 0; bj < 2; ++bj) { const f32x4 v0 = acc[ai][bj][m][0], v1 = acc[ai][bj][m][1];
                        u32x4 w; w.x = cvt_pk_bf16(v0[0], v0[1]); w.y = cvt_pk_bf16(v0[2], v0[3]); w.z = cvt_pk_bf16(v1[0], v1[1]); w.w = cvt_pk_bf16(v1[2], v1[3]);
                        *(u32x4*)(dst + o1 + bj * 256) = w;
                        u32x4 wm; wm.x = (w.x ^ sgn) & msk; wm.y = (w.y ^ sgn) & msk; wm.z = (w.z ^ sgn) & msk; wm.w = (w.w ^ sgn) & msk;
                        *(u32x4*)(dst + o2 + bj * 256) = wm; }
                    ROWFENCE; }
        } else if (ek == K_FNA) {
            unsigned char* dst = ws + OFF_A1;
#pragma unroll
            for (int ai = 0; ai < 2; ++ai)
#pragma unroll
                for (int m = 0; m < 4; ++m) { const int k1 = ai * 128 + m * 16 + rl0;
                    if (k1 < FN1) {
#pragma unroll
                        for (int bj = 0; bj < 2; ++bj)
#pragma unroll
                            for (int n = 0; n < 2; ++n) { const int col = u.pn * 256 + bj * 128 + cl0 + 4 * n; const int ch = col / FN2, l2 = col - ch * FN2; const f32x4 v = acc[ai][bj][m][n];
                                u32x2 w; w.x = cvt_pk_bf16(v[0], v[1]); w.y = cvt_pk_bf16(v[2], v[3]);
                                *(u32x2*)(dst + ((unsigned)((k1 * 1024 + ch) * 2 + u.pm) * 128u + (unsigned)l2) * 2u) = w; } }
                    ROWFENCE; }
        } else if (ek == K_FNB) {
            unsigned char* dst = ws + OFF_GATE + SZ_GATE; const float scale = 1.0f / sqrtf((float)L_TOK * 256.0f);
#pragma unroll
            for (int ai = 0; ai < 2; ++ai)
#pragma unroll
                for (int m = 0; m < 4; ++m) { const int k2 = ai * 128 + m * 16 + rl0;
                    if (k2 < FN2) { const unsigned row = (unsigned)(u.aux + FN1 * k2);
#pragma unroll
                        for (int bj = 0; bj < 2; ++bj) { const unsigned off = (row * 1024u + (unsigned)(u.pn * 256 + bj * 128 + cl0)) * 2u; const u32x4 g = *(const u32x4*)(dst + off);
                            const f32x4 v0 = acc[ai][bj][m][0] * scale, v1 = acc[ai][bj][m][1] * scale;
                            u32x4 w; w.x = cvt_pk_bf16(v0[0] * lo_bf(g.x), v0[1] * hi_bf(g.x)); w.y = cvt_pk_bf16(v0[2] * lo_bf(g.y), v0[3] * hi_bf(g.y));
                            w.z = cvt_pk_bf16(v1[0] * lo_bf(g.z), v1[1] * hi_bf(g.z)); w.w = cvt_pk_bf16(v1[2] * lo_bf(g.w), v1[3] * hi_bf(g.w));
                            *(u32x4*)(dst + off) = w; } }
                    ROWFENCE; }
        } else {
            unsigned char* dst = ws + OFF_H;
#pragma unroll
            for (int ai = 0; ai < 2; ++ai) { f32x4 oq[4][2][2];
#pragma unroll
                for (int m = 0; m < 4; ++m) { const unsigned row = (unsigned)(u.pm * 256 + ai * 128 + m * 16 + rl0);
                    const float* srow = layer == 0 ? (row < (unsigned)NMETA ? metain + (size_t)row * DM : xin + (size_t)(row - NMETA) * DM) : (const float*)(dst + (size_t)row * DM * 4);
#pragma unroll
                    for (int bj = 0; bj < 2; ++bj) { const unsigned col = (unsigned)(u.pn * 256 + bj * 128 + cl0); oq[m][bj][0] = *(const f32x4*)(srow + col); oq[m][bj][1] = *(const f32x4*)(srow + col + 4); } }
#pragma unroll
                for (int m = 0; m < 4; ++m) { const unsigned row = (unsigned)(u.pm * 256 + ai * 128 + m * 16 + rl0);
#pragma unroll
                    for (int bj = 0; bj < 2; ++bj) { const unsigned off = (row * (unsigned)DM + (unsigned)(u.pn * 256 + bj * 128 + cl0)) * 4u;
                        *(f32x4*)(dst + off) = oq[m][bj][0] + acc[ai][bj][m][0]; *(f32x4*)(dst + off + 16) = oq[m][bj][1] + acc[ai][bj][m][1]; } }
                ROWFENCE; }
        }
    }
};

struct EpiBr {
    unsigned char* ws;
    __device__ __forceinline__ bool keep(const Unit& u) const { return u.aux < 2; }
    __device__ __forceinline__ void operator()(ACC_T, const Unit& u, int wr, int wc, int fr, int fq) const {
        const int rl0 = wr * 64 + fr, cl0 = wc * 32 + 8 * fq;
            unsigned char* dst = ws + OFF_M; const unsigned char* mg = ws + OFF_MERGE; const int br = u.aux;
#pragma unroll
            for (int ai = 0; ai < 2; ++ai)
#pragma unroll
              for (int mh = 0; mh < 4; mh += 2) { u32x4 gn[2][2], gd[2][2];
#pragma unroll
                for (int mm = 0; mm < 2; ++mm) { const unsigned row = (unsigned)(u.pm * 256 + ai * 128 + (mh + mm) * 16 + rl0);
#pragma unroll
                    for (int bj = 0; bj < 2; ++bj) { const unsigned col = (unsigned)(u.pn * 256 + bj * 128 + cl0);
                        gn[mm][bj] = *(const u32x4*)(mg + (row * 6144u + (unsigned)br * 2048u + col) * 2u);
                        if (br < 2) gd[mm][bj] = *(const u32x4*)(mg + (row * 6144u + (unsigned)(br + 1) * 2048u + col) * 2u); else gd[mm][bj] = (u32x4){0x3f803f80u, 0x3f803f80u, 0x3f803f80u, 0x3f803f80u}; } }
#pragma unroll
                for (int mm = 0; mm < 2; ++mm) { const int m = mh + mm; const unsigned row = (unsigned)(u.pm * 256 + ai * 128 + m * 16 + rl0);
#pragma unroll
                    for (int bj = 0; bj < 2; ++bj) { const u32x4 g = gn[mm][bj], d = gd[mm][bj];
                        const float s0 = lo_bf(g.x) * __builtin_amdgcn_rcpf(fmaxf(lo_bf(d.x), 1e-30f)), s1 = hi_bf(g.x) * __builtin_amdgcn_rcpf(fmaxf(hi_bf(d.x), 1e-30f));
                        const float s2 = lo_bf(g.y) * __builtin_amdgcn_rcpf(fmaxf(lo_bf(d.y), 1e-30f)), s3 = hi_bf(g.y) * __builtin_amdgcn_rcpf(fmaxf(hi_bf(d.y), 1e-30f));
                        const float s4 = lo_bf(g.z) * __builtin_amdgcn_rcpf(fmaxf(lo_bf(d.z), 1e-30f)), s5 = hi_bf(g.z) * __builtin_amdgcn_rcpf(fmaxf(hi_bf(d.z), 1e-30f));
                        const float s6 = lo_bf(g.w) * __builtin_amdgcn_rcpf(fmaxf(lo_bf(d.w), 1e-30f)), s7 = hi_bf(g.w) * __builtin_amdgcn_rcpf(fmaxf(hi_bf(d.w), 1e-30f));
                        f32x4 v0 = acc[ai][bj][m][0], v1 = acc[ai][bj][m][1];
                        v0[0] *= s0; v0[1] *= s1; v0[2] *= s2; v0[3] *= s3; v1[0] *= s4; v1[1] *= s5; v1[2] *= s6; v1[3] *= s7;
                        acc[ai][bj][m][0] = v0; acc[ai][bj][m][1] = v1;
                        if (br == 2) { const unsigned col = (unsigned)(u.pn * 256 + bj * 128 + cl0);
                            u32x4 w; w.x = cvt_pk_bf16(v0[0], v0[1]); w.y = cvt_pk_bf16(v0[2], v0[3]); w.z = cvt_pk_bf16(v1[0], v1[1]); w.w = cvt_pk_bf16(v1[2], v1[3]);
                            *(u32x4*)(dst + (row * (unsigned)DM + col) * 2u) = w; } } }
                ROWFENCE; }
    }
};

__device__ void phase_prep0(const Params& p, unsigned char* smem) {
    const int tid = opaque_tid(), bid = blockIdx.x, G = gridDim.x;
    const size_t gtid = (size_t)bid * NTHREADS + tid, gstride = (size_t)G * NTHREADS;
    { bf16_t* fa = (bf16_t*)(p.ws + OFF_FA);
      for (size_t i = gtid; i < (size_t)512 * 384; i += gstride) { const int row = (int)(i / 384), col = (int)(i % 384); const int po = row >> 8, k1 = row & 255, pi = col / 192, l1 = col % 192; float v = 0.f;
          if (k1 < FN1 && l1 < FN1) { const int r = (k1 * l1) % FN1; const float a = (float)r / (float)FN1; const float cs = __builtin_amdgcn_cosf(a), sn = __builtin_amdgcn_sinf(a);
              v = (po == 0) ? (pi == 0 ? cs : sn) : (pi == 0 ? -sn : cs); }
          fa[i] = f2bf(v); } }
    { bf16_t* fb = (bf16_t*)(p.ws + OFF_FB);
      for (size_t i = gtid; i < (size_t)FN1 * 65536; i += gstride) { const int k1 = (int)(i >> 16), k2 = (int)((i >> 8) & 255), kk = (int)(i & 255), part = kk >> 7, l2 = kk & 127; float v = 0.f;
          if (k2 < FN2 && l2 < FN2) { const int lp = k1 + FN1 * k2; const int r = (l2 * lp) % L_TOK; const float a = (float)r / (float)L_TOK; v = part == 0 ? __builtin_amdgcn_cosf(a) : __builtin_amdgcn_sinf(a); }
          fb[i] = f2bf(v); } }
    { float* w1s = (float*)smem;
      float* w2s = w1s + 33 * 64;
      float* w3s = w2s + 64 * 64;
      const int lane = tid & 63, wv = tid >> 6;
      for (int layer = 0; layer < 2; ++layer) {
          __syncthreads();
          for (int i = tid; i < 33 * 64; i += NTHREADS) w1s[i] = p.f_w1[layer * 33 * 64 + i];
          for (int i = tid; i < 64 * 64; i += NTHREADS) { w2s[i] = p.f_w2[layer * 4096 + i]; w3s[i] = p.f_w3[layer * 4096 + i]; }
          __syncthreads();
          const float b1 = p.f_b1[layer * 64 + lane], b2 = p.f_b2[layer * 64 + lane], b3 = p.f_b3[layer * 64 + lane], fr = p.f_freq[layer * 64 + lane];
          bf16_t* h3 = (bf16_t*)(p.ws + OFF_H3) + (size_t)layer * L_TOK * 64;
          constexpr float INV2PI = 0.15915494309189535f;
          for (int lag0 = bid * 8 + wv; lag0 < L_TOK; lag0 += G * 16) {
              const int lagA = lag0, lagB = lag0 + G * 8; const bool hasB = lagB < L_TOK; const int lagBc = hasB ? lagB : lagA;
              float zA = 0.f, zB = 0.f;
              if (lane == 0) { zA = (float)lagA / (float)(L_TOK - 1); zB = (float)lagBc / (float)(L_TOK - 1); }
              else if (lane < 33) { const int j = (lane - 1) & 15; const float f = 1e-4f + (float)j * ((15.0f - 1e-4f) / 15.0f);
                  const float rA = f * ((float)lagA / (float)L_TOK), rB = f * ((float)lagBc / (float)L_TOK);
                  zA = lane < 17 ? __builtin_amdgcn_cosf(rA) : -__builtin_amdgcn_sinf(rA); zB = lane < 17 ? __builtin_amdgcn_cosf(rB) : -__builtin_amdgcn_sinf(rB); }
              float aA = b1, aB = b1;
#pragma unroll 3
              for (int i = 0; i < 33; ++i) { const float wgt = w1s[i * 64 + lane]; aA += __int_as_float(__builtin_amdgcn_readlane(__float_as_int(zA), i)) * wgt; aB += __int_as_float(__builtin_amdgcn_readlane(__float_as_int(zB), i)) * wgt; }
              const float h1A = __builtin_amdgcn_sinf(fr * aA * INV2PI), h1B = __builtin_amdgcn_sinf(fr * aB * INV2PI);
              aA = b2; aB = b2;
#pragma unroll 8
              for (int i = 0; i < 64; ++i) { const float wgt = w2s[i * 64 + lane]; aA += __int_as_float(__builtin_amdgcn_readlane(__float_as_int(h1A), i)) * wgt; aB += __int_as_float(__builtin_amdgcn_readlane(__float_as_int(h1B), i)) * wgt; }
              const float h2A = __builtin_amdgcn_sinf(fr * aA * INV2PI), h2B = __builtin_amdgcn_sinf(fr * aB * INV2PI);
              aA = b3; aB = b3;
#pragma unroll 8
              for (int i = 0; i < 64; ++i) { const float wgt = w3s[i * 64 + lane]; aA += __int_as_float(__builtin_amdgcn_readlane(__float_as_int(h2A), i)) * wgt; aB += __int_as_float(__builtin_amdgcn_readlane(__float_as_int(h2B), i)) * wgt; }
              h3[(size_t)lagA * 64 + lane] = f2bf(__builtin_amdgcn_sinf(fr * aA * INV2PI));
              if (hasB) h3[(size_t)lagB * 64 + lane] = f2bf(__builtin_amdgcn_sinf(fr * aB * INV2PI));
          }
      }
      __syncthreads(); }
}

__device__ void convert_matrix(const float* __restrict__ src, int K, int N, bf16_t* __restrict__ dst, int kshift  , int total, float* tile  ) {
    const int tid = opaque_tid(), G = gridDim.x; const int kl0 = tid >> 4, n4 = (tid & 15) * 4, nl = tid >> 3, k8 = (tid & 7) * 8;
    f32x4 pv0 = (f32x4){0.f, 0.f, 0.f, 0.f}, pv1 = pv0;
    int t = blockIdx.x;
    if (t < total) { const int kt = t & ((1 << kshift) - 1), nt_ = t >> kshift; const float* s = src + (size_t)(kt * 64 + kl0) * N + nt_ * 64 + n4; pv0 = *(const f32x4*)s; pv1 = *(const f32x4*)(s + (size_t)32 * N); }
    int buf = 0;
    for (; t < total; t += G) { float* tl = tile + buf * (64 * 65); const int kt = t & ((1 << kshift) - 1), nt_ = t >> kshift;
        tl[kl0 * 65 + n4] = pv0[0]; tl[kl0 * 65 + n4 + 1] = pv0[1]; tl[kl0 * 65 + n4 + 2] = pv0[2]; tl[kl0 * 65 + n4 + 3] = pv0[3];
        tl[(32 + kl0) * 65 + n4] = pv1[0]; tl[(32 + kl0) * 65 + n4 + 1] = pv1[1]; tl[(32 + kl0) * 65 + n4 + 2] = pv1[2]; tl[(32 + kl0) * 65 + n4 + 3] = pv1[3];
        { const int tn = t + G; if (tn < total) { const int kt2 = tn & ((1 << kshift) - 1), nt2 = tn >> kshift; const float* s = src + (size_t)(kt2 * 64 + kl0) * N + nt2 * 64 + n4; pv0 = *(const f32x4*)s; pv1 = *(const f32x4*)(s + (size_t)32 * N); } }
        __syncthreads();
        u32x4 w; w.x = cvt_pk_bf16(tl[(k8 + 0) * 65 + nl], tl[(k8 + 1) * 65 + nl]); w.y = cvt_pk_bf16(tl[(k8 + 2) * 65 + nl], tl[(k8 + 3) * 65 + nl]);
        w.z = cvt_pk_bf16(tl[(k8 + 4) * 65 + nl], tl[(k8 + 5) * 65 + nl]); w.w = cvt_pk_bf16(tl[(k8 + 6) * 65 + nl], tl[(k8 + 7) * 65 + nl]);
        *(u32x4*)(dst + (size_t)(nt_ * 64 + nl) * K + kt * 64 + k8) = w;
        buf ^= 1; }
    __syncthreads();
}

__device__ void phase_p1(const Params& p, int layer, unsigned char* smem) {
    const int tid = opaque_tid(), bid = blockIdx.x, G = gridDim.x;
    float* tile = (float*)smem;
    { const float* win = p.w_in + (size_t)layer * DM * NIN;
      convert_matrix(win, DM, NIN, (bf16_t*)(p.ws + OFF_WT), 5, 32 * 256, tile);
      for (int br = 0; br < 3; ++br) { const float* wsrc = (br == 0 ? p.w_a : br == 1 ? p.w_b : p.w_c) + (size_t)layer * 1024 * DM;
          convert_matrix(wsrc, 1024, DM, (bf16_t*)(p.ws + OFF_WA + br * SZ_WBR), 4, 16 * 32, tile); }
      const float* wo = p.w_out + (size_t)layer * DM * DM;
      convert_matrix(wo, DM, DM, (bf16_t*)(p.ws + OFF_WO), 5, 32 * 32, tile);
      __syncthreads(); }
    { const float* win = p.w_in + (size_t)layer * DM * NIN;
      const int lane = tid & 63, wv = tid >> 6, l15 = lane & 15, quad = lane >> 4;
      for (int t = bid; t < 256; t += G) { const int g = t >> 6, k0 = (t & 63) * 32;
          f32x4 acc[2][2];
#pragma unroll
          for (int jt = 0; jt < 2; ++jt)
#pragma unroll
              for (int nt_ = 0; nt_ < 2; ++nt_) acc[jt][nt_] = (f32x4){0.f, 0.f, 0.f, 0.f};
#pragma unroll 4
          for (int ks = 0; ks < 8; ++ks) { const int c0 = ks * 32 + quad * 8;
              bf16x8 bfr[2];
#pragma unroll
              for (int nt_ = 0; nt_ < 2; ++nt_) { const float* wp = win + (size_t)(k0 + nt_ * 16 + l15) * NIN + 4096 + g * 256 + c0; const f32x4 x0 = *(const f32x4*)wp, x1 = *(const f32x4*)(wp + 4);
                  u32x4 pk; pk.x = cvt_pk_bf16(x0[0], x0[1]); pk.y = cvt_pk_bf16(x0[2], x0[3]); pk.z = cvt_pk_bf16(x1[0], x1[1]); pk.w = cvt_pk_bf16(x1[2], x1[3]); bfr[nt_] = __builtin_bit_cast(bf16x8, pk); }
#pragma unroll
              for (int jt = 0; jt < 2; ++jt) { const int j = wv * 32 + jt * 16 + l15; const bool im = j > 128; const int cp = im ? j - 128 : j; float d[8];
#pragma unroll
                  for (int e = 0; e < 8; ++e) { const float rev = (float)(((c0 + e) * cp) & 255) * (1.0f / 256.0f); d[e] = im ? -__builtin_amdgcn_sinf(rev) : __builtin_amdgcn_cosf(rev); }
                  u32x4 pk; pk.x = cvt_pk_bf16(d[0], d[1]); pk.y = cvt_pk_bf16(d[2], d[3]); pk.z = cvt_pk_bf16(d[4], d[5]); pk.w = cvt_pk_bf16(d[6], d[7]);
                  const bf16x8 afr = __builtin_bit_cast(bf16x8, pk);
#pragma unroll
                  for (int nt_ = 0; nt_ < 2; ++nt_) acc[jt][nt_] = __builtin_amdgcn_mfma_f32_16x16x32_bf16(afr, bfr[nt_], acc[jt][nt_], 0, 0, 0); } }
          bf16_t* dstw = (bf16_t*)(p.ws + OFF_WEFF);
#pragma unroll
          for (int jt = 0; jt < 2; ++jt)
#pragma unroll
              for (int nt_ = 0; nt_ < 2; ++nt_)
#pragma unroll
                  for (int r = 0; r < 4; ++r) dstw[(size_t)(g * 256 + wv * 32 + jt * 16 + quad * 4 + r) * DM + k0 + nt_ * 16 + l15] = f2bf(acc[jt][nt_][r]); }
    }
    { const int lane = tid & 63, wv = tid >> 6; const float* h = (const float*)(p.ws + OFF_H); const float* gam = p.norm_g + layer * DM;
      bf16_t* xn = (bf16_t*)(p.ws + OFF_XN); bf16_t* xnp = (bf16_t*)(p.ws + OFF_XNP);
      for (int l = bid * 8 + wv; l < LP; l += G * 8) {
          if (l < L_TOK) { const f32x4* row = (const f32x4*)(layer == 0 ? (l < NMETA ? p.meta + (size_t)l * DM : p.x + (size_t)(l - NMETA) * DM) : h + (size_t)l * DM); f32x4 v[8]; float ss = 0.f;
#pragma unroll
              for (int i = 0; i < 8; ++i) { v[i] = row[i * 64 + lane]; ss += v[i][0] * v[i][0] + v[i][1] * v[i][1] + v[i][2] * v[i][2] + v[i][3] * v[i][3]; }
              ss = wave_sum(ss); const float inv = rsqrtf(ss * (1.0f / DM) + 1e-6f);
              const int l1 = l / FN2, l2 = l - l1 * FN2; const size_t pr = (size_t)l2 * FN1P + l1;
#pragma unroll
              for (int i = 0; i < 8; ++i) { const f32x4 gg = ((const f32x4*)gam)[i * 64 + lane]; u32x2 w; w.x = cvt_pk_bf16(v[i][0] * inv * gg[0], v[i][1] * inv * gg[1]); w.y = cvt_pk_bf16(v[i][2] * inv * gg[2], v[i][3] * inv * gg[3]);
                  *(u32x2*)(xn + (size_t)l * DM + (i * 64 + lane) * 4) = w; *(u32x2*)(xnp + pr * DM + (i * 64 + lane) * 4) = w; } }
          else { const u32x2 z = (u32x2){0u, 0u};
#pragma unroll
              for (int i = 0; i < 8; ++i) *(u32x2*)(xn + (size_t)l * DM + (i * 64 + lane) * 4) = z; } }
      for (int idx = bid * 8 + wv; idx < FN2 * (FN1P - FN1); idx += G * 8) { const int l2 = idx / (FN1P - FN1), l1 = FN1 + idx % (FN1P - FN1); const size_t pr = (size_t)l2 * FN1P + l1; const u32x2 z = (u32x2){0u, 0u};
#pragma unroll
          for (int i = 0; i < 8; ++i) *(u32x2*)(xnp + pr * DM + (i * 64 + lane) * 4) = z; } }
}

__device__ void na_phase(const Params& p, int layer, unsigned char* smem) {
    const int tid = opaque_tid(), wv = tid >> 6, lane = tid & 63, l15 = lane & 15, quad = lane >> 4;
    const int G = gridDim.x;
    const bf16_t* qkv = (const bf16_t*)(p.ws + OFF_QKV);
    unsigned char* sK = smem;
    bf16_t* sVT = (bf16_t*)(smem + 76032);
    float* sRPB = (float*)(smem + 144640);
    float* sMB = (float*)(smem + 146512);
    const int cb = wv & 3, hf = wv >> 2, c = cb * 16 + l15;
    const int cu = cb == 0 ? 0 : (cb == 1 ? 8 : (cb == 2 ? 24 : 32)), cs = min(max(c - 8, 0), 48);
    u32x4 pk[8], pv[8], pmk = (u32x4){0u, 0u, 0u, 0u}, pmv = (u32x4){0u, 0u, 0u, 0u}; bf16x8 pq0, pq1; float prp = 0.f;
#define NA_LOADS(U) do { const int r_ = (U) >> 4, hd_ = (U) & 15, r0_ = min(max(r_ - 4, 0), 248); \
        _Pragma("unroll") for (int ps = 0; ps < 8; ++ps) { const int tok = ps * 64 + (tid >> 3), ch = tid & 7; const size_t g = (size_t)(NMETA + r0_ * 64 + tok) * 3072 + hd_ * 64 + ch * 8; \
            pk[ps] = *(const u32x4*)(qkv + g + 1024); pv[ps] = *(const u32x4*)(qkv + g + 2048); } \
        if (tid < 128) { const size_t g = (size_t)(tid >> 3) * 3072 + hd_ * 64 + (tid & 7) * 8; pmk = *(const u32x4*)(qkv + g + 1024); pmv = *(const u32x4*)(qkv + g + 2048); } \
        { const bf16_t* qp = qkv + (size_t)(NMETA + r_ * 64 + c) * 3072 + hd_ * 64 + quad * 8; pq0 = *(const bf16x8*)qp; pq1 = *(const bf16x8*)(qp + 32); } \
        if (tid < 465) prp = p.rpb[(size_t)(layer * 16 + hd_) * 465 + tid]; else if (tid >= 480 && tid < 496) prp = p.meta_bias[(layer * 16 + hd_) * 16 + tid - 480]; } while (0)
    int u = blockIdx.x;
    if (u < 4096) NA_LOADS(u);
    for (; u < 4096; u += G) {
        const int r = u >> 4, hd = u & 15, r0 = min(max(r - 4, 0), 248);
        __syncthreads();
#pragma unroll
        for (int ps = 0; ps < 8; ++ps) { const int tok = ps * 64 + (tid >> 3), ch = tid & 7; const u32x4 vv = pv[ps];
            *(u32x4*)(sK + tok * 144 + ch * 16) = pk[ps];
            bf16_t* vt = sVT + (ch * 8) * 536 + tok;
            vt[0] = (bf16_t)vv.x; vt[536] = (bf16_t)(vv.x >> 16); vt[2 * 536] = (bf16_t)vv.y; vt[3 * 536] = (bf16_t)(vv.y >> 16);
            vt[4 * 536] = (bf16_t)vv.z; vt[5 * 536] = (bf16_t)(vv.z >> 16); vt[6 * 536] = (bf16_t)vv.w; vt[7 * 536] = (bf16_t)(vv.w >> 16); }
        if (tid < 128) { const int tok = tid >> 3, ch = tid & 7; const u32x4 vv = pmv;
            *(u32x4*)(sK + (512 + tok) * 144 + ch * 16) = pmk;
            bf16_t* vt = sVT + (ch * 8) * 536 + 512 + tok;
            vt[0] = (bf16_t)vv.x; vt[536] = (bf16_t)(vv.x >> 16); vt[2 * 536] = (bf16_t)vv.y; vt[3 * 536] = (bf16_t)(vv.y >> 16);
            vt[4 * 536] = (bf16_t)vv.z; vt[5 * 536] = (bf16_t)(vv.z >> 16); vt[6 * 536] = (bf16_t)vv.w; vt[7 * 536] = (bf16_t)(vv.w >> 16); }
        if (tid < 465) sRPB[tid] = prp; else if (tid >= 480 && tid < 496) sMB[tid - 480] = prp;
        const bf16x8 bq0 = pq0, bq1 = pq1;
        { const int un = u + G; if (un < 4096) NA_LOADS(un); }
        __syncthreads();
        bf16_t* yc = (bf16_t*)(p.ws + OFF_GATE + 2 * SZ_GATE);
        float gatev[4][4];
        if (hf == 0) {
#pragma unroll
            for (int rr = 0; rr < 4; ++rr)
#pragma unroll
                for (int dt = 0; dt < 4; ++dt) gatev[rr][dt] = bf2f(yc[(size_t)(NMETA + r * 64 + cb * 16 + quad * 4 + rr) * 1024 + hd * 64 + l15 + dt * 16]); }
        float sc[9][4];
#pragma unroll
        for (int ti = 0; ti < 9; ++ti) { const int j = 4 * hf + (ti >> 1), tt = ti & 1; const int slot0 = ti < 8 ? j * 64 + cu + tt * 16 : 512;
            const unsigned char* kp = sK + (slot0 + l15) * 144 + quad * 16;
            const bf16x8 a0 = *(const bf16x8*)kp, a1 = *(const bf16x8*)(kp + 64);
            f32x4 acc = (f32x4){0.f, 0.f, 0.f, 0.f};
            acc = __builtin_amdgcn_mfma_f32_16x16x32_bf16(a0, bq0, acc, 0, 0, 0); acc = __builtin_amdgcn_mfma_f32_16x16x32_bf16(a1, bq1, acc, 0, 0, 0);
            if (ti < 8) { const float* rp = sRPB + (r0 + j - r + 7) * 31 + (15 - c);
#pragma unroll
                for (int rr = 0; rr < 4; ++rr) { const int kc = cu + tt * 16 + quad * 4 + rr; const bool ok = kc >= cs && kc < cs + 16; const int kcc = ok ? kc : cs;
                    sc[ti][rr] = ok ? acc[rr] * 0.125f + rp[kcc] : -1.0e30f; } }
            else {
#pragma unroll
                for (int rr = 0; rr < 4; ++rr) sc[ti][rr] = hf == 0 ? acc[rr] * 0.125f + sMB[quad * 4 + rr] : -1.0e30f; } }
        float mx = -1.0e30f;
#pragma unroll
        for (int ti = 0; ti < 9; ++ti)
#pragma unroll
            for (int rr = 0; rr < 4; ++rr) mx = fmaxf(mx, sc[ti][rr]);
        mx = fmaxf(mx, __shfl_xor(mx, 16)); mx = fmaxf(mx, __shfl_xor(mx, 32));
        float lsum = 0.f;
#pragma unroll
        for (int ti = 0; ti < 9; ++ti)
#pragma unroll
            for (int rr = 0; rr < 4; ++rr) { sc[ti][rr] = __expf(sc[ti][rr] - mx); lsum += sc[ti][rr]; }
        lsum += __shfl_xor(lsum, 16); lsum += __shfl_xor(lsum, 32);
        f32x4 oacc[4];
#pragma unroll
        for (int dt = 0; dt < 4; ++dt) oacc[dt] = (f32x4){0.f, 0.f, 0.f, 0.f};
#pragma unroll
        for (int ks = 0; ks < 5; ++ks) { const int tA = 2 * ks, tB = 2 * ks + 1;
            const int jA = 4 * hf + (tA >> 1); const int slotA = tA < 8 ? jA * 64 + cu + (tA & 1) * 16 : 512; const int slotB = ks < 4 ? (4 * hf + (tB >> 1)) * 64 + cu + 16 : 512;
            u32x4 pa; pa.x = cvt_pk_bf16(sc[tA][0], sc[tA][1]); pa.y = cvt_pk_bf16(sc[tA][2], sc[tA][3]);
            if (ks < 4) { pa.z = cvt_pk_bf16(sc[tA + 1 < 9 ? tA + 1 : 8][0], sc[tA + 1 < 9 ? tA + 1 : 8][1]); pa.w = cvt_pk_bf16(sc[tA + 1 < 9 ? tA + 1 : 8][2], sc[tA + 1 < 9 ? tA + 1 : 8][3]); } else { pa.z = 0u; pa.w = 0u; }
            const bf16x8 af = __builtin_bit_cast(bf16x8, pa);
#pragma unroll
            for (int dt = 0; dt < 4; ++dt) { const bf16_t* vr = sVT + (dt * 16 + l15) * 536 + quad * 4;
                const u32x2 lo = *(const u32x2*)(vr + slotA), hi = *(const u32x2*)(vr + slotB);
                const u32x4 bb = (u32x4){lo.x, lo.y, hi.x, hi.y};
                oacc[dt] = __builtin_amdgcn_mfma_f32_16x16x32_bf16(af, __builtin_bit_cast(bf16x8, bb), oacc[dt], 0, 0, 0); } }
        __syncthreads();
        float* part = (float*)smem + cb * 1056;
        if (hf == 1) {
#pragma unroll
            for (int dt = 0; dt < 4; ++dt)
#pragma unroll
                for (int rr = 0; rr < 4; ++rr) part[(quad * 4 + rr) * 64 + dt * 16 + l15] = oacc[dt][rr];
            if (quad == 0) { part[1024 + l15] = mx; part[1040 + l15] = lsum; } }
        __syncthreads();
        if (hf == 0) {
#pragma unroll
            for (int rr = 0; rr < 4; ++rr) { const int qy = quad * 4 + rr; const float m0 = __shfl(mx, qy), l0 = __shfl(lsum, qy); const float m1 = part[1024 + qy], l1 = part[1040 + qy];
                const float M = fmaxf(m0, m1), f0 = __expf(m0 - M), f1 = __expf(m1 - M); const float inv = 1.0f / (f0 * l0 + f1 * l1);
                bf16_t* gp = yc + (size_t)(NMETA + r * 64 + cb * 16 + qy) * 1024 + hd * 64 + l15;
#pragma unroll
                for (int dt = 0; dt < 4; ++dt) { const float o = (f0 * oacc[dt][rr] + f1 * part[qy * 64 + dt * 16 + l15]) * inv; gp[dt * 16] = f2bf(o * gatev[rr][dt]); } } }
    }
#undef NA_LOADS
}
__device__ void na_meta_unit(const Params& p, int layer) {
    const int tid = opaque_tid();
    if (tid < 256) { const int hd = tid >> 4, qi = tid & 15; const bf16_t* qkv = (const bf16_t*)(p.ws + OFF_QKV);
        float q[64];
        { const u32x4* qp = (const u32x4*)(qkv + (size_t)qi * 3072 + hd * 64);
#pragma unroll
          for (int i = 0; i < 8; ++i) { const u32x4 v = qp[i]; q[i * 8 + 0] = lo_bf(v.x) * 0.125f; q[i * 8 + 1] = hi_bf(v.x) * 0.125f; q[i * 8 + 2] = lo_bf(v.y) * 0.125f; q[i * 8 + 3] = hi_bf(v.y) * 0.125f;
              q[i * 8 + 4] = lo_bf(v.z) * 0.125f; q[i * 8 + 5] = hi_bf(v.z) * 0.125f; q[i * 8 + 6] = lo_bf(v.w) * 0.125f; q[i * 8 + 7] = hi_bf(v.w) * 0.125f; } }
        float o[64];
#pragma unroll
        for (int i = 0; i < 64; ++i) o[i] = 0.f;
        float mx = -3.0e38f, lsum = 0.f;
#pragma unroll 1
        for (int m = 0; m < 16; ++m) { const u32x4* kp = (const u32x4*)(qkv + (size_t)m * 3072 + 1024 + hd * 64); const u32x4* vp = (const u32x4*)(qkv + (size_t)m * 3072 + 2048 + hd * 64);
            float d0 = 0.f, d1 = 0.f;
#pragma unroll
            for (int e = 0; e < 8; ++e) { const u32x4 v = kp[e];
                d0 += q[e * 8 + 0] * lo_bf(v.x) + q[e * 8 + 2] * lo_bf(v.y) + q[e * 8 + 4] * lo_bf(v.z) + q[e * 8 + 6] * lo_bf(v.w);
                d1 += q[e * 8 + 1] * hi_bf(v.x) + q[e * 8 + 3] * hi_bf(v.y) + q[e * 8 + 5] * hi_bf(v.z) + q[e * 8 + 7] * hi_bf(v.w); }
            const float sc = d0 + d1 + p.meta_bias[(layer * 16 + hd) * 16 + m]; const float mnew = fmaxf(mx, sc); const float alpha = __expf(mx - mnew), pi = __expf(sc - mnew);
            lsum = lsum * alpha + pi; mx = mnew;
#pragma unroll
            for (int e = 0; e < 8; ++e) { const u32x4 v = vp[e];
                o[e * 8 + 0] = o[e * 8 + 0] * alpha + pi * lo_bf(v.x); o[e * 8 + 1] = o[e * 8 + 1] * alpha + pi * hi_bf(v.x); o[e * 8 + 2] = o[e * 8 + 2] * alpha + pi * lo_bf(v.y); o[e * 8 + 3] = o[e * 8 + 3] * alpha + pi * hi_bf(v.y);
                o[e * 8 + 4] = o[e * 8 + 4] * alpha + pi * lo_bf(v.z); o[e * 8 + 5] = o[e * 8 + 5] * alpha + pi * hi_bf(v.z); o[e * 8 + 6] = o[e * 8 + 6] * alpha + pi * lo_bf(v.w); o[e * 8 + 7] = o[e * 8 + 7] * alpha + pi * hi_bf(v.w); } }
        const float inv = 1.0f / lsum; u32x4* gp = (u32x4*)((bf16_t*)(p.ws + OFF_GATE + 2 * SZ_GATE) + (size_t)qi * 1024 + hd * 64);
#pragma unroll
        for (int e = 0; e < 8; ++e) { const u32x4 g = gp[e]; u32x4 w;
            w.x = cvt_pk_bf16(o[e * 8 + 0] * inv * lo_bf(g.x), o[e * 8 + 1] * inv * hi_bf(g.x)); w.y = cvt_pk_bf16(o[e * 8 + 2] * inv * lo_bf(g.y), o[e * 8 + 3] * inv * hi_bf(g.y));
            w.z = cvt_pk_bf16(o[e * 8 + 4] * inv * lo_bf(g.z), o[e * 8 + 5] * inv * hi_bf(g.z)); w.w = cvt_pk_bf16(o[e * 8 + 6] * inv * lo_bf(g.w), o[e * 8 + 7] * inv * hi_bf(g.w));
            gp[e] = w; } }
}

__device__ __forceinline__ unsigned rev4_14(unsigned k) { unsigned r = __brev(k) >> 18; return ((r & 0x1555u) << 1) | ((r >> 1) & 0x1555u); }
__device__ __forceinline__ float2 cmul(float2 a, float2 b) { return make_float2(a.x * b.x - a.y * b.y, a.x * b.y + a.y * b.x); }
#define PADI(i) ((i) + ((i) >> 4))
#define CFF(n) cff[2 * PADI((n) >> 1) + ((n) & 1)]
__device__ __forceinline__ void hw_sincos(float rev, float& sn, float& cs) { sn = __builtin_amdgcn_sinf(rev); cs = __builtin_amdgcn_cosf(rev); }
__device__ __forceinline__ float c16(int k) { const float t[10] = {1.0f, 0.9238795325f, 0.7071067812f, 0.3826834324f, 0.0f, -0.3826834324f, -0.7071067812f, -0.9238795325f, -1.0f, -0.9238795325f}; return t[k]; }
__device__ __forceinline__ float s16(int k) { const float t[10] = {0.0f, 0.3826834324f, 0.7071067812f, 0.9238795325f, 1.0f, 0.9238795325f, 0.7071067812f, 0.3826834324f, 0.0f, -0.3826834324f}; return t[k]; }
__device__ __forceinline__ float2 cadd(float2 a, float2 b) { return make_float2(a.x + b.x, a.y + b.y); }
__device__ __forceinline__ float2 csub(float2 a, float2 b) { return make_float2(a.x - b.x, a.y - b.y); }
template <int SGN> __device__ __forceinline__ void bf4(float2& a0, float2& a1, float2& a2, float2& a3) {
    const float2 t0 = cadd(a0, a2), t1 = csub(a0, a2), t2 = cadd(a1, a3), d = csub(a1, a3);
    const float2 t3 = SGN < 0 ? make_float2(d.y, -d.x) : make_float2(-d.y, d.x);
    a0 = cadd(t0, t2); a1 = cadd(t1, t3); a2 = csub(t0, t2); a3 = csub(t1, t3);
}
template <int S> __device__ __forceinline__ void r16_fwd_pass(float2* a) {
    constexpr int Q = S / 4;
    for (int u = opaque_tid(); u < 1024; u += NTHREADS) { const int j = u & (Q - 1); const int base = ((u - j) << 4) + j;
        float2 x[4][4];
#pragma unroll
        for (int aa = 0; aa < 4; ++aa)
#pragma unroll
            for (int bb = 0; bb < 4; ++bb) x[aa][bb] = a[PADI(base + aa * S + bb * Q)];
        float sn, cs; hw_sincos((float)j / (float)(4 * S), sn, cs); const float2 wb0 = make_float2(cs, -sn);
#pragma unroll
        for (int bb = 0; bb < 4; ++bb) { const float2 w1 = bb == 0 ? wb0 : cmul(wb0, make_float2(c16(bb), -s16(bb))); const float2 w2 = cmul(w1, w1), w3 = cmul(w2, w1);
            bf4<-1>(x[0][bb], x[1][bb], x[2][bb], x[3][bb]); x[1][bb] = cmul(x[1][bb], w1); x[2][bb] = cmul(x[2][bb], w2); x[3][bb] = cmul(x[3][bb], w3); }
        hw_sincos((float)j / (float)S, sn, cs); const float2 v1 = make_float2(cs, -sn), v2 = cmul(v1, v1), v3 = cmul(v2, v1);
#pragma unroll
        for (int aa = 0; aa < 4; ++aa) { bf4<-1>(x[aa][0], x[aa][1], x[aa][2], x[aa][3]); x[aa][1] = cmul(x[aa][1], v1); x[aa][2] = cmul(x[aa][2], v2); x[aa][3] = cmul(x[aa][3], v3); }
#pragma unroll
        for (int aa = 0; aa < 4; ++aa)
#pragma unroll
            for (int bb = 0; bb < 4; ++bb) a[PADI(base + aa * S + bb * Q)] = x[aa][bb]; }
    __syncthreads();
}
template <int S> __device__ __forceinline__ void r16_inv_pass(float2* a) {
    constexpr int Q = S / 4;
    for (int u = opaque_tid(); u < 1024; u += NTHREADS) { const int j = u & (Q - 1); const int base = ((u - j) << 4) + j;
        float2 x[4][4];
#pragma unroll
        for (int aa = 0; aa < 4; ++aa)
#pragma unroll
            for (int bb = 0; bb < 4; ++bb) x[aa][bb] = a[PADI(base + aa * S + bb * Q)];
        float sn, cs; hw_sincos((float)j / (float)S, sn, cs); const float2 v1 = make_float2(cs, sn), v2 = cmul(v1, v1), v3 = cmul(v2, v1);
#pragma unroll
        for (int aa = 0; aa < 4; ++aa) { x[aa][1] = cmul(x[aa][1], v1); x[aa][2] = cmul(x[aa][2], v2); x[aa][3] = cmul(x[aa][3], v3); bf4<1>(x[aa][0], x[aa][1], x[aa][2], x[aa][3]); }
        hw_sincos((float)j / (float)(4 * S), sn, cs); const float2 wb0 = make_float2(cs, sn);
#pragma unroll
        for (int bb = 0; bb < 4; ++bb) { const float2 w1 = bb == 0 ? wb0 : cmul(wb0, make_float2(c16(bb), s16(bb))); const float2 w2 = cmul(w1, w1), w3 = cmul(w2, w1);
            x[1][bb] = cmul(x[1][bb], w1); x[2][bb] = cmul(x[2][bb], w2); x[3][bb] = cmul(x[3][bb], w3); bf4<1>(x[0][bb], x[1][bb], x[2][bb], x[3][bb]); }
#pragma unroll
        for (int aa = 0; aa < 4; ++aa)
#pragma unroll
            for (int bb = 0; bb < 4; ++bb) a[PADI(base + aa * S + bb * Q)] = x[aa][bb]; }
    __syncthreads();
}
__device__ void fft_fwd(float2* a) {
    r16_fwd_pass<4096>(a);
    r16_fwd_pass<256>(a);
    { const int span = 16;
        for (int b = opaque_tid(); b < 4096; b += NTHREADS) { const int j = b & (span - 1); const int base = ((b - j) << 2) + j;
            const int i0 = PADI(base), i1 = PADI(base + span), i2 = PADI(base + 2 * span), i3 = PADI(base + 3 * span);
            float2 a0 = a[i0], a1 = a[i1], a2 = a[i2], a3 = a[i3];
            const float2 w1 = make_float2(c16(0) * 0.f + __builtin_amdgcn_cosf((float)j * (1.0f / 64.0f)), -__builtin_amdgcn_sinf((float)j * (1.0f / 64.0f))), w2 = cmul(w1, w1), w3 = cmul(w2, w1);
            bf4<-1>(a0, a1, a2, a3);
            a[i0] = a0; a[i1] = cmul(a1, w1); a[i2] = cmul(a2, w2); a[i3] = cmul(a3, w3); }
        __syncthreads(); }
    for (int blk = opaque_tid(); blk < 1024; blk += NTHREADS) { float2* pb = a + blk * 17; float2 x[16];
#pragma unroll
        for (int e = 0; e < 16; ++e) x[e] = pb[e];
#pragma unroll
        for (int j = 0; j < 4; ++j) { bf4<-1>(x[j], x[j + 4], x[j + 8], x[j + 12]);
            x[j + 4] = cmul(x[j + 4], make_float2(c16(j), -s16(j))); x[j + 8] = cmul(x[j + 8], make_float2(c16(2 * j), -s16(2 * j))); x[j + 12] = cmul(x[j + 12], make_float2(c16(3 * j), -s16(3 * j))); }
#pragma unroll
        for (int g = 0; g < 4; ++g) bf4<-1>(x[4 * g], x[4 * g + 1], x[4 * g + 2], x[4 * g + 3]);
#pragma unroll
        for (int e = 0; e < 16; ++e) pb[e] = x[e]; }
    __syncthreads();
}
__device__ void fft_inv(float2* a) {
    for (int blk = opaque_tid(); blk < 1024; blk += NTHREADS) { float2* pb = a + blk * 17; float2 x[16];
#pragma unroll
        for (int e = 0; e < 16; ++e) x[e] = pb[e];
#pragma unroll
        for (int g = 0; g < 4; ++g) bf4<1>(x[4 * g], x[4 * g + 1], x[4 * g + 2], x[4 * g + 3]);
#pragma unroll
        for (int j = 0; j < 4; ++j) { x[j + 4] = cmul(x[j + 4], make_float2(c16(j), s16(j))); x[j + 8] = cmul(x[j + 8], make_float2(c16(2 * j), s16(2 * j))); x[j + 12] = cmul(x[j + 12], make_float2(c16(3 * j), s16(3 * j)));
            bf4<1>(x[j], x[j + 4], x[j + 8], x[j + 12]); }
#pragma unroll
        for (int e = 0; e < 16; ++e) pb[e] = x[e]; }
    __syncthreads();
    { const int span = 16;
        for (int b = opaque_tid(); b < 4096; b += NTHREADS) { const int j = b & (span - 1); const int base = ((b - j) << 2) + j;
            const int i0 = PADI(base), i1 = PADI(base + span), i2 = PADI(base + 2 * span), i3 = PADI(base + 3 * span);
            const float2 w1 = make_float2(__builtin_amdgcn_cosf((float)j * (1.0f / 64.0f)), __builtin_amdgcn_sinf((float)j * (1.0f / 64.0f))), w2 = cmul(w1, w1), w3 = cmul(w2, w1);
            float2 a0 = a[i0], a1 = cmul(a[i1], w1), a2 = cmul(a[i2], w2), a3 = cmul(a[i3], w3);
            bf4<1>(a0, a1, a2, a3);
            a[i0] = a0; a[i1] = a1; a[i2] = a2; a[i3] = a3; }
        __syncthreads(); }
    r16_inv_pass<256>(a);
    r16_inv_pass<4096>(a);
}
__device__ __forceinline__ void hy_load8(const bf16_t* __restrict__ row, int t0, u32x4& v, float& xl, float& xh) {
    v = *(const u32x4*)(row + t0); xl = t0 > 0 ? bf2f(row[t0 - 1]) : 0.f; xh = (t0 + 8 < L_TOK) ? bf2f(row[t0 + 8]) : 0.f;
}
__device__ __forceinline__ void hy_calc8(const u32x4 v, float xl, float xh, const float (&w)[4], float (&o)[8]) {
    float x[10];
    x[0] = xl; x[9] = xh;
    x[1] = lo_bf(v.x); x[2] = hi_bf(v.x); x[3] = lo_bf(v.y); x[4] = hi_bf(v.y); x[5] = lo_bf(v.z); x[6] = hi_bf(v.z); x[7] = lo_bf(v.w); x[8] = hi_bf(v.w);
#pragma unroll
    for (int e = 0; e < 8; ++e) o[e] = w[0] * x[e] + w[1] * x[e + 1] + w[2] * x[e + 2] + w[3];
}
__device__ __forceinline__ void hy_val8(const bf16_t* __restrict__ row, int t0, const float (&w)[4], float (&o)[8]) { u32x4 v; float xl, xh; hy_load8(row, t0, v, xl, xh); hy_calc8(v, xl, xh, w, o); }
struct HyCh { const bf16_t* __restrict__ ru; const bf16_t* __restrict__ r1; const bf16_t* __restrict__ r2; float wu[4], w1[4], w2[4]; };

constexpr int SD_W4B = 0  , SD_GFX = 512, SD_GBX = 528, SD_EF = 544, SD_EB = 560, SD_VH = 576, SD_VT = 592, SD_END = 608;
constexpr int NCHUNK = L_TOK / 8;

template <int ORDER>
__device__ void hy_conv(const HyCh& hc, float2* cf, float* side, unsigned char* scratch) {
    const int tid = opaque_tid(); float* cff = (float*)cf;
    f32x4* __restrict__ heo = (f32x4*)(scratch + HS_HEO); const float* __restrict__ z2g = (const float*)(scratch + HS_Z2);
    if (tid < 15) side[SD_EF + tid] = CFF(16369 + tid); else if (tid >= 32 && tid < 47) side[SD_EB + tid - 32] = CFF(32768 - (16369 + tid - 32));
    __syncthreads();
    fft_fwd(cf);
    for (int j = tid; j <= 8192; j += NTHREADS) { const unsigned i_ = j < 8192 ? ((((unsigned)j >> 1) << 2) | ((unsigned)j & 1u)) : 2u; const unsigned k = rev4_14(i_); const unsigned kp = (16384u - k) & 16383u; const float2 a = cf[PADI(i_)], bq = cf[PADI(rev4_14(kp))];
        const float bx = bq.x, by = -bq.y; const float sc = 1.0f / 16384.0f;
        heo[j] = (f32x4){0.5f * (a.x + bx) * sc, 0.5f * (a.y + by) * sc, 0.5f * (a.y - by) * sc, -0.5f * (a.x - bx) * sc}; }
    __syncthreads();
    {
        u32x4 rv[4]; float rl[4], rh[4]; f32x4 z0[4], z1[4];
#pragma unroll
        for (int i = 0; i < 4; ++i) { const int c = tid + NTHREADS * i;
            if (ORDER == 0) hy_load8(hc.ru, 8 * c, rv[i], rl[i], rh[i]); else { z0[i] = *(const f32x4*)(z2g + 8 * c); z1[i] = *(const f32x4*)(z2g + 8 * c + 4); } }
#pragma unroll
        for (int i = 0; i < 4; ++i) { const int c = tid + NTHREADS * i; float v[8];
            if (ORDER == 0) hy_calc8(rv[i], rl[i], rh[i], hc.wu, v);
            else { v[0] = z0[i][0]; v[1] = z0[i][1]; v[2] = z0[i][2]; v[3] = z0[i][3]; v[4] = z1[i][0]; v[5] = z1[i][1]; v[6] = z1[i][2]; v[7] = z1[i][3]; }
            float2* d = cf + PADI(4 * c); d[0] = make_float2(v[0], v[1]); d[1] = make_float2(v[2], v[3]); d[2] = make_float2(v[4], v[5]); d[3] = make_float2(v[6], v[7]);
            if (i == 0 && tid < 2) {
#pragma unroll
                for (int e = 0; e < 8; ++e) side[SD_VH + 8 * tid + e] = v[e]; } }
        if (tid < 2) { const int c = NCHUNK - 2 + tid; float v[8];
            if (ORDER == 0) hy_val8(hc.ru, 8 * c, hc.wu, v);
            else { const f32x4 p0 = *(const f32x4*)(z2g + 8 * c), p1 = *(const f32x4*)(z2g + 8 * c + 4); v[0] = p0[0]; v[1] = p0[1]; v[2] = p0[2]; v[3] = p0[3]; v[4] = p1[0]; v[5] = p1[1]; v[6] = p1[2]; v[7] = p1[3]; }
            float2* d = cf + PADI(4 * c); d[0] = make_float2(v[0], v[1]); d[1] = make_float2(v[2], v[3]); d[2] = make_float2(v[4], v[5]); d[3] = make_float2(v[6], v[7]);
#pragma unroll
            for (int e = 0; e < 8; ++e) side[SD_VT + 8 * tid + e] = v[e]; } }
    for (int i = L_TOK / 2 + tid; i < 16384; i += NTHREADS) cf[PADI(i)] = make_float2(0.f, 0.f);
    __syncthreads();
    fft_fwd(cf);
#pragma unroll 4
    for (int j = tid; j <= 8192; j += NTHREADS) { const unsigned i_ = j < 8192 ? ((((unsigned)j >> 1) << 2) | ((unsigned)j & 1u)) : 2u; const unsigned k = rev4_14(i_); const unsigned kp = (16384u - k) & 16383u; const unsigned ik = PADI(i_), ikp = PADI(rev4_14(kp)); const float2 a = cf[ik], bq = cf[ikp];
        const float bx = bq.x, by = -bq.y;
        const float2 XE = make_float2(0.5f * (a.x + bx), 0.5f * (a.y + by)), XO = make_float2(0.5f * (a.y - by), -0.5f * (a.x - bx));
        const f32x4 hh = heo[j]; const float2 HE = make_float2(hh[0], hh[1]), HO = make_float2(hh[2], hh[3]);
        float sn, cs; hw_sincos((float)k / 16384.0f, sn, cs); const float2 w = make_float2(cs, -sn);
        const float2 xoho = cmul(XO, HO), wx = cmul(w, xoho), xehe = cmul(XE, HE), xeho = cmul(XE, HO), xohe = cmul(XO, HE);
        const float2 YE = make_float2(xehe.x + wx.x, xehe.y + wx.y), YO = make_float2(xeho.x + xohe.x, xeho.y + xohe.y);
        cf[ik] = make_float2(YE.x - YO.y, YE.y + YO.x); cf[ikp] = make_float2(YE.x + YO.y, -YE.y + YO.x); }
    __syncthreads();
    fft_inv(cf);
    if (tid < 16) { const int t = tid; float d = 0.f;
        for (int s = t + 16384; s < L_TOK; ++s) { const int l = s - t; const float wrong = l == 16384 ? 0.f : side[SD_EF + 16399 - l]; d += (side[SD_GBX + l - 16384] - wrong) * side[SD_VT + s - 16384]; }
        CFF(t) += d; }
    else if (tid >= 32 && tid < 48) { const int t = 16384 + tid - 32; float d = 0.f;
        for (int s = 0; s <= t - 16384; ++s) { const int l = t - s; const float wrong = l == 16384 ? 0.f : side[SD_EB + 16399 - l]; d += (side[SD_GFX + l - 16384] - wrong) * side[SD_VH + s]; }
        CFF(t) += d; }
    __syncthreads();
}

__device__ void filt_to_lds(const bf16_t* __restrict__ gfp, const bf16_t* __restrict__ gbp, float2* cf, float* side) {
    const int tid = opaque_tid(); float* cff = (float*)cf;
    u32x4 qf[4], qb[4];
#pragma unroll
    for (int i = 0; i < 4; ++i) { const int c = tid + NTHREADS * i; qf[i] = *(const u32x4*)(gfp + 8 * c); qb[i] = *(const u32x4*)(gbp + 8 * c); }
#pragma unroll
    for (int i = 0; i < 4; ++i) { const int c = tid + NTHREADS * i, lag0 = 8 * c; const u32x4 f = qf[i], g = qb[i];
        float2* d = cf + PADI(4 * c); d[0] = make_float2(lo_bf(f.x), hi_bf(f.x)); d[1] = make_float2(lo_bf(f.y), hi_bf(f.y)); d[2] = make_float2(lo_bf(f.z), hi_bf(f.z)); d[3] = make_float2(lo_bf(f.w), hi_bf(f.w));
        if (lag0 >= 1) CFF(32768 - lag0) = lo_bf(g.x);
        CFF(32768 - lag0 - 1) = hi_bf(g.x); CFF(32768 - lag0 - 2) = lo_bf(g.y); CFF(32768 - lag0 - 3) = hi_bf(g.y); CFF(32768 - lag0 - 4) = lo_bf(g.z); CFF(32768 - lag0 - 5) = hi_bf(g.z); CFF(32768 - lag0 - 6) = lo_bf(g.w); CFF(32768 - lag0 - 7) = hi_bf(g.w); }
    if (tid < 2) { const int c = NCHUNK - 2 + tid; const u32x4 f = *(const u32x4*)(gfp + 8 * c), g = *(const u32x4*)(gbp + 8 * c); float* sf = side + SD_GFX + 8 * tid; float* sb = side + SD_GBX + 8 * tid;
        sf[0] = lo_bf(f.x); sf[1] = hi_bf(f.x); sf[2] = lo_bf(f.y); sf[3] = hi_bf(f.y); sf[4] = lo_bf(f.z); sf[5] = hi_bf(f.z); sf[6] = lo_bf(f.w); sf[7] = hi_bf(f.w);
        sb[0] = lo_bf(g.x); sb[1] = hi_bf(g.x); sb[2] = lo_bf(g.y); sb[3] = hi_bf(g.y); sb[4] = lo_bf(g.z); sb[5] = hi_bf(g.z); sb[6] = lo_bf(g.w); sb[7] = hi_bf(g.w); }
    if (tid == 0) CFF(NMAIN) = 0.f;
    __syncthreads();
}

__device__ void hyena_filters(const Params& p, int layer, unsigned char* smem, unsigned char* scrD, unsigned char* scrW) {
    const int tid = opaque_tid(); float2* cf = (float2*)smem; float* cff = (float*)smem; float* side = (float*)(smem + 139264);
    const int bid = blockIdx.x;
    __syncthreads();
    bf16_t* w4b = (bf16_t*)(side + SD_W4B);
    for (int i = tid; i < 16 * 64; i += NTHREADS) { const int row = i >> 6, k = i & 63; w4b[i] = f2bf(p.f_w4[((size_t)layer * 64 + k) * 4096 + (row & 3) * 1024 + bid + 256 * (row >> 2)]); }
    __syncthreads();
    const bf16_t* __restrict__ h3b = (const bf16_t*)(p.ws + OFF_H3) + (size_t)layer * L_TOK * 64;
    const int lane = tid & 63, wv = tid >> 6, col = lane & 15, quad = lane >> 4;
    const int chq = bid + 256 * quad;
    float dk[4];
#pragma unroll
    for (int f = 0; f < 4; ++f) dk[f] = fabsf(p.decay[((layer * 2 + (f >> 1)) * 2 + (f & 1)) * 1024 + chq]) * (1.4426950408889634f / (float)(L_TOK - 1));
    const bf16x8 b0 = *(const bf16x8*)(w4b + col * 64 + quad * 8), b1 = *(const bf16x8*)(w4b + col * 64 + 32 + quad * 8);
    bf16_t* __restrict__ g2 = (bf16_t*)(scrW + HS_G2);
    bf16_t* __restrict__ fq = (bf16_t*)(scrD) + (size_t)(quad > 0 ? quad - 1 : 0) * 4 * L_TOK;
#define FG_LOAD(A0, A1, GB) do { _Pragma("unroll") for (int i = 0; i < 8; ++i) { const bf16_t* hr = h3b + (size_t)(((GB) + 8 * i) * 16 + col) * 64 + quad * 8; A0[i] = *(const bf16x8*)hr; A1[i] = *(const bf16x8*)(hr + 32); } } while (0)
#define FG_GROUP(X0, X1, G_) do { f32x4 acc = (f32x4){0.f, 0.f, 0.f, 0.f}; \
        acc = __builtin_amdgcn_mfma_f32_16x16x32_bf16(b0, X0, acc, 0, 0, 0); acc = __builtin_amdgcn_mfma_f32_16x16x32_bf16(b1, X1, acc, 0, 0, 0); \
        const int lag = (G_) * 16 + col; const float fl = -(float)lag; \
        const float v0 = acc[0] * __builtin_amdgcn_exp2f(fl * dk[0]), v1 = acc[1] * __builtin_amdgcn_exp2f(fl * dk[1]), v2 = acc[2] * __builtin_amdgcn_exp2f(fl * dk[2]), v3 = acc[3] * __builtin_amdgcn_exp2f(fl * dk[3]); \
        if (quad == 0) { g2[lag] = f2bf(v2); g2[L_TOK + lag] = f2bf(v3); \
            if (lag < NMAIN) { CFF(lag) = v0; if (lag >= 1) CFF(32768 - lag) = v1; } else { side[SD_GFX + lag - NMAIN] = v0; side[SD_GBX + lag - NMAIN] = v1; } } \
        else { fq[lag] = f2bf(v0); fq[L_TOK + lag] = f2bf(v1); fq[2 * L_TOK + lag] = f2bf(v2); fq[3 * L_TOK + lag] = f2bf(v3); } } while (0)
#define FG_PROC(A0, A1, GB) do { _Pragma("unroll") for (int i = 0; i < 8; ++i) FG_GROUP(A0[i], A1[i], (GB) + 8 * i); } while (0)
    { bf16x8 pa0[8], pa1[8], pb0[8], pb1[8];
      FG_LOAD(pa0, pa1, wv);
#pragma unroll 1
      for (int m = 0; m < 16; m += 2) { const int gbA = wv + 64 * m, gbB = gbA + 64;
          FG_LOAD(pb0, pb1, gbB);
          FG_PROC(pa0, pa1, gbA);
          if (m + 2 < 16) FG_LOAD(pa0, pa1, gbB + 64);
          FG_PROC(pb0, pb1, gbB); }
      if (wv == 0) { const bf16_t* hr = h3b + (size_t)(1024 * 16 + col) * 64 + quad * 8; const bf16x8 x0 = *(const bf16x8*)hr, x1 = *(const bf16x8*)(hr + 32); FG_GROUP(x0, x1, 1024); } }
#undef FG_LOAD
#undef FG_GROUP
#undef FG_PROC
    if (tid == 0) CFF(NMAIN) = 0.f;
    __syncthreads();
}

__device__ void hyena_unit(const Params& p, int layer, int q, unsigned char* smem, unsigned char* scrD, unsigned char* scratch) {
    const int tid = opaque_tid(); float2* cf = (float2*)smem; float* cff = (float*)smem; float* side = (float*)(smem + 139264);
    const int ch = blockIdx.x + 256 * q;
    const bf16_t* hyin = (const bf16_t*)(p.ws + OFF_HYIN);
    HyCh hc; hc.ru = hyin + (size_t)ch * LP; hc.r1 = hyin + (size_t)(1024 + ch) * LP; hc.r2 = hyin + (size_t)(2048 + ch) * LP;
    { const float* cw = p.conv_w + (size_t)layer * 3 * 3072; const float* cb = p.conv_b + (size_t)layer * 3072;
#pragma unroll
      for (int jj = 0; jj < 3; ++jj) { hc.wu[jj] = cw[jj * 3072 + ch]; hc.w1[jj] = cw[jj * 3072 + 1024 + ch]; hc.w2[jj] = cw[jj * 3072 + 2048 + ch]; }
      hc.wu[3] = cb[ch]; hc.w1[3] = cb[1024 + ch]; hc.w2[3] = cb[2048 + ch]; }
    const float sk0 = p.skip[(layer * 2 + 0) * 1024 + ch], sk1 = p.skip[(layer * 2 + 1) * 1024 + ch];
    float* __restrict__ z2g = (float*)(scratch + HS_Z2);
    const bf16_t* filt = q == 0 ? (const bf16_t*)(scratch + HS_G2) - 2 * (size_t)L_TOK : (const bf16_t*)scrD + (size_t)(q - 1) * 4 * L_TOK;
    bf16_t* __restrict__ hyout = (bf16_t*)(p.ws + OFF_HYOUT) + (size_t)ch * LP;
    if (q > 0) { __syncthreads(); filt_to_lds(filt, filt + L_TOK, cf, side); }
    hy_conv<0>(hc, cf, side, scratch);
    {   u32x4 ru_[4], r1_[4]; float ul[4], uh[4], xl[4], xh[4];
#pragma unroll
        for (int i = 0; i < 4; ++i) { const int c = tid + NTHREADS * i; hy_load8(hc.ru, 8 * c, ru_[i], ul[i], uh[i]); hy_load8(hc.r1, 8 * c, r1_[i], xl[i], xh[i]); }
#pragma unroll
        for (int i = 0; i < 5; ++i) { const int c = i < 4 ? tid + NTHREADS * i : NCHUNK - 2 + tid;
            if (i < 4 || tid < 2) { float u8[8], x8[8];
                if (i < 4) { hy_calc8(ru_[i], ul[i], uh[i], hc.wu, u8); hy_calc8(r1_[i], xl[i], xh[i], hc.w1, x8); } else { hy_val8(hc.ru, 8 * c, hc.wu, u8); hy_val8(hc.r1, 8 * c, hc.w1, x8); }
                const float2* s = cf + PADI(4 * c); const float2 y0 = s[0], y1 = s[1], y2 = s[2], y3 = s[3];
                const f32x4 o0 = (f32x4){x8[0] * (y0.x + sk0 * u8[0]), x8[1] * (y0.y + sk0 * u8[1]), x8[2] * (y1.x + sk0 * u8[2]), x8[3] * (y1.y + sk0 * u8[3])};
                const f32x4 o1 = (f32x4){x8[4] * (y2.x + sk0 * u8[4]), x8[5] * (y2.y + sk0 * u8[5]), x8[6] * (y3.x + sk0 * u8[6]), x8[7] * (y3.y + sk0 * u8[7])};
                *(f32x4*)(z2g + 8 * c) = o0; *(f32x4*)(z2g + 8 * c + 4) = o1; } } }
    __syncthreads();
    filt_to_lds(filt + 2 * (size_t)L_TOK, filt + 3 * (size_t)L_TOK, cf, side);
    hy_conv<1>(hc, cf, side, scratch);
    {   u32x4 r2_[4]; float xl[4], xh[4]; f32x4 z0[4], z1[4];
#pragma unroll
        for (int i = 0; i < 4; ++i) { const int c = tid + NTHREADS * i; hy_load8(hc.r2, 8 * c, r2_[i], xl[i], xh[i]); z0[i] = *(const f32x4*)(z2g + 8 * c); z1[i] = *(const f32x4*)(z2g + 8 * c + 4); }
#pragma unroll
        for (int i = 0; i < 5; ++i) { const int c = i < 4 ? tid + NTHREADS * i : NCHUNK - 2 + tid;
            if (i < 4 || tid < 2) { float x8[8]; f32x4 p0, p1;
                if (i < 4) { hy_calc8(r2_[i], xl[i], xh[i], hc.w2, x8); p0 = z0[i]; p1 = z1[i]; } else { hy_val8(hc.r2, 8 * c, hc.w2, x8); p0 = *(const f32x4*)(z2g + 8 * c); p1 = *(const f32x4*)(z2g + 8 * c + 4); }
                const float2* s = cf + PADI(4 * c); const float2 y0 = s[0], y1 = s[1], y2 = s[2], y3 = s[3];
                u32x4 w; w.x = cvt_pk_bf16(x8[0] * (y0.x + sk1 * p0[0]), x8[1] * (y0.y + sk1 * p0[1])); w.y = cvt_pk_bf16(x8[2] * (y1.x + sk1 * p0[2]), x8[3] * (y1.y + sk1 * p0[3]));
                w.z = cvt_pk_bf16(x8[4] * (y2.x + sk1 * p1[0]), x8[5] * (y2.y + sk1 * p1[1])); w.w = cvt_pk_bf16(x8[6] * (y3.x + sk1 * p1[2]), x8[7] * (y3.y + sk1 * p1[3]));
                *(u32x4*)(hyout + 8 * c) = w; } } }
    __syncthreads();
}

__device__ void transpose_phase(const Params& p, unsigned char* smem) {
    const int tid = opaque_tid(), G = gridDim.x; bf16_t* tile0 = (bf16_t*)smem;
    const bf16_t* __restrict__ hyout = (const bf16_t*)(p.ws + OFF_HYOUT); bf16_t* ya = (bf16_t*)(p.ws + OFF_GATE);
    const int cl = tid >> 3, t8 = (tid & 7) * 8, tl = tid >> 3, c8 = (tid & 7) * 8;
    u32x4 ph = (u32x4){0u, 0u, 0u, 0u}, pg = ph;
    constexpr int TOT = 16 * 257;
    int u = blockIdx.x;
    __syncthreads();
    if (u < TOT) { const int ct = u & 15, tt = u >> 4; ph = *(const u32x4*)(hyout + (size_t)(ct * 64 + cl) * LP + tt * 64 + t8); const int t = tt * 64 + tl; if (t < L_TOK) pg = *(const u32x4*)(ya + (size_t)t * 1024 + ct * 64 + c8); }
    int buf = 0;
    for (; u < TOT; u += G) { bf16_t* tile = tile0 + buf * (64 * 72); const int ct = u & 15, tt = u >> 4;
        *(u32x4*)(tile + cl * 72 + t8) = ph; const u32x4 g = pg;
        { const int un = u + G; if (un < TOT) { const int ct2 = un & 15, tt2 = un >> 4; ph = *(const u32x4*)(hyout + (size_t)(ct2 * 64 + cl) * LP + tt2 * 64 + t8); const int t2 = tt2 * 64 + tl; if (t2 < L_TOK) pg = *(const u32x4*)(ya + (size_t)t2 * 1024 + ct2 * 64 + c8); } }
        __syncthreads();
        const int t = tt * 64 + tl;
        if (t < L_TOK) { float v[8];
#pragma unroll
            for (int i = 0; i < 8; ++i) v[i] = bf2f(tile[(c8 + i) * 72 + tl]);
            u32x4 w; w.x = cvt_pk_bf16(v[0] * lo_bf(g.x), v[1] * hi_bf(g.x)); w.y = cvt_pk_bf16(v[2] * lo_bf(g.y), v[3] * hi_bf(g.y)); w.z = cvt_pk_bf16(v[4] * lo_bf(g.z), v[5] * hi_bf(g.z)); w.w = cvt_pk_bf16(v[6] * lo_bf(g.w), v[7] * hi_bf(g.w));
            *(u32x4*)(ya + (size_t)t * 1024 + ct * 64 + c8) = w; }
        buf ^= 1; }
    __syncthreads();
}

__device__ void phase_final(const Params& p) {
    const int tid = opaque_tid(), lane = tid & 63, wv = tid >> 6; const float* h = (const float*)(p.ws + OFF_H);
    for (int l = NMETA + blockIdx.x * 8 + wv; l < L_TOK; l += gridDim.x * 8) { const f32x4* row = (const f32x4*)(h + (size_t)l * DM); f32x4 v[8]; float ss = 0.f;
#pragma unroll
        for (int i = 0; i < 8; ++i) { v[i] = row[i * 64 + lane]; ss += v[i][0] * v[i][0] + v[i][1] * v[i][1] + v[i][2] * v[i][2] + v[i][3] * v[i][3]; }
        ss = wave_sum(ss); const float inv = rsqrtf(ss * (1.0f / DM) + 1e-6f); f32x4* o = (f32x4*)(p.out + (size_t)(l - NMETA) * DM);
#pragma unroll
        for (int i = 0; i < 8; ++i) { const f32x4 gg = ((const f32x4*)p.final_g)[i * 64 + lane]; o[i * 64 + lane] = v[i] * inv * gg; } }
}

__device__ void mini_branch(const Params& p) {
    const int tid = opaque_tid(), lane = tid & 63, wv = tid >> 6, nt_ = blockIdx.x * 8 + wv;
    if (nt_ < 128) { const int rc = lane & 15, quad = lane >> 4; const int n0 = nt_ * 16;
        const bf16_t* mg = (const bf16_t*)(p.ws + OFF_MERGE); bf16_t* mb = (bf16_t*)(p.ws + OFF_M);
        float tot[4] = {0.f, 0.f, 0.f, 0.f};
#pragma unroll 1
        for (int br = 0; br < 3; ++br) { const bf16_t* A = (const bf16_t*)(p.ws + OFF_GATE + (size_t)br * SZ_GATE) + (size_t)(NMAIN + rc) * 1024 + quad * 8;
            const bf16_t* B = (const bf16_t*)(p.ws + OFF_WA + (size_t)br * SZ_WBR) + (size_t)(n0 + rc) * 1024 + quad * 8;
            f32x4 acc = (f32x4){0.f, 0.f, 0.f, 0.f};
#pragma unroll 1
            for (int kb = 0; kb < 32; kb += 8) { bf16x8 av[8], bv[8];
#pragma unroll
                for (int i = 0; i < 8; ++i) { av[i] = *(const bf16x8*)(A + (kb + i) * 32); bv[i] = *(const bf16x8*)(B + (kb + i) * 32); }
#pragma unroll
                for (int i = 0; i < 8; ++i) acc = __builtin_amdgcn_mfma_f32_16x16x32_bf16(av[i], bv[i], acc, 0, 0, 0); }
#pragma unroll
            for (int r = 0; r < 4; ++r) tot[r] += acc[r] * bf2f(mg[(size_t)(NMAIN + quad * 4 + r) * 6144 + br * 2048 + n0 + rc]); }
#pragma unroll
        for (int r = 0; r < 4; ++r) mb[(size_t)(NMAIN + quad * 4 + r) * DM + n0 + rc] = f2bf(tot[r]); }
}
__device__ void mini_out(const Params& p, int layer) {
    const int tid = opaque_tid(), lane = tid & 63, wv = tid >> 6, nt_ = blockIdx.x * 8 + wv;
    if (nt_ < 128) { const int rc = lane & 15, quad = lane >> 4; const int n0 = nt_ * 16;
        const bf16_t* A = (const bf16_t*)(p.ws + OFF_M) + (size_t)(NMAIN + rc) * DM + quad * 8; const bf16_t* B = (const bf16_t*)(p.ws + OFF_WO) + (size_t)(n0 + rc) * DM + quad * 8;
        f32x4 acc = (f32x4){0.f, 0.f, 0.f, 0.f};
#pragma unroll 1
        for (int kb = 0; kb < 64; kb += 8) { bf16x8 av[8], bv[8];
#pragma unroll
            for (int i = 0; i < 8; ++i) { av[i] = *(const bf16x8*)(A + (kb + i) * 32); bv[i] = *(const bf16x8*)(B + (kb + i) * 32); }
#pragma unroll
            for (int i = 0; i < 8; ++i) acc = __builtin_amdgcn_mfma_f32_16x16x32_bf16(av[i], bv[i], acc, 0, 0, 0); }
        float* h = (float*)(p.ws + OFF_H);
#pragma unroll
        for (int r = 0; r < 4; ++r) { const size_t row = NMAIN + quad * 4 + r; const float bs = layer == 0 ? p.x[(row - NMETA) * DM + n0 + rc] : h[row * DM + n0 + rc]; h[row * DM + n0 + rc] = bs + acc[r]; } }
}

#define XB_TMO      128
#define XB_XCNT(j)  (256  + 64 * (j))
#define XB_XSUB(j)  (1280 + 64 * (j))
#define XB_XGEN(j)  (2304 + 64 * (j))
#define XB_TOP      3328
#define XB_TOPGEN   3392
#define XCD_BAR_WORDS 3456
#define XB_SPIN_CAP (1u << 18)
__device__ __forceinline__ unsigned xb_ld(unsigned* p)              { return __hip_atomic_load(p, __ATOMIC_RELAXED, __HIP_MEMORY_SCOPE_AGENT); }
__device__ __forceinline__ unsigned xb_add(unsigned* p, unsigned v) { return __hip_atomic_fetch_add(p, v, __ATOMIC_RELAXED, __HIP_MEMORY_SCOPE_AGENT); }
__device__ __forceinline__ unsigned xb_xcc_id() { return (unsigned)__builtin_amdgcn_s_getreg((3 << 11) | 20) & 0xFu; }
#define XB_SPIN(cond, bar) do { unsigned _sp = 0; while (cond) { __builtin_amdgcn_s_sleep(1); \
    if ((++_sp & 255u) == 0u) { if (xb_ld(&(bar)[XB_TMO])) break; if (_sp > XB_SPIN_CAP) { atomicAdd(&(bar)[XB_TMO], 1u); break; } } } } while (0)
struct XcdBarrier { unsigned* bar; unsigned x; volatile LAS unsigned* st; };
__device__ __forceinline__ void xcd_barrier_complete(unsigned* bar, unsigned x, unsigned& nloc, unsigned& nx) {
    const unsigned G = gridDim.x * gridDim.y * gridDim.z;
    unsigned sum, cnt, mine, sp = 0u;
    for (;;) {
        sum = 0u; cnt = 0u; mine = 0u;
#pragma unroll
        for (unsigned j = 0; j < 16; ++j) { const unsigned c = xb_ld(&bar[XB_XCNT(j)]); sum += c; cnt += (c > 0u) ? 1u : 0u; mine = (j == x) ? c : mine; }
        if (sum == G) break;
        __builtin_amdgcn_s_sleep(1);
        if ((++sp & 255u) == 0u) { if (xb_ld(&bar[XB_TMO])) break; if (sp > XB_SPIN_CAP) { atomicAdd(&bar[XB_TMO], 1u); break; } }
    }
    nloc = mine > 0u ? mine : 1u; nx = cnt > 0u ? cnt : 1u;
}
__device__ __forceinline__ void xcd_barrier(const XcdBarrier& b) {
    asm volatile("s_waitcnt vmcnt(0)" ::: "memory");
    __syncthreads();
    if (threadIdx.x == 0) {
        unsigned* bar = b.bar;
        __builtin_amdgcn_s_waitcnt(0);
        unsigned nloc = b.st[0], nx = b.st[1];
        if (nloc == 0u) { xcd_barrier_complete(bar, b.x, nloc, nx); b.st[0] = nloc; b.st[1] = nx; }
        const unsigned old = xb_add(&bar[XB_XSUB(b.x)], 1u);
        const unsigned gen = old / nloc;
        if (old + 1u == (gen + 1u) * nloc) {
            __builtin_amdgcn_fence(__ATOMIC_RELEASE, "agent");
            asm volatile("s_waitcnt vmcnt(0)" ::: "memory");
            const unsigned og = xb_add(&bar[XB_TOP], 1u);
            const unsigned tg = og / nx;
            if (og + 1u == (tg + 1u) * nx) xb_add(&bar[XB_TOPGEN], 1u);
            else XB_SPIN(xb_ld(&bar[XB_TOPGEN]) == tg, bar);
            __builtin_amdgcn_fence(__ATOMIC_ACQUIRE, "agent");
            xb_add(&bar[XB_XGEN(b.x)], 1u);
            asm volatile("s_waitcnt vmcnt(0)" ::: "memory");
        } else {
            XB_SPIN(xb_ld(&bar[XB_XGEN(b.x)]) == gen, bar);
            __builtin_amdgcn_fence(__ATOMIC_ACQUIRE, "agent");
            asm volatile("s_waitcnt vmcnt(0)" ::: "memory");
        }
    }
    __syncthreads();
}

enum { OP_P1 = 0, OP_SYNC, OP_GEMM, OP_NA, OP_HYENA, OP_TRANS, OP_NOP };
__global__ void __launch_bounds__(512, 2) hybrid_fwd(Params p) {
    extern __shared__ __attribute__((aligned(16))) unsigned char smem[];
    cg::grid_group grid = cg::this_grid();
    LAS unsigned char* lds = (LAS unsigned char*)smem;
    const int bid = blockIdx.x, G = gridDim.x;
    XcdBarrier xb; xb.bar = (unsigned*)(p.ws + OFF_BAR); xb.x = xb_xcc_id(); xb.st = (volatile LAS unsigned*)(lds + LDS_PHASE_BYTES);
    if (bid == 0) for (int i = opaque_tid(); i < XCD_BAR_WORDS; i += NTHREADS) xb.bar[i] = 0u;
    if (opaque_tid() == 0) { xb.st[0] = 0u; xb.st[1] = 0u; }
    __syncthreads();
    phase_prep0(p, smem);
    constexpr int NOPS = 17;
#pragma clang loop unroll(disable)
    for (int step = 0; step < 2 * NOPS; ++step) {
        const int layer = step / NOPS, s = step - layer * NOPS;
        int op, kind = 0;
        switch (s) {
        case 0: op = OP_P1; break;
        case 2: op = OP_GEMM; kind = K_IN; break;
        case 3: case 4: op = OP_NOP; break;
        case 6: op = OP_GEMM; kind = K_FNA; break;
        case 7: op = OP_NA; break;
        case 8: op = OP_HYENA; break;
        case 10: op = OP_GEMM; kind = K_FNB; break;
        case 11: op = OP_TRANS; break;
        case 13: op = OP_GEMM; kind = K_BR; break;
        case 15: op = OP_GEMM; kind = K_OUT; break;
        default: op = OP_SYNC; break;
        }
        if (op == OP_NOP) { }
        else if (op == OP_SYNC) { if (step == 1) { grid.sync(); if (opaque_tid() == 0) (void)xb_add(&xb.bar[XB_XCNT(xb.x)], 1u); } else xcd_barrier(xb); }
        else if (op == OP_GEMM) {
            Gemm g; g.base = (const char*)p.ws; g.jumpA = 0; g.jumpB = 0;
            switch (kind) {
            case K_FNA: g.lda = 384; g.ldb = FN1P; g.nt = 6; g.ksplit = 3; g.jumpB = (long)((size_t)1024 * PROWS * 2) - 384l; break;
            case K_FNB: g.lda = 256; g.ldb = 256; g.nt = 4; g.ksplit = 4; break;
            case K_BR:  g.lda = 1024; g.ldb = 1024; g.nt = 16; g.ksplit = 16; break;
            default:    g.lda = DM; g.ldb = DM; g.nt = 32; g.ksplit = 32; break;
            }
            SchedAny S{kind, G, bid}; EpiAny E{kind, p.ws, layer, p.x, p.meta};
            if (kind == K_BR) { EpiBr EB{p.ws}; pg8::gemm_phase(lds, g, S, EB); } else pg8::gemm_phase(lds, g, S, E);
            if (kind == K_BR) mini_branch(p); else if (kind == K_OUT) mini_out(p, layer);
        }
        else if (op == OP_P1) { phase_p1(p, layer, smem); }
        else if (op == OP_NA) { na_phase(p, layer, smem); if (bid == G - 1) na_meta_unit(p, layer); }
        else if (op == OP_HYENA) { unsigned char* scrD = (unsigned char*)p.out + (size_t)bid * HSD_STRIDE; unsigned char* scrW = p.ws + WS_END + (size_t)bid * HSW_STRIDE;
            hyena_filters(p, layer, smem, scrD, scrW);
#pragma clang loop unroll(disable)
            for (int q = 0; q < 4; ++q) hyena_unit(p, layer, q, smem, scrD, scrW); }
        else { transpose_phase(p, smem); }
    }
    phase_final(p);
}

extern "C" void kernel_launch(void* const* d_in, const int* in_sizes, int n_in, void* d_out, int out_size, void* d_ws, size_t ws_size, hipStream_t stream) {
    static int grid_blocks = 0;
    if (grid_blocks == 0) {
        if (n_in != 23 || ws_size < WS_END2) { fprintf(stderr, "kernel_launch: need 23 inputs and %zu bytes of workspace (got %d, %zu)\n", (size_t)WS_END2, n_in, ws_size); grid_blocks = -1; return; }
        int dev = 0, cus = 0, per_cu = 0;
        hipGetDevice(&dev); hipDeviceGetAttribute(&cus, hipDeviceAttributeMultiprocessorCount, dev);
        if (hipFuncSetAttribute((const void*)hybrid_fwd, hipFuncAttributeMaxDynamicSharedMemorySize, LDS_BYTES) != hipSuccess) { fprintf(stderr, "kernel_launch: hipFuncSetAttribute failed\n"); grid_blocks = -1; return; }
        hipOccupancyMaxActiveBlocksPerMultiprocessor(&per_cu, (const void*)hybrid_fwd, NTHREADS, LDS_BYTES);
        if (per_cu < 1) per_cu = 1;
        grid_blocks = cus * per_cu;
        if (grid_blocks > 256) grid_blocks = 256;
        if (grid_blocks != 256) { fprintf(stderr, "kernel_launch: this kernel needs 256 co-resident workgroups (got %d)\n", grid_blocks); grid_blocks = -1; return; }
    }
    if (grid_blocks < 0) return;
    Params p{};
    const float** f = (const float**)&p;
    for (int i = 0; i < 23; ++i) f[i] = (const float*)d_in[i];
    p.out = (float*)d_out; p.ws = (unsigned char*)d_ws;
    void* args[] = {&p};
    hipError_t e = hipLaunchCooperativeKernel((const void*)hybrid_fwd, dim3(grid_blocks), dim3(NTHREADS), args, LDS_BYTES, stream);
    if (e != hipSuccess) fprintf(stderr, "cooperative launch failed: %s (grid %d)\n", hipGetErrorString(e), grid_blocks);
}
```

```cpp
#include <hip/hip_runtime.h>
#include <hip/hip_cooperative_groups.h>
#include <cstdio>
namespace cg = cooperative_groups;

#define LAS __attribute__((address_space(3)))
typedef unsigned short bf16_t;
typedef short bf16x8 __attribute__((ext_vector_type(8)));
typedef float f32x4 __attribute__((ext_vector_type(4)));
typedef unsigned u32x4 __attribute__((ext_vector_type(4)));
typedef unsigned u32x2 __attribute__((ext_vector_type(2)));

constexpr int L_TOK = 16400, LP = 16640, DM = 2048, NIN = 16384, NMETA = 16, NMAIN = 16384;
constexpr int FN1 = 164, FN2 = 100, FN1P = 192, PROWS = FN2 * FN1P;
constexpr int NTHREADS = 512, LDS_PHASE_BYTES = 155648, LDS_BYTES = LDS_PHASE_BYTES + 16;

constexpr size_t SZ_H = (size_t)LP * DM * 4, SZ_XN = (size_t)LP * DM * 2, SZ_XNP = (size_t)PROWS * DM * 2;
constexpr size_t OFF_H = 0;
constexpr size_t OFF_XN = OFF_H + SZ_H;
constexpr size_t OFF_XNP = OFF_XN + SZ_XN;
constexpr size_t OFF_A1 = OFF_XN;
constexpr size_t SZ_A1 = (size_t)FN1 * 1024 * 2 * 128 * 2;
constexpr size_t OFF_HYOUT = OFF_A1 + SZ_A1;
constexpr size_t SZ_HYOUT = (size_t)1024 * LP * 2;
static_assert(OFF_HYOUT + SZ_HYOUT <= OFF_XNP + SZ_XNP, "alias overflow");
constexpr size_t OFF_WT = OFF_XNP + SZ_XNP;
constexpr size_t OFF_WEFF = OFF_WT + (size_t)NIN * DM * 2;
constexpr size_t OFF_WA = OFF_WEFF + (size_t)2048 * 2048 * 2;
constexpr size_t SZ_WBR = (size_t)2048 * 1024 * 2;
constexpr size_t OFF_WO = OFF_WA + 3 * SZ_WBR;
constexpr size_t OFF_HYIN = OFF_WO + (size_t)2048 * 2048 * 2;
constexpr size_t OFF_GATE = OFF_HYIN + (size_t)3072 * LP * 2;
constexpr size_t SZ_GATE = (size_t)LP * 1024 * 2;
constexpr size_t OFF_QKV = OFF_GATE + 3 * SZ_GATE;
constexpr size_t OFF_MERGE = OFF_QKV + (size_t)LP * 3072 * 2;
constexpr size_t OFF_ZT = OFF_MERGE + (size_t)LP * 6144 * 2;
constexpr size_t SZ_ZT = (size_t)2048 * PROWS * 2;
constexpr size_t OFF_M = OFF_ZT;
static_assert(SZ_XN <= SZ_ZT, "alias overflow");
constexpr size_t OFF_FA = OFF_ZT + SZ_ZT;
constexpr size_t OFF_FB = OFF_FA + (size_t)512 * 384 * 2;
constexpr size_t OFF_H3 = OFF_FB + (size_t)FN1 * 256 * 256 * 2;
constexpr size_t WS_END = OFF_H3 + (size_t)2 * L_TOK * 64 * 4;
constexpr size_t HS_HEO = 0, HS_Z2 = 131328, HS_G2 = HS_Z2 + 65792, HSW_STRIDE = HS_G2 + 65792;
constexpr size_t FILT_BYTES = (size_t)L_TOK * 2, HSD_STRIDE = 393728;
constexpr size_t OFF_BAR = WS_END + 256 * HSW_STRIDE;
constexpr size_t WS_END2 = OFF_BAR + 16384;
static_assert(HSD_STRIDE >= 12 * FILT_BYTES && HSD_STRIDE * 256 <= (size_t)NMAIN * DM * 4, "scratch overflow");

struct Params {
    const float* x; const float* meta; const float* norm_g; const float* w_in; const float* conv_w; const float* conv_b;
    const float* f_w1; const float* f_b1; const float* f_w2; const float* f_b2; const float* f_w3; const float* f_b3; const float* f_w4;
    const float* f_freq; const float* decay; const float* skip; const float* rpb; const float* meta_bias;
    const float* w_a; const float* w_b; const float* w_c; const float* w_out; const float* final_g;
    float* out; unsigned char* ws;
};

__device__ __forceinline__ int opaque_tid() { int t = threadIdx.x; asm volatile("" : "+v"(t)); return t; }
__device__ __forceinline__ float bf2f(bf16_t b) { return __uint_as_float(((unsigned)b) << 16); }
__device__ __forceinline__ bf16_t f2bf(float f) { unsigned u = __float_as_uint(f); u += 0x7FFFu + ((u >> 16) & 1u); return (bf16_t)(u >> 16); }
__device__ __forceinline__ unsigned cvt_pk_bf16(float lo, float hi) { unsigned r; asm volatile("v_cvt_pk_bf16_f32 %0, %1, %2" : "=v"(r) : "v"(lo), "v"(hi)); return r; }
__device__ __forceinline__ float lo_bf(unsigned u) { return __uint_as_float(u << 16); }
__device__ __forceinline__ float hi_bf(unsigned u) { return __uint_as_float(u & 0xffff0000u); }
__device__ __forceinline__ float silu_f(float v) { return v * __builtin_amdgcn_rcpf(1.0f + __expf(-v)); }
__device__ __forceinline__ float sigm_f(float v) { return __builtin_amdgcn_rcpf(1.0f + __expf(-v)); }
__device__ __forceinline__ float wave_sum(float v) {
#pragma unroll
    for (int o = 32; o >= 1; o >>= 1) v += __shfl_xor(v, o);
    return v;
}

namespace pg8 {
constexpr int BM = 256, BK = 64, HALF = 128, HTB = HALF * BK * 2, STAGE_BYTES = 8 * HTB;
__device__ __forceinline__ int lds_byte(int r, int c) { const int st = (r >> 4) * 2 + (c >> 5), rr = r & 15, cc = c & 31, ob = rr * 64 + cc * 2; return st * 1024 + (ob ^ (((ob >> 9) & 1) << 5)); }
__device__ __forceinline__ void stage_rc(int b, int& R, int& C) { const int st = b / 1024, sb = b % 1024, swz = sb ^ (((sb >> 9) & 1) << 5); R = (st >> 1) * 16 + swz / 64; C = (st & 1) * 32 + (swz % 64) / 2; }
__device__ __forceinline__ int perm32(int rho) { const int n = rho >> 4, i = rho & 15; return 8 * (i >> 2) + 4 * n + (i & 3); }

struct Unit { int pm, pn, aux; size_t offA, offB; };
struct Gemm { const char* base; int lda, ldb, nt, ksplit; long jumpA, jumpB; };

__device__ __forceinline__ void tile_map(int wgid, int nM, int nN, int& pm, int& pn) {
    const int nwg = nM * nN;
    { const int q = nwg / 8, r = nwg % 8, xcd = wgid % 8, off = wgid / 8; wgid = (xcd < r ? xcd * (q + 1) : r * (q + 1) + (xcd - r) * q) + off; }
    const int nig = 8 * nN, gid = wgid / nig, fm = gid * 8, gsz = (nM - fm) < 8 ? (nM - fm) : 8;
    pm = fm + ((wgid % nig) % gsz); pn = (wgid % nig) / gsz;
}

template <class Epi, class Sched>
__device__ __forceinline__ void gemm_phase(LAS unsigned char* lds, const Gemm g, const Sched& S, const Epi& E) {
    const int tid = opaque_tid(), wid = __builtin_amdgcn_readfirstlane(tid >> 6), lane = tid & 63, wr = wid >> 2, wc = wid & 3, fr = lane & 15, fq = lane >> 4;
    const int nt = g.nt;
    unsigned voffA[2], voffB[2];
#pragma unroll
    for (int i = 0; i < 2; ++i) { int R, C; stage_rc(tid * 16 + i * 8192, R, C); const int Rb = (R & ~31) + perm32(R & 31);
        voffA[i] = (unsigned)(R * g.lda + C) * 2u; voffB[i] = (unsigned)(Rb * g.ldb + C) * 2u; }
    const size_t kstep = (size_t)(BK * 2);
    const size_t hstepA = (size_t)HALF * g.lda * 2, hstepB = (size_t)HALF * g.ldb * 2;
    const unsigned ldsw = (unsigned)wid * 1024u;
    const int aoff = lds_byte(wr * 64 + fr, fq * 8), boff = lds_byte(wc * 32 + fr, fq * 8);
#define PG8_KA(p, t) ((p) + (size_t)(t) * kstep + ((t) >= g.ksplit ? g.jumpA : 0l))
#define PG8_KB(p, t) ((p) + (size_t)(t) * kstep + ((t) >= g.ksplit ? g.jumpB : 0l))
#define PG8_SA(b, h) (((b) * 2 + (h)) * HTB)
#define PG8_SB(b, h) ((4 + (b) * 2 + (h)) * HTB)
#define PG8_STAGE(bufoff, gbase, voff) do { _Pragma("unroll") for (int _i = 0; _i < 2; ++_i) \
        __builtin_amdgcn_global_load_lds((const unsigned*)((const char*)(gbase) + (voff)[_i]), (LAS unsigned*)(lds + (bufoff) + ldsw + _i * 8192), 16, 0, 0); } while (0)
#define PG8_LDA(dst, b, h) do { _Pragma("unroll") for (int m = 0; m < 4; ++m) _Pragma("unroll") for (int k = 0; k < 2; ++k) dst[m][k] = *(const LAS bf16x8*)(lds + PG8_SA(b, h) + aoff + m * 2048 + k * 1024); } while (0)
#define PG8_LDB(dst, b, h) do { _Pragma("unroll") for (int n = 0; n < 2; ++n) _Pragma("unroll") for (int k = 0; k < 2; ++k) dst[n][k] = *(const LAS bf16x8*)(lds + PG8_SB(b, h) + boff + n * 2048 + k * 1024); } while (0)
#define PG8_MMA(ai, bj, At, Bt) do { __builtin_amdgcn_s_setprio(1); _Pragma("unroll") for (int m = 0; m < 4; ++m) _Pragma("unroll") for (int n = 0; n < 2; ++n) _Pragma("unroll") for (int k = 0; k < 2; ++k) \
        acc[ai][bj][m][n] = __builtin_amdgcn_mfma_f32_16x16x32_bf16(Bt[n][k], At[m][k], acc[ai][bj][m][n], 0, 0, 0); __builtin_amdgcn_s_setprio(0); } while (0)
#define PG8_WAIT_V(n) asm volatile("s_waitcnt vmcnt(" #n ")" ::: "memory")
#define PG8_WAIT_L(n) asm volatile("s_waitcnt lgkmcnt(" #n ")" ::: "memory")
#define PG8_BAR __builtin_amdgcn_s_barrier()
#define PG8_SCHED __builtin_amdgcn_sched_barrier(0)
    Unit cur, nxt; int ui = 0;
    if (!S.next(0, cur)) return;
    f32x4 acc[2][2][4][2];
#pragma unroll
    for (int a = 0; a < 2; ++a)
#pragma unroll
        for (int b = 0; b < 2; ++b)
#pragma unroll
            for (int m = 0; m < 4; ++m)
#pragma unroll
                for (int n = 0; n < 2; ++n) acc[a][b][m][n] = (f32x4){0.f, 0.f, 0.f, 0.f};
    bf16x8 At[4][2], B0[2][2], B1[2][2];
    const char* cA = g.base + cur.offA; const char* cB = g.base + cur.offB;
    PG8_STAGE(PG8_SB(0, 0), cB, voffB); PG8_STAGE(PG8_SA(0, 0), cA, voffA); PG8_STAGE(PG8_SB(0, 1), cB + hstepB, voffB); PG8_STAGE(PG8_SA(0, 1), cA + hstepA, voffA);
    if (wr == 1) PG8_BAR;
    PG8_WAIT_V(4); PG8_BAR;
    PG8_STAGE(PG8_SB(1, 0), PG8_KB(cB, 1), voffB); PG8_STAGE(PG8_SA(1, 0), PG8_KA(cA, 1), voffA); PG8_STAGE(PG8_SB(1, 1), PG8_KB(cB, 1) + hstepB, voffB);
    PG8_WAIT_V(6); PG8_BAR;
    for (;;) {
        const bool has_next = S.next(ui + 1, nxt);
        const char* nA = has_next ? g.base + nxt.offA : cA; const char* nB = has_next ? g.base + nxt.offB : cB;
        for (int t = 0; t < nt; t += 2) {
            const bool last = (t == nt - 2);
            const char* a1 = PG8_KA(cA, t + 1);
            const char* a2 = last ? nA : PG8_KA(cA, t + 2); const char* b2 = last ? nB : PG8_KB(cB, t + 2);
            const char* a3 = last ? PG8_KA(nA, 1) : PG8_KA(cA, t + 3); const char* b3 = last ? PG8_KB(nB, 1) : PG8_KB(cB, t + 3);
            PG8_LDB(B0, 0, 0); PG8_SCHED; PG8_LDA(At, 0, 0); PG8_STAGE(PG8_SA(1, 1), a1 + hstepA, voffA);
            PG8_WAIT_L(8); PG8_BAR; PG8_WAIT_L(0); PG8_MMA(0, 0, At, B0); PG8_BAR; PG8_SCHED;
            PG8_LDB(B1, 0, 1); PG8_STAGE(PG8_SB(0, 0), b2, voffB);
            PG8_BAR; PG8_WAIT_L(0); PG8_MMA(0, 1, At, B1); PG8_BAR;
            PG8_LDA(At, 0, 1); PG8_STAGE(PG8_SA(0, 0), a2, voffA);
            PG8_BAR; PG8_WAIT_L(0); PG8_MMA(1, 0, At, B0); PG8_BAR; PG8_SCHED;
            PG8_STAGE(PG8_SB(0, 1), b2 + hstepB, voffB);
            PG8_WAIT_V(6); PG8_BAR; PG8_MMA(1, 1, At, B1); PG8_BAR;
            PG8_LDB(B0, 1, 0); PG8_SCHED; PG8_LDA(At, 1, 0); PG8_STAGE(PG8_SA(0, 1), a2 + hstepA, voffA);
            PG8_WAIT_L(8); PG8_BAR; PG8_WAIT_L(0); PG8_MMA(0, 0, At, B0); PG8_BAR; PG8_SCHED;
            PG8_LDB(B1, 1, 1); PG8_STAGE(PG8_SB(1, 0), b3, voffB);
            PG8_BAR; PG8_WAIT_L(0); PG8_MMA(0, 1, At, B1); PG8_BAR;
            PG8_LDA(At, 1, 1); PG8_STAGE(PG8_SA(1, 0), a3, voffA);
            PG8_BAR; PG8_WAIT_L(0); PG8_MMA(1, 0, At, B0); PG8_BAR; PG8_SCHED;
            PG8_STAGE(PG8_SB(1, 1), b3 + hstepB, voffB);
            PG8_WAIT_V(6); PG8_BAR; PG8_MMA(1, 1, At, B1); PG8_BAR;
        }
        E(acc, cur, wr, wc, fr, fq);
        if (!has_next) break;
        { const float zf = E.keep(cur) ? 1.0f : 0.0f;
#pragma unroll
        for (int a = 0; a < 2; ++a)
#pragma unroll
            for (int b = 0; b < 2; ++b)
#pragma unroll
                for (int m = 0; m < 4; ++m)
#pragma unroll
                    for (int n = 0; n < 2; ++n) acc[a][b][m][n] *= zf; }
        cur = nxt; cA = nA; cB = nB; ++ui;
    }
    PG8_WAIT_V(0);
    if (wr == 0) PG8_BAR;
    PG8_BAR;
#undef PG8_KA
#undef PG8_KB
#undef PG8_SA
#undef PG8_SB
#undef PG8_STAGE
#undef PG8_LDA
#undef PG8_LDB
#undef PG8_MMA
#undef PG8_WAIT_V
#undef PG8_WAIT_L
#undef PG8_BAR
#undef PG8_SCHED
}
}
using pg8::Unit; using pg8::Gemm;
#define ACC_T f32x4 (&acc)[2][2][4][2]

enum { K_TOK = 0, K_HYIN = 1, K_F0 = 2, K_FNA = 3, K_FNB = 4, K_BR = 5, K_OUT = 6, K_IN = 7 };
struct SchedAny {
    int kind, G, c;
    __device__ __forceinline__ bool next(int i, Unit& u) const {
        const long Lx = (long)i * G + c;
        switch (kind) {
        case K_IN: {
            if (Lx < 3120) { int pn; pg8::tile_map((int)Lx, 65, 48, u.pm, pn); u.pn = pn < 4 ? 12 + pn : 16 + pn; u.aux = K_TOK;
                u.offA = OFF_XN + (size_t)u.pm * 256 * DM * 2; u.offB = OFF_WT + (size_t)u.pn * 256 * DM * 2; return true; }
            if (Lx < 3900) { pg8::tile_map((int)Lx - 3120, 12, 65, u.pm, u.pn); u.aux = K_HYIN;
                u.offA = OFF_WT + (size_t)u.pm * 256 * DM * 2; u.offB = OFF_XN + (size_t)u.pn * 256 * DM * 2; return true; }
            if (Lx < 4200) { pg8::tile_map((int)Lx - 3900, 4, 75, u.pm, u.pn); u.aux = K_F0;
                u.offA = OFF_WEFF + (size_t)u.pm * 256 * DM * 2; u.offB = OFF_XNP + (size_t)u.pn * 256 * DM * 2; return true; }
            return false; }
        case K_TOK: {
            if (Lx >= 65l * 48) return false; int pn; pg8::tile_map((int)Lx, 65, 48, u.pm, pn); u.pn = pn < 4 ? 12 + pn : 16 + pn; u.aux = 0;
            u.offA = OFF_XN + (size_t)u.pm * 256 * DM * 2; u.offB = OFF_WT + (size_t)u.pn * 256 * DM * 2; return true; }
        case K_HYIN: {
            if (Lx >= 12l * 65) return false; pg8::tile_map((int)Lx, 12, 65, u.pm, u.pn); u.aux = 0;
            u.offA = OFF_WT + (size_t)u.pm * 256 * DM * 2; u.offB = OFF_XN + (size_t)u.pn * 256 * DM * 2; return true; }
        case K_F0: {
            if (Lx >= 8l * 75) return false; pg8::tile_map((int)Lx, 8, 75, u.pm, u.pn); u.aux = 0;
            u.offA = OFF_WEFF + (size_t)u.pm * 256 * DM * 2; u.offB = OFF_XNP + (size_t)u.pn * 256 * DM * 2; return true; }
        case K_FNA: {
            if (Lx >= 2l * 400) return false; pg8::tile_map((int)Lx, 2, 400, u.pm, u.pn); u.aux = 0;
            u.offA = OFF_FA + (size_t)u.pm * 256 * 384 * 2; u.offB = OFF_ZT + (size_t)u.pn * 256 * FN1P * 2; return true; }
        case K_FNB: {
            if (Lx >= 164l * 4) return false; u.aux = (int)(Lx >> 2); u.pm = 0; u.pn = (int)(Lx & 3);
            u.offA = OFF_FB + (size_t)u.aux * 256 * 256 * 2; u.offB = OFF_A1 + (size_t)u.aux * 1024 * 256 * 2 + (size_t)u.pn * 256 * 256 * 2; return true; }
        case K_BR: {
            const int T = (i / 3) * G + c; if (T >= 64 * 8) return false; const int br = i % 3; pg8::tile_map(T, 64, 8, u.pm, u.pn); u.aux = br;
            u.offA = OFF_GATE + (size_t)br * SZ_GATE + (size_t)u.pm * 256 * 1024 * 2; u.offB = OFF_WA + (size_t)br * SZ_WBR + (size_t)u.pn * 256 * 1024 * 2; return true; }
        default: {
            if (Lx >= 64l * 8) return false; pg8::tile_map((int)Lx, 64, 8, u.pm, u.pn); u.aux = 0;
            u.offA = OFF_M + (size_t)u.pm * 256 * DM * 2; u.offB = OFF_WO + (size_t)u.pn * 256 * DM * 2; return true; }
        }
    }
};
#define ROWFENCE asm volatile("" ::: "memory")
#define HARDFENCE do { asm volatile("" ::: "memory"); __builtin_amdgcn_sched_barrier(0); } while (0)
struct EpiAny {
    int kind; unsigned char* ws; int layer; const float* xin; const float* metain;
    __device__ __forceinline__ bool keep(const Unit&) const { return false; }
    __device__ __forceinline__ void operator()(ACC_T, const Unit& u, int wr, int wc, int fr, int fq) const {
        const int rl0 = wr * 64 + fr, cl0 = wc * 32 + 8 * fq;
        const int ek = kind == K_IN ? u.aux : kind;
        if (ek == K_TOK) {
            const int t = u.pn; unsigned char* dst; unsigned ld; int c0, act;
            if (t < 16)      { dst = ws + OFF_GATE;               ld = 1024; c0 = (t - 12) * 256; act = 1; }
            else if (t < 24) { dst = ws + OFF_GATE + SZ_GATE;     ld = 1024; c0 = (t - 20) * 256; act = 1; }
            else if (t < 36) { dst = ws + OFF_QKV;                ld = 3072; c0 = (t - 24) * 256; act = 0; }
            else if (t < 40) { dst = ws + OFF_GATE + 2 * SZ_GATE; ld = 1024; c0 = (t - 36) * 256; act = 1; }
            else             { dst = ws + OFF_MERGE;              ld = 6144; c0 = (t - 40) * 256; act = 2; }
#pragma unroll
            for (int ai = 0; ai < 2; ++ai)
#pragma unroll
                for (int m = 0; m < 4; ++m) { const unsigned row = (unsigned)(u.pm * 256 + ai * 128 + m * 16 + rl0);
#pragma unroll
                    for (int bj = 0; bj < 2; ++bj) { const unsigned off = (row * ld + (unsigned)(c0 + bj * 128 + cl0)) * 2u; f32x4 v0 = acc[ai][bj][m][0], v1 = acc[ai][bj][m][1];
                        if (act == 1) {
#pragma unroll
                            for (int j = 0; j < 4; ++j) { v0[j] = silu_f(v0[j]); v1[j] = silu_f(v1[j]); } }
                        else if (act == 2) {
#pragma unroll
                            for (int j = 0; j < 4; ++j) { v0[j] = sigm_f(v0[j]); v1[j] = sigm_f(v1[j]); } }
                        u32x4 w; w.x = cvt_pk_bf16(v0[0], v0[1]); w.y = cvt_pk_bf16(v0[2], v0[3]); w.z = cvt_pk_bf16(v1[0], v1[1]); w.w = cvt_pk_bf16(v1[2], v1[3]);
                        *(u32x4*)(dst + off) = w; }
                    ROWFENCE; }
        } else if (ek == K_HYIN) {
            unsigned char* dst = ws + OFF_HYIN; const unsigned ld = LP;
#pragma unroll
            for (int ai = 0; ai < 2; ++ai)
#pragma unroll
                for (int m = 0; m < 4; ++m) { const unsigned row = (unsigned)(u.pm * 256 + ai * 128 + m * 16 + rl0);
#pragma unroll
                    for (int bj = 0; bj < 2; ++bj) { const unsigned off = (row * ld + (unsigned)(u.pn * 256 + bj * 128 + cl0)) * 2u; const f32x4 v0 = acc[ai][bj][m][0], v1 = acc[ai][bj][m][1];
                        u32x4 w; w.x = cvt_pk_bf16(v0[0], v0[1]); w.y = cvt_pk_bf16(v0[2], v0[3]); w.z = cvt_pk_bf16(v1[0], v1[1]); w.w = cvt_pk_bf16(v1[2], v1[3]);
                        *(u32x4*)(dst + off) = w; }
                    ROWFENCE; }
        } else if (ek == K_F0) {
            int rlx = rl0, clx = cl0; asm volatile("" : "+v"(rlx), "+v"(clx));
            unsigned char* dst = ws + OFF_ZT; const int g = u.pm; const unsigned colb0 = (unsigned)(u.pn * 256 + clx) * 2u;
#pragma unroll
            for (int ai = 0; ai < 2; ++ai)
#pragma unroll
                for (int m = 0; m < 4; ++m) { const int j = ai * 128 + m * 16 + rlx; const int part = j <= 128 ? 0 : 1; const int cp = j - 128 * part;
                    const unsigned o1 = (unsigned)(part * 1024 + g * 256 + cp) * (unsigned)(PROWS * 2) + colb0;
                    const bool mir = cp >= 1 && cp <= 127; const bool zim = part == 0 && !mir;
                    const unsigned o2 = (unsigned)((mir ? part : 1) * 1024 + g * 256 + (mir ? 256 - cp : cp)) * (unsigned)(PROWS * 2) + colb0;
                    const unsigned sgn = part == 1 ? 0x80008000u : 0u, msk = zim ? 0u : 0xffffffffu;
#pragma unroll
                    for (int bj = 0; bj < 2; ++bj) { const f32x4 v0 = acc[ai][bj][m][0], v1 = acc[ai][bj][m][1];
                        u32x4 w; w.x = cvt_pk_bf16(v0[0], v0[1]); w.y = cvt_pk_bf16(v0[2], v0[3]); w.z = cvt_pk_bf16(v1[0], v1[1]); w.w = cvt_pk_bf16(v1[2], v1[3]);
                        *(u32x4*)(dst + o1 + bj * 256) = w;
                        u32x4 wm; wm.x = (w.x ^ sgn) & msk; wm.y = (w.y ^ sgn) & msk; wm.z = (w.z ^ sgn) & msk; wm.w = (w.w ^ sgn) & msk;
                        *(u32x4*)(dst + o2 + bj * 256) = wm; }
                    ROWFENCE; }
        } else if (ek == K_FNA) {
            unsigned char* dst = ws + OFF_A1;
#pragma unroll
            for (int ai = 0; ai < 2; ++ai)
#pragma unroll
                for (int m = 0; m < 4; ++m) { const int k1 = ai * 128 + m * 16 + rl0;
                    if (k1 < FN1) {
#pragma unroll
                        for (int bj = 0; bj < 2; ++bj)
#pragma unroll
                            for (int n = 0; n < 2; ++n) { const int col = u.pn * 256 + bj * 128 + cl0 + 4 * n; const int ch = col / FN2, l2 = col - ch * FN2; const f32x4 v = acc[ai][bj][m][n];
                                u32x2 w; w.x = cvt_pk_bf16(v[0], v[1]); w.y = cvt_pk_bf16(v[2], v[3]);
                                *(u32x2*)(dst + ((unsigned)((k1 * 1024 + ch) * 2 + u.pm) * 128u + (unsigned)l2) * 2u) = w; } }
                    ROWFENCE; }
        } else if (ek == K_FNB) {
            unsigned char* dst = ws + OFF_GATE + SZ_GATE; const float scale = 1.0f / sqrtf((float)L_TOK * 256.0f);
#pragma unroll
            for (int ai = 0; ai < 2; ++ai)
#pragma unroll
                for (int m = 0; m < 4; ++m) { const int k2 = ai * 128 + m * 16 + rl0;
                    if (k2 < FN2) { const unsigned row = (unsigned)(u.aux + FN1 * k2);
#pragma unroll
                        for (int bj = 0; bj < 2; ++bj) { const unsigned off = (row * 1024u + (unsigned)(u.pn * 256 + bj * 128 + cl0)) * 2u; const u32x4 g = *(const u32x4*)(dst + off);
                            const f32x4 v0 = acc[ai][bj][m][0] * scale, v1 = acc[ai][bj][m][1] * scale;
                            u32x4 w; w.x = cvt_pk_bf16(v0[0] * lo_bf(g.x), v0[1] * hi_bf(g.x)); w.y = cvt_pk_bf16(v0[2] * lo_bf(g.y), v0[3] * hi_bf(g.y));
                            w.z = cvt_pk_bf16(v1[0] * lo_bf(g.z), v1[1] * hi_bf(g.z)); w.w = cvt_pk_bf16(v1[2] * lo_bf(g.w), v1[3] * hi_bf(g.w));
                            *(u32x4*)(dst + off) = w; } }
                    ROWFENCE; }
        } else {
            unsigned char* dst = ws + OFF_H;
#pragma unroll
            for (int ai = 0; ai < 2; ++ai) { f32x4 oq[4][2][2];
#pragma unroll
                for (int m = 0; m < 4; ++m) { const unsigned row = (unsigned)(u.pm * 256 + ai * 128 + m * 16 + rl0);
                    const float* srow = layer == 0 ? (row < (unsigned)NMETA ? metain + (size_t)row * DM : xin + (size_t)(row - NMETA) * DM) : (const float*)(dst + (size_t)row * DM * 4);
#pragma unroll
                    for (int bj = 0; bj < 2; ++bj) { const unsigned col = (unsigned)(u.pn * 256 + bj * 128 + cl0); oq[m][bj][0] = *(const f32x4*)(srow + col); oq[m][bj][1] = *(const f32x4*)(srow + col + 4); } }
#pragma unroll
                for (int m = 0; m < 4; ++m) { const unsigned row = (unsigned)(u.pm * 256 + ai * 128 + m * 16 + rl0);
#pragma unroll
                    for (int bj = 0; bj < 2; ++bj) { const unsigned off = (row * (unsigned)DM + (unsigned)(u.pn * 256 + bj * 128 + cl0)) * 4u;
                        *(f32x4*)(dst + off) = oq[m][bj][0] + acc[ai][bj][m][0]; *(f32x4*)(dst + off + 16) = oq[m][bj][1] + acc[ai][bj][m][1]; } }
                ROWFENCE; }
        }
    }
};

struct EpiBr {
    unsigned char* ws;
    __device__ __forceinline__ bool keep(const Unit& u) const { return u.aux < 2; }
    __device__ __forceinline__ void operator()(ACC_T, const Unit& u, int wr, int wc, int fr, int fq) const {
        const int rl0 = wr * 64 + fr, cl0 = wc * 32 + 8 * fq;
            unsigned char* dst = ws + OFF_M; const unsigned char* mg = ws + OFF_MERGE; const int br = u.aux;
#pragma unroll
            for (int ai = 0; ai < 2; ++ai)
#pragma unroll
              for (int mh = 0; mh < 4; mh += 2) { u32x4 gn[2][2], gd[2][2];
#pragma unroll
                for (int mm = 0; mm < 2; ++mm) { const unsigned row = (unsigned)(u.pm * 256 + ai * 128 + (mh + mm) * 16 + rl0);
#pragma unroll
                    for (int bj = 0; bj < 2; ++bj) { const unsigned col = (unsigned)(u.pn * 256 + bj * 128 + cl0);
                        gn[mm][bj] = *(const u32x4*)(mg + (row * 6144u + (unsigned)br * 2048u + col) * 2u);
                        if (br < 2) gd[mm][bj] = *(const u32x4*)(mg + (row * 6144u + (unsigned)(br + 1) * 2048u + col) * 2u); else gd[mm][bj] = (u32x4){0x3f803f80u, 0x3f803f80u, 0x3f803f80u, 0x3f803f80u}; } }
#pragma unroll
                for (int mm = 0; mm < 2; ++mm) { const int m = mh + mm; const unsigned row = (unsigned)(u.pm * 256 + ai * 128 + m * 16 + rl0);
#pragma unroll
                    for (int bj = 0; bj < 2; ++bj) { const u32x4 g = gn[mm][bj], d = gd[mm][bj];
                        const float s0 = lo_bf(g.x) * __builtin_amdgcn_rcpf(fmaxf(lo_bf(d.x), 1e-30f)), s1 = hi_bf(g.x) * __builtin_amdgcn_rcpf(fmaxf(hi_bf(d.x), 1e-30f));
                        const float s2 = lo_bf(g.y) * __builtin_amdgcn_rcpf(fmaxf(lo_bf(d.y), 1e-30f)), s3 = hi_bf(g.y) * __builtin_amdgcn_rcpf(fmaxf(hi_bf(d.y), 1e-30f));
                        const float s4 = lo_bf(g.z) * __builtin_amdgcn_rcpf(fmaxf(lo_bf(d.z), 1e-30f)), s5 = hi_bf(g.z) * __builtin_amdgcn_rcpf(fmaxf(hi_bf(d.z), 1e-30f));
                        const float s6 = lo_bf(g.w) * __builtin_amdgcn_rcpf(fmaxf(lo_bf(d.w), 1e-30f)), s7 = hi_bf(g.w) * __builtin_amdgcn_rcpf(fmaxf(hi_bf(d.w), 1e-30f));
                        f32x4 v0 = acc[ai][bj][m][0], v1 = acc[ai][bj][m][1];
                        v0[0] *= s0; v0[1] *= s1; v0[2] *= s2; v0[3] *= s3; v1[0] *= s4; v1[1] *= s5; v1[2] *= s6; v1[3] *= s7;
                        acc[ai][bj][m][0] = v0; acc[ai][bj][m][1] = v1;
                        if (br == 2) { const unsigned col = (unsigned)(u.pn * 256 + bj * 128 + cl0);
                            u32x4 w; w.x = cvt_pk_bf16(v0[0], v0[1]); w.y = cvt_pk_bf16(v0[2], v0[3]); w.z = cvt_pk_bf16(v1[0], v1[1]); w.w = cvt_pk_bf16(v1[2], v1[3]);
                            *(u32x4*)(dst + (row * (unsigned)DM + col) * 2u) = w; } } }
                ROWFENCE; }
    }
};

__device__ void phase_prep0(const Params& p, unsigned char* smem) {
    const int tid = opaque_tid(), bid = blockIdx.x, G = gridDim.x;
    const size_t gtid = (size_t)bid * NTHREADS + tid, gstride = (size_t)G * NTHREADS;
    { bf16_t* fa = (bf16_t*)(p.ws + OFF_FA);
      for (size_t i = gtid; i < (size_t)512 * 384; i += gstride) { const int row = (int)(i / 384), col = (int)(i % 384); const int po = row >> 8, k1 = row & 255, pi = col / 192, l1 = col % 192; float v = 0.f;
          if (k1 < FN1 && l1 < FN1) { const int r = (k1 * l1) % FN1; const float a = (float)r / (float)FN1; const float cs = __builtin_amdgcn_cosf(a), sn = __builtin_amdgcn_sinf(a);
              v = (po == 0) ? (pi == 0 ? cs : sn) : (pi == 0 ? -sn : cs); }
          fa[i] = f2bf(v); } }
    { bf16_t* fb = (bf16_t*)(p.ws + OFF_FB);
      for (size_t i = gtid; i < (size_t)FN1 * 65536; i += gstride) { const int k1 = (int)(i >> 16), k2 = (int)((i >> 8) & 255), kk = (int)(i & 255), part = kk >> 7, l2 = kk & 127; float v = 0.f;
          if (k2 < FN2 && l2 < FN2) { const int lp = k1 + FN1 * k2; const int r = (l2 * lp) % L_TOK; const float a = (float)r / (float)L_TOK; v = part == 0 ? __builtin_amdgcn_cosf(a) : __builtin_amdgcn_sinf(a); }
          fb[i] = f2bf(v); } }
    { float* w1s = (float*)smem;
      float* w2s = w1s + 33 * 64;
      float* w3s = w2s + 64 * 64;
      const int lane = tid & 63, wv = tid >> 6;
      for (int layer = 0; layer < 2; ++layer) {
          __syncthreads();
          for (int i = tid; i < 33 * 64; i += NTHREADS) w1s[i] = p.f_w1[layer * 33 * 64 + i];
          for (int i = tid; i < 64 * 64; i += NTHREADS) { w2s[i] = p.f_w2[layer * 4096 + i]; w3s[i] = p.f_w3[layer * 4096 + i]; }
          __syncthreads();
          const float b1 = p.f_b1[layer * 64 + lane], b2 = p.f_b2[layer * 64 + lane], b3 = p.f_b3[layer * 64 + lane], fr = p.f_freq[layer * 64 + lane];
          bf16_t* h3 = (bf16_t*)(p.ws + OFF_H3) + (size_t)layer * L_TOK * 64;
          constexpr float INV2PI = 0.15915494309189535f;
          for (int lag0 = bid * 8 + wv; lag0 < L_TOK; lag0 += G * 16) {
              const int lagA = lag0, lagB = lag0 + G * 8; const bool hasB = lagB < L_TOK; const int lagBc = hasB ? lagB : lagA;
              float zA = 0.f, zB = 0.f;
              if (lane == 0) { zA = (float)lagA / (float)(L_TOK - 1); zB = (float)lagBc / (float)(L_TOK - 1); }
              else if (lane < 33) { const int j = (lane - 1) & 15; const float f = 1e-4f + (float)j * ((15.0f - 1e-4f) / 15.0f);
                  const float rA = f * ((float)lagA / (float)L_TOK), rB = f * ((float)lagBc / (float)L_TOK);
                  zA = lane < 17 ? __builtin_amdgcn_cosf(rA) : -__builtin_amdgcn_sinf(rA); zB = lane < 17 ? __builtin_amdgcn_cosf(rB) : -__builtin_amdgcn_sinf(rB); }
              float aA = b1, aB = b1;
#pragma unroll 3
              for (int i = 0; i < 33; ++i) { const float wgt = w1s[i * 64 + lane]; aA += __int_as_float(__builtin_amdgcn_readlane(__float_as_int(zA), i)) * wgt; aB += __int_as_float(__builtin_amdgcn_readlane(__float_as_int(zB), i)) * wgt; }
              const float h1A = __builtin_amdgcn_sinf(fr * aA * INV2PI), h1B = __builtin_amdgcn_sinf(fr * aB * INV2PI);
              aA = b2; aB = b2;
#pragma unroll 8
              for (int i = 0; i < 64; ++i) { const float wgt = w2s[i * 64 + lane]; aA += __int_as_float(__builtin_amdgcn_readlane(__float_as_int(h1A), i)) * wgt; aB += __int_as_float(__builtin_amdgcn_readlane(__float_as_int(h1B), i)) * wgt; }
              const float h2A = __builtin_amdgcn_sinf(fr * aA * INV2PI), h2B = __builtin_amdgcn_sinf(fr * aB * INV2PI);
              aA = b3; aB = b3;
#pragma unroll 8
              for (int i = 0; i < 64; ++i) { const float wgt = w3s[i * 64 + lane]; aA += __int_as_float(__builtin_amdgcn_readlane(__float_as_int(h2A), i)) * wgt; aB += __int_as_float(__builtin_amdgcn_readlane(__float_as_int(h2B), i)) * wgt; }
              h3[(size_t)lagA * 64 + lane] = f2bf(__builtin_amdgcn_sinf(fr * aA * INV2PI));
              if (hasB) h3[(size_t)lagB * 64 + lane] = f2bf(__builtin_amdgcn_sinf(fr * aB * INV2PI));
          }
      }
      __syncthreads(); }
}

__device__ void convert_matrix(const float* __restrict__ src, int K, int N, bf16_t* __restrict__ dst, int kshift  , int total, float* tile  ) {
    const int tid = opaque_tid(), G = gridDim.x; const int kl0 = tid >> 4, n4 = (tid & 15) * 4, nl = tid >> 3, k8 = (tid & 7) * 8;
    f32x4 pv0 = (f32x4){0.f, 0.f, 0.f, 0.f}, pv1 = pv0;
    int t = blockIdx.x;
    if (t < total) { const int kt = t & ((1 << kshift) - 1), nt_ = t >> kshift; const float* s = src + (size_t)(kt * 64 + kl0) * N + nt_ * 64 + n4; pv0 = *(const f32x4*)s; pv1 = *(const f32x4*)(s + (size_t)32 * N); }
    int buf = 0;
    for (; t < total; t += G) { float* tl = tile + buf * (64 * 65); const int kt = t & ((1 << kshift) - 1), nt_ = t >> kshift;
        tl[kl0 * 65 + n4] = pv0[0]; tl[kl0 * 65 + n4 + 1] = pv0[1]; tl[kl0 * 65 + n4 + 2] = pv0[2]; tl[kl0 * 65 + n4 + 3] = pv0[3];
        tl[(32 + kl0) * 65 + n4] = pv1[0]; tl[(32 + kl0) * 65 + n4 + 1] = pv1[1]; tl[(32 + kl0) * 65 + n4 + 2] = pv1[2]; tl[(32 + kl0) * 65 + n4 + 3] = pv1[3];
        { const int tn = t + G; if (tn < total) { const int kt2 = tn & ((1 << kshift) - 1), nt2 = tn >> kshift; const float* s = src + (size_t)(kt2 * 64 + kl0) * N + nt2 * 64 + n4; pv0 = *(const f32x4*)s; pv1 = *(const f32x4*)(s + (size_t)32 * N); } }
        __syncthreads();
        u32x4 w; w.x = cvt_pk_bf16(tl[(k8 + 0) * 65 + nl], tl[(k8 + 1) * 65 + nl]); w.y = cvt_pk_bf16(tl[(k8 + 2) * 65 + nl], tl[(k8 + 3) * 65 + nl]);
        w.z = cvt_pk_bf16(tl[(k8 + 4) * 65 + nl], tl[(k8 + 5) * 65 + nl]); w.w = cvt_pk_bf16(tl[(k8 + 6) * 65 + nl], tl[(k8 + 7) * 65 + nl]);
        *(u32x4*)(dst + (size_t)(nt_ * 64 + nl) * K + kt * 64 + k8) = w;
        buf ^= 1; }
    __syncthreads();
}

__device__ void phase_p1(const Params& p, int layer, unsigned char* smem) {
    const int tid = opaque_tid(), bid = blockIdx.x, G = gridDim.x;
    float* tile = (float*)smem;
    { const float* win = p.w_in + (size_t)layer * DM * NIN;
      convert_matrix(win, DM, NIN, (bf16_t*)(p.ws + OFF_WT), 5, 32 * 256, tile);
      for (int br = 0; br < 3; ++br) { const float* wsrc = (br == 0 ? p.w_a : br == 1 ? p.w_b : p.w_c) + (size_t)layer * 1024 * DM;
          convert_matrix(wsrc, 1024, DM, (bf16_t*)(p.ws + OFF_WA + br * SZ_WBR), 4, 16 * 32, tile); }
      const float* wo = p.w_out + (size_t)layer * DM * DM;
      convert_matrix(wo, DM, DM, (bf16_t*)(p.ws + OFF_WO), 5, 32 * 32, tile);
      __syncthreads(); }
    { const float* win = p.w_in + (size_t)layer * DM * NIN;
      const int lane = tid & 63, wv = tid >> 6, l15 = lane & 15, quad = lane >> 4;
      for (int t = bid; t < 256; t += G) { const int g = t >> 6, k0 = (t & 63) * 32;
          f32x4 acc[2][2];
#pragma unroll
          for (int jt = 0; jt < 2; ++jt)
#pragma unroll
              for (int nt_ = 0; nt_ < 2; ++nt_) acc[jt][nt_] = (f32x4){0.f, 0.f, 0.f, 0.f};
#pragma unroll 4
          for (int ks = 0; ks < 8; ++ks) { const int c0 = ks * 32 + quad * 8;
              bf16x8 bfr[2];
#pragma unroll
              for (int nt_ = 0; nt_ < 2; ++nt_) { const float* wp = win + (size_t)(k0 + nt_ * 16 + l15) * NIN + 4096 + g * 256 + c0; const f32x4 x0 = *(const f32x4*)wp, x1 = *(const f32x4*)(wp + 4);
                  u32x4 pk; pk.x = cvt_pk_bf16(x0[0], x0[1]); pk.y = cvt_pk_bf16(x0[2], x0[3]); pk.z = cvt_pk_bf16(x1[0], x1[1]); pk.w = cvt_pk_bf16(x1[2], x1[3]); bfr[nt_] = __builtin_bit_cast(bf16x8, pk); }
#pragma unroll
              for (int jt = 0; jt < 2; ++jt) { const int j = wv * 32 + jt * 16 + l15; const bool im = j > 128; const int cp = im ? j - 128 : j; float d[8];
#pragma unroll
                  for (int e = 0; e < 8; ++e) { const float rev = (float)(((c0 + e) * cp) & 255) * (1.0f / 256.0f); d[e] = im ? -__builtin_amdgcn_sinf(rev) : __builtin_amdgcn_cosf(rev); }
                  u32x4 pk; pk.x = cvt_pk_bf16(d[0], d[1]); pk.y = cvt_pk_bf16(d[2], d[3]); pk.z = cvt_pk_bf16(d[4], d[5]); pk.w = cvt_pk_bf16(d[6], d[7]);
                  const bf16x8 afr = __builtin_bit_cast(bf16x8, pk);
#pragma unroll
                  for (int nt_ = 0; nt_ < 2; ++nt_) acc[jt][nt_] = __builtin_amdgcn_mfma_f32_16x16x32_bf16(afr, bfr[nt_], acc[jt][nt_], 0, 0, 0); } }
          bf16_t* dstw = (bf16_t*)(p.ws + OFF_WEFF);
#pragma unroll
          for (int jt = 0; jt < 2; ++jt)
#pragma unroll
              for (int nt_ = 0; nt_ < 2; ++nt_)
#pragma unroll
                  for (int r = 0; r < 4; ++r) dstw[(size_t)(g * 256 + wv * 32 + jt * 16 + quad * 4 + r) * DM + k0 + nt_ * 16 + l15] = f2bf(acc[jt][nt_][r]); }
    }
    { const int lane = tid & 63, wv = tid >> 6; const float* h = (const float*)(p.ws + OFF_H); const float* gam = p.norm_g + layer * DM;
      bf16_t* xn = (bf16_t*)(p.ws + OFF_XN); bf16_t* xnp = (bf16_t*)(p.ws + OFF_XNP);
      for (int l = bid * 8 + wv; l < LP; l += G * 8) {
          if (l < L_TOK) { const f32x4* row = (const f32x4*)(layer == 0 ? (l < NMETA ? p.meta + (size_t)l * DM : p.x + (size_t)(l - NMETA) * DM) : h + (size_t)l * DM); f32x4 v[8]; float ss = 0.f;
#pragma unroll
              for (int i = 0; i < 8; ++i) { v[i] = row[i * 64 + lane]; ss += v[i][0] * v[i][0] + v[i][1] * v[i][1] + v[i][2] * v[i][2] + v[i][3] * v[i][3]; }
              ss = wave_sum(ss); const float inv = rsqrtf(ss * (1.0f / DM) + 1e-6f);
              const int l1 = l / FN2, l2 = l - l1 * FN2; const size_t pr = (size_t)l2 * FN1P + l1;
#pragma unroll
              for (int i = 0; i < 8; ++i) { const f32x4 gg = ((const f32x4*)gam)[i * 64 + lane]; u32x2 w; w.x = cvt_pk_bf16(v[i][0] * inv * gg[0], v[i][1] * inv * gg[1]); w.y = cvt_pk_bf16(v[i][2] * inv * gg[2], v[i][3] * inv * gg[3]);
                  *(u32x2*)(xn + (size_t)l * DM + (i * 64 + lane) * 4) = w; *(u32x2*)(xnp + pr * DM + (i * 64 + lane) * 4) = w; } }
          else { const u32x2 z = (u32x2){0u, 0u};
#pragma unroll
              for (int i = 0; i < 8; ++i) *(u32x2*)(xn + (size_t)l * DM + (i * 64 + lane) * 4) = z; } }
      for (int idx = bid * 8 + wv; idx < FN2 * (FN1P - FN1); idx += G * 8) { const int l2 = idx / (FN1P - FN1), l1 = FN1 + idx % (FN1P - FN1); const size_t pr = (size_t)l2 * FN1P + l1; const u32x2 z = (u32x2){0u, 0u};
#pragma unroll
          for (int i = 0; i < 8; ++i) *(u32x2*)(xnp + pr * DM + (i * 64 + lane) * 4) = z; } }
}

__device__ void na_phase(const Params& p, int layer, unsigned char* smem) {
    const int tid = opaque_tid(), wv = tid >> 6, lane = tid & 63, l15 = lane & 15, quad = lane >> 4;
    const int G = gridDim.x;
    const bf16_t* qkv = (const bf16_t*)(p.ws + OFF_QKV);
    unsigned char* sK = smem;
    bf16_t* sVT = (bf16_t*)(smem + 76032);
    float* sRPB = (float*)(smem + 144640);
    float* sMB = (float*)(smem + 146512);
    const int cb = wv & 3, hf = wv >> 2, c = cb * 16 + l15;
    const int cu = cb == 0 ? 0 : (cb == 1 ? 8 : (cb == 2 ? 24 : 32)), cs = min(max(c - 8, 0), 48);
    u32x4 pk[8], pv[8], pmk = (u32x4){0u, 0u, 0u, 0u}, pmv = (u32x4){0u, 0u, 0u, 0u}; bf16x8 pq0, pq1; float prp = 0.f;
#define NA_LOADS(U) do { const int r_ = (U) >> 4, hd_ = (U) & 15, r0_ = min(max(r_ - 4, 0), 248); \
        _Pragma("unroll") for (int ps = 0; ps < 8; ++ps) { const int tok = ps * 64 + (tid >> 3), ch = tid & 7; const size_t g = (size_t)(NMETA + r0_ * 64 + tok) * 3072 + hd_ * 64 + ch * 8; \
            pk[ps] = *(const u32x4*)(qkv + g + 1024); pv[ps] = *(const u32x4*)(qkv + g + 2048); } \
        if (tid < 128) { const size_t g = (size_t)(tid >> 3) * 3072 + hd_ * 64 + (tid & 7) * 8; pmk = *(const u32x4*)(qkv + g + 1024); pmv = *(const u32x4*)(qkv + g + 2048); } \
        { const bf16_t* qp = qkv + (size_t)(NMETA + r_ * 64 + c) * 3072 + hd_ * 64 + quad * 8; pq0 = *(const bf16x8*)qp; pq1 = *(const bf16x8*)(qp + 32); } \
        if (tid < 465) prp = p.rpb[(size_t)(layer * 16 + hd_) * 465 + tid]; else if (tid >= 480 && tid < 496) prp = p.meta_bias[(layer * 16 + hd_) * 16 + tid - 480]; } while (0)
    int u = blockIdx.x;
    if (u < 4096) NA_LOADS(u);
    for (; u < 4096; u += G) {
        const int r = u >> 4, hd = u & 15, r0 = min(max(r - 4, 0), 248);
        __syncthreads();
#pragma unroll
        for (int ps = 0; ps < 8; ++ps) { const int tok = ps * 64 + (tid >> 3), ch = tid & 7; const u32x4 vv = pv[ps];
            *(u32x4*)(sK + tok * 144 + ch * 16) = pk[ps];
            bf16_t* vt = sVT + (ch * 8) * 536 + tok;
            vt[0] = (bf16_t)vv.x; vt[536] = (bf16_t)(vv.x >> 16); vt[2 * 536] = (bf16_t)vv.y; vt[3 * 536] = (bf16_t)(vv.y >> 16);
            vt[4 * 536] = (bf16_t)vv.z; vt[5 * 536] = (bf16_t)(vv.z >> 16); vt[6 * 536] = (bf16_t)vv.w; vt[7 * 536] = (bf16_t)(vv.w >> 16); }
        if (tid < 128) { const int tok = tid >> 3, ch = tid & 7; const u32x4 vv = pmv;
            *(u32x4*)(sK + (512 + tok) * 144 + ch * 16) = pmk;
            bf16_t* vt = sVT + (ch * 8) * 536 + 512 + tok;
            vt[0] = (bf16_t)vv.x; vt[536] = (bf16_t)(vv.x >> 16); vt[2 * 536] = (bf16_t)vv.y; vt[3 * 536] = (bf16_t)(vv.y >> 16);
            vt[4 * 536] = (bf16_t)vv.z; vt[5 * 536] = (bf16_t)(vv.z >> 16); vt[6 * 536] = (bf16_t)vv.w; vt[7 * 536] = (bf16_t)(vv.w >> 16); }
        if (tid < 465) sRPB[tid] = prp; else if (tid >= 480 && tid < 496) sMB[tid - 480] = prp;
        const bf16x8 bq0 = pq0, bq1 = pq1;
        { const int un = u + G; if (un < 4096) NA_LOADS(un); }
        __syncthreads();
        bf16_t* yc = (bf16_t*)(p.ws + OFF_GATE + 2 * SZ_GATE);
        float gatev[4][4];
        if (hf == 0) {
#pragma unroll
            for (int rr = 0; rr < 4; ++rr)
#pragma unroll
                for (int dt = 0; dt < 4; ++dt) gatev[rr][dt] = bf2f(yc[(size_t)(NMETA + r * 64 + cb * 16 + quad * 4 + rr) * 1024 + hd * 64 + l15 + dt * 16]); }
        float sc[9][4];
#pragma unroll
        for (int ti = 0; ti < 9; ++ti) { const int j = 4 * hf + (ti >> 1), tt = ti & 1; const int slot0 = ti < 8 ? j * 64 + cu + tt * 16 : 512;
            const unsigned char* kp = sK + (slot0 + l15) * 144 + quad * 16;
            const bf16x8 a0 = *(const bf16x8*)kp, a1 = *(const bf16x8*)(kp + 64);
            f32x4 acc = (f32x4){0.f, 0.f, 0.f, 0.f};
            acc = __builtin_amdgcn_mfma_f32_16x16x32_bf16(a0, bq0, acc, 0, 0, 0); acc = __builtin_amdgcn_mfma_f32_16x16x32_bf16(a1, bq1, acc, 0, 0, 0);
            if (ti < 8) { const float* rp = sRPB + (r0 + j - r + 7) * 31 + (15 - c);
#pragma unroll
                for (int rr = 0; rr < 4; ++rr) { const int kc = cu + tt * 16 + quad * 4 + rr; const bool ok = kc >= cs && kc < cs + 16; const int kcc = ok ? kc : cs;
                    sc[ti][rr] = ok ? acc[rr] * 0.125f + rp[kcc] : -1.0e30f; } }
            else {
#pragma unroll
                for (int rr = 0; rr < 4; ++rr) sc[ti][rr] = hf == 0 ? acc[rr] * 0.125f + sMB[quad * 4 + rr] : -1.0e30f; } }
        float mx = -1.0e30f;
#pragma unroll
        for (int ti = 0; ti < 9; ++ti)
#pragma unroll
            for (int rr = 0; rr < 4; ++rr) mx = fmaxf(mx, sc[ti][rr]);
        mx = fmaxf(mx, __shfl_xor(mx, 16)); mx = fmaxf(mx, __shfl_xor(mx, 32));
        float lsum = 0.f;
#pragma unroll
        for (int ti = 0; ti < 9; ++ti)
#pragma unroll
            for (int rr = 0; rr < 4; ++rr) { sc[ti][rr] = __expf(sc[ti][rr] - mx); lsum += sc[ti][rr]; }
        lsum += __shfl_xor(lsum, 16); lsum += __shfl_xor(lsum, 32);
        f32x4 oacc[4];
#pragma unroll
        for (int dt = 0; dt < 4; ++dt) oacc[dt] = (f32x4){0.f, 0.f, 0.f, 0.f};
#pragma unroll
        for (int ks = 0; ks < 5; ++ks) { const int tA = 2 * ks, tB = 2 * ks + 1;
            const int jA = 4 * hf + (tA >> 1); const int slotA = tA < 8 ? jA * 64 + cu + (tA & 1) * 16 : 512; const int slotB = ks < 4 ? (4 * hf + (tB >> 1)) * 64 + cu + 16 : 512;
            u32x4 pa; pa.x = cvt_pk_bf16(sc[tA][0], sc[tA][1]); pa.y = cvt_pk_bf16(sc[tA][2], sc[tA][3]);
            if (ks < 4) { pa.z = cvt_pk_bf16(sc[tA + 1 < 9 ? tA + 1 : 8][0], sc[tA + 1 < 9 ? tA + 1 : 8][1]); pa.w = cvt_pk_bf16(sc[tA + 1 < 9 ? tA + 1 : 8][2], sc[tA + 1 < 9 ? tA + 1 : 8][3]); } else { pa.z = 0u; pa.w = 0u; }
            const bf16x8 af = __builtin_bit_cast(bf16x8, pa);
#pragma unroll
            for (int dt = 0; dt < 4; ++dt) { const bf16_t* vr = sVT + (dt * 16 + l15) * 536 + quad * 4;
                const u32x2 lo = *(const u32x2*)(vr + slotA), hi = *(const u32x2*)(vr + slotB);
                const u32x4 bb = (u32x4){lo.x, lo.y, hi.x, hi.y};
                oacc[dt] = __builtin_amdgcn_mfma_f32_16x16x32_bf16(af, __builtin_bit_cast(bf16x8, bb), oacc[dt], 0, 0, 0); } }
        __syncthreads();
        float* part = (float*)smem + cb * 1056;
        if (hf == 1) {
#pragma unroll
            for (int dt = 0; dt < 4; ++dt)
#pragma unroll
                for (int rr = 0; rr < 4; ++rr) part[(quad * 4 + rr) * 64 + dt * 16 + l15] = oacc[dt][rr];
            if (quad == 0) { part[1024 + l15] = mx; part[1040 + l15] = lsum; } }
        __syncthreads();
        if (hf == 0) {
#pragma unroll
            for (int rr = 0; rr < 4; ++rr) { const int qy = quad * 4 + rr; const float m0 = __shfl(mx, qy), l0 = __shfl(lsum, qy); const float m1 = part[1024 + qy], l1 = part[1040 + qy];
                const float M = fmaxf(m0, m1), f0 = __expf(m0 - M), f1 = __expf(m1 - M); const float inv = 1.0f / (f0 * l0 + f1 * l1);
                bf16_t* gp = yc + (size_t)(NMETA + r * 64 + cb * 16 + qy) * 1024 + hd * 64 + l15;
#pragma unroll
                for (int dt = 0; dt < 4; ++dt) { const float o = (f0 * oacc[dt][rr] + f1 * part[qy * 64 + dt * 16 + l15]) * inv; gp[dt * 16] = f2bf(o * gatev[rr][dt]); } } }
    }
#undef NA_LOADS
}
__device__ void na_meta_unit(const Params& p, int layer) {
    const int tid = opaque_tid();
    if (tid < 256) { const int hd = tid >> 4, qi = tid & 15; const bf16_t* qkv = (const bf16_t*)(p.ws + OFF_QKV);
        float q[64];
        { const u32x4* qp = (const u32x4*)(qkv + (size_t)qi * 3072 + hd * 64);
#pragma unroll
          for (int i = 0; i < 8; ++i) { const u32x4 v = qp[i]; q[i * 8 + 0] = lo_bf(v.x) * 0.125f; q[i * 8 + 1] = hi_bf(v.x) * 0.125f; q[i * 8 + 2] = lo_bf(v.y) * 0.125f; q[i * 8 + 3] = hi_bf(v.y) * 0.125f;
              q[i * 8 + 4] = lo_bf(v.z) * 0.125f; q[i * 8 + 5] = hi_bf(v.z) * 0.125f; q[i * 8 + 6] = lo_bf(v.w) * 0.125f; q[i * 8 + 7] = hi_bf(v.w) * 0.125f; } }
        float o[64];
#pragma unroll
        for (int i = 0; i < 64; ++i) o[i] = 0.f;
        float mx = -3.0e38f, lsum = 0.f;
#pragma unroll 1
        for (int m = 0; m < 16; ++m) { const u32x4* kp = (const u32x4*)(qkv + (size_t)m * 3072 + 1024 + hd * 64); const u32x4* vp = (const u32x4*)(qkv + (size_t)m * 3072 + 2048 + hd * 64);
            float d0 = 0.f, d1 = 0.f;
#pragma unroll
            for (int e = 0; e < 8; ++e) { const u32x4 v = kp[e];
                d0 += q[e * 8 + 0] * lo_bf(v.x) + q[e * 8 + 2] * lo_bf(v.y) + q[e * 8 + 4] * lo_bf(v.z) + q[e * 8 + 6] * lo_bf(v.w);
                d1 += q[e * 8 + 1] * hi_bf(v.x) + q[e * 8 + 3] * hi_bf(v.y) + q[e * 8 + 5] * hi_bf(v.z) + q[e * 8 + 7] * hi_bf(v.w); }
            const float sc = d0 + d1 + p.meta_bias[(layer * 16 + hd) * 16 + m]; const float mnew = fmaxf(mx, sc); const float alpha = __expf(mx - mnew), pi = __expf(sc - mnew);
            lsum = lsum * alpha + pi; mx = mnew;
#pragma unroll
            for (int e = 0; e < 8; ++e) { const u32x4 v = vp[e];
                o[e * 8 + 0] = o[e * 8 + 0] * alpha + pi * lo_bf(v.x); o[e * 8 + 1] = o[e * 8 + 1] * alpha + pi * hi_bf(v.x); o[e * 8 + 2] = o[e * 8 + 2] * alpha + pi * lo_bf(v.y); o[e * 8 + 3] = o[e * 8 + 3] * alpha + pi * hi_bf(v.y);
                o[e * 8 + 4] = o[e * 8 + 4] * alpha + pi * lo_bf(v.z); o[e * 8 + 5] = o[e * 8 + 5] * alpha + pi * hi_bf(v.z); o[e * 8 + 6] = o[e * 8 + 6] * alpha + pi * lo_bf(v.w); o[e * 8 + 7] = o[e * 8 + 7] * alpha + pi * hi_bf(v.w); } }
        const float inv = 1.0f / lsum; u32x4* gp = (u32x4*)((bf16_t*)(p.ws + OFF_GATE + 2 * SZ_GATE) + (size_t)qi * 1024 + hd * 64);
#pragma unroll
        for (int e = 0; e < 8; ++e) { const u32x4 g = gp[e]; u32x4 w;
            w.x = cvt_pk_bf16(o[e * 8 + 0] * inv * lo_bf(g.x), o[e * 8 + 1] * inv * hi_bf(g.x)); w.y = cvt_pk_bf16(o[e * 8 + 2] * inv * lo_bf(g.y), o[e * 8 + 3] * inv * hi_bf(g.y));
            w.z = cvt_pk_bf16(o[e * 8 + 4] * inv * lo_bf(g.z), o[e * 8 + 5] * inv * hi_bf(g.z)); w.w = cvt_pk_bf16(o[e * 8 + 6] * inv * lo_bf(g.w), o[e * 8 + 7] * inv * hi_bf(g.w));
            gp[e] = w; } }
}

__device__ __forceinline__ unsigned rev4_14(unsigned k) { unsigned r = __brev(k) >> 18; return ((r & 0x1555u) << 1) | ((r >> 1) & 0x1555u); }
__device__ __forceinline__ float2 cmul(float2 a, float2 b) { return make_float2(a.x * b.x - a.y * b.y, a.x * b.y + a.y * b.x); }
#define PADI(i) ((i) + ((i) >> 4))
#define CFF(n) cff[2 * PADI((n) >> 1) + ((n) & 1)]
__device__ __forceinline__ void hw_sincos(float rev, float& sn, float& cs) { sn = __builtin_amdgcn_sinf(rev); cs = __builtin_amdgcn_cosf(rev); }
__device__ __forceinline__ float c16(int k) { const float t[10] = {1.0f, 0.9238795325f, 0.7071067812f, 0.3826834324f, 0.0f, -0.3826834324f, -0.7071067812f, -0.9238795325f, -1.0f, -0.9238795325f}; return t[k]; }
__device__ __forceinline__ float s16(int k) { const float t[10] = {0.0f, 0.3826834324f, 0.7071067812f, 0.9238795325f, 1.0f, 0.9238795325f, 0.7071067812f, 0.3826834324f, 0.0f, -0.3826834324f}; return t[k]; }
__device__ __forceinline__ float2 cadd(float2 a, float2 b) { return make_float2(a.x + b.x, a.y + b.y); }
__device__ __forceinline__ float2 csub(float2 a, float2 b) { return make_float2(a.x - b.x, a.y - b.y); }
template <int SGN> __device__ __forceinline__ void bf4(float2& a0, float2& a1, float2& a2, float2& a3) {
    const float2 t0 = cadd(a0, a2), t1 = csub(a0, a2), t2 = cadd(a1, a3), d = csub(a1, a3);
    const float2 t3 = SGN < 0 ? make_float2(d.y, -d.x) : make_float2(-d.y, d.x);
    a0 = cadd(t0, t2); a1 = cadd(t1, t3); a2 = csub(t0, t2); a3 = csub(t1, t3);
}
template <int S> __device__ __forceinline__ void r16_fwd_pass(float2* a) {
    constexpr int Q = S / 4;
    for (int u = opaque_tid(); u < 1024; u += NTHREADS) { const int j = u & (Q - 1); const int base = ((u - j) << 4) + j;
        float2 x[4][4];
#pragma unroll
        for (int aa = 0; aa < 4; ++aa)
#pragma unroll
            for (int bb = 0; bb < 4; ++bb) x[aa][bb] = a[PADI(base + aa * S + bb * Q)];
        float sn, cs; hw_sincos((float)j / (float)(4 * S), sn, cs); const float2 wb0 = make_float2(cs, -sn);
#pragma unroll
        for (int bb = 0; bb < 4; ++bb) { const float2 w1 = bb == 0 ? wb0 : cmul(wb0, make_float2(c16(bb), -s16(bb))); const float2 w2 = cmul(w1, w1), w3 = cmul(w2, w1);
            bf4<-1>(x[0][bb], x[1][bb], x[2][bb], x[3][bb]); x[1][bb] = cmul(x[1][bb], w1); x[2][bb] = cmul(x[2][bb], w2); x[3][bb] = cmul(x[3][bb], w3); }
        hw_sincos((float)j / (float)S, sn, cs); const float2 v1 = make_float2(cs, -sn), v2 = cmul(v1, v1), v3 = cmul(v2, v1);
#pragma unroll
        for (int aa = 0; aa < 4; ++aa) { bf4<-1>(x[aa][0], x[aa][1], x[aa][2], x[aa][3]); x[aa][1] = cmul(x[aa][1], v1); x[aa][2] = cmul(x[aa][2], v2); x[aa][3] = cmul(x[aa][3], v3); }
#pragma unroll
        for (int aa = 0; aa < 4; ++aa)
#pragma unroll
            for (int bb = 0; bb < 4; ++bb) a[PADI(base + aa * S + bb * Q)] = x[aa][bb]; }
    __syncthreads();
}
template <int S> __device__ __forceinline__ void r16_inv_pass(float2* a) {
    constexpr int Q = S / 4;
    for (int u = opaque_tid(); u < 1024; u += NTHREADS) { const int j = u & (Q - 1); const int base = ((u - j) << 4) + j;
        float2 x[4][4];
#pragma unroll
        for (int aa = 0; aa < 4; ++aa)
#pragma unroll
            for (int bb = 0; bb < 4; ++bb) x[aa][bb] = a[PADI(base + aa * S + bb * Q)];
        float sn, cs; hw_sincos((float)j / (float)S, sn, cs); const float2 v1 = make_float2(cs, sn), v2 = cmul(v1, v1), v3 = cmul(v2, v1);
#pragma unroll
        for (int aa = 0; aa < 4; ++aa) { x[aa][1] = cmul(x[aa][1], v1); x[aa][2] = cmul(x[aa][2], v2); x[aa][3] = cmul(x[aa][3], v3); bf4<1>(x[aa][0], x[aa][1], x[aa][2], x[aa][3]); }
        hw_sincos((float)j / (float)(4 * S), sn, cs); const float2 wb0 = make_float2(cs, sn);
#pragma unroll
        for (int bb = 0; bb < 4; ++bb) { const float2 w1 = bb == 0 ? wb0 : cmul(wb0, make_float2(c16(bb), s16(bb))); const float2 w2 = cmul(w1, w1), w3 = cmul(w2, w1);
            x[1][bb] = cmul(x[1][bb], w1); x[2][bb] = cmul(x[2][bb], w2); x[3][bb] = cmul(x[3][bb], w3); bf4<1>(x[0][bb], x[1][bb], x[2][bb], x[3][bb]); }
#pragma unroll
        for (int aa = 0; aa < 4; ++aa)
#pragma unroll
            for (int bb = 0; bb < 4; ++bb) a[PADI(base + aa * S + bb * Q)] = x[aa][bb]; }
    __syncthreads();
}
__device__ void fft_fwd(float2* a) {
    r16_fwd_pass<4096>(a);
    r16_fwd_pass<256>(a);
    { const int span = 16;
        for (int b = opaque_tid(); b < 4096; b += NTHREADS) { const int j = b & (span - 1); const int base = ((b - j) << 2) + j;
            const int i0 = PADI(base), i1 = PADI(base + span), i2 = PADI(base + 2 * span), i3 = PADI(base + 3 * span);
            float2 a0 = a[i0], a1 = a[i1], a2 = a[i2], a3 = a[i3];
            const float2 w1 = make_float2(c16(0) * 0.f + __builtin_amdgcn_cosf((float)j * (1.0f / 64.0f)), -__builtin_amdgcn_sinf((float)j * (1.0f / 64.0f))), w2 = cmul(w1, w1), w3 = cmul(w2, w1);
            bf4<-1>(a0, a1, a2, a3);
            a[i0] = a0; a[i1] = cmul(a1, w1); a[i2] = cmul(a2, w2); a[i3] = cmul(a3, w3); }
        __syncthreads(); }
    for (int blk = opaque_tid(); blk < 1024; blk += NTHREADS) { float2* pb = a + blk * 17; float2 x[16];
#pragma unroll
        for (int e = 0; e < 16; ++e) x[e] = pb[e];
#pragma unroll
        for (int j = 0; j < 4; ++j) { bf4<-1>(x[j], x[j + 4], x[j + 8], x[j + 12]);
            x[j + 4] = cmul(x[j + 4], make_float2(c16(j), -s16(j))); x[j + 8] = cmul(x[j + 8], make_float2(c16(2 * j), -s16(2 * j))); x[j + 12] = cmul(x[j + 12], make_float2(c16(3 * j), -s16(3 * j))); }
#pragma unroll
        for (int g = 0; g < 4; ++g) bf4<-1>(x[4 * g], x[4 * g + 1], x[4 * g + 2], x[4 * g + 3]);
#pragma unroll
        for (int e = 0; e < 16; ++e) pb[e] = x[e]; }
    __syncthreads();
}
__device__ void fft_inv(float2* a) {
    for (int blk = opaque_tid(); blk < 1024; blk += NTHREADS) { float2* pb = a + blk * 17; float2 x[16];
#pragma unroll
        for (int e = 0; e < 16; ++e) x[e] = pb[e];
#pragma unroll
        for (int g = 0; g < 4; ++g) bf4<1>(x[4 * g], x[4 * g + 1], x[4 * g + 2], x[4 * g + 3]);
#pragma unroll
        for (int j = 0; j < 4; ++j) { x[j + 4] = cmul(x[j + 4], make_float2(c16(j), s16(j))); x[j + 8] = cmul(x[j + 8], make_float2(c16(2 * j), s16(2 * j))); x[j + 12] = cmul(x[j + 12], make_float2(c16(3 * j), s16(3 * j)));
            bf4<1>(x[j], x[j + 4], x[j + 8], x[j + 12]); }
#pragma unroll
        for (int e = 0; e < 16; ++e) pb[e] = x[e]; }
    __syncthreads();
    { const int span = 16;
        for (int b = opaque_tid(); b < 4096; b += NTHREADS) { const int j = b & (span - 1); const int base = ((b - j) << 2) + j;
            const int i0 = PADI(base), i1 = PADI(base + span), i2 = PADI(base + 2 * span), i3 = PADI(base + 3 * span);
            const float2 w1 = make_float2(__builtin_amdgcn_cosf((float)j * (1.0f / 64.0f)), __builtin_amdgcn_sinf((float)j * (1.0f / 64.0f))), w2 = cmul(w1, w1), w3 = cmul(w2, w1);
            float2 a0 = a[i0], a1 = cmul(a[i1], w1), a2 = cmul(a[i2], w2), a3 = cmul(a[i3], w3);
            bf4<1>(a0, a1, a2, a3);
            a[i0] = a0; a[i1] = a1; a[i2] = a2; a[i3] = a3; }
        __syncthreads(); }
    r16_inv_pass<256>(a);
    r16_inv_pass<4096>(a);
}
__device__ __forceinline__ void hy_load8(const bf16_t* __restrict__ row, int t0, u32x4& v, float& xl, float& xh) {
    v = *(const u32x4*)(row + t0); xl = t0 > 0 ? bf2f(row[t0 - 1]) : 0.f; xh = (t0 + 8 < L_TOK) ? bf2f(row[t0 + 8]) : 0.f;
}
__device__ __forceinline__ void hy_calc8(const u32x4 v, float xl, float xh, const float (&w)[4], float (&o)[8]) {
    float x[10];
    x[0] = xl; x[9] = xh;
    x[1] = lo_bf(v.x); x[2] = hi_bf(v.x); x[3] = lo_bf(v.y); x[4] = hi_bf(v.y); x[5] = lo_bf(v.z); x[6] = hi_bf(v.z); x[7] = lo_bf(v.w); x[8] = hi_bf(v.w);
#pragma unroll
    for (int e = 0; e < 8; ++e) o[e] = w[0] * x[e] + w[1] * x[e + 1] + w[2] * x[e + 2] + w[3];
}
__device__ __forceinline__ void hy_val8(const bf16_t* __restrict__ row, int t0, const float (&w)[4], float (&o)[8]) { u32x4 v; float xl, xh; hy_load8(row, t0, v, xl, xh); hy_calc8(v, xl, xh, w, o); }
struct HyCh { const bf16_t* __restrict__ ru; const bf16_t* __restrict__ r1; const bf16_t* __restrict__ r2; float wu[4], w1[4], w2[4]; };

constexpr int SD_W4B = 0  , SD_GFX = 512, SD_GBX = 528, SD_EF = 544, SD_EB = 560, SD_VH = 576, SD_VT = 592, SD_END = 608;
constexpr int NCHUNK = L_TOK / 8;

template <int ORDER>
__device__ void hy_conv(const HyCh& hc, float2* cf, float* side, unsigned char* scratch) {
    const int tid = opaque_tid(); float* cff = (float*)cf;
    f32x4* __restrict__ heo = (f32x4*)(scratch + HS_HEO); const float* __restrict__ z2g = (const float*)(scratch + HS_Z2);
    if (tid < 15) side[SD_EF + tid] = CFF(16369 + tid); else if (tid >= 32 && tid < 47) side[SD_EB + tid - 32] = CFF(32768 - (16369 + tid - 32));
    __syncthreads();
    fft_fwd(cf);
    for (int j = tid; j <= 8192; j += NTHREADS) { const unsigned i_ = j < 8192 ? ((((unsigned)j >> 1) << 2) | ((unsigned)j & 1u)) : 2u; const unsigned k = rev4_14(i_); const unsigned kp = (16384u - k) & 16383u; const float2 a = cf[PADI(i_)], bq = cf[PADI(rev4_14(kp))];
        const float bx = bq.x, by = -bq.y; const float sc = 1.0f / 16384.0f;
        heo[j] = (f32x4){0.5f * (a.x + bx) * sc, 0.5f * (a.y + by) * sc, 0.5f * (a.y - by) * sc, -0.5f * (a.x - bx) * sc}; }
    __syncthreads();
    {
        u32x4 rv[4]; float rl[4], rh[4]; f32x4 z0[4], z1[4];
#pragma unroll
        for (int i = 0; i < 4; ++i) { const int c = tid + NTHREADS * i;
            if (ORDER == 0) hy_load8(hc.ru, 8 * c, rv[i], rl[i], rh[i]); else { z0[i] = *(const f32x4*)(z2g + 8 * c); z1[i] = *(const f32x4*)(z2g + 8 * c + 4); } }
#pragma unroll
        for (int i = 0; i < 4; ++i) { const int c = tid + NTHREADS * i; float v[8];
            if (ORDER == 0) hy_calc8(rv[i], rl[i], rh[i], hc.wu, v);
            else { v[0] = z0[i][0]; v[1] = z0[i][1]; v[2] = z0[i][2]; v[3] = z0[i][3]; v[4] = z1[i][0]; v[5] = z1[i][1]; v[6] = z1[i][2]; v[7] = z1[i][3]; }
            float2* d = cf + PADI(4 * c); d[0] = make_float2(v[0], v[1]); d[1] = make_float2(v[2], v[3]); d[2] = make_float2(v[4], v[5]); d[3] = make_float2(v[6], v[7]);
            if (i == 0 && tid < 2) {
#pragma unroll
                for (int e = 0; e < 8; ++e) side[SD_VH + 8 * tid + e] = v[e]; } }
        if (tid < 2) { const int c = NCHUNK - 2 + tid; float v[8];
            if (ORDER == 0) hy_val8(hc.ru, 8 * c, hc.wu, v);
            else { const f32x4 p0 = *(const f32x4*)(z2g + 8 * c), p1 = *(const f32x4*)(z2g + 8 * c + 4); v[0] = p0[0]; v[1] = p0[1]; v[2] = p0[2]; v[3] = p0[3]; v[4] = p1[0]; v[5] = p1[1]; v[6] = p1[2]; v[7] = p1[3]; }
            float2* d = cf + PADI(4 * c); d[0] = make_float2(v[0], v[1]); d[1] = make_float2(v[2], v[3]); d[2] = make_float2(v[4], v[5]); d[3] = make_float2(v[6], v[7]);
#pragma unroll
            for (int e = 0; e < 8; ++e) side[SD_VT + 8 * tid + e] = v[e]; } }
    for (int i = L_TOK / 2 + tid; i < 16384; i += NTHREADS) cf[PADI(i)] = make_float2(0.f, 0.f);
    __syncthreads();
    fft_fwd(cf);
#pragma unroll 4
    for (int j = tid; j <= 8192; j += NTHREADS) { const unsigned i_ = j < 8192 ? ((((unsigned)j >> 1) << 2) | ((unsigned)j & 1u)) : 2u; const unsigned k = rev4_14(i_); const unsigned kp = (16384u - k) & 16383u; const unsigned ik = PADI(i_), ikp = PADI(rev4_14(kp)); const float2 a = cf[ik], bq = cf[ikp];
        const float bx = bq.x, by = -bq.y;
        const float2 XE = make_float2(0.5f * (a.x + bx), 0.5f * (a.y + by)), XO = make_float2(0.5f * (a.y - by), -0.5f * (a.x - bx));
        const f32x4 hh = heo[j]; const float2 HE = make_float2(hh[0], hh[1]), HO = make_float2(hh[2], hh[3]);
        float sn, cs; hw_sincos((float)k / 16384.0f, sn, cs); const float2 w = make_float2(cs, -sn);
        const float2 xoho = cmul(XO, HO), wx = cmul(w, xoho), xehe = cmul(XE, HE), xeho = cmul(XE, HO), xohe = cmul(XO, HE);
        const float2 YE = make_float2(xehe.x + wx.x, xehe.y + wx.y), YO = make_float2(xeho.x + xohe.x, xeho.y + xohe.y);
        cf[ik] = make_float2(YE.x - YO.y, YE.y + YO.x); cf[ikp] = make_float2(YE.x + YO.y, -YE.y + YO.x); }
    __syncthreads();
    fft_inv(cf);
    if (tid < 16) { const int t = tid; float d = 0.f;
        for (int s = t + 16384; s < L_TOK; ++s) { const int l = s - t; const float wrong = l == 16384 ? 0.f : side[SD_EF + 16399 - l]; d += (side[SD_GBX + l - 16384] - wrong) * side[SD_VT + s - 16384]; }
        CFF(t) += d; }
    else if (tid >= 32 && tid < 48) { const int t = 16384 + tid - 32; float d = 0.f;
        for (int s = 0; s <= t - 16384; ++s) { const int l = t - s; const float wrong = l == 16384 ? 0.f : side[SD_EB + 16399 - l]; d += (side[SD_GFX + l - 16384] - wrong) * side[SD_VH + s]; }
        CFF(t) += d; }
    __syncthreads();
}

__device__ void filt_to_lds(const bf16_t* __restrict__ gfp, const bf16_t* __restrict__ gbp, float2* cf, float* side) {
    const int tid = opaque_tid(); float* cff = (float*)cf;
    u32x4 qf[4], qb[4];
#pragma unroll
    for (int i = 0; i < 4; ++i) { const int c = tid + NTHREADS * i; qf[i] = *(const u32x4*)(gfp + 8 * c); qb[i] = *(const u32x4*)(gbp + 8 * c); }
#pragma unroll
    for (int i = 0; i < 4; ++i) { const int c = tid + NTHREADS * i, lag0 = 8 * c; const u32x4 f = qf[i], g = qb[i];
        float2* d = cf + PADI(4 * c); d[0] = make_float2(lo_bf(f.x), hi_bf(f.x)); d[1] = make_float2(lo_bf(f.y), hi_bf(f.y)); d[2] = make_float2(lo_bf(f.z), hi_bf(f.z)); d[3] = make_float2(lo_bf(f.w), hi_bf(f.w));
        if (lag0 >= 1) CFF(32768 - lag0) = lo_bf(g.x);
        CFF(32768 - lag0 - 1) = hi_bf(g.x); CFF(32768 - lag0 - 2) = lo_bf(g.y); CFF(32768 - lag0 - 3) = hi_bf(g.y); CFF(32768 - lag0 - 4) = lo_bf(g.z); CFF(32768 - lag0 - 5) = hi_bf(g.z); CFF(32768 - lag0 - 6) = lo_bf(g.w); CFF(32768 - lag0 - 7) = hi_bf(g.w); }
    if (tid < 2) { const int c = NCHUNK - 2 + tid; const u32x4 f = *(const u32x4*)(gfp + 8 * c), g = *(const u32x4*)(gbp + 8 * c); float* sf = side + SD_GFX + 8 * tid; float* sb = side + SD_GBX + 8 * tid;
        sf[0] = lo_bf(f.x); sf[1] = hi_bf(f.x); sf[2] = lo_bf(f.y); sf[3] = hi_bf(f.y); sf[4] = lo_bf(f.z); sf[5] = hi_bf(f.z); sf[6] = lo_bf(f.w); sf[7] = hi_bf(f.w);
        sb[0] = lo_bf(g.x); sb[1] = hi_bf(g.x); sb[2] = lo_bf(g.y); sb[3] = hi_bf(g.y); sb[4] = lo_bf(g.z); sb[5] = hi_bf(g.z); sb[6] = lo_bf(g.w); sb[7] = hi_bf(g.w); }
    if (tid == 0) CFF(NMAIN) = 0.f;
    __syncthreads();
}

__device__ void hyena_filters(const Params& p, int layer, unsigned char* smem, unsigned char* scrD, unsigned char* scrW) {
    const int tid = opaque_tid(); float2* cf = (float2*)smem; float* cff = (float*)smem; float* side = (float*)(smem + 139264);
    const int bid = blockIdx.x;
    __syncthreads();
    bf16_t* w4b = (bf16_t*)(side + SD_W4B);
    for (int i = tid; i < 16 * 64; i += NTHREADS) { const int row = i >> 6, k = i & 63; w4b[i] = f2bf(p.f_w4[((size_t)layer * 64 + k) * 4096 + (row & 3) * 1024 + bid + 256 * (row >> 2)]); }
    __syncthreads();
    const bf16_t* __restrict__ h3b = (const bf16_t*)(p.ws + OFF_H3) + (size_t)layer * L_TOK * 64;
    const int lane = tid & 63, wv = tid >> 6, col = lane & 15, quad = lane >> 4;
    const int chq = bid + 256 * quad;
    float dk[4];
#pragma unroll
    for (int f = 0; f < 4; ++f) dk[f] = fabsf(p.decay[((layer * 2 + (f >> 1)) * 2 + (f & 1)) * 1024 + chq]) * (1.4426950408889634f / (float)(L_TOK - 1));
    const bf16x8 b0 = *(const bf16x8*)(w4b + col * 64 + quad * 8), b1 = *(const bf16x8*)(w4b + col * 64 + 32 + quad * 8);
    bf16_t* __restrict__ g2 = (bf16_t*)(scrW + HS_G2);
    bf16_t* __restrict__ fq = (bf16_t*)(scrD) + (size_t)(quad > 0 ? quad - 1 : 0) * 4 * L_TOK;
#define FG_LOAD(A0, A1, GB) do { _Pragma("unroll") for (int i = 0; i < 8; ++i) { const bf16_t* hr = h3b + (size_t)(((GB) + 8 * i) * 16 + col) * 64 + quad * 8; A0[i] = *(const bf16x8*)hr; A1[i] = *(const bf16x8*)(hr + 32); } } while (0)
#define FG_GROUP(X0, X1, G_) do { f32x4 acc = (f32x4){0.f, 0.f, 0.f, 0.f}; \
        acc = __builtin_amdgcn_mfma_f32_16x16x32_bf16(b0, X0, acc, 0, 0, 0); acc = __builtin_amdgcn_mfma_f32_16x16x32_bf16(b1, X1, acc, 0, 0, 0); \
        const int lag = (G_) * 16 + col; const float fl = -(float)lag; \
        const float v0 = acc[0] * __builtin_amdgcn_exp2f(fl * dk[0]), v1 = acc[1] * __builtin_amdgcn_exp2f(fl * dk[1]), v2 = acc[2] * __builtin_amdgcn_exp2f(fl * dk[2]), v3 = acc[3] * __builtin_amdgcn_exp2f(fl * dk[3]); \
        if (quad == 0) { g2[lag] = f2bf(v2); g2[L_TOK + lag] = f2bf(v3); \
            if (lag < NMAIN) { CFF(lag) = v0; if (lag >= 1) CFF(32768 - lag) = v1; } else { side[SD_GFX + lag - NMAIN] = v0; side[SD_GBX + lag - NMAIN] = v1; } } \
        else { fq[lag] = f2bf(v0); fq[L_TOK + lag] = f2bf(v1); fq[2 * L_TOK + lag] = f2bf(v2); fq[3 * L_TOK + lag] = f2bf(v3); } } while (0)
#define FG_PROC(A0, A1, GB) do { _Pragma("unroll") for (int i = 0; i < 8; ++i) FG_GROUP(A0[i], A1[i], (GB) + 8 * i); } while (0)
    { bf16x8 pa0[8], pa1[8], pb0[8], pb1[8];
      FG_LOAD(pa0, pa1, wv);
#pragma unroll 1
      for (int m = 0; m < 16; m += 2) { const int gbA = wv + 64 * m, gbB = gbA + 64;
          FG_LOAD(pb0, pb1, gbB);
          FG_PROC(pa0, pa1, gbA);
          if (m + 2 < 16) FG_LOAD(pa0, pa1, gbB + 64);
          FG_PROC(pb0, pb1, gbB); }
      if (wv == 0) { const bf16_t* hr = h3b + (size_t)(1024 * 16 + col) * 64 + quad * 8; const bf16x8 x0 = *(const bf16x8*)hr, x1 = *(const bf16x8*)(hr + 32); FG_GROUP(x0, x1, 1024); } }
#undef FG_LOAD
#undef FG_GROUP
#undef FG_PROC
    if (tid == 0) CFF(NMAIN) = 0.f;
    __syncthreads();
}

__device__ void hyena_unit(const Params& p, int layer, int q, unsigned char* smem, unsigned char* scrD, unsigned char* scratch) {
    const int tid = opaque_tid(); float2* cf = (float2*)smem; float* cff = (float*)smem; float* side = (float*)(smem + 139264);
    const int ch = blockIdx.x + 256 * q;
    const bf16_t* hyin = (const bf16_t*)(p.ws + OFF_HYIN);
    HyCh hc; hc.ru = hyin + (size_t)ch * LP; hc.r1 = hyin + (size_t)(1024 + ch) * LP; hc.r2 = hyin + (size_t)(2048 + ch) * LP;
    { const float* cw = p.conv_w + (size_t)layer * 3 * 3072; const float* cb = p.conv_b + (size_t)layer * 3072;
#pragma unroll
      for (int jj = 0; jj < 3; ++jj) { hc.wu[jj] = cw[jj * 3072 + ch]; hc.w1[jj] = cw[jj * 3072 + 1024 + ch]; hc.w2[jj] = cw[jj * 3072 + 2048 + ch]; }
      hc.wu[3] = cb[ch]; hc.w1[3] = cb[1024 + ch]; hc.w2[3] = cb[2048 + ch]; }
    const float sk0 = p.skip[(layer * 2 + 0) * 1024 + ch], sk1 = p.skip[(layer * 2 + 1) * 1024 + ch];
    float* __restrict__ z2g = (float*)(scratch + HS_Z2);
    const bf16_t* filt = q == 0 ? (const bf16_t*)(scratch + HS_G2) - 2 * (size_t)L_TOK : (const bf16_t*)scrD + (size_t)(q - 1) * 4 * L_TOK;
    bf16_t* __restrict__ hyout = (bf16_t*)(p.ws + OFF_HYOUT) + (size_t)ch * LP;
    if (q > 0) { __syncthreads(); filt_to_lds(filt, filt + L_TOK, cf, side); }
    hy_conv<0>(hc, cf, side, scratch);
    {   u32x4 ru_[4], r1_[4]; float ul[4], uh[4], xl[4], xh[4];
#pragma unroll
        for (int i = 0; i < 4; ++i) { const int c = tid + NTHREADS * i; hy_load8(hc.ru, 8 * c, ru_[i], ul[i], uh[i]); hy_load8(hc.r1, 8 * c, r1_[i], xl[i], xh[i]); }
#pragma unroll
        for (int i = 0; i < 5; ++i) { const int c = i < 4 ? tid + NTHREADS * i : NCHUNK - 2 + tid;
            if (i < 4 || tid < 2) { float u8[8], x8[8];
                if (i < 4) { hy_calc8(ru_[i], ul[i], uh[i], hc.wu, u8); hy_calc8(r1_[i], xl[i], xh[i], hc.w1, x8); } else { hy_val8(hc.ru, 8 * c, hc.wu, u8); hy_val8(hc.r1, 8 * c, hc.w1, x8); }
                const float2* s = cf + PADI(4 * c); const float2 y0 = s[0], y1 = s[1], y2 = s[2], y3 = s[3];
                const f32x4 o0 = (f32x4){x8[0] * (y0.x + sk0 * u8[0]), x8[1] * (y0.y + sk0 * u8[1]), x8[2] * (y1.x + sk0 * u8[2]), x8[3] * (y1.y + sk0 * u8[3])};
                const f32x4 o1 = (f32x4){x8[4] * (y2.x + sk0 * u8[4]), x8[5] * (y2.y + sk0 * u8[5]), x8[6] * (y3.x + sk0 * u8[6]), x8[7] * (y3.y + sk0 * u8[7])};
                *(f32x4*)(z2g + 8 * c) = o0; *(f32x4*)(z2g + 8 * c + 4) = o1; } } }
    __syncthreads();
    filt_to_lds(filt + 2 * (size_t)L_TOK, filt + 3 * (size_t)L_TOK, cf, side);
    hy_conv<1>(hc, cf, side, scratch);
    {   u32x4 r2_[4]; float xl[4], xh[4]; f32x4 z0[4], z1[4];
#pragma unroll
        for (int i = 0; i < 4; ++i) { const int c = tid + NTHREADS * i; hy_load8(hc.r2, 8 * c, r2_[i], xl[i], xh[i]); z0[i] = *(const f32x4*)(z2g + 8 * c); z1[i] = *(const f32x4*)(z2g + 8 * c + 4); }
#pragma unroll
        for (int i = 0; i < 5; ++i) { const int c = i < 4 ? tid + NTHREADS * i : NCHUNK - 2 + tid;
            if (i < 4 || tid < 2) { float x8[8]; f32x4 p0, p1;
                if (i < 4) { hy_calc8(r2_[i], xl[i], xh[i], hc.w2, x8); p0 = z0[i]; p1 = z1[i]; } else { hy_val8(hc.r2, 8 * c, hc.w2, x8); p0 = *(const f32x4*)(z2g + 8 * c); p1 = *(const f32x4*)(z2g + 8 * c + 4); }
                const float2* s = cf + PADI(4 * c); const float2 y0 = s[0], y1 = s[1], y2 = s[2], y3 = s[3];
                u32x4 w; w.x = cvt_pk_bf16(x8[0] * (y0.x + sk1 * p0[0]), x8[1] * (y0.y + sk1 * p0[1])); w.y = cvt_pk_bf16(x8[2] * (y1.x + sk1 * p0[2]), x8[3] * (y1.y + sk1 * p0[3]));
                w.z = cvt_pk_bf16(x8[4] * (y2.x + sk1 * p1[0]), x8[5] * (y2.y + sk1 * p1[1])); w.w = cvt_pk_bf16(x8[6] * (y3.x + sk1 * p1[2]), x8[7] * (y3.y + sk1 * p1[3]));
                *(u32x4*)(hyout + 8 * c) = w; } } }
    __syncthreads();
}

__device__ void transpose_phase(const Params& p, unsigned char* smem) {
    const int tid = opaque_tid(), G = gridDim.x; bf16_t* tile0 = (bf16_t*)smem;
    const bf16_t* __restrict__ hyout = (const bf16_t*)(p.ws + OFF_HYOUT); bf16_t* ya = (bf16_t*)(p.ws + OFF_GATE);
    const int cl = tid >> 3, t8 = (tid & 7) * 8, tl = tid >> 3, c8 = (tid & 7) * 8;
    u32x4 ph = (u32x4){0u, 0u, 0u, 0u}, pg = ph;
    constexpr int TOT = 16 * 257;
    int u = blockIdx.x;
    __syncthreads();
    if (u < TOT) { const int ct = u & 15, tt = u >> 4; ph = *(const u32x4*)(hyout + (size_t)(ct * 64 + cl) * LP + tt * 64 + t8); const int t = tt * 64 + tl; if (t < L_TOK) pg = *(const u32x4*)(ya + (size_t)t * 1024 + ct * 64 + c8); }
    int buf = 0;
    for (; u < TOT; u += G) { bf16_t* tile = tile0 + buf * (64 * 72); const int ct = u & 15, tt = u >> 4;
        *(u32x4*)(tile + cl * 72 + t8) = ph; const u32x4 g = pg;
        { const int un = u + G; if (un < TOT) { const int ct2 = un & 15, tt2 = un >> 4; ph = *(const u32x4*)(hyout + (size_t)(ct2 * 64 + cl) * LP + tt2 * 64 + t8); const int t2 = tt2 * 64 + tl; if (t2 < L_TOK) pg = *(const u32x4*)(ya + (size_t)t2 * 1024 + ct2 * 64 + c8); } }
        __syncthreads();
        const int t = tt * 64 + tl;
        if (t < L_TOK) { float v[8];
#pragma unroll
            for (int i = 0; i < 8; ++i) v[i] = bf2f(tile[(c8 + i) * 72 + tl]);
            u32x4 w; w.x = cvt_pk_bf16(v[0] * lo_bf(g.x), v[1] * hi_bf(g.x)); w.y = cvt_pk_bf16(v[2] * lo_bf(g.y), v[3] * hi_bf(g.y)); w.z = cvt_pk_bf16(v[4] * lo_bf(g.z), v[5] * hi_bf(g.z)); w.w = cvt_pk_bf16(v[6] * lo_bf(g.w), v[7] * hi_bf(g.w));
            *(u32x4*)(ya + (size_t)t * 1024 + ct * 64 + c8) = w; }
        buf ^= 1; }
    __syncthreads();
}

__device__ void phase_final(const Params& p) {
    const int tid = opaque_tid(), lane = tid & 63, wv = tid >> 6; const float* h = (const float*)(p.ws + OFF_H);
    for (int l = NMETA + blockIdx.x * 8 + wv; l < L_TOK; l += gridDim.x * 8) { const f32x4* row = (const f32x4*)(h + (size_t)l * DM); f32x4 v[8]; float ss = 0.f;
#pragma unroll
        for (int i = 0; i < 8; ++i) { v[i] = row[i * 64 + lane]; ss += v[i][0] * v[i][0] + v[i][1] * v[i][1] + v[i][2] * v[i][2] + v[i][3] * v[i][3]; }
        ss = wave_sum(ss); const float inv = rsqrtf(ss * (1.0f / DM) + 1e-6f); f32x4* o = (f32x4*)(p.out + (size_t)(l - NMETA) * DM);
#pragma unroll
        for (int i = 0; i < 8; ++i) { const f32x4 gg = ((const f32x4*)p.final_g)[i * 64 + lane]; o[i * 64 + lane] = v[i] * inv * gg; } }
}

__device__ void mini_branch(const Params& p) {
    const int tid = opaque_tid(), lane = tid & 63, wv = tid >> 6, nt_ = blockIdx.x * 8 + wv;
    if (nt_ < 128) { const int rc = lane & 15, quad = lane >> 4; const int n0 = nt_ * 16;
        const bf16_t* mg = (const bf16_t*)(p.ws + OFF_MERGE); bf16_t* mb = (bf16_t*)(p.ws + OFF_M);
        float tot[4] = {0.f, 0.f, 0.f, 0.f};
#pragma unroll 1
        for (int br = 0; br < 3; ++br) { const bf16_t* A = (const bf16_t*)(p.ws + OFF_GATE + (size_t)br * SZ_GATE) + (size_t)(NMAIN + rc) * 1024 + quad * 8;
            const bf16_t* B = (const bf16_t*)(p.ws + OFF_WA + (size_t)br * SZ_WBR) + (size_t)(n0 + rc) * 1024 + quad * 8;
            f32x4 acc = (f32x4){0.f, 0.f, 0.f, 0.f};
#pragma unroll 1
            for (int kb = 0; kb < 32; kb += 16) { bf16x8 av[16], bv[16];
#pragma unroll
                for (int i = 0; i < 16; ++i) { av[i] = *(const bf16x8*)(A + (kb + i) * 32); bv[i] = *(const bf16x8*)(B + (kb + i) * 32); }
#pragma unroll
                for (int i = 0; i < 16; ++i) acc = __builtin_amdgcn_mfma_f32_16x16x32_bf16(av[i], bv[i], acc, 0, 0, 0); }
#pragma unroll
            for (int r = 0; r < 4; ++r) tot[r] += acc[r] * bf2f(mg[(size_t)(NMAIN + quad * 4 + r) * 6144 + br * 2048 + n0 + rc]); }
#pragma unroll
        for (int r = 0; r < 4; ++r) mb[(size_t)(NMAIN + quad * 4 + r) * DM + n0 + rc] = f2bf(tot[r]); }
}
__device__ void mini_out(const Params& p, int layer) {
    const int tid = opaque_tid(), lane = tid & 63, wv = tid >> 6, nt_ = blockIdx.x * 8 + wv;
    if (nt_ < 128) { const int rc = lane & 15, quad = lane >> 4; const int n0 = nt_ * 16;
        const bf16_t* A = (const bf16_t*)(p.ws + OFF_M) + (size_t)(NMAIN + rc) * DM + quad * 8; const bf16_t* B = (const bf16_t*)(p.ws + OFF_WO) + (size_t)(n0 + rc) * DM + quad * 8;
        f32x4 acc = (f32x4){0.f, 0.f, 0.f, 0.f};
#pragma unroll 1
        for (int kb = 0; kb < 64; kb += 16) { bf16x8 av[16], bv[16];
#pragma unroll
            for (int i = 0; i < 16; ++i) { av[i] = *(const bf16x8*)(A + (kb + i) * 32); bv[i] = *(const bf16x8*)(B + (kb + i) * 32); }
#pragma unroll
            for (int i = 0; i < 16; ++i) acc = __builtin_amdgcn_mfma_f32_16x16x32_bf16(av[i], bv[i], acc, 0, 0, 0); }
        float* h = (float*)(p.ws + OFF_H);
#pragma unroll
        for (int r = 0; r < 4; ++r) { const size_t row = NMAIN + quad * 4 + r; const float bs = layer == 0 ? p.x[(row - NMETA) * DM + n0 + rc] : h[row * DM + n0 + rc]; h[row * DM + n0 + rc] = bs + acc[r]; } }
}

#define XB_TMO      128
#define XB_XCNT(j)  (256  + 64 * (j))
#define XB_XSUB(j)  (1280 + 64 * (j))
#define XB_XGEN(j)  (2304 + 64 * (j))
#define XB_TOP      3328
#define XB_TOPGEN   3392
#define XCD_BAR_WORDS 3456
#define XB_SPIN_CAP (1u << 18)
__device__ __forceinline__ unsigned xb_ld(unsigned* p)              { return __hip_atomic_load(p, __ATOMIC_RELAXED, __HIP_MEMORY_SCOPE_AGENT); }
__device__ __forceinline__ unsigned xb_add(unsigned* p, unsigned v) { return __hip_atomic_fetch_add(p, v, __ATOMIC_RELAXED, __HIP_MEMORY_SCOPE_AGENT); }
__device__ __forceinline__ unsigned xb_xcc_id() { return (unsigned)__builtin_amdgcn_s_getreg((3 << 11) | 20) & 0xFu; }
#define XB_SPIN(cond, bar) do { unsigned _sp = 0; while (cond) { __builtin_amdgcn_s_sleep(1); \
    if ((++_sp & 255u) == 0u) { if (xb_ld(&(bar)[XB_TMO])) break; if (_sp > XB_SPIN_CAP) { atomicAdd(&(bar)[XB_TMO], 1u); break; } } } } while (0)
struct XcdBarrier { unsigned* bar; unsigned x; volatile LAS unsigned* st; };
__device__ __forceinline__ void xcd_barrier_complete(unsigned* bar, unsigned x, unsigned& nloc, unsigned& nx) {
    const unsigned G = gridDim.x * gridDim.y * gridDim.z;
    unsigned sum, cnt, mine, sp = 0u;
    for (;;) {
        sum = 0u; cnt = 0u; mine = 0u;
#pragma unroll
        for (unsigned j = 0; j < 16; ++j) { const unsigned c = xb_ld(&bar[XB_XCNT(j)]); sum += c; cnt += (c > 0u) ? 1u : 0u; mine = (j == x) ? c : mine; }
        if (sum == G) break;
        __builtin_amdgcn_s_sleep(1);
        if ((++sp & 255u) == 0u) { if (xb_ld(&bar[XB_TMO])) break; if (sp > XB_SPIN_CAP) { atomicAdd(&bar[XB_TMO], 1u); break; } }
    }
    nloc = mine > 0u ? mine : 1u; nx = cnt > 0u ? cnt : 1u;
}
__device__ __forceinline__ void xcd_barrier(const XcdBarrier& b) {
    asm volatile("s_waitcnt vmcnt(0)" ::: "memory");
    __syncthreads();
    if (threadIdx.x == 0) {
        unsigned* bar = b.bar;
        __builtin_amdgcn_s_waitcnt(0);
        unsigned nloc = b.st[0], nx = b.st[1];
        if (nloc == 0u) { xcd_barrier_complete(bar, b.x, nloc, nx); b.st[0] = nloc; b.st[1] = nx; }
        const unsigned old = xb_add(&bar[XB_XSUB(b.x)], 1u);
        const unsigned gen = old / nloc;
        if (old + 1u == (gen + 1u) * nloc) {
            __builtin_amdgcn_fence(__ATOMIC_RELEASE, "agent");
            asm volatile("s_waitcnt vmcnt(0)" ::: "memory");
            const unsigned og = xb_add(&bar[XB_TOP], 1u);
            const unsigned tg = og / nx;
            if (og + 1u == (tg + 1u) * nx) xb_add(&bar[XB_TOPGEN], 1u);
            else XB_SPIN(xb_ld(&bar[XB_TOPGEN]) == tg, bar);
            __builtin_amdgcn_fence(__ATOMIC_ACQUIRE, "agent");
            xb_add(&bar[XB_XGEN(b.x)], 1u);
            asm volatile("s_waitcnt vmcnt(0)" ::: "memory");
        } else {
            XB_SPIN(xb_ld(&bar[XB_XGEN(b.x)]) == gen, bar);
            __builtin_amdgcn_fence(__ATOMIC_ACQUIRE, "agent");
            asm volatile("s_waitcnt vmcnt(0)" ::: "memory");
        }
    }
    __syncthreads();
}

enum { OP_P1 = 0, OP_SYNC, OP_GEMM, OP_NA, OP_HYENA, OP_TRANS, OP_NOP };
__global__ void __launch_bounds__(512, 2) hybrid_fwd(Params p) {
    extern __shared__ __attribute__((aligned(16))) unsigned char smem[];
    cg::grid_group grid = cg::this_grid();
    LAS unsigned char* lds = (LAS unsigned char*)smem;
    const int bid = blockIdx.x, G = gridDim.x;
    XcdBarrier xb; xb.bar = (unsigned*)(p.ws + OFF_BAR); xb.x = xb_xcc_id(); xb.st = (volatile LAS unsigned*)(lds + LDS_PHASE_BYTES);
    if (bid == 0) for (int i = opaque_tid(); i < XCD_BAR_WORDS; i += NTHREADS) xb.bar[i] = 0u;
    if (opaque_tid() == 0) { xb.st[0] = 0u; xb.st[1] = 0u; }
    __syncthreads();
    phase_prep0(p, smem);
    constexpr int NOPS = 17;
#pragma clang loop unroll(disable)
    for (int step = 0; step < 2 * NOPS; ++step) {
        const int layer = step / NOPS, s = step - layer * NOPS;
        int op, kind = 0;
        switch (s) {
        case 0: op = OP_P1; break;
        case 2: op = OP_GEMM; kind = K_IN; break;
        case 3: case 4: op = OP_NOP; break;
        case 6: op = OP_GEMM; kind = K_FNA; break;
        case 7: op = OP_NA; break;
        case 8: op = OP_HYENA; break;
        case 10: op = OP_GEMM; kind = K_FNB; break;
        case 11: op = OP_TRANS; break;
        case 13: op = OP_GEMM; kind = K_BR; break;
        case 15: op = OP_GEMM; kind = K_OUT; break;
        default: op = OP_SYNC; break;
        }
        if (op == OP_NOP) { }
        else if (op == OP_SYNC) { if (step == 1) { grid.sync(); if (opaque_tid() == 0) (void)xb_add(&xb.bar[XB_XCNT(xb.x)], 1u); } else xcd_barrier(xb); }
        else if (op == OP_GEMM) {
            Gemm g; g.base = (const char*)p.ws; g.jumpA = 0; g.jumpB = 0;
            switch (kind) {
            case K_FNA: g.lda = 384; g.ldb = FN1P; g.nt = 6; g.ksplit = 3; g.jumpB = (long)((size_t)1024 * PROWS * 2) - 384l; break;
            case K_FNB: g.lda = 256; g.ldb = 256; g.nt = 4; g.ksplit = 4; break;
            case K_BR:  g.lda = 1024; g.ldb = 1024; g.nt = 16; g.ksplit = 16; break;
            default:    g.lda = DM; g.ldb = DM; g.nt = 32; g.ksplit = 32; break;
            }
            SchedAny S{kind, G, bid}; EpiAny E{kind, p.ws, layer, p.x, p.meta};
            if (kind == K_BR) { EpiBr EB{p.ws}; pg8::gemm_phase(lds, g, S, EB); } else pg8::gemm_phase(lds, g, S, E);
            if (kind == K_BR) mini_branch(p); else if (kind == K_OUT) mini_out(p, layer);
        }
        else if (op == OP_P1) { phase_p1(p, layer, smem); }
        else if (op == OP_NA) { na_phase(p, layer, smem); if (bid == G - 1) na_meta_unit(p, layer); }
        else if (op == OP_HYENA) { unsigned char* scrD = (unsigned char*)p.out + (size_t)bid * HSD_STRIDE; unsigned char* scrW = p.ws + WS_END + (size_t)bid * HSW_STRIDE;
            hyena_filters(p, layer, smem, scrD, scrW);
#pragma clang loop unroll(disable)
            for (int q = 0; q < 4; ++q) hyena_unit(p, layer, q, smem, scrD, scrW); }
        else { transpose_phase(p, smem); }
    }
    phase_final(p);
}

extern "C" void kernel_launch(void* const* d_in, const int* in_sizes, int n_in, void* d_out, int out_size, void* d_ws, size_t ws_size, hipStream_t stream) {
    static int grid_blocks = 0;
    if (grid_blocks == 0) {
        if (n_in != 23 || ws_size < WS_END2) { fprintf(stderr, "kernel_launch: need 23 inputs and %zu bytes of workspace (got %d, %zu)\n", (size_t)WS_END2, n_in, ws_size); grid_blocks = -1; return; }
        int dev = 0, cus = 0, per_cu = 0;
        hipGetDevice(&dev); hipDeviceGetAttribute(&cus, hipDeviceAttributeMultiprocessorCount, dev);
        if (hipFuncSetAttribute((const void*)hybrid_fwd, hipFuncAttributeMaxDynamicSharedMemorySize, LDS_BYTES) != hipSuccess) { fprintf(stderr, "kernel_launch: hipFuncSetAttribute failed\n"); grid_blocks = -1; return; }
        hipOccupancyMaxActiveBlocksPerMultiprocessor(&per_cu, (const void*)hybrid_fwd, NTHREADS, LDS_BYTES);
        if (per_cu < 1) per_cu = 1;
        grid_blocks = cus * per_cu;
        if (grid_blocks > 256) grid_blocks = 256;
        if (grid_blocks != 256) { fprintf(stderr, "kernel_launch: this kernel needs 256 co-resident workgroups (got %d)\n", grid_blocks); grid_blocks = -1; return; }
    }
    if (grid_blocks < 0) return;
    Params p{};
    const float** f = (const float**)&p;
    for (int i = 0; i < 23; ++i) f[i] = (const float*)d_in[i];
    p.out = (float*)d_out; p.ws = (unsigned char*)d_ws;
    void* args[] = {&p};
    hipError_t e = hipLaunchCooperativeKernel((const void*)hybrid_fwd, dim3(grid_blocks), dim3(NTHREADS), args, LDS_BYTES, stream);
    if (e != hipSuccess) fprintf(stderr, "cooperative launch failed: %s (grid %d)\n", hipGetErrorString(e), grid_blocks);
}
```

```cpp
#include <hip/hip_runtime.h>
#include <hip/hip_cooperative_groups.h>
#include <cstdio>
namespace cg = cooperative_groups;

#define LAS __attribute__((address_space(3)))
typedef unsigned short bf16_t;
typedef short bf16x8 __attribute__((ext_vector_type(8)));
typedef float f32x4 __attribute__((ext_vector_type(4)));
typedef unsigned u32x4 __attribute__((ext_vector_type(4)));
typedef unsigned u32x2 __attribute__((ext_vector_type(2)));

constexpr int L_TOK = 16400, LP = 16640, DM = 2048, NIN = 16384, NMETA = 16, NMAIN = 16384;
constexpr int FN1 = 164, FN2 = 100, FN1P = 192, PROWS = FN2 * FN1P;
constexpr int NTHREADS = 512, LDS_PHASE_BYTES = 155648, LDS_BYTES = LDS_PHASE_BYTES + 16;

constexpr size_t SZ_H = (size_t)LP * DM * 4, SZ_XN = (size_t)LP * DM * 2, SZ_XNP = (size_t)PROWS * DM * 2;
constexpr size_t OFF_H = 0;
constexpr size_t OFF_XN = OFF_H + SZ_H;
constexpr size_t OFF_XNP = OFF_XN + SZ_XN;
constexpr size_t OFF_A1 = OFF_XN;
constexpr size_t SZ_A1 = (size_t)FN1 * 1024 * 2 * 128 * 2;
constexpr size_t OFF_HYOUT = OFF_A1 + SZ_A1;
constexpr size_t SZ_HYOUT = (size_t)1024 * LP * 2;
static_assert(OFF_HYOUT + SZ_HYOUT <= OFF_XNP + SZ_XNP, "alias overflow");
constexpr size_t OFF_WT = OFF_XNP + SZ_XNP;
constexpr size_t OFF_WEFF = OFF_WT + (size_t)NIN * DM * 2;
constexpr size_t OFF_WA = OFF_WEFF + (size_t)2048 * 2048 * 2;
constexpr size_t SZ_WBR = (size_t)2048 * 1024 * 2;
constexpr size_t OFF_WO = OFF_WA + 3 * SZ_WBR;
constexpr size_t OFF_HYIN = OFF_WO + (size_t)2048 * 2048 * 2;
constexpr size_t OFF_GATE = OFF_HYIN + (size_t)3072 * LP * 2;
constexpr size_t SZ_GATE = (size_t)LP * 1024 * 2;
constexpr size_t OFF_QKV = OFF_GATE + 3 * SZ_GATE;
constexpr size_t OFF_MERGE = OFF_QKV + (size_t)LP * 3072 * 2;
constexpr size_t OFF_ZT = OFF_MERGE + (size_t)LP * 6144 * 2;
constexpr size_t SZ_ZT = (size_t)2048 * PROWS * 2;
constexpr size_t OFF_M = OFF_ZT;
static_assert(SZ_XN <= SZ_ZT, "alias overflow");
constexpr size_t OFF_FA = OFF_ZT + SZ_ZT;
constexpr size_t OFF_FB = OFF_FA + (size_t)512 * 384 * 2;
constexpr size_t OFF_H3 = OFF_FB + (size_t)FN1 * 256 * 256 * 2;
constexpr size_t WS_END = OFF_H3 + (size_t)2 * L_TOK * 64 * 4;
constexpr size_t HS_HEO = 0, HS_Z2 = 131328, HS_G2 = HS_Z2 + 65792, HSW_STRIDE = HS_G2 + 65792;
constexpr size_t FILT_BYTES = (size_t)L_TOK * 2, HSD_STRIDE = 393728;
constexpr size_t OFF_BAR = WS_END + 256 * HSW_STRIDE;
constexpr size_t WS_END2 = OFF_BAR + 16384;
static_assert(HSD_STRIDE >= 12 * FILT_BYTES && HSD_STRIDE * 256 <= (size_t)NMAIN * DM * 4, "scratch overflow");

struct Params {
    const float* x; const float* meta; const float* norm_g; const float* w_in; const float* conv_w; const float* conv_b;
    const float* f_w1; const float* f_b1; const float* f_w2; const float* f_b2; const float* f_w3; const float* f_b3; const float* f_w4;
    const float* f_freq; const float* decay; const float* skip; const float* rpb; const float* meta_bias;
    const float* w_a; const float* w_b; const float* w_c; const float* w_out; const float* final_g;
    float* out; unsigned char* ws;
};

__device__ __forceinline__ int opaque_tid() { int t = threadIdx.x; asm volatile("" : "+v"(t)); return t; }
__device__ __forceinline__ float bf2f(bf16_t b) { return __uint_as_float(((unsigned)b) << 16); }
__device__ __forceinline__ bf16_t f2bf(float f) { unsigned u = __float_as_uint(f); u += 0x7FFFu + ((u >> 16) & 1u); return (bf16_t)(u >> 16); }
__device__ __forceinline__ unsigned cvt_pk_bf16(float lo, float hi) { unsigned r; asm volatile("v_cvt_pk_bf16_f32 %0, %1, %2" : "=v"(r) : "v"(lo), "v"(hi)); return r; }
__device__ __forceinline__ float lo_bf(unsigned u) { return __uint_as_float(u << 16); }
__device__ __forceinline__ float hi_bf(unsigned u) { return __uint_as_float(u & 0xffff0000u); }
__device__ __forceinline__ float silu_f(float v) { return v * __builtin_amdgcn_rcpf(1.0f + __expf(-v)); }
__device__ __forceinline__ float sigm_f(float v) { return __builtin_amdgcn_rcpf(1.0f + __expf(-v)); }
__device__ __forceinline__ float wave_sum(float v) {
#pragma unroll
    for (int o = 32; o >= 1; o >>= 1) v += __shfl_xor(v, o);
    return v;
}

namespace pg8 {
constexpr int BM = 256, BK = 64, HALF = 128, HTB = HALF * BK * 2, STAGE_BYTES = 8 * HTB;
__device__ __forceinline__ int lds_byte(int r, int c) { const int st = (r >> 4) * 2 + (c >> 5), rr = r & 15, cc = c & 31, ob = rr * 64 + cc * 2; return st * 1024 + (ob ^ (((ob >> 9) & 1) << 5)); }
__device__ __forceinline__ void stage_rc(int b, int& R, int& C) { const int st = b / 1024, sb = b % 1024, swz = sb ^ (((sb >> 9) & 1) << 5); R = (st >> 1) * 16 + swz / 64; C = (st & 1) * 32 + (swz % 64) / 2; }
__device__ __forceinline__ int perm32(int rho) { const int n = rho >> 4, i = rho & 15; return 8 * (i >> 2) + 4 * n + (i & 3); }

struct Unit { int pm, pn, aux; size_t offA, offB; };
struct Gemm { const char* base; int lda, ldb, nt, ksplit; long jumpA, jumpB; };

__device__ __forceinline__ void tile_map(int wgid, int nM, int nN, int& pm, int& pn) {
    const int nwg = nM * nN;
    { const int q = nwg / 8, r = nwg % 8, xcd = wgid % 8, off = wgid / 8; wgid = (xcd < r ? xcd * (q + 1) : r * (q + 1) + (xcd - r) * q) + off; }
    const int nig = 8 * nN, gid = wgid / nig, fm = gid * 8, gsz = (nM - fm) < 8 ? (nM - fm) : 8;
    pm = fm + ((wgid % nig) % gsz); pn = (wgid % nig) / gsz;
}

template <class Epi, class Sched>
__device__ __forceinline__ void gemm_phase(LAS unsigned char* lds, const Gemm g, const Sched& S, const Epi& E) {
    const int tid = opaque_tid(), wid = __builtin_amdgcn_readfirstlane(tid >> 6), lane = tid & 63, wr = wid >> 2, wc = wid & 3, fr = lane & 15, fq = lane >> 4;
    const int nt = g.nt;
    unsigned voffA[2], voffB[2];
#pragma unroll
    for (int i = 0; i < 2; ++i) { int R, C; stage_rc(tid * 16 + i * 8192, R, C); const int Rb = (R & ~31) + perm32(R & 31);
        voffA[i] = (unsigned)(R * g.lda + C) * 2u; voffB[i] = (unsigned)(Rb * g.ldb + C) * 2u; }
    const size_t kstep = (size_t)(BK * 2);
    const size_t hstepA = (size_t)HALF * g.lda * 2, hstepB = (size_t)HALF * g.ldb * 2;
    const unsigned ldsw = (unsigned)wid * 1024u;
    const int aoff = lds_byte(wr * 64 + fr, fq * 8), boff = lds_byte(wc * 32 + fr, fq * 8);
#define PG8_KA(p, t) ((p) + (size_t)(t) * kstep + ((t) >= g.ksplit ? g.jumpA : 0l))
#define PG8_KB(p, t) ((p) + (size_t)(t) * kstep + ((t) >= g.ksplit ? g.jumpB : 0l))
#define PG8_SA(b, h) (((b) * 2 + (h)) * HTB)
#define PG8_SB(b, h) ((4 + (b) * 2 + (h)) * HTB)
#define PG8_STAGE(bufoff, gbase, voff) do { _Pragma("unroll") for (int _i = 0; _i < 2; ++_i) \
        __builtin_amdgcn_global_load_lds((const unsigned*)((const char*)(gbase) + (voff)[_i]), (LAS unsigned*)(lds + (bufoff) + ldsw + _i * 8192), 16, 0, 0); } while (0)
#define PG8_LDA(dst, b, h) do { _Pragma("unroll") for (int m = 0; m < 4; ++m) _Pragma("unroll") for (int k = 0; k < 2; ++k) dst[m][k] = *(const LAS bf16x8*)(lds + PG8_SA(b, h) + aoff + m * 2048 + k * 1024); } while (0)
#define PG8_LDB(dst, b, h) do { _Pragma("unroll") for (int n = 0; n < 2; ++n) _Pragma("unroll") for (int k = 0; k < 2; ++k) dst[n][k] = *(const LAS bf16x8*)(lds + PG8_SB(b, h) + boff + n * 2048 + k * 1024); } while (0)
#define PG8_MMA(ai, bj, At, Bt) do { __builtin_amdgcn_s_setprio(1); _Pragma("unroll") for (int m = 0; m < 4; ++m) _Pragma("unroll") for (int n = 0; n < 2; ++n) _Pragma("unroll") for (int k = 0; k < 2; ++k) \
        acc[ai][bj][m][n] = __builtin_amdgcn_mfma_f32_16x16x32_bf16(Bt[n][k], At[m][k], acc[ai][bj][m][n], 0, 0, 0); __builtin_amdgcn_s_setprio(0); } while (0)
#define PG8_WAIT_V(n) asm volatile("s_waitcnt vmcnt(" #n ")" ::: "memory")
#define PG8_WAIT_L(n) asm volatile("s_waitcnt lgkmcnt(" #n ")" ::: "memory")
#define PG8_BAR __builtin_amdgcn_s_barrier()
#define PG8_SCHED __builtin_amdgcn_sched_barrier(0)
    Unit cur, nxt; int ui = 0;
    if (!S.next(0, cur)) return;
    f32x4 acc[2][2][4][2];
#pragma unroll
    for (int a = 0; a < 2; ++a)
#pragma unroll
        for (int b = 0; b < 2; ++b)
#pragma unroll
            for (int m = 0; m < 4; ++m)
#pragma unroll
                for (int n = 0; n < 2; ++n) acc[a][b][m][n] = (f32x4){0.f, 0.f, 0.f, 0.f};
    bf16x8 At[4][2], B0[2][2], B1[2][2];
    const char* cA = g.base + cur.offA; const char* cB = g.base + cur.offB;
    PG8_STAGE(PG8_SB(0, 0), cB, voffB); PG8_STAGE(PG8_SA(0, 0), cA, voffA); PG8_STAGE(PG8_SB(0, 1), cB + hstepB, voffB); PG8_STAGE(PG8_SA(0, 1), cA + hstepA, voffA);
    if (wr == 1) PG8_BAR;
    PG8_WAIT_V(4); PG8_BAR;
    PG8_STAGE(PG8_SB(1, 0), PG8_KB(cB, 1), voffB); PG8_STAGE(PG8_SA(1, 0), PG8_KA(cA, 1), voffA); PG8_STAGE(PG8_SB(1, 1), PG8_KB(cB, 1) + hstepB, voffB);
    PG8_WAIT_V(6); PG8_BAR;
    for (;;) {
        const bool has_next = S.next(ui + 1, nxt);
        const char* nA = has_next ? g.base + nxt.offA : cA; const char* nB = has_next ? g.base + nxt.offB : cB;
        for (int t = 0; t < nt; t += 2) {
            const bool last = (t == nt - 2);
            const char* a1 = PG8_KA(cA, t + 1);
            const char* a2 = last ? nA : PG8_KA(cA, t + 2); const char* b2 = last ? nB : PG8_KB(cB, t + 2);
            const char* a3 = last ? PG8_KA(nA, 1) : PG8_KA(cA, t + 3); const char* b3 = last ? PG8_KB(nB, 1) : PG8_KB(cB, t + 3);
            PG8_LDB(B0, 0, 0); PG8_SCHED; PG8_LDA(At, 0, 0); PG8_STAGE(PG8_SA(1, 1), a1 + hstepA, voffA);
            PG8_WAIT_L(8); PG8_BAR; PG8_WAIT_L(0); PG8_MMA(0, 0, At, B0); PG8_BAR; PG8_SCHED;
            PG8_LDB(B1, 0, 1); PG8_STAGE(PG8_SB(0, 0), b2, voffB);
            PG8_BAR; PG8_WAIT_L(0); PG8_MMA(0, 1, At, B1); PG8_BAR;
            PG8_LDA(At, 0, 1); PG8_STAGE(PG8_SA(0, 0), a2, voffA);
            PG8_BAR; PG8_WAIT_L(0); PG8_MMA(1, 0, At, B0); PG8_BAR; PG8_SCHED;
            PG8_STAGE(PG8_SB(0, 1), b2 + hstepB, voffB);
            PG8_WAIT_V(6); PG8_BAR; PG8_MMA(1, 1, At, B1); PG8_BAR;
            PG8_LDB(B0, 1, 0); PG8_SCHED; PG8_LDA(At, 1, 0); PG8_STAGE(PG8_SA(0, 1), a2 + hstepA, voffA);
            PG8_WAIT_L(8); PG8_BAR; PG8_WAIT_L(0); PG8_MMA(0, 0, At, B0); PG8_BAR; PG8_SCHED;
            PG8_LDB(B1, 1, 1); PG8_STAGE(PG8_SB(1, 0), b3, voffB);
            PG8_BAR; PG8_WAIT_L(0); PG8_MMA(0, 1, At, B1); PG8_BAR;
            PG8_LDA(At, 1, 1); PG8_STAGE(PG8_SA(1, 0), a3, voffA);
            PG8_BAR; PG8_WAIT_L(0); PG8_MMA(1, 0, At, B0); PG8_BAR; PG8_SCHED;
            PG8_STAGE(PG8_SB(1, 1), b3 + hstepB, voffB);
            PG8_WAIT_V(6); PG8_BAR; PG8_MMA(1, 1, At, B1); PG8_BAR;
        }
        E(acc, cur, wr, wc, fr, fq);
        if (!has_next) break;
        { const float zf = E.keep(cur) ? 1.0f : 0.0f;
#pragma unroll
        for (int a = 0; a < 2; ++a)
#pragma unroll
            for (int b = 0; b < 2; ++b)
#pragma unroll
                for (int m = 0; m < 4; ++m)
#pragma unroll
                    for (int n = 0; n < 2; ++n) acc[a][b][m][n] *= zf; }
        cur = nxt; cA = nA; cB = nB; ++ui;
    }
    PG8_WAIT_V(0);
    if (wr == 0) PG8_BAR;
    PG8_BAR;
#undef PG8_KA
#undef PG8_KB
#undef PG8_SA
#undef PG8_SB
#undef PG8_STAGE
#undef PG8_LDA
#undef PG8_LDB
#undef PG8_MMA
#undef PG8_WAIT_V
#undef PG8_WAIT_L
#undef PG8_BAR
#undef PG8_SCHED
}
}
using pg8::Unit; using pg8::Gemm;
#define ACC_T f32x4 (&acc)[2][2][4][2]

enum { K_TOK = 0, K_HYIN = 1, K_F0 = 2, K_FNA = 3, K_FNB = 4, K_BR = 5, K_OUT = 6, K_IN = 7 };
struct SchedAny {
    int kind, G, c;
    __device__ __forceinline__ bool next(int i, Unit& u) const {
        const long Lx = (long)i * G + c;
        switch (kind) {
        case K_IN: {
            if (Lx < 3120) { int pn; pg8::tile_map((int)Lx, 65, 48, u.pm, pn); u.pn = pn < 4 ? 12 + pn : 16 + pn; u.aux = K_TOK;
                u.offA = OFF_XN + (size_t)u.pm * 256 * DM * 2; u.offB = OFF_WT + (size_t)u.pn * 256 * DM * 2; return true; }
            if (Lx < 3900) { pg8::tile_map((int)Lx - 3120, 12, 65, u.pm, u.pn); u.aux = K_HYIN;
                u.offA = OFF_WT + (size_t)u.pm * 256 * DM * 2; u.offB = OFF_XN + (size_t)u.pn * 256 * DM * 2; return true; }
            if (Lx < 4200) { pg8::tile_map((int)Lx - 3900, 4, 75, u.pm, u.pn); u.aux = K_F0;
                u.offA = OFF_WEFF + (size_t)u.pm * 256 * DM * 2; u.offB = OFF_XNP + (size_t)u.pn * 256 * DM * 2; return true; }
            return false; }
        case K_TOK: {
            if (Lx >= 65l * 48) return false; int pn; pg8::tile_map((int)Lx, 65, 48, u.pm, pn); u.pn = pn < 4 ? 12 + pn : 16 + pn; u.aux = 0;
            u.offA = OFF_XN + (size_t)u.pm * 256 * DM * 2; u.offB = OFF_WT + (size_t)u.pn * 256 * DM * 2; return true; }
        case K_HYIN: {
            if (Lx >= 12l * 65) return false; pg8::tile_map((int)Lx, 12, 65, u.pm, u.pn); u.aux = 0;
            u.offA = OFF_WT + (size_t)u.pm * 256 * DM * 2; u.offB = OFF_XN + (size_t)u.pn * 256 * DM * 2; return true; }
        case K_F0: {
            if (Lx >= 8l * 75) return false; pg8::tile_map((int)Lx, 8, 75, u.pm, u.pn); u.aux = 0;
            u.offA = OFF_WEFF + (size_t)u.pm * 256 * DM * 2; u.offB = OFF_XNP + (size_t)u.pn * 256 * DM * 2; return true; }
        case K_FNA: {
            if (Lx >= 2l * 400) return false; pg8::tile_map((int)Lx, 2, 400, u.pm, u.pn); u.aux = 0;
            u.offA = OFF_FA + (size_t)u.pm * 256 * 384 * 2; u.offB = OFF_ZT + (size_t)u.pn * 256 * FN1P * 2; return true; }
        case K_FNB: {
            if (Lx >= 164l * 4) return false; u.aux = (int)(Lx >> 2); u.pm = 0; u.pn = (int)(Lx & 3);
            u.offA = OFF_FB + (size_t)u.aux * 256 * 256 * 2; u.offB = OFF_A1 + (size_t)u.aux * 1024 * 256 * 2 + (size_t)u.pn * 256 * 256 * 2; return true; }
        case K_BR: {
            const int T = (i / 3) * G + c; if (T >= 64 * 8) return false; const int br = i % 3; pg8::tile_map(T, 64, 8, u.pm, u.pn); u.aux = br;
            u.offA = OFF_GATE + (size_t)br * SZ_GATE + (size_t)u.pm * 256 * 1024 * 2; u.offB = OFF_WA + (size_t)br * SZ_WBR + (size_t)u.pn * 256 * 1024 * 2; return true; }
        default: {
            if (Lx >= 64l * 8) return false; pg8::tile_map((int)Lx, 64, 8, u.pm, u.pn); u.aux = 0;
            u.offA = OFF_M + (size_t)u.pm * 256 * DM * 2; u.offB = OFF_WO + (size_t)u.pn * 256 * DM * 2; return true; }
        }
    }
};
#define ROWFENCE asm volatile("" ::: "memory")
#define HARDFENCE do { asm volatile("" ::: "memory"); __builtin_amdgcn_sched_barrier(0); } while (0)
struct EpiAny {
    int kind; unsigned char* ws; int layer; const float* xin; const float* metain;
    __device__ __forceinline__ bool keep(const Unit&) const { return false; }
    __device__ __forceinline__ void operator()(ACC_T, const Unit& u, int wr, int wc, int fr, int fq) const {
        const int rl0 = wr * 64 + fr, cl0 = wc * 32 + 8 * fq;
        const int ek = kind == K_IN ? u.aux : kind;
        if (ek == K_TOK) {
            const int t = u.pn; unsigned char* dst; unsigned ld; int c0, act;
            if (t < 16)      { dst = ws + OFF_GATE;               ld = 1024; c0 = (t - 12) * 256; act = 1; }
            else if (t < 24) { dst = ws + OFF_GATE + SZ_GATE;     ld = 1024; c0 = (t - 20) * 256; act = 1; }
            else if (t < 36) { dst = ws + OFF_QKV;                ld = 3072; c0 = (t - 24) * 256; act = 0; }
            else if (t < 40) { dst = ws + OFF_GATE + 2 * SZ_GATE; ld = 1024; c0 = (t - 36) * 256; act = 1; }
            else             { dst = ws + OFF_MERGE;              ld = 6144; c0 = (t - 40) * 256; act = 2; }
#pragma unroll
            for (int ai = 0; ai < 2; ++ai)
#pragma unroll
                for (int m = 0; m < 4; ++m) { const unsigned row = (unsigned)(u.pm * 256 + ai * 128 + m * 16 + rl0);
#pragma unroll
                    for (int bj = 0; bj < 2; ++bj) { const unsigned off = (row * ld + (unsigned)(c0 + bj * 128 + cl0)) * 2u; f32x4 v0 = acc[ai][bj][m][0], v1 = acc[ai][bj][m][1];
                        if (act == 1) {
#pragma unroll
                            for (int j = 0; j < 4; ++j) { v0[j] = silu_f(v0[j]); v1[j] = silu_f(v1[j]); } }
                        else if (act == 2) {
#pragma unroll
                            for (int j = 0; j < 4; ++j) { v0[j] = sigm_f(v0[j]); v1[j] = sigm_f(v1[j]); } }
                        u32x4 w; w.x = cvt_pk_bf16(v0[0], v0[1]); w.y = cvt_pk_bf16(v0[2], v0[3]); w.z = cvt_pk_bf16(v1[0], v1[1]); w.w = cvt_pk_bf16(v1[2], v1[3]);
                        *(u32x4*)(dst + off) = w; }
                    ROWFENCE; }
        } else if (ek == K_HYIN) {
            unsigned char* dst = ws + OFF_HYIN; const unsigned ld = LP;
#pragma unroll
            for (int ai = 0; ai < 2; ++ai)
#pragma unroll
                for (int m = 0; m < 4; ++m) { const unsigned row = (unsigned)(u.pm * 256 + ai * 128 + m * 16 + rl0);
#pragma unroll
                    for (int bj = 0; bj < 2; ++bj) { const unsigned off = (row * ld + (unsigned)(u.pn * 256 + bj * 128 + cl0)) * 2u; const f32x4 v0 = acc[ai][bj][m][0], v1 = acc[ai][bj][m][1];
                        u32x4 w; w.x = cvt_pk_bf16(v0[0], v0[1]); w.y = cvt_pk_bf16(v0[2], v0[3]); w.z = cvt_pk_bf16(v1[0], v1[1]); w.w = cvt_pk_bf16(v1[2], v1[3]);
                        *(u32x4*)(dst + off) = w; }
                    ROWFENCE; }
        } else if (ek == K_F0) {
            int rlx = rl0, clx = cl0; asm volatile("" : "+v"(rlx), "+v"(clx));
            unsigned char* dst = ws + OFF_ZT; const int g = u.pm; const unsigned colb0 = (unsigned)(u.pn * 256 + clx) * 2u;
#pragma unroll
            for (int ai = 0; ai < 2; ++ai)
#pragma unroll
                for (int m = 0; m < 4; ++m) { const int j = ai * 128 + m * 16 + rlx; const int part = j <= 128 ? 0 : 1; const int cp = j - 128 * part;
                    const unsigned o1 = (unsigned)(part * 1024 + g * 256 + cp) * (unsigned)(PROWS * 2) + colb0;
                    const bool mir = cp >= 1 && cp <= 127; const bool zim = part == 0 && !mir;
                    const unsigned o2 = (unsigned)((mir ? part : 1) * 1024 + g * 256 + (mir ? 256 - cp : cp)) * (unsigned)(PROWS * 2) + colb0;
                    const unsigned sgn = part == 1 ? 0x80008000u : 0u, msk = zim ? 0u : 0xffffffffu;
#pragma unroll
                    for (int bj = 0; bj < 2; ++bj) { const f32x4 v0 = acc[ai][bj][m][0], v1 = acc[ai][bj][m][1];
                        u32x4 w; w.x = cvt_pk_bf16(v0[0], v0[1]); w.y = cvt_pk_bf16(v0[2], v0[3]); w.z = cvt_pk_bf16(v1[0], v1[1]); w.w = cvt_pk_bf16(v1[2], v1[3]);
                        *(u32x4*)(dst + o1 + bj * 256) = w;
                        u32x4 wm; wm.x = (w.x ^ sgn) & msk; wm.y = (w.y ^ sgn) & msk; wm.z = (w.z ^ sgn) & msk; wm.w = (w.w ^ sgn) & msk;
                        *(u32x4*)(dst + o2 + bj * 256) = wm; }
                    ROWFENCE; }
        } else if (ek == K_FNA) {
            unsigned char* dst = ws + OFF_A1;
#pragma unroll
            for (int ai = 0; ai < 2; ++ai)
#pragma unroll
                for (int m = 0; m < 4; ++m) { const int k1 = ai * 128 + m * 16 + rl0;
                    if (k1 < FN1) {
#pragma unroll
                        for (int bj = 0; bj < 2; ++bj)
#pragma unroll
                            for (int n = 0; n < 2; ++n) { const int col = u.pn * 256 + bj * 128 + cl0 + 4 * n; const int ch = col / FN2, l2 = col - ch * FN2; const f32x4 v = acc[ai][bj][m][n];
                                u32x2 w; w.x = cvt_pk_bf16(v[0], v[1]); w.y = cvt_pk_bf16(v[2], v[3]);
                                *(u32x2*)(dst + ((unsigned)((k1 * 1024 + ch) * 2 + u.pm) * 128u + (unsigned)l2) * 2u) = w; } }
                    ROWFENCE; }
        } else if (ek == K_FNB) {
            unsigned char* dst = ws + OFF_GATE + SZ_GATE; const float scale = 1.0f / sqrtf((float)L_TOK * 256.0f);
#pragma unroll
            for (int ai = 0; ai < 2; ++ai)
#pragma unroll
                for (int m = 0; m < 4; ++m) { const int k2 = ai * 128 + m * 16 + rl0;
                    if (k2 < FN2) { const unsigned row = (unsigned)(u.aux + FN1 * k2);
#pragma unroll
                        for (int bj = 0; bj < 2; ++bj) { const unsigned off = (row * 1024u + (unsigned)(u.pn * 256 + bj * 128 + cl0)) * 2u; const u32x4 g = *(const u32x4*)(dst + off);
                            const f32x4 v0 = acc[ai][bj][m][0] * scale, v1 = acc[ai][bj][m][1] * scale;
                            u32x4 w; w.x = cvt_pk_bf16(v0[0] * lo_bf(g.x), v0[1] * hi_bf(g.x)); w.y = cvt_pk_bf16(v0[2] * lo_bf(g.y), v0[3] * hi_bf(g.y));
                            w.z = cvt_pk_bf16(v1[0] * lo_bf(g.z), v1[1] * hi_bf(g.z)); w.w = cvt_pk_bf16(v1[2] * lo_bf(g.w), v1[3] * hi_bf(g.w));
                            *(u32x4*)(dst + off) = w; } }
                    ROWFENCE; }
        } else {
            unsigned char* dst = ws + OFF_H;
#pragma unroll
            for (int ai = 0; ai < 2; ++ai) { f32x4 oq[4][2][2];
#pragma unroll
                for (int m = 0; m < 4; ++m) { const unsigned row = (unsigned)(u.pm * 256 + ai * 128 + m * 16 + rl0);
                    const float* srow = layer == 0 ? (row < (unsigned)NMETA ? metain + (size_t)row * DM : xin + (size_t)(row - NMETA) * DM) : (const float*)(dst + (size_t)row * DM * 4);
#pragma unroll
                    for (int bj = 0; bj < 2; ++bj) { const unsigned col = (unsigned)(u.pn * 256 + bj * 128 + cl0); oq[m][bj][0] = *(const f32x4*)(srow + col); oq[m][bj][1] = *(const f32x4*)(srow + col + 4); } }
#pragma unroll
                for (int m = 0; m < 4; ++m) { const unsigned row = (unsigned)(u.pm * 256 + ai * 128 + m * 16 + rl0);
#pragma unroll
                    for (int bj = 0; bj < 2; ++bj) { const unsigned off = (row * (unsigned)DM + (unsigned)(u.pn * 256 + bj * 128 + cl0)) * 4u;
                        *(f32x4*)(dst + off) = oq[m][bj][0] + acc[ai][bj][m][0]; *(f32x4*)(dst + off + 16) = oq[m][bj][1] + acc[ai][bj][m][1]; } }
                ROWFENCE; }
        }
    }
};

struct EpiBr {
    unsigned char* ws;
    __device__ __forceinline__ bool keep(const Unit& u) const { return u.aux < 2; }
    __device__ __forceinline__ void operator()(ACC_T, const Unit& u, int wr, int wc, int fr, int fq) const {
        const int rl0 = wr * 64 + fr, cl0 = wc * 32 + 8 * fq;
            unsigned char* dst = ws + OFF_M; const unsigned char* mg = ws + OFF_MERGE; const int br = u.aux;
#pragma unroll
            for (int ai = 0; ai < 2; ++ai)
#pragma unroll
              for (int mh = 0; mh < 4; mh += 2) { u32x4 gn[2][2], gd[2][2];
#pragma unroll
                for (int mm = 0; mm < 2; ++mm) { const unsigned row = (unsigned)(u.pm * 256 + ai * 128 + (mh + mm) * 16 + rl0);
#pragma unroll
                    for (int bj = 0; bj < 2; ++bj) { const unsigned col = (unsigned)(u.pn * 256 + bj * 128 + cl0);
                        gn[mm][bj] = *(const u32x4*)(mg + (row * 6144u + (unsigned)br * 2048u + col) * 2u);
                        if (br < 2) gd[mm][bj] = *(const u32x4*)(mg + (row * 6144u + (unsigned)(br + 1) * 2048u + col) * 2u); else gd[mm][bj] = (u32x4){0x3f803f80u, 0x3f803f80u, 0x3f803f80u, 0x3f803f80u}; } }
#pragma unroll
                for (int mm = 0; mm < 2; ++mm) { const int m = mh + mm; const unsigned row = (unsigned)(u.pm * 256 + ai * 128 + m * 16 + rl0);
#pragma unroll
                    for (int bj = 0; bj < 2; ++bj) { const u32x4 g = gn[mm][bj], d = gd[mm][bj];
                        const float s0 = lo_bf(g.x) * __builtin_amdgcn_rcpf(fmaxf(lo_bf(d.x), 1e-30f)), s1 = hi_bf(g.x) * __builtin_amdgcn_rcpf(fmaxf(hi_bf(d.x), 1e-30f));
                        const float s2 = lo_bf(g.y) * __builtin_amdgcn_rcpf(fmaxf(lo_bf(d.y), 1e-30f)), s3 = hi_bf(g.y) * __builtin_amdgcn_rcpf(fmaxf(hi_bf(d.y), 1e-30f));
                        const float s4 = lo_bf(g.z) * __builtin_amdgcn_rcpf(fmaxf(lo_bf(d.z), 1e-30f)), s5 = hi_bf(g.z) * __builtin_amdgcn_rcpf(fmaxf(hi_bf(d.z), 1e-30f));
                        const float s6 = lo_bf(g.w) * __builtin_amdgcn_rcpf(fmaxf(lo_bf(d.w), 1e-30f)), s7 = hi_bf(g.w) * __builtin_amdgcn_rcpf(fmaxf(hi_bf(d.w), 1e-30f));
                        f32x4 v0 = acc[ai][bj][m][0], v1 = acc[ai][bj][m][1];
                        v0[0] *= s0; v0[1] *= s1; v0[2] *= s2; v0[3] *= s3; v1[0] *= s4; v1[1] *= s5; v1[2] *= s6; v1[3] *= s7;
                        acc[ai][bj][m][0] = v0; acc[ai][bj][m][1] = v1;
                        if (br == 2) { const unsigned col = (unsigned)(u.pn * 256 + bj * 128 + cl0);
                            u32x4 w; w.x = cvt_pk_bf16(v0[0], v0[1]); w.y = cvt_pk_bf16(v0[2], v0[3]); w.z = cvt_pk_bf16(v1[0], v1[1]); w.w = cvt_pk_bf16(v1[2], v1[3]);
                            *(u32x4*)(dst + (row * (unsigned)DM + col) * 2u) = w; } } }
                ROWFENCE; }
    }
};

__device__ void phase_prep0(const Params& p, unsigned char* smem) {
    const int tid = opaque_tid(), bid = blockIdx.x, G = gridDim.x;
    const size_t gtid = (size_t)bid * NTHREADS + tid, gstride = (size_t)G * NTHREADS;
    { bf16_t* fa = (bf16_t*)(p.ws + OFF_FA);
      for (size_t i = gtid; i < (size_t)512 * 384; i += gstride) { const int row = (int)(i / 384), col = (int)(i % 384); const int po = row >> 8, k1 = row & 255, pi = col / 192, l1 = col % 192; float v = 0.f;
          if (k1 < FN1 && l1 < FN1) { const int r = (k1 * l1) % FN1; const float a = (float)r / (float)FN1; const float cs = __builtin_amdgcn_cosf(a), sn = __builtin_amdgcn_sinf(a);
              v = (po == 0) ? (pi == 0 ? cs : sn) : (pi == 0 ? -sn : cs); }
          fa[i] = f2bf(v); } }
    { bf16_t* fb = (bf16_t*)(p.ws + OFF_FB);
      for (size_t i = gtid; i < (size_t)FN1 * 65536; i += gstride) { const int k1 = (int)(i >> 16), k2 = (int)((i >> 8) & 255), kk = (int)(i & 255), part = kk >> 7, l2 = kk & 127; float v = 0.f;
          if (k2 < FN2 && l2 < FN2) { const int lp = k1 + FN1 * k2; const int r = (l2 * lp) % L_TOK; const float a = (float)r / (float)L_TOK; v = part == 0 ? __builtin_amdgcn_cosf(a) : __builtin_amdgcn_sinf(a); }
          fb[i] = f2bf(v); } }
    { float* w1s = (float*)smem;
      float* w2s = w1s + 33 * 64;
      float* w3s = w2s + 64 * 64;
      const int lane = tid & 63, wv = tid >> 6;
      for (int layer = 0; layer < 2; ++layer) {
          __syncthreads();
          for (int i = tid; i < 33 * 64; i += NTHREADS) w1s[i] = p.f_w1[layer * 33 * 64 + i];
          for (int i = tid; i < 64 * 64; i += NTHREADS) { w2s[i] = p.f_w2[layer * 4096 + i]; w3s[i] = p.f_w3[layer * 4096 + i]; }
          __syncthreads();
          const float b1 = p.f_b1[layer * 64 + lane], b2 = p.f_b2[layer * 64 + lane], b3 = p.f_b3[layer * 64 + lane], fr = p.f_freq[layer * 64 + lane];
          bf16_t* h3 = (bf16_t*)(p.ws + OFF_H3) + (size_t)layer * L_TOK * 64;
          constexpr float INV2PI = 0.15915494309189535f;
          for (int lag0 = bid * 8 + wv; lag0 < L_TOK; lag0 += G * 16) {
              const int lagA = lag0, lagB = lag0 + G * 8; const bool hasB = lagB < L_TOK; const int lagBc = hasB ? lagB : lagA;
              float zA = 0.f, zB = 0.f;
              if (lane == 0) { zA = (float)lagA / (float)(L_TOK - 1); zB = (float)lagBc / (float)(L_TOK - 1); }
              else if (lane < 33) { const int j = (lane - 1) & 15; const float f = 1e-4f + (float)j * ((15.0f - 1e-4f) / 15.0f);
                  const float rA = f * ((float)lagA / (float)L_TOK), rB = f * ((float)lagBc / (float)L_TOK);
                  zA = lane < 17 ? __builtin_amdgcn_cosf(rA) : -__builtin_amdgcn_sinf(rA); zB = lane < 17 ? __builtin_amdgcn_cosf(rB) : -__builtin_amdgcn_sinf(rB); }
              float aA = b1, aB = b1;
#pragma unroll 3
              for (int i = 0; i < 33; ++i) { const float wgt = w1s[i * 64 + lane]; aA += __int_as_float(__builtin_amdgcn_readlane(__float_as_int(zA), i)) * wgt; aB += __int_as_float(__builtin_amdgcn_readlane(__float_as_int(zB), i)) * wgt; }
              const float h1A = __builtin_amdgcn_sinf(fr * aA * INV2PI), h1B = __builtin_amdgcn_sinf(fr * aB * INV2PI);
              aA = b2; aB = b2;
#pragma unroll 8
              for (int i = 0; i < 64; ++i) { const float wgt = w2s[i * 64 + lane]; aA += __int_as_float(__builtin_amdgcn_readlane(__float_as_int(h1A), i)) * wgt; aB += __int_as_float(__builtin_amdgcn_readlane(__float_as_int(h1B), i)) * wgt; }
              const float h2A = __builtin_amdgcn_sinf(fr * aA * INV2PI), h2B = __builtin_amdgcn_sinf(fr * aB * INV2PI);
              aA = b3; aB = b3;
#pragma unroll 8
              for (int i = 0; i < 64; ++i) { const float wgt = w3s[i * 64 + lane]; aA += __int_as_float(__builtin_amdgcn_readlane(__float_as_int(h2A), i)) * wgt; aB += __int_as_float(__builtin_amdgcn_readlane(__float_as_int(h2B), i)) * wgt; }
              h3[(size_t)lagA * 64 + lane] = f2bf(__builtin_amdgcn_sinf(fr * aA * INV2PI));
              if (hasB) h3[(size_t)lagB * 64 + lane] = f2bf(__builtin_amdgcn_sinf(fr * aB * INV2PI));
          }
      }
      __syncthreads(); }
}

__device__ void convert_matrix(const float* __restrict__ src, int K, int N, bf16_t* __restrict__ dst, int kshift  , int total, float* tile  ) {
    const int tid = opaque_tid(), G = gridDim.x; const int kl0 = tid >> 4, n4 = (tid & 15) * 4, nl = tid >> 3, k8 = (tid & 7) * 8;
    f32x4 pv0 = (f32x4){0.f, 0.f, 0.f, 0.f}, pv1 = pv0;
    int t = blockIdx.x;
    if (t < total) { const int kt = t & ((1 << kshift) - 1), nt_ = t >> kshift; const float* s = src + (size_t)(kt * 64 + kl0) * N + nt_ * 64 + n4; pv0 = *(const f32x4*)s; pv1 = *(const f32x4*)(s + (size_t)32 * N); }
    int buf = 0;
    for (; t < total; t += G) { float* tl = tile + buf * (64 * 65); const int kt = t & ((1 << kshift) - 1), nt_ = t >> kshift;
        tl[kl0 * 65 + n4] = pv0[0]; tl[kl0 * 65 + n4 + 1] = pv0[1]; tl[kl0 * 65 + n4 + 2] = pv0[2]; tl[kl0 * 65 + n4 + 3] = pv0[3];
        tl[(32 + kl0) * 65 + n4] = pv1[0]; tl[(32 + kl0) * 65 + n4 + 1] = pv1[1]; tl[(32 + kl0) * 65 + n4 + 2] = pv1[2]; tl[(32 + kl0) * 65 + n4 + 3] = pv1[3];
        { const int tn = t + G; if (tn < total) { const int kt2 = tn & ((1 << kshift) - 1), nt2 = tn >> kshift; const float* s = src + (size_t)(kt2 * 64 + kl0) * N + nt2 * 64 + n4; pv0 = *(const f32x4*)s; pv1 = *(const f32x4*)(s + (size_t)32 * N); } }
        __syncthreads();
        u32x4 w; w.x = cvt_pk_bf16(tl[(k8 + 0) * 65 + nl], tl[(k8 + 1) * 65 + nl]); w.y = cvt_pk_bf16(tl[(k8 + 2) * 65 + nl], tl[(k8 + 3) * 65 + nl]);
        w.z = cvt_pk_bf16(tl[(k8 + 4) * 65 + nl], tl[(k8 + 5) * 65 + nl]); w.w = cvt_pk_bf16(tl[(k8 + 6) * 65 + nl], tl[(k8 + 7) * 65 + nl]);
        *(u32x4*)(dst + (size_t)(nt_ * 64 + nl) * K + kt * 64 + k8) = w;
        buf ^= 1; }
    __syncthreads();
}

__device__ void phase_p1(const Params& p, int layer, unsigned char* smem) {
    const int tid = opaque_tid(), bid = blockIdx.x, G = gridDim.x;
    float* tile = (float*)smem;
    { const float* win = p.w_in + (size_t)layer * DM * NIN;
      convert_matrix(win, DM, NIN, (bf16_t*)(p.ws + OFF_WT), 5, 32 * 256, tile);
      for (int br = 0; br < 3; ++br) { const float* wsrc = (br == 0 ? p.w_a : br == 1 ? p.w_b : p.w_c) + (size_t)layer * 1024 * DM;
          convert_matrix(wsrc, 1024, DM, (bf16_t*)(p.ws + OFF_WA + br * SZ_WBR), 4, 16 * 32, tile); }
      const float* wo = p.w_out + (size_t)layer * DM * DM;
      convert_matrix(wo, DM, DM, (bf16_t*)(p.ws + OFF_WO), 5, 32 * 32, tile);
      __syncthreads(); }
    { const float* win = p.w_in + (size_t)layer * DM * NIN;
      const int lane = tid & 63, wv = tid >> 6, l15 = lane & 15, quad = lane >> 4;
      for (int t = bid; t < 256; t += G) { const int g = t >> 6, k0 = (t & 63) * 32;
          f32x4 acc[2][2];
#pragma unroll
          for (int jt = 0; jt < 2; ++jt)
#pragma unroll
              for (int nt_ = 0; nt_ < 2; ++nt_) acc[jt][nt_] = (f32x4){0.f, 0.f, 0.f, 0.f};
#pragma unroll
          for (int ks = 0; ks < 8; ++ks) { const int c0 = ks * 32 + quad * 8;
              bf16x8 bfr[2];
#pragma unroll
              for (int nt_ = 0; nt_ < 2; ++nt_) { const float* wp = win + (size_t)(k0 + nt_ * 16 + l15) * NIN + 4096 + g * 256 + c0; const f32x4 x0 = *(const f32x4*)wp, x1 = *(const f32x4*)(wp + 4);
                  u32x4 pk; pk.x = cvt_pk_bf16(x0[0], x0[1]); pk.y = cvt_pk_bf16(x0[2], x0[3]); pk.z = cvt_pk_bf16(x1[0], x1[1]); pk.w = cvt_pk_bf16(x1[2], x1[3]); bfr[nt_] = __builtin_bit_cast(bf16x8, pk); }
#pragma unroll
              for (int jt = 0; jt < 2; ++jt) { const int j = wv * 32 + jt * 16 + l15; const bool im = j > 128; const int cp = im ? j - 128 : j; float d[8];
#pragma unroll
                  for (int e = 0; e < 8; ++e) { const float rev = (float)(((c0 + e) * cp) & 255) * (1.0f / 256.0f); d[e] = im ? -__builtin_amdgcn_sinf(rev) : __builtin_amdgcn_cosf(rev); }
                  u32x4 pk; pk.x = cvt_pk_bf16(d[0], d[1]); pk.y = cvt_pk_bf16(d[2], d[3]); pk.z = cvt_pk_bf16(d[4], d[5]); pk.w = cvt_pk_bf16(d[6], d[7]);
                  const bf16x8 afr = __builtin_bit_cast(bf16x8, pk);
#pragma unroll
                  for (int nt_ = 0; nt_ < 2; ++nt_) acc[jt][nt_] = __builtin_amdgcn_mfma_f32_16x16x32_bf16(afr, bfr[nt_], acc[jt][nt_], 0, 0, 0); } }
          bf16_t* dstw = (bf16_t*)(p.ws + OFF_WEFF);
#pragma unroll
          for (int jt = 0; jt < 2; ++jt)
#pragma unroll
              for (int nt_ = 0; nt_ < 2; ++nt_)
#pragma unroll
                  for (int r = 0; r < 4; ++r) dstw[(size_t)(g * 256 + wv * 32 + jt * 16 + quad * 4 + r) * DM + k0 + nt_ * 16 + l15] = f2bf(acc[jt][nt_][r]); }
    }
    { const int lane = tid & 63, wv = tid >> 6; const float* h = (const float*)(p.ws + OFF_H); const float* gam = p.norm_g + layer * DM;
      bf16_t* xn = (bf16_t*)(p.ws + OFF_XN); bf16_t* xnp = (bf16_t*)(p.ws + OFF_XNP);
      for (int l = bid * 8 + wv; l < LP; l += G * 8) {
          if (l < L_TOK) { const f32x4* row = (const f32x4*)(layer == 0 ? (l < NMETA ? p.meta + (size_t)l * DM : p.x + (size_t)(l - NMETA) * DM) : h + (size_t)l * DM); f32x4 v[8]; float ss = 0.f;
#pragma unroll
              for (int i = 0; i < 8; ++i) { v[i] = row[i * 64 + lane]; ss += v[i][0] * v[i][0] + v[i][1] * v[i][1] + v[i][2] * v[i][2] + v[i][3] * v[i][3]; }
              ss = wave_sum(ss); const float inv = rsqrtf(ss * (1.0f / DM) + 1e-6f);
              const int l1 = l / FN2, l2 = l - l1 * FN2; const size_t pr = (size_t)l2 * FN1P + l1;
#pragma unroll
              for (int i = 0; i < 8; ++i) { const f32x4 gg = ((const f32x4*)gam)[i * 64 + lane]; u32x2 w; w.x = cvt_pk_bf16(v[i][0] * inv * gg[0], v[i][1] * inv * gg[1]); w.y = cvt_pk_bf16(v[i][2] * inv * gg[2], v[i][3] * inv * gg[3]);
                  *(u32x2*)(xn + (size_t)l * DM + (i * 64 + lane) * 4) = w; *(u32x2*)(xnp + pr * DM + (i * 64 + lane) * 4) = w; } }
          else { const u32x2 z = (u32x2){0u, 0u};
#pragma unroll
              for (int i = 0; i < 8; ++i) *(u32x2*)(xn + (size_t)l * DM + (i * 64 + lane) * 4) = z; } }
      for (int idx = bid * 8 + wv; idx < FN2 * (FN1P - FN1); idx += G * 8) { const int l2 = idx / (FN1P - FN1), l1 = FN1 + idx % (FN1P - FN1); const size_t pr = (size_t)l2 * FN1P + l1; const u32x2 z = (u32x2){0u, 0u};
#pragma unroll
          for (int i = 0; i < 8; ++i) *(u32x2*)(xnp + pr * DM + (i * 64 + lane) * 4) = z; } }
}

__device__ void na_phase(const Params& p, int layer, unsigned char* smem) {
    const int tid = opaque_tid(), wv = tid >> 6, lane = tid & 63, l15 = lane & 15, quad = lane >> 4;
    const int G = gridDim.x;
    const bf16_t* qkv = (const bf16_t*)(p.ws + OFF_QKV);
    unsigned char* sK = smem;
    bf16_t* sVT = (bf16_t*)(smem + 76032);
    float* sRPB = (float*)(smem + 144640);
    float* sMB = (float*)(smem + 146512);
    const int cb = wv & 3, hf = wv >> 2, c = cb * 16 + l15;
    const int cu = cb == 0 ? 0 : (cb == 1 ? 8 : (cb == 2 ? 24 : 32)), cs = min(max(c - 8, 0), 48);
    u32x4 pk[8], pv[8], pmk = (u32x4){0u, 0u, 0u, 0u}, pmv = (u32x4){0u, 0u, 0u, 0u}; bf16x8 pq0, pq1; float prp = 0.f;
#define NA_LOADS(U) do { const int r_ = (U) >> 4, hd_ = (U) & 15, r0_ = min(max(r_ - 4, 0), 248); \
        _Pragma("unroll") for (int ps = 0; ps < 8; ++ps) { const int tok = ps * 64 + (tid >> 3), ch = tid & 7; const size_t g = (size_t)(NMETA + r0_ * 64 + tok) * 3072 + hd_ * 64 + ch * 8; \
            pk[ps] = *(const u32x4*)(qkv + g + 1024); pv[ps] = *(const u32x4*)(qkv + g + 2048); } \
        if (tid < 128) { const size_t g = (size_t)(tid >> 3) * 3072 + hd_ * 64 + (tid & 7) * 8; pmk = *(const u32x4*)(qkv + g + 1024); pmv = *(const u32x4*)(qkv + g + 2048); } \
        { const bf16_t* qp = qkv + (size_t)(NMETA + r_ * 64 + c) * 3072 + hd_ * 64 + quad * 8; pq0 = *(const bf16x8*)qp; pq1 = *(const bf16x8*)(qp + 32); } \
        if (tid < 465) prp = p.rpb[(size_t)(layer * 16 + hd_) * 465 + tid]; else if (tid >= 480 && tid < 496) prp = p.meta_bias[(layer * 16 + hd_) * 16 + tid - 480]; } while (0)
    int u = blockIdx.x;
    if (u < 4096) NA_LOADS(u);
    for (; u < 4096; u += G) {
        const int r = u >> 4, hd = u & 15, r0 = min(max(r - 4, 0), 248);
        __syncthreads();
#pragma unroll
        for (int ps = 0; ps < 8; ++ps) { const int tok = ps * 64 + (tid >> 3), ch = tid & 7; const u32x4 vv = pv[ps];
            *(u32x4*)(sK + tok * 144 + ch * 16) = pk[ps];
            bf16_t* vt = sVT + (ch * 8) * 536 + tok;
            vt[0] = (bf16_t)vv.x; vt[536] = (bf16_t)(vv.x >> 16); vt[2 * 536] = (bf16_t)vv.y; vt[3 * 536] = (bf16_t)(vv.y >> 16);
            vt[4 * 536] = (bf16_t)vv.z; vt[5 * 536] = (bf16_t)(vv.z >> 16); vt[6 * 536] = (bf16_t)vv.w; vt[7 * 536] = (bf16_t)(vv.w >> 16); }
        if (tid < 128) { const int tok = tid >> 3, ch = tid & 7; const u32x4 vv = pmv;
            *(u32x4*)(sK + (512 + tok) * 144 + ch * 16) = pmk;
            bf16_t* vt = sVT + (ch * 8) * 536 + 512 + tok;
            vt[0] = (bf16_t)vv.x; vt[536] = (bf16_t)(vv.x >> 16); vt[2 * 536] = (bf16_t)vv.y; vt[3 * 536] = (bf16_t)(vv.y >> 16);
            vt[4 * 536] = (bf16_t)vv.z; vt[5 * 536] = (bf16_t)(vv.z >> 16); vt[6 * 536] = (bf16_t)vv.w; vt[7 * 536] = (bf16_t)(vv.w >> 16); }
        if (tid < 465) sRPB[tid] = prp; else if (tid >= 480 && tid < 496) sMB[tid - 480] = prp;
        const bf16x8 bq0 = pq0, bq1 = pq1;
        { const int un = u + G; if (un < 4096) NA_LOADS(un); }
        __syncthreads();
        bf16_t* yc = (bf16_t*)(p.ws + OFF_GATE + 2 * SZ_GATE);
        float gatev[4][4];
        if (hf == 0) {
#pragma unroll
            for (int rr = 0; rr < 4; ++rr)
#pragma unroll
                for (int dt = 0; dt < 4; ++dt) gatev[rr][dt] = bf2f(yc[(size_t)(NMETA + r * 64 + cb * 16 + quad * 4 + rr) * 1024 + hd * 64 + l15 + dt * 16]); }
        float sc[9][4];
#pragma unroll
        for (int ti = 0; ti < 9; ++ti) { const int j = 4 * hf + (ti >> 1), tt = ti & 1; const int slot0 = ti < 8 ? j * 64 + cu + tt * 16 : 512;
            const unsigned char* kp = sK + (slot0 + l15) * 144 + quad * 16;
            const bf16x8 a0 = *(const bf16x8*)kp, a1 = *(const bf16x8*)(kp + 64);
            f32x4 acc = (f32x4){0.f, 0.f, 0.f, 0.f};
            acc = __builtin_amdgcn_mfma_f32_16x16x32_bf16(a0, bq0, acc, 0, 0, 0); acc = __builtin_amdgcn_mfma_f32_16x16x32_bf16(a1, bq1, acc, 0, 0, 0);
            if (ti < 8) { const float* rp = sRPB + (r0 + j - r + 7) * 31 + (15 - c);
#pragma unroll
                for (int rr = 0; rr < 4; ++rr) { const int kc = cu + tt * 16 + quad * 4 + rr; const bool ok = kc >= cs && kc < cs + 16; const int kcc = ok ? kc : cs;
                    sc[ti][rr] = ok ? acc[rr] * 0.125f + rp[kcc] : -1.0e30f; } }
            else {
#pragma unroll
                for (int rr = 0; rr < 4; ++rr) sc[ti][rr] = hf == 0 ? acc[rr] * 0.125f + sMB[quad * 4 + rr] : -1.0e30f; } }
        float mx = -1.0e30f;
#pragma unroll
        for (int ti = 0; ti < 9; ++ti)
#pragma unroll
            for (int rr = 0; rr < 4; ++rr) mx = fmaxf(mx, sc[ti][rr]);
        mx = fmaxf(mx, __shfl_xor(mx, 16)); mx = fmaxf(mx, __shfl_xor(mx, 32));
        float lsum = 0.f;
#pragma unroll
        for (int ti = 0; ti < 9; ++ti)
#pragma unroll
            for (int rr = 0; rr < 4; ++rr) { sc[ti][rr] = __expf(sc[ti][rr] - mx); lsum += sc[ti][rr]; }
        lsum += __shfl_xor(lsum, 16); lsum += __shfl_xor(lsum, 32);
        f32x4 oacc[4];
#pragma unroll
        for (int dt = 0; dt < 4; ++dt) oacc[dt] = (f32x4){0.f, 0.f, 0.f, 0.f};
#pragma unroll
        for (int ks = 0; ks < 5; ++ks) { const int tA = 2 * ks, tB = 2 * ks + 1;
            const int jA = 4 * hf + (tA >> 1); const int slotA = tA < 8 ? jA * 64 + cu + (tA & 1) * 16 : 512; const int slotB = ks < 4 ? (4 * hf + (tB >> 1)) * 64 + cu + 16 : 512;
            u32x4 pa; pa.x = cvt_pk_bf16(sc[tA][0], sc[tA][1]); pa.y = cvt_pk_bf16(sc[tA][2], sc[tA][3]);
            if (ks < 4) { pa.z = cvt_pk_bf16(sc[tA + 1 < 9 ? tA + 1 : 8][0], sc[tA + 1 < 9 ? tA + 1 : 8][1]); pa.w = cvt_pk_bf16(sc[tA + 1 < 9 ? tA + 1 : 8][2], sc[tA + 1 < 9 ? tA + 1 : 8][3]); } else { pa.z = 0u; pa.w = 0u; }
            const bf16x8 af = __builtin_bit_cast(bf16x8, pa);
#pragma unroll
            for (int dt = 0; dt < 4; ++dt) { const bf16_t* vr = sVT + (dt * 16 + l15) * 536 + quad * 4;
                const u32x2 lo = *(const u32x2*)(vr + slotA), hi = *(const u32x2*)(vr + slotB);
                const u32x4 bb = (u32x4){lo.x, lo.y, hi.x, hi.y};
                oacc[dt] = __builtin_amdgcn_mfma_f32_16x16x32_bf16(af, __builtin_bit_cast(bf16x8, bb), oacc[dt], 0, 0, 0); } }
        __syncthreads();
        float* part = (float*)smem + cb * 1056;
        if (hf == 1) {
#pragma unroll
            for (int dt = 0; dt < 4; ++dt)
#pragma unroll
                for (int rr = 0; rr < 4; ++rr) part[(quad * 4 + rr) * 64 + dt * 16 + l15] = oacc[dt][rr];
            if (quad == 0) { part[1024 + l15] = mx; part[1040 + l15] = lsum; } }
        __syncthreads();
        if (hf == 0) {
#pragma unroll
            for (int rr = 0; rr < 4; ++rr) { const int qy = quad * 4 + rr; const float m0 = __shfl(mx, qy), l0 = __shfl(lsum, qy); const float m1 = part[1024 + qy], l1 = part[1040 + qy];
                const float M = fmaxf(m0, m1), f0 = __expf(m0 - M), f1 = __expf(m1 - M); const float inv = 1.0f / (f0 * l0 + f1 * l1);
                bf16_t* gp = yc + (size_t)(NMETA + r * 64 + cb * 16 + qy) * 1024 + hd * 64 + l15;
#pragma unroll
                for (int dt = 0; dt < 4; ++dt) { const float o = (f0 * oacc[dt][rr] + f1 * part[qy * 64 + dt * 16 + l15]) * inv; gp[dt * 16] = f2bf(o * gatev[rr][dt]); } } }
    }
#undef NA_LOADS
}
__device__ void na_meta_unit(const Params& p, int layer) {
    const int tid = opaque_tid();
    if (tid < 256) { const int hd = tid >> 4, qi = tid & 15; const bf16_t* qkv = (const bf16_t*)(p.ws + OFF_QKV);
        float q[64];
        { const u32x4* qp = (const u32x4*)(qkv + (size_t)qi * 3072 + hd * 64);
#pragma unroll
          for (int i = 0; i < 8; ++i) { const u32x4 v = qp[i]; q[i * 8 + 0] = lo_bf(v.x) * 0.125f; q[i * 8 + 1] = hi_bf(v.x) * 0.125f; q[i * 8 + 2] = lo_bf(v.y) * 0.125f; q[i * 8 + 3] = hi_bf(v.y) * 0.125f;
              q[i * 8 + 4] = lo_bf(v.z) * 0.125f; q[i * 8 + 5] = hi_bf(v.z) * 0.125f; q[i * 8 + 6] = lo_bf(v.w) * 0.125f; q[i * 8 + 7] = hi_bf(v.w) * 0.125f; } }
        float o[64];
#pragma unroll
        for (int i = 0; i < 64; ++i) o[i] = 0.f;
        float mx = -3.0e38f, lsum = 0.f;
#pragma unroll 1
        for (int m = 0; m < 16; ++m) { const u32x4* kp = (const u32x4*)(qkv + (size_t)m * 3072 + 1024 + hd * 64); const u32x4* vp = (const u32x4*)(qkv + (size_t)m * 3072 + 2048 + hd * 64);
            float d0 = 0.f, d1 = 0.f;
#pragma unroll
            for (int e = 0; e < 8; ++e) { const u32x4 v = kp[e];
                d0 += q[e * 8 + 0] * lo_bf(v.x) + q[e * 8 + 2] * lo_bf(v.y) + q[e * 8 + 4] * lo_bf(v.z) + q[e * 8 + 6] * lo_bf(v.w);
                d1 += q[e * 8 + 1] * hi_bf(v.x) + q[e * 8 + 3] * hi_bf(v.y) + q[e * 8 + 5] * hi_bf(v.z) + q[e * 8 + 7] * hi_bf(v.w); }
            const float sc = d0 + d1 + p.meta_bias[(layer * 16 + hd) * 16 + m]; const float mnew = fmaxf(mx, sc); const float alpha = __expf(mx - mnew), pi = __expf(sc - mnew);
            lsum = lsum * alpha + pi; mx = mnew;
#pragma unroll
            for (int e = 0; e < 8; ++e) { const u32x4 v = vp[e];
                o[e * 8 + 0] = o[e * 8 + 0] * alpha + pi * lo_bf(v.x); o[e * 8 + 1] = o[e * 8 + 1] * alpha + pi * hi_bf(v.x); o[e * 8 + 2] = o[e * 8 + 2] * alpha + pi * lo_bf(v.y); o[e * 8 + 3] = o[e * 8 + 3] * alpha + pi * hi_bf(v.y);
                o[e * 8 + 4] = o[e * 8 + 4] * alpha + pi * lo_bf(v.z); o[e * 8 + 5] = o[e * 8 + 5] * alpha + pi * hi_bf(v.z); o[e * 8 + 6] = o[e * 8 + 6] * alpha + pi * lo_bf(v.w); o[e * 8 + 7] = o[e * 8 + 7] * alpha + pi * hi_bf(v.w); } }
        const float inv = 1.0f / lsum; u32x4* gp = (u32x4*)((bf16_t*)(p.ws + OFF_GATE + 2 * SZ_GATE) + (size_t)qi * 1024 + hd * 64);
#pragma unroll
        for (int e = 0; e < 8; ++e) { const u32x4 g = gp[e]; u32x4 w;
            w.x = cvt_pk_bf16(o[e * 8 + 0] * inv * lo_bf(g.x), o[e * 8 + 1] * inv * hi_bf(g.x)); w.y = cvt_pk_bf16(o[e * 8 + 2] * inv * lo_bf(g.y), o[e * 8 + 3] * inv * hi_bf(g.y));
            w.z = cvt_pk_bf16(o[e * 8 + 4] * inv * lo_bf(g.z), o[e * 8 + 5] * inv * hi_bf(g.z)); w.w = cvt_pk_bf16(o[e * 8 + 6] * inv * lo_bf(g.w), o[e * 8 + 7] * inv * hi_bf(g.w));
            gp[e] = w; } }
}

__device__ __forceinline__ unsigned rev4_14(unsigned k) { unsigned r = __brev(k) >> 18; return ((r & 0x1555u) << 1) | ((r >> 1) & 0x1555u); }
__device__ __forceinline__ float2 cmul(float2 a, float2 b) { return make_float2(a.x * b.x - a.y * b.y, a.x * b.y + a.y * b.x); }
#define PADI(i) ((i) + ((i) >> 4))
#define CFF(n) cff[2 * PADI((n) >> 1) + ((n) & 1)]
__device__ __forceinline__ void hw_sincos(float rev, float& sn, float& cs) { sn = __builtin_amdgcn_sinf(rev); cs = __builtin_amdgcn_cosf(rev); }
__device__ __forceinline__ float c16(int k) { const float t[10] = {1.0f, 0.9238795325f, 0.7071067812f, 0.3826834324f, 0.0f, -0.3826834324f, -0.7071067812f, -0.9238795325f, -1.0f, -0.9238795325f}; return t[k]; }
__device__ __forceinline__ float s16(int k) { const float t[10] = {0.0f, 0.3826834324f, 0.7071067812f, 0.9238795325f, 1.0f, 0.9238795325f, 0.7071067812f, 0.3826834324f, 0.0f, -0.3826834324f}; return t[k]; }
__device__ __forceinline__ float2 cadd(float2 a, float2 b) { return make_float2(a.x + b.x, a.y + b.y); }
__device__ __forceinline__ float2 csub(float2 a, float2 b) { return make_float2(a.x - b.x, a.y - b.y); }
template <int SGN> __device__ __forceinline__ void bf4(float2& a0, float2& a1, float2& a2, float2& a3) {
    const float2 t0 = cadd(a0, a2), t1 = csub(a0, a2), t2 = cadd(a1, a3), d = csub(a1, a3);
    const float2 t3 = SGN < 0 ? make_float2(d.y, -d.x) : make_float2(-d.y, d.x);
    a0 = cadd(t0, t2); a1 = cadd(t1, t3); a2 = csub(t0, t2); a3 = csub(t1, t3);
}
template <int S> __device__ __forceinline__ void r16_fwd_pass(float2* a) {
    constexpr int Q = S / 4;
    for (int u = opaque_tid(); u < 1024; u += NTHREADS) { const int j = u & (Q - 1); const int base = ((u - j) << 4) + j;
        float2 x[4][4];
#pragma unroll
        for (int aa = 0; aa < 4; ++aa)
#pragma unroll
            for (int bb = 0; bb < 4; ++bb) x[aa][bb] = a[PADI(base + aa * S + bb * Q)];
        float sn, cs; hw_sincos((float)j / (float)(4 * S), sn, cs); const float2 wb0 = make_float2(cs, -sn);
#pragma unroll
        for (int bb = 0; bb < 4; ++bb) { const float2 w1 = bb == 0 ? wb0 : cmul(wb0, make_float2(c16(bb), -s16(bb))); const float2 w2 = cmul(w1, w1), w3 = cmul(w2, w1);
            bf4<-1>(x[0][bb], x[1][bb], x[2][bb], x[3][bb]); x[1][bb] = cmul(x[1][bb], w1); x[2][bb] = cmul(x[2][bb], w2); x[3][bb] = cmul(x[3][bb], w3); }
        hw_sincos((float)j / (float)S, sn, cs); const float2 v1 = make_float2(cs, -sn), v2 = cmul(v1, v1), v3 = cmul(v2, v1);
#pragma unroll
        for (int aa = 0; aa < 4; ++aa) { bf4<-1>(x[aa][0], x[aa][1], x[aa][2], x[aa][3]); x[aa][1] = cmul(x[aa][1], v1); x[aa][2] = cmul(x[aa][2], v2); x[aa][3] = cmul(x[aa][3], v3); }
#pragma unroll
        for (int aa = 0; aa < 4; ++aa)
#pragma unroll
            for (int bb = 0; bb < 4; ++bb) a[PADI(base + aa * S + bb * Q)] = x[aa][bb]; }
    __syncthreads();
}
template <int S> __device__ __forceinline__ void r16_inv_pass(float2* a) {
    constexpr int Q = S / 4;
    for (int u = opaque_tid(); u < 1024; u += NTHREADS) { const int j = u & (Q - 1); const int base = ((u - j) << 4) + j;
        float2 x[4][4];
#pragma unroll
        for (int aa = 0; aa < 4; ++aa)
#pragma unroll
            for (int bb = 0; bb < 4; ++bb) x[aa][bb] = a[PADI(base + aa * S + bb * Q)];
        float sn, cs; hw_sincos((float)j / (float)S, sn, cs); const float2 v1 = make_float2(cs, sn), v2 = cmul(v1, v1), v3 = cmul(v2, v1);
#pragma unroll
        for (int aa = 0; aa < 4; ++aa) { x[aa][1] = cmul(x[aa][1], v1); x[aa][2] = cmul(x[aa][2], v2); x[aa][3] = cmul(x[aa][3], v3); bf4<1>(x[aa][0], x[aa][1], x[aa][2], x[aa][3]); }
        hw_sincos((float)j / (float)(4 * S), sn, cs); const float2 wb0 = make_float2(cs, sn);
#pragma unroll
        for (int bb = 0; bb < 4; ++bb) { const float2 w1 = bb == 0 ? wb0 : cmul(wb0, make_float2(c16(bb), s16(bb))); const float2 w2 = cmul(w1, w1), w3 = cmul(w2, w1);
            x[1][bb] = cmul(x[1][bb], w1); x[2][bb] = cmul(x[2][bb], w2); x[3][bb] = cmul(x[3][bb], w3); bf4<1>(x[0][bb], x[1][bb], x[2][bb], x[3][bb]); }
#pragma unroll
        for (int aa = 0; aa < 4; ++aa)
#pragma unroll
            for (int bb = 0; bb < 4; ++bb) a[PADI(base + aa * S + bb * Q)] = x[aa][bb]; }
    __syncthreads();
}
__device__ void fft_fwd(float2* a) {
    r16_fwd_pass<4096>(a);
    r16_fwd_pass<256>(a);
    { const int span = 16;
        for (int b = opaque_tid(); b < 4096; b += NTHREADS) { const int j = b & (span - 1); const int base = ((b - j) << 2) + j;
            const int i0 = PADI(base), i1 = PADI(base + span), i2 = PADI(base + 2 * span), i3 = PADI(base + 3 * span);
            float2 a0 = a[i0], a1 = a[i1], a2 = a[i2], a3 = a[i3];
            const float2 w1 = make_float2(c16(0) * 0.f + __builtin_amdgcn_cosf((float)j * (1.0f / 64.0f)), -__builtin_amdgcn_sinf((float)j * (1.0f / 64.0f))), w2 = cmul(w1, w1), w3 = cmul(w2, w1);
            bf4<-1>(a0, a1, a2, a3);
            a[i0] = a0; a[i1] = cmul(a1, w1); a[i2] = cmul(a2, w2); a[i3] = cmul(a3, w3); }
        __syncthreads(); }
    for (int blk = opaque_tid(); blk < 1024; blk += NTHREADS) { float2* pb = a + blk * 17; float2 x[16];
#pragma unroll
        for (int e = 0; e < 16; ++e) x[e] = pb[e];
#pragma unroll
        for (int j = 0; j < 4; ++j) { bf4<-1>(x[j], x[j + 4], x[j + 8], x[j + 12]);
            x[j + 4] = cmul(x[j + 4], make_float2(c16(j), -s16(j))); x[j + 8] = cmul(x[j + 8], make_float2(c16(2 * j), -s16(2 * j))); x[j + 12] = cmul(x[j + 12], make_float2(c16(3 * j), -s16(3 * j))); }
#pragma unroll
        for (int g = 0; g < 4; ++g) bf4<-1>(x[4 * g], x[4 * g + 1], x[4 * g + 2], x[4 * g + 3]);
#pragma unroll
        for (int e = 0; e < 16; ++e) pb[e] = x[e]; }
    __syncthreads();
}
__device__ void fft_inv(float2* a) {
    for (int blk = opaque_tid(); blk < 1024; blk += NTHREADS) { float2* pb = a + blk * 17; float2 x[16];
#pragma unroll
        for (int e = 0; e < 16; ++e) x[e] = pb[e];
#pragma unroll
        for (int g = 0; g < 4; ++g) bf4<1>(x[4 * g], x[4 * g + 1], x[4 * g + 2], x[4 * g + 3]);
#pragma unroll
        for (int j = 0; j < 4; ++j) { x[j + 4] = cmul(x[j + 4], make_float2(c16(j), s16(j))); x[j + 8] = cmul(x[j + 8], make_float2(c16(2 * j), s16(2 * j))); x[j + 12] = cmul(x[j + 12], make_float2(c16(3 * j), s16(3 * j)));
            bf4<1>(x[j], x[j + 4], x[j + 8], x[j + 12]); }
#pragma unroll
        for (int e = 0; e < 16; ++e) pb[e] = x[e]; }
    __syncthreads();
    { const int span = 16;
        for (int b = opaque_tid(); b < 4096; b += NTHREADS) { const int j = b & (span - 1); const int base = ((b - j) << 2) + j;
            const int i0 = PADI(base), i1 = PADI(base + span), i2 = PADI(base + 2 * span), i3 = PADI(base + 3 * span);
            const float2 w1 = make_float2(__builtin_amdgcn_cosf((float)j * (1.0f / 64.0f)), __builtin_amdgcn_sinf((float)j * (1.0f / 64.0f))), w2 = cmul(w1, w1), w3 = cmul(w2, w1);
            float2 a0 = a[i0], a1 = cmul(a[i1], w1), a2 = cmul(a[i2], w2), a3 = cmul(a[i3], w3);
            bf4<1>(a0, a1, a2, a3);
            a[i0] = a0; a[i1] = a1; a[i2] = a2; a[i3] = a3; }
        __syncthreads(); }
    r16_inv_pass<256>(a);
    r16_inv_pass<4096>(a);
}
__device__ __forceinline__ void hy_load8(const bf16_t* __restrict__ row, int t0, u32x4& v, float& xl, float& xh) {
    v = *(const u32x4*)(row + t0); xl = t0 > 0 ? bf2f(row[t0 - 1]) : 0.f; xh = (t0 + 8 < L_TOK) ? bf2f(row[t0 + 8]) : 0.f;
}
__device__ __forceinline__ void hy_calc8(const u32x4 v, float xl, float xh, const float (&w)[4], float (&o)[8]) {
    float x[10];
    x[0] = xl; x[9] = xh;
    x[1] = lo_bf(v.x); x[2] = hi_bf(v.x); x[3] = lo_bf(v.y); x[4] = hi_bf(v.y); x[5] = lo_bf(v.z); x[6] = hi_bf(v.z); x[7] = lo_bf(v.w); x[8] = hi_bf(v.w);
#pragma unroll
    for (int e = 0; e < 8; ++e) o[e] = w[0] * x[e] + w[1] * x[e + 1] + w[2] * x[e + 2] + w[3];
}
__device__ __forceinline__ void hy_val8(const bf16_t* __restrict__ row, int t0, const float (&w)[4], float (&o)[8]) { u32x4 v; float xl, xh; hy_load8(row, t0, v, xl, xh); hy_calc8(v, xl, xh, w, o); }
struct HyCh { const bf16_t* __restrict__ ru; const bf16_t* __restrict__ r1; const bf16_t* __restrict__ r2; float wu[4], w1[4], w2[4]; };

constexpr int SD_W4B = 0  , SD_GFX = 512, SD_GBX = 528, SD_EF = 544, SD_EB = 560, SD_VH = 576, SD_VT = 592, SD_END = 608;
constexpr int NCHUNK = L_TOK / 8;

template <int ORDER>
__device__ void hy_conv(const HyCh& hc, float2* cf, float* side, unsigned char* scratch) {
    const int tid = opaque_tid(); float* cff = (float*)cf;
    f32x4* __restrict__ heo = (f32x4*)(scratch + HS_HEO); const float* __restrict__ z2g = (const float*)(scratch + HS_Z2);
    if (tid < 15) side[SD_EF + tid] = CFF(16369 + tid); else if (tid >= 32 && tid < 47) side[SD_EB + tid - 32] = CFF(32768 - (16369 + tid - 32));
    __syncthreads();
    fft_fwd(cf);
    for (int j = tid; j <= 8192; j += NTHREADS) { const unsigned i_ = j < 8192 ? ((((unsigned)j >> 1) << 2) | ((unsigned)j & 1u)) : 2u; const unsigned k = rev4_14(i_); const unsigned kp = (16384u - k) & 16383u; const float2 a = cf[PADI(i_)], bq = cf[PADI(rev4_14(kp))];
        const float bx = bq.x, by = -bq.y; const float sc = 1.0f / 16384.0f;
        heo[j] = (f32x4){0.5f * (a.x + bx) * sc, 0.5f * (a.y + by) * sc, 0.5f * (a.y - by) * sc, -0.5f * (a.x - bx) * sc}; }
    __syncthreads();
    {
        u32x4 rv[4]; float rl[4], rh[4]; f32x4 z0[4], z1[4];
#pragma unroll
        for (int i = 0; i < 4; ++i) { const int c = tid + NTHREADS * i;
            if (ORDER == 0) hy_load8(hc.ru, 8 * c, rv[i], rl[i], rh[i]); else { z0[i] = *(const f32x4*)(z2g + 8 * c); z1[i] = *(const f32x4*)(z2g + 8 * c + 4); } }
#pragma unroll
        for (int i = 0; i < 4; ++i) { const int c = tid + NTHREADS * i; float v[8];
            if (ORDER == 0) hy_calc8(rv[i], rl[i], rh[i], hc.wu, v);
            else { v[0] = z0[i][0]; v[1] = z0[i][1]; v[2] = z0[i][2]; v[3] = z0[i][3]; v[4] = z1[i][0]; v[5] = z1[i][1]; v[6] = z1[i][2]; v[7] = z1[i][3]; }
            float2* d = cf + PADI(4 * c); d[0] = make_float2(v[0], v[1]); d[1] = make_float2(v[2], v[3]); d[2] = make_float2(v[4], v[5]); d[3] = make_float2(v[6], v[7]);
            if (i == 0 && tid < 2) {
#pragma unroll
                for (int e = 0; e < 8; ++e) side[SD_VH + 8 * tid + e] = v[e]; } }
        if (tid < 2) { const int c = NCHUNK - 2 + tid; float v[8];
            if (ORDER == 0) hy_val8(hc.ru, 8 * c, hc.wu, v);
            else { const f32x4 p0 = *(const f32x4*)(z2g + 8 * c), p1 = *(const f32x4*)(z2g + 8 * c + 4); v[0] = p0[0]; v[1] = p0[1]; v[2] = p0[2]; v[3] = p0[3]; v[4] = p1[0]; v[5] = p1[1]; v[6] = p1[2]; v[7] = p1[3]; }
            float2* d = cf + PADI(4 * c); d[0] = make_float2(v[0], v[1]); d[1] = make_float2(v[2], v[3]); d[2] = make_float2(v[4], v[5]); d[3] = make_float2(v[6], v[7]);
#pragma unroll
            for (int e = 0; e < 8; ++e) side[SD_VT + 8 * tid + e] = v[e]; } }
    for (int i = L_TOK / 2 + tid; i < 16384; i += NTHREADS) cf[PADI(i)] = make_float2(0.f, 0.f);
    __syncthreads();
    fft_fwd(cf);
#pragma unroll 4
    for (int j = tid; j <= 8192; j += NTHREADS) { const unsigned i_ = j < 8192 ? ((((unsigned)j >> 1) << 2) | ((unsigned)j & 1u)) : 2u; const unsigned k = rev4_14(i_); const unsigned kp = (16384u - k) & 16383u; const unsigned ik = PADI(i_), ikp = PADI(rev4_14(kp)); const float2 a = cf[ik], bq = cf[ikp];
        const float bx = bq.x, by = -bq.y;
        const float2 XE = make_float2(0.5f * (a.x + bx), 0.5f * (a.y + by)), XO = make_float2(0.5f * (a.y - by), -0.5f * (a.x - bx));
        const f32x4 hh = heo[j]; const float2 HE = make_float2(hh[0], hh[1]), HO = make_float2(hh[2], hh[3]);
        float sn, cs; hw_sincos((float)k / 16384.0f, sn, cs); const float2 w = make_float2(cs, -sn);
        const float2 xoho = cmul(XO, HO), wx = cmul(w, xoho), xehe = cmul(XE, HE), xeho = cmul(XE, HO), xohe = cmul(XO, HE);
        const float2 YE = make_float2(xehe.x + wx.x, xehe.y + wx.y), YO = make_float2(xeho.x + xohe.x, xeho.y + xohe.y);
        cf[ik] = make_float2(YE.x - YO.y, YE.y + YO.x); cf[ikp] = make_float2(YE.x + YO.y, -YE.y + YO.x); }
    __syncthreads();
    fft_inv(cf);
    if (tid < 16) { const int t = tid; float d = 0.f;
        for (int s = t + 16384; s < L_TOK; ++s) { const int l = s - t; const float wrong = l == 16384 ? 0.f : side[SD_EF + 16399 - l]; d += (side[SD_GBX + l - 16384] - wrong) * side[SD_VT + s - 16384]; }
        CFF(t) += d; }
    else if (tid >= 32 && tid < 48) { const int t = 16384 + tid - 32; float d = 0.f;
        for (int s = 0; s <= t - 16384; ++s) { const int l = t - s; const float wrong = l == 16384 ? 0.f : side[SD_EB + 16399 - l]; d += (side[SD_GFX + l - 16384] - wrong) * side[SD_VH + s]; }
        CFF(t) += d; }
    __syncthreads();
}

__device__ void filt_to_lds(const bf16_t* __restrict__ gfp, const bf16_t* __restrict__ gbp, float2* cf, float* side) {
    const int tid = opaque_tid(); float* cff = (float*)cf;
    u32x4 qf[4], qb[4];
#pragma unroll
    for (int i = 0; i < 4; ++i) { const int c = tid + NTHREADS * i; qf[i] = *(const u32x4*)(gfp + 8 * c); qb[i] = *(const u32x4*)(gbp + 8 * c); }
#pragma unroll
    for (int i = 0; i < 4; ++i) { const int c = tid + NTHREADS * i, lag0 = 8 * c; const u32x4 f = qf[i], g = qb[i];
        float2* d = cf + PADI(4 * c); d[0] = make_float2(lo_bf(f.x), hi_bf(f.x)); d[1] = make_float2(lo_bf(f.y), hi_bf(f.y)); d[2] = make_float2(lo_bf(f.z), hi_bf(f.z)); d[3] = make_float2(lo_bf(f.w), hi_bf(f.w));
        if (lag0 >= 1) CFF(32768 - lag0) = lo_bf(g.x);
        CFF(32768 - lag0 - 1) = hi_bf(g.x); CFF(32768 - lag0 - 2) = lo_bf(g.y); CFF(32768 - lag0 - 3) = hi_bf(g.y); CFF(32768 - lag0 - 4) = lo_bf(g.z); CFF(32768 - lag0 - 5) = hi_bf(g.z); CFF(32768 - lag0 - 6) = lo_bf(g.w); CFF(32768 - lag0 - 7) = hi_bf(g.w); }
    if (tid < 2) { const int c = NCHUNK - 2 + tid; const u32x4 f = *(const u32x4*)(gfp + 8 * c), g = *(const u32x4*)(gbp + 8 * c); float* sf = side + SD_GFX + 8 * tid; float* sb = side + SD_GBX + 8 * tid;
        sf[0] = lo_bf(f.x); sf[1] = hi_bf(f.x); sf[2] = lo_bf(f.y); sf[3] = hi_bf(f.y); sf[4] = lo_bf(f.z); sf[5] = hi_bf(f.z); sf[6] = lo_bf(f.w); sf[7] = hi_bf(f.w);
        sb[0] = lo_bf(g.x); sb[1] = hi_bf(g.x); sb[2] = lo_bf(g.y); sb[3] = hi_bf(g.y); sb[4] = lo_bf(g.z); sb[5] = hi_bf(g.z); sb[6] = lo_bf(g.w); sb[7] = hi_bf(g.w); }
    if (tid == 0) CFF(NMAIN) = 0.f;
    __syncthreads();
}

__device__ void hyena_filters(const Params& p, int layer, unsigned char* smem, unsigned char* scrD, unsigned char* scrW) {
    const int tid = opaque_tid(); float2* cf = (float2*)smem; float* cff = (float*)smem; float* side = (float*)(smem + 139264);
    const int bid = blockIdx.x;
    __syncthreads();
    bf16_t* w4b = (bf16_t*)(side + SD_W4B);
    for (int i = tid; i < 16 * 64; i += NTHREADS) { const int row = i >> 6, k = i & 63; w4b[i] = f2bf(p.f_w4[((size_t)layer * 64 + k) * 4096 + (row & 3) * 1024 + bid + 256 * (row >> 2)]); }
    __syncthreads();
    const bf16_t* __restrict__ h3b = (const bf16_t*)(p.ws + OFF_H3) + (size_t)layer * L_TOK * 64;
    const int lane = tid & 63, wv = tid >> 6, col = lane & 15, quad = lane >> 4;
    const int chq = bid + 256 * quad;
    float dk[4];
#pragma unroll
    for (int f = 0; f < 4; ++f) dk[f] = fabsf(p.decay[((layer * 2 + (f >> 1)) * 2 + (f & 1)) * 1024 + chq]) * (1.4426950408889634f / (float)(L_TOK - 1));
    const bf16x8 b0 = *(const bf16x8*)(w4b + col * 64 + quad * 8), b1 = *(const bf16x8*)(w4b + col * 64 + 32 + quad * 8);
    bf16_t* __restrict__ g2 = (bf16_t*)(scrW + HS_G2);
    bf16_t* __restrict__ fq = (bf16_t*)(scrD) + (size_t)(quad > 0 ? quad - 1 : 0) * 4 * L_TOK;
#define FG_LOAD(A0, A1, GB) do { _Pragma("unroll") for (int i = 0; i < 8; ++i) { const bf16_t* hr = h3b + (size_t)(((GB) + 8 * i) * 16 + col) * 64 + quad * 8; A0[i] = *(const bf16x8*)hr; A1[i] = *(const bf16x8*)(hr + 32); } } while (0)
#define FG_GROUP(X0, X1, G_) do { f32x4 acc = (f32x4){0.f, 0.f, 0.f, 0.f}; \
        acc = __builtin_amdgcn_mfma_f32_16x16x32_bf16(b0, X0, acc, 0, 0, 0); acc = __builtin_amdgcn_mfma_f32_16x16x32_bf16(b1, X1, acc, 0, 0, 0); \
        const int lag = (G_) * 16 + col; const float fl = -(float)lag; \
        const float v0 = acc[0] * __builtin_amdgcn_exp2f(fl * dk[0]), v1 = acc[1] * __builtin_amdgcn_exp2f(fl * dk[1]), v2 = acc[2] * __builtin_amdgcn_exp2f(fl * dk[2]), v3 = acc[3] * __builtin_amdgcn_exp2f(fl * dk[3]); \
        if (quad == 0) { g2[lag] = f2bf(v2); g2[L_TOK + lag] = f2bf(v3); \
            if (lag < NMAIN) { CFF(lag) = v0; if (lag >= 1) CFF(32768 - lag) = v1; } else { side[SD_GFX + lag - NMAIN] = v0; side[SD_GBX + lag - NMAIN] = v1; } } \
        else { fq[lag] = f2bf(v0); fq[L_TOK + lag] = f2bf(v1); fq[2 * L_TOK + lag] = f2bf(v2); fq[3 * L_TOK + lag] = f2bf(v3); } } while (0)
#define FG_PROC(A0, A1, GB) do { _Pragma("unroll") for (int i = 0; i < 8; ++i) FG_GROUP(A0[i], A1[i], (GB) + 8 * i); } while (0)
    { bf16x8 pa0[8], pa1[8], pb0[8], pb1[8];
      FG_LOAD(pa0, pa1, wv);
#pragma unroll 1
      for (int m = 0; m < 16; m += 2) { const int gbA = wv + 64 * m, gbB = gbA + 64;
          FG_LOAD(pb0, pb1, gbB);
          FG_PROC(pa0, pa1, gbA);
          if (m + 2 < 16) FG_LOAD(pa0, pa1, gbB + 64);
          FG_PROC(pb0, pb1, gbB); }
      if (wv == 0) { const bf16_t* hr = h3b + (size_t)(1024 * 16 + col) * 64 + quad * 8; const bf16x8 x0 = *(const bf16x8*)hr, x1 = *(const bf16x8*)(hr + 32); FG_GROUP(x0, x1, 1024); } }
#undef FG_LOAD
#undef FG_GROUP
#undef FG_PROC
    if (tid == 0) CFF(NMAIN) = 0.f;
    __syncthreads();
}

__device__ void hyena_unit(const Params& p, int layer, int q, unsigned char* smem, unsigned char* scrD, unsigned char* scratch) {
    const int tid = opaque_tid(); float2* cf = (float2*)smem; float* cff = (float*)smem; float* side = (float*)(smem + 139264);
    const int ch = blockIdx.x + 256 * q;
    const bf16_t* hyin = (const bf16_t*)(p.ws + OFF_HYIN);
    HyCh hc; hc.ru = hyin + (size_t)ch * LP; hc.r1 = hyin + (size_t)(1024 + ch) * LP; hc.r2 = hyin + (size_t)(2048 + ch) * LP;
    { const float* cw = p.conv_w + (size_t)layer * 3 * 3072; const float* cb = p.conv_b + (size_t)layer * 3072;
#pragma unroll
      for (int jj = 0; jj < 3; ++jj) { hc.wu[jj] = cw[jj * 3072 + ch]; hc.w1[jj] = cw[jj * 3072 + 1024 + ch]; hc.w2[jj] = cw[jj * 3072 + 2048 + ch]; }
      hc.wu[3] = cb[ch]; hc.w1[3] = cb[1024 + ch]; hc.w2[3] = cb[2048 + ch]; }
    const float sk0 = p.skip[(layer * 2 + 0) * 1024 + ch], sk1 = p.skip[(layer * 2 + 1) * 1024 + ch];
    float* __restrict__ z2g = (float*)(scratch + HS_Z2);
    const bf16_t* filt = q == 0 ? (const bf16_t*)(scratch + HS_G2) - 2 * (size_t)L_TOK : (const bf16_t*)scrD + (size_t)(q - 1) * 4 * L_TOK;
    bf16_t* __restrict__ hyout = (bf16_t*)(p.ws + OFF_HYOUT) + (size_t)ch * LP;
    if (q > 0) { __syncthreads(); filt_to_lds(filt, filt + L_TOK, cf, side); }
    hy_conv<0>(hc, cf, side, scratch);
    {   u32x4 ru_[4], r1_[4]; float ul[4], uh[4], xl[4], xh[4];
#pragma unroll
        for (int i = 0; i < 4; ++i) { const int c = tid + NTHREADS * i; hy_load8(hc.ru, 8 * c, ru_[i], ul[i], uh[i]); hy_load8(hc.r1, 8 * c, r1_[i], xl[i], xh[i]); }
#pragma unroll
        for (int i = 0; i < 5; ++i) { const int c = i < 4 ? tid + NTHREADS * i : NCHUNK - 2 + tid;
            if (i < 4 || tid < 2) { float u8[8], x8[8];
                if (i < 4) { hy_calc8(ru_[i], ul[i], uh[i], hc.wu, u8); hy_calc8(r1_[i], xl[i], xh[i], hc.w1, x8); } else { hy_val8(hc.ru, 8 * c, hc.wu, u8); hy_val8(hc.r1, 8 * c, hc.w1, x8); }
                const float2* s = cf + PADI(4 * c); const float2 y0 = s[0], y1 = s[1], y2 = s[2], y3 = s[3];
                const f32x4 o0 = (f32x4){x8[0] * (y0.x + sk0 * u8[0]), x8[1] * (y0.y + sk0 * u8[1]), x8[2] * (y1.x + sk0 * u8[2]), x8[3] * (y1.y + sk0 * u8[3])};
                const f32x4 o1 = (f32x4){x8[4] * (y2.x + sk0 * u8[4]), x8[5] * (y2.y + sk0 * u8[5]), x8[6] * (y3.x + sk0 * u8[6]), x8[7] * (y3.y + sk0 * u8[7])};
                *(f32x4*)(z2g + 8 * c) = o0; *(f32x4*)(z2g + 8 * c + 4) = o1; } } }
    __syncthreads();
    filt_to_lds(filt + 2 * (size_t)L_TOK, filt + 3 * (size_t)L_TOK, cf, side);
    hy_conv<1>(hc, cf, side, scratch);
    {   u32x4 r2_[4]; float xl[4], xh[4]; f32x4 z0[4], z1[4];
#pragma unroll
        for (int i = 0; i < 4; ++i) { const int c = tid + NTHREADS * i; hy_load8(hc.r2, 8 * c, r2_[i], xl[i], xh[i]); z0[i] = *(const f32x4*)(z2g + 8 * c); z1[i] = *(const f32x4*)(z2g + 8 * c + 4); }
#pragma unroll
        for (int i = 0; i < 5; ++i) { const int c = i < 4 ? tid + NTHREADS * i : NCHUNK - 2 + tid;
            if (i < 4 || tid < 2) { float x8[8]; f32x4 p0, p1;
                if (i < 4) { hy_calc8(r2_[i], xl[i], xh[i], hc.w2, x8); p0 = z0[i]; p1 = z1[i]; } else { hy_val8(hc.r2, 8 * c, hc.w2, x8); p0 = *(const f32x4*)(z2g + 8 * c); p1 = *(const f32x4*)(z2g + 8 * c + 4); }
                const float2* s = cf + PADI(4 * c); const float2 y0 = s[0], y1 = s[1], y2 = s[2], y3 = s[3];
                u32x4 w; w.x = cvt_pk_bf16(x8[0] * (y0.x + sk1 * p0[0]), x8[1] * (y0.y + sk1 * p0[1])); w.y = cvt_pk_bf16(x8[2] * (y1.x + sk1 * p0[2]), x8[3] * (y1.y + sk1 * p0[3]));
                w.z = cvt_pk_bf16(x8[4] * (y2.x + sk1 * p1[0]), x8[5] * (y2.y + sk1 * p1[1])); w.w = cvt_pk_bf16(x8[6] * (y3.x + sk1 * p1[2]), x8[7] * (y3.y + sk1 * p1[3]));
                *(u32x4*)(hyout + 8 * c) = w; } } }
    __syncthreads();
}

__device__ void transpose_phase(const Params& p, unsigned char* smem) {
    const int tid = opaque_tid(), G = gridDim.x; bf16_t* tile0 = (bf16_t*)smem;
    const bf16_t* __restrict__ hyout = (const bf16_t*)(p.ws + OFF_HYOUT); bf16_t* ya = (bf16_t*)(p.ws + OFF_GATE);
    const int cl = tid >> 3, t8 = (tid & 7) * 8, tl = tid >> 3, c8 = (tid & 7) * 8;
    u32x4 ph = (u32x4){0u, 0u, 0u, 0u}, pg = ph;
    constexpr int TOT = 16 * 257;
    int u = blockIdx.x;
    __syncthreads();
    if (u < TOT) { const int ct = u & 15, tt = u >> 4; ph = *(const u32x4*)(hyout + (size_t)(ct * 64 + cl) * LP + tt * 64 + t8); const int t = tt * 64 + tl; if (t < L_TOK) pg = *(const u32x4*)(ya + (size_t)t * 1024 + ct * 64 + c8); }
    int buf = 0;
    for (; u < TOT; u += G) { bf16_t* tile = tile0 + buf * (64 * 72); const int ct = u & 15, tt = u >> 4;
        *(u32x4*)(tile + cl * 72 + t8) = ph; const u32x4 g = pg;
        { const int un = u + G; if (un < TOT) { const int ct2 = un & 15, tt2 = un >> 4; ph = *(const u32x4*)(hyout + (size_t)(ct2 * 64 + cl) * LP + tt2 * 64 + t8); const int t2 = tt2 * 64 + tl; if (t2 < L_TOK) pg = *(const u32x4*)(ya + (size_t)t2 * 1024 + ct2 * 64 + c8); } }
        __syncthreads();
        const int t = tt * 64 + tl;
        if (t < L_TOK) { float v[8];
#pragma unroll
            for (int i = 0; i < 8; ++i) v[i] = bf2f(tile[(c8 + i) * 72 + tl]);
            u32x4 w; w.x = cvt_pk_bf16(v[0] * lo_bf(g.x), v[1] * hi_bf(g.x)); w.y = cvt_pk_bf16(v[2] * lo_bf(g.y), v[3] * hi_bf(g.y)); w.z = cvt_pk_bf16(v[4] * lo_bf(g.z), v[5] * hi_bf(g.z)); w.w = cvt_pk_bf16(v[6] * lo_bf(g.w), v[7] * hi_bf(g.w));
            *(u32x4*)(ya + (size_t)t * 1024 + ct * 64 + c8) = w; }
        buf ^= 1; }
    __syncthreads();
}

__device__ void phase_final(const Params& p) {
    const int tid = opaque_tid(), lane = tid & 63, wv = tid >> 6; const float* h = (const float*)(p.ws + OFF_H);
    for (int l = NMETA + blockIdx.x * 8 + wv; l < L_TOK; l += gridDim.x * 8) { const f32x4* row = (const f32x4*)(h + (size_t)l * DM); f32x4 v[8]; float ss = 0.f;
#pragma unroll
        for (int i = 0; i < 8; ++i) { v[i] = row[i * 64 + lane]; ss += v[i][0] * v[i][0] + v[i][1] * v[i][1] + v[i][2] * v[i][2] + v[i][3] * v[i][3]; }
        ss = wave_sum(ss); const float inv = rsqrtf(ss * (1.0f / DM) + 1e-6f); f32x4* o = (f32x4*)(p.out + (size_t)(l - NMETA) * DM);
#pragma unroll
        for (int i = 0; i < 8; ++i) { const f32x4 gg = ((const f32x4*)p.final_g)[i * 64 + lane]; o[i * 64 + lane] = v[i] * inv * gg; } }
}

__device__ void mini_branch(const Params& p) {
    const int tid = opaque_tid(), lane = tid & 63, wv = tid >> 6, nt_ = blockIdx.x * 8 + wv;
    if (nt_ < 128) { const int rc = lane & 15, quad = lane >> 4; const int n0 = nt_ * 16;
        const bf16_t* mg = (const bf16_t*)(p.ws + OFF_MERGE); bf16_t* mb = (bf16_t*)(p.ws + OFF_M);
        float tot[4] = {0.f, 0.f, 0.f, 0.f};
#pragma unroll 1
        for (int br = 0; br < 3; ++br) { const bf16_t* A = (const bf16_t*)(p.ws + OFF_GATE + (size_t)br * SZ_GATE) + (size_t)(NMAIN + rc) * 1024 + quad * 8;
            const bf16_t* B = (const bf16_t*)(p.ws + OFF_WA + (size_t)br * SZ_WBR) + (size_t)(n0 + rc) * 1024 + quad * 8;
            f32x4 acc = (f32x4){0.f, 0.f, 0.f, 0.f};
#pragma unroll 1
            for (int kb = 0; kb < 32; kb += 8) { bf16x8 av[8], bv[8];
#pragma unroll
                for (int i = 0; i < 8; ++i) { av[i] = *(const bf16x8*)(A + (kb + i) * 32); bv[i] = *(const bf16x8*)(B + (kb + i) * 32); }
#pragma unroll
                for (int i = 0; i < 8; ++i) acc = __builtin_amdgcn_mfma_f32_16x16x32_bf16(av[i], bv[i], acc, 0, 0, 0); }
#pragma unroll
            for (int r = 0; r < 4; ++r) tot[r] += acc[r] * bf2f(mg[(size_t)(NMAIN + quad * 4 + r) * 6144 + br * 2048 + n0 + rc]); }
#pragma unroll
        for (int r = 0; r < 4; ++r) mb[(size_t)(NMAIN + quad * 4 + r) * DM + n0 + rc] = f2bf(tot[r]); }
}
__device__ void mini_out(const Params& p, int layer) {
    const int tid = opaque_tid(), lane = tid & 63, wv = tid >> 6, nt_ = blockIdx.x * 8 + wv;
    if (nt_ < 128) { const int rc = lane & 15, quad = lane >> 4; const int n0 = nt_ * 16;
        const bf16_t* A = (const bf16_t*)(p.ws + OFF_M) + (size_t)(NMAIN + rc) * DM + quad * 8; const bf16_t* B = (const bf16_t*)(p.ws + OFF_WO) + (size_t)(n0 + rc) * DM + quad * 8;
        f32x4 acc = (f32x4){0.f, 0.f, 0.f, 0.f};
#pragma unroll 1
        for (int kb = 0; kb < 64; kb += 8) { bf16x8 av[8], bv[8];
#pragma unroll
            for (int i = 0; i < 8; ++i) { av[i] = *(const bf16x8*)(A + (kb + i) * 32); bv[i] = *(const bf16x8*)(B + (kb + i) * 32); }
#pragma unroll
            for (int i = 0; i < 8; ++i) acc = __builtin_amdgcn_mfma_f32_16x16x32_bf16(av[i], bv[i], acc, 0, 0, 0); }
        float* h = (float*)(p.ws + OFF_H);
#pragma unroll
        for (int r = 0; r < 4; ++r) { const size_t row = NMAIN + quad * 4 + r; const float bs = layer == 0 ? p.x[(row - NMETA) * DM + n0 + rc] : h[row * DM + n0 + rc]; h[row * DM + n0 + rc] = bs + acc[r]; } }
}

#define XB_TMO      128
#define XB_XCNT(j)  (256  + 64 * (j))
#define XB_XSUB(j)  (1280 + 64 * (j))
#define XB_XGEN(j)  (2304 + 64 * (j))
#define XB_TOP      3328
#define XB_TOPGEN   3392
#define XCD_BAR_WORDS 3456
#define XB_SPIN_CAP (1u << 18)
__device__ __forceinline__ unsigned xb_ld(unsigned* p)              { return __hip_atomic_load(p, __ATOMIC_RELAXED, __HIP_MEMORY_SCOPE_AGENT); }
__device__ __forceinline__ unsigned xb_add(unsigned* p, unsigned v) { return __hip_atomic_fetch_add(p, v, __ATOMIC_RELAXED, __HIP_MEMORY_SCOPE_AGENT); }
__device__ __forceinline__ unsigned xb_xcc_id() { return (unsigned)__builtin_amdgcn_s_getreg((3 << 11) | 20) & 0xFu; }
#define XB_SPIN(cond, bar) do { unsigned _sp = 0; while (cond) { __builtin_amdgcn_s_sleep(1); \
    if ((++_sp & 255u) == 0u) { if (xb_ld(&(bar)[XB_TMO])) break; if (_sp > XB_SPIN_CAP) { atomicAdd(&(bar)[XB_TMO], 1u); break; } } } } while (0)
struct XcdBarrier { unsigned* bar; unsigned x; volatile LAS unsigned* st; };
__device__ __forceinline__ void xcd_barrier_complete(unsigned* bar, unsigned x, unsigned& nloc, unsigned& nx) {
    const unsigned G = gridDim.x * gridDim.y * gridDim.z;
    unsigned sum, cnt, mine, sp = 0u;
    for (;;) {
        sum = 0u; cnt = 0u; mine = 0u;
#pragma unroll
        for (unsigned j = 0; j < 16; ++j) { const unsigned c = xb_ld(&bar[XB_XCNT(j)]); sum += c; cnt += (c > 0u) ? 1u : 0u; mine = (j == x) ? c : mine; }
        if (sum == G) break;
        __builtin_amdgcn_s_sleep(1);
        if ((++sp & 255u) == 0u) { if (xb_ld(&bar[XB_TMO])) break; if (sp > XB_SPIN_CAP) { atomicAdd(&bar[XB_TMO], 1u); break; } }
    }
    nloc = mine > 0u ? mine : 1u; nx = cnt > 0u ? cnt : 1u;
}
__device__ __forceinline__ void xcd_barrier(const XcdBarrier& b) {
    asm volatile("s_waitcnt vmcnt(0)" ::: "memory");
    __syncthreads();
    if (threadIdx.x == 0) {
        unsigned* bar = b.bar;
        __builtin_amdgcn_s_waitcnt(0);
        unsigned nloc = b.st[0], nx = b.st[1];
        if (nloc == 0u) { xcd_barrier_complete(bar, b.x, nloc, nx); b.st[0] = nloc; b.st[1] = nx; }
        const unsigned old = xb_add(&bar[XB_XSUB(b.x)], 1u);
        const unsigned gen = old / nloc;
        if (old + 1u == (gen + 1u) * nloc) {
            __builtin_amdgcn_fence(__ATOMIC_RELEASE, "agent");
            asm volatile("s_waitcnt vmcnt(0)" ::: "memory");
            const unsigned og = xb_add(&bar[XB_TOP], 1u);
            const unsigned tg = og / nx;
            if (og + 1u == (tg + 1u) * nx) xb_add(&bar[XB_TOPGEN], 1u);
            else XB_SPIN(xb_ld(&bar[XB_TOPGEN]) == tg, bar);
            __builtin_amdgcn_fence(__ATOMIC_ACQUIRE, "agent");
            xb_add(&bar[XB_XGEN(b.x)], 1u);
            asm volatile("s_waitcnt vmcnt(0)" ::: "memory");
        } else {
            XB_SPIN(xb_ld(&bar[XB_XGEN(b.x)]) == gen, bar);
            __builtin_amdgcn_fence(__ATOMIC_ACQUIRE, "agent");
            asm volatile("s_waitcnt vmcnt(0)" ::: "memory");
        }
    }
    __syncthreads();
}

enum { OP_P1 = 0, OP_SYNC, OP_GEMM, OP_NA, OP_HYENA, OP_TRANS, OP_NOP };
__global__ void __launch_bounds__(512, 2) hybrid_fwd(Params p) {
    extern __shared__ __attribute__((aligned(16))) unsigned char smem[];
    cg::grid_group grid = cg::this_grid();
    LAS unsigned char* lds = (LAS unsigned char*)smem;
    const int bid = blockIdx.x, G = gridDim.x;
    XcdBarrier xb; xb.bar = (unsigned*)(p.ws + OFF_BAR); xb.x = xb_xcc_id(); xb.st = (volatile LAS unsigned*)(lds + LDS_PHASE_BYTES);
    if (bid == 0) for (int i = opaque_tid(); i < XCD_BAR_WORDS; i += NTHREADS) xb.bar[i] = 0u;
    if (opaque_tid() == 0) { xb.st[0] = 0u; xb.st[1] = 0u; }
    __syncthreads();
    phase_prep0(p, smem);
    constexpr int NOPS = 17;
#pragma clang loop unroll(disable)
    for (int step = 0; step < 2 * NOPS; ++step) {
        const int layer = step / NOPS, s = step - layer * NOPS;
        int op, kind = 0;
        switch (s) {
        case 0: op = OP_P1; break;
        case 2: op = OP_GEMM; kind = K_IN; break;
        case 3: case 4: op = OP_NOP; break;
        case 6: op = OP_GEMM; kind = K_FNA; break;
        case 7: op = OP_NA; break;
        case 8: op = OP_HYENA; break;
        case 10: op = OP_GEMM; kind = K_FNB; break;
        case 11: op = OP_TRANS; break;
        case 13: op = OP_GEMM; kind = K_BR; break;
        case 15: op = OP_GEMM; kind = K_OUT; break;
        default: op = OP_SYNC; break;
        }
        if (op == OP_NOP) { }
        else if (op == OP_SYNC) { if (step == 1) { grid.sync(); if (opaque_tid() == 0) (void)xb_add(&xb.bar[XB_XCNT(xb.x)], 1u); } else xcd_barrier(xb); }
        else if (op == OP_GEMM) {
            Gemm g; g.base = (const char*)p.ws; g.jumpA = 0; g.jumpB = 0;
            switch (kind) {
            case K_FNA: g.lda = 384; g.ldb = FN1P; g.nt = 6; g.ksplit = 3; g.jumpB = (long)((size_t)1024 * PROWS * 2) - 384l; break;
            case K_FNB: g.lda = 256; g.ldb = 256; g.nt = 4; g.ksplit = 4; break;
            case K_BR:  g.lda = 1024; g.ldb = 1024; g.nt = 16; g.ksplit = 16; break;
            default:    g.lda = DM; g.ldb = DM; g.nt = 32; g.ksplit = 32; break;
            }
            SchedAny S{kind, G, bid}; EpiAny E{kind, p.ws, layer, p.x, p.meta};
            if (kind == K_BR) { EpiBr EB{p.ws}; pg8::gemm_phase(lds, g, S, EB); } else pg8::gemm_phase(lds, g, S, E);
            if (kind == K_BR) mini_branch(p); else if (kind == K_OUT) mini_out(p, layer);
        }
        else if (op == OP_P1) { phase_p1(p, layer, smem); }
        else if (op == OP_NA) { na_phase(p, layer, smem); if (bid == G - 1) na_meta_unit(p, layer); }
        else if (op == OP_HYENA) { unsigned char* scrD = (unsigned char*)p.out + (size_t)bid * HSD_STRIDE; unsigned char* scrW = p.ws + WS_END + (size_t)bid * HSW_STRIDE;
            hyena_filters(p, layer, smem, scrD, scrW);
#pragma clang loop unroll(disable)
            for (int q = 0; q < 4; ++q) hyena_unit(p, layer, q, smem, scrD, scrW); }
        else { transpose_phase(p, smem); }
    }
    phase_final(p);
}

extern "C" void kernel_launch(void* const* d_in, const int* in_sizes, int n_in, void* d_out, int out_size, void* d_ws, size_t ws_size, hipStream_t stream) {
    static int grid_blocks = 0;
    if (grid_blocks == 0) {
        if (n_in != 23 || ws_size < WS_END2) { fprintf(stderr, "kernel_launch: need 23 inputs and %zu bytes of workspace (got %d, %zu)\n", (size_t)WS_END2, n_in, ws_size); grid_blocks = -1; return; }
        int dev = 0, cus = 0, per_cu = 0;
        hipGetDevice(&dev); hipDeviceGetAttribute(&cus, hipDeviceAttributeMultiprocessorCount, dev);
        if (hipFuncSetAttribute((const void*)hybrid_fwd, hipFuncAttributeMaxDynamicSharedMemorySize, LDS_BYTES) != hipSuccess) { fprintf(stderr, "kernel_launch: hipFuncSetAttribute failed\n"); grid_blocks = -1; return; }
        hipOccupancyMaxActiveBlocksPerMultiprocessor(&per_cu, (const void*)hybrid_fwd, NTHREADS, LDS_BYTES);
        if (per_cu < 1) per_cu = 1;
        grid_blocks = cus * per_cu;
        if (grid_blocks > 256) grid_blocks = 256;
        if (grid_blocks != 256) { fprintf(stderr, "kernel_launch: this kernel needs 256 co-resident workgroups (got %d)\n", grid_blocks); grid_blocks = -1; return; }
    }
    if (grid_blocks < 0) return;
    Params p{};
    const float** f = (const float**)&p;
    for (int i = 0; i < 23; ++i) f[i] = (const float*)d_in[i];
    p.out = (float*)d_out; p.ws = (unsigned char*)d_ws;
    void* args[] = {&p};
    hipError_t e = hipLaunchCooperativeKernel((const void*)hybrid_fwd, dim3(grid_blocks), dim3(NTHREADS), args, LDS_BYTES, stream);
    if (e != hipSuccess) fprintf(stderr, "cooperative launch failed: %s (grid %d)\n", hipGetErrorString(e), grid_blocks);
}
```
